# Optimizing an MI355X kernel written in HIP

```python
import jax, jax.numpy as jnp
from jax import lax
import numpy as np

D_MODEL = 1024
BATCH = 16
SEQ = 2048
DEPTH = 1

EPS = 1e-6
N_MEM = 256
BRANCH_WIDTH = 512
N_BRANCH = 3
HG_HEADS = 4
HG_DK = 128
HG_DV = 128
HG_WIDTH = HG_HEADS * HG_DV
HG_CHUNK = 64
SC_WIDTH = BRANCH_WIDTH
SC_KERNEL = 3
MX_HEADS = 4
MX_HD = 128
MX_WIDTH = MX_HEADS * MX_HD
IN_SPLITS = tuple(BRANCH_WIDTH * i for i in range(1, 10))
IN_COLS = 9 * BRANCH_WIDTH + N_BRANCH * D_MODEL
PEER_HEADS = 8
PEER_NKEYS = 128
PEER_N = PEER_NKEYS * PEER_NKEYS
PEER_DQ = 256
PEER_TOPK = 16
PEER_TOKEN_BLOCK = 128

kernel_name = "hybrid_hgrn2_shortconv_memattn_peer_encoder"


def rms_norm(x, g):
    xf = x.astype(jnp.float32)
    y = xf * lax.rsqrt(jnp.mean(xf * xf, axis=-1, keepdims=True) + EPS)
    return (y * g.astype(jnp.float32)).astype(x.dtype)


def hgrn2_chunk_scan(q, k, v, log_f):
    B, S, H, _ = q.shape
    C = HG_CHUNK
    n = S // C
    to_chunks = lambda t: t.reshape(B, n, C, H, t.shape[-1]).transpose(0, 3, 1, 2, 4)
    q, k, v, log_f = map(to_chunks, (q, k, v, log_f))
    G = jnp.cumsum(log_f, axis=3)
    G_ref = G[:, :, :, C // 2 - 1:C // 2, :]
    q_r = q * jnp.exp(G - G_ref)
    k_r = k * jnp.exp(G_ref - G)
    scores = jnp.einsum('bhncd,bhnsd->bhncs', q_r, k_r)
    mask = jnp.tril(jnp.ones((C, C), dtype=bool))
    intra = jnp.einsum('bhncs,bhnse->bhnce', jnp.where(mask, scores, 0.0), v)
    G_last = G[:, :, :, -1:, :]
    dS = jnp.einsum('bhncd,bhnce->bhnde', k * jnp.exp(G_last - G), v)
    decay = jnp.exp(G_last[:, :, :, 0, :])

    def step(S_prev, inp):
        dS_c, dec_c = inp
        return dec_c[..., None] * S_prev + dS_c, S_prev

    S0 = jnp.zeros((B, H, q.shape[-1], v.shape[-1]), jnp.float32)
    _, S_start = lax.scan(step, S0, (jnp.moveaxis(dS, 2, 0), jnp.moveaxis(decay, 2, 0)))
    S_start = jnp.moveaxis(S_start, 0, 2)
    inter = jnp.einsum('bhncd,bhnde->bhnce', q * jnp.exp(G), S_start)
    o = intra + inter
    return o.transpose(0, 2, 3, 1, 4).reshape(B, S, H, v.shape[-1])


def hgrn2_direction(q, v, z, lb, reverse):
    B, S = z.shape[:2]
    zf = z.astype(jnp.float32)
    log_f = jnp.log(lb + (1.0 - lb) * jax.nn.sigmoid(zf))
    k = (1.0 - lb) * jax.nn.sigmoid(-zf)
    heads = lambda t: t.reshape(B, S, HG_HEADS, HG_DK)
    args = (heads(q), heads(k), v.reshape(B, S, HG_HEADS, HG_DV), heads(log_f))
    if reverse:
        args = tuple(jnp.flip(t, axis=1) for t in args)
    o = hgrn2_chunk_scan(*args)
    return jnp.flip(o, axis=1) if reverse else o


def token_mixers(h, mem, w_in, lb, hg_norm_g, sc_conv_w, mem_norm_g, w_mem_kv, w_branch, w_out):
    B, S, _ = h.shape
    proj = h @ w_in
    hq, hi, hf_fwd, hf_bwd, hg, sb, sc, sh, mq, gates = jnp.split(proj, IN_SPLITS, axis=-1)

    q = jax.nn.silu(hq.astype(jnp.float32))
    v = hi.astype(jnp.float32)
    o = hgrn2_direction(q, v, hf_fwd, lb[0], False) + hgrn2_direction(q, v, hf_bwd, lb[1], True)
    o = o * lax.rsqrt(jnp.mean(o * o, axis=-1, keepdims=True) + EPS)
    y_hg = (o.reshape(B, S, HG_WIDTH) * hg_norm_g.astype(jnp.float32)
            * jax.nn.silu(hg.astype(jnp.float32))).astype(h.dtype)

    u = sc * sh
    conv = lax.conv_general_dilated(u, sc_conv_w[:, None, :], window_strides=(1,), padding='SAME',
                                    dimension_numbers=('NWC', 'WIO', 'NWC'),
                                    feature_group_count=SC_WIDTH)
    y_sc = sb * conv

    m = rms_norm(mem, mem_norm_g)
    mk, mv = jnp.split(m @ w_mem_kv, 2, axis=-1)
    qh = mq.reshape(B, S, MX_HEADS, MX_HD)
    kh = mk.reshape(B, N_MEM, MX_HEADS, MX_HD)
    vh = mv.reshape(B, N_MEM, MX_HEADS, MX_HD)
    logits = jnp.einsum('bshd,bmhd->bhsm', qh, kh).astype(jnp.float32) * (MX_HD ** -0.5)
    p = jax.nn.softmax(logits, axis=-1).astype(h.dtype)
    y_mx = jnp.einsum('bhsm,bmhd->bshd', p, vh).reshape(B, S, MX_WIDTH)

    branches = jnp.stack([y_hg, y_sc, y_mx], axis=2)
    projected = jnp.einsum('bsnc,ncd->bsnd', branches, w_branch)
    gate = jax.nn.sigmoid(gates.reshape(B, S, N_BRANCH, D_MODEL))
    merged = jnp.sum(gate * projected, axis=2)
    return merged @ w_out


def peer(h, w_q, sub_keys, u, v):
    B, S, D = h.shape
    T = B * S
    hf = h.reshape(T, D)
    q = (hf @ w_q).reshape(T, PEER_HEADS, 2, PEER_DQ // 2).astype(jnp.float32)
    s = jnp.einsum('thpd,hpkd->thpk', q, sub_keys.astype(jnp.float32))
    top_s, top_i = lax.top_k(s, PEER_TOPK)
    cand_s = (top_s[:, :, 0, :, None] + top_s[:, :, 1, None, :]).reshape(T, PEER_HEADS, -1)
    cand_i = (top_i[:, :, 0, :, None] * PEER_NKEYS + top_i[:, :, 1, None, :]).reshape(T, PEER_HEADS, -1)
    best_s, best_pos = lax.top_k(cand_s, PEER_TOPK)
    expert_idx = jnp.take_along_axis(cand_i, best_pos, axis=-1)
    gate = jax.nn.softmax(best_s, axis=-1).astype(h.dtype)

    nb = T // PEER_TOKEN_BLOCK

    def block(args):
        xb, idxb, gb = args
        ub = jnp.take(u, idxb, axis=0)
        act = jax.nn.gelu(jnp.einsum('td,thkd->thk', xb, ub), approximate=False)
        vb = jnp.take(v, idxb, axis=0)
        return jnp.einsum('thk,thkd->td', gb * act, vb)

    out = lax.map(block, (hf.reshape(nb, PEER_TOKEN_BLOCK, D),
                          expert_idx.reshape(nb, PEER_TOKEN_BLOCK, PEER_HEADS, PEER_TOPK),
                          gate.reshape(nb, PEER_TOKEN_BLOCK, PEER_HEADS, PEER_TOPK)))
    return out.reshape(B, S, D)


def setup_inputs(seed: int = 0) -> dict:
    key = jax.random.key(seed)
    ks = jax.random.split(key, 20)
    f32 = jnp.float32
    nrm = lambda k, shape, scale: jax.random.normal(k, shape, f32) * scale
    gain = lambda k, shape: 1.0 + 0.05 * jax.random.normal(k, shape, f32)
    return {
        "x": nrm(ks[0], (BATCH, SEQ, D_MODEL), 1.0),
        "mem": nrm(ks[1], (BATCH, N_MEM, D_MODEL), 1.0),
        "norm_mix_g": gain(ks[2], (DEPTH, D_MODEL)),
        "w_in": nrm(ks[3], (DEPTH, D_MODEL, IN_COLS), D_MODEL ** -0.5),
        "hg_lb": nrm(ks[4], (DEPTH + 1, 2, HG_WIDTH), 0.1),
        "hg_norm_g": gain(ks[5], (DEPTH, HG_WIDTH)),
        "sc_conv_w": nrm(ks[6], (DEPTH, SC_KERNEL, SC_WIDTH), SC_KERNEL ** -0.5),
        "mem_norm_g": gain(ks[7], (DEPTH, D_MODEL)),
        "w_mem_kv": nrm(ks[8], (DEPTH, D_MODEL, 2 * MX_WIDTH), D_MODEL ** -0.5),
        "w_branch": nrm(ks[9], (DEPTH, N_BRANCH, BRANCH_WIDTH, D_MODEL), BRANCH_WIDTH ** -0.5),
        "w_out": nrm(ks[10], (DEPTH, D_MODEL, D_MODEL), D_MODEL ** -0.5),
        "norm_ffn_g": gain(ks[11], (DEPTH, D_MODEL)),
        "peer_w_q": nrm(ks[12], (DEPTH, D_MODEL, PEER_HEADS * PEER_DQ), D_MODEL ** -0.5),
        "peer_sub_keys": nrm(ks[13], (DEPTH, PEER_HEADS, 2, PEER_NKEYS, PEER_DQ // 2), (PEER_DQ // 2) ** -0.5),
        "peer_u": nrm(ks[14], (DEPTH, PEER_N, D_MODEL), D_MODEL ** -0.5),
        "peer_v": nrm(ks[15], (DEPTH, PEER_N, D_MODEL), D_MODEL ** -0.5),
        "final_norm_g": gain(ks[16], (D_MODEL,)),
    }


def reference(x, mem, norm_mix_g, w_in, hg_lb, hg_norm_g, sc_conv_w, mem_norm_g, w_mem_kv,
              w_branch, w_out, norm_ffn_g, peer_w_q, peer_sub_keys, peer_u, peer_v, final_norm_g):
    lb_table = jnp.cumsum(jax.nn.softmax(hg_lb.astype(jnp.float32), axis=0), axis=0)
    for l in range(DEPTH):
        h = rms_norm(x, norm_mix_g[l])
        x = x + token_mixers(h, mem, w_in[l], lb_table[l], hg_norm_g[l], sc_conv_w[l],
                             mem_norm_g[l], w_mem_kv[l], w_branch[l], w_out[l])
        h = rms_norm(x, norm_ffn_g[l])
        x = x + peer(h, peer_w_q[l], peer_sub_keys[l], peer_u[l], peer_v[l])
    return rms_norm(x, final_norm_g)
```

```cpp
#include <hip/hip_runtime.h>
#include <cstdio>
#include <cstdint>

#ifndef MK_N_LAUNCHES
#define MK_N_LAUNCHES 0
#endif

#define LAS __attribute__((address_space(3)))
#define GAS __attribute__((address_space(1)))
typedef unsigned short bf16;
typedef short bf16x8 __attribute__((ext_vector_type(8)));
typedef short s16x4 __attribute__((ext_vector_type(4)));
typedef short v4i16_t __attribute__((ext_vector_type(4)));
typedef float f32x2 __attribute__((ext_vector_type(2)));
typedef float f32x4 __attribute__((ext_vector_type(4)));
typedef float f32x16 __attribute__((ext_vector_type(16)));
typedef unsigned u32x2 __attribute__((ext_vector_type(2)));
typedef unsigned u32x4 __attribute__((ext_vector_type(4)));
typedef __bf16 bf16x2_t __attribute__((ext_vector_type(2)));
typedef GAS unsigned gu32;
#define RLX_AGENT __ATOMIC_RELAXED, __HIP_MEMORY_SCOPE_AGENT
#define DI __device__ __forceinline__

constexpr int D_MODEL = 1024, BATCH = 16, SEQ = 2048, T_ALL = BATCH * SEQ;
constexpr int NGRP = 2, BG = BATCH / NGRP, TG = BG * SEQ;
constexpr int PC = 7680;
constexpr int C_HQ = 0, C_HI = 512, C_FF = 1024, C_FB = 1536, C_HG = 2048, C_SB = 2560, C_SC = 3072, C_SH = 3584, C_MQ = 4096, C_GATE = 4608;
constexpr int NMEM = 256, CHUNK = 64, NCHUNK = SEQ / CHUNK;
constexpr float EPS = 1e-6f;

constexpr size_t MiB = 1u << 20;
constexpr size_t WS_CTL = 0, CTL_ZERO_BYTES = 1 * MiB;
constexpr size_t WS_LB = 1 * MiB;
constexpr size_t WS_SSP = 2 * MiB;
constexpr size_t WS_DEC = 4 * MiB;
constexpr size_t WS_WIN = 5 * MiB, WS_WKV = 20 * MiB, WS_WBR = 22 * MiB, WS_WOUT = 25 * MiB, WS_WQ = 27 * MiB, WS_KBD = 31 * MiB;
constexpr size_t WS_MN = 32 * MiB, WS_KMEM = 40 * MiB, WS_VT = 44 * MiB;
constexpr size_t WS_XG = 48 * MiB;
constexpr size_t WS_YHG = 112 * MiB, WS_YSC = 128 * MiB, WS_YMX = 144 * MiB;
constexpr size_t WS_DS = 160 * MiB;
constexpr size_t WS_MACC = 160 * MiB;
constexpr size_t WS_MERGED = 224 * MiB;
constexpr size_t WS_PROJ = 256 * MiB;
constexpr size_t WS_U = 112 * MiB, WS_V = 144 * MiB;
constexpr size_t WS_Q = 176 * MiB;
constexpr size_t WS_S = 256 * MiB;
constexpr size_t WS_END = 496 * MiB;
constexpr size_t OUT_SST = 64 * MiB;

constexpr int LDS_BYTES = 160 * 1024;
constexpr int MISC_OFF = LDS_BYTES - 512;
constexpr int NWAVES = 8;

DI unsigned f2bf(float f) { unsigned u = __builtin_bit_cast(unsigned, f); return (u + 0x7fffu + ((u >> 16) & 1u)) >> 16; }
DI unsigned pk2(float lo, float hi) { return f2bf(lo) | (f2bf(hi) << 16); }
DI float bf2f(unsigned short b) { return __builtin_bit_cast(float, (unsigned)b << 16); }
DI float bflo(unsigned w) { return __builtin_bit_cast(float, w << 16); }
DI float bfhi(unsigned w) { return __builtin_bit_cast(float, w & 0xffff0000u); }
DI float wave_sum(float v) {
#pragma unroll
    for (int o = 1; o < 64; o <<= 1) v += __shfl_xor(v, o);
    return v;
}
DI unsigned cvtpk(float lo, float hi) { f32x2 v = {lo, hi}; bf16x2_t b = __builtin_convertvector(v, bf16x2_t); return __builtin_bit_cast(unsigned, b); }
DI float sigmoidf_(float z) { return 1.0f / (1.0f + __expf(-z)); }

namespace pg8 {
constexpr int BM = 256, BK = 64, HALF = 128, HTB = HALF * BK * 2, STAGE_BYTES = 8 * HTB, NXCD = 8, WGM = 8;
__host__ __device__ __forceinline__ int lds_byte(int r, int c) { const int st = (r >> 4) * 2 + (c >> 5), rr = r & 15, cc = c & 31, ob = rr * 64 + cc * 2; return st * 1024 + (ob ^ (((ob >> 9) & 1) << 5)); }
__host__ __device__ __forceinline__ void stage_rc(int b, int& R, int& C) { const int st = b / 1024, sb = b % 1024, swz = sb ^ (((sb >> 9) & 1) << 5); R = (st >> 1) * 16 + swz / 64; C = (st & 1) * 32 + (swz % 64) / 2; }
__host__ __device__ __forceinline__ int perm32(int rho) { const int n = rho >> 4, i = rho & 15; return 8 * (i >> 2) + 4 * n + (i & 3); }

struct Unit { int pm, pn, z; };
struct Gemm { int lda, ldb, K; };

struct StaticOrder {
    int nM, nN, nwg, G, c;
    __device__ void init(int M, int N, int G_, int c_) { nM = M / BM; nN = N / BM; nwg = nM * nN; G = G_; c = c_; }
    __device__ bool tile(int i, Unit& u) const {
        const long L = (long)i * G + c; if (L >= nwg) return false;
        int wgid = (int)L; { const int q = nwg / NXCD, r = nwg % NXCD, xcd = wgid % NXCD, off = wgid / NXCD; wgid = (xcd < r ? xcd * (q + 1) : r * (q + 1) + (xcd - r) * q) + off; }
        const int nig = WGM * nN, gid = wgid / nig, fm = gid * WGM, gsz = (nM - fm) < WGM ? (nM - fm) : WGM;
        u.pm = fm + ((wgid % nig) % gsz); u.pn = (wgid % nig) / gsz; u.z = 0; return true;
    }
};

DI unsigned cvt_pk_bf16(float lo, float hi) { return cvtpk(lo, hi); }

template <class Epi, class Sched, bool ALIGN_EPI, bool SP2>
DI void gemm_phase(LAS unsigned char* lds, const Gemm g, const Sched& S, const Epi& E) {
    int tid_ = threadIdx.x; asm volatile("" : "+v"(tid_));
    const int tid = tid_, wid = __builtin_amdgcn_readfirstlane(tid >> 6), lane = tid & 63, wr = wid >> 2, wc = wid & 3, fr = lane & 15, fq = lane >> 4;
    int K_ = g.K; asm volatile("" : "+s"(K_));
    const int K = K_, nt = K / BK;
    unsigned voffA[2], voffB[2];
#pragma unroll
    for (int i = 0; i < 2; ++i) { int R, C; stage_rc(tid * 16 + i * 8192, R, C); const int Rb = Epi::PERM ? ((R & ~31) + perm32(R & 31)) : R;
        voffA[i] = (unsigned)(R * g.lda + C) * 2u; voffB[i] = (unsigned)(Rb * g.ldb + C) * 2u; }
    const size_t kstep = (size_t)(BK * 2);
    const size_t hA = (size_t)HALF * g.lda * 2, hB = (size_t)HALF * g.ldb * 2;
    const unsigned ldsw = (unsigned)wid * 1024u;
    const int aoff = lds_byte(wr * 64 + fr, fq * 8), boff = lds_byte(wc * 32 + fr, fq * 8);
#define PG8_SA(b, h) (((b) * 2 + (h)) * HTB)
#define PG8_SB(b, h) ((4 + (b) * 2 + (h)) * HTB)
#define PG8_STAGE(bufoff, gbase, voff) do { _Pragma("unroll") for (int _i = 0; _i < 2; ++_i) \
        __builtin_amdgcn_global_load_lds((const unsigned*)((const char*)(gbase) + (voff)[_i]), (LAS unsigned*)(lds + (bufoff) + ldsw + _i * 8192), 16, 0, 0); } while (0)
#define PG8_LDA(dst, b, h) do { _Pragma("unroll") for (int m = 0; m < 4; ++m) _Pragma("unroll") for (int k = 0; k < 2; ++k) dst[m][k] = *(const LAS bf16x8*)(lds + PG8_SA(b, h) + aoff + m * 2048 + k * 1024); } while (0)
#define PG8_LDB(dst, b, h) do { _Pragma("unroll") for (int n = 0; n < 2; ++n) _Pragma("unroll") for (int k = 0; k < 2; ++k) dst[n][k] = *(const LAS bf16x8*)(lds + PG8_SB(b, h) + boff + n * 2048 + k * 1024); } while (0)
#define PG8_MMA(ai, bj, At, Bt) do { __builtin_amdgcn_s_setprio(1); _Pragma("unroll") for (int m = 0; m < 4; ++m) _Pragma("unroll") for (int n = 0; n < 2; ++n) _Pragma("unroll") for (int k = 0; k < 2; ++k) \
        acc[ai][bj][m][n] = __builtin_amdgcn_mfma_f32_16x16x32_bf16(Bt[n][k], At[m][k], acc[ai][bj][m][n], 0, 0, 0); __builtin_amdgcn_s_setprio(0); } while (0)
#define PG8_WAIT_V(n) asm volatile("s_waitcnt vmcnt(" #n ")" ::: "memory")
#define PG8_WAIT_L(n) asm volatile("s_waitcnt lgkmcnt(" #n ")" ::: "memory")
#define PG8_BAR __builtin_amdgcn_s_barrier()
#define PG8_SCHED __builtin_amdgcn_sched_barrier(0)
    Unit cur, nxt; int ui = 0;
    if (!S.next(0, cur)) return;
    f32x4 acc[2][2][4][2];
#pragma unroll
    for (int a = 0; a < 2; ++a)
#pragma unroll
        for (int b = 0; b < 2; ++b)
#pragma unroll
            for (int m = 0; m < 4; ++m)
#pragma unroll
                for (int n = 0; n < 2; ++n) acc[a][b][m][n] = (f32x4){0.f, 0.f, 0.f, 0.f};
    bf16x8 At[4][2], B0[2][2], B1[2][2];
    const char* cA = S.a_base(cur); const char* cB = S.b_base(cur);
    if constexpr (SP2) {
        PG8_STAGE(PG8_SB(0, 0), cB, voffB); PG8_STAGE(PG8_SB(0, 1), cB + hB, voffB); PG8_STAGE(PG8_SA(0, 0), cA, voffA); PG8_STAGE(PG8_SA(0, 1), cA + hA, voffA);
        if (wr == 1) PG8_BAR;
        PG8_WAIT_V(2); PG8_BAR;
        PG8_STAGE(PG8_SB(1, 0), cB + kstep, voffB); PG8_STAGE(PG8_SA(1, 0), cA + kstep, voffA); PG8_STAGE(PG8_SB(1, 1), cB + hB + kstep, voffB);
        PG8_WAIT_V(6); PG8_BAR;
    } else {
        PG8_STAGE(PG8_SB(0, 0), cB, voffB); PG8_STAGE(PG8_SA(0, 0), cA, voffA); PG8_STAGE(PG8_SB(0, 1), cB + hB, voffB); PG8_STAGE(PG8_SA(0, 1), cA + hA, voffA);
        if (wr == 1) PG8_BAR;
        PG8_WAIT_V(4); PG8_BAR;
        PG8_STAGE(PG8_SB(1, 0), cB + kstep, voffB); PG8_STAGE(PG8_SA(1, 0), cA + kstep, voffA); PG8_STAGE(PG8_SB(1, 1), cB + hB + kstep, voffB);
        PG8_WAIT_V(6); PG8_BAR;
    }
    for (;;) {
        const bool has_next = S.next(ui + 1, nxt);
        const char* nA = has_next ? S.a_base(nxt) : cA; const char* nB = has_next ? S.b_base(nxt) : cB;
        for (int t = 0; t < nt; t += 2) {
            const bool last = (t == nt - 2);
            const char* a1 = cA + (size_t)(t + 1) * kstep;
            const char* a2 = last ? nA : cA + (size_t)(t + 2) * kstep; const char* b2 = last ? nB : cB + (size_t)(t + 2) * kstep;
            const char* a3 = a2 + kstep; const char* b3 = b2 + kstep;
            if constexpr (SP2) {
            PG8_LDB(B0, 0, 0); PG8_LDB(B1, 0, 1); PG8_SCHED; PG8_LDA(At, 0, 0); PG8_STAGE(PG8_SA(1, 1), a1 + hA, voffA);
            PG8_WAIT_V(8); PG8_WAIT_L(0); PG8_BAR; PG8_MMA(0, 0, At, B0); PG8_MMA(0, 1, At, B1); PG8_BAR; PG8_SCHED;
            PG8_LDA(At, 0, 1); PG8_STAGE(PG8_SB(0, 0), b2, voffB); PG8_STAGE(PG8_SB(0, 1), b2 + hB, voffB); PG8_STAGE(PG8_SA(0, 0), a2, voffA);
            PG8_WAIT_V(8); PG8_WAIT_L(0); PG8_BAR; PG8_MMA(1, 0, At, B0); PG8_MMA(1, 1, At, B1); PG8_BAR; PG8_SCHED;
            PG8_LDB(B0, 1, 0); PG8_LDB(B1, 1, 1); PG8_SCHED; PG8_LDA(At, 1, 0); PG8_STAGE(PG8_SA(0, 1), a2 + hA, voffA);
            PG8_WAIT_V(8); PG8_WAIT_L(0); PG8_BAR; PG8_MMA(0, 0, At, B0); PG8_MMA(0, 1, At, B1); PG8_BAR; PG8_SCHED;
            PG8_LDA(At, 1, 1); PG8_STAGE(PG8_SB(1, 0), b3, voffB); PG8_STAGE(PG8_SB(1, 1), b3 + hB, voffB); PG8_STAGE(PG8_SA(1, 0), a3, voffA);
            PG8_WAIT_V(8); PG8_WAIT_L(0); PG8_BAR; PG8_MMA(1, 0, At, B0); PG8_MMA(1, 1, At, B1); PG8_BAR; PG8_SCHED;
            } else {
            PG8_LDB(B0, 0, 0); PG8_SCHED; PG8_LDA(At, 0, 0); PG8_STAGE(PG8_SA(1, 1), a1 + hA, voffA);
            PG8_WAIT_L(8); PG8_BAR; PG8_WAIT_L(0); PG8_MMA(0, 0, At, B0); PG8_BAR; PG8_SCHED;
            PG8_LDB(B1, 0, 1); PG8_STAGE(PG8_SB(0, 0), b2, voffB);
            PG8_BAR; PG8_WAIT_L(0); PG8_MMA(0, 1, At, B1); PG8_BAR;
            PG8_LDA(At, 0, 1); PG8_STAGE(PG8_SA(0, 0), a2, voffA);
            PG8_BAR; PG8_WAIT_L(0); PG8_MMA(1, 0, At, B0); PG8_BAR; PG8_SCHED;
            PG8_STAGE(PG8_SB(0, 1), b2 + hB, voffB);
            PG8_WAIT_V(6); PG8_BAR; PG8_MMA(1, 1, At, B1); PG8_BAR;
            PG8_LDB(B0, 1, 0); PG8_SCHED; PG8_LDA(At, 1, 0); PG8_STAGE(PG8_SA(0, 1), a2 + hA, voffA);
            PG8_WAIT_L(8); PG8_BAR; PG8_WAIT_L(0); PG8_MMA(0, 0, At, B0); PG8_BAR; PG8_SCHED;
            PG8_LDB(B1, 1, 1); PG8_STAGE(PG8_SB(1, 0), b3, voffB);
            PG8_BAR; PG8_WAIT_L(0); PG8_MMA(0, 1, At, B1); PG8_BAR;
            PG8_LDA(At, 1, 1); PG8_STAGE(PG8_SA(1, 0), a3, voffA);
            PG8_BAR; PG8_WAIT_L(0); PG8_MMA(1, 0, At, B0); PG8_BAR; PG8_SCHED;
            PG8_STAGE(PG8_SB(1, 1), b3 + hB, voffB);
            PG8_WAIT_V(6); PG8_BAR; PG8_MMA(1, 1, At, B1); PG8_BAR;
            }
        }
        if constexpr (ALIGN_EPI) { if (wr == 0) PG8_BAR; }
        E(acc, cur, wr, wc, fr, fq);
        if (!has_next) break;
#pragma unroll
        for (int a = 0; a < 2; ++a)
#pragma unroll
            for (int b = 0; b < 2; ++b)
#pragma unroll
                for (int m = 0; m < 4; ++m)
#pragma unroll
                    for (int n = 0; n < 2; ++n) acc[a][b][m][n] = (f32x4){0.f, 0.f, 0.f, 0.f};
        cur = nxt; cA = nA; cB = nB; ++ui;
        if constexpr (ALIGN_EPI) { if (wr == 1) PG8_BAR; }
    }
    PG8_WAIT_V(0);
    if constexpr (!ALIGN_EPI) { if (wr == 0) PG8_BAR; }
    PG8_BAR;
#undef PG8_SA
#undef PG8_SB
#undef PG8_STAGE
#undef PG8_LDA
#undef PG8_LDB
#undef PG8_MMA
#undef PG8_WAIT_V
#undef PG8_WAIT_L
#undef PG8_BAR
#undef PG8_SCHED
}
}

namespace pg8 {
struct PlainOrder : StaticOrder {
    const char* A; const char* Bt; size_t a_tile, b_tile;
    __device__ bool next(int i, Unit& u) const { return tile(i, u); }
    DI const char* a_base(const Unit& u) const { return A + (size_t)u.pm * a_tile; }
    DI const char* b_base(const Unit& u) const { return Bt + (size_t)u.pn * b_tile; }
};
struct BranchOrder : StaticOrder {
    const char* Y; const char* Wb;
    __device__ bool next(int i, Unit& u) const { if (!tile(i / 3, u)) return false; u.z = i % 3; return true; }
    DI const char* a_base(const Unit& u) const { return Y + (size_t)u.z * (16 * MiB) + (size_t)u.pm * (256 * 512 * 2); }
    DI const char* b_base(const Unit& u) const { return Wb + (size_t)u.z * (1024 * 512 * 2) + (size_t)u.pn * (256 * 512 * 2); }
};
struct ScoreOrder : StaticOrder {
    const char* Q; const char* Kbd;
    __device__ bool next(int i, Unit& u) const { return tile(i, u); }
    DI const char* a_base(const Unit& u) const { return Q + (size_t)u.pm * (256 * 2048 * 2) + (size_t)u.pn * 512; }
    DI const char* b_base(const Unit& u) const { return Kbd + (size_t)u.pn * (256 * 256 * 2); }
};

struct EpiBf16 {
    static constexpr bool PERM = true;
    bf16* O; int ldc;
    DI void operator()(const f32x4 (&acc)[2][2][4][2], const Unit& u, int wr, int wc, int fr, int fq) const {
        const int row0 = u.pm * BM + wr * 64 + fr, col0 = u.pn * BM + wc * 32 + 8 * fq;
#pragma unroll
        for (int ai = 0; ai < 2; ++ai)
#pragma unroll
            for (int m = 0; m < 4; ++m) { bf16* rowp = O + (size_t)(row0 + ai * HALF + m * 16) * ldc + col0;
#pragma unroll
                for (int bj = 0; bj < 2; ++bj) { const f32x4 v0 = acc[ai][bj][m][0], v1 = acc[ai][bj][m][1];
                    u32x4 w; w.x = cvt_pk_bf16(v0[0], v0[1]); w.y = cvt_pk_bf16(v0[2], v0[3]); w.z = cvt_pk_bf16(v1[0], v1[1]); w.w = cvt_pk_bf16(v1[2], v1[3]);
                    *(u32x4*)(rowp + bj * HALF) = w; } }
    }
};
struct EpiQ {
    static constexpr bool PERM = true;
    bf16* O; int ldc; const float* ssp;
    DI void operator()(const f32x4 (&acc)[2][2][4][2], const Unit& u, int wr, int wc, int fr, int fq) const {
        const int row0 = u.pm * BM + wr * 64 + fr, col0 = u.pn * BM + wc * 32 + 8 * fq;
#pragma unroll
        for (int ai = 0; ai < 2; ++ai)
#pragma unroll
            for (int m = 0; m < 4; ++m) { const int row = row0 + ai * HALF + m * 16; const f32x4* sp = (const f32x4*)(ssp + (size_t)row * 16);
                const f32x4 s0 = sp[0], s1 = sp[1], s2 = sp[2], s3 = sp[3];
                const float ss = ((s0[0] + s0[1]) + (s0[2] + s0[3])) + ((s1[0] + s1[1]) + (s1[2] + s1[3])) + ((s2[0] + s2[1]) + (s2[2] + s2[3])) + ((s3[0] + s3[1]) + (s3[2] + s3[3]));
                const float rs = 1.0f / sqrtf(ss * (1.0f / 1024.0f) + EPS);
                bf16* rowp = O + (size_t)row * ldc + col0;
#pragma unroll
                for (int bj = 0; bj < 2; ++bj) { const f32x4 v0 = acc[ai][bj][m][0] * rs, v1 = acc[ai][bj][m][1] * rs;
                    u32x4 w; w.x = cvt_pk_bf16(v0[0], v0[1]); w.y = cvt_pk_bf16(v0[2], v0[3]); w.z = cvt_pk_bf16(v1[0], v1[1]); w.w = cvt_pk_bf16(v1[2], v1[3]);
                    *(u32x4*)(rowp + bj * HALF) = w; }
                asm volatile("" ::: "memory"); }
    }
};
struct EpiF32 {
    static constexpr bool PERM = false;
    float* C; int ldc;
    DI void operator()(const f32x4 (&acc)[2][2][4][2], const Unit& u, int wr, int wc, int fr, int fq) const {
        const int row0 = u.pm * BM + wr * 64 + fr, col0 = u.pn * BM + wc * 32 + 4 * fq;
#pragma unroll
        for (int ai = 0; ai < 2; ++ai)
#pragma unroll
            for (int m = 0; m < 4; ++m) { float* rowp = C + (size_t)(row0 + ai * HALF + m * 16) * ldc + col0;
#pragma unroll
                for (int bj = 0; bj < 2; ++bj)
#pragma unroll
                    for (int n = 0; n < 2; ++n) *(f32x4*)(rowp + bj * HALF + n * 16) = acc[ai][bj][m][n]; }
    }
};
struct EpiBranch {
    static constexpr bool PERM = true;
    const bf16* proj; float* macc; bf16* merged;
    DI void operator()(const f32x4 (&acc)[2][2][4][2], const Unit& u, int wr, int wc, int fr, int fq) const {
        const int row0 = u.pm * BM + wr * 64 + fr, col0 = u.pn * BM + wc * 32 + 8 * fq;
#pragma unroll
        for (int ai = 0; ai < 2; ++ai)
#pragma unroll
            for (int m = 0; m < 4; ++m) { const int row = row0 + ai * HALF + m * 16;
#pragma unroll
                for (int bj = 0; bj < 2; ++bj) { const int col = col0 + bj * HALF;
                    const u32x4 gw = *(const u32x4*)(proj + (size_t)row * PC + C_GATE + u.z * 1024 + col);
                    f32x4 v0 = acc[ai][bj][m][0], v1 = acc[ai][bj][m][1];
                    v0[0] *= sigmoidf_(bflo(gw.x)); v0[1] *= sigmoidf_(bfhi(gw.x)); v0[2] *= sigmoidf_(bflo(gw.y)); v0[3] *= sigmoidf_(bfhi(gw.y));
                    v1[0] *= sigmoidf_(bflo(gw.z)); v1[1] *= sigmoidf_(bfhi(gw.z)); v1[2] *= sigmoidf_(bflo(gw.w)); v1[3] *= sigmoidf_(bfhi(gw.w));
                    float* mp = macc + (size_t)row * 1024 + col;
                    if (u.z > 0) { v0 += *(const f32x4*)mp; v1 += *(const f32x4*)(mp + 4); }
                    if (u.z < 2) { *(f32x4*)mp = v0; *(f32x4*)(mp + 4) = v1; }
                    else { u32x4 w; w.x = cvt_pk_bf16(v0[0], v0[1]); w.y = cvt_pk_bf16(v0[2], v0[3]); w.z = cvt_pk_bf16(v1[0], v1[1]); w.w = cvt_pk_bf16(v1[2], v1[3]);
                        *(u32x4*)(merged + (size_t)row * 1024 + col) = w; } }
                asm volatile("" ::: "memory"); }
    }
};
struct EpiOut {
    static constexpr bool PERM = true;
    const float* x; float* x1; bf16* xg; const float* gffn; float* ssp;
    DI void operator()(const f32x4 (&acc)[2][2][4][2], const Unit& u, int wr, int wc, int fr, int fq) const {
        const int row0 = u.pm * BM + wr * 64 + fr, col0 = u.pn * BM + wc * 32 + 8 * fq;
        f32x4 g0[2], g1[2];
#pragma unroll
        for (int bj = 0; bj < 2; ++bj) { g0[bj] = *(const f32x4*)(gffn + col0 + bj * HALF); g1[bj] = *(const f32x4*)(gffn + col0 + bj * HALF + 4); }
#pragma unroll
        for (int ai = 0; ai < 2; ++ai)
#pragma unroll
            for (int m = 0; m < 4; ++m) { const int row = row0 + ai * HALF + m * 16; float ss = 0.f;
#pragma unroll
                for (int bj = 0; bj < 2; ++bj) { const size_t off = (size_t)row * 1024 + col0 + bj * HALF;
                    const f32x4 v0 = acc[ai][bj][m][0] + *(const f32x4*)(x + off), v1 = acc[ai][bj][m][1] + *(const f32x4*)(x + off + 4);
                    *(f32x4*)(x1 + off) = v0; *(f32x4*)(x1 + off + 4) = v1;
                    ss += (v0[0] * v0[0] + v0[1] * v0[1]) + (v0[2] * v0[2] + v0[3] * v0[3]) + (v1[0] * v1[0] + v1[1] * v1[1]) + (v1[2] * v1[2] + v1[3] * v1[3]);
                    const f32x4 a = v0 * g0[bj], b = v1 * g1[bj];
                    u32x4 w; w.x = cvt_pk_bf16(a[0], a[1]); w.y = cvt_pk_bf16(a[2], a[3]); w.z = cvt_pk_bf16(b[0], b[1]); w.w = cvt_pk_bf16(b[2], b[3]);
                    *(u32x4*)(xg + off) = w; }
                ss += __shfl_xor(ss, 16); ss += __shfl_xor(ss, 32);
                if (fq == 0) ssp[(size_t)row * 16 + u.pn * 4 + wc] = ss;
                asm volatile("" ::: "memory"); }
    }
};
}

#define XB_TMO      128
#define XB_XCNT(j)  (256  + 64 * (j))
#define XB_XSUB(j)  (1280 + 64 * (j))
#define XB_XGEN(j)  (2304 + 64 * (j))
#define XB_TOP      3328
#define XB_TOPGEN   3392
#define XCD_BAR_WORDS 3456
#define XB_SPIN_CAP (1u << 18)
constexpr int CW_BAR = 4096;

DI unsigned xb_ld(unsigned* p)              { return __hip_atomic_load(p, __ATOMIC_RELAXED, __HIP_MEMORY_SCOPE_AGENT); }
DI unsigned xb_add(unsigned* p, unsigned v) { return __hip_atomic_fetch_add(p, v, __ATOMIC_RELAXED, __HIP_MEMORY_SCOPE_AGENT); }
DI unsigned xb_xcc_id() { return (unsigned)__builtin_amdgcn_s_getreg((3 << 11) | 20) & 0xFu; }
#define XB_SPIN(cond, bar) do { unsigned _sp = 0; while (cond) { __builtin_amdgcn_s_sleep(1); \
    if ((++_sp & 255u) == 0u) { if (xb_ld(&(bar)[XB_TMO])) break; if (_sp > XB_SPIN_CAP) { atomicAdd(&(bar)[XB_TMO], 1u); break; } } } } while (0)

struct XcdBarrier { unsigned* bar; unsigned x; volatile LAS unsigned* st; };

DI XcdBarrier xcd_barrier_post(unsigned* bar, volatile LAS unsigned* st) {
    XcdBarrier b; b.bar = bar; b.x = xb_xcc_id(); b.st = st;
    if (threadIdx.x == 0) (void)xb_add(&bar[XB_XCNT(b.x)], 1u);
    return b;
}
DI void xcd_barrier_complete(unsigned* bar, unsigned x, unsigned& nloc, unsigned& nx) {
    const unsigned G = gridDim.x * gridDim.y * gridDim.z;
    unsigned sum, cnt, mine, sp = 0u;
    for (;;) {
        sum = 0u; cnt = 0u; mine = 0u;
#pragma unroll
        for (unsigned j = 0; j < 16; ++j) { const unsigned c = xb_ld(&bar[XB_XCNT(j)]); sum += c; cnt += (c > 0u) ? 1u : 0u; mine = (j == x) ? c : mine; }
        if (sum == G) break;
        __builtin_amdgcn_s_sleep(1);
        if ((++sp & 255u) == 0u) { if (xb_ld(&bar[XB_TMO])) break; if (sp > XB_SPIN_CAP) { atomicAdd(&bar[XB_TMO], 1u); break; } }
    }
    nloc = mine > 0u ? mine : 1u; nx = cnt > 0u ? cnt : 1u;
}
DI void xcd_barrier(const XcdBarrier& b) {
    asm volatile("s_waitcnt vmcnt(0)" ::: "memory");
    __syncthreads();
    if (threadIdx.x == 0) {
        unsigned* bar = b.bar;
        __builtin_amdgcn_s_waitcnt(0);
        unsigned nloc = b.st[0], nx = b.st[1];
        if (nloc == 0u) { xcd_barrier_complete(bar, b.x, nloc, nx); b.st[0] = nloc; b.st[1] = nx; }
        const unsigned old = xb_add(&bar[XB_XSUB(b.x)], 1u);
        const unsigned gen = old / nloc;
        if (old + 1u == (gen + 1u) * nloc) {
            __builtin_amdgcn_fence(__ATOMIC_RELEASE, "agent");
            asm volatile("s_waitcnt vmcnt(0)" ::: "memory");
            const unsigned og = xb_add(&bar[XB_TOP], 1u);
            const unsigned tg = og / nx;
            if (og + 1u == (tg + 1u) * nx) xb_add(&bar[XB_TOPGEN], 1u);
            else XB_SPIN(xb_ld(&bar[XB_TOPGEN]) == tg, bar);
            __builtin_amdgcn_fence(__ATOMIC_ACQUIRE, "agent");
            xb_add(&bar[XB_XGEN(b.x)], 1u);
            asm volatile("s_waitcnt vmcnt(0)" ::: "memory");
        } else {
            XB_SPIN(xb_ld(&bar[XB_XGEN(b.x)]) == gen, bar);
            __builtin_amdgcn_fence(__ATOMIC_ACQUIRE, "agent");
            asm volatile("s_waitcnt vmcnt(0)" ::: "memory");
        }
    }
    __syncthreads();
}

struct Frame {
    LAS unsigned char* lds;
    int tid, lane, wave;
    DI void refresh() { int t = threadIdx.x; asm volatile("" : "+v"(t)); tid = t; lane = t & 63; wave = __builtin_amdgcn_readfirstlane(t >> 6); }
    int vcu, G;
    const float *x, *mem, *norm_mix_g, *w_in, *hg_lb, *hg_norm_g, *sc_conv_w, *mem_norm_g, *w_mem_kv, *w_branch, *w_out, *norm_ffn_g, *peer_w_q, *peer_sub_keys, *peer_u, *peer_v, *final_norm_g;
    float* out; unsigned char* ws;
};

DI void p0_transpose_item(const float* W, int K, int N, bf16* WT, LAS float* scr, int item, int lane) {
    const int nblk = N / 32, kb = item / nblk, nb = item % nblk, k0 = 64 * kb, n0 = 32 * nb;
#pragma unroll 8
    for (int i = 0; i < 32; ++i) { const int kk = 2 * i + (lane >> 5); scr[kk * 33 + (lane & 31)] = W[(size_t)(k0 + kk) * N + n0 + (lane & 31)]; }
    asm volatile("s_waitcnt lgkmcnt(0)" ::: "memory");
    const int c = lane & 7;
#pragma unroll
    for (int j = 0; j < 4; ++j) { const int n = (lane >> 3) + 8 * j; const LAS float* s = scr + (8 * c) * 33 + n;
        u32x4 o; o.x = pk2(s[0 * 33], s[1 * 33]); o.y = pk2(s[2 * 33], s[3 * 33]); o.z = pk2(s[4 * 33], s[5 * 33]); o.w = pk2(s[6 * 33], s[7 * 33]);
        *(u32x4*)(WT + (size_t)(n0 + n) * K + k0 + 8 * c) = o; }
    asm volatile("s_waitcnt lgkmcnt(0)" ::: "memory");
}
DI void rms_row_to_bf16(const float* xrow, const float* g, bf16* orow, int lane) {
    const f32x4* xr = (const f32x4*)xrow + lane; const f32x4* gr = (const f32x4*)g + lane;
    f32x4 v[4]; float s = 0.f;
#pragma unroll
    for (int j = 0; j < 4; ++j) { v[j] = xr[64 * j]; s += (v[j].x * v[j].x + v[j].y * v[j].y) + (v[j].z * v[j].z + v[j].w * v[j].w); }
    const float rstd = 1.0f / sqrtf(wave_sum(s) * (1.f / 1024.f) + EPS);
    unsigned long long* o8 = (unsigned long long*)orow + lane;
#pragma unroll
    for (int j = 0; j < 4; ++j) { const f32x4 gg = gr[64 * j]; const f32x4 y = v[j] * rstd * gg;
        o8[64 * j] = (unsigned long long)pk2(y.x, y.y) | ((unsigned long long)pk2(y.z, y.w) << 32); }
}
DI void p0_prologue(Frame& F) {
    F.refresh();
    LAS float* scr = (LAS float*)(F.lds + F.wave * 16384);
    const int gw = F.vcu * NWAVES + F.wave, NGW = F.G * NWAVES;
    unsigned char* ws = F.ws;
    constexpr int I_IN = (1024 / 64) * (PC / 32), I_KV = (1024 / 64) * (1024 / 32), I_BR = (512 / 64) * (1024 / 32), I_OUT = (1024 / 64) * (1024 / 32), I_Q = (1024 / 64) * (2048 / 32);
    constexpr int NITEMS = I_IN + I_KV + 3 * I_BR + I_OUT + I_Q;
    for (int it = gw; it < NITEMS; it += NGW) {
        int r = it;
        if (r < I_IN) { p0_transpose_item(F.w_in, 1024, PC, (bf16*)(ws + WS_WIN), scr, r, F.lane); continue; } r -= I_IN;
        if (r < I_KV) { p0_transpose_item(F.w_mem_kv, 1024, 1024, (bf16*)(ws + WS_WKV), scr, r, F.lane); continue; } r -= I_KV;
        if (r < 3 * I_BR) { const int n = r / I_BR; p0_transpose_item(F.w_branch + (size_t)n * 512 * 1024, 512, 1024, (bf16*)(ws + WS_WBR) + (size_t)n * 1024 * 512, scr, r % I_BR, F.lane); continue; } r -= 3 * I_BR;
        if (r < I_OUT) { p0_transpose_item(F.w_out, 1024, 1024, (bf16*)(ws + WS_WOUT), scr, r, F.lane); continue; } r -= I_OUT;
        p0_transpose_item(F.peer_w_q, 1024, 2048, (bf16*)(ws + WS_WQ), scr, r, F.lane);
    }
    const int gt = F.vcu * 512 + F.tid, NGT = F.G * 512;
    for (int it = gt; it < 8 * 256 * 32; it += NGT) {
        const int c8 = it & 31, row = (it >> 5) & 255, h = it >> 13, p = row >> 7, key = row & 127;
        u32x4 o = (u32x4){0u, 0u, 0u, 0u};
        if ((c8 >> 4) == p) { const float* s = F.peer_sub_keys + (((size_t)(h * 2 + p) * 128 + key) * 128 + (c8 & 15) * 8);
            const f32x4 a = *(const f32x4*)s, b = *(const f32x4*)(s + 4); o.x = pk2(a.x, a.y); o.y = pk2(a.z, a.w); o.z = pk2(b.x, b.y); o.w = pk2(b.z, b.w); }
        *(u32x4*)((bf16*)(ws + WS_KBD) + ((size_t)(h * 256 + row) * 256 + c8 * 8)) = o;
    }
    for (int it = gt; it < 1024; it += NGT) { const float a0 = F.hg_lb[it], a1 = F.hg_lb[1024 + it]; const float m = fmaxf(a0, a1); const float e0 = __expf(a0 - m), e1 = __expf(a1 - m);
        ((float*)(ws + WS_LB))[it] = e0 / (e0 + e1); }
    for (int m = gw; m < BATCH * NMEM; m += NGW) rms_row_to_bf16(F.mem + (size_t)m * 1024, F.mem_norm_g, (bf16*)(ws + WS_MN) + (size_t)m * 1024, F.lane);
    for (int m = gw; m < T_ALL; m += NGW) rms_row_to_bf16(F.x + (size_t)m * 1024, F.norm_mix_g, (bf16*)(ws + WS_XG) + (size_t)m * 1024, F.lane);
}

DI s16x4 tr16(const LAS unsigned char* p) { return __builtin_bit_cast(s16x4, __builtin_amdgcn_ds_read_tr16_b64_v4i16((LAS v4i16_t*)p)); }
DI bf16x8 cat8(s16x4 lo, s16x4 hi) { return __builtin_shufflevector(lo, hi, 0, 1, 2, 3, 4, 5, 6, 7); }
#define MFMA32(a, b, c) __builtin_amdgcn_mfma_f32_32x32x16_bf16((a), (b), (c), 0, 0, 0)
DI int crow(int reg, int h) { return (reg & 3) + 8 * (reg >> 2) + 4 * h; }
DI bf16x8 pack8(const f32x16& x, int s) {
    u32x4 p; p.x = cvtpk(x[8 * s], x[8 * s + 1]); p.y = cvtpk(x[8 * s + 2], x[8 * s + 3]); p.z = cvtpk(x[8 * s + 4], x[8 * s + 5]); p.w = cvtpk(x[8 * s + 6], x[8 * s + 7]);
    return __builtin_bit_cast(bf16x8, p);
}
constexpr int TS = 272;

DI void gate16(const bf16* zc, float lb, float (&L)[16], float (&kk)[16], float (&lf)[16]) {
    float run = 0.f; const float oml = 1.0f - lb;
#pragma unroll
    for (int i = 0; i < 16; ++i) { const float z = bf2f(zc[(size_t)i * PC]); const float sg = sigmoidf_(z); const float f = lb + oml * sg;
        lf[i] = __logf(f); kk[i] = oml * (1.0f - sg); run += lf[i]; L[i] = run; }
}

DI void hgrn_a_item(Frame& F, int item) {
    F.refresh();
    constexpr int T_V = 0, T_KF = 17408, T_KB = 34816, TOT = 52224;
    LAS unsigned char* lds = F.lds;
    const int n = item & 31, h = (item >> 5) & 3, b = item >> 7;
    const bf16* proj = (const bf16*)(F.ws + WS_PROJ) + ((size_t)b * SEQ + n * CHUNK) * PC;
    const int tid = F.tid, d = tid & 127, tq = tid >> 7;
    const float* lbp = (const float*)(F.ws + WS_LB);
    const float lbf = lbp[h * 128 + d], lbb = lbp[512 + h * 128 + d];
#pragma unroll
    for (int i = 0; i < 2; ++i) { const int id = tid + 512 * i, c = id >> 4, ch = id & 15;
        *(LAS u32x4*)(lds + T_V + c * TS + ch * 16) = *(const u32x4*)(proj + (size_t)c * PC + C_HI + h * 128 + ch * 8); }
    float Lf[16], kf[16], lff[16], Lb[16], kb[16], lfb[16];
    gate16(proj + (size_t)(16 * tq) * PC + C_FF + h * 128 + d, lbf, Lf, kf, lff);
    gate16(proj + (size_t)(16 * tq) * PC + C_FB + h * 128 + d, lbb, Lb, kb, lfb);
    LAS float* tot = (LAS float*)(lds + TOT);
    tot[(0 * 4 + tq) * 128 + d] = Lf[15]; tot[(1 * 4 + tq) * 128 + d] = Lb[15];
    __syncthreads();
    const float tf0 = tot[0 * 128 + d], tf1 = tot[1 * 128 + d], tf2 = tot[2 * 128 + d], tf3 = tot[3 * 128 + d];
    const float tb0 = tot[4 * 128 + d], tb1 = tot[5 * 128 + d], tb2 = tot[6 * 128 + d], tb3 = tot[7 * 128 + d];
    const float offf = (tq > 0 ? tf0 : 0.f) + (tq > 1 ? tf1 : 0.f) + (tq > 2 ? tf2 : 0.f), glf = (tf0 + tf1) + (tf2 + tf3);
    const float offb = (tq < 1 ? tb1 : 0.f) + (tq < 2 ? tb2 : 0.f) + (tq < 3 ? tb3 : 0.f), glb = (tb0 + tb1) + (tb2 + tb3);
    const float tbq = Lb[15];
#pragma unroll
    for (int i = 0; i < 16; ++i) { const int c = 16 * tq + i;
        const float G = offf + Lf[i]; const float kd = kf[i] * __expf(glf - G);
        const float Gb = offb + (tbq - Lb[i] + lfb[i]); const float kdb = kb[i] * __expf(glb - Gb);
        ((LAS bf16*)(lds + T_KF + c * TS))[d] = (bf16)f2bf(kd); ((LAS bf16*)(lds + T_KB + c * TS))[d] = (bf16)f2bf(kdb); }
    if (tq == 0) { float* dec = (float*)(F.ws + WS_DEC) + (size_t)item * 256; dec[d] = __expf(glf); dec[128 + d] = __expf(glb); }
    __syncthreads();
    const int w = F.wave, lane = F.lane, r = lane & 31, hh = lane >> 5, blk = (lane >> 4) & 1, q = (lane & 15) >> 2, p = lane & 3;
    const int dt = w >> 1, et0 = (w & 1) * 2;
#pragma unroll
    for (int dir = 0; dir < 2; ++dir) { const int TK = dir ? T_KB : T_KF;
#pragma unroll
        for (int e2 = 0; e2 < 2; ++e2) { const int et = et0 + e2; f32x16 acc;
#pragma unroll
            for (int i = 0; i < 16; ++i) acc[i] = 0.f;
#pragma unroll
            for (int ks = 0; ks < 4; ++ks) {
                const LAS unsigned char* ap = lds + TK + (16 * ks + 8 * hh + q) * TS + (32 * dt + 16 * blk + 4 * p) * 2;
                const LAS unsigned char* bp = lds + T_V + (16 * ks + 8 * hh + q) * TS + (32 * et + 16 * blk + 4 * p) * 2;
                const bf16x8 a = cat8(tr16(ap), tr16(ap + 4 * TS)), bq = cat8(tr16(bp), tr16(bp + 4 * TS));
                acc = MFMA32(a, bq, acc); }
            bf16* dsb = (bf16*)(F.ws + WS_DS) + ((size_t)(item * 2 + dir) * 128 + 32 * et + r) * 128 + 32 * dt + 4 * hh;
#pragma unroll
            for (int g4 = 0; g4 < 4; ++g4) { u32x2 wv; wv.x = cvtpk(acc[4 * g4], acc[4 * g4 + 1]); wv.y = cvtpk(acc[4 * g4 + 2], acc[4 * g4 + 3]); *(u32x2*)(dsb + 8 * g4) = wv; } } }
    __syncthreads();
}

DI void hgrn_scan(Frame& F) {
    F.refresh();
    const bf16* dS = (const bf16*)(F.ws + WS_DS); bf16* Sst = (bf16*)((unsigned char*)F.out + OUT_SST); const float* dec = (const float*)(F.ws + WS_DEC);
    const int gt = F.vcu * 512 + F.tid, NGT = F.G * 512;
    for (int id = gt; id < BG * 4 * 2 * 128 * 32; id += NGT) {
        const int d4 = id & 31, e = (id >> 5) & 127, dir = (id >> 12) & 1, bh = id >> 13;
        f32x4 S = (f32x4){0.f, 0.f, 0.f, 0.f};
#pragma unroll 4
        for (int s = 0; s < 32; ++s) { const int n = dir ? 31 - s : s, item = bh * 32 + n;
            const size_t off = ((size_t)(item * 2 + dir) * 128 + e) * 128 + d4 * 4;
            u32x2 o; o.x = cvtpk(S.x, S.y); o.y = cvtpk(S.z, S.w); *(u32x2*)(Sst + off) = o;
            const f32x4 dc = *(const f32x4*)(dec + (size_t)(item * 2 + dir) * 128 + d4 * 4);
            const u32x2 wv = *(const u32x2*)(dS + off);
            S.x = dc.x * S.x + bflo(wv.x); S.y = dc.y * S.y + bfhi(wv.x); S.z = dc.z * S.z + bflo(wv.y); S.w = dc.w * S.w + bfhi(wv.y); }
    }
}

DI void hgrn_c_item(Frame& F, int item) {
    F.refresh();
    constexpr int T_QRF = 0, T_KRF = 17408, T_QGF = 34816, T_QRB = 52224, T_KRB = 69632, T_QGB = 87040, T_V = 104448, TOT = 121856, O_OFF = 0, OS = 132;
    LAS unsigned char* lds = F.lds;
    const int n = item & 31, h = (item >> 5) & 3, b = item >> 7;
    const size_t row0 = (size_t)b * SEQ + n * CHUNK;
    const bf16* proj = (const bf16*)(F.ws + WS_PROJ) + row0 * PC;
    const int tid = F.tid, d = tid & 127, tq = tid >> 7;
    const float* lbp = (const float*)(F.ws + WS_LB);
    const float lbf = lbp[h * 128 + d], lbb = lbp[512 + h * 128 + d];
#pragma unroll
    for (int i = 0; i < 2; ++i) { const int id = tid + 512 * i, c = id >> 4, ch = id & 15;
        *(LAS u32x4*)(lds + T_V + c * TS + ch * 16) = *(const u32x4*)(proj + (size_t)c * PC + C_HI + h * 128 + ch * 8); }
    float qv[16];
#pragma unroll
    for (int i = 0; i < 16; ++i) { const float z = bf2f(proj[(size_t)(16 * tq + i) * PC + C_HQ + h * 128 + d]); qv[i] = z * sigmoidf_(z); }
    float Lf[16], kf[16], lff[16], Lb[16], kb[16], lfb[16];
    gate16(proj + (size_t)(16 * tq) * PC + C_FF + h * 128 + d, lbf, Lf, kf, lff);
    gate16(proj + (size_t)(16 * tq) * PC + C_FB + h * 128 + d, lbb, Lb, kb, lfb);
    LAS float* tot = (LAS float*)(lds + TOT);
    tot[(0 * 4 + tq) * 128 + d] = Lf[15]; tot[(1 * 4 + tq) * 128 + d] = Lb[15];
    __syncthreads();
    {
        const float tf0 = tot[0 * 128 + d], tf1 = tot[1 * 128 + d], tf2 = tot[2 * 128 + d];
        const float tb1 = tot[5 * 128 + d], tb2 = tot[6 * 128 + d], tb3 = tot[7 * 128 + d];
        const float offf = (tq > 0 ? tf0 : 0.f) + (tq > 1 ? tf1 : 0.f) + (tq > 2 ? tf2 : 0.f), greff = tf0 + tf1;
        const float offb = (tq < 1 ? tb1 : 0.f) + (tq < 2 ? tb2 : 0.f) + (tq < 3 ? tb3 : 0.f), grefb = tb2 + tb3;
        const float tbq = Lb[15];
#pragma unroll
        for (int i = 0; i < 16; ++i) { const int c = 16 * tq + i;
            const float G = offf + Lf[i]; const float x = G - greff;
            ((LAS bf16*)(lds + T_QRF + c * TS))[d] = (bf16)f2bf(qv[i] * __expf(x)); ((LAS bf16*)(lds + T_KRF + c * TS))[d] = (bf16)f2bf(kf[i] * __expf(-x)); ((LAS bf16*)(lds + T_QGF + c * TS))[d] = (bf16)f2bf(qv[i] * __expf(G));
            const float Gb = offb + (tbq - Lb[i] + lfb[i]); const float xb = Gb - grefb;
            ((LAS bf16*)(lds + T_QRB + c * TS))[d] = (bf16)f2bf(qv[i] * __expf(xb)); ((LAS bf16*)(lds + T_KRB + c * TS))[d] = (bf16)f2bf(kb[i] * __expf(-xb)); ((LAS bf16*)(lds + T_QGB + c * TS))[d] = (bf16)f2bf(qv[i] * __expf(Gb)); }
    }
    __syncthreads();
    const int w = F.wave, lane = F.lane, r = lane & 31, hh = lane >> 5, blk = (lane >> 4) & 1, q = (lane & 15) >> 2, p = lane & 3;
    const int ct = w >> 2, et = w & 3;
    const bf16* Sst = (const bf16*)((const unsigned char*)F.out + OUT_SST);
    f32x16 o;
#pragma unroll
    for (int i = 0; i < 16; ++i) o[i] = 0.f;
#pragma unroll
    for (int dir = 0; dir < 2; ++dir) { const int TQR = dir ? T_QRB : T_QRF, TKR = dir ? T_KRB : T_KRF, TQG = dir ? T_QGB : T_QGF;
#pragma unroll
        for (int st = 0; st < 2; ++st) {
            if (dir == 0 ? (st > ct) : (st < ct)) continue;
            f32x16 X;
#pragma unroll
            for (int i = 0; i < 16; ++i) X[i] = 0.f;
#pragma unroll
            for (int ks = 0; ks < 8; ++ks) { const bf16x8 a = *(const LAS bf16x8*)(lds + TKR + (32 * st + r) * TS + (16 * ks + 8 * hh) * 2), bq = *(const LAS bf16x8*)(lds + TQR + (32 * ct + r) * TS + (16 * ks + 8 * hh) * 2);
                X = MFMA32(a, bq, X); }
            const int cc = 32 * ct + r;
#pragma unroll
            for (int i = 0; i < 16; ++i) { const int s = 32 * st + crow(i, hh); const bool keep = dir == 0 ? (s <= cc) : (s >= cc); X[i] = keep ? X[i] : 0.f; }
#pragma unroll
            for (int s2 = 0; s2 < 2; ++s2) { const bf16x8 xs = pack8(X, s2);
                const LAS unsigned char* vp = lds + T_V + (32 * st + 16 * s2 + 4 * hh + q) * TS + (32 * et + 16 * blk + 4 * p) * 2;
                const bf16x8 pb = cat8(tr16(vp), tr16(vp + 8 * TS));
                o = MFMA32(xs, pb, o); }
        }
        const bf16* sp = Sst + ((size_t)(item * 2 + dir) * 128 + 32 * et + r) * 128 + 8 * hh;
#pragma unroll
        for (int ks = 0; ks < 8; ++ks) { const bf16x8 a = *(const LAS bf16x8*)(lds + TQG + (32 * ct + r) * TS + (16 * ks + 8 * hh) * 2); const bf16x8 bq = *(const bf16x8*)(sp + 16 * ks);
            o = MFMA32(a, bq, o); }
    }
    __syncthreads();
    LAS float* O = (LAS float*)(lds + O_OFF);
#pragma unroll
    for (int i = 0; i < 16; ++i) O[(32 * ct + crow(i, hh)) * OS + 32 * et + r] = o[i];
    __syncthreads();
    const float g0 = F.hg_norm_g[h * 128 + 2 * lane], g1 = F.hg_norm_g[h * 128 + 2 * lane + 1];
    bf16* yhg = (bf16*)(F.ws + WS_YHG);
#pragma unroll
    for (int k = 0; k < 8; ++k) { const int c = 8 * w + k; const f32x2 v = *(const LAS f32x2*)(O + c * OS + 2 * lane);
        const float ss = wave_sum(v.x * v.x + v.y * v.y); const float rstd = 1.0f / sqrtf(ss * (1.0f / 128.0f) + EPS);
        const unsigned hw = *(const unsigned*)(proj + (size_t)c * PC + C_HG + h * 128 + 2 * lane); const float z0 = bflo(hw), z1 = bfhi(hw);
        const float y0 = v.x * rstd * g0 * (z0 * sigmoidf_(z0)), y1 = v.y * rstd * g1 * (z1 * sigmoidf_(z1));
        *(unsigned*)(yhg + (row0 + c) * 512 + h * 128 + 2 * lane) = cvtpk(y0, y1); }
    __syncthreads();
}

DI void attn_item(Frame& F, int g, int item) {
    F.refresh();
    constexpr int KS = 272, VS = 528, K_OFF = 0, V_OFF = 69632;
    LAS unsigned char* lds = F.lds;
    const int qb = item & 7, h = (item >> 3) & 3, b = item >> 5, bglob = g * BG + b;
    const bf16* Km = (const bf16*)(F.ws + WS_KMEM) + (size_t)bglob * 256 * 512 + h * 128;
    const bf16* VT = (const bf16*)(F.ws + WS_VT) + (size_t)(h * 128) * 4096 + bglob * 256;
    const int tid = F.tid;
#pragma unroll
    for (int i = 0; i < 8; ++i) { const int id = tid + 512 * i, key = id >> 4, ch = id & 15;
        *(LAS u32x4*)(lds + K_OFF + key * KS + ch * 16) = *(const u32x4*)(Km + (size_t)key * 512 + ch * 8); }
#pragma unroll
    for (int i = 0; i < 8; ++i) { const int id = tid + 512 * i, e = id >> 5, ch = id & 31;
        *(LAS u32x4*)(lds + V_OFF + e * VS + ch * 16) = *(const u32x4*)(VT + (size_t)e * 4096 + ch * 8); }
    __syncthreads();
    const int w = F.wave, lane = F.lane, r = lane & 31, hh = lane >> 5;
    const size_t qrow0 = (size_t)b * SEQ + qb * 256 + w * 32;
    const bf16* proj = (const bf16*)(F.ws + WS_PROJ);
    bf16x8 qf[8];
#pragma unroll
    for (int ks = 0; ks < 8; ++ks) qf[ks] = *(const bf16x8*)(proj + (qrow0 + r) * PC + C_MQ + h * 128 + 16 * ks + 8 * hh);
    const float scale = 0.08838834764831845f;
    float m_run = -INFINITY, l_run = 0.f;
#pragma unroll 1
    for (int kt = 0; kt < 8; ++kt) {
        f32x16 X;
#pragma unroll
        for (int i = 0; i < 16; ++i) X[i] = 0.f;
#pragma unroll
        for (int ks = 0; ks < 8; ++ks) { const bf16x8 a = *(const LAS bf16x8*)(lds + K_OFF + (32 * kt + r) * KS + (16 * ks + 8 * hh) * 2); X = MFMA32(a, qf[ks], X); }
        float tm = X[0];
#pragma unroll
        for (int i = 1; i < 16; ++i) tm = fmaxf(tm, X[i]);
        tm *= scale;
        const float mn = fmaxf(m_run, tm); float ls = 0.f;
#pragma unroll
        for (int i = 0; i < 16; ++i) ls += __expf(X[i] * scale - mn);
        l_run = l_run * __expf(m_run - mn) + ls; m_run = mn;
    }
    { const float mo = __shfl_xor(m_run, 32), lo = __shfl_xor(l_run, 32); const float m = fmaxf(m_run, mo);
      l_run = l_run * __expf(m_run - m) + lo * __expf(mo - m); m_run = m; }
    const float inv_l = 1.0f / l_run;
    f32x16 O[4];
#pragma unroll
    for (int e = 0; e < 4; ++e)
#pragma unroll
        for (int i = 0; i < 16; ++i) O[e][i] = 0.f;
#pragma unroll 1
    for (int kt = 0; kt < 8; ++kt) {
        f32x16 X;
#pragma unroll
        for (int i = 0; i < 16; ++i) X[i] = 0.f;
#pragma unroll
        for (int ks = 0; ks < 8; ++ks) { const bf16x8 a = *(const LAS bf16x8*)(lds + K_OFF + (32 * kt + r) * KS + (16 * ks + 8 * hh) * 2); X = MFMA32(a, qf[ks], X); }
#pragma unroll
        for (int i = 0; i < 16; ++i) X[i] = __expf(X[i] * scale - m_run) * inv_l;
#pragma unroll
        for (int s2 = 0; s2 < 2; ++s2) { const bf16x8 xs = pack8(X, s2);
#pragma unroll
            for (int e = 0; e < 4; ++e) { const LAS unsigned char* vp = lds + V_OFF + (32 * e + r) * VS + (32 * kt + 16 * s2 + 4 * hh) * 2;
                const bf16x8 pb = cat8(*(const LAS s16x4*)vp, *(const LAS s16x4*)(vp + 16));
                O[e] = MFMA32(xs, pb, O[e]); } }
    }
    bf16* ymx = (bf16*)(F.ws + WS_YMX);
#pragma unroll
    for (int e = 0; e < 4; ++e)
#pragma unroll
        for (int i = 0; i < 16; ++i) ymx[(qrow0 + crow(i, hh)) * 512 + h * 128 + 32 * e + r] = (bf16)f2bf(O[e][i]);
    __syncthreads();
}

DI void conv_phase(Frame& F) {
    F.refresh();
    const bf16* proj = (const bf16*)(F.ws + WS_PROJ); bf16* ysc = (bf16*)(F.ws + WS_YSC); const float* cw = F.sc_conv_w;
    const int gt = F.vcu * 512 + F.tid, NGT = F.G * 512;
    for (int id = gt; id < TG * 64; id += NGT) {
        const int c8 = id & 63, t = id >> 6, ts = t & (SEQ - 1);
        const bf16* pr = proj + (size_t)t * PC + c8 * 8;
        const u32x4 z4 = (u32x4){0u, 0u, 0u, 0u};
        const u32x4 sb = *(const u32x4*)(pr + C_SB), c1 = *(const u32x4*)(pr + C_SC), h1 = *(const u32x4*)(pr + C_SH);
        const u32x4 c0 = ts > 0 ? *(const u32x4*)(pr - PC + C_SC) : z4, h0 = ts > 0 ? *(const u32x4*)(pr - PC + C_SH) : z4;
        const u32x4 c2 = ts < SEQ - 1 ? *(const u32x4*)(pr + PC + C_SC) : z4, h2 = ts < SEQ - 1 ? *(const u32x4*)(pr + PC + C_SH) : z4;
        const f32x4 wa0 = *(const f32x4*)(cw + c8 * 8), wa1 = *(const f32x4*)(cw + c8 * 8 + 4), wb0 = *(const f32x4*)(cw + 512 + c8 * 8), wb1 = *(const f32x4*)(cw + 512 + c8 * 8 + 4),
                    wc0 = *(const f32x4*)(cw + 1024 + c8 * 8), wc1 = *(const f32x4*)(cw + 1024 + c8 * 8 + 4);
        float y[8];
#pragma unroll
        for (int k = 0; k < 4; ++k) {
            const float w0l = k < 2 ? wa0[2 * k] : wa1[2 * k - 4], w0h = k < 2 ? wa0[2 * k + 1] : wa1[2 * k - 3];
            const float w1l = k < 2 ? wb0[2 * k] : wb1[2 * k - 4], w1h = k < 2 ? wb0[2 * k + 1] : wb1[2 * k - 3];
            const float w2l = k < 2 ? wc0[2 * k] : wc1[2 * k - 4], w2h = k < 2 ? wc0[2 * k + 1] : wc1[2 * k - 3];
            y[2 * k]     = bflo(sb[k]) * (w0l * (bflo(c0[k]) * bflo(h0[k])) + w1l * (bflo(c1[k]) * bflo(h1[k])) + w2l * (bflo(c2[k]) * bflo(h2[k])));
            y[2 * k + 1] = bfhi(sb[k]) * (w0h * (bfhi(c0[k]) * bfhi(h0[k])) + w1h * (bfhi(c1[k]) * bfhi(h1[k])) + w2h * (bfhi(c2[k]) * bfhi(h2[k]))); }
        u32x4 o; o.x = cvtpk(y[0], y[1]); o.y = cvtpk(y[2], y[3]); o.z = cvtpk(y[4], y[5]); o.w = cvtpk(y[6], y[7]);
        *(u32x4*)(ysc + (size_t)t * 512 + c8 * 8) = o;
    }
}

DI unsigned ord_key(float v, int idx) { unsigned u = __builtin_bit_cast(unsigned, v); u ^= (u >> 31) ? 0xFFFFFFFFu : 0x80000000u; return (u & 0xFFFFFF80u) | (unsigned)(127 - idx); }
DI float key_val(unsigned k) { unsigned u = k & 0xFFFFFF80u; u = (u & 0x80000000u) ? (u ^ 0x80000000u) : ~u; return __builtin_bit_cast(float, u); }
DI float dot2bf(unsigned a, unsigned b, float c) { return __builtin_amdgcn_fdot2_f32_bf16(__builtin_bit_cast(bf16x2_t, a), __builtin_bit_cast(bf16x2_t, b), c, false); }
DI float dot8(const u32x4& a, const u32x4& b, float c) { c = dot2bf(a.x, b.x, c); c = dot2bf(a.y, b.y, c); c = dot2bf(a.z, b.z, c); return dot2bf(a.w, b.w, c); }
__host__ __device__ constexpr int cand_off(int i) { return i == 0 ? 0 : i == 1 ? 16 : i == 2 ? 24 : i == 3 ? 29 : i == 4 ? 33 : i == 5 ? 36 : i == 6 ? 38 : i == 7 ? 40 : 34 + i; }
__host__ __device__ constexpr int cand_i(int c) { return c < 16 ? 0 : c < 24 ? 1 : c < 29 ? 2 : c < 33 ? 3 : c < 36 ? 4 : c < 38 ? 5 : c < 40 ? 6 : c < 42 ? 7 : c - 34; }
__host__ __device__ constexpr int cand_pos(int c) { return cand_i(c) * 16 + (c - cand_off(cand_i(c))); }

DI void peer_topk(const float* srow, LAS int* widx, LAS float* wgate, int lane) {
    const int gq = lane >> 4, li = lane & 15;
    const int ci = cand_i(lane), cj = lane - cand_off(ci), cpos = ci * 16 + cj; const bool cvalid = lane < 50;
#pragma unroll 1
    for (int hp = 0; hp < 4; ++hp) {
        const int head = 2 * hp + (gq >> 1), p = gq & 1;
        const f32x4 va = *(const f32x4*)(srow + head * 256 + p * 128 + li * 8), vb = *(const f32x4*)(srow + head * 256 + p * 128 + li * 8 + 4);
        unsigned k[8];
        k[0] = ord_key(va.x, li * 8 + 0); k[1] = ord_key(va.y, li * 8 + 1); k[2] = ord_key(va.z, li * 8 + 2); k[3] = ord_key(va.w, li * 8 + 3);
        k[4] = ord_key(vb.x, li * 8 + 4); k[5] = ord_key(vb.y, li * 8 + 5); k[6] = ord_key(vb.z, li * 8 + 6); k[7] = ord_key(vb.w, li * 8 + 7);
        unsigned mine = 0u;
#pragma unroll
        for (int rd = 0; rd < 16; ++rd) {
            unsigned m = max(max(max(k[0], k[1]), max(k[2], k[3])), max(max(k[4], k[5]), max(k[6], k[7])));
            m = max(m, (unsigned)__shfl_xor((int)m, 1, 16)); m = max(m, (unsigned)__shfl_xor((int)m, 2, 16)); m = max(m, (unsigned)__shfl_xor((int)m, 4, 16)); m = max(m, (unsigned)__shfl_xor((int)m, 8, 16));
            mine = (li == rd) ? m : mine;
#pragma unroll
            for (int j = 0; j < 8; ++j) k[j] = (k[j] == m) ? 0u : k[j];
        }
        const float sc = key_val(mine); const int ix = 127 - (int)(mine & 127u);
#pragma unroll
        for (int hsel = 0; hsel < 2; ++hsel) {
            const float a = __shfl(sc, 32 * hsel + ci), bq = __shfl(sc, 32 * hsel + 16 + cj);
            const int ia = __shfl(ix, 32 * hsel + ci), ib = __shfl(ix, 32 * hsel + 16 + cj);
            const float cs = a + bq;
            int rank = 0;
#pragma unroll
            for (int c2 = 0; c2 < 50; ++c2) { const float v2 = __builtin_bit_cast(float, __builtin_amdgcn_readlane(__builtin_bit_cast(int, cs), c2));
                rank += ((v2 > cs) || (v2 == cs && cand_pos(c2) < cpos)) ? 1 : 0; }
            const bool sel = cvalid && rank < 16;
            const float mx = __builtin_bit_cast(float, __builtin_amdgcn_readlane(__builtin_bit_cast(int, cs), 0));
            const float ev = sel ? __expf(cs - mx) : 0.f;
            const float sum = wave_sum(ev);
            if (sel) { const int hd = 2 * hp + hsel; widx[hd * 16 + rank] = ia * 128 + ib; wgate[hd * 16 + rank] = ev / sum; }
        }
    }
}

DI void peer_phase(Frame& F, int tg) {
    F.refresh();
    const int gw = F.vcu * NWAVES + F.wave, NGW = F.G * NWAVES, lane = F.lane;
    LAS int* widx = (LAS int*)(F.lds + F.wave * 1024); LAS float* wgate = (LAS float*)(F.lds + F.wave * 1024 + 512);
    const bf16* U = (const bf16*)(F.ws + WS_U); const bf16* V = (const bf16*)(F.ws + WS_V);
    const f32x4* gf = (const f32x4*)F.final_norm_g;
    for (int tl = gw; tl < TG; tl += NGW) {
        const size_t t = (size_t)tg * TG + tl;
        peer_topk((const float*)(F.ws + WS_S) + (size_t)tl * 2048, widx, wgate, lane);
        asm volatile("s_waitcnt lgkmcnt(0)" ::: "memory");
        const bf16* xr = (const bf16*)(F.ws + WS_XG) + t * 1024;
        const u32x4 hx0 = *(const u32x4*)(xr + lane * 8), hx1 = *(const u32x4*)(xr + 512 + lane * 8);
        const f32x4* sp = (const f32x4*)((const float*)(F.ws + WS_SSP) + t * 16);
        const f32x4 s0 = sp[0], s1 = sp[1], s2 = sp[2], s3 = sp[3];
        const float ssx = ((s0[0] + s0[1]) + (s0[2] + s0[3])) + ((s1[0] + s1[1]) + (s1[2] + s1[3])) + ((s2[0] + s2[1]) + (s2[2] + s2[3])) + ((s3[0] + s3[1]) + (s3[2] + s3[3]));
        const float rstd = 1.0f / sqrtf(ssx * (1.0f / 1024.0f) + EPS);
        float outv[16];
#pragma unroll
        for (int i = 0; i < 16; ++i) outv[i] = 0.f;
#pragma unroll 1
        for (int half = 0; half < 2; ++half) {
            float dots = 0.f;
#pragma unroll 1
            for (int j = 0; j < 64; j += 4) {
                u32x4 ua[4], ub[4];
#pragma unroll
                for (int k = 0; k < 4; ++k) { const int e = __builtin_amdgcn_readfirstlane(widx[half * 64 + j + k]); const bf16* ur = U + (size_t)e * 1024;
                    ua[k] = *(const u32x4*)(ur + lane * 8); ub[k] = *(const u32x4*)(ur + 512 + lane * 8); }
#pragma unroll
                for (int k = 0; k < 4; ++k) { float pd = dot8(hx0, ua[k], 0.f); pd = dot8(hx1, ub[k], pd); pd = wave_sum(pd); dots = (lane == j + k) ? pd : dots; }
            }
            const float av = dots * rstd;
            const float cf = wgate[half * 64 + lane] * (0.5f * av * (1.0f + erff(av * 0.70710678118654752f)));
#pragma unroll 1
            for (int j = 0; j < 64; j += 4) {
                u32x4 va[4], vb[4]; float c[4];
#pragma unroll
                for (int k = 0; k < 4; ++k) { const int e = __builtin_amdgcn_readfirstlane(widx[half * 64 + j + k]); const bf16* vr = V + (size_t)e * 1024;
                    va[k] = *(const u32x4*)(vr + lane * 8); vb[k] = *(const u32x4*)(vr + 512 + lane * 8);
                    c[k] = __builtin_bit_cast(float, __builtin_amdgcn_readlane(__builtin_bit_cast(int, cf), j + k)); }
#pragma unroll
                for (int k = 0; k < 4; ++k) {
                    outv[0] += c[k] * bflo(va[k].x); outv[1] += c[k] * bfhi(va[k].x); outv[2] += c[k] * bflo(va[k].y); outv[3] += c[k] * bfhi(va[k].y);
                    outv[4] += c[k] * bflo(va[k].z); outv[5] += c[k] * bfhi(va[k].z); outv[6] += c[k] * bflo(va[k].w); outv[7] += c[k] * bfhi(va[k].w);
                    outv[8] += c[k] * bflo(vb[k].x); outv[9] += c[k] * bfhi(vb[k].x); outv[10] += c[k] * bflo(vb[k].y); outv[11] += c[k] * bfhi(vb[k].y);
                    outv[12] += c[k] * bflo(vb[k].z); outv[13] += c[k] * bfhi(vb[k].z); outv[14] += c[k] * bflo(vb[k].w); outv[15] += c[k] * bfhi(vb[k].w); }
            }
        }
        float* xo = F.out + t * 1024;
        f32x4 a0 = *(const f32x4*)(xo + lane * 8), a1 = *(const f32x4*)(xo + lane * 8 + 4), a2 = *(const f32x4*)(xo + 512 + lane * 8), a3 = *(const f32x4*)(xo + 512 + lane * 8 + 4);
        a0 += (f32x4){outv[0], outv[1], outv[2], outv[3]}; a1 += (f32x4){outv[4], outv[5], outv[6], outv[7]}; a2 += (f32x4){outv[8], outv[9], outv[10], outv[11]}; a3 += (f32x4){outv[12], outv[13], outv[14], outv[15]};
        float ss = (a0.x * a0.x + a0.y * a0.y) + (a0.z * a0.z + a0.w * a0.w) + (a1.x * a1.x + a1.y * a1.y) + (a1.z * a1.z + a1.w * a1.w)
                 + (a2.x * a2.x + a2.y * a2.y) + (a2.z * a2.z + a2.w * a2.w) + (a3.x * a3.x + a3.y * a3.y) + (a3.z * a3.z + a3.w * a3.w);
        ss = wave_sum(ss);
        const float rf = 1.0f / sqrtf(ss * (1.0f / 1024.0f) + EPS);
        *(f32x4*)(xo + lane * 8) = a0 * rf * gf[lane * 2]; *(f32x4*)(xo + lane * 8 + 4) = a1 * rf * gf[lane * 2 + 1];
        *(f32x4*)(xo + 512 + lane * 8) = a2 * rf * gf[128 + lane * 2]; *(f32x4*)(xo + 512 + lane * 8 + 4) = a3 * rf * gf[128 + lane * 2 + 1];
        asm volatile("s_waitcnt lgkmcnt(0)" ::: "memory");
    }
}

DI void convert_uv(Frame& F) {
    F.refresh();
    const int gt = F.vcu * 512 + F.tid, NGT = F.G * 512;
    for (int id = gt; id < 2 * 16384 * 128; id += NGT) {
        const int which = id >> 21, off = (id & ((1 << 21) - 1)) * 8;
        const float* src = (which ? F.peer_v : F.peer_u) + off; bf16* dst = (bf16*)(F.ws + (which ? WS_V : WS_U)) + off;
        const f32x4 a = *(const f32x4*)src, b = *(const f32x4*)(src + 4);
        u32x4 o; o.x = cvtpk(a.x, a.y); o.y = cvtpk(a.z, a.w); o.z = cvtpk(b.x, b.y); o.w = cvtpk(b.z, b.w);
        *(u32x4*)dst = o;
    }
}

constexpr int N_PHASES = 19;
struct Args { const float* in[17]; float* out; unsigned char* ws; int ph_lo, ph_hi; };

__global__ void __launch_bounds__(NWAVES * 64, 2) fwd_kernel(Args args) {
    extern __shared__ __attribute__((aligned(16))) unsigned char lds_raw[];
    Frame F;
    F.lds = (LAS unsigned char*)lds_raw;
    F.tid = threadIdx.x; F.lane = F.tid & 63; F.wave = __builtin_amdgcn_readfirstlane(F.tid >> 6);
    F.G = gridDim.x; { const int bx = blockIdx.x; F.vcu = (F.G % 8 == 0) ? (bx % 8) * (F.G / 8) + bx / 8 : bx; }
    F.x = args.in[0]; F.mem = args.in[1]; F.norm_mix_g = args.in[2]; F.w_in = args.in[3]; F.hg_lb = args.in[4]; F.hg_norm_g = args.in[5]; F.sc_conv_w = args.in[6];
    F.mem_norm_g = args.in[7]; F.w_mem_kv = args.in[8]; F.w_branch = args.in[9]; F.w_out = args.in[10]; F.norm_ffn_g = args.in[11]; F.peer_w_q = args.in[12];
    F.peer_sub_keys = args.in[13]; F.peer_u = args.in[14]; F.peer_v = args.in[15]; F.final_norm_g = args.in[16];
    F.out = args.out; F.ws = args.ws;
    volatile LAS unsigned* MISC = (volatile LAS unsigned*)(F.lds + MISC_OFF);
    for (int u = F.tid; u < (LDS_BYTES - MISC_OFF) / 4; u += NWAVES * 64) MISC[u] = 0u;
    __syncthreads();
    unsigned* barw = (unsigned*)(F.ws + WS_CTL) + CW_BAR;
    XcdBarrier bar; bar.bar = barw; bar.x = 0; bar.st = nullptr;
    const bool one_launch = (args.ph_hi - args.ph_lo) > 1;
    if (one_launch) bar = xcd_barrier_post(barw, MISC + 8);
    const int lo = args.ph_lo, hi = args.ph_hi;
#define IN(k) (lo <= (k) && (k) < hi)
#ifndef PMASK
#define PMASK 0x3ff
#endif
#define PC_(c) ((PMASK >> (c)) & 1)
#define SEAM(k) do { if (IN(k) && IN((k) + 1)) xcd_barrier(bar); } while (0)
    unsigned char* ws = F.ws;
    const int G = F.G, cid = (int)blockIdx.x;

    if (PC_(0) && IN(0)) { p0_prologue(F); } SEAM(0);

#pragma unroll 1
    for (int g = 0; g < NGRP; ++g) {
        const int pb = 1 + 6 * g;
        if (PC_(1) && IN(pb)) {
            { pg8::PlainOrder S; S.init(TG, PC, G, cid); S.A = (const char*)(ws + WS_XG) + (size_t)g * TG * 1024 * 2; S.Bt = (const char*)(ws + WS_WIN); S.a_tile = 256 * 1024 * 2; S.b_tile = 256 * 1024 * 2;
              pg8::EpiBf16 E{(bf16*)(ws + WS_PROJ), PC};
              pg8::gemm_phase<pg8::EpiBf16, pg8::PlainOrder, true, true>(F.lds, pg8::Gemm{1024, 1024, 1024}, S, E); }
            if (g == 0) {
                { pg8::PlainOrder S; S.init(BATCH * NMEM, 512, G, cid); S.A = (const char*)(ws + WS_MN); S.Bt = (const char*)(ws + WS_WKV); S.a_tile = 256 * 1024 * 2; S.b_tile = 256 * 1024 * 2;
                  pg8::EpiBf16 E{(bf16*)(ws + WS_KMEM), 512};
                  pg8::gemm_phase<pg8::EpiBf16, pg8::PlainOrder, true, true>(F.lds, pg8::Gemm{1024, 1024, 1024}, S, E); }
                { pg8::PlainOrder S; S.init(512, BATCH * NMEM, G, cid); S.A = (const char*)(ws + WS_WKV) + (size_t)512 * 1024 * 2; S.Bt = (const char*)(ws + WS_MN); S.a_tile = 256 * 1024 * 2; S.b_tile = 256 * 1024 * 2;
                  pg8::EpiBf16 E{(bf16*)(ws + WS_VT), BATCH * NMEM};
                  pg8::gemm_phase<pg8::EpiBf16, pg8::PlainOrder, true, true>(F.lds, pg8::Gemm{1024, 1024, 1024}, S, E); }
            }
        } SEAM(pb);
        if (PC_(2) && IN(pb + 1)) {
            for (int it = F.vcu * 4; it < BG * 4 * NCHUNK; it += G * 4) { for (int k = 0; k < 4; ++k) hgrn_a_item(F, it + k); }
            for (int it = F.vcu; it < BG * 4 * 8; it += G) attn_item(F, g, it);
            conv_phase(F);
        } SEAM(pb + 1);
        if (PC_(3) && IN(pb + 2)) { hgrn_scan(F); } SEAM(pb + 2);
        if (PC_(4) && IN(pb + 3)) { for (int it = F.vcu * 4; it < BG * 4 * NCHUNK; it += G * 4) { for (int k = 0; k < 4; ++k) hgrn_c_item(F, it + k); } } SEAM(pb + 3);
        if (PC_(5) && IN(pb + 4)) {
            pg8::BranchOrder S; S.init(TG, 1024, G, cid); S.Y = (const char*)(ws + WS_YHG); S.Wb = (const char*)(ws + WS_WBR);
            pg8::EpiBranch E{(const bf16*)(ws + WS_PROJ), (float*)(ws + WS_MACC), (bf16*)(ws + WS_MERGED)};
            pg8::gemm_phase<pg8::EpiBranch, pg8::BranchOrder, true, true>(F.lds, pg8::Gemm{512, 512, 512}, S, E);
        } SEAM(pb + 4);
        if (PC_(6) && IN(pb + 5)) {
            pg8::PlainOrder S; S.init(TG, 1024, G, cid); S.A = (const char*)(ws + WS_MERGED); S.Bt = (const char*)(ws + WS_WOUT); S.a_tile = 256 * 1024 * 2; S.b_tile = 256 * 1024 * 2;
            pg8::EpiOut E{F.x + (size_t)g * TG * 1024, F.out + (size_t)g * TG * 1024, (bf16*)(ws + WS_XG) + (size_t)g * TG * 1024, F.norm_ffn_g, (float*)(ws + WS_SSP) + (size_t)g * TG * 16};
            pg8::gemm_phase<pg8::EpiOut, pg8::PlainOrder, true, true>(F.lds, pg8::Gemm{1024, 1024, 1024}, S, E);
        } SEAM(pb + 5);
    }
#pragma unroll 1
    for (int tg = 0; tg < NGRP; ++tg) {
        const int pb = 13 + 3 * tg;
        if (PC_(7) && IN(pb)) {
            if (tg == 0) convert_uv(F);
            pg8::PlainOrder S; S.init(TG, 2048, G, cid); S.A = (const char*)(ws + WS_XG) + (size_t)tg * TG * 1024 * 2; S.Bt = (const char*)(ws + WS_WQ); S.a_tile = 256 * 1024 * 2; S.b_tile = 256 * 1024 * 2;
            pg8::EpiQ E{(bf16*)(ws + WS_Q), 2048, (const float*)(ws + WS_SSP) + (size_t)tg * TG * 16};
            pg8::gemm_phase<pg8::EpiQ, pg8::PlainOrder, true, true>(F.lds, pg8::Gemm{1024, 1024, 1024}, S, E);
        } SEAM(pb);
        if (PC_(8) && IN(pb + 1)) {
            pg8::ScoreOrder S; S.init(TG, 2048, G, cid); S.Q = (const char*)(ws + WS_Q); S.Kbd = (const char*)(ws + WS_KBD);
            pg8::EpiF32 E{(float*)(ws + WS_S), 2048};
            pg8::gemm_phase<pg8::EpiF32, pg8::ScoreOrder, true, true>(F.lds, pg8::Gemm{2048, 256, 256}, S, E);
        } SEAM(pb + 1);
        if (PC_(9) && IN(pb + 2)) { peer_phase(F, tg); } SEAM(pb + 2);
    }
#undef IN
#undef SEAM
}

extern "C" void kernel_launch(void* const* d_in, const int* in_sizes, int n_in, void* d_out, int out_size, void* d_ws, size_t ws_size, hipStream_t stream) {
    static int ready = 0;
    if (ready == 0) {
        if (n_in != 17 || out_size != T_ALL * D_MODEL || ws_size < WS_END) { fprintf(stderr, "kernel_launch: unexpected shapes (n_in %d, out %d, ws %zu)\n", n_in, out_size, ws_size); ready = -1; return; }
        if (hipFuncSetAttribute((const void*)fwd_kernel, hipFuncAttributeMaxDynamicSharedMemorySize, LDS_BYTES) != hipSuccess) { fprintf(stderr, "kernel_launch: hipFuncSetAttribute failed\n"); ready = -1; return; }
        ready = 1;
    }
    if (ready < 0) return;
    (void)hipMemsetAsync((char*)d_ws + WS_CTL, 0, CTL_ZERO_BYTES, stream);
    Args a{};
    for (int i = 0; i < 17; ++i) a.in[i] = (const float*)d_in[i];
    a.out = (float*)d_out; a.ws = (unsigned char*)d_ws;
    const int grid = 256;
#if MK_N_LAUNCHES == 1
    a.ph_lo = 0; a.ph_hi = N_PHASES;
    hipLaunchKernelGGL(fwd_kernel, dim3(grid), dim3(NWAVES * 64), LDS_BYTES, stream, a);
#else
    for (int li = 0; li < N_PHASES; ++li) { a.ph_lo = li; a.ph_hi = li + 1; hipLaunchKernelGGL(fwd_kernel, dim3(grid), dim3(NWAVES * 64), LDS_BYTES, stream, a); }
#endif
}
```

```cpp
#include <hip/hip_runtime.h>
#include <cstdio>
#include <cstdint>

#ifndef MK_N_LAUNCHES
#define MK_N_LAUNCHES 1
#endif

#define LAS __attribute__((address_space(3)))
#define GAS __attribute__((address_space(1)))
typedef unsigned short bf16;
typedef short bf16x8 __attribute__((ext_vector_type(8)));
typedef short s16x4 __attribute__((ext_vector_type(4)));
typedef short v4i16_t __attribute__((ext_vector_type(4)));
typedef float f32x2 __attribute__((ext_vector_type(2)));
typedef float f32x4 __attribute__((ext_vector_type(4)));
typedef float f32x16 __attribute__((ext_vector_type(16)));
typedef unsigned u32x2 __attribute__((ext_vector_type(2)));
typedef unsigned u32x4 __attribute__((ext_vector_type(4)));
typedef __bf16 bf16x2_t __attribute__((ext_vector_type(2)));
typedef GAS unsigned gu32;
#define RLX_AGENT __ATOMIC_RELAXED, __HIP_MEMORY_SCOPE_AGENT
#define DI __device__ __forceinline__

constexpr int D_MODEL = 1024, BATCH = 16, SEQ = 2048, T_ALL = BATCH * SEQ;
constexpr int NGRP = 2, BG = BATCH / NGRP, TG = BG * SEQ;
constexpr int PC = 7680;
constexpr int C_HQ = 0, C_HI = 512, C_FF = 1024, C_FB = 1536, C_HG = 2048, C_SB = 2560, C_SC = 3072, C_SH = 3584, C_MQ = 4096, C_GATE = 4608;
constexpr int NMEM = 256, CHUNK = 64, NCHUNK = SEQ / CHUNK;
constexpr float EPS = 1e-6f;

constexpr size_t MiB = 1u << 20;
constexpr size_t WS_CTL = 0, CTL_ZERO_BYTES = 1 * MiB;
constexpr size_t WS_LB = 1 * MiB;
constexpr size_t WS_SSP = 2 * MiB;
constexpr size_t WS_DEC = 4 * MiB;
constexpr size_t WS_WIN = 5 * MiB, WS_WKV = 20 * MiB, WS_WBR = 22 * MiB, WS_WOUT = 25 * MiB, WS_WQ = 27 * MiB, WS_KBD = 31 * MiB;
constexpr size_t WS_MN = 32 * MiB, WS_KMEM = 40 * MiB, WS_VT = 44 * MiB;
constexpr size_t WS_XG = 48 * MiB;
constexpr size_t WS_YHG = 112 * MiB, WS_YSC = 128 * MiB, WS_YMX = 144 * MiB;
constexpr size_t WS_DS = 160 * MiB;
constexpr size_t WS_MACC = 160 * MiB;
constexpr size_t WS_MERGED = 224 * MiB;
constexpr size_t WS_PROJ = 256 * MiB;
constexpr size_t WS_U = 112 * MiB, WS_V = 144 * MiB;
constexpr size_t WS_Q = 176 * MiB;
constexpr size_t WS_S = 256 * MiB;
constexpr size_t WS_END = 496 * MiB;
constexpr size_t OUT_SST = 64 * MiB;

constexpr int LDS_BYTES = 160 * 1024;
constexpr int MISC_OFF = LDS_BYTES - 512;
constexpr int NWAVES = 8;

DI unsigned f2bf(float f) { unsigned u = __builtin_bit_cast(unsigned, f); return (u + 0x7fffu + ((u >> 16) & 1u)) >> 16; }
DI unsigned pk2(float lo, float hi) { return f2bf(lo) | (f2bf(hi) << 16); }
DI float bf2f(unsigned short b) { return __builtin_bit_cast(float, (unsigned)b << 16); }
DI float bflo(unsigned w) { return __builtin_bit_cast(float, w << 16); }
DI float bfhi(unsigned w) { return __builtin_bit_cast(float, w & 0xffff0000u); }
DI float wave_sum(float v) {
#pragma unroll
    for (int o = 1; o < 64; o <<= 1) v += __shfl_xor(v, o);
    return v;
}
DI unsigned cvtpk(float lo, float hi) { f32x2 v = {lo, hi}; bf16x2_t b = __builtin_convertvector(v, bf16x2_t); return __builtin_bit_cast(unsigned, b); }
DI float sigmoidf_(float z) { return 1.0f / (1.0f + __expf(-z)); }

namespace pg8 {
constexpr int BM = 256, BK = 64, HALF = 128, HTB = HALF * BK * 2, STAGE_BYTES = 8 * HTB, NXCD = 8, WGM = 8;
__host__ __device__ __forceinline__ int lds_byte(int r, int c) { const int st = (r >> 4) * 2 + (c >> 5), rr = r & 15, cc = c & 31, ob = rr * 64 + cc * 2; return st * 1024 + (ob ^ (((ob >> 9) & 1) << 5)); }
__host__ __device__ __forceinline__ void stage_rc(int b, int& R, int& C) { const int st = b / 1024, sb = b % 1024, swz = sb ^ (((sb >> 9) & 1) << 5); R = (st >> 1) * 16 + swz / 64; C = (st & 1) * 32 + (swz % 64) / 2; }
__host__ __device__ __forceinline__ int perm32(int rho) { const int n = rho >> 4, i = rho & 15; return 8 * (i >> 2) + 4 * n + (i & 3); }

struct Unit { int pm, pn, z; };
struct Gemm { int lda, ldb, K; };

struct StaticOrder {
    int nM, nN, nwg, G, c;
    __device__ void init(int M, int N, int G_, int c_) { nM = M / BM; nN = N / BM; nwg = nM * nN; G = G_; c = c_; }
    __device__ bool tile(int i, Unit& u) const {
        const long L = (long)i * G + c; if (L >= nwg) return false;
        int wgid = (int)L; { const int q = nwg / NXCD, r = nwg % NXCD, xcd = wgid % NXCD, off = wgid / NXCD; wgid = (xcd < r ? xcd * (q + 1) : r * (q + 1) + (xcd - r) * q) + off; }
        const int nig = WGM * nN, gid = wgid / nig, fm = gid * WGM, gsz = (nM - fm) < WGM ? (nM - fm) : WGM;
        u.pm = fm + ((wgid % nig) % gsz); u.pn = (wgid % nig) / gsz; u.z = 0; return true;
    }
};

DI unsigned cvt_pk_bf16(float lo, float hi) { return cvtpk(lo, hi); }

template <class Epi, class Sched, bool ALIGN_EPI, bool SP2>
DI void gemm_phase(LAS unsigned char* lds, const Gemm g, const Sched& S, const Epi& E) {
    int tid_ = threadIdx.x; asm volatile("" : "+v"(tid_));
    const int tid = tid_, wid = __builtin_amdgcn_readfirstlane(tid >> 6), lane = tid & 63, wr = wid >> 2, wc = wid & 3, fr = lane & 15, fq = lane >> 4;
    int K_ = g.K; asm volatile("" : "+s"(K_));
    const int K = K_, nt = K / BK;
    unsigned voffA[2], voffB[2];
#pragma unroll
    for (int i = 0; i < 2; ++i) { int R, C; stage_rc(tid * 16 + i * 8192, R, C); const int Rb = Epi::PERM ? ((R & ~31) + perm32(R & 31)) : R;
        voffA[i] = (unsigned)(R * g.lda + C) * 2u; voffB[i] = (unsigned)(Rb * g.ldb + C) * 2u; }
    const size_t kstep = (size_t)(BK * 2);
    const size_t hA = (size_t)HALF * g.lda * 2, hB = (size_t)HALF * g.ldb * 2;
    const unsigned ldsw = (unsigned)wid * 1024u;
    const int aoff = lds_byte(wr * 64 + fr, fq * 8), boff = lds_byte(wc * 32 + fr, fq * 8);
#define PG8_SA(b, h) (((b) * 2 + (h)) * HTB)
#define PG8_SB(b, h) ((4 + (b) * 2 + (h)) * HTB)
#define PG8_STAGE(bufoff, gbase, voff) do { _Pragma("unroll") for (int _i = 0; _i < 2; ++_i) \
        __builtin_amdgcn_global_load_lds((const unsigned*)((const char*)(gbase) + (voff)[_i]), (LAS unsigned*)(lds + (bufoff) + ldsw + _i * 8192), 16, 0, 0); } while (0)
#define PG8_LDA(dst, b, h) do { _Pragma("unroll") for (int m = 0; m < 4; ++m) _Pragma("unroll") for (int k = 0; k < 2; ++k) dst[m][k] = *(const LAS bf16x8*)(lds + PG8_SA(b, h) + aoff + m * 2048 + k * 1024); } while (0)
#define PG8_LDB(dst, b, h) do { _Pragma("unroll") for (int n = 0; n < 2; ++n) _Pragma("unroll") for (int k = 0; k < 2; ++k) dst[n][k] = *(const LAS bf16x8*)(lds + PG8_SB(b, h) + boff + n * 2048 + k * 1024); } while (0)
#define PG8_MMA(ai, bj, At, Bt) do { __builtin_amdgcn_s_setprio(1); _Pragma("unroll") for (int m = 0; m < 4; ++m) _Pragma("unroll") for (int n = 0; n < 2; ++n) _Pragma("unroll") for (int k = 0; k < 2; ++k) \
        acc[ai][bj][m][n] = __builtin_amdgcn_mfma_f32_16x16x32_bf16(Bt[n][k], At[m][k], acc[ai][bj][m][n], 0, 0, 0); __builtin_amdgcn_s_setprio(0); } while (0)
#define PG8_WAIT_V(n) asm volatile("s_waitcnt vmcnt(" #n ")" ::: "memory")
#define PG8_WAIT_L(n) asm volatile("s_waitcnt lgkmcnt(" #n ")" ::: "memory")
#define PG8_BAR __builtin_amdgcn_s_barrier()
#define PG8_SCHED __builtin_amdgcn_sched_barrier(0)
    Unit cur, nxt; int ui = 0;
    if (!S.next(0, cur)) return;
    f32x4 acc[2][2][4][2];
#pragma unroll
    for (int a = 0; a < 2; ++a)
#pragma unroll
        for (int b = 0; b < 2; ++b)
#pragma unroll
            for (int m = 0; m < 4; ++m)
#pragma unroll
                for (int n = 0; n < 2; ++n) acc[a][b][m][n] = (f32x4){0.f, 0.f, 0.f, 0.f};
    bf16x8 At[4][2], B0[2][2], B1[2][2];
    const char* cA = S.a_base(cur); const char* cB = S.b_base(cur);
    if constexpr (SP2) {
        PG8_STAGE(PG8_SB(0, 0), cB, voffB); PG8_STAGE(PG8_SB(0, 1), cB + hB, voffB); PG8_STAGE(PG8_SA(0, 0), cA, voffA); PG8_STAGE(PG8_SA(0, 1), cA + hA, voffA);
        if (wr == 1) PG8_BAR;
        PG8_WAIT_V(2); PG8_BAR;
        PG8_STAGE(PG8_SB(1, 0), cB + kstep, voffB); PG8_STAGE(PG8_SA(1, 0), cA + kstep, voffA); PG8_STAGE(PG8_SB(1, 1), cB + hB + kstep, voffB);
        PG8_WAIT_V(6); PG8_BAR;
    } else {
        PG8_STAGE(PG8_SB(0, 0), cB, voffB); PG8_STAGE(PG8_SA(0, 0), cA, voffA); PG8_STAGE(PG8_SB(0, 1), cB + hB, voffB); PG8_STAGE(PG8_SA(0, 1), cA + hA, voffA);
        if (wr == 1) PG8_BAR;
        PG8_WAIT_V(4); PG8_BAR;
        PG8_STAGE(PG8_SB(1, 0), cB + kstep, voffB); PG8_STAGE(PG8_SA(1, 0), cA + kstep, voffA); PG8_STAGE(PG8_SB(1, 1), cB + hB + kstep, voffB);
        PG8_WAIT_V(6); PG8_BAR;
    }
    for (;;) {
        const bool has_next = S.next(ui + 1, nxt);
        const char* nA = has_next ? S.a_base(nxt) : cA; const char* nB = has_next ? S.b_base(nxt) : cB;
        for (int t = 0; t < nt; t += 2) {
            const bool last = (t == nt - 2);
            const char* a1 = cA + (size_t)(t + 1) * kstep;
            const char* a2 = last ? nA : cA + (size_t)(t + 2) * kstep; const char* b2 = last ? nB : cB + (size_t)(t + 2) * kstep;
            const char* a3 = a2 + kstep; const char* b3 = b2 + kstep;
            if constexpr (SP2) {
            PG8_LDB(B0, 0, 0); PG8_LDB(B1, 0, 1); PG8_SCHED; PG8_LDA(At, 0, 0); PG8_STAGE(PG8_SA(1, 1), a1 + hA, voffA);
            PG8_WAIT_V(8); PG8_WAIT_L(0); PG8_BAR; PG8_MMA(0, 0, At, B0); PG8_MMA(0, 1, At, B1); PG8_BAR; PG8_SCHED;
            PG8_LDA(At, 0, 1); PG8_STAGE(PG8_SB(0, 0), b2, voffB); PG8_STAGE(PG8_SB(0, 1), b2 + hB, voffB); PG8_STAGE(PG8_SA(0, 0), a2, voffA);
            PG8_WAIT_V(8); PG8_WAIT_L(0); PG8_BAR; PG8_MMA(1, 0, At, B0); PG8_MMA(1, 1, At, B1); PG8_BAR; PG8_SCHED;
            PG8_LDB(B0, 1, 0); PG8_LDB(B1, 1, 1); PG8_SCHED; PG8_LDA(At, 1, 0); PG8_STAGE(PG8_SA(0, 1), a2 + hA, voffA);
            PG8_WAIT_V(8); PG8_WAIT_L(0); PG8_BAR; PG8_MMA(0, 0, At, B0); PG8_MMA(0, 1, At, B1); PG8_BAR; PG8_SCHED;
            PG8_LDA(At, 1, 1); PG8_STAGE(PG8_SB(1, 0), b3, voffB); PG8_STAGE(PG8_SB(1, 1), b3 + hB, voffB); PG8_STAGE(PG8_SA(1, 0), a3, voffA);
            PG8_WAIT_V(8); PG8_WAIT_L(0); PG8_BAR; PG8_MMA(1, 0, At, B0); PG8_MMA(1, 1, At, B1); PG8_BAR; PG8_SCHED;
            } else {
            PG8_LDB(B0, 0, 0); PG8_SCHED; PG8_LDA(At, 0, 0); PG8_STAGE(PG8_SA(1, 1), a1 + hA, voffA);
            PG8_WAIT_L(8); PG8_BAR; PG8_WAIT_L(0); PG8_MMA(0, 0, At, B0); PG8_BAR; PG8_SCHED;
            PG8_LDB(B1, 0, 1); PG8_STAGE(PG8_SB(0, 0), b2, voffB);
            PG8_BAR; PG8_WAIT_L(0); PG8_MMA(0, 1, At, B1); PG8_BAR;
            PG8_LDA(At, 0, 1); PG8_STAGE(PG8_SA(0, 0), a2, voffA);
            PG8_BAR; PG8_WAIT_L(0); PG8_MMA(1, 0, At, B0); PG8_BAR; PG8_SCHED;
            PG8_STAGE(PG8_SB(0, 1), b2 + hB, voffB);
            PG8_WAIT_V(6); PG8_BAR; PG8_MMA(1, 1, At, B1); PG8_BAR;
            PG8_LDB(B0, 1, 0); PG8_SCHED; PG8_LDA(At, 1, 0); PG8_STAGE(PG8_SA(0, 1), a2 + hA, voffA);
            PG8_WAIT_L(8); PG8_BAR; PG8_WAIT_L(0); PG8_MMA(0, 0, At, B0); PG8_BAR; PG8_SCHED;
            PG8_LDB(B1, 1, 1); PG8_STAGE(PG8_SB(1, 0), b3, voffB);
            PG8_BAR; PG8_WAIT_L(0); PG8_MMA(0, 1, At, B1); PG8_BAR;
            PG8_LDA(At, 1, 1); PG8_STAGE(PG8_SA(1, 0), a3, voffA);
            PG8_BAR; PG8_WAIT_L(0); PG8_MMA(1, 0, At, B0); PG8_BAR; PG8_SCHED;
            PG8_STAGE(PG8_SB(1, 1), b3 + hB, voffB);
            PG8_WAIT_V(6); PG8_BAR; PG8_MMA(1, 1, At, B1); PG8_BAR;
            }
        }
        if constexpr (ALIGN_EPI) { if (wr == 0) PG8_BAR; }
        E(acc, cur, wr, wc, fr, fq);
        if (!has_next) break;
#pragma unroll
        for (int a = 0; a < 2; ++a)
#pragma unroll
            for (int b = 0; b < 2; ++b)
#pragma unroll
                for (int m = 0; m < 4; ++m)
#pragma unroll
                    for (int n = 0; n < 2; ++n) acc[a][b][m][n] = (f32x4){0.f, 0.f, 0.f, 0.f};
        cur = nxt; cA = nA; cB = nB; ++ui;
        if constexpr (ALIGN_EPI) { if (wr == 1) PG8_BAR; }
    }
    PG8_WAIT_V(0);
    if constexpr (!ALIGN_EPI) { if (wr == 0) PG8_BAR; }
    PG8_BAR;
#undef PG8_SA
#undef PG8_SB
#undef PG8_STAGE
#undef PG8_LDA
#undef PG8_LDB
#undef PG8_MMA
#undef PG8_WAIT_V
#undef PG8_WAIT_L
#undef PG8_BAR
#undef PG8_SCHED
}
}

namespace pg8 {
struct PlainOrder : StaticOrder {
    const char* A; const char* Bt; size_t a_tile, b_tile;
    __device__ bool next(int i, Unit& u) const { return tile(i, u); }
    DI const char* a_base(const Unit& u) const { return A + (size_t)u.pm * a_tile; }
    DI const char* b_base(const Unit& u) const { return Bt + (size_t)u.pn * b_tile; }
};
struct BranchOrder : StaticOrder {
    const char* Y; const char* Wb;
    __device__ bool next(int i, Unit& u) const { if (!tile(i / 3, u)) return false; u.z = i % 3; return true; }
    DI const char* a_base(const Unit& u) const { return Y + (size_t)u.z * (16 * MiB) + (size_t)u.pm * (256 * 512 * 2); }
    DI const char* b_base(const Unit& u) const { return Wb + (size_t)u.z * (1024 * 512 * 2) + (size_t)u.pn * (256 * 512 * 2); }
};
struct ScoreOrder : StaticOrder {
    const char* Q; const char* Kbd;
    __device__ bool next(int i, Unit& u) const { return tile(i, u); }
    DI const char* a_base(const Unit& u) const { return Q + (size_t)u.pm * (256 * 2048 * 2) + (size_t)u.pn * 512; }
    DI const char* b_base(const Unit& u) const { return Kbd + (size_t)u.pn * (256 * 256 * 2); }
};

struct EpiBf16 {
    static constexpr bool PERM = true;
    bf16* O; int ldc;
    DI void operator()(const f32x4 (&acc)[2][2][4][2], const Unit& u, int wr, int wc, int fr, int fq) const {
        const int row0 = u.pm * BM + wr * 64 + fr, col0 = u.pn * BM + wc * 32 + 8 * fq;
#pragma unroll
        for (int ai = 0; ai < 2; ++ai)
#pragma unroll
            for (int m = 0; m < 4; ++m) { bf16* rowp = O + (size_t)(row0 + ai * HALF + m * 16) * ldc + col0;
#pragma unroll
                for (int bj = 0; bj < 2; ++bj) { const f32x4 v0 = acc[ai][bj][m][0], v1 = acc[ai][bj][m][1];
                    u32x4 w; w.x = cvt_pk_bf16(v0[0], v0[1]); w.y = cvt_pk_bf16(v0[2], v0[3]); w.z = cvt_pk_bf16(v1[0], v1[1]); w.w = cvt_pk_bf16(v1[2], v1[3]);
                    *(u32x4*)(rowp + bj * HALF) = w; } }
    }
};
struct EpiQ {
    static constexpr bool PERM = true;
    bf16* O; int ldc; const float* ssp;
    DI void operator()(const f32x4 (&acc)[2][2][4][2], const Unit& u, int wr, int wc, int fr, int fq) const {
        const int row0 = u.pm * BM + wr * 64 + fr, col0 = u.pn * BM + wc * 32 + 8 * fq;
#pragma unroll
        for (int ai = 0; ai < 2; ++ai)
#pragma unroll
            for (int m = 0; m < 4; ++m) { const int row = row0 + ai * HALF + m * 16; const f32x4* sp = (const f32x4*)(ssp + (size_t)row * 16);
                const f32x4 s0 = sp[0], s1 = sp[1], s2 = sp[2], s3 = sp[3];
                const float ss = ((s0[0] + s0[1]) + (s0[2] + s0[3])) + ((s1[0] + s1[1]) + (s1[2] + s1[3])) + ((s2[0] + s2[1]) + (s2[2] + s2[3])) + ((s3[0] + s3[1]) + (s3[2] + s3[3]));
                const float rs = 1.0f / sqrtf(ss * (1.0f / 1024.0f) + EPS);
                bf16* rowp = O + (size_t)row * ldc + col0;
#pragma unroll
                for (int bj = 0; bj < 2; ++bj) { const f32x4 v0 = acc[ai][bj][m][0] * rs, v1 = acc[ai][bj][m][1] * rs;
                    u32x4 w; w.x = cvt_pk_bf16(v0[0], v0[1]); w.y = cvt_pk_bf16(v0[2], v0[3]); w.z = cvt_pk_bf16(v1[0], v1[1]); w.w = cvt_pk_bf16(v1[2], v1[3]);
                    *(u32x4*)(rowp + bj * HALF) = w; }
                asm volatile("" ::: "memory"); }
    }
};
struct EpiF32 {
    static constexpr bool PERM = false;
    float* C; int ldc;
    DI void operator()(const f32x4 (&acc)[2][2][4][2], const Unit& u, int wr, int wc, int fr, int fq) const {
        const int row0 = u.pm * BM + wr * 64 + fr, col0 = u.pn * BM + wc * 32 + 4 * fq;
#pragma unroll
        for (int ai = 0; ai < 2; ++ai)
#pragma unroll
            for (int m = 0; m < 4; ++m) { float* rowp = C + (size_t)(row0 + ai * HALF + m * 16) * ldc + col0;
#pragma unroll
                for (int bj = 0; bj < 2; ++bj)
#pragma unroll
                    for (int n = 0; n < 2; ++n) *(f32x4*)(rowp + bj * HALF + n * 16) = acc[ai][bj][m][n]; }
    }
};
struct EpiBranch {
    static constexpr bool PERM = true;
    const bf16* proj; float* macc; bf16* merged;
    DI void operator()(const f32x4 (&acc)[2][2][4][2], const Unit& u, int wr, int wc, int fr, int fq) const {
        const int row0 = u.pm * BM + wr * 64 + fr, col0 = u.pn * BM + wc * 32 + 8 * fq;
#pragma unroll
        for (int ai = 0; ai < 2; ++ai)
#pragma unroll
            for (int m = 0; m < 4; ++m) { const int row = row0 + ai * HALF + m * 16;
#pragma unroll
                for (int bj = 0; bj < 2; ++bj) { const int col = col0 + bj * HALF;
                    const u32x4 gw = *(const u32x4*)(proj + (size_t)row * PC + C_GATE + u.z * 1024 + col);
                    f32x4 v0 = acc[ai][bj][m][0], v1 = acc[ai][bj][m][1];
                    v0[0] *= sigmoidf_(bflo(gw.x)); v0[1] *= sigmoidf_(bfhi(gw.x)); v0[2] *= sigmoidf_(bflo(gw.y)); v0[3] *= sigmoidf_(bfhi(gw.y));
                    v1[0] *= sigmoidf_(bflo(gw.z)); v1[1] *= sigmoidf_(bfhi(gw.z)); v1[2] *= sigmoidf_(bflo(gw.w)); v1[3] *= sigmoidf_(bfhi(gw.w));
                    float* mp = macc + (size_t)row * 1024 + col;
                    if (u.z > 0) { v0 += *(const f32x4*)mp; v1 += *(const f32x4*)(mp + 4); }
                    if (u.z < 2) { *(f32x4*)mp = v0; *(f32x4*)(mp + 4) = v1; }
                    else { u32x4 w; w.x = cvt_pk_bf16(v0[0], v0[1]); w.y = cvt_pk_bf16(v0[2], v0[3]); w.z = cvt_pk_bf16(v1[0], v1[1]); w.w = cvt_pk_bf16(v1[2], v1[3]);
                        *(u32x4*)(merged + (size_t)row * 1024 + col) = w; } }
                asm volatile("" ::: "memory"); }
    }
};
struct EpiOut {
    static constexpr bool PERM = true;
    const float* x; float* x1; bf16* xg; const float* gffn; float* ssp;
    DI void operator()(const f32x4 (&acc)[2][2][4][2], const Unit& u, int wr, int wc, int fr, int fq) const {
        const int row0 = u.pm * BM + wr * 64 + fr, col0 = u.pn * BM + wc * 32 + 8 * fq;
        f32x4 g0[2], g1[2];
#pragma unroll
        for (int bj = 0; bj < 2; ++bj) { g0[bj] = *(const f32x4*)(gffn + col0 + bj * HALF); g1[bj] = *(const f32x4*)(gffn + col0 + bj * HALF + 4); }
#pragma unroll
        for (int ai = 0; ai < 2; ++ai)
#pragma unroll
            for (int m = 0; m < 4; ++m) { const int row = row0 + ai * HALF + m * 16; float ss = 0.f;
#pragma unroll
                for (int bj = 0; bj < 2; ++bj) { const size_t off = (size_t)row * 1024 + col0 + bj * HALF;
                    const f32x4 v0 = acc[ai][bj][m][0] + *(const f32x4*)(x + off), v1 = acc[ai][bj][m][1] + *(const f32x4*)(x + off + 4);
                    *(f32x4*)(x1 + off) = v0; *(f32x4*)(x1 + off + 4) = v1;
                    ss += (v0[0] * v0[0] + v0[1] * v0[1]) + (v0[2] * v0[2] + v0[3] * v0[3]) + (v1[0] * v1[0] + v1[1] * v1[1]) + (v1[2] * v1[2] + v1[3] * v1[3]);
                    const f32x4 a = v0 * g0[bj], b = v1 * g1[bj];
                    u32x4 w; w.x = cvt_pk_bf16(a[0], a[1]); w.y = cvt_pk_bf16(a[2], a[3]); w.z = cvt_pk_bf16(b[0], b[1]); w.w = cvt_pk_bf16(b[2], b[3]);
                    *(u32x4*)(xg + off) = w; }
                ss += __shfl_xor(ss, 16); ss += __shfl_xor(ss, 32);
                if (fq == 0) ssp[(size_t)row * 16 + u.pn * 4 + wc] = ss;
                asm volatile("" ::: "memory"); }
    }
};
}

#define XB_TMO      128
#define XB_XCNT(j)  (256  + 64 * (j))
#define XB_XSUB(j)  (1280 + 64 * (j))
#define XB_XGEN(j)  (2304 + 64 * (j))
#define XB_TOP      3328
#define XB_TOPGEN   3392
#define XCD_BAR_WORDS 3456
#define XB_SPIN_CAP (1u << 18)
constexpr int CW_BAR = 4096;

DI unsigned xb_ld(unsigned* p)              { return __hip_atomic_load(p, __ATOMIC_RELAXED, __HIP_MEMORY_SCOPE_AGENT); }
DI unsigned xb_add(unsigned* p, unsigned v) { return __hip_atomic_fetch_add(p, v, __ATOMIC_RELAXED, __HIP_MEMORY_SCOPE_AGENT); }
DI unsigned xb_xcc_id() { return (unsigned)__builtin_amdgcn_s_getreg((3 << 11) | 20) & 0xFu; }
#define XB_SPIN(cond, bar) do { unsigned _sp = 0; while (cond) { __builtin_amdgcn_s_sleep(1); \
    if ((++_sp & 255u) == 0u) { if (xb_ld(&(bar)[XB_TMO])) break; if (_sp > XB_SPIN_CAP) { atomicAdd(&(bar)[XB_TMO], 1u); break; } } } } while (0)

struct XcdBarrier { unsigned* bar; unsigned x; volatile LAS unsigned* st; };

DI XcdBarrier xcd_barrier_post(unsigned* bar, volatile LAS unsigned* st) {
    XcdBarrier b; b.bar = bar; b.x = xb_xcc_id(); b.st = st;
    if (threadIdx.x == 0) (void)xb_add(&bar[XB_XCNT(b.x)], 1u);
    return b;
}
DI void xcd_barrier_complete(unsigned* bar, unsigned x, unsigned& nloc, unsigned& nx) {
    const unsigned G = gridDim.x * gridDim.y * gridDim.z;
    unsigned sum, cnt, mine, sp = 0u;
    for (;;) {
        sum = 0u; cnt = 0u; mine = 0u;
#pragma unroll
        for (unsigned j = 0; j < 16; ++j) { const unsigned c = xb_ld(&bar[XB_XCNT(j)]); sum += c; cnt += (c > 0u) ? 1u : 0u; mine = (j == x) ? c : mine; }
        if (sum == G) break;
        __builtin_amdgcn_s_sleep(1);
        if ((++sp & 255u) == 0u) { if (xb_ld(&bar[XB_TMO])) break; if (sp > XB_SPIN_CAP) { atomicAdd(&bar[XB_TMO], 1u); break; } }
    }
    nloc = mine > 0u ? mine : 1u; nx = cnt > 0u ? cnt : 1u;
}
DI void xcd_barrier(const XcdBarrier& b) {
    asm volatile("s_waitcnt vmcnt(0)" ::: "memory");
    __syncthreads();
    if (threadIdx.x == 0) {
        unsigned* bar = b.bar;
        __builtin_amdgcn_s_waitcnt(0);
        unsigned nloc = b.st[0], nx = b.st[1];
        if (nloc == 0u) { xcd_barrier_complete(bar, b.x, nloc, nx); b.st[0] = nloc; b.st[1] = nx; }
        const unsigned old = xb_add(&bar[XB_XSUB(b.x)], 1u);
        const unsigned gen = old / nloc;
        if (old + 1u == (gen + 1u) * nloc) {
            __builtin_amdgcn_fence(__ATOMIC_RELEASE, "agent");
            asm volatile("s_waitcnt vmcnt(0)" ::: "memory");
            const unsigned og = xb_add(&bar[XB_TOP], 1u);
            const unsigned tg = og / nx;
            if (og + 1u == (tg + 1u) * nx) xb_add(&bar[XB_TOPGEN], 1u);
            else XB_SPIN(xb_ld(&bar[XB_TOPGEN]) == tg, bar);
            __builtin_amdgcn_fence(__ATOMIC_ACQUIRE, "agent");
            xb_add(&bar[XB_XGEN(b.x)], 1u);
            asm volatile("s_waitcnt vmcnt(0)" ::: "memory");
        } else {
            XB_SPIN(xb_ld(&bar[XB_XGEN(b.x)]) == gen, bar);
            __builtin_amdgcn_fence(__ATOMIC_ACQUIRE, "agent");
            asm volatile("s_waitcnt vmcnt(0)" ::: "memory");
        }
    }
    __syncthreads();
}

struct Frame {
    LAS unsigned char* lds;
    int tid, lane, wave;
    DI void refresh() { int t = threadIdx.x; asm volatile("" : "+v"(t)); tid = t; lane = t & 63; wave = __builtin_amdgcn_readfirstlane(t >> 6); }
    int vcu, G;
    const float *x, *mem, *norm_mix_g, *w_in, *hg_lb, *hg_norm_g, *sc_conv_w, *mem_norm_g, *w_mem_kv, *w_branch, *w_out, *norm_ffn_g, *peer_w_q, *peer_sub_keys, *peer_u, *peer_v, *final_norm_g;
    float* out; unsigned char* ws;
};

DI void p0_transpose_item(const float* W, int K, int N, bf16* WT, LAS float* scr, int item, int lane) {
    const int nblk = N / 32, kb = item / nblk, nb = item % nblk, k0 = 64 * kb, n0 = 32 * nb;
#pragma unroll 8
    for (int i = 0; i < 32; ++i) { const int kk = 2 * i + (lane >> 5); scr[kk * 33 + (lane & 31)] = W[(size_t)(k0 + kk) * N + n0 + (lane & 31)]; }
    asm volatile("s_waitcnt lgkmcnt(0)" ::: "memory");
    const int c = lane & 7;
#pragma unroll
    for (int j = 0; j < 4; ++j) { const int n = (lane >> 3) + 8 * j; const LAS float* s = scr + (8 * c) * 33 + n;
        u32x4 o; o.x = pk2(s[0 * 33], s[1 * 33]); o.y = pk2(s[2 * 33], s[3 * 33]); o.z = pk2(s[4 * 33], s[5 * 33]); o.w = pk2(s[6 * 33], s[7 * 33]);
        *(u32x4*)(WT + (size_t)(n0 + n) * K + k0 + 8 * c) = o; }
    asm volatile("s_waitcnt lgkmcnt(0)" ::: "memory");
}
DI void rms_row_to_bf16(const float* xrow, const float* g, bf16* orow, int lane) {
    const f32x4* xr = (const f32x4*)xrow + lane; const f32x4* gr = (const f32x4*)g + lane;
    f32x4 v[4]; float s = 0.f;
#pragma unroll
    for (int j = 0; j < 4; ++j) { v[j] = xr[64 * j]; s += (v[j].x * v[j].x + v[j].y * v[j].y) + (v[j].z * v[j].z + v[j].w * v[j].w); }
    const float rstd = 1.0f / sqrtf(wave_sum(s) * (1.f / 1024.f) + EPS);
    unsigned long long* o8 = (unsigned long long*)orow + lane;
#pragma unroll
    for (int j = 0; j < 4; ++j) { const f32x4 gg = gr[64 * j]; const f32x4 y = v[j] * rstd * gg;
        o8[64 * j] = (unsigned long long)pk2(y.x, y.y) | ((unsigned long long)pk2(y.z, y.w) << 32); }
}
DI void p0_prologue(Frame& F) {
    F.refresh();
    LAS float* scr = (LAS float*)(F.lds + F.wave * 16384);
    const int gw = F.vcu * NWAVES + F.wave, NGW = F.G * NWAVES;
    unsigned char* ws = F.ws;
    constexpr int I_IN = (1024 / 64) * (PC / 32), I_KV = (1024 / 64) * (1024 / 32), I_BR = (512 / 64) * (1024 / 32), I_OUT = (1024 / 64) * (1024 / 32), I_Q = (1024 / 64) * (2048 / 32);
    constexpr int NITEMS = I_IN + I_KV + 3 * I_BR + I_OUT + I_Q;
    for (int it = gw; it < NITEMS; it += NGW) {
        int r = it;
        if (r < I_IN) { p0_transpose_item(F.w_in, 1024, PC, (bf16*)(ws + WS_WIN), scr, r, F.lane); continue; } r -= I_IN;
        if (r < I_KV) { p0_transpose_item(F.w_mem_kv, 1024, 1024, (bf16*)(ws + WS_WKV), scr, r, F.lane); continue; } r -= I_KV;
        if (r < 3 * I_BR) { const int n = r / I_BR; p0_transpose_item(F.w_branch + (size_t)n * 512 * 1024, 512, 1024, (bf16*)(ws + WS_WBR) + (size_t)n * 1024 * 512, scr, r % I_BR, F.lane); continue; } r -= 3 * I_BR;
        if (r < I_OUT) { p0_transpose_item(F.w_out, 1024, 1024, (bf16*)(ws + WS_WOUT), scr, r, F.lane); continue; } r -= I_OUT;
        p0_transpose_item(F.peer_w_q, 1024, 2048, (bf16*)(ws + WS_WQ), scr, r, F.lane);
    }
    const int gt = F.vcu * 512 + F.tid, NGT = F.G * 512;
    for (int it = gt; it < 8 * 256 * 32; it += NGT) {
        const int c8 = it & 31, row = (it >> 5) & 255, h = it >> 13, p = row >> 7, key = row & 127;
        u32x4 o = (u32x4){0u, 0u, 0u, 0u};
        if ((c8 >> 4) == p) { const float* s = F.peer_sub_keys + (((size_t)(h * 2 + p) * 128 + key) * 128 + (c8 & 15) * 8);
            const f32x4 a = *(const f32x4*)s, b = *(const f32x4*)(s + 4); o.x = pk2(a.x, a.y); o.y = pk2(a.z, a.w); o.z = pk2(b.x, b.y); o.w = pk2(b.z, b.w); }
        *(u32x4*)((bf16*)(ws + WS_KBD) + ((size_t)(h * 256 + row) * 256 + c8 * 8)) = o;
    }
    for (int it = gt; it < 1024; it += NGT) { const float a0 = F.hg_lb[it], a1 = F.hg_lb[1024 + it]; const float m = fmaxf(a0, a1); const float e0 = __expf(a0 - m), e1 = __expf(a1 - m);
        ((float*)(ws + WS_LB))[it] = e0 / (e0 + e1); }
    for (int m = gw; m < BATCH * NMEM; m += NGW) rms_row_to_bf16(F.mem + (size_t)m * 1024, F.mem_norm_g, (bf16*)(ws + WS_MN) + (size_t)m * 1024, F.lane);
    for (int m = gw; m < T_ALL; m += NGW) rms_row_to_bf16(F.x + (size_t)m * 1024, F.norm_mix_g, (bf16*)(ws + WS_XG) + (size_t)m * 1024, F.lane);
}

DI s16x4 tr16(const LAS unsigned char* p) { return __builtin_bit_cast(s16x4, __builtin_amdgcn_ds_read_tr16_b64_v4i16((LAS v4i16_t*)p)); }
DI bf16x8 cat8(s16x4 lo, s16x4 hi) { return __builtin_shufflevector(lo, hi, 0, 1, 2, 3, 4, 5, 6, 7); }
#define MFMA32(a, b, c) __builtin_amdgcn_mfma_f32_32x32x16_bf16((a), (b), (c), 0, 0, 0)
DI int crow(int reg, int h) { return (reg & 3) + 8 * (reg >> 2) + 4 * h; }
DI bf16x8 pack8(const f32x16& x, int s) {
    u32x4 p; p.x = cvtpk(x[8 * s], x[8 * s + 1]); p.y = cvtpk(x[8 * s + 2], x[8 * s + 3]); p.z = cvtpk(x[8 * s + 4], x[8 * s + 5]); p.w = cvtpk(x[8 * s + 6], x[8 * s + 7]);
    return __builtin_bit_cast(bf16x8, p);
}
constexpr int TS = 272;

DI void gate16(const bf16* zc, float lb, float (&L)[16], float (&kk)[16], float (&lf)[16]) {
    float run = 0.f; const float oml = 1.0f - lb;
#pragma unroll
    for (int i = 0; i < 16; ++i) { const float z = bf2f(zc[(size_t)i * PC]); const float sg = sigmoidf_(z); const float f = lb + oml * sg;
        lf[i] = __logf(f); kk[i] = oml * (1.0f - sg); run += lf[i]; L[i] = run; }
}

DI void hgrn_a_item(Frame& F, int item) {
    F.refresh();
    constexpr int T_V = 0, T_KF = 17408, T_KB = 34816, TOT = 52224;
    LAS unsigned char* lds = F.lds;
    const int n = item & 31, h = (item >> 5) & 3, b = item >> 7;
    const bf16* proj = (const bf16*)(F.ws + WS_PROJ) + ((size_t)b * SEQ + n * CHUNK) * PC;
    const int tid = F.tid, d = tid & 127, tq = tid >> 7;
    const float* lbp = (const float*)(F.ws + WS_LB);
    const float lbf = lbp[h * 128 + d], lbb = lbp[512 + h * 128 + d];
#pragma unroll
    for (int i = 0; i < 2; ++i) { const int id = tid + 512 * i, c = id >> 4, ch = id & 15;
        *(LAS u32x4*)(lds + T_V + c * TS + ch * 16) = *(const u32x4*)(proj + (size_t)c * PC + C_HI + h * 128 + ch * 8); }
    float Lf[16], kf[16], lff[16], Lb[16], kb[16], lfb[16];
    gate16(proj + (size_t)(16 * tq) * PC + C_FF + h * 128 + d, lbf, Lf, kf, lff);
    gate16(proj + (size_t)(16 * tq) * PC + C_FB + h * 128 + d, lbb, Lb, kb, lfb);
    LAS float* tot = (LAS float*)(lds + TOT);
    tot[(0 * 4 + tq) * 128 + d] = Lf[15]; tot[(1 * 4 + tq) * 128 + d] = Lb[15];
    __syncthreads();
    const float tf0 = tot[0 * 128 + d], tf1 = tot[1 * 128 + d], tf2 = tot[2 * 128 + d], tf3 = tot[3 * 128 + d];
    const float tb0 = tot[4 * 128 + d], tb1 = tot[5 * 128 + d], tb2 = tot[6 * 128 + d], tb3 = tot[7 * 128 + d];
    const float offf = (tq > 0 ? tf0 : 0.f) + (tq > 1 ? tf1 : 0.f) + (tq > 2 ? tf2 : 0.f), glf = (tf0 + tf1) + (tf2 + tf3);
    const float offb = (tq < 1 ? tb1 : 0.f) + (tq < 2 ? tb2 : 0.f) + (tq < 3 ? tb3 : 0.f), glb = (tb0 + tb1) + (tb2 + tb3);
    const float tbq = Lb[15];
#pragma unroll
    for (int i = 0; i < 16; ++i) { const int c = 16 * tq + i;
        const float G = offf + Lf[i]; const float kd = kf[i] * __expf(glf - G);
        const float Gb = offb + (tbq - Lb[i] + lfb[i]); const float kdb = kb[i] * __expf(glb - Gb);
        ((LAS bf16*)(lds + T_KF + c * TS))[d] = (bf16)f2bf(kd); ((LAS bf16*)(lds + T_KB + c * TS))[d] = (bf16)f2bf(kdb); }
    if (tq == 0) { float* dec = (float*)(F.ws + WS_DEC) + (size_t)item * 256; dec[d] = __expf(glf); dec[128 + d] = __expf(glb); }
    __syncthreads();
    const int w = F.wave, lane = F.lane, r = lane & 31, hh = lane >> 5, blk = (lane >> 4) & 1, q = (lane & 15) >> 2, p = lane & 3;
    const int dt = w >> 1, et0 = (w & 1) * 2;
#pragma unroll
    for (int dir = 0; dir < 2; ++dir) { const int TK = dir ? T_KB : T_KF;
#pragma unroll
        for (int e2 = 0; e2 < 2; ++e2) { const int et = et0 + e2; f32x16 acc;
#pragma unroll
            for (int i = 0; i < 16; ++i) acc[i] = 0.f;
#pragma unroll
            for (int ks = 0; ks < 4; ++ks) {
                const LAS unsigned char* ap = lds + TK + (16 * ks + 8 * hh + q) * TS + (32 * dt + 16 * blk + 4 * p) * 2;
                const LAS unsigned char* bp = lds + T_V + (16 * ks + 8 * hh + q) * TS + (32 * et + 16 * blk + 4 * p) * 2;
                const bf16x8 a = cat8(tr16(ap), tr16(ap + 4 * TS)), bq = cat8(tr16(bp), tr16(bp + 4 * TS));
                acc = MFMA32(a, bq, acc); }
            bf16* dsb = (bf16*)(F.ws + WS_DS) + ((size_t)(item * 2 + dir) * 128 + 32 * et + r) * 128 + 32 * dt + 4 * hh;
#pragma unroll
            for (int g4 = 0; g4 < 4; ++g4) { u32x2 wv; wv.x = cvtpk(acc[4 * g4], acc[4 * g4 + 1]); wv.y = cvtpk(acc[4 * g4 + 2], acc[4 * g4 + 3]); *(u32x2*)(dsb + 8 * g4) = wv; } } }
    __syncthreads();
}

DI void hgrn_scan(Frame& F) {
    F.refresh();
    const bf16* dS = (const bf16*)(F.ws + WS_DS); bf16* Sst = (bf16*)((unsigned char*)F.out + OUT_SST); const float* dec = (const float*)(F.ws + WS_DEC);
    const int gt = F.vcu * 512 + F.tid, NGT = F.G * 512;
    for (int id = gt; id < BG * 4 * 2 * 128 * 32; id += NGT) {
        const int d4 = id & 31, e = (id >> 5) & 127, dir = (id >> 12) & 1, bh = id >> 13;
        f32x4 S = (f32x4){0.f, 0.f, 0.f, 0.f};
#pragma unroll 4
        for (int s = 0; s < 32; ++s) { const int n = dir ? 31 - s : s, item = bh * 32 + n;
            const size_t off = ((size_t)(item * 2 + dir) * 128 + e) * 128 + d4 * 4;
            u32x2 o; o.x = cvtpk(S.x, S.y); o.y = cvtpk(S.z, S.w); *(u32x2*)(Sst + off) = o;
            const f32x4 dc = *(const f32x4*)(dec + (size_t)(item * 2 + dir) * 128 + d4 * 4);
            const u32x2 wv = *(const u32x2*)(dS + off);
            S.x = dc.x * S.x + bflo(wv.x); S.y = dc.y * S.y + bfhi(wv.x); S.z = dc.z * S.z + bflo(wv.y); S.w = dc.w * S.w + bfhi(wv.y); }
    }
}

DI void hgrn_c_item(Frame& F, int item) {
    F.refresh();
    constexpr int T_QRF = 0, T_KRF = 17408, T_QGF = 34816, T_QRB = 52224, T_KRB = 69632, T_QGB = 87040, T_V = 104448, TOT = 121856, O_OFF = 0, OS = 132;
    LAS unsigned char* lds = F.lds;
    const int n = item & 31, h = (item >> 5) & 3, b = item >> 7;
    const size_t row0 = (size_t)b * SEQ + n * CHUNK;
    const bf16* proj = (const bf16*)(F.ws + WS_PROJ) + row0 * PC;
    const int tid = F.tid, d = tid & 127, tq = tid >> 7;
    const float* lbp = (const float*)(F.ws + WS_LB);
    const float lbf = lbp[h * 128 + d], lbb = lbp[512 + h * 128 + d];
#pragma unroll
    for (int i = 0; i < 2; ++i) { const int id = tid + 512 * i, c = id >> 4, ch = id & 15;
        *(LAS u32x4*)(lds + T_V + c * TS + ch * 16) = *(const u32x4*)(proj + (size_t)c * PC + C_HI + h * 128 + ch * 8); }
    float qv[16];
#pragma unroll
    for (int i = 0; i < 16; ++i) { const float z = bf2f(proj[(size_t)(16 * tq + i) * PC + C_HQ + h * 128 + d]); qv[i] = z * sigmoidf_(z); }
    float Lf[16], kf[16], lff[16], Lb[16], kb[16], lfb[16];
    gate16(proj + (size_t)(16 * tq) * PC + C_FF + h * 128 + d, lbf, Lf, kf, lff);
    gate16(proj + (size_t)(16 * tq) * PC + C_FB + h * 128 + d, lbb, Lb, kb, lfb);
    LAS float* tot = (LAS float*)(lds + TOT);
    tot[(0 * 4 + tq) * 128 + d] = Lf[15]; tot[(1 * 4 + tq) * 128 + d] = Lb[15];
    __syncthreads();
    {
        const float tf0 = tot[0 * 128 + d], tf1 = tot[1 * 128 + d], tf2 = tot[2 * 128 + d];
        const float tb1 = tot[5 * 128 + d], tb2 = tot[6 * 128 + d], tb3 = tot[7 * 128 + d];
        const float offf = (tq > 0 ? tf0 : 0.f) + (tq > 1 ? tf1 : 0.f) + (tq > 2 ? tf2 : 0.f), greff = tf0 + tf1;
        const float offb = (tq < 1 ? tb1 : 0.f) + (tq < 2 ? tb2 : 0.f) + (tq < 3 ? tb3 : 0.f), grefb = tb2 + tb3;
        const float tbq = Lb[15];
#pragma unroll
        for (int i = 0; i < 16; ++i) { const int c = 16 * tq + i;
            const float G = offf + Lf[i]; const float x = G - greff;
            ((LAS bf16*)(lds + T_QRF + c * TS))[d] = (bf16)f2bf(qv[i] * __expf(x)); ((LAS bf16*)(lds + T_KRF + c * TS))[d] = (bf16)f2bf(kf[i] * __expf(-x)); ((LAS bf16*)(lds + T_QGF + c * TS))[d] = (bf16)f2bf(qv[i] * __expf(G));
            const float Gb = offb + (tbq - Lb[i] + lfb[i]); const float xb = Gb - grefb;
            ((LAS bf16*)(lds + T_QRB + c * TS))[d] = (bf16)f2bf(qv[i] * __expf(xb)); ((LAS bf16*)(lds + T_KRB + c * TS))[d] = (bf16)f2bf(kb[i] * __expf(-xb)); ((LAS bf16*)(lds + T_QGB + c * TS))[d] = (bf16)f2bf(qv[i] * __expf(Gb)); }
    }
    __syncthreads();
    const int w = F.wave, lane = F.lane, r = lane & 31, hh = lane >> 5, blk = (lane >> 4) & 1, q = (lane & 15) >> 2, p = lane & 3;
    const int ct = w >> 2, et = w & 3;
    const bf16* Sst = (const bf16*)((const unsigned char*)F.out + OUT_SST);
    f32x16 o;
#pragma unroll
    for (int i = 0; i < 16; ++i) o[i] = 0.f;
#pragma unroll
    for (int dir = 0; dir < 2; ++dir) { const int TQR = dir ? T_QRB : T_QRF, TKR = dir ? T_KRB : T_KRF, TQG = dir ? T_QGB : T_QGF;
#pragma unroll
        for (int st = 0; st < 2; ++st) {
            if (dir == 0 ? (st > ct) : (st < ct)) continue;
            f32x16 X;
#pragma unroll
            for (int i = 0; i < 16; ++i) X[i] = 0.f;
#pragma unroll
            for (int ks = 0; ks < 8; ++ks) { const bf16x8 a = *(const LAS bf16x8*)(lds + TKR + (32 * st + r) * TS + (16 * ks + 8 * hh) * 2), bq = *(const LAS bf16x8*)(lds + TQR + (32 * ct + r) * TS + (16 * ks + 8 * hh) * 2);
                X = MFMA32(a, bq, X); }
            const int cc = 32 * ct + r;
#pragma unroll
            for (int i = 0; i < 16; ++i) { const int s = 32 * st + crow(i, hh); const bool keep = dir == 0 ? (s <= cc) : (s >= cc); X[i] = keep ? X[i] : 0.f; }
#pragma unroll
            for (int s2 = 0; s2 < 2; ++s2) { const bf16x8 xs = pack8(X, s2);
                const LAS unsigned char* vp = lds + T_V + (32 * st + 16 * s2 + 4 * hh + q) * TS + (32 * et + 16 * blk + 4 * p) * 2;
                const bf16x8 pb = cat8(tr16(vp), tr16(vp + 8 * TS));
                o = MFMA32(xs, pb, o); }
        }
        const bf16* sp = Sst + ((size_t)(item * 2 + dir) * 128 + 32 * et + r) * 128 + 8 * hh;
#pragma unroll
        for (int ks = 0; ks < 8; ++ks) { const bf16x8 a = *(const LAS bf16x8*)(lds + TQG + (32 * ct + r) * TS + (16 * ks + 8 * hh) * 2); const bf16x8 bq = *(const bf16x8*)(sp + 16 * ks);
            o = MFMA32(a, bq, o); }
    }
    __syncthreads();
    LAS float* O = (LAS float*)(lds + O_OFF);
#pragma unroll
    for (int i = 0; i < 16; ++i) O[(32 * ct + crow(i, hh)) * OS + 32 * et + r] = o[i];
    __syncthreads();
    const float g0 = F.hg_norm_g[h * 128 + 2 * lane], g1 = F.hg_norm_g[h * 128 + 2 * lane + 1];
    bf16* yhg = (bf16*)(F.ws + WS_YHG);
#pragma unroll
    for (int k = 0; k < 8; ++k) { const int c = 8 * w + k; const f32x2 v = *(const LAS f32x2*)(O + c * OS + 2 * lane);
        const float ss = wave_sum(v.x * v.x + v.y * v.y); const float rstd = 1.0f / sqrtf(ss * (1.0f / 128.0f) + EPS);
        const unsigned hw = *(const unsigned*)(proj + (size_t)c * PC + C_HG + h * 128 + 2 * lane); const float z0 = bflo(hw), z1 = bfhi(hw);
        const float y0 = v.x * rstd * g0 * (z0 * sigmoidf_(z0)), y1 = v.y * rstd * g1 * (z1 * sigmoidf_(z1));
        *(unsigned*)(yhg + (row0 + c) * 512 + h * 128 + 2 * lane) = cvtpk(y0, y1); }
    __syncthreads();
}

DI void attn_item(Frame& F, int g, int item) {
    F.refresh();
    constexpr int KS = 272, VS = 528, K_OFF = 0, V_OFF = 69632;
    LAS unsigned char* lds = F.lds;
    const int qb = item & 7, h = (item >> 3) & 3, b = item >> 5, bglob = g * BG + b;
    const bf16* Km = (const bf16*)(F.ws + WS_KMEM) + (size_t)bglob * 256 * 512 + h * 128;
    const bf16* VT = (const bf16*)(F.ws + WS_VT) + (size_t)(h * 128) * 4096 + bglob * 256;
    const int tid = F.tid;
#pragma unroll
    for (int i = 0; i < 8; ++i) { const int id = tid + 512 * i, key = id >> 4, ch = id & 15;
        *(LAS u32x4*)(lds + K_OFF + key * KS + ch * 16) = *(const u32x4*)(Km + (size_t)key * 512 + ch * 8); }
#pragma unroll
    for (int i = 0; i < 8; ++i) { const int id = tid + 512 * i, e = id >> 5, ch = id & 31;
        *(LAS u32x4*)(lds + V_OFF + e * VS + ch * 16) = *(const u32x4*)(VT + (size_t)e * 4096 + ch * 8); }
    __syncthreads();
    const int w = F.wave, lane = F.lane, r = lane & 31, hh = lane >> 5;
    const size_t qrow0 = (size_t)b * SEQ + qb * 256 + w * 32;
    const bf16* proj = (const bf16*)(F.ws + WS_PROJ);
    bf16x8 qf[8];
#pragma unroll
    for (int ks = 0; ks < 8; ++ks) qf[ks] = *(const bf16x8*)(proj + (qrow0 + r) * PC + C_MQ + h * 128 + 16 * ks + 8 * hh);
    const float scale = 0.08838834764831845f;
    float m_run = -INFINITY, l_run = 0.f;
#pragma unroll 1
    for (int kt = 0; kt < 8; ++kt) {
        f32x16 X;
#pragma unroll
        for (int i = 0; i < 16; ++i) X[i] = 0.f;
#pragma unroll
        for (int ks = 0; ks < 8; ++ks) { const bf16x8 a = *(const LAS bf16x8*)(lds + K_OFF + (32 * kt + r) * KS + (16 * ks + 8 * hh) * 2); X = MFMA32(a, qf[ks], X); }
        float tm = X[0];
#pragma unroll
        for (int i = 1; i < 16; ++i) tm = fmaxf(tm, X[i]);
        tm *= scale;
        const float mn = fmaxf(m_run, tm); float ls = 0.f;
#pragma unroll
        for (int i = 0; i < 16; ++i) ls += __expf(X[i] * scale - mn);
        l_run = l_run * __expf(m_run - mn) + ls; m_run = mn;
    }
    { const float mo = __shfl_xor(m_run, 32), lo = __shfl_xor(l_run, 32); const float m = fmaxf(m_run, mo);
      l_run = l_run * __expf(m_run - m) + lo * __expf(mo - m); m_run = m; }
    const float inv_l = 1.0f / l_run;
    f32x16 O[4];
#pragma unroll
    for (int e = 0; e < 4; ++e)
#pragma unroll
        for (int i = 0; i < 16; ++i) O[e][i] = 0.f;
#pragma unroll 1
    for (int kt = 0; kt < 8; ++kt) {
        f32x16 X;
#pragma unroll
        for (int i = 0; i < 16; ++i) X[i] = 0.f;
#pragma unroll
        for (int ks = 0; ks < 8; ++ks) { const bf16x8 a = *(const LAS bf16x8*)(lds + K_OFF + (32 * kt + r) * KS + (16 * ks + 8 * hh) * 2); X = MFMA32(a, qf[ks], X); }
#pragma unroll
        for (int i = 0; i < 16; ++i) X[i] = __expf(X[i] * scale - m_run) * inv_l;
#pragma unroll
        for (int s2 = 0; s2 < 2; ++s2) { const bf16x8 xs = pack8(X, s2);
#pragma unroll
            for (int e = 0; e < 4; ++e) { const LAS unsigned char* vp = lds + V_OFF + (32 * e + r) * VS + (32 * kt + 16 * s2 + 4 * hh) * 2;
                const bf16x8 pb = cat8(*(const LAS s16x4*)vp, *(const LAS s16x4*)(vp + 16));
                O[e] = MFMA32(xs, pb, O[e]); } }
    }
    bf16* ymx = (bf16*)(F.ws + WS_YMX);
#pragma unroll
    for (int e = 0; e < 4; ++e)
#pragma unroll
        for (int i = 0; i < 16; ++i) ymx[(qrow0 + crow(i, hh)) * 512 + h * 128 + 32 * e + r] = (bf16)f2bf(O[e][i]);
    __syncthreads();
}

DI void conv_phase(Frame& F) {
    F.refresh();
    const bf16* proj = (const bf16*)(F.ws + WS_PROJ); bf16* ysc = (bf16*)(F.ws + WS_YSC); const float* cw = F.sc_conv_w;
    const int gt = F.vcu * 512 + F.tid, NGT = F.G * 512;
    for (int id = gt; id < TG * 64; id += NGT) {
        const int c8 = id & 63, t = id >> 6, ts = t & (SEQ - 1);
        const bf16* pr = proj + (size_t)t * PC + c8 * 8;
        const u32x4 z4 = (u32x4){0u, 0u, 0u, 0u};
        const u32x4 sb = *(const u32x4*)(pr + C_SB), c1 = *(const u32x4*)(pr + C_SC), h1 = *(const u32x4*)(pr + C_SH);
        const u32x4 c0 = ts > 0 ? *(const u32x4*)(pr - PC + C_SC) : z4, h0 = ts > 0 ? *(const u32x4*)(pr - PC + C_SH) : z4;
        const u32x4 c2 = ts < SEQ - 1 ? *(const u32x4*)(pr + PC + C_SC) : z4, h2 = ts < SEQ - 1 ? *(const u32x4*)(pr + PC + C_SH) : z4;
        const f32x4 wa0 = *(const f32x4*)(cw + c8 * 8), wa1 = *(const f32x4*)(cw + c8 * 8 + 4), wb0 = *(const f32x4*)(cw + 512 + c8 * 8), wb1 = *(const f32x4*)(cw + 512 + c8 * 8 + 4),
                    wc0 = *(const f32x4*)(cw + 1024 + c8 * 8), wc1 = *(const f32x4*)(cw + 1024 + c8 * 8 + 4);
        float y[8];
#pragma unroll
        for (int k = 0; k < 4; ++k) {
            const float w0l = k < 2 ? wa0[2 * k] : wa1[2 * k - 4], w0h = k < 2 ? wa0[2 * k + 1] : wa1[2 * k - 3];
            const float w1l = k < 2 ? wb0[2 * k] : wb1[2 * k - 4], w1h = k < 2 ? wb0[2 * k + 1] : wb1[2 * k - 3];
            const float w2l = k < 2 ? wc0[2 * k] : wc1[2 * k - 4], w2h = k < 2 ? wc0[2 * k + 1] : wc1[2 * k - 3];
            y[2 * k]     = bflo(sb[k]) * (w0l * (bflo(c0[k]) * bflo(h0[k])) + w1l * (bflo(c1[k]) * bflo(h1[k])) + w2l * (bflo(c2[k]) * bflo(h2[k])));
            y[2 * k + 1] = bfhi(sb[k]) * (w0h * (bfhi(c0[k]) * bfhi(h0[k])) + w1h * (bfhi(c1[k]) * bfhi(h1[k])) + w2h * (bfhi(c2[k]) * bfhi(h2[k]))); }
        u32x4 o; o.x = cvtpk(y[0], y[1]); o.y = cvtpk(y[2], y[3]); o.z = cvtpk(y[4], y[5]); o.w = cvtpk(y[6], y[7]);
        *(u32x4*)(ysc + (size_t)t * 512 + c8 * 8) = o;
    }
}

DI unsigned ord_key(float v, int idx) { unsigned u = __builtin_bit_cast(unsigned, v); u ^= (u >> 31) ? 0xFFFFFFFFu : 0x80000000u; return (u & 0xFFFFFF80u) | (unsigned)(127 - idx); }
DI float key_val(unsigned k) { unsigned u = k & 0xFFFFFF80u; u = (u & 0x80000000u) ? (u ^ 0x80000000u) : ~u; return __builtin_bit_cast(float, u); }
DI float dot2bf(unsigned a, unsigned b, float c) { return __builtin_amdgcn_fdot2_f32_bf16(__builtin_bit_cast(bf16x2_t, a), __builtin_bit_cast(bf16x2_t, b), c, false); }
DI float dot8(const u32x4& a, const u32x4& b, float c) { c = dot2bf(a.x, b.x, c); c = dot2bf(a.y, b.y, c); c = dot2bf(a.z, b.z, c); return dot2bf(a.w, b.w, c); }
__host__ __device__ constexpr int cand_off(int i) { return i == 0 ? 0 : i == 1 ? 16 : i == 2 ? 24 : i == 3 ? 29 : i == 4 ? 33 : i == 5 ? 36 : i == 6 ? 38 : i == 7 ? 40 : 34 + i; }
__host__ __device__ constexpr int cand_i(int c) { return c < 16 ? 0 : c < 24 ? 1 : c < 29 ? 2 : c < 33 ? 3 : c < 36 ? 4 : c < 38 ? 5 : c < 40 ? 6 : c < 42 ? 7 : c - 34; }
__host__ __device__ constexpr int cand_pos(int c) { return cand_i(c) * 16 + (c - cand_off(cand_i(c))); }

DI void peer_topk(const float* srow, LAS int* widx, LAS float* wgate, int lane) {
    const int gq = lane >> 4, li = lane & 15;
    const int ci = cand_i(lane), cj = lane - cand_off(ci), cpos = ci * 16 + cj; const bool cvalid = lane < 50;
#pragma unroll 1
    for (int hp = 0; hp < 4; ++hp) {
        const int head = 2 * hp + (gq >> 1), p = gq & 1;
        const f32x4 va = *(const f32x4*)(srow + head * 256 + p * 128 + li * 8), vb = *(const f32x4*)(srow + head * 256 + p * 128 + li * 8 + 4);
        unsigned k[8];
        k[0] = ord_key(va.x, li * 8 + 0); k[1] = ord_key(va.y, li * 8 + 1); k[2] = ord_key(va.z, li * 8 + 2); k[3] = ord_key(va.w, li * 8 + 3);
        k[4] = ord_key(vb.x, li * 8 + 4); k[5] = ord_key(vb.y, li * 8 + 5); k[6] = ord_key(vb.z, li * 8 + 6); k[7] = ord_key(vb.w, li * 8 + 7);
        unsigned mine = 0u;
#pragma unroll
        for (int rd = 0; rd < 16; ++rd) {
            unsigned m = max(max(max(k[0], k[1]), max(k[2], k[3])), max(max(k[4], k[5]), max(k[6], k[7])));
            m = max(m, (unsigned)__shfl_xor((int)m, 1, 16)); m = max(m, (unsigned)__shfl_xor((int)m, 2, 16)); m = max(m, (unsigned)__shfl_xor((int)m, 4, 16)); m = max(m, (unsigned)__shfl_xor((int)m, 8, 16));
            mine = (li == rd) ? m : mine;
#pragma unroll
            for (int j = 0; j < 8; ++j) k[j] = (k[j] == m) ? 0u : k[j];
        }
        const float sc = key_val(mine); const int ix = 127 - (int)(mine & 127u);
#pragma unroll
        for (int hsel = 0; hsel < 2; ++hsel) {
            const float a = __shfl(sc, 32 * hsel + ci), bq = __shfl(sc, 32 * hsel + 16 + cj);
            const int ia = __shfl(ix, 32 * hsel + ci), ib = __shfl(ix, 32 * hsel + 16 + cj);
            const float cs = a + bq;
            int rank = 0;
#pragma unroll
            for (int c2 = 0; c2 < 50; ++c2) { const float v2 = __builtin_bit_cast(float, __builtin_amdgcn_readlane(__builtin_bit_cast(int, cs), c2));
                rank += ((v2 > cs) || (v2 == cs && cand_pos(c2) < cpos)) ? 1 : 0; }
            const bool sel = cvalid && rank < 16;
            const float mx = __builtin_bit_cast(float, __builtin_amdgcn_readlane(__builtin_bit_cast(int, cs), 0));
            const float ev = sel ? __expf(cs - mx) : 0.f;
            const float sum = wave_sum(ev);
            if (sel) { const int hd = 2 * hp + hsel; widx[hd * 16 + rank] = ia * 128 + ib; wgate[hd * 16 + rank] = ev / sum; }
        }
    }
}

DI void peer_phase(Frame& F, int tg) {
    F.refresh();
    const int gw = F.vcu * NWAVES + F.wave, NGW = F.G * NWAVES, lane = F.lane;
    LAS int* widx = (LAS int*)(F.lds + F.wave * 1024); LAS float* wgate = (LAS float*)(F.lds + F.wave * 1024 + 512);
    const bf16* U = (const bf16*)(F.ws + WS_U); const bf16* V = (const bf16*)(F.ws + WS_V);
    const f32x4* gf = (const f32x4*)F.final_norm_g;
    for (int tl = gw; tl < TG; tl += NGW) {
        const size_t t = (size_t)tg * TG + tl;
        peer_topk((const float*)(F.ws + WS_S) + (size_t)tl * 2048, widx, wgate, lane);
        asm volatile("s_waitcnt lgkmcnt(0)" ::: "memory");
        const bf16* xr = (const bf16*)(F.ws + WS_XG) + t * 1024;
        const u32x4 hx0 = *(const u32x4*)(xr + lane * 8), hx1 = *(const u32x4*)(xr + 512 + lane * 8);
        const f32x4* sp = (const f32x4*)((const float*)(F.ws + WS_SSP) + t * 16);
        const f32x4 s0 = sp[0], s1 = sp[1], s2 = sp[2], s3 = sp[3];
        const float ssx = ((s0[0] + s0[1]) + (s0[2] + s0[3])) + ((s1[0] + s1[1]) + (s1[2] + s1[3])) + ((s2[0] + s2[1]) + (s2[2] + s2[3])) + ((s3[0] + s3[1]) + (s3[2] + s3[3]));
        const float rstd = 1.0f / sqrtf(ssx * (1.0f / 1024.0f) + EPS);
        float outv[16];
#pragma unroll
        for (int i = 0; i < 16; ++i) outv[i] = 0.f;
#pragma unroll 1
        for (int half = 0; half < 2; ++half) {
            float dots = 0.f;
#pragma unroll 1
            for (int j = 0; j < 64; j += 4) {
                u32x4 ua[4], ub[4];
#pragma unroll
                for (int k = 0; k < 4; ++k) { const int e = __builtin_amdgcn_readfirstlane(widx[half * 64 + j + k]); const bf16* ur = U + (size_t)e * 1024;
                    ua[k] = *(const u32x4*)(ur + lane * 8); ub[k] = *(const u32x4*)(ur + 512 + lane * 8); }
#pragma unroll
                for (int k = 0; k < 4; ++k) { float pd = dot8(hx0, ua[k], 0.f); pd = dot8(hx1, ub[k], pd); pd = wave_sum(pd); dots = (lane == j + k) ? pd : dots; }
            }
            const float av = dots * rstd;
            const float cf = wgate[half * 64 + lane] * (0.5f * av * (1.0f + erff(av * 0.70710678118654752f)));
#pragma unroll 1
            for (int j = 0; j < 64; j += 4) {
                u32x4 va[4], vb[4]; float c[4];
#pragma unroll
                for (int k = 0; k < 4; ++k) { const int e = __builtin_amdgcn_readfirstlane(widx[half * 64 + j + k]); const bf16* vr = V + (size_t)e * 1024;
                    va[k] = *(const u32x4*)(vr + lane * 8); vb[k] = *(const u32x4*)(vr + 512 + lane * 8);
                    c[k] = __builtin_bit_cast(float, __builtin_amdgcn_readlane(__builtin_bit_cast(int, cf), j + k)); }
#pragma unroll
                for (int k = 0; k < 4; ++k) {
                    outv[0] += c[k] * bflo(va[k].x); outv[1] += c[k] * bfhi(va[k].x); outv[2] += c[k] * bflo(va[k].y); outv[3] += c[k] * bfhi(va[k].y);
                    outv[4] += c[k] * bflo(va[k].z); outv[5] += c[k] * bfhi(va[k].z); outv[6] += c[k] * bflo(va[k].w); outv[7] += c[k] * bfhi(va[k].w);
                    outv[8] += c[k] * bflo(vb[k].x); outv[9] += c[k] * bfhi(vb[k].x); outv[10] += c[k] * bflo(vb[k].y); outv[11] += c[k] * bfhi(vb[k].y);
                    outv[12] += c[k] * bflo(vb[k].z); outv[13] += c[k] * bfhi(vb[k].z); outv[14] += c[k] * bflo(vb[k].w); outv[15] += c[k] * bfhi(vb[k].w); }
            }
        }
        float* xo = F.out + t * 1024;
        f32x4 a0 = *(const f32x4*)(xo + lane * 8), a1 = *(const f32x4*)(xo + lane * 8 + 4), a2 = *(const f32x4*)(xo + 512 + lane * 8), a3 = *(const f32x4*)(xo + 512 + lane * 8 + 4);
        a0 += (f32x4){outv[0], outv[1], outv[2], outv[3]}; a1 += (f32x4){outv[4], outv[5], outv[6], outv[7]}; a2 += (f32x4){outv[8], outv[9], outv[10], outv[11]}; a3 += (f32x4){outv[12], outv[13], outv[14], outv[15]};
        float ss = (a0.x * a0.x + a0.y * a0.y) + (a0.z * a0.z + a0.w * a0.w) + (a1.x * a1.x + a1.y * a1.y) + (a1.z * a1.z + a1.w * a1.w)
                 + (a2.x * a2.x + a2.y * a2.y) + (a2.z * a2.z + a2.w * a2.w) + (a3.x * a3.x + a3.y * a3.y) + (a3.z * a3.z + a3.w * a3.w);
        ss = wave_sum(ss);
        const float rf = 1.0f / sqrtf(ss * (1.0f / 1024.0f) + EPS);
        *(f32x4*)(xo + lane * 8) = a0 * rf * gf[lane * 2]; *(f32x4*)(xo + lane * 8 + 4) = a1 * rf * gf[lane * 2 + 1];
        *(f32x4*)(xo + 512 + lane * 8) = a2 * rf * gf[128 + lane * 2]; *(f32x4*)(xo + 512 + lane * 8 + 4) = a3 * rf * gf[128 + lane * 2 + 1];
        asm volatile("s_waitcnt lgkmcnt(0)" ::: "memory");
    }
}

DI void convert_uv(Frame& F) {
    F.refresh();
    const int gt = F.vcu * 512 + F.tid, NGT = F.G * 512;
    for (int id = gt; id < 2 * 16384 * 128; id += NGT) {
        const int which = id >> 21, off = (id & ((1 << 21) - 1)) * 8;
        const float* src = (which ? F.peer_v : F.peer_u) + off; bf16* dst = (bf16*)(F.ws + (which ? WS_V : WS_U)) + off;
        const f32x4 a = *(const f32x4*)src, b = *(const f32x4*)(src + 4);
        u32x4 o; o.x = cvtpk(a.x, a.y); o.y = cvtpk(a.z, a.w); o.z = cvtpk(b.x, b.y); o.w = cvtpk(b.z, b.w);
        *(u32x4*)dst = o;
    }
}

constexpr int N_PHASES = 19;
struct Args { const float* in[17]; float* out; unsigned char* ws; int ph_lo, ph_hi; };

__global__ void __launch_bounds__(NWAVES * 64, 2) fwd_kernel(Args args) {
    extern __shared__ __attribute__((aligned(16))) unsigned char lds_raw[];
    Frame F;
    F.lds = (LAS unsigned char*)lds_raw;
    F.tid = threadIdx.x; F.lane = F.tid & 63; F.wave = __builtin_amdgcn_readfirstlane(F.tid >> 6);
    F.G = gridDim.x; { const int bx = blockIdx.x; F.vcu = (F.G % 8 == 0) ? (bx % 8) * (F.G / 8) + bx / 8 : bx; }
    F.x = args.in[0]; F.mem = args.in[1]; F.norm_mix_g = args.in[2]; F.w_in = args.in[3]; F.hg_lb = args.in[4]; F.hg_norm_g = args.in[5]; F.sc_conv_w = args.in[6];
    F.mem_norm_g = args.in[7]; F.w_mem_kv = args.in[8]; F.w_branch = args.in[9]; F.w_out = args.in[10]; F.norm_ffn_g = args.in[11]; F.peer_w_q = args.in[12];
    F.peer_sub_keys = args.in[13]; F.peer_u = args.in[14]; F.peer_v = args.in[15]; F.final_norm_g = args.in[16];
    F.out = args.out; F.ws = args.ws;
    volatile LAS unsigned* MISC = (volatile LAS unsigned*)(F.lds + MISC_OFF);
    for (int u = F.tid; u < (LDS_BYTES - MISC_OFF) / 4; u += NWAVES * 64) MISC[u] = 0u;
    __syncthreads();
    unsigned* barw = (unsigned*)(F.ws + WS_CTL) + CW_BAR;
    XcdBarrier bar; bar.bar = barw; bar.x = 0; bar.st = nullptr;
    const bool one_launch = (args.ph_hi - args.ph_lo) > 1;
    if (one_launch) bar = xcd_barrier_post(barw, MISC + 8);
    const int lo = args.ph_lo, hi = args.ph_hi;
#define IN(k) (lo <= (k) && (k) < hi)
#ifndef PMASK
#define PMASK 0x3ff
#endif
#define PC_(c) ((PMASK >> (c)) & 1)
#define SEAM(k) do { if (IN(k) && IN((k) + 1)) xcd_barrier(bar); } while (0)
    unsigned char* ws = F.ws;
    const int G = F.G, cid = (int)blockIdx.x;

    if (PC_(0) && IN(0)) { p0_prologue(F); } SEAM(0);

#pragma unroll 1
    for (int g = 0; g < NGRP; ++g) {
        const int pb = 1 + 6 * g;
        if (PC_(1) && IN(pb)) {
            { pg8::PlainOrder S; S.init(TG, PC, G, cid); S.A = (const char*)(ws + WS_XG) + (size_t)g * TG * 1024 * 2; S.Bt = (const char*)(ws + WS_WIN); S.a_tile = 256 * 1024 * 2; S.b_tile = 256 * 1024 * 2;
              pg8::EpiBf16 E{(bf16*)(ws + WS_PROJ), PC};
              pg8::gemm_phase<pg8::EpiBf16, pg8::PlainOrder, true, true>(F.lds, pg8::Gemm{1024, 1024, 1024}, S, E); }
            if (g == 0) {
                { pg8::PlainOrder S; S.init(BATCH * NMEM, 512, G, cid); S.A = (const char*)(ws + WS_MN); S.Bt = (const char*)(ws + WS_WKV); S.a_tile = 256 * 1024 * 2; S.b_tile = 256 * 1024 * 2;
                  pg8::EpiBf16 E{(bf16*)(ws + WS_KMEM), 512};
                  pg8::gemm_phase<pg8::EpiBf16, pg8::PlainOrder, true, true>(F.lds, pg8::Gemm{1024, 1024, 1024}, S, E); }
                { pg8::PlainOrder S; S.init(512, BATCH * NMEM, G, cid); S.A = (const char*)(ws + WS_WKV) + (size_t)512 * 1024 * 2; S.Bt = (const char*)(ws + WS_MN); S.a_tile = 256 * 1024 * 2; S.b_tile = 256 * 1024 * 2;
                  pg8::EpiBf16 E{(bf16*)(ws + WS_VT), BATCH * NMEM};
                  pg8::gemm_phase<pg8::EpiBf16, pg8::PlainOrder, true, true>(F.lds, pg8::Gemm{1024, 1024, 1024}, S, E); }
            }
        } SEAM(pb);
        if (PC_(2) && IN(pb + 1)) {
            for (int it = F.vcu * 4; it < BG * 4 * NCHUNK; it += G * 4) { for (int k = 0; k < 4; ++k) hgrn_a_item(F, it + k); }
            for (int it = F.vcu; it < BG * 4 * 8; it += G) attn_item(F, g, it);
            conv_phase(F);
        } SEAM(pb + 1);
        if (PC_(3) && IN(pb + 2)) { hgrn_scan(F); } SEAM(pb + 2);
        if (PC_(4) && IN(pb + 3)) { for (int it = F.vcu * 4; it < BG * 4 * NCHUNK; it += G * 4) { for (int k = 0; k < 4; ++k) hgrn_c_item(F, it + k); } } SEAM(pb + 3);
        if (PC_(5) && IN(pb + 4)) {
            pg8::BranchOrder S; S.init(TG, 1024, G, cid); S.Y = (const char*)(ws + WS_YHG); S.Wb = (const char*)(ws + WS_WBR);
            pg8::EpiBranch E{(const bf16*)(ws + WS_PROJ), (float*)(ws + WS_MACC), (bf16*)(ws + WS_MERGED)};
            pg8::gemm_phase<pg8::EpiBranch, pg8::BranchOrder, true, true>(F.lds, pg8::Gemm{512, 512, 512}, S, E);
        } SEAM(pb + 4);
        if (PC_(6) && IN(pb + 5)) {
            pg8::PlainOrder S; S.init(TG, 1024, G, cid); S.A = (const char*)(ws + WS_MERGED); S.Bt = (const char*)(ws + WS_WOUT); S.a_tile = 256 * 1024 * 2; S.b_tile = 256 * 1024 * 2;
            pg8::EpiOut E{F.x + (size_t)g * TG * 1024, F.out + (size_t)g * TG * 1024, (bf16*)(ws + WS_XG) + (size_t)g * TG * 1024, F.norm_ffn_g, (float*)(ws + WS_SSP) + (size_t)g * TG * 16};
            pg8::gemm_phase<pg8::EpiOut, pg8::PlainOrder, true, true>(F.lds, pg8::Gemm{1024, 1024, 1024}, S, E);
        } SEAM(pb + 5);
    }
#pragma unroll 1
    for (int tg = 0; tg < NGRP; ++tg) {
        const int pb = 13 + 3 * tg;
        if (PC_(7) && IN(pb)) {
            if (tg == 0) convert_uv(F);
            pg8::PlainOrder S; S.init(TG, 2048, G, cid); S.A = (const char*)(ws + WS_XG) + (size_t)tg * TG * 1024 * 2; S.Bt = (const char*)(ws + WS_WQ); S.a_tile = 256 * 1024 * 2; S.b_tile = 256 * 1024 * 2;
            pg8::EpiQ E{(bf16*)(ws + WS_Q), 2048, (const float*)(ws + WS_SSP) + (size_t)tg * TG * 16};
            pg8::gemm_phase<pg8::EpiQ, pg8::PlainOrder, true, true>(F.lds, pg8::Gemm{1024, 1024, 1024}, S, E);
        } SEAM(pb);
        if (PC_(8) && IN(pb + 1)) {
            pg8::ScoreOrder S; S.init(TG, 2048, G, cid); S.Q = (const char*)(ws + WS_Q); S.Kbd = (const char*)(ws + WS_KBD);
            pg8::EpiF32 E{(float*)(ws + WS_S), 2048};
            pg8::gemm_phase<pg8::EpiF32, pg8::ScoreOrder, true, true>(F.lds, pg8::Gemm{2048, 256, 256}, S, E);
        } SEAM(pb + 1);
        if (PC_(9) && IN(pb + 2)) { peer_phase(F, tg); } SEAM(pb + 2);
    }
#undef IN
#undef SEAM
}

extern "C" void kernel_launch(void* const* d_in, const int* in_sizes, int n_in, void* d_out, int out_size, void* d_ws, size_t ws_size, hipStream_t stream) {
    static int ready = 0;
    if (ready == 0) {
        if (n_in != 17 || out_size != T_ALL * D_MODEL || ws_size < WS_END) { fprintf(stderr, "kernel_launch: unexpected shapes (n_in %d, out %d, ws %zu)\n", n_in, out_size, ws_size); ready = -1; return; }
        if (hipFuncSetAttribute((const void*)fwd_kernel, hipFuncAttributeMaxDynamicSharedMemorySize, LDS_BYTES) != hipSuccess) { fprintf(stderr, "kernel_launch: hipFuncSetAttribute failed\n"); ready = -1; return; }
        ready = 1;
    }
    if (ready < 0) return;
    (void)hipMemsetAsync((char*)d_ws + WS_CTL, 0, CTL_ZERO_BYTES, stream);
    Args a{};
    for (int i = 0; i < 17; ++i) a.in[i] = (const float*)d_in[i];
    a.out = (float*)d_out; a.ws = (unsigned char*)d_ws;
    const int grid = 256;
#if MK_N_LAUNCHES == 1
    a.ph_lo = 0; a.ph_hi = N_PHASES;
    hipLaunchKernelGGL(fwd_kernel, dim3(grid), dim3(NWAVES * 64), LDS_BYTES, stream, a);
#else
    for (int li = 0; li < N_PHASES; ++li) { a.ph_lo = li; a.ph_hi = li + 1; hipLaunchKernelGGL(fwd_kernel, dim3(grid), dim3(NWAVES * 64), LDS_BYTES, stream, a); }
#endif
}
```

```cpp
#include <hip/hip_runtime.h>
#include <cstdio>
#include <cstdint>

#ifndef MK_N_LAUNCHES
#define MK_N_LAUNCHES 1
#endif

#define LAS __attribute__((address_space(3)))
#define GAS __attribute__((address_space(1)))
typedef unsigned short bf16;
typedef short bf16x8 __attribute__((ext_vector_type(8)));
typedef short s16x4 __attribute__((ext_vector_type(4)));
typedef short v4i16_t __attribute__((ext_vector_type(4)));
typedef float f32x2 __attribute__((ext_vector_type(2)));
typedef float f32x4 __attribute__((ext_vector_type(4)));
typedef float f32x16 __attribute__((ext_vector_type(16)));
typedef unsigned u32x2 __attribute__((ext_vector_type(2)));
typedef unsigned u32x4 __attribute__((ext_vector_type(4)));
typedef __bf16 bf16x2_t __attribute__((ext_vector_type(2)));
typedef GAS unsigned gu32;
#define RLX_AGENT __ATOMIC_RELAXED, __HIP_MEMORY_SCOPE_AGENT
#define DI __device__ __forceinline__

constexpr int D_MODEL = 1024, BATCH = 16, SEQ = 2048, T_ALL = BATCH * SEQ;
constexpr int NGRP = 2, BG = BATCH / NGRP, TG = BG * SEQ;
constexpr int PC = 7680;
constexpr int C_HQ = 0, C_HI = 512, C_FF = 1024, C_FB = 1536, C_HG = 2048, C_SB = 2560, C_SC = 3072, C_SH = 3584, C_MQ = 4096, C_GATE = 4608;
constexpr int NMEM = 256, CHUNK = 64, NCHUNK = SEQ / CHUNK;
constexpr float EPS = 1e-6f;

constexpr size_t MiB = 1u << 20;
constexpr size_t WS_CTL = 0, CTL_ZERO_BYTES = 1 * MiB;
constexpr size_t WS_LB = 1 * MiB;
constexpr size_t WS_SSP = 2 * MiB;
constexpr size_t WS_DEC = 4 * MiB;
constexpr size_t WS_WIN = 5 * MiB, WS_WKV = 20 * MiB, WS_WBR = 22 * MiB, WS_WOUT = 25 * MiB, WS_WQ = 27 * MiB, WS_KBD = 31 * MiB;
constexpr size_t WS_MN = 32 * MiB, WS_KMEM = 40 * MiB, WS_VT = 44 * MiB;
constexpr size_t WS_XG = 48 * MiB;
constexpr size_t WS_YHG = 112 * MiB, WS_YSC = 128 * MiB, WS_YMX = 144 * MiB;
constexpr size_t WS_DS = 160 * MiB;
constexpr size_t WS_MACC = 160 * MiB;
constexpr size_t WS_MERGED = 224 * MiB;
constexpr size_t WS_PROJ = 256 * MiB;
constexpr size_t WS_U = 112 * MiB, WS_V = 128 * MiB;
constexpr size_t WS_Q = 176 * MiB;
constexpr size_t WS_S = 256 * MiB;
constexpr size_t WS_END = 496 * MiB;
constexpr size_t OUT_SST = 64 * MiB;

constexpr int LDS_BYTES = 160 * 1024;
constexpr int MISC_OFF = LDS_BYTES - 512;
constexpr int NWAVES = 8;

DI unsigned f2bf(float f) { unsigned u = __builtin_bit_cast(unsigned, f); return (u + 0x7fffu + ((u >> 16) & 1u)) >> 16; }
DI unsigned pk2(float lo, float hi) { return f2bf(lo) | (f2bf(hi) << 16); }
DI float bf2f(unsigned short b) { return __builtin_bit_cast(float, (unsigned)b << 16); }
DI float bflo(unsigned w) { return __builtin_bit_cast(float, w << 16); }
DI float bfhi(unsigned w) { return __builtin_bit_cast(float, w & 0xffff0000u); }
DI float wave_sum(float v) {
#pragma unroll
    for (int o = 1; o < 64; o <<= 1) v += __shfl_xor(v, o);
    return v;
}
DI unsigned cvtpk(float lo, float hi) { f32x2 v = {lo, hi}; bf16x2_t b = __builtin_convertvector(v, bf16x2_t); return __builtin_bit_cast(unsigned, b); }
DI float sigmoidf_(float z) { return 1.0f / (1.0f + __expf(-z)); }

namespace pg8 {
constexpr int BM = 256, BK = 64, HALF = 128, HTB = HALF * BK * 2, STAGE_BYTES = 8 * HTB, NXCD = 8, WGM = 8;
__host__ __device__ __forceinline__ int lds_byte(int r, int c) { const int st = (r >> 4) * 2 + (c >> 5), rr = r & 15, cc = c & 31, ob = rr * 64 + cc * 2; return st * 1024 + (ob ^ (((ob >> 9) & 1) << 5)); }
__host__ __device__ __forceinline__ void stage_rc(int b, int& R, int& C) { const int st = b / 1024, sb = b % 1024, swz = sb ^ (((sb >> 9) & 1) << 5); R = (st >> 1) * 16 + swz / 64; C = (st & 1) * 32 + (swz % 64) / 2; }
__host__ __device__ __forceinline__ int perm32(int rho) { const int n = rho >> 4, i = rho & 15; return 8 * (i >> 2) + 4 * n + (i & 3); }

struct Unit { int pm, pn, z; };
struct Gemm { int lda, ldb, K; };

struct StaticOrder {
    int nM, nN, nwg, G, c;
    __device__ void init(int M, int N, int G_, int c_) { nM = M / BM; nN = N / BM; nwg = nM * nN; G = G_; c = c_; }
    __device__ bool tile(int i, Unit& u) const {
        const long L = (long)i * G + c; if (L >= nwg) return false;
        int wgid = (int)L; { const int q = nwg / NXCD, r = nwg % NXCD, xcd = wgid % NXCD, off = wgid / NXCD; wgid = (xcd < r ? xcd * (q + 1) : r * (q + 1) + (xcd - r) * q) + off; }
        const int nig = WGM * nN, gid = wgid / nig, fm = gid * WGM, gsz = (nM - fm) < WGM ? (nM - fm) : WGM;
        u.pm = fm + ((wgid % nig) % gsz); u.pn = (wgid % nig) / gsz; u.z = 0; return true;
    }
};

DI unsigned cvt_pk_bf16(float lo, float hi) { return cvtpk(lo, hi); }

template <class Epi, class Sched, bool ALIGN_EPI, bool SP2>
DI void gemm_phase(LAS unsigned char* lds, const Gemm g, const Sched& S, const Epi& E) {
    int tid_ = threadIdx.x; asm volatile("" : "+v"(tid_));
    const int tid = tid_, wid = __builtin_amdgcn_readfirstlane(tid >> 6), lane = tid & 63, wr = wid >> 2, wc = wid & 3, fr = lane & 15, fq = lane >> 4;
    int K_ = g.K; asm volatile("" : "+s"(K_));
    const int K = K_, nt = K / BK;
    unsigned voffA[2], voffB[2];
#pragma unroll
    for (int i = 0; i < 2; ++i) { int R, C; stage_rc(tid * 16 + i * 8192, R, C); const int Rb = Epi::PERM ? ((R & ~31) + perm32(R & 31)) : R;
        voffA[i] = (unsigned)(R * g.lda + C) * 2u; voffB[i] = (unsigned)(Rb * g.ldb + C) * 2u; }
    const size_t kstep = (size_t)(BK * 2);
    const size_t hA = (size_t)HALF * g.lda * 2, hB = (size_t)HALF * g.ldb * 2;
    const unsigned ldsw = (unsigned)wid * 1024u;
    const int aoff = lds_byte(wr * 64 + fr, fq * 8), boff = lds_byte(wc * 32 + fr, fq * 8);
#define PG8_SA(b, h) (((b) * 2 + (h)) * HTB)
#define PG8_SB(b, h) ((4 + (b) * 2 + (h)) * HTB)
#define PG8_STAGE(bufoff, gbase, voff) do { _Pragma("unroll") for (int _i = 0; _i < 2; ++_i) \
        __builtin_amdgcn_global_load_lds((const unsigned*)((const char*)(gbase) + (voff)[_i]), (LAS unsigned*)(lds + (bufoff) + ldsw + _i * 8192), 16, 0, 0); } while (0)
#define PG8_LDA(dst, b, h) do { _Pragma("unroll") for (int m = 0; m < 4; ++m) _Pragma("unroll") for (int k = 0; k < 2; ++k) dst[m][k] = *(const LAS bf16x8*)(lds + PG8_SA(b, h) + aoff + m * 2048 + k * 1024); } while (0)
#define PG8_LDB(dst, b, h) do { _Pragma("unroll") for (int n = 0; n < 2; ++n) _Pragma("unroll") for (int k = 0; k < 2; ++k) dst[n][k] = *(const LAS bf16x8*)(lds + PG8_SB(b, h) + boff + n * 2048 + k * 1024); } while (0)
#define PG8_MMA(ai, bj, At, Bt) do { __builtin_amdgcn_s_setprio(1); _Pragma("unroll") for (int m = 0; m < 4; ++m) _Pragma("unroll") for (int n = 0; n < 2; ++n) _Pragma("unroll") for (int k = 0; k < 2; ++k) \
        acc[ai][bj][m][n] = __builtin_amdgcn_mfma_f32_16x16x32_bf16(Bt[n][k], At[m][k], acc[ai][bj][m][n], 0, 0, 0); __builtin_amdgcn_s_setprio(0); } while (0)
#define PG8_WAIT_V(n) asm volatile("s_waitcnt vmcnt(" #n ")" ::: "memory")
#define PG8_WAIT_L(n) asm volatile("s_waitcnt lgkmcnt(" #n ")" ::: "memory")
#define PG8_BAR __builtin_amdgcn_s_barrier()
#define PG8_SCHED __builtin_amdgcn_sched_barrier(0)
    Unit cur, nxt; int ui = 0;
    if (!S.next(0, cur)) return;
    f32x4 acc[2][2][4][2];
#pragma unroll
    for (int a = 0; a < 2; ++a)
#pragma unroll
        for (int b = 0; b < 2; ++b)
#pragma unroll
            for (int m = 0; m < 4; ++m)
#pragma unroll
                for (int n = 0; n < 2; ++n) acc[a][b][m][n] = (f32x4){0.f, 0.f, 0.f, 0.f};
    bf16x8 At[4][2], B0[2][2], B1[2][2];
    const char* cA = S.a_base(cur); const char* cB = S.b_base(cur);
    if constexpr (SP2) {
        PG8_STAGE(PG8_SB(0, 0), cB, voffB); PG8_STAGE(PG8_SB(0, 1), cB + hB, voffB); PG8_STAGE(PG8_SA(0, 0), cA, voffA); PG8_STAGE(PG8_SA(0, 1), cA + hA, voffA);
        if (wr == 1) PG8_BAR;
        PG8_WAIT_V(2); PG8_BAR;
        PG8_STAGE(PG8_SB(1, 0), cB + kstep, voffB); PG8_STAGE(PG8_SA(1, 0), cA + kstep, voffA); PG8_STAGE(PG8_SB(1, 1), cB + hB + kstep, voffB);
        PG8_WAIT_V(6); PG8_BAR;
    } else {
        PG8_STAGE(PG8_SB(0, 0), cB, voffB); PG8_STAGE(PG8_SA(0, 0), cA, voffA); PG8_STAGE(PG8_SB(0, 1), cB + hB, voffB); PG8_STAGE(PG8_SA(0, 1), cA + hA, voffA);
        if (wr == 1) PG8_BAR;
        PG8_WAIT_V(4); PG8_BAR;
        PG8_STAGE(PG8_SB(1, 0), cB + kstep, voffB); PG8_STAGE(PG8_SA(1, 0), cA + kstep, voffA); PG8_STAGE(PG8_SB(1, 1), cB + hB + kstep, voffB);
        PG8_WAIT_V(6); PG8_BAR;
    }
    for (;;) {
        const bool has_next = S.next(ui + 1, nxt);
        const char* nA = has_next ? S.a_base(nxt) : cA; const char* nB = has_next ? S.b_base(nxt) : cB;
        for (int t = 0; t < nt; t += 2) {
            const bool last = (t == nt - 2);
            const char* a1 = cA + (size_t)(t + 1) * kstep;
            const char* a2 = last ? nA : cA + (size_t)(t + 2) * kstep; const char* b2 = last ? nB : cB + (size_t)(t + 2) * kstep;
            const char* a3 = a2 + kstep; const char* b3 = b2 + kstep;
            if constexpr (SP2) {
            PG8_LDB(B0, 0, 0); PG8_LDB(B1, 0, 1); PG8_SCHED; PG8_LDA(At, 0, 0); PG8_STAGE(PG8_SA(1, 1), a1 + hA, voffA);
            PG8_WAIT_V(8); PG8_WAIT_L(0); PG8_BAR; PG8_MMA(0, 0, At, B0); PG8_MMA(0, 1, At, B1); PG8_BAR; PG8_SCHED;
            PG8_LDA(At, 0, 1); PG8_STAGE(PG8_SB(0, 0), b2, voffB); PG8_STAGE(PG8_SB(0, 1), b2 + hB, voffB); PG8_STAGE(PG8_SA(0, 0), a2, voffA);
            PG8_WAIT_V(8); PG8_WAIT_L(0); PG8_BAR; PG8_MMA(1, 0, At, B0); PG8_MMA(1, 1, At, B1); PG8_BAR; PG8_SCHED;
            PG8_LDB(B0, 1, 0); PG8_LDB(B1, 1, 1); PG8_SCHED; PG8_LDA(At, 1, 0); PG8_STAGE(PG8_SA(0, 1), a2 + hA, voffA);
            PG8_WAIT_V(8); PG8_WAIT_L(0); PG8_BAR; PG8_MMA(0, 0, At, B0); PG8_MMA(0, 1, At, B1); PG8_BAR; PG8_SCHED;
            PG8_LDA(At, 1, 1); PG8_STAGE(PG8_SB(1, 0), b3, voffB); PG8_STAGE(PG8_SB(1, 1), b3 + hB, voffB); PG8_STAGE(PG8_SA(1, 0), a3, voffA);
            PG8_WAIT_V(8); PG8_WAIT_L(0); PG8_BAR; PG8_MMA(1, 0, At, B0); PG8_MMA(1, 1, At, B1); PG8_BAR; PG8_SCHED;
            } else {
            PG8_LDB(B0, 0, 0); PG8_SCHED; PG8_LDA(At, 0, 0); PG8_STAGE(PG8_SA(1, 1), a1 + hA, voffA);
            PG8_WAIT_L(8); PG8_BAR; PG8_WAIT_L(0); PG8_MMA(0, 0, At, B0); PG8_BAR; PG8_SCHED;
            PG8_LDB(B1, 0, 1); PG8_STAGE(PG8_SB(0, 0), b2, voffB);
            PG8_BAR; PG8_WAIT_L(0); PG8_MMA(0, 1, At, B1); PG8_BAR;
            PG8_LDA(At, 0, 1); PG8_STAGE(PG8_SA(0, 0), a2, voffA);
            PG8_BAR; PG8_WAIT_L(0); PG8_MMA(1, 0, At, B0); PG8_BAR; PG8_SCHED;
            PG8_STAGE(PG8_SB(0, 1), b2 + hB, voffB);
            PG8_WAIT_V(6); PG8_BAR; PG8_MMA(1, 1, At, B1); PG8_BAR;
            PG8_LDB(B0, 1, 0); PG8_SCHED; PG8_LDA(At, 1, 0); PG8_STAGE(PG8_SA(0, 1), a2 + hA, voffA);
            PG8_WAIT_L(8); PG8_BAR; PG8_WAIT_L(0); PG8_MMA(0, 0, At, B0); PG8_BAR; PG8_SCHED;
            PG8_LDB(B1, 1, 1); PG8_STAGE(PG8_SB(1, 0), b3, voffB);
            PG8_BAR; PG8_WAIT_L(0); PG8_MMA(0, 1, At, B1); PG8_BAR;
            PG8_LDA(At, 1, 1); PG8_STAGE(PG8_SA(1, 0), a3, voffA);
            PG8_BAR; PG8_WAIT_L(0); PG8_MMA(1, 0, At, B0); PG8_BAR; PG8_SCHED;
            PG8_STAGE(PG8_SB(1, 1), b3 + hB, voffB);
            PG8_WAIT_V(6); PG8_BAR; PG8_MMA(1, 1, At, B1); PG8_BAR;
            }
        }
        if constexpr (ALIGN_EPI) { if (wr == 0) PG8_BAR; }
        E(acc, cur, wr, wc, fr, fq);
        if (!has_next) break;
#pragma unroll
        for (int a = 0; a < 2; ++a)
#pragma unroll
            for (int b = 0; b < 2; ++b)
#pragma unroll
                for (int m = 0; m < 4; ++m)
#pragma unroll
                    for (int n = 0; n < 2; ++n) acc[a][b][m][n] = (f32x4){0.f, 0.f, 0.f, 0.f};
        cur = nxt; cA = nA; cB = nB; ++ui;
        if constexpr (ALIGN_EPI) { if (wr == 1) PG8_BAR; }
    }
    PG8_WAIT_V(0);
    if constexpr (!ALIGN_EPI) { if (wr == 0) PG8_BAR; }
    PG8_BAR;
#undef PG8_SA
#undef PG8_SB
#undef PG8_STAGE
#undef PG8_LDA
#undef PG8_LDB
#undef PG8_MMA
#undef PG8_WAIT_V
#undef PG8_WAIT_L
#undef PG8_BAR
#undef PG8_SCHED
}
}

namespace pg8 {
struct PlainOrder : StaticOrder {
    const char* A; const char* Bt; size_t a_tile, b_tile;
    __device__ bool next(int i, Unit& u) const { return tile(i, u); }
    DI const char* a_base(const Unit& u) const { return A + (size_t)u.pm * a_tile; }
    DI const char* b_base(const Unit& u) const { return Bt + (size_t)u.pn * b_tile; }
};
struct BranchOrder : StaticOrder {
    const char* Y; const char* Wb;
    __device__ bool next(int i, Unit& u) const { if (!tile(i / 3, u)) return false; u.z = i % 3; return true; }
    DI const char* a_base(const Unit& u) const { return Y + (size_t)u.z * (16 * MiB) + (size_t)u.pm * (256 * 512 * 2); }
    DI const char* b_base(const Unit& u) const { return Wb + (size_t)u.z * (1024 * 512 * 2) + (size_t)u.pn * (256 * 512 * 2); }
};
struct ScoreOrder : StaticOrder {
    const char* Q; const char* Kbd;
    __device__ bool next(int i, Unit& u) const { return tile(i, u); }
    DI const char* a_base(const Unit& u) const { return Q + (size_t)u.pm * (256 * 2048 * 2) + (size_t)u.pn * 512; }
    DI const char* b_base(const Unit& u) const { return Kbd + (size_t)u.pn * (256 * 256 * 2); }
};

struct EpiBf16 {
    static constexpr bool PERM = true;
    bf16* O; int ldc;
    DI void operator()(const f32x4 (&acc)[2][2][4][2], const Unit& u, int wr, int wc, int fr, int fq) const {
        const int row0 = u.pm * BM + wr * 64 + fr, col0 = u.pn * BM + wc * 32 + 8 * fq;
#pragma unroll
        for (int ai = 0; ai < 2; ++ai)
#pragma unroll
            for (int m = 0; m < 4; ++m) { bf16* rowp = O + (size_t)(row0 + ai * HALF + m * 16) * ldc + col0;
#pragma unroll
                for (int bj = 0; bj < 2; ++bj) { const f32x4 v0 = acc[ai][bj][m][0], v1 = acc[ai][bj][m][1];
                    u32x4 w; w.x = cvt_pk_bf16(v0[0], v0[1]); w.y = cvt_pk_bf16(v0[2], v0[3]); w.z = cvt_pk_bf16(v1[0], v1[1]); w.w = cvt_pk_bf16(v1[2], v1[3]);
                    *(u32x4*)(rowp + bj * HALF) = w; } }
    }
};
struct EpiQ {
    static constexpr bool PERM = true;
    bf16* O; int ldc; const float* ssp;
    DI void operator()(const f32x4 (&acc)[2][2][4][2], const Unit& u, int wr, int wc, int fr, int fq) const {
        const int row0 = u.pm * BM + wr * 64 + fr, col0 = u.pn * BM + wc * 32 + 8 * fq;
#pragma unroll
        for (int ai = 0; ai < 2; ++ai)
#pragma unroll
            for (int m = 0; m < 4; ++m) { const int row = row0 + ai * HALF + m * 16; const f32x4* sp = (const f32x4*)(ssp + (size_t)row * 16);
                const f32x4 s0 = sp[0], s1 = sp[1], s2 = sp[2], s3 = sp[3];
                const float ss = ((s0[0] + s0[1]) + (s0[2] + s0[3])) + ((s1[0] + s1[1]) + (s1[2] + s1[3])) + ((s2[0] + s2[1]) + (s2[2] + s2[3])) + ((s3[0] + s3[1]) + (s3[2] + s3[3]));
                const float rs = 1.0f / sqrtf(ss * (1.0f / 1024.0f) + EPS);
                bf16* rowp = O + (size_t)row * ldc + col0;
#pragma unroll
                for (int bj = 0; bj < 2; ++bj) { const f32x4 v0 = acc[ai][bj][m][0] * rs, v1 = acc[ai][bj][m][1] * rs;
                    u32x4 w; w.x = cvt_pk_bf16(v0[0], v0[1]); w.y = cvt_pk_bf16(v0[2], v0[3]); w.z = cvt_pk_bf16(v1[0], v1[1]); w.w = cvt_pk_bf16(v1[2], v1[3]);
                    *(u32x4*)(rowp + bj * HALF) = w; }
                asm volatile("" ::: "memory"); }
    }
};
struct EpiF32 {
    static constexpr bool PERM = false;
    float* C; int ldc;
    DI void operator()(const f32x4 (&acc)[2][2][4][2], const Unit& u, int wr, int wc, int fr, int fq) const {
        const int row0 = u.pm * BM + wr * 64 + fr, col0 = u.pn * BM + wc * 32 + 4 * fq;
#pragma unroll
        for (int ai = 0; ai < 2; ++ai)
#pragma unroll
            for (int m = 0; m < 4; ++m) { float* rowp = C + (size_t)(row0 + ai * HALF + m * 16) * ldc + col0;
#pragma unroll
                for (int bj = 0; bj < 2; ++bj)
#pragma unroll
                    for (int n = 0; n < 2; ++n) *(f32x4*)(rowp + bj * HALF + n * 16) = acc[ai][bj][m][n]; }
    }
};
struct EpiBranch {
    static constexpr bool PERM = true;
    const bf16* proj; float* macc; bf16* merged;
    DI void operator()(const f32x4 (&acc)[2][2][4][2], const Unit& u, int wr, int wc, int fr, int fq) const {
        const int row0 = u.pm * BM + wr * 64 + fr, col0 = u.pn * BM + wc * 32 + 8 * fq;
#pragma unroll
        for (int ai = 0; ai < 2; ++ai)
#pragma unroll
            for (int m = 0; m < 4; ++m) { const int row = row0 + ai * HALF + m * 16;
#pragma unroll
                for (int bj = 0; bj < 2; ++bj) { const int col = col0 + bj * HALF;
                    const u32x4 gw = *(const u32x4*)(proj + (size_t)row * PC + C_GATE + u.z * 1024 + col);
                    f32x4 v0 = acc[ai][bj][m][0], v1 = acc[ai][bj][m][1];
                    v0[0] *= sigmoidf_(bflo(gw.x)); v0[1] *= sigmoidf_(bfhi(gw.x)); v0[2] *= sigmoidf_(bflo(gw.y)); v0[3] *= sigmoidf_(bfhi(gw.y));
                    v1[0] *= sigmoidf_(bflo(gw.z)); v1[1] *= sigmoidf_(bfhi(gw.z)); v1[2] *= sigmoidf_(bflo(gw.w)); v1[3] *= sigmoidf_(bfhi(gw.w));
                    float* mp = macc + (size_t)row * 1024 + col;
                    if (u.z > 0) { v0 += *(const f32x4*)mp; v1 += *(const f32x4*)(mp + 4); }
                    if (u.z < 2) { *(f32x4*)mp = v0; *(f32x4*)(mp + 4) = v1; }
                    else { u32x4 w; w.x = cvt_pk_bf16(v0[0], v0[1]); w.y = cvt_pk_bf16(v0[2], v0[3]); w.z = cvt_pk_bf16(v1[0], v1[1]); w.w = cvt_pk_bf16(v1[2], v1[3]);
                        *(u32x4*)(merged + (size_t)row * 1024 + col) = w; } }
                asm volatile("" ::: "memory"); }
    }
};
struct EpiOut {
    static constexpr bool PERM = true;
    const float* x; float* x1; bf16* xg; const float* gffn; float* ssp;
    DI void operator()(const f32x4 (&acc)[2][2][4][2], const Unit& u, int wr, int wc, int fr, int fq) const {
        const int row0 = u.pm * BM + wr * 64 + fr, col0 = u.pn * BM + wc * 32 + 8 * fq;
        f32x4 g0[2], g1[2];
#pragma unroll
        for (int bj = 0; bj < 2; ++bj) { g0[bj] = *(const f32x4*)(gffn + col0 + bj * HALF); g1[bj] = *(const f32x4*)(gffn + col0 + bj * HALF + 4); }
#pragma unroll
        for (int ai = 0; ai < 2; ++ai)
#pragma unroll
            for (int m = 0; m < 4; ++m) { const int row = row0 + ai * HALF + m * 16; float ss = 0.f;
#pragma unroll
                for (int bj = 0; bj < 2; ++bj) { const size_t off = (size_t)row * 1024 + col0 + bj * HALF;
                    const f32x4 v0 = acc[ai][bj][m][0] + *(const f32x4*)(x + off), v1 = acc[ai][bj][m][1] + *(const f32x4*)(x + off + 4);
                    *(f32x4*)(x1 + off) = v0; *(f32x4*)(x1 + off + 4) = v1;
                    ss += (v0[0] * v0[0] + v0[1] * v0[1]) + (v0[2] * v0[2] + v0[3] * v0[3]) + (v1[0] * v1[0] + v1[1] * v1[1]) + (v1[2] * v1[2] + v1[3] * v1[3]);
                    const f32x4 a = v0 * g0[bj], b = v1 * g1[bj];
                    u32x4 w; w.x = cvt_pk_bf16(a[0], a[1]); w.y = cvt_pk_bf16(a[2], a[3]); w.z = cvt_pk_bf16(b[0], b[1]); w.w = cvt_pk_bf16(b[2], b[3]);
                    *(u32x4*)(xg + off) = w; }
                ss += __shfl_xor(ss, 16); ss += __shfl_xor(ss, 32);
                if (fq == 0) ssp[(size_t)row * 16 + u.pn * 4 + wc] = ss;
                asm volatile("" ::: "memory"); }
    }
};
}

#define XB_TMO      128
#define XB_XCNT(j)  (256  + 64 * (j))
#define XB_XSUB(j)  (1280 + 64 * (j))
#define XB_XGEN(j)  (2304 + 64 * (j))
#define XB_TOP      3328
#define XB_TOPGEN   3392
#define XCD_BAR_WORDS 3456
#define XB_SPIN_CAP (1u << 18)
constexpr int CW_BAR = 4096;

DI unsigned xb_ld(unsigned* p)              { return __hip_atomic_load(p, __ATOMIC_RELAXED, __HIP_MEMORY_SCOPE_AGENT); }
DI unsigned xb_add(unsigned* p, unsigned v) { return __hip_atomic_fetch_add(p, v, __ATOMIC_RELAXED, __HIP_MEMORY_SCOPE_AGENT); }
DI unsigned xb_xcc_id() { return (unsigned)__builtin_amdgcn_s_getreg((3 << 11) | 20) & 0xFu; }
#define XB_SPIN(cond, bar) do { unsigned _sp = 0; while (cond) { __builtin_amdgcn_s_sleep(1); \
    if ((++_sp & 255u) == 0u) { if (xb_ld(&(bar)[XB_TMO])) break; if (_sp > XB_SPIN_CAP) { atomicAdd(&(bar)[XB_TMO], 1u); break; } } } } while (0)

struct XcdBarrier { unsigned* bar; unsigned x; volatile LAS unsigned* st; };

DI XcdBarrier xcd_barrier_post(unsigned* bar, volatile LAS unsigned* st) {
    XcdBarrier b; b.bar = bar; b.x = xb_xcc_id(); b.st = st;
    if (threadIdx.x == 0) (void)xb_add(&bar[XB_XCNT(b.x)], 1u);
    return b;
}
DI void xcd_barrier_complete(unsigned* bar, unsigned x, unsigned& nloc, unsigned& nx) {
    const unsigned G = gridDim.x * gridDim.y * gridDim.z;
    unsigned sum, cnt, mine, sp = 0u;
    for (;;) {
        sum = 0u; cnt = 0u; mine = 0u;
#pragma unroll
        for (unsigned j = 0; j < 16; ++j) { const unsigned c = xb_ld(&bar[XB_XCNT(j)]); sum += c; cnt += (c > 0u) ? 1u : 0u; mine = (j == x) ? c : mine; }
        if (sum == G) break;
        __builtin_amdgcn_s_sleep(1);
        if ((++sp & 255u) == 0u) { if (xb_ld(&bar[XB_TMO])) break; if (sp > XB_SPIN_CAP) { atomicAdd(&bar[XB_TMO], 1u); break; } }
    }
    nloc = mine > 0u ? mine : 1u; nx = cnt > 0u ? cnt : 1u;
}
DI void xcd_barrier(const XcdBarrier& b) {
    asm volatile("s_waitcnt vmcnt(0)" ::: "memory");
    __syncthreads();
    if (threadIdx.x == 0) {
        unsigned* bar = b.bar;
        __builtin_amdgcn_s_waitcnt(0);
        unsigned nloc = b.st[0], nx = b.st[1];
        if (nloc == 0u) { xcd_barrier_complete(bar, b.x, nloc, nx); b.st[0] = nloc; b.st[1] = nx; }
        const unsigned old = xb_add(&bar[XB_XSUB(b.x)], 1u);
        const unsigned gen = old / nloc;
        if (old + 1u == (gen + 1u) * nloc) {
            __builtin_amdgcn_fence(__ATOMIC_RELEASE, "agent");
            asm volatile("s_waitcnt vmcnt(0)" ::: "memory");
            const unsigned og = xb_add(&bar[XB_TOP], 1u);
            const unsigned tg = og / nx;
            if (og + 1u == (tg + 1u) * nx) xb_add(&bar[XB_TOPGEN], 1u);
            else XB_SPIN(xb_ld(&bar[XB_TOPGEN]) == tg, bar);
            __builtin_amdgcn_fence(__ATOMIC_ACQUIRE, "agent");
            xb_add(&bar[XB_XGEN(b.x)], 1u);
            asm volatile("s_waitcnt vmcnt(0)" ::: "memory");
        } else {
            XB_SPIN(xb_ld(&bar[XB_XGEN(b.x)]) == gen, bar);
            __builtin_amdgcn_fence(__ATOMIC_ACQUIRE, "agent");
            asm volatile("s_waitcnt vmcnt(0)" ::: "memory");
        }
    }
    __syncthreads();
}

struct Frame {
    LAS unsigned char* lds;
    int tid, lane, wave;
    DI void refresh() { int t = threadIdx.x; asm volatile("" : "+v"(t)); tid = t; lane = t & 63; wave = __builtin_amdgcn_readfirstlane(t >> 6); }
    int vcu, G;
    const float *x, *mem, *norm_mix_g, *w_in, *hg_lb, *hg_norm_g, *sc_conv_w, *mem_norm_g, *w_mem_kv, *w_branch, *w_out, *norm_ffn_g, *peer_w_q, *peer_sub_keys, *peer_u, *peer_v, *final_norm_g;
    float* out; unsigned char* ws;
};

DI void p0_transpose_item(const float* W, int K, int N, bf16* WT, LAS float* scr, int item, int lane) {
    const int nblk = N / 32, kb = item / nblk, nb = item % nblk, k0 = 64 * kb, n0 = 32 * nb;
#pragma unroll 8
    for (int i = 0; i < 32; ++i) { const int kk = 2 * i + (lane >> 5); scr[kk * 33 + (lane & 31)] = W[(size_t)(k0 + kk) * N + n0 + (lane & 31)]; }
    asm volatile("s_waitcnt lgkmcnt(0)" ::: "memory");
    const int c = lane & 7;
#pragma unroll
    for (int j = 0; j < 4; ++j) { const int n = (lane >> 3) + 8 * j; const LAS float* s = scr + (8 * c) * 33 + n;
        u32x4 o; o.x = pk2(s[0 * 33], s[1 * 33]); o.y = pk2(s[2 * 33], s[3 * 33]); o.z = pk2(s[4 * 33], s[5 * 33]); o.w = pk2(s[6 * 33], s[7 * 33]);
        *(u32x4*)(WT + (size_t)(n0 + n) * K + k0 + 8 * c) = o; }
    asm volatile("s_waitcnt lgkmcnt(0)" ::: "memory");
}
DI void rms_row_to_bf16(const float* xrow, const float* g, bf16* orow, int lane) {
    const f32x4* xr = (const f32x4*)xrow + lane; const f32x4* gr = (const f32x4*)g + lane;
    f32x4 v[4]; float s = 0.f;
#pragma unroll
    for (int j = 0; j < 4; ++j) { v[j] = xr[64 * j]; s += (v[j].x * v[j].x + v[j].y * v[j].y) + (v[j].z * v[j].z + v[j].w * v[j].w); }
    const float rstd = 1.0f / sqrtf(wave_sum(s) * (1.f / 1024.f) + EPS);
    unsigned long long* o8 = (unsigned long long*)orow + lane;
#pragma unroll
    for (int j = 0; j < 4; ++j) { const f32x4 gg = gr[64 * j]; const f32x4 y = v[j] * rstd * gg;
        o8[64 * j] = (unsigned long long)pk2(y.x, y.y) | ((unsigned long long)pk2(y.z, y.w) << 32); }
}
DI void p0_prologue(Frame& F) {
    F.refresh();
    LAS float* scr = (LAS float*)(F.lds + F.wave * 16384);
    const int gw = F.vcu * NWAVES + F.wave, NGW = F.G * NWAVES;
    unsigned char* ws = F.ws;
    constexpr int I_IN = (1024 / 64) * (PC / 32), I_KV = (1024 / 64) * (1024 / 32), I_BR = (512 / 64) * (1024 / 32), I_OUT = (1024 / 64) * (1024 / 32), I_Q = (1024 / 64) * (2048 / 32);
    constexpr int NITEMS = I_IN + I_KV + 3 * I_BR + I_OUT + I_Q;
    for (int it = gw; it < NITEMS; it += NGW) {
        int r = it;
        if (r < I_IN) { p0_transpose_item(F.w_in, 1024, PC, (bf16*)(ws + WS_WIN), scr, r, F.lane); continue; } r -= I_IN;
        if (r < I_KV) { p0_transpose_item(F.w_mem_kv, 1024, 1024, (bf16*)(ws + WS_WKV), scr, r, F.lane); continue; } r -= I_KV;
        if (r < 3 * I_BR) { const int n = r / I_BR; p0_transpose_item(F.w_branch + (size_t)n * 512 * 1024, 512, 1024, (bf16*)(ws + WS_WBR) + (size_t)n * 1024 * 512, scr, r % I_BR, F.lane); continue; } r -= 3 * I_BR;
        if (r < I_OUT) { p0_transpose_item(F.w_out, 1024, 1024, (bf16*)(ws + WS_WOUT), scr, r, F.lane); continue; } r -= I_OUT;
        p0_transpose_item(F.peer_w_q, 1024, 2048, (bf16*)(ws + WS_WQ), scr, r, F.lane);
    }
    const int gt = F.vcu * 512 + F.tid, NGT = F.G * 512;
    for (int it = gt; it < 8 * 256 * 32; it += NGT) {
        const int c8 = it & 31, row = (it >> 5) & 255, h = it >> 13, p = row >> 7, key = row & 127;
        u32x4 o = (u32x4){0u, 0u, 0u, 0u};
        if ((c8 >> 4) == p) { const float* s = F.peer_sub_keys + (((size_t)(h * 2 + p) * 128 + key) * 128 + (c8 & 15) * 8);
            const f32x4 a = *(const f32x4*)s, b = *(const f32x4*)(s + 4); o.x = pk2(a.x, a.y); o.y = pk2(a.z, a.w); o.z = pk2(b.x, b.y); o.w = pk2(b.z, b.w); }
        *(u32x4*)((bf16*)(ws + WS_KBD) + ((size_t)(h * 256 + row) * 256 + c8 * 8)) = o;
    }
    for (int it = gt; it < 1024; it += NGT) { const float a0 = F.hg_lb[it], a1 = F.hg_lb[1024 + it]; const float m = fmaxf(a0, a1); const float e0 = __expf(a0 - m), e1 = __expf(a1 - m);
        ((float*)(ws + WS_LB))[it] = e0 / (e0 + e1); }
    for (int m = gw; m < BATCH * NMEM; m += NGW) rms_row_to_bf16(F.mem + (size_t)m * 1024, F.mem_norm_g, (bf16*)(ws + WS_MN) + (size_t)m * 1024, F.lane);
    for (int m = gw; m < T_ALL; m += NGW) rms_row_to_bf16(F.x + (size_t)m * 1024, F.norm_mix_g, (bf16*)(ws + WS_XG) + (size_t)m * 1024, F.lane);
}

DI s16x4 tr16(const LAS unsigned char* p) { return __builtin_bit_cast(s16x4, __builtin_amdgcn_ds_read_tr16_b64_v4i16((LAS v4i16_t*)p)); }
DI bf16x8 cat8(s16x4 lo, s16x4 hi) { return __builtin_shufflevector(lo, hi, 0, 1, 2, 3, 4, 5, 6, 7); }
#define MFMA32(a, b, c) __builtin_amdgcn_mfma_f32_32x32x16_bf16((a), (b), (c), 0, 0, 0)
DI int crow(int reg, int h) { return (reg & 3) + 8 * (reg >> 2) + 4 * h; }
DI bf16x8 pack8(const f32x16& x, int s) {
    u32x4 p; p.x = cvtpk(x[8 * s], x[8 * s + 1]); p.y = cvtpk(x[8 * s + 2], x[8 * s + 3]); p.z = cvtpk(x[8 * s + 4], x[8 * s + 5]); p.w = cvtpk(x[8 * s + 6], x[8 * s + 7]);
    return __builtin_bit_cast(bf16x8, p);
}
constexpr int TS = 272;

DI void gate16(const bf16* zc, float lb, float (&L)[16], float (&kk)[16], float (&lf)[16]) {
    float run = 0.f; const float oml = 1.0f - lb;
#pragma unroll
    for (int i = 0; i < 16; ++i) { const float z = bf2f(zc[(size_t)i * PC]); const float sg = sigmoidf_(z); const float f = lb + oml * sg;
        lf[i] = __logf(f); kk[i] = oml * (1.0f - sg); run += lf[i]; L[i] = run; }
}

DI void hgrn_a_item(Frame& F, int item) {
    F.refresh();
    constexpr int T_V = 0, T_KF = 17408, T_KB = 34816, TOT = 52224;
    LAS unsigned char* lds = F.lds;
    const int n = item & 31, h = (item >> 5) & 3, b = item >> 7;
    const bf16* proj = (const bf16*)(F.ws + WS_PROJ) + ((size_t)b * SEQ + n * CHUNK) * PC;
    const int tid = F.tid, d = tid & 127, tq = tid >> 7;
    const float* lbp = (const float*)(F.ws + WS_LB);
    const float lbf = lbp[h * 128 + d], lbb = lbp[512 + h * 128 + d];
#pragma unroll
    for (int i = 0; i < 2; ++i) { const int id = tid + 512 * i, c = id >> 4, ch = id & 15;
        *(LAS u32x4*)(lds + T_V + c * TS + ch * 16) = *(const u32x4*)(proj + (size_t)c * PC + C_HI + h * 128 + ch * 8); }
    float Lf[16], kf[16], lff[16], Lb[16], kb[16], lfb[16];
    gate16(proj + (size_t)(16 * tq) * PC + C_FF + h * 128 + d, lbf, Lf, kf, lff);
    gate16(proj + (size_t)(16 * tq) * PC + C_FB + h * 128 + d, lbb, Lb, kb, lfb);
    LAS float* tot = (LAS float*)(lds + TOT);
    tot[(0 * 4 + tq) * 128 + d] = Lf[15]; tot[(1 * 4 + tq) * 128 + d] = Lb[15];
    __syncthreads();
    const float tf0 = tot[0 * 128 + d], tf1 = tot[1 * 128 + d], tf2 = tot[2 * 128 + d], tf3 = tot[3 * 128 + d];
    const float tb0 = tot[4 * 128 + d], tb1 = tot[5 * 128 + d], tb2 = tot[6 * 128 + d], tb3 = tot[7 * 128 + d];
    const float offf = (tq > 0 ? tf0 : 0.f) + (tq > 1 ? tf1 : 0.f) + (tq > 2 ? tf2 : 0.f), glf = (tf0 + tf1) + (tf2 + tf3);
    const float offb = (tq < 1 ? tb1 : 0.f) + (tq < 2 ? tb2 : 0.f) + (tq < 3 ? tb3 : 0.f), glb = (tb0 + tb1) + (tb2 + tb3);
    const float tbq = Lb[15];
#pragma unroll
    for (int i = 0; i < 16; ++i) { const int c = 16 * tq + i;
        const float G = offf + Lf[i]; const float kd = kf[i] * __expf(glf - G);
        const float Gb = offb + (tbq - Lb[i] + lfb[i]); const float kdb = kb[i] * __expf(glb - Gb);
        ((LAS bf16*)(lds + T_KF + c * TS))[d] = (bf16)f2bf(kd); ((LAS bf16*)(lds + T_KB + c * TS))[d] = (bf16)f2bf(kdb); }
    if (tq == 0) { float* dec = (float*)(F.ws + WS_DEC) + (size_t)item * 256; dec[d] = __expf(glf); dec[128 + d] = __expf(glb); }
    __syncthreads();
    const int w = F.wave, lane = F.lane, r = lane & 31, hh = lane >> 5, blk = (lane >> 4) & 1, q = (lane & 15) >> 2, p = lane & 3;
    const int dt = w >> 1, et0 = (w & 1) * 2;
#pragma unroll
    for (int dir = 0; dir < 2; ++dir) { const int TK = dir ? T_KB : T_KF;
#pragma unroll
        for (int e2 = 0; e2 < 2; ++e2) { const int et = et0 + e2; f32x16 acc;
#pragma unroll
            for (int i = 0; i < 16; ++i) acc[i] = 0.f;
#pragma unroll
            for (int ks = 0; ks < 4; ++ks) {
                const LAS unsigned char* ap = lds + TK + (16 * ks + 8 * hh + q) * TS + (32 * dt + 16 * blk + 4 * p) * 2;
                const LAS unsigned char* bp = lds + T_V + (16 * ks + 8 * hh + q) * TS + (32 * et + 16 * blk + 4 * p) * 2;
                const bf16x8 a = cat8(tr16(ap), tr16(ap + 4 * TS)), bq = cat8(tr16(bp), tr16(bp + 4 * TS));
                acc = MFMA32(a, bq, acc); }
            bf16* dsb = (bf16*)(F.ws + WS_DS) + ((size_t)(item * 2 + dir) * 128 + 32 * et + r) * 128 + 32 * dt + 4 * hh;
#pragma unroll
            for (int g4 = 0; g4 < 4; ++g4) { u32x2 wv; wv.x = cvtpk(acc[4 * g4], acc[4 * g4 + 1]); wv.y = cvtpk(acc[4 * g4 + 2], acc[4 * g4 + 3]); *(u32x2*)(dsb + 8 * g4) = wv; } } }
    __syncthreads();
}

DI void hgrn_scan(Frame& F) {
    F.refresh();
    const bf16* dS = (const bf16*)(F.ws + WS_DS); bf16* Sst = (bf16*)((unsigned char*)F.out + OUT_SST); const float* dec = (const float*)(F.ws + WS_DEC);
    const int gt = F.vcu * 512 + F.tid, NGT = F.G * 512;
    for (int id = gt; id < BG * 4 * 2 * 128 * 32; id += NGT) {
        const int d4 = id & 31, e = (id >> 5) & 127, dir = (id >> 12) & 1, bh = id >> 13;
        f32x4 S = (f32x4){0.f, 0.f, 0.f, 0.f};
#pragma unroll 4
        for (int s = 0; s < 32; ++s) { const int n = dir ? 31 - s : s, item = bh * 32 + n;
            const size_t off = ((size_t)(item * 2 + dir) * 128 + e) * 128 + d4 * 4;
            u32x2 o; o.x = cvtpk(S.x, S.y); o.y = cvtpk(S.z, S.w); *(u32x2*)(Sst + off) = o;
            const f32x4 dc = *(const f32x4*)(dec + (size_t)(item * 2 + dir) * 128 + d4 * 4);
            const u32x2 wv = *(const u32x2*)(dS + off);
            S.x = dc.x * S.x + bflo(wv.x); S.y = dc.y * S.y + bfhi(wv.x); S.z = dc.z * S.z + bflo(wv.y); S.w = dc.w * S.w + bfhi(wv.y); }
    }
}

DI void hgrn_c_item(Frame& F, int item) {
    F.refresh();
    constexpr int T_QRF = 0, T_KRF = 17408, T_QGF = 34816, T_QRB = 52224, T_KRB = 69632, T_QGB = 87040, T_V = 104448, TOT = 121856, O_OFF = 0, OS = 132;
    LAS unsigned char* lds = F.lds;
    const int n = item & 31, h = (item >> 5) & 3, b = item >> 7;
    const size_t row0 = (size_t)b * SEQ + n * CHUNK;
    const bf16* proj = (const bf16*)(F.ws + WS_PROJ) + row0 * PC;
    const int tid = F.tid, d = tid & 127, tq = tid >> 7;
    const float* lbp = (const float*)(F.ws + WS_LB);
    const float lbf = lbp[h * 128 + d], lbb = lbp[512 + h * 128 + d];
#pragma unroll
    for (int i = 0; i < 2; ++i) { const int id = tid + 512 * i, c = id >> 4, ch = id & 15;
        *(LAS u32x4*)(lds + T_V + c * TS + ch * 16) = *(const u32x4*)(proj + (size_t)c * PC + C_HI + h * 128 + ch * 8); }
    float qv[16];
#pragma unroll
    for (int i = 0; i < 16; ++i) { const float z = bf2f(proj[(size_t)(16 * tq + i) * PC + C_HQ + h * 128 + d]); qv[i] = z * sigmoidf_(z); }
    float Lf[16], kf[16], lff[16], Lb[16], kb[16], lfb[16];
    gate16(proj + (size_t)(16 * tq) * PC + C_FF + h * 128 + d, lbf, Lf, kf, lff);
    gate16(proj + (size_t)(16 * tq) * PC + C_FB + h * 128 + d, lbb, Lb, kb, lfb);
    LAS float* tot = (LAS float*)(lds + TOT);
    tot[(0 * 4 + tq) * 128 + d] = Lf[15]; tot[(1 * 4 + tq) * 128 + d] = Lb[15];
    __syncthreads();
    {
        const float tf0 = tot[0 * 128 + d], tf1 = tot[1 * 128 + d], tf2 = tot[2 * 128 + d];
        const float tb1 = tot[5 * 128 + d], tb2 = tot[6 * 128 + d], tb3 = tot[7 * 128 + d];
        const float offf = (tq > 0 ? tf0 : 0.f) + (tq > 1 ? tf1 : 0.f) + (tq > 2 ? tf2 : 0.f), greff = tf0 + tf1;
        const float offb = (tq < 1 ? tb1 : 0.f) + (tq < 2 ? tb2 : 0.f) + (tq < 3 ? tb3 : 0.f), grefb = tb2 + tb3;
        const float tbq = Lb[15];
#pragma unroll
        for (int i = 0; i < 16; ++i) { const int c = 16 * tq + i;
            const float G = offf + Lf[i]; const float x = G - greff;
            ((LAS bf16*)(lds + T_QRF + c * TS))[d] = (bf16)f2bf(qv[i] * __expf(x)); ((LAS bf16*)(lds + T_KRF + c * TS))[d] = (bf16)f2bf(kf[i] * __expf(-x)); ((LAS bf16*)(lds + T_QGF + c * TS))[d] = (bf16)f2bf(qv[i] * __expf(G));
            const float Gb = offb + (tbq - Lb[i] + lfb[i]); const float xb = Gb - grefb;
            ((LAS bf16*)(lds + T_QRB + c * TS))[d] = (bf16)f2bf(qv[i] * __expf(xb)); ((LAS bf16*)(lds + T_KRB + c * TS))[d] = (bf16)f2bf(kb[i] * __expf(-xb)); ((LAS bf16*)(lds + T_QGB + c * TS))[d] = (bf16)f2bf(qv[i] * __expf(Gb)); }
    }
    __syncthreads();
    const int w = F.wave, lane = F.lane, r = lane & 31, hh = lane >> 5, blk = (lane >> 4) & 1, q = (lane & 15) >> 2, p = lane & 3;
    const int ct = w >> 2, et = w & 3;
    const bf16* Sst = (const bf16*)((const unsigned char*)F.out + OUT_SST);
    f32x16 o;
#pragma unroll
    for (int i = 0; i < 16; ++i) o[i] = 0.f;
#pragma unroll
    for (int dir = 0; dir < 2; ++dir) { const int TQR = dir ? T_QRB : T_QRF, TKR = dir ? T_KRB : T_KRF, TQG = dir ? T_QGB : T_QGF;
#pragma unroll
        for (int st = 0; st < 2; ++st) {
            if (dir == 0 ? (st > ct) : (st < ct)) continue;
            f32x16 X;
#pragma unroll
            for (int i = 0; i < 16; ++i) X[i] = 0.f;
#pragma unroll
            for (int ks = 0; ks < 8; ++ks) { const bf16x8 a = *(const LAS bf16x8*)(lds + TKR + (32 * st + r) * TS + (16 * ks + 8 * hh) * 2), bq = *(const LAS bf16x8*)(lds + TQR + (32 * ct + r) * TS + (16 * ks + 8 * hh) * 2);
                X = MFMA32(a, bq, X); }
            const int cc = 32 * ct + r;
#pragma unroll
            for (int i = 0; i < 16; ++i) { const int s = 32 * st + crow(i, hh); const bool keep = dir == 0 ? (s <= cc) : (s >= cc); X[i] = keep ? X[i] : 0.f; }
#pragma unroll
            for (int s2 = 0; s2 < 2; ++s2) { const bf16x8 xs = pack8(X, s2);
                const LAS unsigned char* vp = lds + T_V + (32 * st + 16 * s2 + 4 * hh + q) * TS + (32 * et + 16 * blk + 4 * p) * 2;
                const bf16x8 pb = cat8(tr16(vp), tr16(vp + 8 * TS));
                o = MFMA32(xs, pb, o); }
        }
        const bf16* sp = Sst + ((size_t)(item * 2 + dir) * 128 + 32 * et + r) * 128 + 8 * hh;
#pragma unroll
        for (int ks = 0; ks < 8; ++ks) { const bf16x8 a = *(const LAS bf16x8*)(lds + TQG + (32 * ct + r) * TS + (16 * ks + 8 * hh) * 2); const bf16x8 bq = *(const bf16x8*)(sp + 16 * ks);
            o = MFMA32(a, bq, o); }
    }
    __syncthreads();
    LAS float* O = (LAS float*)(lds + O_OFF);
#pragma unroll
    for (int i = 0; i < 16; ++i) O[(32 * ct + crow(i, hh)) * OS + 32 * et + r] = o[i];
    __syncthreads();
    const float g0 = F.hg_norm_g[h * 128 + 2 * lane], g1 = F.hg_norm_g[h * 128 + 2 * lane + 1];
    bf16* yhg = (bf16*)(F.ws + WS_YHG);
#pragma unroll
    for (int k = 0; k < 8; ++k) { const int c = 8 * w + k; const f32x2 v = *(const LAS f32x2*)(O + c * OS + 2 * lane);
        const float ss = wave_sum(v.x * v.x + v.y * v.y); const float rstd = 1.0f / sqrtf(ss * (1.0f / 128.0f) + EPS);
        const unsigned hw = *(const unsigned*)(proj + (size_t)c * PC + C_HG + h * 128 + 2 * lane); const float z0 = bflo(hw), z1 = bfhi(hw);
        const float y0 = v.x * rstd * g0 * (z0 * sigmoidf_(z0)), y1 = v.y * rstd * g1 * (z1 * sigmoidf_(z1));
        *(unsigned*)(yhg + (row0 + c) * 512 + h * 128 + 2 * lane) = cvtpk(y0, y1); }
    __syncthreads();
}

DI void attn_item(Frame& F, int g, int item) {
    F.refresh();
    constexpr int KS = 272, VS = 528, K_OFF = 0, V_OFF = 69632;
    LAS unsigned char* lds = F.lds;
    const int qb = item & 7, h = (item >> 3) & 3, b = item >> 5, bglob = g * BG + b;
    const bf16* Km = (const bf16*)(F.ws + WS_KMEM) + (size_t)bglob * 256 * 512 + h * 128;
    const bf16* VT = (const bf16*)(F.ws + WS_VT) + (size_t)(h * 128) * 4096 + bglob * 256;
    const int tid = F.tid;
#pragma unroll
    for (int i = 0; i < 8; ++i) { const int id = tid + 512 * i, key = id >> 4, ch = id & 15;
        *(LAS u32x4*)(lds + K_OFF + key * KS + ch * 16) = *(const u32x4*)(Km + (size_t)key * 512 + ch * 8); }
#pragma unroll
    for (int i = 0; i < 8; ++i) { const int id = tid + 512 * i, e = id >> 5, ch = id & 31;
        *(LAS u32x4*)(lds + V_OFF + e * VS + ch * 16) = *(const u32x4*)(VT + (size_t)e * 4096 + ch * 8); }
    __syncthreads();
    const int w = F.wave, lane = F.lane, r = lane & 31, hh = lane >> 5;
    const size_t qrow0 = (size_t)b * SEQ + qb * 256 + w * 32;
    const bf16* proj = (const bf16*)(F.ws + WS_PROJ);
    bf16x8 qf[8];
#pragma unroll
    for (int ks = 0; ks < 8; ++ks) qf[ks] = *(const bf16x8*)(proj + (qrow0 + r) * PC + C_MQ + h * 128 + 16 * ks + 8 * hh);
    const float scale = 0.08838834764831845f;
    float m_run = -INFINITY, l_run = 0.f;
#pragma unroll 1
    for (int kt = 0; kt < 8; ++kt) {
        f32x16 X;
#pragma unroll
        for (int i = 0; i < 16; ++i) X[i] = 0.f;
#pragma unroll
        for (int ks = 0; ks < 8; ++ks) { const bf16x8 a = *(const LAS bf16x8*)(lds + K_OFF + (32 * kt + r) * KS + (16 * ks + 8 * hh) * 2); X = MFMA32(a, qf[ks], X); }
        float tm = X[0];
#pragma unroll
        for (int i = 1; i < 16; ++i) tm = fmaxf(tm, X[i]);
        tm *= scale;
        const float mn = fmaxf(m_run, tm); float ls = 0.f;
#pragma unroll
        for (int i = 0; i < 16; ++i) ls += __expf(X[i] * scale - mn);
        l_run = l_run * __expf(m_run - mn) + ls; m_run = mn;
    }
    { const float mo = __shfl_xor(m_run, 32), lo = __shfl_xor(l_run, 32); const float m = fmaxf(m_run, mo);
      l_run = l_run * __expf(m_run - m) + lo * __expf(mo - m); m_run = m; }
    const float inv_l = 1.0f / l_run;
    f32x16 O[4];
#pragma unroll
    for (int e = 0; e < 4; ++e)
#pragma unroll
        for (int i = 0; i < 16; ++i) O[e][i] = 0.f;
#pragma unroll 1
    for (int kt = 0; kt < 8; ++kt) {
        f32x16 X;
#pragma unroll
        for (int i = 0; i < 16; ++i) X[i] = 0.f;
#pragma unroll
        for (int ks = 0; ks < 8; ++ks) { const bf16x8 a = *(const LAS bf16x8*)(lds + K_OFF + (32 * kt + r) * KS + (16 * ks + 8 * hh) * 2); X = MFMA32(a, qf[ks], X); }
#pragma unroll
        for (int i = 0; i < 16; ++i) X[i] = __expf(X[i] * scale - m_run) * inv_l;
#pragma unroll
        for (int s2 = 0; s2 < 2; ++s2) { const bf16x8 xs = pack8(X, s2);
#pragma unroll
            for (int e = 0; e < 4; ++e) { const LAS unsigned char* vp = lds + V_OFF + (32 * e + r) * VS + (32 * kt + 16 * s2 + 4 * hh) * 2;
                const bf16x8 pb = cat8(*(const LAS s16x4*)vp, *(const LAS s16x4*)(vp + 16));
                O[e] = MFMA32(xs, pb, O[e]); } }
    }
    bf16* ymx = (bf16*)(F.ws + WS_YMX);
#pragma unroll
    for (int e = 0; e < 4; ++e)
#pragma unroll
        for (int i = 0; i < 16; ++i) ymx[(qrow0 + crow(i, hh)) * 512 + h * 128 + 32 * e + r] = (bf16)f2bf(O[e][i]);
    __syncthreads();
}

DI void conv_phase(Frame& F) {
    F.refresh();
    const bf16* proj = (const bf16*)(F.ws + WS_PROJ); bf16* ysc = (bf16*)(F.ws + WS_YSC); const float* cw = F.sc_conv_w;
    const int gt = F.vcu * 512 + F.tid, NGT = F.G * 512;
    for (int id = gt; id < TG * 64; id += NGT) {
        const int c8 = id & 63, t = id >> 6, ts = t & (SEQ - 1);
        const bf16* pr = proj + (size_t)t * PC + c8 * 8;
        const u32x4 z4 = (u32x4){0u, 0u, 0u, 0u};
        const u32x4 sb = *(const u32x4*)(pr + C_SB), c1 = *(const u32x4*)(pr + C_SC), h1 = *(const u32x4*)(pr + C_SH);
        const u32x4 c0 = ts > 0 ? *(const u32x4*)(pr - PC + C_SC) : z4, h0 = ts > 0 ? *(const u32x4*)(pr - PC + C_SH) : z4;
        const u32x4 c2 = ts < SEQ - 1 ? *(const u32x4*)(pr + PC + C_SC) : z4, h2 = ts < SEQ - 1 ? *(const u32x4*)(pr + PC + C_SH) : z4;
        const f32x4 wa0 = *(const f32x4*)(cw + c8 * 8), wa1 = *(const f32x4*)(cw + c8 * 8 + 4), wb0 = *(const f32x4*)(cw + 512 + c8 * 8), wb1 = *(const f32x4*)(cw + 512 + c8 * 8 + 4),
                    wc0 = *(const f32x4*)(cw + 1024 + c8 * 8), wc1 = *(const f32x4*)(cw + 1024 + c8 * 8 + 4);
        float y[8];
#pragma unroll
        for (int k = 0; k < 4; ++k) {
            const float w0l = k < 2 ? wa0[2 * k] : wa1[2 * k - 4], w0h = k < 2 ? wa0[2 * k + 1] : wa1[2 * k - 3];
            const float w1l = k < 2 ? wb0[2 * k] : wb1[2 * k - 4], w1h = k < 2 ? wb0[2 * k + 1] : wb1[2 * k - 3];
            const float w2l = k < 2 ? wc0[2 * k] : wc1[2 * k - 4], w2h = k < 2 ? wc0[2 * k + 1] : wc1[2 * k - 3];
            y[2 * k]     = bflo(sb[k]) * (w0l * (bflo(c0[k]) * bflo(h0[k])) + w1l * (bflo(c1[k]) * bflo(h1[k])) + w2l * (bflo(c2[k]) * bflo(h2[k])));
            y[2 * k + 1] = bfhi(sb[k]) * (w0h * (bfhi(c0[k]) * bfhi(h0[k])) + w1h * (bfhi(c1[k]) * bfhi(h1[k])) + w2h * (bfhi(c2[k]) * bfhi(h2[k]))); }
        u32x4 o; o.x = cvtpk(y[0], y[1]); o.y = cvtpk(y[2], y[3]); o.z = cvtpk(y[4], y[5]); o.w = cvtpk(y[6], y[7]);
        *(u32x4*)(ysc + (size_t)t * 512 + c8 * 8) = o;
    }
}

DI unsigned ord_key(float v, int idx) { unsigned u = __builtin_bit_cast(unsigned, v); u ^= (u >> 31) ? 0xFFFFFFFFu : 0x80000000u; return (u & 0xFFFFFF80u) | (unsigned)(127 - idx); }
DI float key_val(unsigned k) { unsigned u = k & 0xFFFFFF80u; u = (u & 0x80000000u) ? (u ^ 0x80000000u) : ~u; return __builtin_bit_cast(float, u); }
DI float dot2bf(unsigned a, unsigned b, float c) { return __builtin_amdgcn_fdot2_f32_bf16(__builtin_bit_cast(bf16x2_t, a), __builtin_bit_cast(bf16x2_t, b), c, false); }
DI float dot8(const u32x4& a, const u32x4& b, float c) { c = dot2bf(a.x, b.x, c); c = dot2bf(a.y, b.y, c); c = dot2bf(a.z, b.z, c); return dot2bf(a.w, b.w, c); }
__host__ __device__ constexpr int cand_off(int i) { return i == 0 ? 0 : i == 1 ? 16 : i == 2 ? 24 : i == 3 ? 29 : i == 4 ? 33 : i == 5 ? 36 : i == 6 ? 38 : i == 7 ? 40 : 34 + i; }
__host__ __device__ constexpr int cand_i(int c) { return c < 16 ? 0 : c < 24 ? 1 : c < 29 ? 2 : c < 33 ? 3 : c < 36 ? 4 : c < 38 ? 5 : c < 40 ? 6 : c < 42 ? 7 : c - 34; }
__host__ __device__ constexpr int cand_pos(int c) { return cand_i(c) * 16 + (c - cand_off(cand_i(c))); }

template <int CTRL> DI unsigned dpp_u(unsigned v) { return (unsigned)__builtin_amdgcn_update_dpp(0, (int)v, CTRL, 0xF, 0xF, false); }
template <int CTRL> DI float dpp_f(float v) { return __builtin_bit_cast(float, __builtin_amdgcn_update_dpp(0, __builtin_bit_cast(int, v), CTRL, 0xF, 0xF, false)); }
DI float bperm_f(int addr, float v) { return __builtin_bit_cast(float, __builtin_amdgcn_ds_bpermute(addr, __builtin_bit_cast(int, v))); }
DI unsigned row_max16(unsigned m) { m = max(m, dpp_u<0xB1>(m)); m = max(m, dpp_u<0x4E>(m)); m = max(m, dpp_u<0x141>(m)); return max(m, dpp_u<0x140>(m)); }
DI float row_sum16(float v) { v += dpp_f<0xB1>(v); v += dpp_f<0x4E>(v); v += dpp_f<0x141>(v); return v + dpp_f<0x140>(v); }

DI void peer_topk(const float* srow, LAS int* widx, LAS float* wgate, int lane) {
    const int gq = lane >> 4, li = lane & 15;
    const int ci = cand_i(lane), cj = lane - cand_off(ci), cpos = ci * 16 + cj; const bool cvalid = lane < 50;
#pragma unroll 1
    for (int hp = 0; hp < 4; ++hp) {
        const int head = 2 * hp + (gq >> 1), p = gq & 1;
        const f32x4 va = *(const f32x4*)(srow + head * 256 + p * 128 + li * 8), vb = *(const f32x4*)(srow + head * 256 + p * 128 + li * 8 + 4);
        unsigned k[8];
        k[0] = ord_key(va.x, li * 8 + 0); k[1] = ord_key(va.y, li * 8 + 1); k[2] = ord_key(va.z, li * 8 + 2); k[3] = ord_key(va.w, li * 8 + 3);
        k[4] = ord_key(vb.x, li * 8 + 4); k[5] = ord_key(vb.y, li * 8 + 5); k[6] = ord_key(vb.z, li * 8 + 6); k[7] = ord_key(vb.w, li * 8 + 7);
        unsigned mine = 0u;
#pragma unroll
        for (int rd = 0; rd < 16; ++rd) {
            const unsigned m = row_max16(max(max(max(k[0], k[1]), max(k[2], k[3])), max(max(k[4], k[5]), max(k[6], k[7]))));
            mine = (li == rd) ? m : mine;
#pragma unroll
            for (int j = 0; j < 8; ++j) k[j] = (k[j] == m) ? 0u : k[j];
        }
        const float sc = key_val(mine); const int ix = 127 - (int)(mine & 127u);
#pragma unroll
        for (int hsel = 0; hsel < 2; ++hsel) {
            const float a = __shfl(sc, 32 * hsel + ci), bq = __shfl(sc, 32 * hsel + 16 + cj);
            const int ia = __shfl(ix, 32 * hsel + ci), ib = __shfl(ix, 32 * hsel + 16 + cj);
            const float cs = a + bq;
            int rank = 0;
#pragma unroll
            for (int c2 = 0; c2 < 50; ++c2) { const float v2 = __builtin_bit_cast(float, __builtin_amdgcn_readlane(__builtin_bit_cast(int, cs), c2));
                rank += ((v2 > cs) || (v2 == cs && cand_pos(c2) < cpos)) ? 1 : 0; }
            const bool sel = cvalid && rank < 16;
            const float mx = __builtin_bit_cast(float, __builtin_amdgcn_readlane(__builtin_bit_cast(int, cs), 0));
            const float ev = sel ? __expf(cs - mx) : 0.f;
            const float sum = wave_sum(ev);
            if (sel) { const int hd = 2 * hp + hsel; widx[hd * 16 + rank] = ia * 128 + ib; wgate[hd * 16 + rank] = ev / sum; }
        }
    }
}

constexpr float PEER_TAB_SCALE = 256.0f;
DI void peer_phase(Frame& F, int tg) {
    F.refresh();
    const int gw = F.vcu * NWAVES + F.wave, NGW = F.G * NWAVES, lane = F.lane, gq = lane >> 4, li = lane & 15;
    LAS int* widx = (LAS int*)(F.lds + F.wave * 1024); LAS float* wgate = (LAS float*)(F.lds + F.wave * 1024 + 512);
    const unsigned char* U = F.ws + WS_U; const unsigned char* V = F.ws + WS_V;
    const int a4 = (lane ^ 4) << 2, a8 = (lane ^ 8) << 2, a16 = (lane ^ 16) << 2, a32 = (lane ^ 32) << 2;
    const bool b0 = lane & 1, b1 = lane & 2, b2 = lane & 4, b3 = lane & 8, b4 = lane & 16, b5 = lane & 32;
    for (int tl = gw; tl < TG; tl += NGW) {
        const size_t t = (size_t)tg * TG + tl;
        peer_topk((const float*)(F.ws + WS_S) + (size_t)tl * 2048, widx, wgate, lane);
        asm volatile("s_waitcnt lgkmcnt(0)" ::: "memory");
        const f32x4* sp = (const f32x4*)((const float*)(F.ws + WS_SSP) + t * 16);
        const f32x4 s0 = sp[0], s1 = sp[1], s2 = sp[2], s3 = sp[3];
        const float ssx = ((s0[0] + s0[1]) + (s0[2] + s0[3])) + ((s1[0] + s1[1]) + (s1[2] + s1[3])) + ((s2[0] + s2[1]) + (s2[2] + s2[3])) + ((s3[0] + s3[1]) + (s3[2] + s3[3]));
        const float ascale = (1.0f / sqrtf(ssx * (1.0f / 1024.0f) + EPS)) * (1.0f / PEER_TAB_SCALE);
#define PEER_LOADROW(buf, k) do { const int k_ = (k); const int e_ = widx[((k_ & 31) >> 4) * 64 + 4 * (k_ & 15) + gq]; const unsigned char* r_ = (k_ < 32 ? U : V) + (size_t)e_ * 1024 + 16 * li; \
        buf[0] = *(const u32x4*)(r_); buf[1] = *(const u32x4*)(r_ + 256); buf[2] = *(const u32x4*)(r_ + 512); buf[3] = *(const u32x4*)(r_ + 768); } while (0)
        u32x4 r0[4], r1[4], r2[4], r3[4];
        PEER_LOADROW(r0, 0); PEER_LOADROW(r1, 1); PEER_LOADROW(r2, 2); PEER_LOADROW(r3, 3);
        float totA = 0.f, totB = 0.f;
        {
            f32x2 hreg[4][8];
            const bf16* xr = (const bf16*)(F.ws + WS_XG) + t * 1024 + 16 * li;
#pragma unroll
            for (int c = 0; c < 4; ++c) { const u32x4 w0 = *(const u32x4*)(xr + 256 * c), w1 = *(const u32x4*)(xr + 256 * c + 8);
#pragma unroll
                for (int q = 0; q < 4; ++q) { hreg[c][q] = (f32x2){bflo(w0[q]), bfhi(w0[q])}; hreg[c][4 + q] = (f32x2){bflo(w1[q]), bfhi(w1[q])}; } }
#define PEER_DOT(dst, buf) do { f32x2 acc_ = (f32x2){0.f, 0.f}; _Pragma("unroll") for (int c = 0; c < 4; ++c) _Pragma("unroll") for (int q = 0; q < 4; ++q) { \
            acc_ = __builtin_amdgcn_cvt_pk_f32_fp8(buf[c][q], false) * hreg[c][2 * q] + acc_; acc_ = __builtin_amdgcn_cvt_pk_f32_fp8(buf[c][q], true) * hreg[c][2 * q + 1] + acc_; } dst = acc_.x + acc_.y; } while (0)
#pragma unroll 1
            for (int mi = 0; mi < 8; ++mi) {
                float p0, p1, p2, p3;
                PEER_DOT(p0, r0); __builtin_amdgcn_sched_barrier(0); PEER_LOADROW(r0, 4 * mi + 4); __builtin_amdgcn_sched_barrier(0);
                PEER_DOT(p1, r1); __builtin_amdgcn_sched_barrier(0); PEER_LOADROW(r1, 4 * mi + 5); __builtin_amdgcn_sched_barrier(0);
                PEER_DOT(p2, r2); __builtin_amdgcn_sched_barrier(0); PEER_LOADROW(r2, 4 * mi + 6); __builtin_amdgcn_sched_barrier(0);
                PEER_DOT(p3, r3); __builtin_amdgcn_sched_barrier(0); PEER_LOADROW(r3, 4 * mi + 7); __builtin_amdgcn_sched_barrier(0);
                const float qa = (b0 ? p1 : p0) + dpp_f<0xB1>(b0 ? p0 : p1), qb = (b0 ? p3 : p2) + dpp_f<0xB1>(b0 ? p2 : p3);
                float rr = (b1 ? qb : qa) + dpp_f<0x4E>(b1 ? qa : qb);
                rr += bperm_f(a4, rr); rr += bperm_f(a8, rr);
                const bool mine = (li >> 2) == (mi & 3);
                totA = (mine && mi < 4) ? rr : totA; totB = (mine && mi >= 4) ? rr : totB;
            }
        }
        float cfA, cfB;
        { const float av = totA * ascale; cfA = wgate[4 * li + gq] * (0.5f * av * (1.0f + erff(av * 0.70710678118654752f))) * (1.0f / PEER_TAB_SCALE); }
        { const float av = totB * ascale; cfB = wgate[64 + 4 * li + gq] * (0.5f * av * (1.0f + erff(av * 0.70710678118654752f))) * (1.0f / PEER_TAB_SCALE); }
        f32x2 o2[4][8];
#pragma unroll
        for (int c = 0; c < 4; ++c)
#pragma unroll
            for (int m = 0; m < 8; ++m) o2[c][m] = (f32x2){0.f, 0.f};
#define PEER_AXPY(buf, kk) do { const float cv_ = bperm_f(((lane & 48) | ((kk) & 15)) << 2, ((kk) & 16) ? cfB : cfA); const f32x2 cc_ = (f32x2){cv_, cv_}; \
            _Pragma("unroll") for (int c = 0; c < 4; ++c) _Pragma("unroll") for (int q = 0; q < 4; ++q) { \
            o2[c][2 * q] = __builtin_amdgcn_cvt_pk_f32_fp8(buf[c][q], false) * cc_ + o2[c][2 * q]; o2[c][2 * q + 1] = __builtin_amdgcn_cvt_pk_f32_fp8(buf[c][q], true) * cc_ + o2[c][2 * q + 1]; } } while (0)
#pragma unroll 1
        for (int mi = 0; mi < 8; ++mi) {
            const bool more = mi < 7;
            PEER_AXPY(r0, 4 * mi + 0); __builtin_amdgcn_sched_barrier(0); if (more) PEER_LOADROW(r0, 32 + 4 * mi + 4); __builtin_amdgcn_sched_barrier(0);
            PEER_AXPY(r1, 4 * mi + 1); __builtin_amdgcn_sched_barrier(0); if (more) PEER_LOADROW(r1, 32 + 4 * mi + 5); __builtin_amdgcn_sched_barrier(0);
            PEER_AXPY(r2, 4 * mi + 2); __builtin_amdgcn_sched_barrier(0); if (more) PEER_LOADROW(r2, 32 + 4 * mi + 6); __builtin_amdgcn_sched_barrier(0);
            PEER_AXPY(r3, 4 * mi + 3); __builtin_amdgcn_sched_barrier(0); if (more) PEER_LOADROW(r3, 32 + 4 * mi + 7); __builtin_amdgcn_sched_barrier(0);
        }
#undef PEER_LOADROW
#undef PEER_DOT
#undef PEER_AXPY
        f32x2 o1[2][8], of[8];
#pragma unroll
        for (int c = 0; c < 2; ++c)
#pragma unroll
            for (int m = 0; m < 8; ++m) { const f32x2 keep = b4 ? o2[c + 2][m] : o2[c][m], send = b4 ? o2[c][m] : o2[c + 2][m];
                o1[c][m] = keep + (f32x2){bperm_f(a16, send.x), bperm_f(a16, send.y)}; }
#pragma unroll
        for (int m = 0; m < 8; ++m) { const f32x2 keep = b5 ? o1[1][m] : o1[0][m], send = b5 ? o1[0][m] : o1[1][m];
            of[m] = keep + (f32x2){bperm_f(a32, send.x), bperm_f(a32, send.y)}; }
        const int cidx = (b4 ? 2 : 0) + (b5 ? 1 : 0);
        float* xo = F.out + t * 1024 + 256 * cidx + 16 * li; const float* gfp = F.final_norm_g + 256 * cidx + 16 * li;
        f32x4 a[4]; float ss = 0.f;
#pragma unroll
        for (int k = 0; k < 4; ++k) { a[k] = *(const f32x4*)(xo + 4 * k) + (f32x4){of[2 * k].x, of[2 * k].y, of[2 * k + 1].x, of[2 * k + 1].y};
            ss += (a[k].x * a[k].x + a[k].y * a[k].y) + (a[k].z * a[k].z + a[k].w * a[k].w); }
        ss = wave_sum(ss);
        const float rf = 1.0f / sqrtf(ss * (1.0f / 1024.0f) + EPS);
#pragma unroll
        for (int k = 0; k < 4; ++k) *(f32x4*)(xo + 4 * k) = a[k] * rf * *(const f32x4*)(gfp + 4 * k);
        asm volatile("s_waitcnt lgkmcnt(0)" ::: "memory");
    }
}

DI void convert_uv(Frame& F) {
    F.refresh();
    const int gt = F.vcu * 512 + F.tid, NGT = F.G * 512;
    for (int id = gt; id < 2 * 16384 * 64; id += NGT) {
        const int which = id >> 20, off = (id & ((1 << 20) - 1)) * 16;
        const float* src = (which ? F.peer_v : F.peer_u) + off; unsigned char* dst = F.ws + (which ? WS_V : WS_U) + off;
        u32x4 o;
#pragma unroll
        for (int q = 0; q < 4; ++q) { const f32x4 v = *(const f32x4*)(src + 4 * q) * PEER_TAB_SCALE; int pk = __builtin_amdgcn_cvt_pk_fp8_f32(v.x, v.y, 0, false); pk = __builtin_amdgcn_cvt_pk_fp8_f32(v.z, v.w, pk, true); o[q] = (unsigned)pk; }
        *(u32x4*)dst = o;
    }
}

constexpr int N_PHASES = 19;
struct Args { const float* in[17]; float* out; unsigned char* ws; int ph_lo, ph_hi; };

__global__ void __launch_bounds__(NWAVES * 64, 2) fwd_kernel(Args args) {
    extern __shared__ __attribute__((aligned(16))) unsigned char lds_raw[];
    Frame F;
    F.lds = (LAS unsigned char*)lds_raw;
    F.tid = threadIdx.x; F.lane = F.tid & 63; F.wave = __builtin_amdgcn_readfirstlane(F.tid >> 6);
    F.G = gridDim.x; { const int bx = blockIdx.x; F.vcu = (F.G % 8 == 0) ? (bx % 8) * (F.G / 8) + bx / 8 : bx; }
    F.x = args.in[0]; F.mem = args.in[1]; F.norm_mix_g = args.in[2]; F.w_in = args.in[3]; F.hg_lb = args.in[4]; F.hg_norm_g = args.in[5]; F.sc_conv_w = args.in[6];
    F.mem_norm_g = args.in[7]; F.w_mem_kv = args.in[8]; F.w_branch = args.in[9]; F.w_out = args.in[10]; F.norm_ffn_g = args.in[11]; F.peer_w_q = args.in[12];
    F.peer_sub_keys = args.in[13]; F.peer_u = args.in[14]; F.peer_v = args.in[15]; F.final_norm_g = args.in[16];
    F.out = args.out; F.ws = args.ws;
    volatile LAS unsigned* MISC = (volatile LAS unsigned*)(F.lds + MISC_OFF);
    for (int u = F.tid; u < (LDS_BYTES - MISC_OFF) / 4; u += NWAVES * 64) MISC[u] = 0u;
    __syncthreads();
    unsigned* barw = (unsigned*)(F.ws + WS_CTL) + CW_BAR;
    XcdBarrier bar; bar.bar = barw; bar.x = 0; bar.st = nullptr;
    const bool one_launch = (args.ph_hi - args.ph_lo) > 1;
    if (one_launch) bar = xcd_barrier_post(barw, MISC + 8);
    const int lo = args.ph_lo, hi = args.ph_hi;
#define IN(k) (lo <= (k) && (k) < hi)
#ifndef PMASK
#define PMASK 0x3ff
#endif
#define PC_(c) ((PMASK >> (c)) & 1)
#ifndef REP_MASK
#define REP_MASK 0
#endif
#define REPS(c) for (int rep_ = 0; rep_ < 1 + 2 * ((REP_MASK >> (c)) & 1); ++rep_)
#define SEAM(k) do { if (IN(k) && IN((k) + 1)) xcd_barrier(bar); } while (0)
    unsigned char* ws = F.ws;
    const int G = F.G, cid = (int)blockIdx.x;

    if (PC_(0) && IN(0)) { REPS(0) p0_prologue(F); } SEAM(0);

#pragma unroll 1
    for (int g = 0; g < NGRP; ++g) {
        const int pb = 1 + 6 * g;
        if (PC_(1) && IN(pb)) REPS(1) {
            { pg8::PlainOrder S; S.init(TG, PC, G, cid); S.A = (const char*)(ws + WS_XG) + (size_t)g * TG * 1024 * 2; S.Bt = (const char*)(ws + WS_WIN); S.a_tile = 256 * 1024 * 2; S.b_tile = 256 * 1024 * 2;
              pg8::EpiBf16 E{(bf16*)(ws + WS_PROJ), PC};
              pg8::gemm_phase<pg8::EpiBf16, pg8::PlainOrder, true, true>(F.lds, pg8::Gemm{1024, 1024, 1024}, S, E); }
            if (g == 0) {
                { pg8::PlainOrder S; S.init(BATCH * NMEM, 512, G, cid); S.A = (const char*)(ws + WS_MN); S.Bt = (const char*)(ws + WS_WKV); S.a_tile = 256 * 1024 * 2; S.b_tile = 256 * 1024 * 2;
                  pg8::EpiBf16 E{(bf16*)(ws + WS_KMEM), 512};
                  pg8::gemm_phase<pg8::EpiBf16, pg8::PlainOrder, true, true>(F.lds, pg8::Gemm{1024, 1024, 1024}, S, E); }
                { pg8::PlainOrder S; S.init(512, BATCH * NMEM, G, cid); S.A = (const char*)(ws + WS_WKV) + (size_t)512 * 1024 * 2; S.Bt = (const char*)(ws + WS_MN); S.a_tile = 256 * 1024 * 2; S.b_tile = 256 * 1024 * 2;
                  pg8::EpiBf16 E{(bf16*)(ws + WS_VT), BATCH * NMEM};
                  pg8::gemm_phase<pg8::EpiBf16, pg8::PlainOrder, true, true>(F.lds, pg8::Gemm{1024, 1024, 1024}, S, E); }
            }
        } SEAM(pb);
        if (PC_(2) && IN(pb + 1)) REPS(2) {
            for (int it = F.vcu * 4; it < BG * 4 * NCHUNK; it += G * 4) { for (int k = 0; k < 4; ++k) hgrn_a_item(F, it + k); }
            for (int it = F.vcu; it < BG * 4 * 8; it += G) attn_item(F, g, it);
            conv_phase(F);
        } SEAM(pb + 1);
        if (PC_(3) && IN(pb + 2)) { REPS(3) hgrn_scan(F); } SEAM(pb + 2);
        if (PC_(4) && IN(pb + 3)) REPS(4) { for (int it = F.vcu * 4; it < BG * 4 * NCHUNK; it += G * 4) { for (int k = 0; k < 4; ++k) hgrn_c_item(F, it + k); } } SEAM(pb + 3);
        if (PC_(5) && IN(pb + 4)) REPS(5) {
            pg8::BranchOrder S; S.init(TG, 1024, G, cid); S.Y = (const char*)(ws + WS_YHG); S.Wb = (const char*)(ws + WS_WBR);
            pg8::EpiBranch E{(const bf16*)(ws + WS_PROJ), (float*)(ws + WS_MACC), (bf16*)(ws + WS_MERGED)};
            pg8::gemm_phase<pg8::EpiBranch, pg8::BranchOrder, true, true>(F.lds, pg8::Gemm{512, 512, 512}, S, E);
        } SEAM(pb + 4);
        if (PC_(6) && IN(pb + 5)) REPS(6) {
            pg8::PlainOrder S; S.init(TG, 1024, G, cid); S.A = (const char*)(ws + WS_MERGED); S.Bt = (const char*)(ws + WS_WOUT); S.a_tile = 256 * 1024 * 2; S.b_tile = 256 * 1024 * 2;
            pg8::EpiOut E{F.x + (size_t)g * TG * 1024, F.out + (size_t)g * TG * 1024, (bf16*)(ws + WS_XG) + (size_t)g * TG * 1024, F.norm_ffn_g, (float*)(ws + WS_SSP) + (size_t)g * TG * 16};
            pg8::gemm_phase<pg8::EpiOut, pg8::PlainOrder, true, true>(F.lds, pg8::Gemm{1024, 1024, 1024}, S, E);
        } SEAM(pb + 5);
    }
#pragma unroll 1
    for (int tg = 0; tg < NGRP; ++tg) {
        const int pb = 13 + 3 * tg;
        if (PC_(7) && IN(pb)) REPS(7) {
            if (tg == 0) convert_uv(F);
            pg8::PlainOrder S; S.init(TG, 2048, G, cid); S.A = (const char*)(ws + WS_XG) + (size_t)tg * TG * 1024 * 2; S.Bt = (const char*)(ws + WS_WQ); S.a_tile = 256 * 1024 * 2; S.b_tile = 256 * 1024 * 2;
            pg8::EpiQ E{(bf16*)(ws + WS_Q), 2048, (const float*)(ws + WS_SSP) + (size_t)tg * TG * 16};
            pg8::gemm_phase<pg8::EpiQ, pg8::PlainOrder, true, true>(F.lds, pg8::Gemm{1024, 1024, 1024}, S, E);
        } SEAM(pb);
        if (PC_(8) && IN(pb + 1)) REPS(8) {
            pg8::ScoreOrder S; S.init(TG, 2048, G, cid); S.Q = (const char*)(ws + WS_Q); S.Kbd = (const char*)(ws + WS_KBD);
            pg8::EpiF32 E{(float*)(ws + WS_S), 2048};
            pg8::gemm_phase<pg8::EpiF32, pg8::ScoreOrder, true, true>(F.lds, pg8::Gemm{2048, 256, 256}, S, E);
        } SEAM(pb + 1);
        if (PC_(9) && IN(pb + 2)) { peer_phase(F, tg); } SEAM(pb + 2);
    }
#undef IN
#undef SEAM
}

extern "C" void kernel_launch(void* const* d_in, const int* in_sizes, int n_in, void* d_out, int out_size, void* d_ws, size_t ws_size, hipStream_t stream) {
    static int ready = 0;
    if (ready == 0) {
        if (n_in != 17 || out_size != T_ALL * D_MODEL || ws_size < WS_END) { fprintf(stderr, "kernel_launch: unexpected shapes (n_in %d, out %d, ws %zu)\n", n_in, out_size, ws_size); ready = -1; return; }
        if (hipFuncSetAttribute((const void*)fwd_kernel, hipFuncAttributeMaxDynamicSharedMemorySize, LDS_BYTES) != hipSuccess) { fprintf(stderr, "kernel_launch: hipFuncSetAttribute failed\n"); ready = -1; return; }
        ready = 1;
    }
    if (ready < 0) return;
    (void)hipMemsetAsync((char*)d_ws + WS_CTL, 0, CTL_ZERO_BYTES, stream);
    Args a{};
    for (int i = 0; i < 17; ++i) a.in[i] = (const float*)d_in[i];
    a.out = (float*)d_out; a.ws = (unsigned char*)d_ws;
    const int grid = 256;
#if MK_N_LAUNCHES == 1
    a.ph_lo = 0; a.ph_hi = N_PHASES;
    hipLaunchKernelGGL(fwd_kernel, dim3(grid), dim3(NWAVES * 64), LDS_BYTES, stream, a);
#else
    for (int li = 0; li < N_PHASES; ++li) { a.ph_lo = li; a.ph_hi = li + 1; hipLaunchKernelGGL(fwd_kernel, dim3(grid), dim3(NWAVES * 64), LDS_BYTES, stream, a); }
#endif
}
```

```cpp
#include <hip/hip_runtime.h>
#include <cstdio>
#include <cstdint>

#ifndef MK_N_LAUNCHES
#define MK_N_LAUNCHES 1
#endif

#define LAS __attribute__((address_space(3)))
#define GAS __attribute__((address_space(1)))
typedef unsigned short bf16;
typedef short bf16x8 __attribute__((ext_vector_type(8)));
typedef short s16x4 __attribute__((ext_vector_type(4)));
typedef short v4i16_t __attribute__((ext_vector_type(4)));
typedef float f32x2 __attribute__((ext_vector_type(2)));
typedef float f32x4 __attribute__((ext_vector_type(4)));
typedef float f32x16 __attribute__((ext_vector_type(16)));
typedef unsigned u32x2 __attribute__((ext_vector_type(2)));
typedef unsigned u32x4 __attribute__((ext_vector_type(4)));
typedef __bf16 bf16x2_t __attribute__((ext_vector_type(2)));
typedef GAS unsigned gu32;
#define RLX_AGENT __ATOMIC_RELAXED, __HIP_MEMORY_SCOPE_AGENT
#define DI __device__ __forceinline__

constexpr int D_MODEL = 1024, BATCH = 16, SEQ = 2048, T_ALL = BATCH * SEQ;
constexpr int NGRP = 2, BG = BATCH / NGRP, TG = BG * SEQ;
constexpr int PC = 7680;
constexpr int C_HQ = 0, C_HI = 512, C_FF = 1024, C_FB = 1536, C_HG = 2048, C_SB = 2560, C_SC = 3072, C_SH = 3584, C_MQ = 4096, C_GATE = 4608;
constexpr int NMEM = 256, CHUNK = 64, NCHUNK = SEQ / CHUNK;
constexpr float EPS = 1e-6f;

constexpr size_t MiB = 1u << 20;
constexpr size_t WS_CTL = 0, CTL_ZERO_BYTES = 1 * MiB;
constexpr size_t WS_LB = 1 * MiB;
constexpr size_t WS_SSP = 2 * MiB;
constexpr size_t WS_DEC = 4 * MiB;
constexpr size_t WS_WIN = 5 * MiB, WS_WKV = 20 * MiB, WS_WBR = 22 * MiB, WS_WOUT = 25 * MiB, WS_WQ = 27 * MiB, WS_KBD = 31 * MiB;
constexpr size_t WS_MN = 32 * MiB, WS_KMEM = 40 * MiB, WS_VT = 44 * MiB;
constexpr size_t WS_XG = 48 * MiB;
constexpr size_t WS_YHG = 112 * MiB, WS_YSC = 128 * MiB, WS_YMX = 144 * MiB;
constexpr size_t WS_DS = 160 * MiB;
constexpr size_t WS_MACC = 160 * MiB;
constexpr size_t WS_MERGED = 224 * MiB;
constexpr size_t WS_PROJ = 256 * MiB;
constexpr size_t WS_U = 112 * MiB, WS_V = 128 * MiB;
constexpr size_t WS_Q = 176 * MiB;
constexpr size_t WS_S = 256 * MiB;
constexpr size_t WS_END = 496 * MiB;
constexpr size_t OUT_SST = 64 * MiB;

constexpr int LDS_BYTES = 160 * 1024;
constexpr int MISC_OFF = LDS_BYTES - 512;
constexpr int NWAVES = 8;

DI unsigned f2bf(float f) { unsigned u = __builtin_bit_cast(unsigned, f); return (u + 0x7fffu + ((u >> 16) & 1u)) >> 16; }
DI unsigned pk2(float lo, float hi) { return f2bf(lo) | (f2bf(hi) << 16); }
DI float bf2f(unsigned short b) { return __builtin_bit_cast(float, (unsigned)b << 16); }
DI float bflo(unsigned w) { return __builtin_bit_cast(float, w << 16); }
DI float bfhi(unsigned w) { return __builtin_bit_cast(float, w & 0xffff0000u); }
DI float wave_sum(float v) {
#pragma unroll
    for (int o = 1; o < 64; o <<= 1) v += __shfl_xor(v, o);
    return v;
}
DI unsigned cvtpk(float lo, float hi) { f32x2 v = {lo, hi}; bf16x2_t b = __builtin_convertvector(v, bf16x2_t); return __builtin_bit_cast(unsigned, b); }
DI float sigmoidf_(float z) { return 1.0f / (1.0f + __expf(-z)); }

namespace pg8 {
constexpr int BM = 256, BK = 64, HALF = 128, HTB = HALF * BK * 2, STAGE_BYTES = 8 * HTB, NXCD = 8, WGM = 8;
__host__ __device__ __forceinline__ int lds_byte(int r, int c) { const int st = (r >> 4) * 2 + (c >> 5), rr = r & 15, cc = c & 31, ob = rr * 64 + cc * 2; return st * 1024 + (ob ^ (((ob >> 9) & 1) << 5)); }
__host__ __device__ __forceinline__ void stage_rc(int b, int& R, int& C) { const int st = b / 1024, sb = b % 1024, swz = sb ^ (((sb >> 9) & 1) << 5); R = (st >> 1) * 16 + swz / 64; C = (st & 1) * 32 + (swz % 64) / 2; }
__host__ __device__ __forceinline__ int perm32(int rho) { const int n = rho >> 4, i = rho & 15; return 8 * (i >> 2) + 4 * n + (i & 3); }

struct Unit { int pm, pn, z; };
struct Gemm { int lda, ldb, K; };

struct StaticOrder {
    int nM, nN, nwg, G, c;
    __device__ void init(int M, int N, int G_, int c_) { nM = M / BM; nN = N / BM; nwg = nM * nN; G = G_; c = c_; }
    __device__ bool tile(int i, Unit& u) const {
        const long L = (long)i * G + c; if (L >= nwg) return false;
        int wgid = (int)L; { const int q = nwg / NXCD, r = nwg % NXCD, xcd = wgid % NXCD, off = wgid / NXCD; wgid = (xcd < r ? xcd * (q + 1) : r * (q + 1) + (xcd - r) * q) + off; }
        const int nig = WGM * nN, gid = wgid / nig, fm = gid * WGM, gsz = (nM - fm) < WGM ? (nM - fm) : WGM;
        u.pm = fm + ((wgid % nig) % gsz); u.pn = (wgid % nig) / gsz; u.z = 0; return true;
    }
};

DI unsigned cvt_pk_bf16(float lo, float hi) { return cvtpk(lo, hi); }

template <class Epi, class Sched, bool ALIGN_EPI, bool SP2>
DI void gemm_phase(LAS unsigned char* lds, const Gemm g, const Sched& S, const Epi& E) {
    int tid_ = threadIdx.x; asm volatile("" : "+v"(tid_));
    const int tid = tid_, wid = __builtin_amdgcn_readfirstlane(tid >> 6), lane = tid & 63, wr = wid >> 2, wc = wid & 3, fr = lane & 15, fq = lane >> 4;
    int K_ = g.K; asm volatile("" : "+s"(K_));
    const int K = K_, nt = K / BK;
    unsigned voffA[2], voffB[2];
#pragma unroll
    for (int i = 0; i < 2; ++i) { int R, C; stage_rc(tid * 16 + i * 8192, R, C); const int Rb = Epi::PERM ? ((R & ~31) + perm32(R & 31)) : R;
        voffA[i] = (unsigned)(R * g.lda + C) * 2u; voffB[i] = (unsigned)(Rb * g.ldb + C) * 2u; }
    const size_t kstep = (size_t)(BK * 2);
    const size_t hA = (size_t)HALF * g.lda * 2, hB = (size_t)HALF * g.ldb * 2;
    const unsigned ldsw = (unsigned)wid * 1024u;
    const int aoff = lds_byte(wr * 64 + fr, fq * 8), boff = lds_byte(wc * 32 + fr, fq * 8);
#define PG8_SA(b, h) (((b) * 2 + (h)) * HTB)
#define PG8_SB(b, h) ((4 + (b) * 2 + (h)) * HTB)
#define PG8_STAGE(bufoff, gbase, voff) do { _Pragma("unroll") for (int _i = 0; _i < 2; ++_i) \
        __builtin_amdgcn_global_load_lds((const unsigned*)((const char*)(gbase) + (voff)[_i]), (LAS unsigned*)(lds + (bufoff) + ldsw + _i * 8192), 16, 0, 0); } while (0)
#define PG8_LDA(dst, b, h) do { _Pragma("unroll") for (int m = 0; m < 4; ++m) _Pragma("unroll") for (int k = 0; k < 2; ++k) dst[m][k] = *(const LAS bf16x8*)(lds + PG8_SA(b, h) + aoff + m * 2048 + k * 1024); } while (0)
#define PG8_LDB(dst, b, h) do { _Pragma("unroll") for (int n = 0; n < 2; ++n) _Pragma("unroll") for (int k = 0; k < 2; ++k) dst[n][k] = *(const LAS bf16x8*)(lds + PG8_SB(b, h) + boff + n * 2048 + k * 1024); } while (0)
#define PG8_MMA(ai, bj, At, Bt) do { __builtin_amdgcn_s_setprio(1); _Pragma("unroll") for (int m = 0; m < 4; ++m) _Pragma("unroll") for (int n = 0; n < 2; ++n) _Pragma("unroll") for (int k = 0; k < 2; ++k) \
        acc[ai][bj][m][n] = __builtin_amdgcn_mfma_f32_16x16x32_bf16(Bt[n][k], At[m][k], acc[ai][bj][m][n], 0, 0, 0); __builtin_amdgcn_s_setprio(0); } while (0)
#define PG8_WAIT_V(n) asm volatile("s_waitcnt vmcnt(" #n ")" ::: "memory")
#define PG8_WAIT_L(n) asm volatile("s_waitcnt lgkmcnt(" #n ")" ::: "memory")
#define PG8_BAR __builtin_amdgcn_s_barrier()
#define PG8_SCHED __builtin_amdgcn_sched_barrier(0)
    Unit cur, nxt; int ui = 0;
    if (!S.next(0, cur)) return;
    f32x4 acc[2][2][4][2];
#pragma unroll
    for (int a = 0; a < 2; ++a)
#pragma unroll
        for (int b = 0; b < 2; ++b)
#pragma unroll
            for (int m = 0; m < 4; ++m)
#pragma unroll
                for (int n = 0; n < 2; ++n) acc[a][b][m][n] = (f32x4){0.f, 0.f, 0.f, 0.f};
    bf16x8 At[4][2], B0[2][2], B1[2][2];
    const char* cA = S.a_base(cur); const char* cB = S.b_base(cur);
    if constexpr (SP2) {
        PG8_STAGE(PG8_SB(0, 0), cB, voffB); PG8_STAGE(PG8_SB(0, 1), cB + hB, voffB); PG8_STAGE(PG8_SA(0, 0), cA, voffA); PG8_STAGE(PG8_SA(0, 1), cA + hA, voffA);
        if (wr == 1) PG8_BAR;
        PG8_WAIT_V(2); PG8_BAR;
        PG8_STAGE(PG8_SB(1, 0), cB + kstep, voffB); PG8_STAGE(PG8_SA(1, 0), cA + kstep, voffA); PG8_STAGE(PG8_SB(1, 1), cB + hB + kstep, voffB);
        PG8_WAIT_V(6); PG8_BAR;
    } else {
        PG8_STAGE(PG8_SB(0, 0), cB, voffB); PG8_STAGE(PG8_SA(0, 0), cA, voffA); PG8_STAGE(PG8_SB(0, 1), cB + hB, voffB); PG8_STAGE(PG8_SA(0, 1), cA + hA, voffA);
        if (wr == 1) PG8_BAR;
        PG8_WAIT_V(4); PG8_BAR;
        PG8_STAGE(PG8_SB(1, 0), cB + kstep, voffB); PG8_STAGE(PG8_SA(1, 0), cA + kstep, voffA); PG8_STAGE(PG8_SB(1, 1), cB + hB + kstep, voffB);
        PG8_WAIT_V(6); PG8_BAR;
    }
    for (;;) {
        const bool has_next = S.next(ui + 1, nxt);
        const char* nA = has_next ? S.a_base(nxt) : cA; const char* nB = has_next ? S.b_base(nxt) : cB;
        for (int t = 0; t < nt; t += 2) {
            const bool last = (t == nt - 2);
            const char* a1 = cA + (size_t)(t + 1) * kstep;
            const char* a2 = last ? nA : cA + (size_t)(t + 2) * kstep; const char* b2 = last ? nB : cB + (size_t)(t + 2) * kstep;
            const char* a3 = a2 + kstep; const char* b3 = b2 + kstep;
            if constexpr (SP2) {
            PG8_LDB(B0, 0, 0); PG8_LDB(B1, 0, 1); PG8_SCHED; PG8_LDA(At, 0, 0); PG8_STAGE(PG8_SA(1, 1), a1 + hA, voffA);
            PG8_WAIT_V(8); PG8_WAIT_L(0); PG8_BAR; PG8_MMA(0, 0, At, B0); PG8_MMA(0, 1, At, B1); PG8_BAR; PG8_SCHED;
            PG8_LDA(At, 0, 1); PG8_STAGE(PG8_SB(0, 0), b2, voffB); PG8_STAGE(PG8_SB(0, 1), b2 + hB, voffB); PG8_STAGE(PG8_SA(0, 0), a2, voffA);
            PG8_WAIT_V(8); PG8_WAIT_L(0); PG8_BAR; PG8_MMA(1, 0, At, B0); PG8_MMA(1, 1, At, B1); PG8_BAR; PG8_SCHED;
            PG8_LDB(B0, 1, 0); PG8_LDB(B1, 1, 1); PG8_SCHED; PG8_LDA(At, 1, 0); PG8_STAGE(PG8_SA(0, 1), a2 + hA, voffA);
            PG8_WAIT_V(8); PG8_WAIT_L(0); PG8_BAR; PG8_MMA(0, 0, At, B0); PG8_MMA(0, 1, At, B1); PG8_BAR; PG8_SCHED;
            PG8_LDA(At, 1, 1); PG8_STAGE(PG8_SB(1, 0), b3, voffB); PG8_STAGE(PG8_SB(1, 1), b3 + hB, voffB); PG8_STAGE(PG8_SA(1, 0), a3, voffA);
            PG8_WAIT_V(8); PG8_WAIT_L(0); PG8_BAR; PG8_MMA(1, 0, At, B0); PG8_MMA(1, 1, At, B1); PG8_BAR; PG8_SCHED;
            } else {
            PG8_LDB(B0, 0, 0); PG8_SCHED; PG8_LDA(At, 0, 0); PG8_STAGE(PG8_SA(1, 1), a1 + hA, voffA);
            PG8_WAIT_L(8); PG8_BAR; PG8_WAIT_L(0); PG8_MMA(0, 0, At, B0); PG8_BAR; PG8_SCHED;
            PG8_LDB(B1, 0, 1); PG8_STAGE(PG8_SB(0, 0), b2, voffB);
            PG8_BAR; PG8_WAIT_L(0); PG8_MMA(0, 1, At, B1); PG8_BAR;
            PG8_LDA(At, 0, 1); PG8_STAGE(PG8_SA(0, 0), a2, voffA);
            PG8_BAR; PG8_WAIT_L(0); PG8_MMA(1, 0, At, B0); PG8_BAR; PG8_SCHED;
            PG8_STAGE(PG8_SB(0, 1), b2 + hB, voffB);
            PG8_WAIT_V(6); PG8_BAR; PG8_MMA(1, 1, At, B1); PG8_BAR;
            PG8_LDB(B0, 1, 0); PG8_SCHED; PG8_LDA(At, 1, 0); PG8_STAGE(PG8_SA(0, 1), a2 + hA, voffA);
            PG8_WAIT_L(8); PG8_BAR; PG8_WAIT_L(0); PG8_MMA(0, 0, At, B0); PG8_BAR; PG8_SCHED;
            PG8_LDB(B1, 1, 1); PG8_STAGE(PG8_SB(1, 0), b3, voffB);
            PG8_BAR; PG8_WAIT_L(0); PG8_MMA(0, 1, At, B1); PG8_BAR;
            PG8_LDA(At, 1, 1); PG8_STAGE(PG8_SA(1, 0), a3, voffA);
            PG8_BAR; PG8_WAIT_L(0); PG8_MMA(1, 0, At, B0); PG8_BAR; PG8_SCHED;
            PG8_STAGE(PG8_SB(1, 1), b3 + hB, voffB);
            PG8_WAIT_V(6); PG8_BAR; PG8_MMA(1, 1, At, B1); PG8_BAR;
            }
        }
        if constexpr (ALIGN_EPI) { if (wr == 0) PG8_BAR; }
        E(acc, cur, wr, wc, fr, fq);
        if (!has_next) break;
#pragma unroll
        for (int a = 0; a < 2; ++a)
#pragma unroll
            for (int b = 0; b < 2; ++b)
#pragma unroll
                for (int m = 0; m < 4; ++m)
#pragma unroll
                    for (int n = 0; n < 2; ++n) acc[a][b][m][n] = (f32x4){0.f, 0.f, 0.f, 0.f};
        cur = nxt; cA = nA; cB = nB; ++ui;
        if constexpr (ALIGN_EPI) { if (wr == 1) PG8_BAR; }
    }
    PG8_WAIT_V(0);
    if constexpr (!ALIGN_EPI) { if (wr == 0) PG8_BAR; }
    PG8_BAR;
#undef PG8_SA
#undef PG8_SB
#undef PG8_STAGE
#undef PG8_LDA
#undef PG8_LDB
#undef PG8_MMA
#undef PG8_WAIT_V
#undef PG8_WAIT_L
#undef PG8_BAR
#undef PG8_SCHED
}
}

namespace pg8 {
struct PlainOrder : StaticOrder {
    const char* A; const char* Bt; size_t a_tile, b_tile;
    __device__ bool next(int i, Unit& u) const { return tile(i, u); }
    DI const char* a_base(const Unit& u) const { return A + (size_t)u.pm * a_tile; }
    DI const char* b_base(const Unit& u) const { return Bt + (size_t)u.pn * b_tile; }
};
struct BranchOrder : StaticOrder {
    const char* Y; const char* Wb;
    __device__ bool next(int i, Unit& u) const { if (!tile(i / 3, u)) return false; u.z = i % 3; return true; }
    DI const char* a_base(const Unit& u) const { return Y + (size_t)u.z * (16 * MiB) + (size_t)u.pm * (256 * 512 * 2); }
    DI const char* b_base(const Unit& u) const { return Wb + (size_t)u.z * (1024 * 512 * 2) + (size_t)u.pn * (256 * 512 * 2); }
};
struct ScoreOrder : StaticOrder {
    const char* Q; const char* Kbd;
    __device__ bool next(int i, Unit& u) const { return tile(i, u); }
    DI const char* a_base(const Unit& u) const { return Q + (size_t)u.pm * (256 * 2048 * 2) + (size_t)u.pn * 512; }
    DI const char* b_base(const Unit& u) const { return Kbd + (size_t)u.pn * (256 * 256 * 2); }
};

struct EpiBf16 {
    static constexpr bool PERM = true;
    bf16* O; int ldc;
    DI void operator()(const f32x4 (&acc)[2][2][4][2], const Unit& u, int wr, int wc, int fr, int fq) const {
        const int row0 = u.pm * BM + wr * 64 + fr, col0 = u.pn * BM + wc * 32 + 8 * fq;
#pragma unroll
        for (int ai = 0; ai < 2; ++ai)
#pragma unroll
            for (int m = 0; m < 4; ++m) { bf16* rowp = O + (size_t)(row0 + ai * HALF + m * 16) * ldc + col0;
#pragma unroll
                for (int bj = 0; bj < 2; ++bj) { const f32x4 v0 = acc[ai][bj][m][0], v1 = acc[ai][bj][m][1];
                    u32x4 w; w.x = cvt_pk_bf16(v0[0], v0[1]); w.y = cvt_pk_bf16(v0[2], v0[3]); w.z = cvt_pk_bf16(v1[0], v1[1]); w.w = cvt_pk_bf16(v1[2], v1[3]);
                    *(u32x4*)(rowp + bj * HALF) = w; } }
    }
};
struct EpiQ {
    static constexpr bool PERM = true;
    bf16* O; int ldc; const float* ssp;
    DI void operator()(const f32x4 (&acc)[2][2][4][2], const Unit& u, int wr, int wc, int fr, int fq) const {
        const int row0 = u.pm * BM + wr * 64 + fr, col0 = u.pn * BM + wc * 32 + 8 * fq;
#pragma unroll
        for (int ai = 0; ai < 2; ++ai)
#pragma unroll
            for (int m = 0; m < 4; ++m) { const int row = row0 + ai * HALF + m * 16; const f32x4* sp = (const f32x4*)(ssp + (size_t)row * 16);
                const f32x4 s0 = sp[0], s1 = sp[1], s2 = sp[2], s3 = sp[3];
                const float ss = ((s0[0] + s0[1]) + (s0[2] + s0[3])) + ((s1[0] + s1[1]) + (s1[2] + s1[3])) + ((s2[0] + s2[1]) + (s2[2] + s2[3])) + ((s3[0] + s3[1]) + (s3[2] + s3[3]));
                const float rs = 1.0f / sqrtf(ss * (1.0f / 1024.0f) + EPS);
                bf16* rowp = O + (size_t)row * ldc + col0;
#pragma unroll
                for (int bj = 0; bj < 2; ++bj) { const f32x4 v0 = acc[ai][bj][m][0] * rs, v1 = acc[ai][bj][m][1] * rs;
                    u32x4 w; w.x = cvt_pk_bf16(v0[0], v0[1]); w.y = cvt_pk_bf16(v0[2], v0[3]); w.z = cvt_pk_bf16(v1[0], v1[1]); w.w = cvt_pk_bf16(v1[2], v1[3]);
                    *(u32x4*)(rowp + bj * HALF) = w; }
                asm volatile("" ::: "memory"); }
    }
};
struct EpiF32 {
    static constexpr bool PERM = false;
    float* C; int ldc;
    DI void operator()(const f32x4 (&acc)[2][2][4][2], const Unit& u, int wr, int wc, int fr, int fq) const {
        const int row0 = u.pm * BM + wr * 64 + fr, col0 = u.pn * BM + wc * 32 + 4 * fq;
#pragma unroll
        for (int ai = 0; ai < 2; ++ai)
#pragma unroll
            for (int m = 0; m < 4; ++m) { float* rowp = C + (size_t)(row0 + ai * HALF + m * 16) * ldc + col0;
#pragma unroll
                for (int bj = 0; bj < 2; ++bj)
#pragma unroll
                    for (int n = 0; n < 2; ++n) *(f32x4*)(rowp + bj * HALF + n * 16) = acc[ai][bj][m][n]; }
    }
};
struct EpiBranch {
    static constexpr bool PERM = true;
    const bf16* proj; float* macc; bf16* merged;
    DI void operator()(const f32x4 (&acc)[2][2][4][2], const Unit& u, int wr, int wc, int fr, int fq) const {
        const int row0 = u.pm * BM + wr * 64 + fr, col0 = u.pn * BM + wc * 32 + 8 * fq;
#pragma unroll
        for (int ai = 0; ai < 2; ++ai)
#pragma unroll
            for (int m = 0; m < 4; ++m) { const int row = row0 + ai * HALF + m * 16;
#pragma unroll
                for (int bj = 0; bj < 2; ++bj) { const int col = col0 + bj * HALF;
                    const u32x4 gw = *(const u32x4*)(proj + (size_t)row * PC + C_GATE + u.z * 1024 + col);
                    f32x4 v0 = acc[ai][bj][m][0], v1 = acc[ai][bj][m][1];
                    v0[0] *= sigmoidf_(bflo(gw.x)); v0[1] *= sigmoidf_(bfhi(gw.x)); v0[2] *= sigmoidf_(bflo(gw.y)); v0[3] *= sigmoidf_(bfhi(gw.y));
                    v1[0] *= sigmoidf_(bflo(gw.z)); v1[1] *= sigmoidf_(bfhi(gw.z)); v1[2] *= sigmoidf_(bflo(gw.w)); v1[3] *= sigmoidf_(bfhi(gw.w));
                    float* mp = macc + (size_t)row * 1024 + col;
                    if (u.z > 0) { v0 += *(const f32x4*)mp; v1 += *(const f32x4*)(mp + 4); }
                    if (u.z < 2) { *(f32x4*)mp = v0; *(f32x4*)(mp + 4) = v1; }
                    else { u32x4 w; w.x = cvt_pk_bf16(v0[0], v0[1]); w.y = cvt_pk_bf16(v0[2], v0[3]); w.z = cvt_pk_bf16(v1[0], v1[1]); w.w = cvt_pk_bf16(v1[2], v1[3]);
                        *(u32x4*)(merged + (size_t)row * 1024 + col) = w; } }
                asm volatile("" ::: "memory"); }
    }
};
struct EpiOut {
    static constexpr bool PERM = true;
    const float* x; float* x1; bf16* xg; const float* gffn; float* ssp;
    DI void operator()(const f32x4 (&acc)[2][2][4][2], const Unit& u, int wr, int wc, int fr, int fq) const {
        const int row0 = u.pm * BM + wr * 64 + fr, col0 = u.pn * BM + wc * 32 + 8 * fq;
        f32x4 g0[2], g1[2];
#pragma unroll
        for (int bj = 0; bj < 2; ++bj) { g0[bj] = *(const f32x4*)(gffn + col0 + bj * HALF); g1[bj] = *(const f32x4*)(gffn + col0 + bj * HALF + 4); }
#pragma unroll
        for (int ai = 0; ai < 2; ++ai)
#pragma unroll
            for (int m = 0; m < 4; ++m) { const int row = row0 + ai * HALF + m * 16; float ss = 0.f;
#pragma unroll
                for (int bj = 0; bj < 2; ++bj) { const size_t off = (size_t)row * 1024 + col0 + bj * HALF;
                    const f32x4 v0 = acc[ai][bj][m][0] + *(const f32x4*)(x + off), v1 = acc[ai][bj][m][1] + *(const f32x4*)(x + off + 4);
                    *(f32x4*)(x1 + off) = v0; *(f32x4*)(x1 + off + 4) = v1;
                    ss += (v0[0] * v0[0] + v0[1] * v0[1]) + (v0[2] * v0[2] + v0[3] * v0[3]) + (v1[0] * v1[0] + v1[1] * v1[1]) + (v1[2] * v1[2] + v1[3] * v1[3]);
                    const f32x4 a = v0 * g0[bj], b = v1 * g1[bj];
                    u32x4 w; w.x = cvt_pk_bf16(a[0], a[1]); w.y = cvt_pk_bf16(a[2], a[3]); w.z = cvt_pk_bf16(b[0], b[1]); w.w = cvt_pk_bf16(b[2], b[3]);
                    *(u32x4*)(xg + off) = w; }
                ss += __shfl_xor(ss, 16); ss += __shfl_xor(ss, 32);
                if (fq == 0) ssp[(size_t)row * 16 + u.pn * 4 + wc] = ss;
                asm volatile("" ::: "memory"); }
    }
};
}

#define XB_TMO      128
#define XB_XCNT(j)  (256  + 64 * (j))
#define XB_XSUB(j)  (1280 + 64 * (j))
#define XB_XGEN(j)  (2304 + 64 * (j))
#define XB_TOP      3328
#define XB_TOPGEN   3392
#define XCD_BAR_WORDS 3456
#define XB_SPIN_CAP (1u << 18)
constexpr int CW_BAR = 4096;

DI unsigned xb_ld(unsigned* p)              { return __hip_atomic_load(p, __ATOMIC_RELAXED, __HIP_MEMORY_SCOPE_AGENT); }
DI unsigned xb_add(unsigned* p, unsigned v) { return __hip_atomic_fetch_add(p, v, __ATOMIC_RELAXED, __HIP_MEMORY_SCOPE_AGENT); }
DI unsigned xb_xcc_id() { return (unsigned)__builtin_amdgcn_s_getreg((3 << 11) | 20) & 0xFu; }
#define XB_SPIN(cond, bar) do { unsigned _sp = 0; while (cond) { __builtin_amdgcn_s_sleep(1); \
    if ((++_sp & 255u) == 0u) { if (xb_ld(&(bar)[XB_TMO])) break; if (_sp > XB_SPIN_CAP) { atomicAdd(&(bar)[XB_TMO], 1u); break; } } } } while (0)

struct XcdBarrier { unsigned* bar; unsigned x; volatile LAS unsigned* st; };

DI XcdBarrier xcd_barrier_post(unsigned* bar, volatile LAS unsigned* st) {
    XcdBarrier b; b.bar = bar; b.x = xb_xcc_id(); b.st = st;
    if (threadIdx.x == 0) (void)xb_add(&bar[XB_XCNT(b.x)], 1u);
    return b;
}
DI void xcd_barrier_complete(unsigned* bar, unsigned x, unsigned& nloc, unsigned& nx) {
    const unsigned G = gridDim.x * gridDim.y * gridDim.z;
    unsigned sum, cnt, mine, sp = 0u;
    for (;;) {
        sum = 0u; cnt = 0u; mine = 0u;
#pragma unroll
        for (unsigned j = 0; j < 16; ++j) { const unsigned c = xb_ld(&bar[XB_XCNT(j)]); sum += c; cnt += (c > 0u) ? 1u : 0u; mine = (j == x) ? c : mine; }
        if (sum == G) break;
        __builtin_amdgcn_s_sleep(1);
        if ((++sp & 255u) == 0u) { if (xb_ld(&bar[XB_TMO])) break; if (sp > XB_SPIN_CAP) { atomicAdd(&bar[XB_TMO], 1u); break; } }
    }
    nloc = mine > 0u ? mine : 1u; nx = cnt > 0u ? cnt : 1u;
}
DI void xcd_barrier(const XcdBarrier& b) {
    asm volatile("s_waitcnt vmcnt(0)" ::: "memory");
    __syncthreads();
    if (threadIdx.x == 0) {
        unsigned* bar = b.bar;
        __builtin_amdgcn_s_waitcnt(0);
        unsigned nloc = b.st[0], nx = b.st[1];
        if (nloc == 0u) { xcd_barrier_complete(bar, b.x, nloc, nx); b.st[0] = nloc; b.st[1] = nx; }
        const unsigned old = xb_add(&bar[XB_XSUB(b.x)], 1u);
        const unsigned gen = old / nloc;
        if (old + 1u == (gen + 1u) * nloc) {
            __builtin_amdgcn_fence(__ATOMIC_RELEASE, "agent");
            asm volatile("s_waitcnt vmcnt(0)" ::: "memory");
            const unsigned og = xb_add(&bar[XB_TOP], 1u);
            const unsigned tg = og / nx;
            if (og + 1u == (tg + 1u) * nx) xb_add(&bar[XB_TOPGEN], 1u);
            else XB_SPIN(xb_ld(&bar[XB_TOPGEN]) == tg, bar);
            __builtin_amdgcn_fence(__ATOMIC_ACQUIRE, "agent");
            xb_add(&bar[XB_XGEN(b.x)], 1u);
            asm volatile("s_waitcnt vmcnt(0)" ::: "memory");
        } else {
            XB_SPIN(xb_ld(&bar[XB_XGEN(b.x)]) == gen, bar);
            __builtin_amdgcn_fence(__ATOMIC_ACQUIRE, "agent");
            asm volatile("s_waitcnt vmcnt(0)" ::: "memory");
        }
    }
    __syncthreads();
}

struct Frame {
    LAS unsigned char* lds;
    int tid, lane, wave;
    DI void refresh() { int t = threadIdx.x; asm volatile("" : "+v"(t)); tid = t; lane = t & 63; wave = __builtin_amdgcn_readfirstlane(t >> 6); }
    int vcu, G;
    const float *x, *mem, *norm_mix_g, *w_in, *hg_lb, *hg_norm_g, *sc_conv_w, *mem_norm_g, *w_mem_kv, *w_branch, *w_out, *norm_ffn_g, *peer_w_q, *peer_sub_keys, *peer_u, *peer_v, *final_norm_g;
    float* out; unsigned char* ws;
};

DI void p0_transpose_item(const float* W, int K, int N, bf16* WT, LAS float* scr, int item, int lane) {
    const int nblk = N / 32, kb = item / nblk, nb = item % nblk, k0 = 64 * kb, n0 = 32 * nb;
#pragma unroll 8
    for (int i = 0; i < 32; ++i) { const int kk = 2 * i + (lane >> 5); scr[kk * 33 + (lane & 31)] = W[(size_t)(k0 + kk) * N + n0 + (lane & 31)]; }
    asm volatile("s_waitcnt lgkmcnt(0)" ::: "memory");
    const int c = lane & 7;
#pragma unroll
    for (int j = 0; j < 4; ++j) { const int n = (lane >> 3) + 8 * j; const LAS float* s = scr + (8 * c) * 33 + n;
        u32x4 o; o.x = pk2(s[0 * 33], s[1 * 33]); o.y = pk2(s[2 * 33], s[3 * 33]); o.z = pk2(s[4 * 33], s[5 * 33]); o.w = pk2(s[6 * 33], s[7 * 33]);
        *(u32x4*)(WT + (size_t)(n0 + n) * K + k0 + 8 * c) = o; }
    asm volatile("s_waitcnt lgkmcnt(0)" ::: "memory");
}
DI void rms_row_to_bf16(const float* xrow, const float* g, bf16* orow, int lane) {
    const f32x4* xr = (const f32x4*)xrow + lane; const f32x4* gr = (const f32x4*)g + lane;
    f32x4 v[4]; float s = 0.f;
#pragma unroll
    for (int j = 0; j < 4; ++j) { v[j] = xr[64 * j]; s += (v[j].x * v[j].x + v[j].y * v[j].y) + (v[j].z * v[j].z + v[j].w * v[j].w); }
    const float rstd = 1.0f / sqrtf(wave_sum(s) * (1.f / 1024.f) + EPS);
    unsigned long long* o8 = (unsigned long long*)orow + lane;
#pragma unroll
    for (int j = 0; j < 4; ++j) { const f32x4 gg = gr[64 * j]; const f32x4 y = v[j] * rstd * gg;
        o8[64 * j] = (unsigned long long)pk2(y.x, y.y) | ((unsigned long long)pk2(y.z, y.w) << 32); }
}
DI void p0_prologue(Frame& F) {
    F.refresh();
    LAS float* scr = (LAS float*)(F.lds + F.wave * 16384);
    const int gw = F.vcu * NWAVES + F.wave, NGW = F.G * NWAVES;
    unsigned char* ws = F.ws;
    constexpr int I_IN = (1024 / 64) * (PC / 32), I_KV = (1024 / 64) * (1024 / 32), I_BR = (512 / 64) * (1024 / 32), I_OUT = (1024 / 64) * (1024 / 32), I_Q = (1024 / 64) * (2048 / 32);
    constexpr int NITEMS = I_IN + I_KV + 3 * I_BR + I_OUT + I_Q;
    for (int it = gw; it < NITEMS; it += NGW) {
        int r = it;
        if (r < I_IN) { p0_transpose_item(F.w_in, 1024, PC, (bf16*)(ws + WS_WIN), scr, r, F.lane); continue; } r -= I_IN;
        if (r < I_KV) { p0_transpose_item(F.w_mem_kv, 1024, 1024, (bf16*)(ws + WS_WKV), scr, r, F.lane); continue; } r -= I_KV;
        if (r < 3 * I_BR) { const int n = r / I_BR; p0_transpose_item(F.w_branch + (size_t)n * 512 * 1024, 512, 1024, (bf16*)(ws + WS_WBR) + (size_t)n * 1024 * 512, scr, r % I_BR, F.lane); continue; } r -= 3 * I_BR;
        if (r < I_OUT) { p0_transpose_item(F.w_out, 1024, 1024, (bf16*)(ws + WS_WOUT), scr, r, F.lane); continue; } r -= I_OUT;
        p0_transpose_item(F.peer_w_q, 1024, 2048, (bf16*)(ws + WS_WQ), scr, r, F.lane);
    }
    const int gt = F.vcu * 512 + F.tid, NGT = F.G * 512;
    for (int it = gt; it < 8 * 256 * 32; it += NGT) {
        const int c8 = it & 31, row = (it >> 5) & 255, h = it >> 13, p = row >> 7, key = row & 127;
        u32x4 o = (u32x4){0u, 0u, 0u, 0u};
        if ((c8 >> 4) == p) { const float* s = F.peer_sub_keys + (((size_t)(h * 2 + p) * 128 + key) * 128 + (c8 & 15) * 8);
            const f32x4 a = *(const f32x4*)s, b = *(const f32x4*)(s + 4); o.x = pk2(a.x, a.y); o.y = pk2(a.z, a.w); o.z = pk2(b.x, b.y); o.w = pk2(b.z, b.w); }
        *(u32x4*)((bf16*)(ws + WS_KBD) + ((size_t)(h * 256 + row) * 256 + c8 * 8)) = o;
    }
    for (int it = gt; it < 1024; it += NGT) { const float a0 = F.hg_lb[it], a1 = F.hg_lb[1024 + it]; const float m = fmaxf(a0, a1); const float e0 = __expf(a0 - m), e1 = __expf(a1 - m);
        ((float*)(ws + WS_LB))[it] = e0 / (e0 + e1); }
    for (int m = gw; m < BATCH * NMEM; m += NGW) rms_row_to_bf16(F.mem + (size_t)m * 1024, F.mem_norm_g, (bf16*)(ws + WS_MN) + (size_t)m * 1024, F.lane);
    for (int m = gw; m < T_ALL; m += NGW) rms_row_to_bf16(F.x + (size_t)m * 1024, F.norm_mix_g, (bf16*)(ws + WS_XG) + (size_t)m * 1024, F.lane);
}

DI s16x4 tr16(const LAS unsigned char* p) { return __builtin_bit_cast(s16x4, __builtin_amdgcn_ds_read_tr16_b64_v4i16((LAS v4i16_t*)p)); }
DI bf16x8 cat8(s16x4 lo, s16x4 hi) { return __builtin_shufflevector(lo, hi, 0, 1, 2, 3, 4, 5, 6, 7); }
#define MFMA32(a, b, c) __builtin_amdgcn_mfma_f32_32x32x16_bf16((a), (b), (c), 0, 0, 0)
DI int crow(int reg, int h) { return (reg & 3) + 8 * (reg >> 2) + 4 * h; }
DI bf16x8 pack8(const f32x16& x, int s) {
    u32x4 p; p.x = cvtpk(x[8 * s], x[8 * s + 1]); p.y = cvtpk(x[8 * s + 2], x[8 * s + 3]); p.z = cvtpk(x[8 * s + 4], x[8 * s + 5]); p.w = cvtpk(x[8 * s + 6], x[8 * s + 7]);
    return __builtin_bit_cast(bf16x8, p);
}
constexpr int TS = 272;

DI void stage_tile(LAS unsigned char* tile, const bf16* src, int tid) {
#pragma unroll
    for (int i = 0; i < 2; ++i) { const int id = tid + 512 * i, c = id >> 4, ch = id & 15;
        *(LAS u32x4*)(tile + c * TS + ch * 16) = *(const u32x4*)(src + (size_t)c * PC + ch * 8); }
}
DI float touch_tile(const bf16* src, int i128) { return *(const float*)(src + (size_t)(i128 >> 1) * PC + (i128 & 1) * 64); }
DI void gate16(const LAS unsigned char* zt, int d, int tq, float lb, float (&L)[16], float (&kk)[16], float (&lf)[16]) {
    float run = 0.f; const float oml = 1.0f - lb;
#pragma unroll
    for (int i = 0; i < 16; ++i) { const float z = bf2f(((const LAS bf16*)(zt + (16 * tq + i) * TS))[d]); const float sg = sigmoidf_(z); const float f = lb + oml * sg;
        lf[i] = __logf(f); kk[i] = oml * (1.0f - sg); run += lf[i]; L[i] = run; }
}

DI void hgrn_a_item(Frame& F, int item, bool has_next) {
    F.refresh();
    constexpr int T_V = 0, T_KF = 17408, T_KB = 34816, TOT = 52224;
    LAS unsigned char* lds = F.lds;
    const int n = item & 31, h = (item >> 5) & 3, b = item >> 7;
    const bf16* proj = (const bf16*)(F.ws + WS_PROJ) + ((size_t)b * SEQ + n * CHUNK) * PC;
    const int tid = F.tid, d = tid & 127, tq = tid >> 7;
    const float* lbp = (const float*)(F.ws + WS_LB);
    const float lbf = lbp[h * 128 + d], lbb = lbp[512 + h * 128 + d];
    stage_tile(lds + T_V, proj + C_HI + h * 128, tid); stage_tile(lds + T_KF, proj + C_FF + h * 128, tid); stage_tile(lds + T_KB, proj + C_FB + h * 128, tid);
    float tch = 0.f;
    if (has_next) { const bf16* pn = proj + (size_t)CHUNK * PC + h * 128; const int i128 = tid & 127, wsel = tid >> 7; tch = touch_tile(pn + (wsel == 0 ? C_HI : wsel == 1 ? C_FF : C_FB), i128); }
    __syncthreads();
    float Lf[16], kf[16], lff[16], Lb[16], kb[16], lfb[16];
    gate16(lds + T_KF, d, tq, lbf, Lf, kf, lff);
    gate16(lds + T_KB, d, tq, lbb, Lb, kb, lfb);
    LAS float* tot = (LAS float*)(lds + TOT);
    tot[(0 * 4 + tq) * 128 + d] = Lf[15]; tot[(1 * 4 + tq) * 128 + d] = Lb[15];
    asm volatile("" :: "v"(tch));
    __syncthreads();
    const float tf0 = tot[0 * 128 + d], tf1 = tot[1 * 128 + d], tf2 = tot[2 * 128 + d], tf3 = tot[3 * 128 + d];
    const float tb0 = tot[4 * 128 + d], tb1 = tot[5 * 128 + d], tb2 = tot[6 * 128 + d], tb3 = tot[7 * 128 + d];
    const float offf = (tq > 0 ? tf0 : 0.f) + (tq > 1 ? tf1 : 0.f) + (tq > 2 ? tf2 : 0.f), glf = (tf0 + tf1) + (tf2 + tf3);
    const float offb = (tq < 1 ? tb1 : 0.f) + (tq < 2 ? tb2 : 0.f) + (tq < 3 ? tb3 : 0.f), glb = (tb0 + tb1) + (tb2 + tb3);
    const float tbq = Lb[15];
#pragma unroll
    for (int i = 0; i < 16; ++i) { const int c = 16 * tq + i;
        const float G = offf + Lf[i]; const float kd = kf[i] * __expf(glf - G);
        const float Gb = offb + (tbq - Lb[i] + lfb[i]); const float kdb = kb[i] * __expf(glb - Gb);
        ((LAS bf16*)(lds + T_KF + c * TS))[d] = (bf16)f2bf(kd); ((LAS bf16*)(lds + T_KB + c * TS))[d] = (bf16)f2bf(kdb); }
    if (tq == 0) { float* dec = (float*)(F.ws + WS_DEC) + (size_t)item * 256; dec[d] = __expf(glf); dec[128 + d] = __expf(glb); }
    __syncthreads();
    const int w = F.wave, lane = F.lane, r = lane & 31, hh = lane >> 5, blk = (lane >> 4) & 1, q = (lane & 15) >> 2, p = lane & 3;
    const int dt = w >> 1, et0 = (w & 1) * 2;
#pragma unroll
    for (int dir = 0; dir < 2; ++dir) { const int TK = dir ? T_KB : T_KF;
#pragma unroll
        for (int e2 = 0; e2 < 2; ++e2) { const int et = et0 + e2; f32x16 acc;
#pragma unroll
            for (int i = 0; i < 16; ++i) acc[i] = 0.f;
#pragma unroll
            for (int ks = 0; ks < 4; ++ks) {
                const LAS unsigned char* ap = lds + TK + (16 * ks + 8 * hh + q) * TS + (32 * dt + 16 * blk + 4 * p) * 2;
                const LAS unsigned char* bp = lds + T_V + (16 * ks + 8 * hh + q) * TS + (32 * et + 16 * blk + 4 * p) * 2;
                const bf16x8 a = cat8(tr16(ap), tr16(ap + 4 * TS)), bq = cat8(tr16(bp), tr16(bp + 4 * TS));
                acc = MFMA32(a, bq, acc); }
            bf16* dsb = (bf16*)(F.ws + WS_DS) + ((size_t)(item * 2 + dir) * 128 + 32 * et + r) * 128 + 32 * dt + 4 * hh;
#pragma unroll
            for (int g4 = 0; g4 < 4; ++g4) { u32x2 wv; wv.x = cvtpk(acc[4 * g4], acc[4 * g4 + 1]); wv.y = cvtpk(acc[4 * g4 + 2], acc[4 * g4 + 3]); *(u32x2*)(dsb + 8 * g4) = wv; } } }
    __syncthreads();
}

DI void hgrn_scan(Frame& F) {
    F.refresh();
    const bf16* dS = (const bf16*)(F.ws + WS_DS); bf16* Sst = (bf16*)((unsigned char*)F.out + OUT_SST); const float* dec = (const float*)(F.ws + WS_DEC);
    const int gt = F.vcu * 512 + F.tid, NGT = F.G * 512;
    for (int id = gt; id < BG * 4 * 2 * 128 * 32; id += NGT) {
        const int d4 = id & 31, e = (id >> 5) & 127, dir = (id >> 12) & 1, bh = id >> 13;
        f32x4 S = (f32x4){0.f, 0.f, 0.f, 0.f};
#pragma unroll 4
        for (int s = 0; s < 32; ++s) { const int n = dir ? 31 - s : s, item = bh * 32 + n;
            const size_t off = ((size_t)(item * 2 + dir) * 128 + e) * 128 + d4 * 4;
            u32x2 o; o.x = cvtpk(S.x, S.y); o.y = cvtpk(S.z, S.w); *(u32x2*)(Sst + off) = o;
            const f32x4 dc = *(const f32x4*)(dec + (size_t)(item * 2 + dir) * 128 + d4 * 4);
            const u32x2 wv = *(const u32x2*)(dS + off);
            S.x = dc.x * S.x + bflo(wv.x); S.y = dc.y * S.y + bfhi(wv.x); S.z = dc.z * S.z + bflo(wv.y); S.w = dc.w * S.w + bfhi(wv.y); }
    }
}

DI void hgrn_c_item(Frame& F, int item, bool has_next) {
    F.refresh();
    constexpr int T_QRF = 0, T_KRF = 17408, T_QGF = 34816, T_QRB = 52224, T_KRB = 69632, T_QGB = 87040, T_V = 104448, TOT = 121856, O_OFF = 0, OS = 132;
    LAS unsigned char* lds = F.lds;
    const int n = item & 31, h = (item >> 5) & 3, b = item >> 7;
    const size_t row0 = (size_t)b * SEQ + n * CHUNK;
    const bf16* proj = (const bf16*)(F.ws + WS_PROJ) + row0 * PC;
    const int tid = F.tid, d = tid & 127, tq = tid >> 7;
    const float* lbp = (const float*)(F.ws + WS_LB);
    const float lbf = lbp[h * 128 + d], lbb = lbp[512 + h * 128 + d];
    stage_tile(lds + T_V, proj + C_HI + h * 128, tid); stage_tile(lds + T_KRF, proj + C_FF + h * 128, tid); stage_tile(lds + T_KRB, proj + C_FB + h * 128, tid); stage_tile(lds + T_QRF, proj + C_HQ + h * 128, tid);
    float tch = 0.f, tch2 = 0.f;
    if (has_next) { const bf16* pn = proj + (size_t)CHUNK * PC + h * 128; const int i128 = tid & 127, wsel = tid >> 7; tch = touch_tile(pn + (wsel == 0 ? C_HI : wsel == 1 ? C_FF : wsel == 2 ? C_FB : C_HQ), i128);
        tch2 = *(const float*)((const unsigned char*)F.out + OUT_SST + (size_t)(item + 1) * 65536 + (size_t)tid * 128); }
    __syncthreads();
    float qv[16];
#pragma unroll
    for (int i = 0; i < 16; ++i) { const float z = bf2f(((const LAS bf16*)(lds + T_QRF + (16 * tq + i) * TS))[d]); qv[i] = z * sigmoidf_(z); }
    float Lf[16], kf[16], lff[16], Lb[16], kb[16], lfb[16];
    gate16(lds + T_KRF, d, tq, lbf, Lf, kf, lff);
    gate16(lds + T_KRB, d, tq, lbb, Lb, kb, lfb);
    LAS float* tot = (LAS float*)(lds + TOT);
    tot[(0 * 4 + tq) * 128 + d] = Lf[15]; tot[(1 * 4 + tq) * 128 + d] = Lb[15];
    asm volatile("" :: "v"(tch), "v"(tch2));
    __syncthreads();
    {
        const float tf0 = tot[0 * 128 + d], tf1 = tot[1 * 128 + d], tf2 = tot[2 * 128 + d];
        const float tb1 = tot[5 * 128 + d], tb2 = tot[6 * 128 + d], tb3 = tot[7 * 128 + d];
        const float offf = (tq > 0 ? tf0 : 0.f) + (tq > 1 ? tf1 : 0.f) + (tq > 2 ? tf2 : 0.f), greff = tf0 + tf1;
        const float offb = (tq < 1 ? tb1 : 0.f) + (tq < 2 ? tb2 : 0.f) + (tq < 3 ? tb3 : 0.f), grefb = tb2 + tb3;
        const float tbq = Lb[15];
#pragma unroll
        for (int i = 0; i < 16; ++i) { const int c = 16 * tq + i;
            const float G = offf + Lf[i]; const float x = G - greff;
            ((LAS bf16*)(lds + T_QRF + c * TS))[d] = (bf16)f2bf(qv[i] * __expf(x)); ((LAS bf16*)(lds + T_KRF + c * TS))[d] = (bf16)f2bf(kf[i] * __expf(-x)); ((LAS bf16*)(lds + T_QGF + c * TS))[d] = (bf16)f2bf(qv[i] * __expf(G));
            const float Gb = offb + (tbq - Lb[i] + lfb[i]); const float xb = Gb - grefb;
            ((LAS bf16*)(lds + T_QRB + c * TS))[d] = (bf16)f2bf(qv[i] * __expf(xb)); ((LAS bf16*)(lds + T_KRB + c * TS))[d] = (bf16)f2bf(kb[i] * __expf(-xb)); ((LAS bf16*)(lds + T_QGB + c * TS))[d] = (bf16)f2bf(qv[i] * __expf(Gb)); }
    }
    __syncthreads();
    const int w = F.wave, lane = F.lane, r = lane & 31, hh = lane >> 5, blk = (lane >> 4) & 1, q = (lane & 15) >> 2, p = lane & 3;
    const int ct = w >> 2, et = w & 3;
    const bf16* Sst = (const bf16*)((const unsigned char*)F.out + OUT_SST);
    f32x16 o;
#pragma unroll
    for (int i = 0; i < 16; ++i) o[i] = 0.f;
#pragma unroll
    for (int dir = 0; dir < 2; ++dir) { const int TQR = dir ? T_QRB : T_QRF, TKR = dir ? T_KRB : T_KRF, TQG = dir ? T_QGB : T_QGF;
#pragma unroll
        for (int st = 0; st < 2; ++st) {
            if (dir == 0 ? (st > ct) : (st < ct)) continue;
            f32x16 X;
#pragma unroll
            for (int i = 0; i < 16; ++i) X[i] = 0.f;
#pragma unroll
            for (int ks = 0; ks < 8; ++ks) { const bf16x8 a = *(const LAS bf16x8*)(lds + TKR + (32 * st + r) * TS + (16 * ks + 8 * hh) * 2), bq = *(const LAS bf16x8*)(lds + TQR + (32 * ct + r) * TS + (16 * ks + 8 * hh) * 2);
                X = MFMA32(a, bq, X); }
            const int cc = 32 * ct + r;
#pragma unroll
            for (int i = 0; i < 16; ++i) { const int s = 32 * st + crow(i, hh); const bool keep = dir == 0 ? (s <= cc) : (s >= cc); X[i] = keep ? X[i] : 0.f; }
#pragma unroll
            for (int s2 = 0; s2 < 2; ++s2) { const bf16x8 xs = pack8(X, s2);
                const LAS unsigned char* vp = lds + T_V + (32 * st + 16 * s2 + 4 * hh + q) * TS + (32 * et + 16 * blk + 4 * p) * 2;
                const bf16x8 pb = cat8(tr16(vp), tr16(vp + 8 * TS));
                o = MFMA32(xs, pb, o); }
        }
        const bf16* sp = Sst + ((size_t)(item * 2 + dir) * 128 + 32 * et + r) * 128 + 8 * hh;
#pragma unroll
        for (int ks = 0; ks < 8; ++ks) { const bf16x8 a = *(const LAS bf16x8*)(lds + TQG + (32 * ct + r) * TS + (16 * ks + 8 * hh) * 2); const bf16x8 bq = *(const bf16x8*)(sp + 16 * ks);
            o = MFMA32(a, bq, o); }
    }
    __syncthreads();
    LAS float* O = (LAS float*)(lds + O_OFF);
#pragma unroll
    for (int i = 0; i < 16; ++i) O[(32 * ct + crow(i, hh)) * OS + 32 * et + r] = o[i];
    __syncthreads();
    const float g0 = F.hg_norm_g[h * 128 + 2 * lane], g1 = F.hg_norm_g[h * 128 + 2 * lane + 1];
    bf16* yhg = (bf16*)(F.ws + WS_YHG);
#pragma unroll
    for (int k = 0; k < 8; ++k) { const int c = 8 * w + k; const f32x2 v = *(const LAS f32x2*)(O + c * OS + 2 * lane);
        const float ss = wave_sum(v.x * v.x + v.y * v.y); const float rstd = 1.0f / sqrtf(ss * (1.0f / 128.0f) + EPS);
        const unsigned hw = *(const unsigned*)(proj + (size_t)c * PC + C_HG + h * 128 + 2 * lane); const float z0 = bflo(hw), z1 = bfhi(hw);
        const float y0 = v.x * rstd * g0 * (z0 * sigmoidf_(z0)), y1 = v.y * rstd * g1 * (z1 * sigmoidf_(z1));
        *(unsigned*)(yhg + (row0 + c) * 512 + h * 128 + 2 * lane) = cvtpk(y0, y1); }
    __syncthreads();
}

DI void attn_item(Frame& F, int g, int item) {
    F.refresh();
    constexpr int KS = 272, VS = 528, K_OFF = 0, V_OFF = 69632;
    LAS unsigned char* lds = F.lds;
    const int qb = item & 7, h = (item >> 3) & 3, b = item >> 5, bglob = g * BG + b;
    const bf16* Km = (const bf16*)(F.ws + WS_KMEM) + (size_t)bglob * 256 * 512 + h * 128;
    const bf16* VT = (const bf16*)(F.ws + WS_VT) + (size_t)(h * 128) * 4096 + bglob * 256;
    const int tid = F.tid;
#pragma unroll
    for (int i = 0; i < 8; ++i) { const int id = tid + 512 * i, key = id >> 4, ch = id & 15;
        *(LAS u32x4*)(lds + K_OFF + key * KS + ch * 16) = *(const u32x4*)(Km + (size_t)key * 512 + ch * 8); }
#pragma unroll
    for (int i = 0; i < 8; ++i) { const int id = tid + 512 * i, e = id >> 5, ch = id & 31;
        *(LAS u32x4*)(lds + V_OFF + e * VS + ch * 16) = *(const u32x4*)(VT + (size_t)e * 4096 + ch * 8); }
    __syncthreads();
    const int w = F.wave, lane = F.lane, r = lane & 31, hh = lane >> 5;
    const size_t qrow0 = (size_t)b * SEQ + qb * 256 + w * 32;
    const bf16* proj = (const bf16*)(F.ws + WS_PROJ);
    bf16x8 qf[8];
#pragma unroll
    for (int ks = 0; ks < 8; ++ks) qf[ks] = *(const bf16x8*)(proj + (qrow0 + r) * PC + C_MQ + h * 128 + 16 * ks + 8 * hh);
    const float scale = 0.08838834764831845f;
    float m_run = -INFINITY, l_run = 0.f;
#pragma unroll 1
    for (int kt = 0; kt < 8; ++kt) {
        f32x16 X;
#pragma unroll
        for (int i = 0; i < 16; ++i) X[i] = 0.f;
#pragma unroll
        for (int ks = 0; ks < 8; ++ks) { const bf16x8 a = *(const LAS bf16x8*)(lds + K_OFF + (32 * kt + r) * KS + (16 * ks + 8 * hh) * 2); X = MFMA32(a, qf[ks], X); }
        float tm = X[0];
#pragma unroll
        for (int i = 1; i < 16; ++i) tm = fmaxf(tm, X[i]);
        tm *= scale;
        const float mn = fmaxf(m_run, tm); float ls = 0.f;
#pragma unroll
        for (int i = 0; i < 16; ++i) ls += __expf(X[i] * scale - mn);
        l_run = l_run * __expf(m_run - mn) + ls; m_run = mn;
    }
    { const float mo = __shfl_xor(m_run, 32), lo = __shfl_xor(l_run, 32); const float m = fmaxf(m_run, mo);
      l_run = l_run * __expf(m_run - m) + lo * __expf(mo - m); m_run = m; }
    const float inv_l = 1.0f / l_run;
    f32x16 O[4];
#pragma unroll
    for (int e = 0; e < 4; ++e)
#pragma unroll
        for (int i = 0; i < 16; ++i) O[e][i] = 0.f;
#pragma unroll 1
    for (int kt = 0; kt < 8; ++kt) {
        f32x16 X;
#pragma unroll
        for (int i = 0; i < 16; ++i) X[i] = 0.f;
#pragma unroll
        for (int ks = 0; ks < 8; ++ks) { const bf16x8 a = *(const LAS bf16x8*)(lds + K_OFF + (32 * kt + r) * KS + (16 * ks + 8 * hh) * 2); X = MFMA32(a, qf[ks], X); }
#pragma unroll
        for (int i = 0; i < 16; ++i) X[i] = __expf(X[i] * scale - m_run) * inv_l;
#pragma unroll
        for (int s2 = 0; s2 < 2; ++s2) { const bf16x8 xs = pack8(X, s2);
#pragma unroll
            for (int e = 0; e < 4; ++e) { const LAS unsigned char* vp = lds + V_OFF + (32 * e + r) * VS + (32 * kt + 16 * s2 + 4 * hh) * 2;
                const bf16x8 pb = cat8(*(const LAS s16x4*)vp, *(const LAS s16x4*)(vp + 16));
                O[e] = MFMA32(xs, pb, O[e]); } }
    }
    bf16* ymx = (bf16*)(F.ws + WS_YMX);
#pragma unroll
    for (int e = 0; e < 4; ++e)
#pragma unroll
        for (int i = 0; i < 16; ++i) ymx[(qrow0 + crow(i, hh)) * 512 + h * 128 + 32 * e + r] = (bf16)f2bf(O[e][i]);
    __syncthreads();
}

DI void conv_phase(Frame& F) {
    F.refresh();
    const bf16* proj = (const bf16*)(F.ws + WS_PROJ); bf16* ysc = (bf16*)(F.ws + WS_YSC); const float* cw = F.sc_conv_w;
    const int gt = F.vcu * 512 + F.tid, NGT = F.G * 512;
    for (int id = gt; id < TG * 64; id += NGT) {
        const int c8 = id & 63, t = id >> 6, ts = t & (SEQ - 1);
        const bf16* pr = proj + (size_t)t * PC + c8 * 8;
        const u32x4 z4 = (u32x4){0u, 0u, 0u, 0u};
        const u32x4 sb = *(const u32x4*)(pr + C_SB), c1 = *(const u32x4*)(pr + C_SC), h1 = *(const u32x4*)(pr + C_SH);
        const u32x4 c0 = ts > 0 ? *(const u32x4*)(pr - PC + C_SC) : z4, h0 = ts > 0 ? *(const u32x4*)(pr - PC + C_SH) : z4;
        const u32x4 c2 = ts < SEQ - 1 ? *(const u32x4*)(pr + PC + C_SC) : z4, h2 = ts < SEQ - 1 ? *(const u32x4*)(pr + PC + C_SH) : z4;
        const f32x4 wa0 = *(const f32x4*)(cw + c8 * 8), wa1 = *(const f32x4*)(cw + c8 * 8 + 4), wb0 = *(const f32x4*)(cw + 512 + c8 * 8), wb1 = *(const f32x4*)(cw + 512 + c8 * 8 + 4),
                    wc0 = *(const f32x4*)(cw + 1024 + c8 * 8), wc1 = *(const f32x4*)(cw + 1024 + c8 * 8 + 4);
        float y[8];
#pragma unroll
        for (int k = 0; k < 4; ++k) {
            const float w0l = k < 2 ? wa0[2 * k] : wa1[2 * k - 4], w0h = k < 2 ? wa0[2 * k + 1] : wa1[2 * k - 3];
            const float w1l = k < 2 ? wb0[2 * k] : wb1[2 * k - 4], w1h = k < 2 ? wb0[2 * k + 1] : wb1[2 * k - 3];
            const float w2l = k < 2 ? wc0[2 * k] : wc1[2 * k - 4], w2h = k < 2 ? wc0[2 * k + 1] : wc1[2 * k - 3];
            y[2 * k]     = bflo(sb[k]) * (w0l * (bflo(c0[k]) * bflo(h0[k])) + w1l * (bflo(c1[k]) * bflo(h1[k])) + w2l * (bflo(c2[k]) * bflo(h2[k])));
            y[2 * k + 1] = bfhi(sb[k]) * (w0h * (bfhi(c0[k]) * bfhi(h0[k])) + w1h * (bfhi(c1[k]) * bfhi(h1[k])) + w2h * (bfhi(c2[k]) * bfhi(h2[k]))); }
        u32x4 o; o.x = cvtpk(y[0], y[1]); o.y = cvtpk(y[2], y[3]); o.z = cvtpk(y[4], y[5]); o.w = cvtpk(y[6], y[7]);
        *(u32x4*)(ysc + (size_t)t * 512 + c8 * 8) = o;
    }
}

DI unsigned ord_key(float v, int idx) { unsigned u = __builtin_bit_cast(unsigned, v); u ^= (u >> 31) ? 0xFFFFFFFFu : 0x80000000u; return (u & 0xFFFFFF80u) | (unsigned)(127 - idx); }
DI float key_val(unsigned k) { unsigned u = k & 0xFFFFFF80u; u = (u & 0x80000000u) ? (u ^ 0x80000000u) : ~u; return __builtin_bit_cast(float, u); }
DI float dot2bf(unsigned a, unsigned b, float c) { return __builtin_amdgcn_fdot2_f32_bf16(__builtin_bit_cast(bf16x2_t, a), __builtin_bit_cast(bf16x2_t, b), c, false); }
DI float dot8(const u32x4& a, const u32x4& b, float c) { c = dot2bf(a.x, b.x, c); c = dot2bf(a.y, b.y, c); c = dot2bf(a.z, b.z, c); return dot2bf(a.w, b.w, c); }
__host__ __device__ constexpr int cand_off(int i) { return i == 0 ? 0 : i == 1 ? 16 : i == 2 ? 24 : i == 3 ? 29 : i == 4 ? 33 : i == 5 ? 36 : i == 6 ? 38 : i == 7 ? 40 : 34 + i; }
__host__ __device__ constexpr int cand_i(int c) { return c < 16 ? 0 : c < 24 ? 1 : c < 29 ? 2 : c < 33 ? 3 : c < 36 ? 4 : c < 38 ? 5 : c < 40 ? 6 : c < 42 ? 7 : c - 34; }
__host__ __device__ constexpr int cand_pos(int c) { return cand_i(c) * 16 + (c - cand_off(cand_i(c))); }

template <int CTRL> DI unsigned dpp_u(unsigned v) { return (unsigned)__builtin_amdgcn_update_dpp(0, (int)v, CTRL, 0xF, 0xF, false); }
template <int CTRL> DI float dpp_f(float v) { return __builtin_bit_cast(float, __builtin_amdgcn_update_dpp(0, __builtin_bit_cast(int, v), CTRL, 0xF, 0xF, false)); }
DI float bperm_f(int addr, float v) { return __builtin_bit_cast(float, __builtin_amdgcn_ds_bpermute(addr, __builtin_bit_cast(int, v))); }
DI unsigned row_max16(unsigned m) { m = max(m, dpp_u<0xB1>(m)); m = max(m, dpp_u<0x4E>(m)); m = max(m, dpp_u<0x141>(m)); return max(m, dpp_u<0x140>(m)); }
DI float row_sum16(float v) { v += dpp_f<0xB1>(v); v += dpp_f<0x4E>(v); v += dpp_f<0x141>(v); return v + dpp_f<0x140>(v); }

DI void peer_topk(const float* srow, LAS int* widx, LAS float* wgate, int lane) {
    const int gq = lane >> 4, li = lane & 15;
    const int ci = cand_i(lane), cj = lane - cand_off(ci), cpos = ci * 16 + cj; const bool cvalid = lane < 50;
    const float* sl = srow + (gq >> 1) * 256 + (gq & 1) * 128 + li * 8;
    f32x4 nva = *(const f32x4*)sl, nvb = *(const f32x4*)(sl + 4);
#pragma unroll 1
    for (int hp = 0; hp < 4; ++hp) {
        const f32x4 va = nva, vb = nvb;
        if (hp < 3) { nva = *(const f32x4*)(sl + 512 * (hp + 1)); nvb = *(const f32x4*)(sl + 512 * (hp + 1) + 4); }
        unsigned k[8];
        k[0] = ord_key(va.x, li * 8 + 0); k[1] = ord_key(va.y, li * 8 + 1); k[2] = ord_key(va.z, li * 8 + 2); k[3] = ord_key(va.w, li * 8 + 3);
        k[4] = ord_key(vb.x, li * 8 + 4); k[5] = ord_key(vb.y, li * 8 + 5); k[6] = ord_key(vb.z, li * 8 + 6); k[7] = ord_key(vb.w, li * 8 + 7);
        unsigned mine = 0u;
#pragma unroll
        for (int rd = 0; rd < 16; ++rd) {
            const unsigned m = row_max16(max(max(max(k[0], k[1]), max(k[2], k[3])), max(max(k[4], k[5]), max(k[6], k[7]))));
            mine = (li == rd) ? m : mine;
#pragma unroll
            for (int j = 0; j < 8; ++j) k[j] = (k[j] == m) ? 0u : k[j];
        }
        const float sc = key_val(mine); const int ix = 127 - (int)(mine & 127u);
#pragma unroll
        for (int hsel = 0; hsel < 2; ++hsel) {
            const float a = __shfl(sc, 32 * hsel + ci), bq = __shfl(sc, 32 * hsel + 16 + cj);
            const int ia = __shfl(ix, 32 * hsel + ci), ib = __shfl(ix, 32 * hsel + 16 + cj);
            const float cs = a + bq;
            unsigned ck = __builtin_bit_cast(unsigned, cs); ck ^= (ck >> 31) ? 0xFFFFFFFFu : 0x80000000u; ck = cvalid ? ((ck & ~63u) | (unsigned)(63 - lane)) : 0u;
            int rank = 0;
#pragma unroll
            for (int c2 = 0; c2 < 50; ++c2) { const unsigned k2 = (unsigned)__builtin_amdgcn_readlane((int)ck, c2); rank += (int)(k2 > ck); }
            const bool sel = cvalid && rank < 16;
            const float mx = __builtin_bit_cast(float, __builtin_amdgcn_readlane(__builtin_bit_cast(int, cs), 0));
            const float ev = sel ? __expf(cs - mx) : 0.f;
            const float sum = wave_sum(ev);
            if (sel) { const int hd = 2 * hp + hsel; widx[hd * 16 + rank] = ia * 128 + ib; wgate[hd * 16 + rank] = ev / sum; }
        }
    }
}

constexpr float PEER_TAB_SCALE = 256.0f;
#ifndef PEER_PROBE
#define PEER_PROBE 0
#endif
DI void peer_phase(Frame& F, int tg) {
    F.refresh();
    const int gw = F.vcu * NWAVES + F.wave, NGW = F.G * NWAVES, lane = F.lane, gq = lane >> 4, li = lane & 15;
    LAS int* widx = (LAS int*)(F.lds + F.wave * 1024); LAS float* wgate = (LAS float*)(F.lds + F.wave * 1024 + 512);
    const unsigned char* U = F.ws + WS_U; const unsigned char* V = F.ws + WS_V;
    const int a4 = (lane ^ 4) << 2, a8 = (lane ^ 8) << 2, a16 = (lane ^ 16) << 2, a32 = (lane ^ 32) << 2;
    const bool b0 = lane & 1, b1 = lane & 2, b2 = lane & 4, b3 = lane & 8, b4 = lane & 16, b5 = lane & 32;
    for (int tl = gw; tl < TG; tl += NGW) {
        const size_t t = (size_t)tg * TG + tl;
        float tch0 = 0.f, tch1 = 0.f, tch2 = 0.f, tch3 = 0.f;
        if (tl + NGW < TG) { const size_t tn = t + NGW;
            tch0 = ((const float*)(F.ws + WS_S) + (size_t)(tl + NGW) * 2048)[lane * 32];
            tch1 = (F.out + tn * 1024)[(lane & 31) * 32];
            tch2 = ((const float*)((const bf16*)(F.ws + WS_XG) + tn * 1024))[(lane & 15) * 32];
            tch3 = ((const float*)(F.ws + WS_SSP) + tn * 16)[lane & 15]; }
        for (int rp_ = 0; rp_ < (PEER_PROBE == 1 ? 2 : 1); ++rp_) peer_topk((const float*)(F.ws + WS_S) + (size_t)tl * 2048, widx, wgate, lane);
        asm volatile("s_waitcnt lgkmcnt(0)" :: "v"(tch0), "v"(tch1), "v"(tch2), "v"(tch3) : "memory");
        const f32x4* sp = (const f32x4*)((const float*)(F.ws + WS_SSP) + t * 16);
        const f32x4 s0 = sp[0], s1 = sp[1], s2 = sp[2], s3 = sp[3];
        const float ssx = ((s0[0] + s0[1]) + (s0[2] + s0[3])) + ((s1[0] + s1[1]) + (s1[2] + s1[3])) + ((s2[0] + s2[1]) + (s2[2] + s2[3])) + ((s3[0] + s3[1]) + (s3[2] + s3[3]));
        const float ascale = (1.0f / sqrtf(ssx * (1.0f / 1024.0f) + EPS)) * (1.0f / PEER_TAB_SCALE);
        f32x2 of[8];
        for (int rg_ = 0; rg_ < (PEER_PROBE == 2 ? 2 : 1); ++rg_) {
#define PEER_LOADROW(buf, k) do { const int k_ = (k); const int e_ = widx[((k_ & 31) >> 4) * 64 + 4 * (k_ & 15) + gq]; const unsigned char* r_ = (k_ < 32 ? U : V) + (size_t)e_ * 1024 + 16 * li; \
        buf[0] = *(const u32x4*)(r_); buf[1] = *(const u32x4*)(r_ + 256); buf[2] = *(const u32x4*)(r_ + 512); buf[3] = *(const u32x4*)(r_ + 768); } while (0)
        u32x4 r0[4], r1[4], r2[4], r3[4];
        PEER_LOADROW(r0, 0); PEER_LOADROW(r1, 1); PEER_LOADROW(r2, 2); PEER_LOADROW(r3, 3);
        float totA = 0.f, totB = 0.f;
        {
            f32x2 hreg[4][8];
            const bf16* xr = (const bf16*)(F.ws + WS_XG) + t * 1024 + 16 * li;
#pragma unroll
            for (int c = 0; c < 4; ++c) { const u32x4 w0 = *(const u32x4*)(xr + 256 * c), w1 = *(const u32x4*)(xr + 256 * c + 8);
#pragma unroll
                for (int q = 0; q < 4; ++q) { hreg[c][q] = (f32x2){bflo(w0[q]), bfhi(w0[q])}; hreg[c][4 + q] = (f32x2){bflo(w1[q]), bfhi(w1[q])}; } }
#define PEER_DOT(dst, buf) do { f32x2 acc_ = (f32x2){0.f, 0.f}; _Pragma("unroll") for (int c = 0; c < 4; ++c) _Pragma("unroll") for (int q = 0; q < 4; ++q) { \
            acc_ = __builtin_amdgcn_cvt_pk_f32_fp8(buf[c][q], false) * hreg[c][2 * q] + acc_; acc_ = __builtin_amdgcn_cvt_pk_f32_fp8(buf[c][q], true) * hreg[c][2 * q + 1] + acc_; } dst = acc_.x + acc_.y; } while (0)
#pragma unroll 1
            for (int mi = 0; mi < 8; ++mi) {
                float p0, p1, p2, p3;
                PEER_DOT(p0, r0); __builtin_amdgcn_sched_barrier(0); PEER_LOADROW(r0, 4 * mi + 4); __builtin_amdgcn_sched_barrier(0);
                PEER_DOT(p1, r1); __builtin_amdgcn_sched_barrier(0); PEER_LOADROW(r1, 4 * mi + 5); __builtin_amdgcn_sched_barrier(0);
                PEER_DOT(p2, r2); __builtin_amdgcn_sched_barrier(0); PEER_LOADROW(r2, 4 * mi + 6); __builtin_amdgcn_sched_barrier(0);
                PEER_DOT(p3, r3); __builtin_amdgcn_sched_barrier(0); PEER_LOADROW(r3, 4 * mi + 7); __builtin_amdgcn_sched_barrier(0);
                const float qa = (b0 ? p1 : p0) + dpp_f<0xB1>(b0 ? p0 : p1), qb = (b0 ? p3 : p2) + dpp_f<0xB1>(b0 ? p2 : p3);
                float rr = (b1 ? qb : qa) + dpp_f<0x4E>(b1 ? qa : qb);
                rr += bperm_f(a4, rr); rr += bperm_f(a8, rr);
                const bool mine = (li >> 2) == (mi & 3);
                totA = (mine && mi < 4) ? rr : totA; totB = (mine && mi >= 4) ? rr : totB;
            }
        }
        float cfA, cfB;
        { const float av = totA * ascale; cfA = wgate[4 * li + gq] * (0.5f * av * (1.0f + erff(av * 0.70710678118654752f))) * (1.0f / PEER_TAB_SCALE); }
        { const float av = totB * ascale; cfB = wgate[64 + 4 * li + gq] * (0.5f * av * (1.0f + erff(av * 0.70710678118654752f))) * (1.0f / PEER_TAB_SCALE); }
        f32x2 o2[4][8];
#pragma unroll
        for (int c = 0; c < 4; ++c)
#pragma unroll
            for (int m = 0; m < 8; ++m) o2[c][m] = (f32x2){0.f, 0.f};
#define PEER_AXPY(buf, kk) do { const float cv_ = bperm_f(((lane & 48) | ((kk) & 15)) << 2, ((kk) & 16) ? cfB : cfA); const f32x2 cc_ = (f32x2){cv_, cv_}; \
            _Pragma("unroll") for (int c = 0; c < 4; ++c) _Pragma("unroll") for (int q = 0; q < 4; ++q) { \
            o2[c][2 * q] = __builtin_amdgcn_cvt_pk_f32_fp8(buf[c][q], false) * cc_ + o2[c][2 * q]; o2[c][2 * q + 1] = __builtin_amdgcn_cvt_pk_f32_fp8(buf[c][q], true) * cc_ + o2[c][2 * q + 1]; } } while (0)
#pragma unroll 1
        for (int mi = 0; mi < 8; ++mi) {
            const bool more = mi < 7;
            PEER_AXPY(r0, 4 * mi + 0); __builtin_amdgcn_sched_barrier(0); if (more) PEER_LOADROW(r0, 32 + 4 * mi + 4); __builtin_amdgcn_sched_barrier(0);
            PEER_AXPY(r1, 4 * mi + 1); __builtin_amdgcn_sched_barrier(0); if (more) PEER_LOADROW(r1, 32 + 4 * mi + 5); __builtin_amdgcn_sched_barrier(0);
            PEER_AXPY(r2, 4 * mi + 2); __builtin_amdgcn_sched_barrier(0); if (more) PEER_LOADROW(r2, 32 + 4 * mi + 6); __builtin_amdgcn_sched_barrier(0);
            PEER_AXPY(r3, 4 * mi + 3); __builtin_amdgcn_sched_barrier(0); if (more) PEER_LOADROW(r3, 32 + 4 * mi + 7); __builtin_amdgcn_sched_barrier(0);
        }
#undef PEER_LOADROW
#undef PEER_DOT
#undef PEER_AXPY
        f32x2 o1[2][8];
#pragma unroll
        for (int c = 0; c < 2; ++c)
#pragma unroll
            for (int m = 0; m < 8; ++m) { const f32x2 keep = b4 ? o2[c + 2][m] : o2[c][m], send = b4 ? o2[c][m] : o2[c + 2][m];
                o1[c][m] = keep + (f32x2){bperm_f(a16, send.x), bperm_f(a16, send.y)}; }
#pragma unroll
        for (int m = 0; m < 8; ++m) { const f32x2 keep = b5 ? o1[1][m] : o1[0][m], send = b5 ? o1[0][m] : o1[1][m];
            of[m] = keep + (f32x2){bperm_f(a32, send.x), bperm_f(a32, send.y)}; }
#pragma unroll
        for (int m = 0; m < 8; ++m) asm volatile("" : "+v"(of[m].x), "+v"(of[m].y));
        }
        const int cidx = (b4 ? 2 : 0) + (b5 ? 1 : 0);
        float* xo = F.out + t * 1024 + 256 * cidx + 16 * li; const float* gfp = F.final_norm_g + 256 * cidx + 16 * li;
        f32x4 a[4]; float ss = 0.f;
#pragma unroll
        for (int k = 0; k < 4; ++k) { a[k] = *(const f32x4*)(xo + 4 * k) + (f32x4){of[2 * k].x, of[2 * k].y, of[2 * k + 1].x, of[2 * k + 1].y};
            ss += (a[k].x * a[k].x + a[k].y * a[k].y) + (a[k].z * a[k].z + a[k].w * a[k].w); }
        ss = wave_sum(ss);
        const float rf = 1.0f / sqrtf(ss * (1.0f / 1024.0f) + EPS);
#pragma unroll
        for (int k = 0; k < 4; ++k) *(f32x4*)(xo + 4 * k) = a[k] * rf * *(const f32x4*)(gfp + 4 * k);
        asm volatile("s_waitcnt lgkmcnt(0)" ::: "memory");
    }
}

DI void convert_uv(Frame& F) {
    F.refresh();
    const int gt = F.vcu * 512 + F.tid, NGT = F.G * 512;
    for (int id = gt; id < 2 * 16384 * 64; id += NGT) {
        const int which = id >> 20, off = (id & ((1 << 20) - 1)) * 16;
        const float* src = (which ? F.peer_v : F.peer_u) + off; unsigned char* dst = F.ws + (which ? WS_V : WS_U) + off;
        u32x4 o;
#pragma unroll
        for (int q = 0; q < 4; ++q) { const f32x4 v = *(const f32x4*)(src + 4 * q) * PEER_TAB_SCALE; int pk = __builtin_amdgcn_cvt_pk_fp8_f32(v.x, v.y, 0, false); pk = __builtin_amdgcn_cvt_pk_fp8_f32(v.z, v.w, pk, true); o[q] = (unsigned)pk; }
        *(u32x4*)dst = o;
    }
}

constexpr int N_PHASES = 19;
struct Args { const float* in[17]; float* out; unsigned char* ws; int ph_lo, ph_hi; };

__global__ void __launch_bounds__(NWAVES * 64, 2) fwd_kernel(Args args) {
    extern __shared__ __attribute__((aligned(16))) unsigned char lds_raw[];
    Frame F;
    F.lds = (LAS unsigned char*)lds_raw;
    F.tid = threadIdx.x; F.lane = F.tid & 63; F.wave = __builtin_amdgcn_readfirstlane(F.tid >> 6);
    F.G = gridDim.x; { const int bx = blockIdx.x; F.vcu = (F.G % 8 == 0) ? (bx % 8) * (F.G / 8) + bx / 8 : bx; }
    F.x = args.in[0]; F.mem = args.in[1]; F.norm_mix_g = args.in[2]; F.w_in = args.in[3]; F.hg_lb = args.in[4]; F.hg_norm_g = args.in[5]; F.sc_conv_w = args.in[6];
    F.mem_norm_g = args.in[7]; F.w_mem_kv = args.in[8]; F.w_branch = args.in[9]; F.w_out = args.in[10]; F.norm_ffn_g = args.in[11]; F.peer_w_q = args.in[12];
    F.peer_sub_keys = args.in[13]; F.peer_u = args.in[14]; F.peer_v = args.in[15]; F.final_norm_g = args.in[16];
    F.out = args.out; F.ws = args.ws;
    volatile LAS unsigned* MISC = (volatile LAS unsigned*)(F.lds + MISC_OFF);
    for (int u = F.tid; u < (LDS_BYTES - MISC_OFF) / 4; u += NWAVES * 64) MISC[u] = 0u;
    __syncthreads();
    unsigned* barw = (unsigned*)(F.ws + WS_CTL) + CW_BAR;
    XcdBarrier bar; bar.bar = barw; bar.x = 0; bar.st = nullptr;
    const bool one_launch = (args.ph_hi - args.ph_lo) > 1;
    if (one_launch) bar = xcd_barrier_post(barw, MISC + 8);
    const int lo = args.ph_lo, hi = args.ph_hi;
#define IN(k) (lo <= (k) && (k) < hi)
#ifndef PMASK
#define PMASK 0x3ff
#endif
#define PC_(c) ((PMASK >> (c)) & 1)
#ifndef REP_MASK
#define REP_MASK 0
#endif
#define REPS(c) for (int rep_ = 0; rep_ < 1 + 2 * ((REP_MASK >> (c)) & 1); ++rep_)
#define SEAM(k) do { if (IN(k) && IN((k) + 1)) xcd_barrier(bar); } while (0)
    unsigned char* ws = F.ws;
    const int G = F.G, cid = (int)blockIdx.x;

    if (PC_(0) && IN(0)) { REPS(0) p0_prologue(F); } SEAM(0);

#pragma unroll 1
    for (int g = 0; g < NGRP; ++g) {
        const int pb = 1 + 6 * g;
        if (PC_(1) && IN(pb)) REPS(1) {
            { pg8::PlainOrder S; S.init(TG, PC, G, cid); S.A = (const char*)(ws + WS_XG) + (size_t)g * TG * 1024 * 2; S.Bt = (const char*)(ws + WS_WIN); S.a_tile = 256 * 1024 * 2; S.b_tile = 256 * 1024 * 2;
              pg8::EpiBf16 E{(bf16*)(ws + WS_PROJ), PC};
              pg8::gemm_phase<pg8::EpiBf16, pg8::PlainOrder, true, true>(F.lds, pg8::Gemm{1024, 1024, 1024}, S, E); }
            if (g == 0) {
                { pg8::PlainOrder S; S.init(BATCH * NMEM, 512, G, cid); S.A = (const char*)(ws + WS_MN); S.Bt = (const char*)(ws + WS_WKV); S.a_tile = 256 * 1024 * 2; S.b_tile = 256 * 1024 * 2;
                  pg8::EpiBf16 E{(bf16*)(ws + WS_KMEM), 512};
                  pg8::gemm_phase<pg8::EpiBf16, pg8::PlainOrder, true, true>(F.lds, pg8::Gemm{1024, 1024, 1024}, S, E); }
                { pg8::PlainOrder S; S.init(512, BATCH * NMEM, G, cid); S.A = (const char*)(ws + WS_WKV) + (size_t)512 * 1024 * 2; S.Bt = (const char*)(ws + WS_MN); S.a_tile = 256 * 1024 * 2; S.b_tile = 256 * 1024 * 2;
                  pg8::EpiBf16 E{(bf16*)(ws + WS_VT), BATCH * NMEM};
                  pg8::gemm_phase<pg8::EpiBf16, pg8::PlainOrder, true, true>(F.lds, pg8::Gemm{1024, 1024, 1024}, S, E); }
            }
        } SEAM(pb);
        if (PC_(2) && IN(pb + 1)) REPS(2) {
            for (int it = F.vcu * 4; it < BG * 4 * NCHUNK; it += G * 4) { for (int k = 0; k < 4; ++k) hgrn_a_item(F, it + k, k < 3); }
            for (int it = F.vcu; it < BG * 4 * 8; it += G) attn_item(F, g, it);
            conv_phase(F);
        } SEAM(pb + 1);
        if (PC_(3) && IN(pb + 2)) { REPS(3) hgrn_scan(F); } SEAM(pb + 2);
        if (PC_(4) && IN(pb + 3)) REPS(4) { for (int it = F.vcu * 4; it < BG * 4 * NCHUNK; it += G * 4) { for (int k = 0; k < 4; ++k) hgrn_c_item(F, it + k, k < 3); } } SEAM(pb + 3);
        if (PC_(5) && IN(pb + 4)) REPS(5) {
            pg8::BranchOrder S; S.init(TG, 1024, G, cid); S.Y = (const char*)(ws + WS_YHG); S.Wb = (const char*)(ws + WS_WBR);
            pg8::EpiBranch E{(const bf16*)(ws + WS_PROJ), (float*)(ws + WS_MACC), (bf16*)(ws + WS_MERGED)};
            pg8::gemm_phase<pg8::EpiBranch, pg8::BranchOrder, true, true>(F.lds, pg8::Gemm{512, 512, 512}, S, E);
        } SEAM(pb + 4);
        if (PC_(6) && IN(pb + 5)) REPS(6) {
            pg8::PlainOrder S; S.init(TG, 1024, G, cid); S.A = (const char*)(ws + WS_MERGED); S.Bt = (const char*)(ws + WS_WOUT); S.a_tile = 256 * 1024 * 2; S.b_tile = 256 * 1024 * 2;
            pg8::EpiOut E{F.x + (size_t)g * TG * 1024, F.out + (size_t)g * TG * 1024, (bf16*)(ws + WS_XG) + (size_t)g * TG * 1024, F.norm_ffn_g, (float*)(ws + WS_SSP) + (size_t)g * TG * 16};
            pg8::gemm_phase<pg8::EpiOut, pg8::PlainOrder, true, true>(F.lds, pg8::Gemm{1024, 1024, 1024}, S, E);
        } SEAM(pb + 5);
    }
#pragma unroll 1
    for (int tg = 0; tg < NGRP; ++tg) {
        const int pb = 13 + 3 * tg;
        if (PC_(7) && IN(pb)) REPS(7) {
            if (tg == 0) convert_uv(F);
            pg8::PlainOrder S; S.init(TG, 2048, G, cid); S.A = (const char*)(ws + WS_XG) + (size_t)tg * TG * 1024 * 2; S.Bt = (const char*)(ws + WS_WQ); S.a_tile = 256 * 1024 * 2; S.b_tile = 256 * 1024 * 2;
            pg8::EpiQ E{(bf16*)(ws + WS_Q), 2048, (const float*)(ws + WS_SSP) + (size_t)tg * TG * 16};
            pg8::gemm_phase<pg8::EpiQ, pg8::PlainOrder, true, true>(F.lds, pg8::Gemm{1024, 1024, 1024}, S, E);
        } SEAM(pb);
        if (PC_(8) && IN(pb + 1)) REPS(8) {
            pg8::ScoreOrder S; S.init(TG, 2048, G, cid); S.Q = (const char*)(ws + WS_Q); S.Kbd = (const char*)(ws + WS_KBD);
            pg8::EpiF32 E{(float*)(ws + WS_S), 2048};
            pg8::gemm_phase<pg8::EpiF32, pg8::ScoreOrder, true, true>(F.lds, pg8::Gemm{2048, 256, 256}, S, E);
        } SEAM(pb + 1);
        if (PC_(9) && IN(pb + 2)) { peer_phase(F, tg); } SEAM(pb + 2);
    }
#undef IN
#undef SEAM
}

extern "C" void kernel_launch(void* const* d_in, const int* in_sizes, int n_in, void* d_out, int out_size, void* d_ws, size_t ws_size, hipStream_t stream) {
    static int ready = 0;
    if (ready == 0) {
        if (n_in != 17 || out_size != T_ALL * D_MODEL || ws_size < WS_END) { fprintf(stderr, "kernel_launch: unexpected shapes (n_in %d, out %d, ws %zu)\n", n_in, out_size, ws_size); ready = -1; return; }
        if (hipFuncSetAttribute((const void*)fwd_kernel, hipFuncAttributeMaxDynamicSharedMemorySize, LDS_BYTES) != hipSuccess) { fprintf(stderr, "kernel_launch: hipFuncSetAttribute failed\n"); ready = -1; return; }
        ready = 1;
    }
    if (ready < 0) return;
    (void)hipMemsetAsync((char*)d_ws + WS_CTL, 0, CTL_ZERO_BYTES, stream);
    Args a{};
    for (int i = 0; i < 17; ++i) a.in[i] = (const float*)d_in[i];
    a.out = (float*)d_out; a.ws = (unsigned char*)d_ws;
    const int grid = 256;
#if MK_N_LAUNCHES == 1
    a.ph_lo = 0; a.ph_hi = N_PHASES;
    hipLaunchKernelGGL(fwd_kernel, dim3(grid), dim3(NWAVES * 64), LDS_BYTES, stream, a);
#else
    for (int li = 0; li < N_PHASES; ++li) { a.ph_lo = li; a.ph_hi = li + 1; hipLaunchKernelGGL(fwd_kernel, dim3(grid), dim3(NWAVES * 64), LDS_BYTES, stream, a); }
#endif
}
```

```cpp
#include <hip/hip_runtime.h>
#include <cstdio>
#include <cstdint>

#ifndef MK_N_LAUNCHES
#define MK_N_LAUNCHES 1
#endif

#define LAS __attribute__((address_space(3)))
#define GAS __attribute__((address_space(1)))
typedef unsigned short bf16;
typedef short bf16x8 __attribute__((ext_vector_type(8)));
typedef short s16x4 __attribute__((ext_vector_type(4)));
typedef short v4i16_t __attribute__((ext_vector_type(4)));
typedef float f32x2 __attribute__((ext_vector_type(2)));
typedef float f32x4 __attribute__((ext_vector_type(4)));
typedef float f32x16 __attribute__((ext_vector_type(16)));
typedef unsigned u32x2 __attribute__((ext_vector_type(2)));
typedef unsigned u32x4 __attribute__((ext_vector_type(4)));
typedef __bf16 bf16x2_t __attribute__((ext_vector_type(2)));
typedef GAS unsigned gu32;
#define RLX_AGENT __ATOMIC_RELAXED, __HIP_MEMORY_SCOPE_AGENT
#define DI __device__ __forceinline__

constexpr int D_MODEL = 1024, BATCH = 16, SEQ = 2048, T_ALL = BATCH * SEQ;
constexpr int NGRP = 2, BG = BATCH / NGRP, TG = BG * SEQ;
constexpr int PC = 7680;
constexpr int C_HQ = 0, C_HI = 512, C_FF = 1024, C_FB = 1536, C_HG = 2048, C_SB = 2560, C_SC = 3072, C_SH = 3584, C_MQ = 4096, C_GATE = 4608;
constexpr int NMEM = 256, CHUNK = 64, NCHUNK = SEQ / CHUNK;
constexpr float EPS = 1e-6f;

constexpr size_t MiB = 1u << 20;
constexpr size_t WS_CTL = 0, CTL_ZERO_BYTES = 1 * MiB;
constexpr size_t WS_LB = 1 * MiB;
constexpr size_t WS_SSP = 2 * MiB;
constexpr size_t WS_DEC = 4 * MiB;
constexpr size_t WS_WIN = 5 * MiB, WS_WKV = 20 * MiB, WS_WBR = 22 * MiB, WS_WOUT = 25 * MiB, WS_WQ = 27 * MiB, WS_KBD = 31 * MiB;
constexpr size_t WS_MN = 32 * MiB, WS_KMEM = 40 * MiB, WS_VT = 44 * MiB;
constexpr size_t WS_XG = 48 * MiB;
constexpr size_t WS_YHG = 112 * MiB, WS_YSC = 128 * MiB, WS_YMX = 144 * MiB;
constexpr size_t WS_DS = 160 * MiB;
constexpr size_t WS_MACC = 160 * MiB;
constexpr size_t WS_MERGED = 224 * MiB;
constexpr size_t WS_PROJ = 256 * MiB;
constexpr size_t WS_U = 112 * MiB, WS_V = 128 * MiB;
constexpr size_t WS_Q = 176 * MiB;
constexpr size_t WS_S = 256 * MiB;
constexpr size_t WS_END = 496 * MiB;
constexpr size_t OUT_SST = 64 * MiB;

constexpr int LDS_BYTES = 160 * 1024;
constexpr int MISC_OFF = LDS_BYTES - 512;
constexpr int NWAVES = 8;

DI unsigned f2bf(float f) { unsigned u = __builtin_bit_cast(unsigned, f); return (u + 0x7fffu + ((u >> 16) & 1u)) >> 16; }
DI unsigned pk2(float lo, float hi) { return f2bf(lo) | (f2bf(hi) << 16); }
DI float bf2f(unsigned short b) { return __builtin_bit_cast(float, (unsigned)b << 16); }
DI float bflo(unsigned w) { return __builtin_bit_cast(float, w << 16); }
DI float bfhi(unsigned w) { return __builtin_bit_cast(float, w & 0xffff0000u); }
DI float wave_sum(float v) {
#pragma unroll
    for (int o = 1; o < 64; o <<= 1) v += __shfl_xor(v, o);
    return v;
}
DI unsigned cvtpk(float lo, float hi) { f32x2 v = {lo, hi}; bf16x2_t b = __builtin_convertvector(v, bf16x2_t); return __builtin_bit_cast(unsigned, b); }
template <int CTRL> DI unsigned dpp_u(unsigned v) { return (unsigned)__builtin_amdgcn_update_dpp(0, (int)v, CTRL, 0xF, 0xF, false); }
template <int CTRL> DI float dpp_f(float v) { return __builtin_bit_cast(float, __builtin_amdgcn_update_dpp(0, __builtin_bit_cast(int, v), CTRL, 0xF, 0xF, false)); }
DI float bperm_f(int addr, float v) { return __builtin_bit_cast(float, __builtin_amdgcn_ds_bpermute(addr, __builtin_bit_cast(int, v))); }
DI unsigned row_max16(unsigned m) { m = max(m, dpp_u<0xB1>(m)); m = max(m, dpp_u<0x4E>(m)); m = max(m, dpp_u<0x141>(m)); return max(m, dpp_u<0x140>(m)); }
DI float row_sum16(float v) { v += dpp_f<0xB1>(v); v += dpp_f<0x4E>(v); v += dpp_f<0x141>(v); return v + dpp_f<0x140>(v); }

DI float fast_sig(float z) { return __builtin_amdgcn_rcpf(1.0f + __builtin_amdgcn_exp2f(-1.4426950408889634f * z)); }
DI float sigmoidf_(float z) { return 1.0f / (1.0f + __expf(-z)); }

namespace pg8 {
constexpr int BM = 256, BK = 64, HALF = 128, HTB = HALF * BK * 2, STAGE_BYTES = 8 * HTB, NXCD = 8, WGM = 8;
__host__ __device__ __forceinline__ int lds_byte(int r, int c) { const int st = (r >> 4) * 2 + (c >> 5), rr = r & 15, cc = c & 31, ob = rr * 64 + cc * 2; return st * 1024 + (ob ^ (((ob >> 9) & 1) << 5)); }
__host__ __device__ __forceinline__ void stage_rc(int b, int& R, int& C) { const int st = b / 1024, sb = b % 1024, swz = sb ^ (((sb >> 9) & 1) << 5); R = (st >> 1) * 16 + swz / 64; C = (st & 1) * 32 + (swz % 64) / 2; }
__host__ __device__ __forceinline__ int perm32(int rho) { const int n = rho >> 4, i = rho & 15; return 8 * (i >> 2) + 4 * n + (i & 3); }

struct Unit { int pm, pn, z; };
struct Gemm { int lda, ldb, K; };

struct StaticOrder {
    int nM, nN, nwg, G, c;
    __device__ void init(int M, int N, int G_, int c_) { nM = M / BM; nN = N / BM; nwg = nM * nN; G = G_; c = c_; }
    __device__ bool tile(int i, Unit& u) const {
        const long L = (long)i * G + c; if (L >= nwg) return false;
        int wgid = (int)L; { const int q = nwg / NXCD, r = nwg % NXCD, xcd = wgid % NXCD, off = wgid / NXCD; wgid = (xcd < r ? xcd * (q + 1) : r * (q + 1) + (xcd - r) * q) + off; }
        const int nig = WGM * nN, gid = wgid / nig, fm = gid * WGM, gsz = (nM - fm) < WGM ? (nM - fm) : WGM;
        u.pm = fm + ((wgid % nig) % gsz); u.pn = (wgid % nig) / gsz; u.z = 0; return true;
    }
};

DI unsigned cvt_pk_bf16(float lo, float hi) { return cvtpk(lo, hi); }

template <class Epi, class Sched, bool ALIGN_EPI, bool SP2>
DI void gemm_phase(LAS unsigned char* lds, const Gemm g, const Sched& S, const Epi& E) {
    int tid_ = threadIdx.x; asm volatile("" : "+v"(tid_));
    const int tid = tid_, wid = __builtin_amdgcn_readfirstlane(tid >> 6), lane = tid & 63, wr = wid >> 2, wc = wid & 3, fr = lane & 15, fq = lane >> 4;
    int K_ = g.K; asm volatile("" : "+s"(K_));
    const int K = K_, nt = K / BK;
    unsigned voffA[2], voffB[2];
#pragma unroll
    for (int i = 0; i < 2; ++i) { int R, C; stage_rc(tid * 16 + i * 8192, R, C); const int Rb = Epi::PERM ? ((R & ~31) + perm32(R & 31)) : R;
        voffA[i] = (unsigned)(R * g.lda + C) * 2u; voffB[i] = (unsigned)(Rb * g.ldb + C) * 2u; }
    const size_t kstep = (size_t)(BK * 2);
    const size_t hA = (size_t)HALF * g.lda * 2, hB = (size_t)HALF * g.ldb * 2;
    const unsigned ldsw = (unsigned)wid * 1024u;
    const int aoff = lds_byte(wr * 64 + fr, fq * 8), boff = lds_byte(wc * 32 + fr, fq * 8);
#define PG8_SA(b, h) (((b) * 2 + (h)) * HTB)
#define PG8_SB(b, h) ((4 + (b) * 2 + (h)) * HTB)
#define PG8_STAGE(bufoff, gbase, voff) do { _Pragma("unroll") for (int _i = 0; _i < 2; ++_i) \
        __builtin_amdgcn_global_load_lds((const unsigned*)((const char*)(gbase) + (voff)[_i]), (LAS unsigned*)(lds + (bufoff) + ldsw + _i * 8192), 16, 0, 0); } while (0)
#define PG8_LDA(dst, b, h) do { _Pragma("unroll") for (int m = 0; m < 4; ++m) _Pragma("unroll") for (int k = 0; k < 2; ++k) dst[m][k] = *(const LAS bf16x8*)(lds + PG8_SA(b, h) + aoff + m * 2048 + k * 1024); } while (0)
#define PG8_LDB(dst, b, h) do { _Pragma("unroll") for (int n = 0; n < 2; ++n) _Pragma("unroll") for (int k = 0; k < 2; ++k) dst[n][k] = *(const LAS bf16x8*)(lds + PG8_SB(b, h) + boff + n * 2048 + k * 1024); } while (0)
#define PG8_MMA(ai, bj, At, Bt) do { __builtin_amdgcn_s_setprio(1); _Pragma("unroll") for (int m = 0; m < 4; ++m) _Pragma("unroll") for (int n = 0; n < 2; ++n) _Pragma("unroll") for (int k = 0; k < 2; ++k) \
        acc[ai][bj][m][n] = __builtin_amdgcn_mfma_f32_16x16x32_bf16(Bt[n][k], At[m][k], acc[ai][bj][m][n], 0, 0, 0); __builtin_amdgcn_s_setprio(0); } while (0)
#define PG8_WAIT_V(n) asm volatile("s_waitcnt vmcnt(" #n ")" ::: "memory")
#define PG8_WAIT_L(n) asm volatile("s_waitcnt lgkmcnt(" #n ")" ::: "memory")
#define PG8_BAR __builtin_amdgcn_s_barrier()
#define PG8_SCHED __builtin_amdgcn_sched_barrier(0)
    Unit cur, nxt; int ui = 0;
    if (!S.next(0, cur)) return;
    f32x4 acc[2][2][4][2];
#pragma unroll
    for (int a = 0; a < 2; ++a)
#pragma unroll
        for (int b = 0; b < 2; ++b)
#pragma unroll
            for (int m = 0; m < 4; ++m)
#pragma unroll
                for (int n = 0; n < 2; ++n) acc[a][b][m][n] = (f32x4){0.f, 0.f, 0.f, 0.f};
    bf16x8 At[4][2], B0[2][2], B1[2][2];
    const char* cA = S.a_base(cur); const char* cB = S.b_base(cur);
    if constexpr (SP2) {
        PG8_STAGE(PG8_SB(0, 0), cB, voffB); PG8_STAGE(PG8_SB(0, 1), cB + hB, voffB); PG8_STAGE(PG8_SA(0, 0), cA, voffA); PG8_STAGE(PG8_SA(0, 1), cA + hA, voffA);
        if (wr == 1) PG8_BAR;
        PG8_WAIT_V(2); PG8_BAR;
        PG8_STAGE(PG8_SB(1, 0), cB + kstep, voffB); PG8_STAGE(PG8_SA(1, 0), cA + kstep, voffA); PG8_STAGE(PG8_SB(1, 1), cB + hB + kstep, voffB);
        PG8_WAIT_V(6); PG8_BAR;
    } else {
        PG8_STAGE(PG8_SB(0, 0), cB, voffB); PG8_STAGE(PG8_SA(0, 0), cA, voffA); PG8_STAGE(PG8_SB(0, 1), cB + hB, voffB); PG8_STAGE(PG8_SA(0, 1), cA + hA, voffA);
        if (wr == 1) PG8_BAR;
        PG8_WAIT_V(4); PG8_BAR;
        PG8_STAGE(PG8_SB(1, 0), cB + kstep, voffB); PG8_STAGE(PG8_SA(1, 0), cA + kstep, voffA); PG8_STAGE(PG8_SB(1, 1), cB + hB + kstep, voffB);
        PG8_WAIT_V(6); PG8_BAR;
    }
    for (;;) {
        const bool has_next = S.next(ui + 1, nxt);
        const char* nA = has_next ? S.a_base(nxt) : cA; const char* nB = has_next ? S.b_base(nxt) : cB;
        for (int t = 0; t < nt; t += 2) {
            const bool last = (t == nt - 2);
            const char* a1 = cA + (size_t)(t + 1) * kstep;
            const char* a2 = last ? nA : cA + (size_t)(t + 2) * kstep; const char* b2 = last ? nB : cB + (size_t)(t + 2) * kstep;
            const char* a3 = a2 + kstep; const char* b3 = b2 + kstep;
            if constexpr (SP2) {
            PG8_LDB(B0, 0, 0); PG8_LDB(B1, 0, 1); PG8_SCHED; PG8_LDA(At, 0, 0); PG8_STAGE(PG8_SA(1, 1), a1 + hA, voffA);
            PG8_WAIT_V(8); PG8_WAIT_L(0); PG8_BAR; PG8_MMA(0, 0, At, B0); PG8_MMA(0, 1, At, B1); PG8_BAR; PG8_SCHED;
            PG8_LDA(At, 0, 1); PG8_STAGE(PG8_SB(0, 0), b2, voffB); PG8_STAGE(PG8_SB(0, 1), b2 + hB, voffB); PG8_STAGE(PG8_SA(0, 0), a2, voffA);
            PG8_WAIT_V(8); PG8_WAIT_L(0); PG8_BAR; PG8_MMA(1, 0, At, B0); PG8_MMA(1, 1, At, B1); PG8_BAR; PG8_SCHED;
            PG8_LDB(B0, 1, 0); PG8_LDB(B1, 1, 1); PG8_SCHED; PG8_LDA(At, 1, 0); PG8_STAGE(PG8_SA(0, 1), a2 + hA, voffA);
            PG8_WAIT_V(8); PG8_WAIT_L(0); PG8_BAR; PG8_MMA(0, 0, At, B0); PG8_MMA(0, 1, At, B1); PG8_BAR; PG8_SCHED;
            PG8_LDA(At, 1, 1); PG8_STAGE(PG8_SB(1, 0), b3, voffB); PG8_STAGE(PG8_SB(1, 1), b3 + hB, voffB); PG8_STAGE(PG8_SA(1, 0), a3, voffA);
            PG8_WAIT_V(8); PG8_WAIT_L(0); PG8_BAR; PG8_MMA(1, 0, At, B0); PG8_MMA(1, 1, At, B1); PG8_BAR; PG8_SCHED;
            } else {
            PG8_LDB(B0, 0, 0); PG8_SCHED; PG8_LDA(At, 0, 0); PG8_STAGE(PG8_SA(1, 1), a1 + hA, voffA);
            PG8_WAIT_L(8); PG8_BAR; PG8_WAIT_L(0); PG8_MMA(0, 0, At, B0); PG8_BAR; PG8_SCHED;
            PG8_LDB(B1, 0, 1); PG8_STAGE(PG8_SB(0, 0), b2, voffB);
            PG8_BAR; PG8_WAIT_L(0); PG8_MMA(0, 1, At, B1); PG8_BAR;
            PG8_LDA(At, 0, 1); PG8_STAGE(PG8_SA(0, 0), a2, voffA);
            PG8_BAR; PG8_WAIT_L(0); PG8_MMA(1, 0, At, B0); PG8_BAR; PG8_SCHED;
            PG8_STAGE(PG8_SB(0, 1), b2 + hB, voffB);
            PG8_WAIT_V(6); PG8_BAR; PG8_MMA(1, 1, At, B1); PG8_BAR;
            PG8_LDB(B0, 1, 0); PG8_SCHED; PG8_LDA(At, 1, 0); PG8_STAGE(PG8_SA(0, 1), a2 + hA, voffA);
            PG8_WAIT_L(8); PG8_BAR; PG8_WAIT_L(0); PG8_MMA(0, 0, At, B0); PG8_BAR; PG8_SCHED;
            PG8_LDB(B1, 1, 1); PG8_STAGE(PG8_SB(1, 0), b3, voffB);
            PG8_BAR; PG8_WAIT_L(0); PG8_MMA(0, 1, At, B1); PG8_BAR;
            PG8_LDA(At, 1, 1); PG8_STAGE(PG8_SA(1, 0), a3, voffA);
            PG8_BAR; PG8_WAIT_L(0); PG8_MMA(1, 0, At, B0); PG8_BAR; PG8_SCHED;
            PG8_STAGE(PG8_SB(1, 1), b3 + hB, voffB);
            PG8_WAIT_V(6); PG8_BAR; PG8_MMA(1, 1, At, B1); PG8_BAR;
            }
        }
        if constexpr (ALIGN_EPI) { if (wr == 0) PG8_BAR; }
        E(acc, cur, wr, wc, fr, fq);
        if (!has_next) break;
#pragma unroll
        for (int a = 0; a < 2; ++a)
#pragma unroll
            for (int b = 0; b < 2; ++b)
#pragma unroll
                for (int m = 0; m < 4; ++m)
#pragma unroll
                    for (int n = 0; n < 2; ++n) acc[a][b][m][n] = (f32x4){0.f, 0.f, 0.f, 0.f};
        cur = nxt; cA = nA; cB = nB; ++ui;
        if constexpr (ALIGN_EPI) { if (wr == 1) PG8_BAR; }
    }
    PG8_WAIT_V(0);
    if constexpr (!ALIGN_EPI) { if (wr == 0) PG8_BAR; }
    PG8_BAR;
#undef PG8_SA
#undef PG8_SB
#undef PG8_STAGE
#undef PG8_LDA
#undef PG8_LDB
#undef PG8_MMA
#undef PG8_WAIT_V
#undef PG8_WAIT_L
#undef PG8_BAR
#undef PG8_SCHED
}
}

namespace pg8 {
struct PlainOrder : StaticOrder {
    const char* A; const char* Bt; size_t a_tile, b_tile;
    __device__ bool next(int i, Unit& u) const { return tile(i, u); }
    DI const char* a_base(const Unit& u) const { return A + (size_t)u.pm * a_tile; }
    DI const char* b_base(const Unit& u) const { return Bt + (size_t)u.pn * b_tile; }
};
struct InOrder : StaticOrder {
    const char* H; const char* Win; const char* Mn; const char* Wkv; int n_extra;
    __device__ bool next(int i, Unit& u) const {
        const long L = (long)i * G + c;
        if (L >= (long)nwg + n_extra) return false;
        Unit t; t.pm = 0; t.pn = 0; t.z = 0;
        const bool main_tile = L < nwg;
        if (main_tile) (void)tile(i, t);
        const int e = (int)(L - nwg);
        const int pm1 = e >> 1, pn1 = e & 1, pm2 = (e - 32) >> 4, pn2 = (e - 32) & 15; const bool k1 = e < 32;
        u.pm = main_tile ? t.pm : (k1 ? pm1 : pm2); u.pn = main_tile ? t.pn : (k1 ? pn1 : pn2); u.z = main_tile ? 0 : (k1 ? 1 : 2);
        return true;
    }
    DI const char* a_base(const Unit& u) const { const long d1 = Mn - H, d2 = (Wkv + (size_t)512 * 1024 * 2) - H; return H + ((u.z == 1) ? d1 : 0L) + ((u.z == 2) ? d2 : 0L) + (size_t)u.pm * (256 * 1024 * 2); }
    DI const char* b_base(const Unit& u) const { const long d1 = Wkv - Win, d2 = Mn - Win; return Win + ((u.z == 1) ? d1 : 0L) + ((u.z == 2) ? d2 : 0L) + (size_t)u.pn * (256 * 1024 * 2); }
};
struct EpiIn {
    static constexpr bool PERM = true;
    bf16* proj; bf16* kmem; bf16* vt;
    DI void operator()(const f32x4 (&acc)[2][2][4][2], const Unit& u, int wr, int wc, int fr, int fq) const {
        const long dk = kmem - proj, dv = vt - proj; bf16* O = proj + ((u.z == 1) ? dk : 0L) + ((u.z == 2) ? dv : 0L); const int ldc = PC + ((u.z == 1) ? 512 - PC : 0) + ((u.z == 2) ? BATCH * NMEM - PC : 0);
        const int row0 = u.pm * BM + wr * 64 + fr, col0 = u.pn * BM + wc * 32 + 8 * fq;
#pragma unroll
        for (int ai = 0; ai < 2; ++ai)
#pragma unroll
            for (int m = 0; m < 4; ++m) { bf16* rowp = O + (size_t)(row0 + ai * HALF + m * 16) * ldc + col0;
#pragma unroll
                for (int bj = 0; bj < 2; ++bj) { const f32x4 v0 = acc[ai][bj][m][0], v1 = acc[ai][bj][m][1];
                    u32x4 w; w.x = cvt_pk_bf16(v0[0], v0[1]); w.y = cvt_pk_bf16(v0[2], v0[3]); w.z = cvt_pk_bf16(v1[0], v1[1]); w.w = cvt_pk_bf16(v1[2], v1[3]);
                    *(u32x4*)(rowp + bj * HALF) = w; } }
    }
};
struct BranchOrder : StaticOrder {
    const char* Y; const char* Wb;
    __device__ bool next(int i, Unit& u) const { if (!tile(i / 3, u)) return false; u.z = i % 3; return true; }
    DI const char* a_base(const Unit& u) const { return Y + (size_t)u.z * (16 * MiB) + (size_t)u.pm * (256 * 512 * 2); }
    DI const char* b_base(const Unit& u) const { return Wb + (size_t)u.z * (1024 * 512 * 2) + (size_t)u.pn * (256 * 512 * 2); }
};
struct ScoreOrder : StaticOrder {
    const char* Q; const char* Kbd;
    __device__ bool next(int i, Unit& u) const { return tile(i, u); }
    DI const char* a_base(const Unit& u) const { return Q + (size_t)u.pm * (256 * 2048 * 2) + (size_t)u.pn * 512; }
    DI const char* b_base(const Unit& u) const { return Kbd + (size_t)u.pn * (256 * 256 * 2); }
};

struct EpiBf16 {
    static constexpr bool PERM = true;
    bf16* O; int ldc;
    DI void operator()(const f32x4 (&acc)[2][2][4][2], const Unit& u, int wr, int wc, int fr, int fq) const {
        const int row0 = u.pm * BM + wr * 64 + fr, col0 = u.pn * BM + wc * 32 + 8 * fq;
#pragma unroll
        for (int ai = 0; ai < 2; ++ai)
#pragma unroll
            for (int m = 0; m < 4; ++m) { bf16* rowp = O + (size_t)(row0 + ai * HALF + m * 16) * ldc + col0;
#pragma unroll
                for (int bj = 0; bj < 2; ++bj) { const f32x4 v0 = acc[ai][bj][m][0], v1 = acc[ai][bj][m][1];
                    u32x4 w; w.x = cvt_pk_bf16(v0[0], v0[1]); w.y = cvt_pk_bf16(v0[2], v0[3]); w.z = cvt_pk_bf16(v1[0], v1[1]); w.w = cvt_pk_bf16(v1[2], v1[3]);
                    *(u32x4*)(rowp + bj * HALF) = w; } }
    }
};
struct EpiQ {
    static constexpr bool PERM = true;
    bf16* O; int ldc; const float* ssp;
    DI void operator()(const f32x4 (&acc)[2][2][4][2], const Unit& u, int wr, int wc, int fr, int fq) const {
        const int row0 = u.pm * BM + wr * 64 + fr, col0 = u.pn * BM + wc * 32 + 8 * fq;
#pragma unroll
        for (int ai = 0; ai < 2; ++ai)
#pragma unroll
            for (int m = 0; m < 4; ++m) { const int row = row0 + ai * HALF + m * 16; const f32x4* sp = (const f32x4*)(ssp + (size_t)row * 16);
                const f32x4 s0 = sp[0], s1 = sp[1], s2 = sp[2], s3 = sp[3];
                const float ss = ((s0[0] + s0[1]) + (s0[2] + s0[3])) + ((s1[0] + s1[1]) + (s1[2] + s1[3])) + ((s2[0] + s2[1]) + (s2[2] + s2[3])) + ((s3[0] + s3[1]) + (s3[2] + s3[3]));
                const float rs = 1.0f / sqrtf(ss * (1.0f / 1024.0f) + EPS);
                bf16* rowp = O + (size_t)row * ldc + col0;
#pragma unroll
                for (int bj = 0; bj < 2; ++bj) { const f32x4 v0 = acc[ai][bj][m][0] * rs, v1 = acc[ai][bj][m][1] * rs;
                    u32x4 w; w.x = cvt_pk_bf16(v0[0], v0[1]); w.y = cvt_pk_bf16(v0[2], v0[3]); w.z = cvt_pk_bf16(v1[0], v1[1]); w.w = cvt_pk_bf16(v1[2], v1[3]);
                    *(u32x4*)(rowp + bj * HALF) = w; }
                asm volatile("" ::: "memory"); }
    }
};
struct EpiF32 {
    static constexpr bool PERM = false;
    float* C; int ldc;
    DI void operator()(const f32x4 (&acc)[2][2][4][2], const Unit& u, int wr, int wc, int fr, int fq) const {
        const int row0 = u.pm * BM + wr * 64 + fr, col0 = u.pn * BM + wc * 32 + 4 * fq;
#pragma unroll
        for (int ai = 0; ai < 2; ++ai)
#pragma unroll
            for (int m = 0; m < 4; ++m) { float* rowp = C + (size_t)(row0 + ai * HALF + m * 16) * ldc + col0;
#pragma unroll
                for (int bj = 0; bj < 2; ++bj)
#pragma unroll
                    for (int n = 0; n < 2; ++n) *(f32x4*)(rowp + bj * HALF + n * 16) = acc[ai][bj][m][n]; }
    }
};
struct EpiBranch {
    static constexpr bool PERM = true;
    const bf16* proj; bf16* gbuf; bf16* merged;
    DI void operator()(const f32x4 (&acc)[2][2][4][2], const Unit& u, int wr, int wc, int fr, int fq) const {
        const int row0 = u.pm * BM + wr * 64 + fr, col0 = u.pn * BM + wc * 32 + 8 * fq;
#pragma unroll
        for (int ai = 0; ai < 2; ++ai)
#pragma unroll
            for (int m = 0; m < 4; ++m) { const int row = row0 + ai * HALF + m * 16;
#pragma unroll
                for (int bj = 0; bj < 2; ++bj) { const int col = col0 + bj * HALF;
                    const u32x4 gw = *(const u32x4*)(proj + (size_t)row * PC + C_GATE + u.z * 1024 + col);
                    f32x4 v0 = acc[ai][bj][m][0], v1 = acc[ai][bj][m][1];
                    v0[0] *= fast_sig(bflo(gw.x)); v0[1] *= fast_sig(bfhi(gw.x)); v0[2] *= fast_sig(bflo(gw.y)); v0[3] *= fast_sig(bfhi(gw.y));
                    v1[0] *= fast_sig(bflo(gw.z)); v1[1] *= fast_sig(bfhi(gw.z)); v1[2] *= fast_sig(bflo(gw.w)); v1[3] *= fast_sig(bfhi(gw.w));
                    const size_t off = (size_t)row * 1024 + col;
                    if (u.z == 2) { const u32x4 p0 = *(const u32x4*)(gbuf + off), p1 = *(const u32x4*)(gbuf + (size_t)TG * 1024 + off);
                        v0[0] += bflo(p0.x) + bflo(p1.x); v0[1] += bfhi(p0.x) + bfhi(p1.x); v0[2] += bflo(p0.y) + bflo(p1.y); v0[3] += bfhi(p0.y) + bfhi(p1.y);
                        v1[0] += bflo(p0.z) + bflo(p1.z); v1[1] += bfhi(p0.z) + bfhi(p1.z); v1[2] += bflo(p0.w) + bflo(p1.w); v1[3] += bfhi(p0.w) + bfhi(p1.w); }
                    u32x4 w; w.x = cvt_pk_bf16(v0[0], v0[1]); w.y = cvt_pk_bf16(v0[2], v0[3]); w.z = cvt_pk_bf16(v1[0], v1[1]); w.w = cvt_pk_bf16(v1[2], v1[3]);
                    *(u32x4*)((u.z == 2 ? merged : gbuf + (size_t)u.z * TG * 1024) + off) = w; }
                asm volatile("" ::: "memory"); }
    }
};
struct EpiOut {
    static constexpr bool PERM = true;
    const float* x; float* x1; bf16* xg; const float* gffn; float* ssp;
    DI void operator()(const f32x4 (&acc)[2][2][4][2], const Unit& u, int wr, int wc, int fr, int fq) const {
        const int row0 = u.pm * BM + wr * 64 + fr, col0 = u.pn * BM + wc * 32 + 8 * fq;
        f32x4 g0[2], g1[2];
#pragma unroll
        for (int bj = 0; bj < 2; ++bj) { g0[bj] = *(const f32x4*)(gffn + col0 + bj * HALF); g1[bj] = *(const f32x4*)(gffn + col0 + bj * HALF + 4); }
#pragma unroll
        for (int ai = 0; ai < 2; ++ai)
#pragma unroll
            for (int m = 0; m < 4; ++m) { const int row = row0 + ai * HALF + m * 16; float ss = 0.f;
#pragma unroll
                for (int bj = 0; bj < 2; ++bj) { const size_t off = (size_t)row * 1024 + col0 + bj * HALF;
                    const f32x4 v0 = acc[ai][bj][m][0] + *(const f32x4*)(x + off), v1 = acc[ai][bj][m][1] + *(const f32x4*)(x + off + 4);
                    *(f32x4*)(x1 + off) = v0; *(f32x4*)(x1 + off + 4) = v1;
                    ss += (v0[0] * v0[0] + v0[1] * v0[1]) + (v0[2] * v0[2] + v0[3] * v0[3]) + (v1[0] * v1[0] + v1[1] * v1[1]) + (v1[2] * v1[2] + v1[3] * v1[3]);
                    const f32x4 a = v0 * g0[bj], b = v1 * g1[bj];
                    u32x4 w; w.x = cvt_pk_bf16(a[0], a[1]); w.y = cvt_pk_bf16(a[2], a[3]); w.z = cvt_pk_bf16(b[0], b[1]); w.w = cvt_pk_bf16(b[2], b[3]);
                    *(u32x4*)(xg + off) = w; }
                ss += __shfl_xor(ss, 16); ss += __shfl_xor(ss, 32);
                if (fq == 0) ssp[(size_t)row * 16 + u.pn * 4 + wc] = ss;
                asm volatile("" ::: "memory"); }
    }
};
}

#define XB_TMO      128
#define XB_XCNT(j)  (256  + 64 * (j))
#define XB_XSUB(j)  (1280 + 64 * (j))
#define XB_XGEN(j)  (2304 + 64 * (j))
#define XB_TOP      3328
#define XB_TOPGEN   3392
#define XCD_BAR_WORDS 3456
#define XB_SPIN_CAP (1u << 18)
constexpr int CW_BAR = 4096;

DI unsigned xb_ld(unsigned* p)              { return __hip_atomic_load(p, __ATOMIC_RELAXED, __HIP_MEMORY_SCOPE_AGENT); }
DI unsigned xb_add(unsigned* p, unsigned v) { return __hip_atomic_fetch_add(p, v, __ATOMIC_RELAXED, __HIP_MEMORY_SCOPE_AGENT); }
DI unsigned xb_xcc_id() { return (unsigned)__builtin_amdgcn_s_getreg((3 << 11) | 20) & 0xFu; }
#define XB_SPIN(cond, bar) do { unsigned _sp = 0; while (cond) { __builtin_amdgcn_s_sleep(1); \
    if ((++_sp & 255u) == 0u) { if (xb_ld(&(bar)[XB_TMO])) break; if (_sp > XB_SPIN_CAP) { atomicAdd(&(bar)[XB_TMO], 1u); break; } } } } while (0)

struct XcdBarrier { unsigned* bar; unsigned x; volatile LAS unsigned* st; };

DI XcdBarrier xcd_barrier_post(unsigned* bar, volatile LAS unsigned* st) {
    XcdBarrier b; b.bar = bar; b.x = xb_xcc_id(); b.st = st;
    if (threadIdx.x == 0) (void)xb_add(&bar[XB_XCNT(b.x)], 1u);
    return b;
}
DI void xcd_barrier_complete(unsigned* bar, unsigned x, unsigned& nloc, unsigned& nx) {
    const unsigned G = gridDim.x * gridDim.y * gridDim.z;
    unsigned sum, cnt, mine, sp = 0u;
    for (;;) {
        sum = 0u; cnt = 0u; mine = 0u;
#pragma unroll
        for (unsigned j = 0; j < 16; ++j) { const unsigned c = xb_ld(&bar[XB_XCNT(j)]); sum += c; cnt += (c > 0u) ? 1u : 0u; mine = (j == x) ? c : mine; }
        if (sum == G) break;
        __builtin_amdgcn_s_sleep(1);
        if ((++sp & 255u) == 0u) { if (xb_ld(&bar[XB_TMO])) break; if (sp > XB_SPIN_CAP) { atomicAdd(&bar[XB_TMO], 1u); break; } }
    }
    nloc = mine > 0u ? mine : 1u; nx = cnt > 0u ? cnt : 1u;
}
DI void xcd_barrier(const XcdBarrier& b) {
    asm volatile("s_waitcnt vmcnt(0)" ::: "memory");
    __syncthreads();
    if (threadIdx.x == 0) {
        unsigned* bar = b.bar;
        __builtin_amdgcn_s_waitcnt(0);
        unsigned nloc = b.st[0], nx = b.st[1];
        if (nloc == 0u) { xcd_barrier_complete(bar, b.x, nloc, nx); b.st[0] = nloc; b.st[1] = nx; }
        const unsigned old = xb_add(&bar[XB_XSUB(b.x)], 1u);
        const unsigned gen = old / nloc;
        if (old + 1u == (gen + 1u) * nloc) {
            __builtin_amdgcn_fence(__ATOMIC_RELEASE, "agent");
            asm volatile("s_waitcnt vmcnt(0)" ::: "memory");
            const unsigned og = xb_add(&bar[XB_TOP], 1u);
            const unsigned tg = og / nx;
            if (og + 1u == (tg + 1u) * nx) xb_add(&bar[XB_TOPGEN], 1u);
            else XB_SPIN(xb_ld(&bar[XB_TOPGEN]) == tg, bar);
            __builtin_amdgcn_fence(__ATOMIC_ACQUIRE, "agent");
            xb_add(&bar[XB_XGEN(b.x)], 1u);
            asm volatile("s_waitcnt vmcnt(0)" ::: "memory");
        } else {
            XB_SPIN(xb_ld(&bar[XB_XGEN(b.x)]) == gen, bar);
            __builtin_amdgcn_fence(__ATOMIC_ACQUIRE, "agent");
            asm volatile("s_waitcnt vmcnt(0)" ::: "memory");
        }
    }
    __syncthreads();
}

struct Frame {
    LAS unsigned char* lds;
    int tid, lane, wave;
    DI void refresh() { int t = threadIdx.x; asm volatile("" : "+v"(t)); tid = t; lane = t & 63; wave = __builtin_amdgcn_readfirstlane(t >> 6); }
    int vcu, G;
    const float *x, *mem, *norm_mix_g, *w_in, *hg_lb, *hg_norm_g, *sc_conv_w, *mem_norm_g, *w_mem_kv, *w_branch, *w_out, *norm_ffn_g, *peer_w_q, *peer_sub_keys, *peer_u, *peer_v, *final_norm_g;
    float* out; unsigned char* ws;
};

DI void p0_transpose_item(const float* W, int K, int N, bf16* WT, LAS float* scr, int item, int lane) {
    const int nblk = N / 32, kb = item / nblk, nb = item % nblk, k0 = 64 * kb, n0 = 32 * nb;
#pragma unroll 8
    for (int i = 0; i < 32; ++i) { const int kk = 2 * i + (lane >> 5); scr[kk * 33 + (lane & 31)] = W[(size_t)(k0 + kk) * N + n0 + (lane & 31)]; }
    asm volatile("s_waitcnt lgkmcnt(0)" ::: "memory");
    const int c = lane & 7;
#pragma unroll
    for (int j = 0; j < 4; ++j) { const int n = (lane >> 3) + 8 * j; const LAS float* s = scr + (8 * c) * 33 + n;
        u32x4 o; o.x = pk2(s[0 * 33], s[1 * 33]); o.y = pk2(s[2 * 33], s[3 * 33]); o.z = pk2(s[4 * 33], s[5 * 33]); o.w = pk2(s[6 * 33], s[7 * 33]);
        *(u32x4*)(WT + (size_t)(n0 + n) * K + k0 + 8 * c) = o; }
    asm volatile("s_waitcnt lgkmcnt(0)" ::: "memory");
}
DI void rms_row_to_bf16(const float* xrow, const float* g, bf16* orow, int lane) {
    const f32x4* xr = (const f32x4*)xrow + lane; const f32x4* gr = (const f32x4*)g + lane;
    f32x4 v[4]; float s = 0.f;
#pragma unroll
    for (int j = 0; j < 4; ++j) { v[j] = xr[64 * j]; s += (v[j].x * v[j].x + v[j].y * v[j].y) + (v[j].z * v[j].z + v[j].w * v[j].w); }
    const float rstd = 1.0f / sqrtf(wave_sum(s) * (1.f / 1024.f) + EPS);
    unsigned long long* o8 = (unsigned long long*)orow + lane;
#pragma unroll
    for (int j = 0; j < 4; ++j) { const f32x4 gg = gr[64 * j]; const f32x4 y = v[j] * rstd * gg;
        o8[64 * j] = (unsigned long long)pk2(y.x, y.y) | ((unsigned long long)pk2(y.z, y.w) << 32); }
}
DI void p0_prologue(Frame& F) {
    F.refresh();
    LAS float* scr = (LAS float*)(F.lds + F.wave * 16384);
    const int gw = F.vcu * NWAVES + F.wave, NGW = F.G * NWAVES;
    unsigned char* ws = F.ws;
    constexpr int I_IN = (1024 / 64) * (PC / 32), I_KV = (1024 / 64) * (1024 / 32), I_BR = (512 / 64) * (1024 / 32), I_OUT = (1024 / 64) * (1024 / 32), I_Q = (1024 / 64) * (2048 / 32);
    constexpr int NITEMS = I_IN + I_KV + 3 * I_BR + I_OUT + I_Q;
    for (int it = gw; it < NITEMS; it += NGW) {
        int r = it;
        if (r < I_IN) { p0_transpose_item(F.w_in, 1024, PC, (bf16*)(ws + WS_WIN), scr, r, F.lane); continue; } r -= I_IN;
        if (r < I_KV) { p0_transpose_item(F.w_mem_kv, 1024, 1024, (bf16*)(ws + WS_WKV), scr, r, F.lane); continue; } r -= I_KV;
        if (r < 3 * I_BR) { const int n = r / I_BR; p0_transpose_item(F.w_branch + (size_t)n * 512 * 1024, 512, 1024, (bf16*)(ws + WS_WBR) + (size_t)n * 1024 * 512, scr, r % I_BR, F.lane); continue; } r -= 3 * I_BR;
        if (r < I_OUT) { p0_transpose_item(F.w_out, 1024, 1024, (bf16*)(ws + WS_WOUT), scr, r, F.lane); continue; } r -= I_OUT;
        p0_transpose_item(F.peer_w_q, 1024, 2048, (bf16*)(ws + WS_WQ), scr, r, F.lane);
    }
    const int gt = F.vcu * 512 + F.tid, NGT = F.G * 512;
    for (int it = gt; it < 8 * 256 * 32; it += NGT) {
        const int c8 = it & 31, row = (it >> 5) & 255, h = it >> 13, p = row >> 7, key = row & 127;
        u32x4 o = (u32x4){0u, 0u, 0u, 0u};
        if ((c8 >> 4) == p) { const float* s = F.peer_sub_keys + (((size_t)(h * 2 + p) * 128 + key) * 128 + (c8 & 15) * 8);
            const f32x4 a = *(const f32x4*)s, b = *(const f32x4*)(s + 4); o.x = pk2(a.x, a.y); o.y = pk2(a.z, a.w); o.z = pk2(b.x, b.y); o.w = pk2(b.z, b.w); }
        *(u32x4*)((bf16*)(ws + WS_KBD) + ((size_t)(h * 256 + row) * 256 + c8 * 8)) = o;
    }
    for (int it = gt; it < 1024; it += NGT) { const float a0 = F.hg_lb[it], a1 = F.hg_lb[1024 + it]; const float m = fmaxf(a0, a1); const float e0 = __expf(a0 - m), e1 = __expf(a1 - m);
        ((float*)(ws + WS_LB))[it] = e0 / (e0 + e1); }
    for (int m = gw; m < BATCH * NMEM; m += NGW) rms_row_to_bf16(F.mem + (size_t)m * 1024, F.mem_norm_g, (bf16*)(ws + WS_MN) + (size_t)m * 1024, F.lane);
    for (int m = gw; m < T_ALL; m += NGW) rms_row_to_bf16(F.x + (size_t)m * 1024, F.norm_mix_g, (bf16*)(ws + WS_XG) + (size_t)m * 1024, F.lane);
}

DI s16x4 tr16(const LAS unsigned char* p) { return __builtin_bit_cast(s16x4, __builtin_amdgcn_ds_read_tr16_b64_v4i16((LAS v4i16_t*)p)); }
DI bf16x8 cat8(s16x4 lo, s16x4 hi) { return __builtin_shufflevector(lo, hi, 0, 1, 2, 3, 4, 5, 6, 7); }
#define MFMA32(a, b, c) __builtin_amdgcn_mfma_f32_32x32x16_bf16((a), (b), (c), 0, 0, 0)
DI int crow(int reg, int h) { return (reg & 3) + 8 * (reg >> 2) + 4 * h; }
DI bf16x8 pack8(const f32x16& x, int s) {
    u32x4 p; p.x = cvtpk(x[8 * s], x[8 * s + 1]); p.y = cvtpk(x[8 * s + 2], x[8 * s + 3]); p.z = cvtpk(x[8 * s + 4], x[8 * s + 5]); p.w = cvtpk(x[8 * s + 6], x[8 * s + 7]);
    return __builtin_bit_cast(bf16x8, p);
}
constexpr int TS = 272;

DI void stage_tile(LAS unsigned char* tile, const bf16* src, int tid) {
#pragma unroll
    for (int i = 0; i < 2; ++i) { const int id = tid + 512 * i, c = id >> 4, ch = id & 15;
        *(LAS u32x4*)(tile + c * TS + ch * 16) = *(const u32x4*)(src + (size_t)c * PC + ch * 8); }
}
DI float touch_tile(const bf16* src, int i128) { return *(const float*)(src + (size_t)(i128 >> 1) * PC + (i128 & 1) * 64); }
DI void gate8(const LAS unsigned char* zt, int dp, int ts, f32x2 lb, f32x2 (&L)[8], f32x2 (&kk)[8], f32x2 (&lf)[8]) {
    f32x2 run = (f32x2){0.f, 0.f}; const f32x2 oml = 1.0f - lb;
#pragma unroll
    for (int i = 0; i < 8; ++i) { const unsigned w = *(const LAS unsigned*)(zt + (8 * ts + i) * TS + 4 * dp);
        const f32x2 sg = (f32x2){fast_sig(bflo(w)), fast_sig(bfhi(w))}; const f32x2 f = lb + oml * sg;
        lf[i] = (f32x2){__builtin_amdgcn_logf(f.x), __builtin_amdgcn_logf(f.y)}; kk[i] = oml * (1.0f - sg); run += lf[i]; L[i] = run; }
}
DI f32x2 exp2x2(f32x2 v) { return (f32x2){__builtin_amdgcn_exp2f(v.x), __builtin_amdgcn_exp2f(v.y)}; }
struct SliceSums { f32x2 offf, offb, glf, glb, greff, grefb; };
DI SliceSums slice_sums(const LAS float* tot, int dp, int ts) {
    SliceSums r; f32x2 tf[8], tb[8];
#pragma unroll
    for (int j = 0; j < 8; ++j) { tf[j] = *(const LAS f32x2*)(tot + j * 128 + 2 * dp); tb[j] = *(const LAS f32x2*)(tot + (8 + j) * 128 + 2 * dp); }
    r.offf = (f32x2){0.f, 0.f}; r.offb = (f32x2){0.f, 0.f};
#pragma unroll
    for (int j = 0; j < 8; ++j) { if (j < ts) r.offf += tf[j]; if (j > ts) r.offb += tb[j]; }
    r.greff = (tf[0] + tf[1]) + (tf[2] + tf[3]); r.glf = r.greff + ((tf[4] + tf[5]) + (tf[6] + tf[7]));
    r.grefb = (tb[4] + tb[5]) + (tb[6] + tb[7]); r.glb = r.grefb + ((tb[0] + tb[1]) + (tb[2] + tb[3]));
    return r;
}

DI void hgrn_a_item(Frame& F, int item, bool has_next) {
    F.refresh();
    constexpr int T_V = 0, T_KF = 17408, T_KB = 34816, TOT = 52224;
    LAS unsigned char* lds = F.lds;
    const int n = item & 31, h = (item >> 5) & 3, b = item >> 7;
    const bf16* proj = (const bf16*)(F.ws + WS_PROJ) + ((size_t)b * SEQ + n * CHUNK) * PC;
    const int tid = F.tid, dp = tid & 63, ts = F.wave;
    const float* lbp = (const float*)(F.ws + WS_LB);
    const f32x2 lbf = *(const f32x2*)(lbp + h * 128 + 2 * dp), lbb = *(const f32x2*)(lbp + 512 + h * 128 + 2 * dp);
    stage_tile(lds + T_V, proj + C_HI + h * 128, tid); stage_tile(lds + T_KF, proj + C_FF + h * 128, tid); stage_tile(lds + T_KB, proj + C_FB + h * 128, tid);
    float tch = 0.f;
    if (has_next) { const bf16* pn = proj + (size_t)CHUNK * PC + h * 128; const int i128 = tid & 127, wsel = tid >> 7; tch = touch_tile(pn + (wsel == 0 ? C_HI : wsel == 1 ? C_FF : C_FB), i128); }
    __syncthreads();
    f32x2 Lf[8], kf[8], lff[8], Lb[8], kb[8], lfb[8];
    gate8(lds + T_KF, dp, ts, lbf, Lf, kf, lff);
    gate8(lds + T_KB, dp, ts, lbb, Lb, kb, lfb);
    LAS float* tot = (LAS float*)(lds + TOT);
    *(LAS f32x2*)(tot + ts * 128 + 2 * dp) = Lf[7]; *(LAS f32x2*)(tot + (8 + ts) * 128 + 2 * dp) = Lb[7];
    asm volatile("" :: "v"(tch));
    __syncthreads();
    const SliceSums ss = slice_sums(tot, dp, ts);
    const f32x2 tbq = Lb[7];
#pragma unroll
    for (int i = 0; i < 8; ++i) { const int c = 8 * ts + i;
        const f32x2 G = ss.offf + Lf[i]; const f32x2 kd = kf[i] * exp2x2(ss.glf - G);
        const f32x2 Gb = ss.offb + (tbq - Lb[i] + lfb[i]); const f32x2 kdb = kb[i] * exp2x2(ss.glb - Gb);
        *(LAS unsigned*)(lds + T_KF + c * TS + 4 * dp) = cvtpk(kd.x, kd.y); *(LAS unsigned*)(lds + T_KB + c * TS + 4 * dp) = cvtpk(kdb.x, kdb.y); }
    if (ts == 0) { float* dec = (float*)(F.ws + WS_DEC) + (size_t)item * 256; *(f32x2*)(dec + 2 * dp) = exp2x2(ss.glf); *(f32x2*)(dec + 128 + 2 * dp) = exp2x2(ss.glb); }
    __syncthreads();
    const int w = F.wave, lane = F.lane, r = lane & 31, hh = lane >> 5, blk = (lane >> 4) & 1, q = (lane & 15) >> 2, p = lane & 3;
    const int dt = w >> 1, et0 = (w & 1) * 2;
#pragma unroll
    for (int dir = 0; dir < 2; ++dir) { const int TK = dir ? T_KB : T_KF;
#pragma unroll
        for (int e2 = 0; e2 < 2; ++e2) { const int et = et0 + e2; f32x16 acc;
#pragma unroll
            for (int i = 0; i < 16; ++i) acc[i] = 0.f;
#pragma unroll
            for (int ks = 0; ks < 4; ++ks) {
                const LAS unsigned char* ap = lds + TK + (16 * ks + 8 * hh + q) * TS + (32 * dt + 16 * blk + 4 * p) * 2;
                const LAS unsigned char* bp = lds + T_V + (16 * ks + 8 * hh + q) * TS + (32 * et + 16 * blk + 4 * p) * 2;
                const bf16x8 a = cat8(tr16(ap), tr16(ap + 4 * TS)), bq = cat8(tr16(bp), tr16(bp + 4 * TS));
                acc = MFMA32(a, bq, acc); }
            bf16* dsb = (bf16*)(F.ws + WS_DS) + ((size_t)(item * 2 + dir) * 128 + 32 * et + r) * 128 + 32 * dt + 4 * hh;
#pragma unroll
            for (int g4 = 0; g4 < 4; ++g4) { u32x2 wv; wv.x = cvtpk(acc[4 * g4], acc[4 * g4 + 1]); wv.y = cvtpk(acc[4 * g4 + 2], acc[4 * g4 + 3]); *(u32x2*)(dsb + 8 * g4) = wv; } } }
    __syncthreads();
}

DI void hgrn_scan(Frame& F) {
    F.refresh();
    const bf16* dS = (const bf16*)(F.ws + WS_DS); bf16* Sst = (bf16*)((unsigned char*)F.out + OUT_SST); const float* dec = (const float*)(F.ws + WS_DEC);
    const int gt = F.vcu * 512 + F.tid, NGT = F.G * 512;
    for (int id = gt; id < BG * 4 * 2 * 128 * 32; id += NGT) {
        const int d4 = id & 31, e = (id >> 5) & 127, dir = (id >> 12) & 1, bh = id >> 13;
        f32x4 S = (f32x4){0.f, 0.f, 0.f, 0.f};
#pragma unroll 4
        for (int s = 0; s < 32; ++s) { const int n = dir ? 31 - s : s, item = bh * 32 + n;
            const size_t off = ((size_t)(item * 2 + dir) * 128 + e) * 128 + d4 * 4;
            u32x2 o; o.x = cvtpk(S.x, S.y); o.y = cvtpk(S.z, S.w); *(u32x2*)(Sst + off) = o;
            const f32x4 dc = *(const f32x4*)(dec + (size_t)(item * 2 + dir) * 128 + d4 * 4);
            const u32x2 wv = *(const u32x2*)(dS + off);
            S.x = dc.x * S.x + bflo(wv.x); S.y = dc.y * S.y + bfhi(wv.x); S.z = dc.z * S.z + bflo(wv.y); S.w = dc.w * S.w + bfhi(wv.y); }
    }
}

DI void hgrn_c_item(Frame& F, int item, bool has_next) {
    F.refresh();
    constexpr int T_QRF = 0, T_KRF = 17408, T_QGF = 34816, T_QRB = 52224, T_KRB = 69632, T_QGB = 87040, T_V = 104448, TOT = 121856, O_OFF = 0, OS = 132;
    LAS unsigned char* lds = F.lds;
    const int n = item & 31, h = (item >> 5) & 3, b = item >> 7;
    const size_t row0 = (size_t)b * SEQ + n * CHUNK;
    const bf16* proj = (const bf16*)(F.ws + WS_PROJ) + row0 * PC;
    const int tid = F.tid, dp = tid & 63, ts = F.wave;
    const float* lbp = (const float*)(F.ws + WS_LB);
    const f32x2 lbf = *(const f32x2*)(lbp + h * 128 + 2 * dp), lbb = *(const f32x2*)(lbp + 512 + h * 128 + 2 * dp);
    stage_tile(lds + T_V, proj + C_HI + h * 128, tid); stage_tile(lds + T_KRF, proj + C_FF + h * 128, tid); stage_tile(lds + T_KRB, proj + C_FB + h * 128, tid); stage_tile(lds + T_QRF, proj + C_HQ + h * 128, tid);
    float tch = 0.f, tch2 = 0.f;
    if (has_next) { const bf16* pn = proj + (size_t)CHUNK * PC + h * 128; const int i128 = tid & 127, wsel = tid >> 7; tch = touch_tile(pn + (wsel == 0 ? C_HI : wsel == 1 ? C_FF : wsel == 2 ? C_FB : C_HQ), i128);
        tch2 = *(const float*)((const unsigned char*)F.out + OUT_SST + (size_t)(item + 1) * 65536 + (size_t)tid * 128); }
    __syncthreads();
    f32x2 qv[8];
#pragma unroll
    for (int i = 0; i < 8; ++i) { const unsigned w = *(const LAS unsigned*)(lds + T_QRF + (8 * ts + i) * TS + 4 * dp); const float z0 = bflo(w), z1 = bfhi(w); qv[i] = (f32x2){z0 * fast_sig(z0), z1 * fast_sig(z1)}; }
    f32x2 Lf[8], kf[8], lff[8], Lb[8], kb[8], lfb[8];
    gate8(lds + T_KRF, dp, ts, lbf, Lf, kf, lff);
    gate8(lds + T_KRB, dp, ts, lbb, Lb, kb, lfb);
    LAS float* tot = (LAS float*)(lds + TOT);
    *(LAS f32x2*)(tot + ts * 128 + 2 * dp) = Lf[7]; *(LAS f32x2*)(tot + (8 + ts) * 128 + 2 * dp) = Lb[7];
    asm volatile("" :: "v"(tch), "v"(tch2));
    __syncthreads();
    {
        const SliceSums ss = slice_sums(tot, dp, ts);
        const f32x2 tbq = Lb[7];
#pragma unroll
        for (int i = 0; i < 8; ++i) { const int c = 8 * ts + i; const int o = c * TS + 4 * dp;
            const f32x2 G = ss.offf + Lf[i]; const f32x2 x = G - ss.greff;
            const f32x2 qr = qv[i] * exp2x2(x), kr = kf[i] * exp2x2(-x), qg = qv[i] * exp2x2(G);
            *(LAS unsigned*)(lds + T_QRF + o) = cvtpk(qr.x, qr.y); *(LAS unsigned*)(lds + T_KRF + o) = cvtpk(kr.x, kr.y); *(LAS unsigned*)(lds + T_QGF + o) = cvtpk(qg.x, qg.y);
            const f32x2 Gb = ss.offb + (tbq - Lb[i] + lfb[i]); const f32x2 xb = Gb - ss.grefb;
            const f32x2 qrb = qv[i] * exp2x2(xb), krb = kb[i] * exp2x2(-xb), qgb = qv[i] * exp2x2(Gb);
            *(LAS unsigned*)(lds + T_QRB + o) = cvtpk(qrb.x, qrb.y); *(LAS unsigned*)(lds + T_KRB + o) = cvtpk(krb.x, krb.y); *(LAS unsigned*)(lds + T_QGB + o) = cvtpk(qgb.x, qgb.y); }
    }
    __syncthreads();
    const int w = F.wave, lane = F.lane, r = lane & 31, hh = lane >> 5, blk = (lane >> 4) & 1, q = (lane & 15) >> 2, p = lane & 3;
    const int ct = w >> 2, et = w & 3;
    const bf16* Sst = (const bf16*)((const unsigned char*)F.out + OUT_SST);
    f32x16 o;
#pragma unroll
    for (int i = 0; i < 16; ++i) o[i] = 0.f;
#pragma unroll
    for (int dir = 0; dir < 2; ++dir) { const int TQR = dir ? T_QRB : T_QRF, TKR = dir ? T_KRB : T_KRF, TQG = dir ? T_QGB : T_QGF;
#pragma unroll
        for (int st = 0; st < 2; ++st) {
            if (dir == 0 ? (st > ct) : (st < ct)) continue;
            f32x16 X;
#pragma unroll
            for (int i = 0; i < 16; ++i) X[i] = 0.f;
#pragma unroll
            for (int ks = 0; ks < 8; ++ks) { const bf16x8 a = *(const LAS bf16x8*)(lds + TKR + (32 * st + r) * TS + (16 * ks + 8 * hh) * 2), bq = *(const LAS bf16x8*)(lds + TQR + (32 * ct + r) * TS + (16 * ks + 8 * hh) * 2);
                X = MFMA32(a, bq, X); }
            const int cc = 32 * ct + r;
#pragma unroll
            for (int i = 0; i < 16; ++i) { const int s = 32 * st + crow(i, hh); const bool keep = dir == 0 ? (s <= cc) : (s >= cc); X[i] = keep ? X[i] : 0.f; }
#pragma unroll
            for (int s2 = 0; s2 < 2; ++s2) { const bf16x8 xs = pack8(X, s2);
                const LAS unsigned char* vp = lds + T_V + (32 * st + 16 * s2 + 4 * hh + q) * TS + (32 * et + 16 * blk + 4 * p) * 2;
                const bf16x8 pb = cat8(tr16(vp), tr16(vp + 8 * TS));
                o = MFMA32(xs, pb, o); }
        }
        const bf16* sp = Sst + ((size_t)(item * 2 + dir) * 128 + 32 * et + r) * 128 + 8 * hh;
#pragma unroll
        for (int ks = 0; ks < 8; ++ks) { const bf16x8 a = *(const LAS bf16x8*)(lds + TQG + (32 * ct + r) * TS + (16 * ks + 8 * hh) * 2); const bf16x8 bq = *(const bf16x8*)(sp + 16 * ks);
            o = MFMA32(a, bq, o); }
    }
    unsigned hw[8];
#pragma unroll
    for (int k = 0; k < 8; ++k) hw[k] = *(const unsigned*)(proj + (size_t)(8 * w + k) * PC + C_HG + h * 128 + 2 * lane);
    __syncthreads();
    LAS float* O = (LAS float*)(lds + O_OFF);
#pragma unroll
    for (int i = 0; i < 16; ++i) O[(32 * ct + crow(i, hh)) * OS + 32 * et + r] = o[i];
    __syncthreads();
    const f32x2 gn = *(const f32x2*)(F.hg_norm_g + h * 128 + 2 * lane);
    bf16* yhg = (bf16*)(F.ws + WS_YHG);
    const int a16 = (lane ^ 16) << 2, a32 = (lane ^ 32) << 2;
#pragma unroll
    for (int k = 0; k < 8; ++k) { const int c = 8 * w + k; const f32x2 v = *(const LAS f32x2*)(O + c * OS + 2 * lane);
        float ss = row_sum16(v.x * v.x + v.y * v.y); ss += bperm_f(a16, ss); ss += bperm_f(a32, ss);
        const float rstd = __builtin_amdgcn_rsqf(ss * (1.0f / 128.0f) + EPS);
        const float z0 = bflo(hw[k]), z1 = bfhi(hw[k]);
        const float y0 = v.x * rstd * gn.x * (z0 * fast_sig(z0)), y1 = v.y * rstd * gn.y * (z1 * fast_sig(z1));
        *(unsigned*)(yhg + (row0 + c) * 512 + h * 128 + 2 * lane) = cvtpk(y0, y1); }
    __syncthreads();
}

DI void attn_item(Frame& F, int g, int item) {
    F.refresh();
    constexpr int KS = 272, VS = 528, K_OFF = 0, V_OFF = 69632;
    LAS unsigned char* lds = F.lds;
    const int qb = item & 7, h = (item >> 3) & 3, b = item >> 5, bglob = g * BG + b;
    const bf16* Km = (const bf16*)(F.ws + WS_KMEM) + (size_t)bglob * 256 * 512 + h * 128;
    const bf16* VT = (const bf16*)(F.ws + WS_VT) + (size_t)(h * 128) * 4096 + bglob * 256;
    const int tid = F.tid;
#pragma unroll
    for (int i = 0; i < 8; ++i) { const int id = tid + 512 * i, key = id >> 4, ch = id & 15;
        *(LAS u32x4*)(lds + K_OFF + key * KS + ch * 16) = *(const u32x4*)(Km + (size_t)key * 512 + ch * 8); }
#pragma unroll
    for (int i = 0; i < 8; ++i) { const int id = tid + 512 * i, e = id >> 5, ch = id & 31;
        *(LAS u32x4*)(lds + V_OFF + e * VS + ch * 16) = *(const u32x4*)(VT + (size_t)e * 4096 + ch * 8); }
    __syncthreads();
    const int w = F.wave, lane = F.lane, r = lane & 31, hh = lane >> 5;
    const size_t qrow0 = (size_t)b * SEQ + qb * 256 + w * 32;
    const bf16* proj = (const bf16*)(F.ws + WS_PROJ);
    bf16x8 qf[8];
#pragma unroll
    for (int ks = 0; ks < 8; ++ks) qf[ks] = *(const bf16x8*)(proj + (qrow0 + r) * PC + C_MQ + h * 128 + 16 * ks + 8 * hh);
    const float scale = 0.08838834764831845f;
    float m_run = -INFINITY, l_run = 0.f;
#pragma unroll 1
    for (int kt = 0; kt < 8; ++kt) {
        f32x16 X;
#pragma unroll
        for (int i = 0; i < 16; ++i) X[i] = 0.f;
#pragma unroll
        for (int ks = 0; ks < 8; ++ks) { const bf16x8 a = *(const LAS bf16x8*)(lds + K_OFF + (32 * kt + r) * KS + (16 * ks + 8 * hh) * 2); X = MFMA32(a, qf[ks], X); }
        float tm = X[0];
#pragma unroll
        for (int i = 1; i < 16; ++i) tm = fmaxf(tm, X[i]);
        tm *= scale;
        const float mn = fmaxf(m_run, tm); float ls = 0.f;
#pragma unroll
        for (int i = 0; i < 16; ++i) ls += __expf(X[i] * scale - mn);
        l_run = l_run * __expf(m_run - mn) + ls; m_run = mn;
    }
    { const float mo = __shfl_xor(m_run, 32), lo = __shfl_xor(l_run, 32); const float m = fmaxf(m_run, mo);
      l_run = l_run * __expf(m_run - m) + lo * __expf(mo - m); m_run = m; }
    const float inv_l = 1.0f / l_run;
    f32x16 O[4];
#pragma unroll
    for (int e = 0; e < 4; ++e)
#pragma unroll
        for (int i = 0; i < 16; ++i) O[e][i] = 0.f;
#pragma unroll 1
    for (int kt = 0; kt < 8; ++kt) {
        f32x16 X;
#pragma unroll
        for (int i = 0; i < 16; ++i) X[i] = 0.f;
#pragma unroll
        for (int ks = 0; ks < 8; ++ks) { const bf16x8 a = *(const LAS bf16x8*)(lds + K_OFF + (32 * kt + r) * KS + (16 * ks + 8 * hh) * 2); X = MFMA32(a, qf[ks], X); }
#pragma unroll
        for (int i = 0; i < 16; ++i) X[i] = __expf(X[i] * scale - m_run) * inv_l;
#pragma unroll
        for (int s2 = 0; s2 < 2; ++s2) { const bf16x8 xs = pack8(X, s2);
#pragma unroll
            for (int e = 0; e < 4; ++e) { const LAS unsigned char* vp = lds + V_OFF + (32 * e + r) * VS + (32 * kt + 16 * s2 + 4 * hh) * 2;
                const bf16x8 pb = cat8(*(const LAS s16x4*)vp, *(const LAS s16x4*)(vp + 16));
                O[e] = MFMA32(xs, pb, O[e]); } }
    }
    bf16* ymx = (bf16*)(F.ws + WS_YMX);
#pragma unroll
    for (int e = 0; e < 4; ++e)
#pragma unroll
        for (int i = 0; i < 16; ++i) ymx[(qrow0 + crow(i, hh)) * 512 + h * 128 + 32 * e + r] = (bf16)f2bf(O[e][i]);
    __syncthreads();
}

DI void conv_phase(Frame& F) {
    F.refresh();
    const bf16* proj = (const bf16*)(F.ws + WS_PROJ); bf16* ysc = (bf16*)(F.ws + WS_YSC); const float* cw = F.sc_conv_w;
    const int gt = F.vcu * 512 + F.tid, NGT = F.G * 512;
    for (int id = gt; id < TG * 64; id += NGT) {
        const int c8 = id & 63, t = id >> 6, ts = t & (SEQ - 1);
        const bf16* pr = proj + (size_t)t * PC + c8 * 8;
        const u32x4 z4 = (u32x4){0u, 0u, 0u, 0u};
        const u32x4 sb = *(const u32x4*)(pr + C_SB), c1 = *(const u32x4*)(pr + C_SC), h1 = *(const u32x4*)(pr + C_SH);
        const u32x4 c0 = ts > 0 ? *(const u32x4*)(pr - PC + C_SC) : z4, h0 = ts > 0 ? *(const u32x4*)(pr - PC + C_SH) : z4;
        const u32x4 c2 = ts < SEQ - 1 ? *(const u32x4*)(pr + PC + C_SC) : z4, h2 = ts < SEQ - 1 ? *(const u32x4*)(pr + PC + C_SH) : z4;
        const f32x4 wa0 = *(const f32x4*)(cw + c8 * 8), wa1 = *(const f32x4*)(cw + c8 * 8 + 4), wb0 = *(const f32x4*)(cw + 512 + c8 * 8), wb1 = *(const f32x4*)(cw + 512 + c8 * 8 + 4),
                    wc0 = *(const f32x4*)(cw + 1024 + c8 * 8), wc1 = *(const f32x4*)(cw + 1024 + c8 * 8 + 4);
        float y[8];
#pragma unroll
        for (int k = 0; k < 4; ++k) {
            const float w0l = k < 2 ? wa0[2 * k] : wa1[2 * k - 4], w0h = k < 2 ? wa0[2 * k + 1] : wa1[2 * k - 3];
            const float w1l = k < 2 ? wb0[2 * k] : wb1[2 * k - 4], w1h = k < 2 ? wb0[2 * k + 1] : wb1[2 * k - 3];
            const float w2l = k < 2 ? wc0[2 * k] : wc1[2 * k - 4], w2h = k < 2 ? wc0[2 * k + 1] : wc1[2 * k - 3];
            y[2 * k]     = bflo(sb[k]) * (w0l * (bflo(c0[k]) * bflo(h0[k])) + w1l * (bflo(c1[k]) * bflo(h1[k])) + w2l * (bflo(c2[k]) * bflo(h2[k])));
            y[2 * k + 1] = bfhi(sb[k]) * (w0h * (bfhi(c0[k]) * bfhi(h0[k])) + w1h * (bfhi(c1[k]) * bfhi(h1[k])) + w2h * (bfhi(c2[k]) * bfhi(h2[k]))); }
        u32x4 o; o.x = cvtpk(y[0], y[1]); o.y = cvtpk(y[2], y[3]); o.z = cvtpk(y[4], y[5]); o.w = cvtpk(y[6], y[7]);
        *(u32x4*)(ysc + (size_t)t * 512 + c8 * 8) = o;
    }
}

DI unsigned ord_key(float v, int idx) { unsigned u = __builtin_bit_cast(unsigned, v); u ^= (u >> 31) ? 0xFFFFFFFFu : 0x80000000u; return (u & 0xFFFFFF80u) | (unsigned)(127 - idx); }
DI float key_val(unsigned k) { unsigned u = k & 0xFFFFFF80u; u = (u & 0x80000000u) ? (u ^ 0x80000000u) : ~u; return __builtin_bit_cast(float, u); }
DI float dot2bf(unsigned a, unsigned b, float c) { return __builtin_amdgcn_fdot2_f32_bf16(__builtin_bit_cast(bf16x2_t, a), __builtin_bit_cast(bf16x2_t, b), c, false); }
DI float dot8(const u32x4& a, const u32x4& b, float c) { c = dot2bf(a.x, b.x, c); c = dot2bf(a.y, b.y, c); c = dot2bf(a.z, b.z, c); return dot2bf(a.w, b.w, c); }
__host__ __device__ constexpr int cand_off(int i) { return i == 0 ? 0 : i == 1 ? 16 : i == 2 ? 24 : i == 3 ? 29 : i == 4 ? 33 : i == 5 ? 36 : i == 6 ? 38 : i == 7 ? 40 : 34 + i; }
__host__ __device__ constexpr int cand_i(int c) { return c < 16 ? 0 : c < 24 ? 1 : c < 29 ? 2 : c < 33 ? 3 : c < 36 ? 4 : c < 38 ? 5 : c < 40 ? 6 : c < 42 ? 7 : c - 34; }
__host__ __device__ constexpr int cand_pos(int c) { return cand_i(c) * 16 + (c - cand_off(cand_i(c))); }

DI void peer_topk(const float* srow, LAS int* widx, LAS float* wgate, int lane) {
    const int gq = lane >> 4, li = lane & 15;
    const int ci = cand_i(lane), cj = lane - cand_off(ci), cpos = ci * 16 + cj; const bool cvalid = lane < 50;
    const float* sl = srow + (gq >> 1) * 256 + (gq & 1) * 128 + li * 8;
    f32x4 nva = *(const f32x4*)sl, nvb = *(const f32x4*)(sl + 4);
#pragma unroll 1
    for (int hp = 0; hp < 4; ++hp) {
        const f32x4 va = nva, vb = nvb;
        if (hp < 3) { nva = *(const f32x4*)(sl + 512 * (hp + 1)); nvb = *(const f32x4*)(sl + 512 * (hp + 1) + 4); }
        unsigned k[8];
        k[0] = ord_key(va.x, li * 8 + 0); k[1] = ord_key(va.y, li * 8 + 1); k[2] = ord_key(va.z, li * 8 + 2); k[3] = ord_key(va.w, li * 8 + 3);
        k[4] = ord_key(vb.x, li * 8 + 4); k[5] = ord_key(vb.y, li * 8 + 5); k[6] = ord_key(vb.z, li * 8 + 6); k[7] = ord_key(vb.w, li * 8 + 7);
        unsigned mine = 0u;
#pragma unroll
        for (int rd = 0; rd < 16; ++rd) {
            const unsigned m = row_max16(max(max(max(k[0], k[1]), max(k[2], k[3])), max(max(k[4], k[5]), max(k[6], k[7]))));
            mine = (li == rd) ? m : mine;
#pragma unroll
            for (int j = 0; j < 8; ++j) k[j] = (k[j] == m) ? 0u : k[j];
        }
        const float sc = key_val(mine); const int ix = 127 - (int)(mine & 127u);
#pragma unroll
        for (int hsel = 0; hsel < 2; ++hsel) {
            const float a = __shfl(sc, 32 * hsel + ci), bq = __shfl(sc, 32 * hsel + 16 + cj);
            const int ia = __shfl(ix, 32 * hsel + ci), ib = __shfl(ix, 32 * hsel + 16 + cj);
            const float cs = a + bq;
            unsigned ck = __builtin_bit_cast(unsigned, cs); ck ^= (ck >> 31) ? 0xFFFFFFFFu : 0x80000000u; ck = cvalid ? ((ck & ~63u) | (unsigned)(63 - lane)) : 0u;
            int rank = 0;
#pragma unroll
            for (int c2 = 0; c2 < 50; ++c2) { const unsigned k2 = (unsigned)__builtin_amdgcn_readlane((int)ck, c2); rank += (int)(k2 > ck); }
            const bool sel = cvalid && rank < 16;
            const float mx = __builtin_bit_cast(float, __builtin_amdgcn_readlane(__builtin_bit_cast(int, cs), 0));
            const float ev = sel ? __expf(cs - mx) : 0.f;
            const float sum = wave_sum(ev);
            if (sel) { const int hd = 2 * hp + hsel; widx[hd * 16 + rank] = ia * 128 + ib; wgate[hd * 16 + rank] = ev / sum; }
        }
    }
}

constexpr float PEER_TAB_SCALE = 256.0f;
#ifndef PEER_PROBE
#define PEER_PROBE 0
#endif
DI void peer_phase(Frame& F, int tg) {
    F.refresh();
    const int gw = F.vcu * NWAVES + F.wave, NGW = F.G * NWAVES, lane = F.lane, gq = lane >> 4, li = lane & 15;
    LAS int* widx = (LAS int*)(F.lds + F.wave * 1024); LAS float* wgate = (LAS float*)(F.lds + F.wave * 1024 + 512);
    const unsigned char* U = F.ws + WS_U; const unsigned char* V = F.ws + WS_V;
    const int a4 = (lane ^ 4) << 2, a8 = (lane ^ 8) << 2, a16 = (lane ^ 16) << 2, a32 = (lane ^ 32) << 2;
    const bool b0 = lane & 1, b1 = lane & 2, b2 = lane & 4, b3 = lane & 8, b4 = lane & 16, b5 = lane & 32;
    for (int tl = gw; tl < TG; tl += NGW) {
        const size_t t = (size_t)tg * TG + tl;
        float tch0 = 0.f, tch1 = 0.f, tch2 = 0.f, tch3 = 0.f;
        if (tl + NGW < TG) { const size_t tn = t + NGW;
            tch0 = ((const float*)(F.ws + WS_S) + (size_t)(tl + NGW) * 2048)[lane * 32];
            tch1 = (F.out + tn * 1024)[(lane & 31) * 32];
            tch2 = ((const float*)((const bf16*)(F.ws + WS_XG) + tn * 1024))[(lane & 15) * 32];
            tch3 = ((const float*)(F.ws + WS_SSP) + tn * 16)[lane & 15]; }
        for (int rp_ = 0; rp_ < (PEER_PROBE == 1 ? 2 : 1); ++rp_) peer_topk((const float*)(F.ws + WS_S) + (size_t)tl * 2048, widx, wgate, lane);
        asm volatile("s_waitcnt lgkmcnt(0)" :: "v"(tch0), "v"(tch1), "v"(tch2), "v"(tch3) : "memory");
        const f32x4* sp = (const f32x4*)((const float*)(F.ws + WS_SSP) + t * 16);
        const f32x4 s0 = sp[0], s1 = sp[1], s2 = sp[2], s3 = sp[3];
        const float ssx = ((s0[0] + s0[1]) + (s0[2] + s0[3])) + ((s1[0] + s1[1]) + (s1[2] + s1[3])) + ((s2[0] + s2[1]) + (s2[2] + s2[3])) + ((s3[0] + s3[1]) + (s3[2] + s3[3]));
        const float ascale = (1.0f / sqrtf(ssx * (1.0f / 1024.0f) + EPS)) * (1.0f / PEER_TAB_SCALE);
        f32x2 of[8];
        for (int rg_ = 0; rg_ < (PEER_PROBE == 2 ? 2 : 1); ++rg_) {
#define PEER_LOADROW(buf, k) do { const int k_ = (k); const int e_ = widx[((k_ & 31) >> 4) * 64 + 4 * (k_ & 15) + gq]; const unsigned char* r_ = (k_ < 32 ? U : V) + (size_t)e_ * 1024 + 16 * li; \
        buf[0] = *(const u32x4*)(r_); buf[1] = *(const u32x4*)(r_ + 256); buf[2] = *(const u32x4*)(r_ + 512); buf[3] = *(const u32x4*)(r_ + 768); } while (0)
        u32x4 r0[4], r1[4], r2[4], r3[4];
        PEER_LOADROW(r0, 0); PEER_LOADROW(r1, 1); PEER_LOADROW(r2, 2); PEER_LOADROW(r3, 3);
        float totA = 0.f, totB = 0.f;
        {
            f32x2 hreg[4][8];
            const bf16* xr = (const bf16*)(F.ws + WS_XG) + t * 1024 + 16 * li;
#pragma unroll
            for (int c = 0; c < 4; ++c) { const u32x4 w0 = *(const u32x4*)(xr + 256 * c), w1 = *(const u32x4*)(xr + 256 * c + 8);
#pragma unroll
                for (int q = 0; q < 4; ++q) { hreg[c][q] = (f32x2){bflo(w0[q]), bfhi(w0[q])}; hreg[c][4 + q] = (f32x2){bflo(w1[q]), bfhi(w1[q])}; } }
#define PEER_DOT(dst, buf) do { f32x2 acc_ = (f32x2){0.f, 0.f}; _Pragma("unroll") for (int c = 0; c < 4; ++c) _Pragma("unroll") for (int q = 0; q < 4; ++q) { \
            acc_ = __builtin_amdgcn_cvt_pk_f32_fp8(buf[c][q], false) * hreg[c][2 * q] + acc_; acc_ = __builtin_amdgcn_cvt_pk_f32_fp8(buf[c][q], true) * hreg[c][2 * q + 1] + acc_; } dst = acc_.x + acc_.y; } while (0)
#pragma unroll 1
            for (int mi = 0; mi < 8; ++mi) {
                float p0, p1, p2, p3;
                PEER_DOT(p0, r0); __builtin_amdgcn_sched_barrier(0); PEER_LOADROW(r0, 4 * mi + 4); __builtin_amdgcn_sched_barrier(0);
                PEER_DOT(p1, r1); __builtin_amdgcn_sched_barrier(0); PEER_LOADROW(r1, 4 * mi + 5); __builtin_amdgcn_sched_barrier(0);
                PEER_DOT(p2, r2); __builtin_amdgcn_sched_barrier(0); PEER_LOADROW(r2, 4 * mi + 6); __builtin_amdgcn_sched_barrier(0);
                PEER_DOT(p3, r3); __builtin_amdgcn_sched_barrier(0); PEER_LOADROW(r3, 4 * mi + 7); __builtin_amdgcn_sched_barrier(0);
                const float qa = (b0 ? p1 : p0) + dpp_f<0xB1>(b0 ? p0 : p1), qb = (b0 ? p3 : p2) + dpp_f<0xB1>(b0 ? p2 : p3);
                float rr = (b1 ? qb : qa) + dpp_f<0x4E>(b1 ? qa : qb);
                rr += bperm_f(a4, rr); rr += bperm_f(a8, rr);
                const bool mine = (li >> 2) == (mi & 3);
                totA = (mine && mi < 4) ? rr : totA; totB = (mine && mi >= 4) ? rr : totB;
            }
        }
        float cfA, cfB;
        { const float av = totA * ascale; cfA = wgate[4 * li + gq] * (0.5f * av * (1.0f + erff(av * 0.70710678118654752f))) * (1.0f / PEER_TAB_SCALE); }
        { const float av = totB * ascale; cfB = wgate[64 + 4 * li + gq] * (0.5f * av * (1.0f + erff(av * 0.70710678118654752f))) * (1.0f / PEER_TAB_SCALE); }
        f32x2 o2[4][8];
#pragma unroll
        for (int c = 0; c < 4; ++c)
#pragma unroll
            for (int m = 0; m < 8; ++m) o2[c][m] = (f32x2){0.f, 0.f};
#define PEER_AXPY(buf, kk) do { const float cv_ = bperm_f(((lane & 48) | ((kk) & 15)) << 2, ((kk) & 16) ? cfB : cfA); const f32x2 cc_ = (f32x2){cv_, cv_}; \
            _Pragma("unroll") for (int c = 0; c < 4; ++c) _Pragma("unroll") for (int q = 0; q < 4; ++q) { \
            o2[c][2 * q] = __builtin_amdgcn_cvt_pk_f32_fp8(buf[c][q], false) * cc_ + o2[c][2 * q]; o2[c][2 * q + 1] = __builtin_amdgcn_cvt_pk_f32_fp8(buf[c][q], true) * cc_ + o2[c][2 * q + 1]; } } while (0)
#pragma unroll 1
        for (int mi = 0; mi < 8; ++mi) {
            const bool more = mi < 7;
            PEER_AXPY(r0, 4 * mi + 0); __builtin_amdgcn_sched_barrier(0); if (more) PEER_LOADROW(r0, 32 + 4 * mi + 4); __builtin_amdgcn_sched_barrier(0);
            PEER_AXPY(r1, 4 * mi + 1); __builtin_amdgcn_sched_barrier(0); if (more) PEER_LOADROW(r1, 32 + 4 * mi + 5); __builtin_amdgcn_sched_barrier(0);
            PEER_AXPY(r2, 4 * mi + 2); __builtin_amdgcn_sched_barrier(0); if (more) PEER_LOADROW(r2, 32 + 4 * mi + 6); __builtin_amdgcn_sched_barrier(0);
            PEER_AXPY(r3, 4 * mi + 3); __builtin_amdgcn_sched_barrier(0); if (more) PEER_LOADROW(r3, 32 + 4 * mi + 7); __builtin_amdgcn_sched_barrier(0);
        }
#undef PEER_LOADROW
#undef PEER_DOT
#undef PEER_AXPY
        f32x2 o1[2][8];
#pragma unroll
        for (int c = 0; c < 2; ++c)
#pragma unroll
            for (int m = 0; m < 8; ++m) { const f32x2 keep = b4 ? o2[c + 2][m] : o2[c][m], send = b4 ? o2[c][m] : o2[c + 2][m];
                o1[c][m] = keep + (f32x2){bperm_f(a16, send.x), bperm_f(a16, send.y)}; }
#pragma unroll
        for (int m = 0; m < 8; ++m) { const f32x2 keep = b5 ? o1[1][m] : o1[0][m], send = b5 ? o1[0][m] : o1[1][m];
            of[m] = keep + (f32x2){bperm_f(a32, send.x), bperm_f(a32, send.y)}; }
#pragma unroll
        for (int m = 0; m < 8; ++m) asm volatile("" : "+v"(of[m].x), "+v"(of[m].y));
        }
        const int cidx = (b4 ? 2 : 0) + (b5 ? 1 : 0);
        float* xo = F.out + t * 1024 + 256 * cidx + 16 * li; const float* gfp = F.final_norm_g + 256 * cidx + 16 * li;
        f32x4 a[4]; float ss = 0.f;
#pragma unroll
        for (int k = 0; k < 4; ++k) { a[k] = *(const f32x4*)(xo + 4 * k) + (f32x4){of[2 * k].x, of[2 * k].y, of[2 * k + 1].x, of[2 * k + 1].y};
            ss += (a[k].x * a[k].x + a[k].y * a[k].y) + (a[k].z * a[k].z + a[k].w * a[k].w); }
        ss = wave_sum(ss);
        const float rf = 1.0f / sqrtf(ss * (1.0f / 1024.0f) + EPS);
#pragma unroll
        for (int k = 0; k < 4; ++k) *(f32x4*)(xo + 4 * k) = a[k] * rf * *(const f32x4*)(gfp + 4 * k);
        asm volatile("s_waitcnt lgkmcnt(0)" ::: "memory");
    }
}

DI void convert_uv(Frame& F) {
    F.refresh();
    const int gt = F.vcu * 512 + F.tid, NGT = F.G * 512;
    for (int id = gt; id < 2 * 16384 * 64; id += NGT) {
        const int which = id >> 20, off = (id & ((1 << 20) - 1)) * 16;
        const float* src = (which ? F.peer_v : F.peer_u) + off; unsigned char* dst = F.ws + (which ? WS_V : WS_U) + off;
        u32x4 o;
#pragma unroll
        for (int q = 0; q < 4; ++q) { const f32x4 v = *(const f32x4*)(src + 4 * q) * PEER_TAB_SCALE; int pk = __builtin_amdgcn_cvt_pk_fp8_f32(v.x, v.y, 0, false); pk = __builtin_amdgcn_cvt_pk_fp8_f32(v.z, v.w, pk, true); o[q] = (unsigned)pk; }
        *(u32x4*)dst = o;
    }
}

constexpr int N_PHASES = 19;
struct Args { const float* in[17]; float* out; unsigned char* ws; int ph_lo, ph_hi; };

__global__ void __launch_bounds__(NWAVES * 64, 2) fwd_kernel(Args args) {
    extern __shared__ __attribute__((aligned(16))) unsigned char lds_raw[];
    Frame F;
    F.lds = (LAS unsigned char*)lds_raw;
    F.tid = threadIdx.x; F.lane = F.tid & 63; F.wave = __builtin_amdgcn_readfirstlane(F.tid >> 6);
    F.G = gridDim.x; { const int bx = blockIdx.x; F.vcu = (F.G % 8 == 0) ? (bx % 8) * (F.G / 8) + bx / 8 : bx; }
    F.x = args.in[0]; F.mem = args.in[1]; F.norm_mix_g = args.in[2]; F.w_in = args.in[3]; F.hg_lb = args.in[4]; F.hg_norm_g = args.in[5]; F.sc_conv_w = args.in[6];
    F.mem_norm_g = args.in[7]; F.w_mem_kv = args.in[8]; F.w_branch = args.in[9]; F.w_out = args.in[10]; F.norm_ffn_g = args.in[11]; F.peer_w_q = args.in[12];
    F.peer_sub_keys = args.in[13]; F.peer_u = args.in[14]; F.peer_v = args.in[15]; F.final_norm_g = args.in[16];
    F.out = args.out; F.ws = args.ws;
    volatile LAS unsigned* MISC = (volatile LAS unsigned*)(F.lds + MISC_OFF);
    for (int u = F.tid; u < (LDS_BYTES - MISC_OFF) / 4; u += NWAVES * 64) MISC[u] = 0u;
    __syncthreads();
    unsigned* barw = (unsigned*)(F.ws + WS_CTL) + CW_BAR;
    XcdBarrier bar; bar.bar = barw; bar.x = 0; bar.st = nullptr;
    const bool one_launch = (args.ph_hi - args.ph_lo) > 1;
    if (one_launch) bar = xcd_barrier_post(barw, MISC + 8);
    const int lo = args.ph_lo, hi = args.ph_hi;
#define IN(k) (lo <= (k) && (k) < hi)
#ifndef PMASK
#define PMASK 0x3ff
#endif
#define PC_(c) ((PMASK >> (c)) & 1)
#ifndef REP_MASK
#define REP_MASK 0
#endif
#define REPS(c) for (int rep_ = 0; rep_ < 1 + 2 * ((REP_MASK >> (c)) & 1); ++rep_)
#define SEAM(k) do { if (IN(k) && IN((k) + 1)) xcd_barrier(bar); } while (0)
    unsigned char* ws = F.ws;
    const int G = F.G, cid = (int)blockIdx.x;

    if (PC_(0) && IN(0)) { REPS(0) p0_prologue(F); } SEAM(0);

#pragma unroll 1
    for (int g = 0; g < NGRP; ++g) {
        const int pb = 1 + 6 * g;
        if (PC_(1) && IN(pb)) REPS(1) {
            pg8::InOrder S; S.init(TG, PC, G, cid); S.H = (const char*)(ws + WS_XG) + (size_t)g * TG * 1024 * 2; S.Win = (const char*)(ws + WS_WIN); S.Mn = (const char*)(ws + WS_MN); S.Wkv = (const char*)(ws + WS_WKV); S.n_extra = (g == 0) ? 64 : 0;
            pg8::EpiIn E{(bf16*)(ws + WS_PROJ), (bf16*)(ws + WS_KMEM), (bf16*)(ws + WS_VT)};
            pg8::gemm_phase<pg8::EpiIn, pg8::InOrder, true, true>(F.lds, pg8::Gemm{1024, 1024, 1024}, S, E);
        } SEAM(pb);
        if (PC_(2) && IN(pb + 1)) REPS(2) {
            for (int it = F.vcu * 4; it < BG * 4 * NCHUNK; it += G * 4) { for (int k = 0; k < 4; ++k) hgrn_a_item(F, it + k, k < 3); }
            for (int it = F.vcu; it < BG * 4 * 8; it += G) attn_item(F, g, it);
            conv_phase(F);
        } SEAM(pb + 1);
        if (PC_(3) && IN(pb + 2)) { REPS(3) hgrn_scan(F); } SEAM(pb + 2);
        if (PC_(4) && IN(pb + 3)) REPS(4) { for (int it = F.vcu * 4; it < BG * 4 * NCHUNK; it += G * 4) { for (int k = 0; k < 4; ++k) hgrn_c_item(F, it + k, k < 3); } } SEAM(pb + 3);
        if (PC_(5) && IN(pb + 4)) REPS(5) {
            pg8::BranchOrder S; S.init(TG, 1024, G, cid); S.Y = (const char*)(ws + WS_YHG); S.Wb = (const char*)(ws + WS_WBR);
            pg8::EpiBranch E{(const bf16*)(ws + WS_PROJ), (bf16*)(ws + WS_MACC), (bf16*)(ws + WS_MERGED)};
            pg8::gemm_phase<pg8::EpiBranch, pg8::BranchOrder, true, true>(F.lds, pg8::Gemm{512, 512, 512}, S, E);
        } SEAM(pb + 4);
        if (PC_(6) && IN(pb + 5)) REPS(6) {
            pg8::PlainOrder S; S.init(TG, 1024, G, cid); S.A = (const char*)(ws + WS_MERGED); S.Bt = (const char*)(ws + WS_WOUT); S.a_tile = 256 * 1024 * 2; S.b_tile = 256 * 1024 * 2;
            pg8::EpiOut E{F.x + (size_t)g * TG * 1024, F.out + (size_t)g * TG * 1024, (bf16*)(ws + WS_XG) + (size_t)g * TG * 1024, F.norm_ffn_g, (float*)(ws + WS_SSP) + (size_t)g * TG * 16};
            pg8::gemm_phase<pg8::EpiOut, pg8::PlainOrder, true, true>(F.lds, pg8::Gemm{1024, 1024, 1024}, S, E);
        } SEAM(pb + 5);
    }
#pragma unroll 1
    for (int tg = 0; tg < NGRP; ++tg) {
        const int pb = 13 + 3 * tg;
        if (PC_(7) && IN(pb)) REPS(7) {
            if (tg == 0) convert_uv(F);
            pg8::PlainOrder S; S.init(TG, 2048, G, cid); S.A = (const char*)(ws + WS_XG) + (size_t)tg * TG * 1024 * 2; S.Bt = (const char*)(ws + WS_WQ); S.a_tile = 256 * 1024 * 2; S.b_tile = 256 * 1024 * 2;
            pg8::EpiQ E{(bf16*)(ws + WS_Q), 2048, (const float*)(ws + WS_SSP) + (size_t)tg * TG * 16};
            pg8::gemm_phase<pg8::EpiQ, pg8::PlainOrder, true, true>(F.lds, pg8::Gemm{1024, 1024, 1024}, S, E);
        } SEAM(pb);
        if (PC_(8) && IN(pb + 1)) REPS(8) {
            pg8::ScoreOrder S; S.init(TG, 2048, G, cid); S.Q = (const char*)(ws + WS_Q); S.Kbd = (const char*)(ws + WS_KBD);
            pg8::EpiF32 E{(float*)(ws + WS_S), 2048};
            pg8::gemm_phase<pg8::EpiF32, pg8::ScoreOrder, true, true>(F.lds, pg8::Gemm{2048, 256, 256}, S, E);
        } SEAM(pb + 1);
        if (PC_(9) && IN(pb + 2)) { peer_phase(F, tg); } SEAM(pb + 2);
    }
#undef IN
#undef SEAM
}

extern "C" void kernel_launch(void* const* d_in, const int* in_sizes, int n_in, void* d_out, int out_size, void* d_ws, size_t ws_size, hipStream_t stream) {
    static int ready = 0;
    if (ready == 0) {
        if (n_in != 17 || out_size != T_ALL * D_MODEL || ws_size < WS_END) { fprintf(stderr, "kernel_launch: unexpected shapes (n_in %d, out %d, ws %zu)\n", n_in, out_size, ws_size); ready = -1; return; }
        if (hipFuncSetAttribute((const void*)fwd_kernel, hipFuncAttributeMaxDynamicSharedMemorySize, LDS_BYTES) != hipSuccess) { fprintf(stderr, "kernel_launch: hipFuncSetAttribute failed\n"); ready = -1; return; }
        ready = 1;
    }
    if (ready < 0) return;
    (void)hipMemsetAsync((char*)d_ws + WS_CTL, 0, CTL_ZERO_BYTES, stream);
    Args a{};
    for (int i = 0; i < 17; ++i) a.in[i] = (const float*)d_in[i];
    a.out = (float*)d_out; a.ws = (unsigned char*)d_ws;
    const int grid = 256;
#if MK_N_LAUNCHES == 1
    a.ph_lo = 0; a.ph_hi = N_PHASES;
    hipLaunchKernelGGL(fwd_kernel, dim3(grid), dim3(NWAVES * 64), LDS_BYTES, stream, a);
#else
    for (int li = 0; li < N_PHASES; ++li) { a.ph_lo = li; a.ph_hi = li + 1; hipLaunchKernelGGL(fwd_kernel, dim3(grid), dim3(NWAVES * 64), LDS_BYTES, stream, a); }
#endif
}
```

```cpp
#include <hip/hip_runtime.h>
#include <cstdio>
#include <cstdint>

#ifndef MK_N_LAUNCHES
#define MK_N_LAUNCHES 1
#endif

#define LAS __attribute__((address_space(3)))
#define GAS __attribute__((address_space(1)))
typedef unsigned short bf16;
typedef short bf16x8 __attribute__((ext_vector_type(8)));
typedef short s16x4 __attribute__((ext_vector_type(4)));
typedef short v4i16_t __attribute__((ext_vector_type(4)));
typedef float f32x2 __attribute__((ext_vector_type(2)));
typedef float f32x4 __attribute__((ext_vector_type(4)));
typedef float f32x16 __attribute__((ext_vector_type(16)));
typedef unsigned u32x2 __attribute__((ext_vector_type(2)));
typedef unsigned u32x4 __attribute__((ext_vector_type(4)));
typedef __bf16 bf16x2_t __attribute__((ext_vector_type(2)));
typedef GAS unsigned gu32;
#define RLX_AGENT __ATOMIC_RELAXED, __HIP_MEMORY_SCOPE_AGENT
#define DI __device__ __forceinline__

constexpr int D_MODEL = 1024, BATCH = 16, SEQ = 2048, T_ALL = BATCH * SEQ;
constexpr int NGRP = 2, BG = BATCH / NGRP, TG = BG * SEQ;
constexpr int PC = 7680;
constexpr int C_HQ = 0, C_HI = 512, C_FF = 1024, C_FB = 1536, C_HG = 2048, C_SB = 2560, C_SC = 3072, C_SH = 3584, C_MQ = 4096, C_GATE = 4608;
constexpr int NMEM = 256, CHUNK = 64, NCHUNK = SEQ / CHUNK;
constexpr float EPS = 1e-6f;

constexpr size_t MiB = 1u << 20;
constexpr size_t WS_CTL = 0, CTL_ZERO_BYTES = 1 * MiB;
constexpr size_t WS_LB = 1 * MiB;
constexpr size_t WS_SSP = 2 * MiB;
constexpr size_t WS_DEC = 4 * MiB;
constexpr size_t WS_WIN = 5 * MiB, WS_WKV = 20 * MiB, WS_WBR = 22 * MiB, WS_WOUT = 25 * MiB, WS_WQ = 27 * MiB, WS_KBD = 31 * MiB;
constexpr size_t WS_MN = 32 * MiB, WS_KMEM = 40 * MiB, WS_VT = 44 * MiB;
constexpr size_t WS_XG = 48 * MiB;
constexpr size_t WS_YHG = 112 * MiB, WS_YSC = 128 * MiB, WS_YMX = 144 * MiB;
constexpr size_t WS_DS = 160 * MiB;
constexpr size_t WS_MACC = 160 * MiB;
constexpr size_t WS_MERGED = 224 * MiB;
constexpr size_t WS_PROJ = 256 * MiB;
constexpr size_t WS_U = 496 * MiB, WS_V = 504 * MiB;
constexpr size_t WS_Q = 176 * MiB;
constexpr size_t WS_S = 256 * MiB;
constexpr size_t WS_END = 512 * MiB;
constexpr size_t OUT_SST = 64 * MiB;

constexpr int LDS_BYTES = 160 * 1024;
constexpr int MISC_OFF = LDS_BYTES - 512;
constexpr int NWAVES = 8;

DI unsigned f2bf(float f) { unsigned u = __builtin_bit_cast(unsigned, f); return (u + 0x7fffu + ((u >> 16) & 1u)) >> 16; }
DI unsigned pk2(float lo, float hi) { return f2bf(lo) | (f2bf(hi) << 16); }
DI float bf2f(unsigned short b) { return __builtin_bit_cast(float, (unsigned)b << 16); }
DI float bflo(unsigned w) { return __builtin_bit_cast(float, w << 16); }
DI float bfhi(unsigned w) { return __builtin_bit_cast(float, w & 0xffff0000u); }
DI float wave_sum(float v) {
#pragma unroll
    for (int o = 1; o < 64; o <<= 1) v += __shfl_xor(v, o);
    return v;
}
DI unsigned cvtpk(float lo, float hi) { f32x2 v = {lo, hi}; bf16x2_t b = __builtin_convertvector(v, bf16x2_t); return __builtin_bit_cast(unsigned, b); }
template <int CTRL> DI unsigned dpp_u(unsigned v) { return (unsigned)__builtin_amdgcn_update_dpp(0, (int)v, CTRL, 0xF, 0xF, false); }
template <int CTRL> DI float dpp_f(float v) { return __builtin_bit_cast(float, __builtin_amdgcn_update_dpp(0, __builtin_bit_cast(int, v), CTRL, 0xF, 0xF, false)); }
DI float bperm_f(int addr, float v) { return __builtin_bit_cast(float, __builtin_amdgcn_ds_bpermute(addr, __builtin_bit_cast(int, v))); }
DI unsigned row_max16(unsigned m) { m = max(m, dpp_u<0xB1>(m)); m = max(m, dpp_u<0x4E>(m)); m = max(m, dpp_u<0x141>(m)); return max(m, dpp_u<0x140>(m)); }
DI float row_sum16(float v) { v += dpp_f<0xB1>(v); v += dpp_f<0x4E>(v); v += dpp_f<0x141>(v); return v + dpp_f<0x140>(v); }

DI float fast_sig(float z) { return __builtin_amdgcn_rcpf(1.0f + __builtin_amdgcn_exp2f(-1.4426950408889634f * z)); }
DI float sigmoidf_(float z) { return 1.0f / (1.0f + __expf(-z)); }

namespace pg8 {
constexpr int BM = 256, BK = 64, HALF = 128, HTB = HALF * BK * 2, STAGE_BYTES = 8 * HTB, NXCD = 8, WGM = 8;
__host__ __device__ __forceinline__ int lds_byte(int r, int c) { const int st = (r >> 4) * 2 + (c >> 5), rr = r & 15, cc = c & 31, ob = rr * 64 + cc * 2; return st * 1024 + (ob ^ (((ob >> 9) & 1) << 5)); }
__host__ __device__ __forceinline__ void stage_rc(int b, int& R, int& C) { const int st = b / 1024, sb = b % 1024, swz = sb ^ (((sb >> 9) & 1) << 5); R = (st >> 1) * 16 + swz / 64; C = (st & 1) * 32 + (swz % 64) / 2; }
__host__ __device__ __forceinline__ int perm32(int rho) { const int n = rho >> 4, i = rho & 15; return 8 * (i >> 2) + 4 * n + (i & 3); }

struct Unit { int pm, pn, z; };
struct Gemm { int lda, ldb, K; };

struct StaticOrder {
    int nM, nN, nwg, G, c;
    __device__ void init(int M, int N, int G_, int c_) { nM = M / BM; nN = N / BM; nwg = nM * nN; G = G_; c = c_; }
    __device__ bool tile(int i, Unit& u) const {
        const long L = (long)i * G + c; if (L >= nwg) return false;
        int wgid = (int)L; { const int q = nwg / NXCD, r = nwg % NXCD, xcd = wgid % NXCD, off = wgid / NXCD; wgid = (xcd < r ? xcd * (q + 1) : r * (q + 1) + (xcd - r) * q) + off; }
        const int nig = WGM * nN, gid = wgid / nig, fm = gid * WGM, gsz = (nM - fm) < WGM ? (nM - fm) : WGM;
        u.pm = fm + ((wgid % nig) % gsz); u.pn = (wgid % nig) / gsz; u.z = 0; return true;
    }
};

DI unsigned cvt_pk_bf16(float lo, float hi) { return cvtpk(lo, hi); }

template <class Epi, class Sched, bool ALIGN_EPI, bool SP2>
DI void gemm_phase(LAS unsigned char* lds, const Gemm g, const Sched& S, const Epi& E) {
    int tid_ = threadIdx.x; asm volatile("" : "+v"(tid_));
    const int tid = tid_, wid = __builtin_amdgcn_readfirstlane(tid >> 6), lane = tid & 63, wr = wid >> 2, wc = wid & 3, fr = lane & 15, fq = lane >> 4;
    int K_ = g.K; asm volatile("" : "+s"(K_));
    const int K = K_, nt = K / BK;
    unsigned voffA[2], voffB[2];
#pragma unroll
    for (int i = 0; i < 2; ++i) { int R, C; stage_rc(tid * 16 + i * 8192, R, C); const int Rb = Epi::PERM ? ((R & ~31) + perm32(R & 31)) : R;
        voffA[i] = (unsigned)(R * g.lda + C) * 2u; voffB[i] = (unsigned)(Rb * g.ldb + C) * 2u; }
    const size_t kstep = (size_t)(BK * 2);
    const size_t hA = (size_t)HALF * g.lda * 2, hB = (size_t)HALF * g.ldb * 2;
    const unsigned ldsw = (unsigned)wid * 1024u;
    const int aoff = lds_byte(wr * 64 + fr, fq * 8), boff = lds_byte(wc * 32 + fr, fq * 8);
#define PG8_SA(b, h) (((b) * 2 + (h)) * HTB)
#define PG8_SB(b, h) ((4 + (b) * 2 + (h)) * HTB)
#define PG8_STAGE(bufoff, gbase, voff) do { _Pragma("unroll") for (int _i = 0; _i < 2; ++_i) \
        __builtin_amdgcn_global_load_lds((const unsigned*)((const char*)(gbase) + (voff)[_i]), (LAS unsigned*)(lds + (bufoff) + ldsw + _i * 8192), 16, 0, 0); } while (0)
#define PG8_LDA(dst, b, h) do { _Pragma("unroll") for (int m = 0; m < 4; ++m) _Pragma("unroll") for (int k = 0; k < 2; ++k) dst[m][k] = *(const LAS bf16x8*)(lds + PG8_SA(b, h) + aoff + m * 2048 + k * 1024); } while (0)
#define PG8_LDB(dst, b, h) do { _Pragma("unroll") for (int n = 0; n < 2; ++n) _Pragma("unroll") for (int k = 0; k < 2; ++k) dst[n][k] = *(const LAS bf16x8*)(lds + PG8_SB(b, h) + boff + n * 2048 + k * 1024); } while (0)
#define PG8_MMA(ai, bj, At, Bt) do { __builtin_amdgcn_s_setprio(1); _Pragma("unroll") for (int m = 0; m < 4; ++m) _Pragma("unroll") for (int n = 0; n < 2; ++n) _Pragma("unroll") for (int k = 0; k < 2; ++k) \
        acc[ai][bj][m][n] = __builtin_amdgcn_mfma_f32_16x16x32_bf16(Bt[n][k], At[m][k], acc[ai][bj][m][n], 0, 0, 0); __builtin_amdgcn_s_setprio(0); } while (0)
#define PG8_WAIT_V(n) asm volatile("s_waitcnt vmcnt(" #n ")" ::: "memory")
#define PG8_WAIT_L(n) asm volatile("s_waitcnt lgkmcnt(" #n ")" ::: "memory")
#define PG8_BAR __builtin_amdgcn_s_barrier()
#define PG8_SCHED __builtin_amdgcn_sched_barrier(0)
    Unit cur, nxt; int ui = 0;
    if (!S.next(0, cur)) return;
    f32x4 acc[2][2][4][2];
#pragma unroll
    for (int a = 0; a < 2; ++a)
#pragma unroll
        for (int b = 0; b < 2; ++b)
#pragma unroll
            for (int m = 0; m < 4; ++m)
#pragma unroll
                for (int n = 0; n < 2; ++n) acc[a][b][m][n] = (f32x4){0.f, 0.f, 0.f, 0.f};
    bf16x8 At[4][2], B0[2][2], B1[2][2];
    const char* cA = S.a_base(cur); const char* cB = S.b_base(cur);
    if constexpr (SP2) {
        PG8_STAGE(PG8_SB(0, 0), cB, voffB); PG8_STAGE(PG8_SB(0, 1), cB + hB, voffB); PG8_STAGE(PG8_SA(0, 0), cA, voffA); PG8_STAGE(PG8_SA(0, 1), cA + hA, voffA);
        if (wr == 1) PG8_BAR;
        PG8_WAIT_V(2); PG8_BAR;
        PG8_STAGE(PG8_SB(1, 0), cB + kstep, voffB); PG8_STAGE(PG8_SA(1, 0), cA + kstep, voffA); PG8_STAGE(PG8_SB(1, 1), cB + hB + kstep, voffB);
        PG8_WAIT_V(6); PG8_BAR;
    } else {
        PG8_STAGE(PG8_SB(0, 0), cB, voffB); PG8_STAGE(PG8_SA(0, 0), cA, voffA); PG8_STAGE(PG8_SB(0, 1), cB + hB, voffB); PG8_STAGE(PG8_SA(0, 1), cA + hA, voffA);
        if (wr == 1) PG8_BAR;
        PG8_WAIT_V(4); PG8_BAR;
        PG8_STAGE(PG8_SB(1, 0), cB + kstep, voffB); PG8_STAGE(PG8_SA(1, 0), cA + kstep, voffA); PG8_STAGE(PG8_SB(1, 1), cB + hB + kstep, voffB);
        PG8_WAIT_V(6); PG8_BAR;
    }
    for (;;) {
        const bool has_next = S.next(ui + 1, nxt);
        const char* nA = has_next ? S.a_base(nxt) : cA; const char* nB = has_next ? S.b_base(nxt) : cB;
        for (int t = 0; t < nt; t += 2) {
            const bool last = (t == nt - 2);
            const char* a1 = cA + (size_t)(t + 1) * kstep;
            const char* a2 = last ? nA : cA + (size_t)(t + 2) * kstep; const char* b2 = last ? nB : cB + (size_t)(t + 2) * kstep;
            const char* a3 = a2 + kstep; const char* b3 = b2 + kstep;
            if constexpr (SP2) {
            PG8_LDB(B0, 0, 0); PG8_LDB(B1, 0, 1); PG8_SCHED; PG8_LDA(At, 0, 0); PG8_STAGE(PG8_SA(1, 1), a1 + hA, voffA);
            PG8_WAIT_V(8); PG8_WAIT_L(0); PG8_BAR; PG8_MMA(0, 0, At, B0); PG8_MMA(0, 1, At, B1); PG8_BAR; PG8_SCHED;
            PG8_LDA(At, 0, 1); PG8_STAGE(PG8_SB(0, 0), b2, voffB); PG8_STAGE(PG8_SB(0, 1), b2 + hB, voffB); PG8_STAGE(PG8_SA(0, 0), a2, voffA);
            PG8_WAIT_V(8); PG8_WAIT_L(0); PG8_BAR; PG8_MMA(1, 0, At, B0); PG8_MMA(1, 1, At, B1); PG8_BAR; PG8_SCHED;
            PG8_LDB(B0, 1, 0); PG8_LDB(B1, 1, 1); PG8_SCHED; PG8_LDA(At, 1, 0); PG8_STAGE(PG8_SA(0, 1), a2 + hA, voffA);
            PG8_WAIT_V(8); PG8_WAIT_L(0); PG8_BAR; PG8_MMA(0, 0, At, B0); PG8_MMA(0, 1, At, B1); PG8_BAR; PG8_SCHED;
            PG8_LDA(At, 1, 1); PG8_STAGE(PG8_SB(1, 0), b3, voffB); PG8_STAGE(PG8_SB(1, 1), b3 + hB, voffB); PG8_STAGE(PG8_SA(1, 0), a3, voffA);
            PG8_WAIT_V(8); PG8_WAIT_L(0); PG8_BAR; PG8_MMA(1, 0, At, B0); PG8_MMA(1, 1, At, B1); PG8_BAR; PG8_SCHED;
            } else {
            PG8_LDB(B0, 0, 0); PG8_SCHED; PG8_LDA(At, 0, 0); PG8_STAGE(PG8_SA(1, 1), a1 + hA, voffA);
            PG8_WAIT_L(8); PG8_BAR; PG8_WAIT_L(0); PG8_MMA(0, 0, At, B0); PG8_BAR; PG8_SCHED;
            PG8_LDB(B1, 0, 1); PG8_STAGE(PG8_SB(0, 0), b2, voffB);
            PG8_BAR; PG8_WAIT_L(0); PG8_MMA(0, 1, At, B1); PG8_BAR;
            PG8_LDA(At, 0, 1); PG8_STAGE(PG8_SA(0, 0), a2, voffA);
            PG8_BAR; PG8_WAIT_L(0); PG8_MMA(1, 0, At, B0); PG8_BAR; PG8_SCHED;
            PG8_STAGE(PG8_SB(0, 1), b2 + hB, voffB);
            PG8_WAIT_V(6); PG8_BAR; PG8_MMA(1, 1, At, B1); PG8_BAR;
            PG8_LDB(B0, 1, 0); PG8_SCHED; PG8_LDA(At, 1, 0); PG8_STAGE(PG8_SA(0, 1), a2 + hA, voffA);
            PG8_WAIT_L(8); PG8_BAR; PG8_WAIT_L(0); PG8_MMA(0, 0, At, B0); PG8_BAR; PG8_SCHED;
            PG8_LDB(B1, 1, 1); PG8_STAGE(PG8_SB(1, 0), b3, voffB);
            PG8_BAR; PG8_WAIT_L(0); PG8_MMA(0, 1, At, B1); PG8_BAR;
            PG8_LDA(At, 1, 1); PG8_STAGE(PG8_SA(1, 0), a3, voffA);
            PG8_BAR; PG8_WAIT_L(0); PG8_MMA(1, 0, At, B0); PG8_BAR; PG8_SCHED;
            PG8_STAGE(PG8_SB(1, 1), b3 + hB, voffB);
            PG8_WAIT_V(6); PG8_BAR; PG8_MMA(1, 1, At, B1); PG8_BAR;
            }
        }
        if constexpr (ALIGN_EPI) { if (wr == 0) PG8_BAR; }
        E(acc, cur, wr, wc, fr, fq);
        if (!has_next) break;
#pragma unroll
        for (int a = 0; a < 2; ++a)
#pragma unroll
            for (int b = 0; b < 2; ++b)
#pragma unroll
                for (int m = 0; m < 4; ++m)
#pragma unroll
                    for (int n = 0; n < 2; ++n) acc[a][b][m][n] = (f32x4){0.f, 0.f, 0.f, 0.f};
        cur = nxt; cA = nA; cB = nB; ++ui;
        if constexpr (ALIGN_EPI) { if (wr == 1) PG8_BAR; }
    }
    PG8_WAIT_V(0);
    if constexpr (!ALIGN_EPI) { if (wr == 0) PG8_BAR; }
    PG8_BAR;
#undef PG8_SA
#undef PG8_SB
#undef PG8_STAGE
#undef PG8_LDA
#undef PG8_LDB
#undef PG8_MMA
#undef PG8_WAIT_V
#undef PG8_WAIT_L
#undef PG8_BAR
#undef PG8_SCHED
}
}

namespace pg8 {
struct PlainOrder : StaticOrder {
    const char* A; const char* Bt; size_t a_tile, b_tile;
    __device__ bool next(int i, Unit& u) const { return tile(i, u); }
    DI const char* a_base(const Unit& u) const { return A + (size_t)u.pm * a_tile; }
    DI const char* b_base(const Unit& u) const { return Bt + (size_t)u.pn * b_tile; }
};
struct InOrder : StaticOrder {
    const char* H; const char* Win; const char* Mn; const char* Wkv; int n_extra;
    __device__ bool next(int i, Unit& u) const {
        const long L = (long)i * G + c;
        if (L >= (long)nwg + n_extra) return false;
        Unit t; t.pm = 0; t.pn = 0; t.z = 0;
        const bool main_tile = L < nwg;
        if (main_tile) (void)tile(i, t);
        const int e = (int)(L - nwg);
        const int pm1 = e >> 1, pn1 = e & 1, pm2 = (e - 32) >> 4, pn2 = (e - 32) & 15; const bool k1 = e < 32;
        u.pm = main_tile ? t.pm : (k1 ? pm1 : pm2); u.pn = main_tile ? t.pn : (k1 ? pn1 : pn2); u.z = main_tile ? 0 : (k1 ? 1 : 2);
        return true;
    }
    DI const char* a_base(const Unit& u) const { const long d1 = Mn - H, d2 = (Wkv + (size_t)512 * 1024 * 2) - H; return H + ((u.z == 1) ? d1 : 0L) + ((u.z == 2) ? d2 : 0L) + (size_t)u.pm * (256 * 1024 * 2); }
    DI const char* b_base(const Unit& u) const { const long d1 = Wkv - Win, d2 = Mn - Win; return Win + ((u.z == 1) ? d1 : 0L) + ((u.z == 2) ? d2 : 0L) + (size_t)u.pn * (256 * 1024 * 2); }
};
struct EpiIn {
    static constexpr bool PERM = true;
    bf16* proj; bf16* kmem; bf16* vt;
    DI void operator()(const f32x4 (&acc)[2][2][4][2], const Unit& u, int wr, int wc, int fr, int fq) const {
        const long dk = kmem - proj, dv = vt - proj; bf16* O = proj + ((u.z == 1) ? dk : 0L) + ((u.z == 2) ? dv : 0L); const int ldc = PC + ((u.z == 1) ? 512 - PC : 0) + ((u.z == 2) ? BATCH * NMEM - PC : 0);
        const int row0 = u.pm * BM + wr * 64 + fr, col0 = u.pn * BM + wc * 32 + 8 * fq;
#pragma unroll
        for (int ai = 0; ai < 2; ++ai)
#pragma unroll
            for (int m = 0; m < 4; ++m) { bf16* rowp = O + (size_t)(row0 + ai * HALF + m * 16) * ldc + col0;
#pragma unroll
                for (int bj = 0; bj < 2; ++bj) { const f32x4 v0 = acc[ai][bj][m][0], v1 = acc[ai][bj][m][1];
                    u32x4 w; w.x = cvt_pk_bf16(v0[0], v0[1]); w.y = cvt_pk_bf16(v0[2], v0[3]); w.z = cvt_pk_bf16(v1[0], v1[1]); w.w = cvt_pk_bf16(v1[2], v1[3]);
                    *(u32x4*)(rowp + bj * HALF) = w; } }
    }
};
struct BranchOrder : StaticOrder {
    const char* Y; const char* Wb;
    __device__ bool next(int i, Unit& u) const { if (!tile(i / 3, u)) return false; u.z = i % 3; return true; }
    DI const char* a_base(const Unit& u) const { return Y + (size_t)u.z * (16 * MiB) + (size_t)u.pm * (256 * 512 * 2); }
    DI const char* b_base(const Unit& u) const { return Wb + (size_t)u.z * (1024 * 512 * 2) + (size_t)u.pn * (256 * 512 * 2); }
};
struct ScoreOrder : StaticOrder {
    const char* Q; const char* Kbd;
    __device__ bool next(int i, Unit& u) const { return tile(i, u); }
    DI const char* a_base(const Unit& u) const { return Q + (size_t)u.pm * (256 * 2048 * 2) + (size_t)u.pn * 512; }
    DI const char* b_base(const Unit& u) const { return Kbd + (size_t)u.pn * (256 * 256 * 2); }
};

struct EpiBf16 {
    static constexpr bool PERM = true;
    bf16* O; int ldc;
    DI void operator()(const f32x4 (&acc)[2][2][4][2], const Unit& u, int wr, int wc, int fr, int fq) const {
        const int row0 = u.pm * BM + wr * 64 + fr, col0 = u.pn * BM + wc * 32 + 8 * fq;
#pragma unroll
        for (int ai = 0; ai < 2; ++ai)
#pragma unroll
            for (int m = 0; m < 4; ++m) { bf16* rowp = O + (size_t)(row0 + ai * HALF + m * 16) * ldc + col0;
#pragma unroll
                for (int bj = 0; bj < 2; ++bj) { const f32x4 v0 = acc[ai][bj][m][0], v1 = acc[ai][bj][m][1];
                    u32x4 w; w.x = cvt_pk_bf16(v0[0], v0[1]); w.y = cvt_pk_bf16(v0[2], v0[3]); w.z = cvt_pk_bf16(v1[0], v1[1]); w.w = cvt_pk_bf16(v1[2], v1[3]);
                    *(u32x4*)(rowp + bj * HALF) = w; } }
    }
};
struct EpiQ {
    static constexpr bool PERM = true;
    bf16* O; int ldc; const float* ssp;
    DI void operator()(const f32x4 (&acc)[2][2][4][2], const Unit& u, int wr, int wc, int fr, int fq) const {
        const int row0 = u.pm * BM + wr * 64 + fr, col0 = u.pn * BM + wc * 32 + 8 * fq;
#pragma unroll
        for (int ai = 0; ai < 2; ++ai)
#pragma unroll
            for (int m = 0; m < 4; ++m) { const int row = row0 + ai * HALF + m * 16; const f32x4* sp = (const f32x4*)(ssp + (size_t)row * 16);
                const f32x4 s0 = sp[0], s1 = sp[1], s2 = sp[2], s3 = sp[3];
                const float ss = ((s0[0] + s0[1]) + (s0[2] + s0[3])) + ((s1[0] + s1[1]) + (s1[2] + s1[3])) + ((s2[0] + s2[1]) + (s2[2] + s2[3])) + ((s3[0] + s3[1]) + (s3[2] + s3[3]));
                const float rs = 1.0f / sqrtf(ss * (1.0f / 1024.0f) + EPS);
                bf16* rowp = O + (size_t)row * ldc + col0;
#pragma unroll
                for (int bj = 0; bj < 2; ++bj) { const f32x4 v0 = acc[ai][bj][m][0] * rs, v1 = acc[ai][bj][m][1] * rs;
                    u32x4 w; w.x = cvt_pk_bf16(v0[0], v0[1]); w.y = cvt_pk_bf16(v0[2], v0[3]); w.z = cvt_pk_bf16(v1[0], v1[1]); w.w = cvt_pk_bf16(v1[2], v1[3]);
                    *(u32x4*)(rowp + bj * HALF) = w; }
                asm volatile("" ::: "memory"); }
    }
};
struct EpiF32 {
    static constexpr bool PERM = false;
    float* C; int ldc;
    DI void operator()(const f32x4 (&acc)[2][2][4][2], const Unit& u, int wr, int wc, int fr, int fq) const {
        const int row0 = u.pm * BM + wr * 64 + fr, col0 = u.pn * BM + wc * 32 + 4 * fq;
#pragma unroll
        for (int ai = 0; ai < 2; ++ai)
#pragma unroll
            for (int m = 0; m < 4; ++m) { float* rowp = C + (size_t)(row0 + ai * HALF + m * 16) * ldc + col0;
#pragma unroll
                for (int bj = 0; bj < 2; ++bj)
#pragma unroll
                    for (int n = 0; n < 2; ++n) *(f32x4*)(rowp + bj * HALF + n * 16) = acc[ai][bj][m][n]; }
    }
};
struct EpiBranch {
    static constexpr bool PERM = true;
    const bf16* proj; bf16* gbuf; bf16* merged;
    DI void operator()(const f32x4 (&acc)[2][2][4][2], const Unit& u, int wr, int wc, int fr, int fq) const {
        const int row0 = u.pm * BM + wr * 64 + fr, col0 = u.pn * BM + wc * 32 + 8 * fq;
#pragma unroll
        for (int ai = 0; ai < 2; ++ai)
#pragma unroll
            for (int m = 0; m < 4; ++m) { const int row = row0 + ai * HALF + m * 16;
#pragma unroll
                for (int bj = 0; bj < 2; ++bj) { const int col = col0 + bj * HALF;
                    const u32x4 gw = *(const u32x4*)(proj + (size_t)row * PC + C_GATE + u.z * 1024 + col);
                    f32x4 v0 = acc[ai][bj][m][0], v1 = acc[ai][bj][m][1];
                    v0[0] *= fast_sig(bflo(gw.x)); v0[1] *= fast_sig(bfhi(gw.x)); v0[2] *= fast_sig(bflo(gw.y)); v0[3] *= fast_sig(bfhi(gw.y));
                    v1[0] *= fast_sig(bflo(gw.z)); v1[1] *= fast_sig(bfhi(gw.z)); v1[2] *= fast_sig(bflo(gw.w)); v1[3] *= fast_sig(bfhi(gw.w));
                    const size_t off = (size_t)row * 1024 + col;
                    if (u.z == 2) { const u32x4 p0 = *(const u32x4*)(gbuf + off), p1 = *(const u32x4*)(gbuf + (size_t)TG * 1024 + off);
                        v0[0] += bflo(p0.x) + bflo(p1.x); v0[1] += bfhi(p0.x) + bfhi(p1.x); v0[2] += bflo(p0.y) + bflo(p1.y); v0[3] += bfhi(p0.y) + bfhi(p1.y);
                        v1[0] += bflo(p0.z) + bflo(p1.z); v1[1] += bfhi(p0.z) + bfhi(p1.z); v1[2] += bflo(p0.w) + bflo(p1.w); v1[3] += bfhi(p0.w) + bfhi(p1.w); }
                    u32x4 w; w.x = cvt_pk_bf16(v0[0], v0[1]); w.y = cvt_pk_bf16(v0[2], v0[3]); w.z = cvt_pk_bf16(v1[0], v1[1]); w.w = cvt_pk_bf16(v1[2], v1[3]);
                    *(u32x4*)((u.z == 2 ? merged : gbuf + (size_t)u.z * TG * 1024) + off) = w; }
                asm volatile("" ::: "memory"); }
    }
};
struct EpiOut {
    static constexpr bool PERM = true;
    const float* x; float* x1; bf16* xg; const float* gffn; float* ssp;
    DI void operator()(const f32x4 (&acc)[2][2][4][2], const Unit& u, int wr, int wc, int fr, int fq) const {
        const int row0 = u.pm * BM + wr * 64 + fr, col0 = u.pn * BM + wc * 32 + 8 * fq;
        f32x4 g0[2], g1[2];
#pragma unroll
        for (int bj = 0; bj < 2; ++bj) { g0[bj] = *(const f32x4*)(gffn + col0 + bj * HALF); g1[bj] = *(const f32x4*)(gffn + col0 + bj * HALF + 4); }
#pragma unroll
        for (int ai = 0; ai < 2; ++ai)
#pragma unroll
            for (int m = 0; m < 4; ++m) { const int row = row0 + ai * HALF + m * 16; float ss = 0.f;
#pragma unroll
                for (int bj = 0; bj < 2; ++bj) { const size_t off = (size_t)row * 1024 + col0 + bj * HALF;
                    const f32x4 v0 = acc[ai][bj][m][0] + *(const f32x4*)(x + off), v1 = acc[ai][bj][m][1] + *(const f32x4*)(x + off + 4);
                    *(f32x4*)(x1 + off) = v0; *(f32x4*)(x1 + off + 4) = v1;
                    ss += (v0[0] * v0[0] + v0[1] * v0[1]) + (v0[2] * v0[2] + v0[3] * v0[3]) + (v1[0] * v1[0] + v1[1] * v1[1]) + (v1[2] * v1[2] + v1[3] * v1[3]);
                    const f32x4 a = v0 * g0[bj], b = v1 * g1[bj];
                    u32x4 w; w.x = cvt_pk_bf16(a[0], a[1]); w.y = cvt_pk_bf16(a[2], a[3]); w.z = cvt_pk_bf16(b[0], b[1]); w.w = cvt_pk_bf16(b[2], b[3]);
                    *(u32x4*)(xg + off) = w; }
                ss += __shfl_xor(ss, 16); ss += __shfl_xor(ss, 32);
                if (fq == 0) ssp[(size_t)row * 16 + u.pn * 4 + wc] = ss;
                asm volatile("" ::: "memory"); }
    }
};
}

#define XB_TMO      128
#define XB_XCNT(j)  (256  + 64 * (j))
#define XB_XSUB(j)  (1280 + 64 * (j))
#define XB_XGEN(j)  (2304 + 64 * (j))
#define XB_TOP      3328
#define XB_TOPGEN   3392
#define XCD_BAR_WORDS 3456
#define XB_SPIN_CAP (1u << 18)
constexpr int CW_BAR = 4096;

DI unsigned xb_ld(unsigned* p)              { return __hip_atomic_load(p, __ATOMIC_RELAXED, __HIP_MEMORY_SCOPE_AGENT); }
DI unsigned xb_add(unsigned* p, unsigned v) { return __hip_atomic_fetch_add(p, v, __ATOMIC_RELAXED, __HIP_MEMORY_SCOPE_AGENT); }
DI unsigned xb_xcc_id() { return (unsigned)__builtin_amdgcn_s_getreg((3 << 11) | 20) & 0xFu; }
#define XB_SPIN(cond, bar) do { unsigned _sp = 0; while (cond) { __builtin_amdgcn_s_sleep(1); \
    if ((++_sp & 255u) == 0u) { if (xb_ld(&(bar)[XB_TMO])) break; if (_sp > XB_SPIN_CAP) { atomicAdd(&(bar)[XB_TMO], 1u); break; } } } } while (0)

struct XcdBarrier { unsigned* bar; unsigned x; volatile LAS unsigned* st; };

DI XcdBarrier xcd_barrier_post(unsigned* bar, volatile LAS unsigned* st) {
    XcdBarrier b; b.bar = bar; b.x = xb_xcc_id(); b.st = st;
    if (threadIdx.x == 0) (void)xb_add(&bar[XB_XCNT(b.x)], 1u);
    return b;
}
DI void xcd_barrier_complete(unsigned* bar, unsigned x, unsigned& nloc, unsigned& nx) {
    const unsigned G = gridDim.x * gridDim.y * gridDim.z;
    unsigned sum, cnt, mine, sp = 0u;
    for (;;) {
        sum = 0u; cnt = 0u; mine = 0u;
#pragma unroll
        for (unsigned j = 0; j < 16; ++j) { const unsigned c = xb_ld(&bar[XB_XCNT(j)]); sum += c; cnt += (c > 0u) ? 1u : 0u; mine = (j == x) ? c : mine; }
        if (sum == G) break;
        __builtin_amdgcn_s_sleep(1);
        if ((++sp & 255u) == 0u) { if (xb_ld(&bar[XB_TMO])) break; if (sp > XB_SPIN_CAP) { atomicAdd(&bar[XB_TMO], 1u); break; } }
    }
    nloc = mine > 0u ? mine : 1u; nx = cnt > 0u ? cnt : 1u;
}
DI void xcd_barrier(const XcdBarrier& b) {
    asm volatile("s_waitcnt vmcnt(0)" ::: "memory");
    __syncthreads();
    if (threadIdx.x == 0) {
        unsigned* bar = b.bar;
        __builtin_amdgcn_s_waitcnt(0);
        unsigned nloc = b.st[0], nx = b.st[1];
        if (nloc == 0u) { xcd_barrier_complete(bar, b.x, nloc, nx); b.st[0] = nloc; b.st[1] = nx; }
        const unsigned old = xb_add(&bar[XB_XSUB(b.x)], 1u);
        const unsigned gen = old / nloc;
        if (old + 1u == (gen + 1u) * nloc) {
            __builtin_amdgcn_fence(__ATOMIC_RELEASE, "agent");
            asm volatile("s_waitcnt vmcnt(0)" ::: "memory");
            const unsigned og = xb_add(&bar[XB_TOP], 1u);
            const unsigned tg = og / nx;
            if (og + 1u == (tg + 1u) * nx) xb_add(&bar[XB_TOPGEN], 1u);
            else XB_SPIN(xb_ld(&bar[XB_TOPGEN]) == tg, bar);
            __builtin_amdgcn_fence(__ATOMIC_ACQUIRE, "agent");
            xb_add(&bar[XB_XGEN(b.x)], 1u);
            asm volatile("s_waitcnt vmcnt(0)" ::: "memory");
        } else {
            XB_SPIN(xb_ld(&bar[XB_XGEN(b.x)]) == gen, bar);
            __builtin_amdgcn_fence(__ATOMIC_ACQUIRE, "agent");
            asm volatile("s_waitcnt vmcnt(0)" ::: "memory");
        }
    }
    __syncthreads();
}

struct Frame {
    LAS unsigned char* lds;
    int tid, lane, wave;
    DI void refresh() { int t = threadIdx.x; asm volatile("" : "+v"(t)); tid = t; lane = t & 63; wave = __builtin_amdgcn_readfirstlane(t >> 6); }
    int vcu, G;
    const float *x, *mem, *norm_mix_g, *w_in, *hg_lb, *hg_norm_g, *sc_conv_w, *mem_norm_g, *w_mem_kv, *w_branch, *w_out, *norm_ffn_g, *peer_w_q, *peer_sub_keys, *peer_u, *peer_v, *final_norm_g;
    float* out; unsigned char* ws;
};

DI void p0_transpose_item(const float* W, int K, int N, bf16* WT, LAS float* scr, int item, int lane) {
    const int nblk = N / 32, kb = item / nblk, nb = item % nblk, k0 = 64 * kb, n0 = 32 * nb;
#pragma unroll 8
    for (int i = 0; i < 32; ++i) { const int kk = 2 * i + (lane >> 5); scr[kk * 33 + (lane & 31)] = W[(size_t)(k0 + kk) * N + n0 + (lane & 31)]; }
    asm volatile("s_waitcnt lgkmcnt(0)" ::: "memory");
    const int c = lane & 7;
#pragma unroll
    for (int j = 0; j < 4; ++j) { const int n = (lane >> 3) + 8 * j; const LAS float* s = scr + (8 * c) * 33 + n;
        u32x4 o; o.x = pk2(s[0 * 33], s[1 * 33]); o.y = pk2(s[2 * 33], s[3 * 33]); o.z = pk2(s[4 * 33], s[5 * 33]); o.w = pk2(s[6 * 33], s[7 * 33]);
        *(u32x4*)(WT + (size_t)(n0 + n) * K + k0 + 8 * c) = o; }
    asm volatile("s_waitcnt lgkmcnt(0)" ::: "memory");
}
DI void rms_row_to_bf16(const float* xrow, const float* g, bf16* orow, int lane) {
    const f32x4* xr = (const f32x4*)xrow + lane; const f32x4* gr = (const f32x4*)g + lane;
    f32x4 v[4]; float s = 0.f;
#pragma unroll
    for (int j = 0; j < 4; ++j) { v[j] = xr[64 * j]; s += (v[j].x * v[j].x + v[j].y * v[j].y) + (v[j].z * v[j].z + v[j].w * v[j].w); }
    const float rstd = 1.0f / sqrtf(wave_sum(s) * (1.f / 1024.f) + EPS);
    unsigned long long* o8 = (unsigned long long*)orow + lane;
#pragma unroll
    for (int j = 0; j < 4; ++j) { const f32x4 gg = gr[64 * j]; const f32x4 y = v[j] * rstd * gg;
        o8[64 * j] = (unsigned long long)pk2(y.x, y.y) | ((unsigned long long)pk2(y.z, y.w) << 32); }
}
DI void p0_prologue(Frame& F) {
    F.refresh();
    LAS float* scr = (LAS float*)(F.lds + F.wave * 16384);
    const int gw = F.vcu * NWAVES + F.wave, NGW = F.G * NWAVES;
    unsigned char* ws = F.ws;
    constexpr int I_IN = (1024 / 64) * (PC / 32), I_KV = (1024 / 64) * (1024 / 32), I_BR = (512 / 64) * (1024 / 32), I_OUT = (1024 / 64) * (1024 / 32), I_Q = (1024 / 64) * (2048 / 32);
    constexpr int NITEMS = I_IN + I_KV + 3 * I_BR + I_OUT + I_Q;
    for (int it = gw; it < NITEMS; it += NGW) {
        int r = it;
        if (r < I_IN) { p0_transpose_item(F.w_in, 1024, PC, (bf16*)(ws + WS_WIN), scr, r, F.lane); continue; } r -= I_IN;
        if (r < I_KV) { p0_transpose_item(F.w_mem_kv, 1024, 1024, (bf16*)(ws + WS_WKV), scr, r, F.lane); continue; } r -= I_KV;
        if (r < 3 * I_BR) { const int n = r / I_BR; p0_transpose_item(F.w_branch + (size_t)n * 512 * 1024, 512, 1024, (bf16*)(ws + WS_WBR) + (size_t)n * 1024 * 512, scr, r % I_BR, F.lane); continue; } r -= 3 * I_BR;
        if (r < I_OUT) { p0_transpose_item(F.w_out, 1024, 1024, (bf16*)(ws + WS_WOUT), scr, r, F.lane); continue; } r -= I_OUT;
        p0_transpose_item(F.peer_w_q, 1024, 2048, (bf16*)(ws + WS_WQ), scr, r, F.lane);
    }
    const int gt = F.vcu * 512 + F.tid, NGT = F.G * 512;
    for (int it = gt; it < 8 * 256 * 32; it += NGT) {
        const int c8 = it & 31, row = (it >> 5) & 255, h = it >> 13, p = row >> 7, key = row & 127;
        u32x4 o = (u32x4){0u, 0u, 0u, 0u};
        if ((c8 >> 4) == p) { const float* s = F.peer_sub_keys + (((size_t)(h * 2 + p) * 128 + key) * 128 + (c8 & 15) * 8);
            const f32x4 a = *(const f32x4*)s, b = *(const f32x4*)(s + 4); o.x = pk2(a.x, a.y); o.y = pk2(a.z, a.w); o.z = pk2(b.x, b.y); o.w = pk2(b.z, b.w); }
        *(u32x4*)((bf16*)(ws + WS_KBD) + ((size_t)(h * 256 + row) * 256 + c8 * 8)) = o;
    }
    for (int it = gt; it < 1024; it += NGT) { const float a0 = F.hg_lb[it], a1 = F.hg_lb[1024 + it]; const float m = fmaxf(a0, a1); const float e0 = __expf(a0 - m), e1 = __expf(a1 - m);
        ((float*)(ws + WS_LB))[it] = e0 / (e0 + e1); }
    for (int m = gw; m < BATCH * NMEM; m += NGW) rms_row_to_bf16(F.mem + (size_t)m * 1024, F.mem_norm_g, (bf16*)(ws + WS_MN) + (size_t)m * 1024, F.lane);
    for (int m = gw; m < T_ALL; m += NGW) rms_row_to_bf16(F.x + (size_t)m * 1024, F.norm_mix_g, (bf16*)(ws + WS_XG) + (size_t)m * 1024, F.lane);
}

DI s16x4 tr16(const LAS unsigned char* p) { return __builtin_bit_cast(s16x4, __builtin_amdgcn_ds_read_tr16_b64_v4i16((LAS v4i16_t*)p)); }
DI bf16x8 cat8(s16x4 lo, s16x4 hi) { return __builtin_shufflevector(lo, hi, 0, 1, 2, 3, 4, 5, 6, 7); }
#define MFMA32(a, b, c) __builtin_amdgcn_mfma_f32_32x32x16_bf16((a), (b), (c), 0, 0, 0)
DI int crow(int reg, int h) { return (reg & 3) + 8 * (reg >> 2) + 4 * h; }
DI bf16x8 pack8(const f32x16& x, int s) {
    u32x4 p; p.x = cvtpk(x[8 * s], x[8 * s + 1]); p.y = cvtpk(x[8 * s + 2], x[8 * s + 3]); p.z = cvtpk(x[8 * s + 4], x[8 * s + 5]); p.w = cvtpk(x[8 * s + 6], x[8 * s + 7]);
    return __builtin_bit_cast(bf16x8, p);
}
constexpr int TS = 272;

DI void stage_tile(LAS unsigned char* tile, const bf16* src, int tid) {
#pragma unroll
    for (int i = 0; i < 2; ++i) { const int id = tid + 512 * i, c = id >> 4, ch = id & 15;
        *(LAS u32x4*)(tile + c * TS + ch * 16) = *(const u32x4*)(src + (size_t)c * PC + ch * 8); }
}
DI float touch_tile(const bf16* src, int i128) { return *(const float*)(src + (size_t)(i128 >> 1) * PC + (i128 & 1) * 64); }
DI void gate8(const LAS unsigned char* zt, int dp, int ts, f32x2 lb, f32x2 (&L)[8], f32x2 (&kk)[8], f32x2 (&lf)[8]) {
    f32x2 run = (f32x2){0.f, 0.f}; const f32x2 oml = 1.0f - lb;
#pragma unroll
    for (int i = 0; i < 8; ++i) { const unsigned w = *(const LAS unsigned*)(zt + (8 * ts + i) * TS + 4 * dp);
        const f32x2 sg = (f32x2){fast_sig(bflo(w)), fast_sig(bfhi(w))}; const f32x2 f = lb + oml * sg;
        lf[i] = (f32x2){__builtin_amdgcn_logf(f.x), __builtin_amdgcn_logf(f.y)}; kk[i] = oml * (1.0f - sg); run += lf[i]; L[i] = run; }
}
DI f32x2 exp2x2(f32x2 v) { return (f32x2){__builtin_amdgcn_exp2f(v.x), __builtin_amdgcn_exp2f(v.y)}; }
struct SliceSums { f32x2 offf, offb, glf, glb, greff, grefb; };
DI SliceSums slice_sums(const LAS float* tot, int dp, int ts) {
    SliceSums r; f32x2 tf[8], tb[8];
#pragma unroll
    for (int j = 0; j < 8; ++j) { tf[j] = *(const LAS f32x2*)(tot + j * 128 + 2 * dp); tb[j] = *(const LAS f32x2*)(tot + (8 + j) * 128 + 2 * dp); }
    r.offf = (f32x2){0.f, 0.f}; r.offb = (f32x2){0.f, 0.f};
#pragma unroll
    for (int j = 0; j < 8; ++j) { if (j < ts) r.offf += tf[j]; if (j > ts) r.offb += tb[j]; }
    r.greff = (tf[0] + tf[1]) + (tf[2] + tf[3]); r.glf = r.greff + ((tf[4] + tf[5]) + (tf[6] + tf[7]));
    r.grefb = (tb[4] + tb[5]) + (tb[6] + tb[7]); r.glb = r.grefb + ((tb[0] + tb[1]) + (tb[2] + tb[3]));
    return r;
}

DI void hgrn_a_item(Frame& F, int item, bool has_next) {
    F.refresh();
    constexpr int T_V = 0, T_KF = 17408, T_KB = 34816, TOT = 52224;
    LAS unsigned char* lds = F.lds;
    const int n = item & 31, h = (item >> 5) & 3, b = item >> 7;
    const bf16* proj = (const bf16*)(F.ws + WS_PROJ) + ((size_t)b * SEQ + n * CHUNK) * PC;
    const int tid = F.tid, dp = tid & 63, ts = F.wave;
    const float* lbp = (const float*)(F.ws + WS_LB);
    const f32x2 lbf = *(const f32x2*)(lbp + h * 128 + 2 * dp), lbb = *(const f32x2*)(lbp + 512 + h * 128 + 2 * dp);
    stage_tile(lds + T_V, proj + C_HI + h * 128, tid); stage_tile(lds + T_KF, proj + C_FF + h * 128, tid); stage_tile(lds + T_KB, proj + C_FB + h * 128, tid);
    float tch = 0.f;
    if (has_next) { const bf16* pn = proj + (size_t)CHUNK * PC + h * 128; const int i128 = tid & 127, wsel = tid >> 7; tch = touch_tile(pn + (wsel == 0 ? C_HI : wsel == 1 ? C_FF : C_FB), i128); }
    __syncthreads();
    f32x2 Lf[8], kf[8], lff[8], Lb[8], kb[8], lfb[8];
    gate8(lds + T_KF, dp, ts, lbf, Lf, kf, lff);
    gate8(lds + T_KB, dp, ts, lbb, Lb, kb, lfb);
    LAS float* tot = (LAS float*)(lds + TOT);
    *(LAS f32x2*)(tot + ts * 128 + 2 * dp) = Lf[7]; *(LAS f32x2*)(tot + (8 + ts) * 128 + 2 * dp) = Lb[7];
    asm volatile("" :: "v"(tch));
    __syncthreads();
    const SliceSums ss = slice_sums(tot, dp, ts);
    const f32x2 tbq = Lb[7];
#pragma unroll
    for (int i = 0; i < 8; ++i) { const int c = 8 * ts + i;
        const f32x2 G = ss.offf + Lf[i]; const f32x2 kd = kf[i] * exp2x2(ss.glf - G);
        const f32x2 Gb = ss.offb + (tbq - Lb[i] + lfb[i]); const f32x2 kdb = kb[i] * exp2x2(ss.glb - Gb);
        *(LAS unsigned*)(lds + T_KF + c * TS + 4 * dp) = cvtpk(kd.x, kd.y); *(LAS unsigned*)(lds + T_KB + c * TS + 4 * dp) = cvtpk(kdb.x, kdb.y); }
    if (ts == 0) { float* dec = (float*)(F.ws + WS_DEC) + (size_t)item * 256; *(f32x2*)(dec + 2 * dp) = exp2x2(ss.glf); *(f32x2*)(dec + 128 + 2 * dp) = exp2x2(ss.glb); }
    __syncthreads();
    const int w = F.wave, lane = F.lane, r = lane & 31, hh = lane >> 5, blk = (lane >> 4) & 1, q = (lane & 15) >> 2, p = lane & 3;
    const int dt = w >> 1, et0 = (w & 1) * 2;
#pragma unroll
    for (int dir = 0; dir < 2; ++dir) { const int TK = dir ? T_KB : T_KF;
#pragma unroll
        for (int e2 = 0; e2 < 2; ++e2) { const int et = et0 + e2; f32x16 acc;
#pragma unroll
            for (int i = 0; i < 16; ++i) acc[i] = 0.f;
#pragma unroll
            for (int ks = 0; ks < 4; ++ks) {
                const LAS unsigned char* ap = lds + TK + (16 * ks + 8 * hh + q) * TS + (32 * dt + 16 * blk + 4 * p) * 2;
                const LAS unsigned char* bp = lds + T_V + (16 * ks + 8 * hh + q) * TS + (32 * et + 16 * blk + 4 * p) * 2;
                const bf16x8 a = cat8(tr16(ap), tr16(ap + 4 * TS)), bq = cat8(tr16(bp), tr16(bp + 4 * TS));
                acc = MFMA32(a, bq, acc); }
            bf16* dsb = (bf16*)(F.ws + WS_DS) + ((size_t)(item * 2 + dir) * 128 + 32 * et + r) * 128 + 32 * dt + 4 * hh;
#pragma unroll
            for (int g4 = 0; g4 < 4; ++g4) { u32x2 wv; wv.x = cvtpk(acc[4 * g4], acc[4 * g4 + 1]); wv.y = cvtpk(acc[4 * g4 + 2], acc[4 * g4 + 3]); *(u32x2*)(dsb + 8 * g4) = wv; } } }
    __syncthreads();
}

DI void hgrn_scan(Frame& F) {
    F.refresh();
    const bf16* dS = (const bf16*)(F.ws + WS_DS); bf16* Sst = (bf16*)((unsigned char*)F.out + OUT_SST); const float* dec = (const float*)(F.ws + WS_DEC);
    const int gt = F.vcu * 512 + F.tid, NGT = F.G * 512;
    for (int id = gt; id < BG * 4 * 2 * 128 * 32; id += NGT) {
        const int d4 = id & 31, e = (id >> 5) & 127, dir = (id >> 12) & 1, bh = id >> 13;
        f32x4 S = (f32x4){0.f, 0.f, 0.f, 0.f};
#pragma unroll 4
        for (int s = 0; s < 32; ++s) { const int n = dir ? 31 - s : s, item = bh * 32 + n;
            const size_t off = ((size_t)(item * 2 + dir) * 128 + e) * 128 + d4 * 4;
            u32x2 o; o.x = cvtpk(S.x, S.y); o.y = cvtpk(S.z, S.w); *(u32x2*)(Sst + off) = o;
            const f32x4 dc = *(const f32x4*)(dec + (size_t)(item * 2 + dir) * 128 + d4 * 4);
            const u32x2 wv = *(const u32x2*)(dS + off);
            S.x = dc.x * S.x + bflo(wv.x); S.y = dc.y * S.y + bfhi(wv.x); S.z = dc.z * S.z + bflo(wv.y); S.w = dc.w * S.w + bfhi(wv.y); }
    }
}

DI void hgrn_c_item(Frame& F, int item, bool has_next) {
    F.refresh();
    constexpr int T_QRF = 0, T_KRF = 17408, T_QGF = 34816, T_QRB = 52224, T_KRB = 69632, T_QGB = 87040, T_V = 104448, TOT = 121856, O_OFF = 0, OS = 132;
    LAS unsigned char* lds = F.lds;
    const int n = item & 31, h = (item >> 5) & 3, b = item >> 7;
    const size_t row0 = (size_t)b * SEQ + n * CHUNK;
    const bf16* proj = (const bf16*)(F.ws + WS_PROJ) + row0 * PC;
    const int tid = F.tid, dp = tid & 63, ts = F.wave;
    const float* lbp = (const float*)(F.ws + WS_LB);
    const f32x2 lbf = *(const f32x2*)(lbp + h * 128 + 2 * dp), lbb = *(const f32x2*)(lbp + 512 + h * 128 + 2 * dp);
    stage_tile(lds + T_V, proj + C_HI + h * 128, tid); stage_tile(lds + T_KRF, proj + C_FF + h * 128, tid); stage_tile(lds + T_KRB, proj + C_FB + h * 128, tid); stage_tile(lds + T_QRF, proj + C_HQ + h * 128, tid);
    float tch = 0.f, tch2 = 0.f;
    if (has_next) { const bf16* pn = proj + (size_t)CHUNK * PC + h * 128; const int i128 = tid & 127, wsel = tid >> 7; tch = touch_tile(pn + (wsel == 0 ? C_HI : wsel == 1 ? C_FF : wsel == 2 ? C_FB : C_HQ), i128);
        tch2 = *(const float*)((const unsigned char*)F.out + OUT_SST + (size_t)(item + 1) * 65536 + (size_t)tid * 128); }
    __syncthreads();
    f32x2 qv[8];
#pragma unroll
    for (int i = 0; i < 8; ++i) { const unsigned w = *(const LAS unsigned*)(lds + T_QRF + (8 * ts + i) * TS + 4 * dp); const float z0 = bflo(w), z1 = bfhi(w); qv[i] = (f32x2){z0 * fast_sig(z0), z1 * fast_sig(z1)}; }
    f32x2 Lf[8], kf[8], lff[8], Lb[8], kb[8], lfb[8];
    gate8(lds + T_KRF, dp, ts, lbf, Lf, kf, lff);
    gate8(lds + T_KRB, dp, ts, lbb, Lb, kb, lfb);
    LAS float* tot = (LAS float*)(lds + TOT);
    *(LAS f32x2*)(tot + ts * 128 + 2 * dp) = Lf[7]; *(LAS f32x2*)(tot + (8 + ts) * 128 + 2 * dp) = Lb[7];
    asm volatile("" :: "v"(tch), "v"(tch2));
    __syncthreads();
    {
        const SliceSums ss = slice_sums(tot, dp, ts);
        const f32x2 tbq = Lb[7];
#pragma unroll
        for (int i = 0; i < 8; ++i) { const int c = 8 * ts + i; const int o = c * TS + 4 * dp;
            const f32x2 G = ss.offf + Lf[i]; const f32x2 x = G - ss.greff;
            const f32x2 qr = qv[i] * exp2x2(x), kr = kf[i] * exp2x2(-x), qg = qv[i] * exp2x2(G);
            *(LAS unsigned*)(lds + T_QRF + o) = cvtpk(qr.x, qr.y); *(LAS unsigned*)(lds + T_KRF + o) = cvtpk(kr.x, kr.y); *(LAS unsigned*)(lds + T_QGF + o) = cvtpk(qg.x, qg.y);
            const f32x2 Gb = ss.offb + (tbq - Lb[i] + lfb[i]); const f32x2 xb = Gb - ss.grefb;
            const f32x2 qrb = qv[i] * exp2x2(xb), krb = kb[i] * exp2x2(-xb), qgb = qv[i] * exp2x2(Gb);
            *(LAS unsigned*)(lds + T_QRB + o) = cvtpk(qrb.x, qrb.y); *(LAS unsigned*)(lds + T_KRB + o) = cvtpk(krb.x, krb.y); *(LAS unsigned*)(lds + T_QGB + o) = cvtpk(qgb.x, qgb.y); }
    }
    __syncthreads();
    const int w = F.wave, lane = F.lane, r = lane & 31, hh = lane >> 5, blk = (lane >> 4) & 1, q = (lane & 15) >> 2, p = lane & 3;
    const int ct = w >> 2, et = w & 3;
    const bf16* Sst = (const bf16*)((const unsigned char*)F.out + OUT_SST);
    f32x16 o;
#pragma unroll
    for (int i = 0; i < 16; ++i) o[i] = 0.f;
#pragma unroll
    for (int dir = 0; dir < 2; ++dir) { const int TQR = dir ? T_QRB : T_QRF, TKR = dir ? T_KRB : T_KRF, TQG = dir ? T_QGB : T_QGF;
#pragma unroll
        for (int st = 0; st < 2; ++st) {
            if (dir == 0 ? (st > ct) : (st < ct)) continue;
            f32x16 X;
#pragma unroll
            for (int i = 0; i < 16; ++i) X[i] = 0.f;
#pragma unroll
            for (int ks = 0; ks < 8; ++ks) { const bf16x8 a = *(const LAS bf16x8*)(lds + TKR + (32 * st + r) * TS + (16 * ks + 8 * hh) * 2), bq = *(const LAS bf16x8*)(lds + TQR + (32 * ct + r) * TS + (16 * ks + 8 * hh) * 2);
                X = MFMA32(a, bq, X); }
            const int cc = 32 * ct + r;
#pragma unroll
            for (int i = 0; i < 16; ++i) { const int s = 32 * st + crow(i, hh); const bool keep = dir == 0 ? (s <= cc) : (s >= cc); X[i] = keep ? X[i] : 0.f; }
#pragma unroll
            for (int s2 = 0; s2 < 2; ++s2) { const bf16x8 xs = pack8(X, s2);
                const LAS unsigned char* vp = lds + T_V + (32 * st + 16 * s2 + 4 * hh + q) * TS + (32 * et + 16 * blk + 4 * p) * 2;
                const bf16x8 pb = cat8(tr16(vp), tr16(vp + 8 * TS));
                o = MFMA32(xs, pb, o); }
        }
        const bf16* sp = Sst + ((size_t)(item * 2 + dir) * 128 + 32 * et + r) * 128 + 8 * hh;
#pragma unroll
        for (int ks = 0; ks < 8; ++ks) { const bf16x8 a = *(const LAS bf16x8*)(lds + TQG + (32 * ct + r) * TS + (16 * ks + 8 * hh) * 2); const bf16x8 bq = *(const bf16x8*)(sp + 16 * ks);
            o = MFMA32(a, bq, o); }
    }
    unsigned hw[8];
#pragma unroll
    for (int k = 0; k < 8; ++k) hw[k] = *(const unsigned*)(proj + (size_t)(8 * w + k) * PC + C_HG + h * 128 + 2 * lane);
    __syncthreads();
    LAS float* O = (LAS float*)(lds + O_OFF);
#pragma unroll
    for (int i = 0; i < 16; ++i) O[(32 * ct + crow(i, hh)) * OS + 32 * et + r] = o[i];
    __syncthreads();
    const f32x2 gn = *(const f32x2*)(F.hg_norm_g + h * 128 + 2 * lane);
    bf16* yhg = (bf16*)(F.ws + WS_YHG);
    const int a16 = (lane ^ 16) << 2, a32 = (lane ^ 32) << 2;
#pragma unroll
    for (int k = 0; k < 8; ++k) { const int c = 8 * w + k; const f32x2 v = *(const LAS f32x2*)(O + c * OS + 2 * lane);
        float ss = row_sum16(v.x * v.x + v.y * v.y); ss += bperm_f(a16, ss); ss += bperm_f(a32, ss);
        const float rstd = __builtin_amdgcn_rsqf(ss * (1.0f / 128.0f) + EPS);
        const float z0 = bflo(hw[k]), z1 = bfhi(hw[k]);
        const float y0 = v.x * rstd * gn.x * (z0 * fast_sig(z0)), y1 = v.y * rstd * gn.y * (z1 * fast_sig(z1));
        *(unsigned*)(yhg + (row0 + c) * 512 + h * 128 + 2 * lane) = cvtpk(y0, y1); }
    __syncthreads();
}

DI void attn_item(Frame& F, int g, int item) {
    F.refresh();
    constexpr int KS = 272, VS = 528, K_OFF = 0, V_OFF = 69632;
    LAS unsigned char* lds = F.lds;
    const int qb = item & 7, h = (item >> 3) & 3, b = item >> 5, bglob = g * BG + b;
    const bf16* Km = (const bf16*)(F.ws + WS_KMEM) + (size_t)bglob * 256 * 512 + h * 128;
    const bf16* VT = (const bf16*)(F.ws + WS_VT) + (size_t)(h * 128) * 4096 + bglob * 256;
    const int tid = F.tid;
#pragma unroll
    for (int i = 0; i < 8; ++i) { const int id = tid + 512 * i, key = id >> 4, ch = id & 15;
        *(LAS u32x4*)(lds + K_OFF + key * KS + ch * 16) = *(const u32x4*)(Km + (size_t)key * 512 + ch * 8); }
#pragma unroll
    for (int i = 0; i < 8; ++i) { const int id = tid + 512 * i, e = id >> 5, ch = id & 31;
        *(LAS u32x4*)(lds + V_OFF + e * VS + ch * 16) = *(const u32x4*)(VT + (size_t)e * 4096 + ch * 8); }
    __syncthreads();
    const int w = F.wave, lane = F.lane, r = lane & 31, hh = lane >> 5;
    const size_t qrow0 = (size_t)b * SEQ + qb * 256 + w * 32;
    const bf16* proj = (const bf16*)(F.ws + WS_PROJ);
    bf16x8 qf[8];
#pragma unroll
    for (int ks = 0; ks < 8; ++ks) qf[ks] = *(const bf16x8*)(proj + (qrow0 + r) * PC + C_MQ + h * 128 + 16 * ks + 8 * hh);
    const float scale = 0.08838834764831845f;
    float m_run = -INFINITY, l_run = 0.f;
#pragma unroll 1
    for (int kt = 0; kt < 8; ++kt) {
        f32x16 X;
#pragma unroll
        for (int i = 0; i < 16; ++i) X[i] = 0.f;
#pragma unroll
        for (int ks = 0; ks < 8; ++ks) { const bf16x8 a = *(const LAS bf16x8*)(lds + K_OFF + (32 * kt + r) * KS + (16 * ks + 8 * hh) * 2); X = MFMA32(a, qf[ks], X); }
        float tm = X[0];
#pragma unroll
        for (int i = 1; i < 16; ++i) tm = fmaxf(tm, X[i]);
        tm *= scale;
        const float mn = fmaxf(m_run, tm); float ls = 0.f;
#pragma unroll
        for (int i = 0; i < 16; ++i) ls += __expf(X[i] * scale - mn);
        l_run = l_run * __expf(m_run - mn) + ls; m_run = mn;
    }
    { const float mo = __shfl_xor(m_run, 32), lo = __shfl_xor(l_run, 32); const float m = fmaxf(m_run, mo);
      l_run = l_run * __expf(m_run - m) + lo * __expf(mo - m); m_run = m; }
    const float inv_l = 1.0f / l_run;
    f32x16 O[4];
#pragma unroll
    for (int e = 0; e < 4; ++e)
#pragma unroll
        for (int i = 0; i < 16; ++i) O[e][i] = 0.f;
#pragma unroll 1
    for (int kt = 0; kt < 8; ++kt) {
        f32x16 X;
#pragma unroll
        for (int i = 0; i < 16; ++i) X[i] = 0.f;
#pragma unroll
        for (int ks = 0; ks < 8; ++ks) { const bf16x8 a = *(const LAS bf16x8*)(lds + K_OFF + (32 * kt + r) * KS + (16 * ks + 8 * hh) * 2); X = MFMA32(a, qf[ks], X); }
#pragma unroll
        for (int i = 0; i < 16; ++i) X[i] = __expf(X[i] * scale - m_run) * inv_l;
#pragma unroll
        for (int s2 = 0; s2 < 2; ++s2) { const bf16x8 xs = pack8(X, s2);
#pragma unroll
            for (int e = 0; e < 4; ++e) { const LAS unsigned char* vp = lds + V_OFF + (32 * e + r) * VS + (32 * kt + 16 * s2 + 4 * hh) * 2;
                const bf16x8 pb = cat8(*(const LAS s16x4*)vp, *(const LAS s16x4*)(vp + 16));
                O[e] = MFMA32(xs, pb, O[e]); } }
    }
    bf16* ymx = (bf16*)(F.ws + WS_YMX);
#pragma unroll
    for (int e = 0; e < 4; ++e)
#pragma unroll
        for (int i = 0; i < 16; ++i) ymx[(qrow0 + crow(i, hh)) * 512 + h * 128 + 32 * e + r] = (bf16)f2bf(O[e][i]);
    __syncthreads();
}

DI void conv_phase(Frame& F) {
    F.refresh();
    const bf16* proj = (const bf16*)(F.ws + WS_PROJ); bf16* ysc = (bf16*)(F.ws + WS_YSC); const float* cw = F.sc_conv_w;
    const int gt = F.vcu * 512 + F.tid, NGT = F.G * 512;
    for (int id = gt; id < TG * 64; id += NGT) {
        const int c8 = id & 63, t = id >> 6, ts = t & (SEQ - 1);
        const bf16* pr = proj + (size_t)t * PC + c8 * 8;
        const u32x4 z4 = (u32x4){0u, 0u, 0u, 0u};
        const u32x4 sb = *(const u32x4*)(pr + C_SB), c1 = *(const u32x4*)(pr + C_SC), h1 = *(const u32x4*)(pr + C_SH);
        const u32x4 c0 = ts > 0 ? *(const u32x4*)(pr - PC + C_SC) : z4, h0 = ts > 0 ? *(const u32x4*)(pr - PC + C_SH) : z4;
        const u32x4 c2 = ts < SEQ - 1 ? *(const u32x4*)(pr + PC + C_SC) : z4, h2 = ts < SEQ - 1 ? *(const u32x4*)(pr + PC + C_SH) : z4;
        const f32x4 wa0 = *(const f32x4*)(cw + c8 * 8), wa1 = *(const f32x4*)(cw + c8 * 8 + 4), wb0 = *(const f32x4*)(cw + 512 + c8 * 8), wb1 = *(const f32x4*)(cw + 512 + c8 * 8 + 4),
                    wc0 = *(const f32x4*)(cw + 1024 + c8 * 8), wc1 = *(const f32x4*)(cw + 1024 + c8 * 8 + 4);
        float y[8];
#pragma unroll
        for (int k = 0; k < 4; ++k) {
            const float w0l = k < 2 ? wa0[2 * k] : wa1[2 * k - 4], w0h = k < 2 ? wa0[2 * k + 1] : wa1[2 * k - 3];
            const float w1l = k < 2 ? wb0[2 * k] : wb1[2 * k - 4], w1h = k < 2 ? wb0[2 * k + 1] : wb1[2 * k - 3];
            const float w2l = k < 2 ? wc0[2 * k] : wc1[2 * k - 4], w2h = k < 2 ? wc0[2 * k + 1] : wc1[2 * k - 3];
            y[2 * k]     = bflo(sb[k]) * (w0l * (bflo(c0[k]) * bflo(h0[k])) + w1l * (bflo(c1[k]) * bflo(h1[k])) + w2l * (bflo(c2[k]) * bflo(h2[k])));
            y[2 * k + 1] = bfhi(sb[k]) * (w0h * (bfhi(c0[k]) * bfhi(h0[k])) + w1h * (bfhi(c1[k]) * bfhi(h1[k])) + w2h * (bfhi(c2[k]) * bfhi(h2[k]))); }
        u32x4 o; o.x = cvtpk(y[0], y[1]); o.y = cvtpk(y[2], y[3]); o.z = cvtpk(y[4], y[5]); o.w = cvtpk(y[6], y[7]);
        *(u32x4*)(ysc + (size_t)t * 512 + c8 * 8) = o;
    }
}

DI unsigned ord_key(float v, int idx) { unsigned u = __builtin_bit_cast(unsigned, v); u ^= (u >> 31) ? 0xFFFFFFFFu : 0x80000000u; return (u & 0xFFFFFF80u) | (unsigned)(127 - idx); }
DI float key_val(unsigned k) { unsigned u = k & 0xFFFFFF80u; u = (u & 0x80000000u) ? (u ^ 0x80000000u) : ~u; return __builtin_bit_cast(float, u); }
DI float dot2bf(unsigned a, unsigned b, float c) { return __builtin_amdgcn_fdot2_f32_bf16(__builtin_bit_cast(bf16x2_t, a), __builtin_bit_cast(bf16x2_t, b), c, false); }
DI float dot8(const u32x4& a, const u32x4& b, float c) { c = dot2bf(a.x, b.x, c); c = dot2bf(a.y, b.y, c); c = dot2bf(a.z, b.z, c); return dot2bf(a.w, b.w, c); }
__host__ __device__ constexpr int cand_off(int i) { return i == 0 ? 0 : i == 1 ? 16 : i == 2 ? 24 : i == 3 ? 29 : i == 4 ? 33 : i == 5 ? 36 : i == 6 ? 38 : i == 7 ? 40 : 34 + i; }
__host__ __device__ constexpr int cand_i(int c) { return c < 16 ? 0 : c < 24 ? 1 : c < 29 ? 2 : c < 33 ? 3 : c < 36 ? 4 : c < 38 ? 5 : c < 40 ? 6 : c < 42 ? 7 : c - 34; }
__host__ __device__ constexpr int cand_pos(int c) { return cand_i(c) * 16 + (c - cand_off(cand_i(c))); }

#define PEER_CE(i, j) do { const unsigned hi_ = max(k[i], k[j]), lo_ = min(k[i], k[j]); k[i] = hi_; k[j] = lo_; } while (0)
DI void peer_topk(const float* srow, LAS int* widx, LAS float* wgate, int lane) {
    const int gq = lane >> 4, li = lane & 15;
    const int ci = cand_i(lane), cj = lane - cand_off(ci); const bool cvalid = lane < 50;
    const int a16 = (lane ^ 16) << 2, a32 = (lane ^ 32) << 2;
    const float* sl = srow + (gq >> 1) * 256 + (gq & 1) * 128 + li * 8;
    f32x4 nva = *(const f32x4*)sl, nvb = *(const f32x4*)(sl + 4);
#pragma unroll 1
    for (int hp = 0; hp < 4; ++hp) {
        const f32x4 va = nva, vb = nvb;
        if (hp < 3) { nva = *(const f32x4*)(sl + 512 * (hp + 1)); nvb = *(const f32x4*)(sl + 512 * (hp + 1) + 4); }
        unsigned k[8];
        k[0] = ord_key(va.x, li * 8 + 0); k[1] = ord_key(va.y, li * 8 + 1); k[2] = ord_key(va.z, li * 8 + 2); k[3] = ord_key(va.w, li * 8 + 3);
        k[4] = ord_key(vb.x, li * 8 + 4); k[5] = ord_key(vb.y, li * 8 + 5); k[6] = ord_key(vb.z, li * 8 + 6); k[7] = ord_key(vb.w, li * 8 + 7);
        PEER_CE(0, 1); PEER_CE(2, 3); PEER_CE(4, 5); PEER_CE(6, 7); PEER_CE(0, 2); PEER_CE(1, 3); PEER_CE(4, 6); PEER_CE(5, 7); PEER_CE(1, 2); PEER_CE(5, 6);
        PEER_CE(0, 4); PEER_CE(1, 5); PEER_CE(2, 6); PEER_CE(3, 7); PEER_CE(2, 4); PEER_CE(3, 5); PEER_CE(1, 2); PEER_CE(3, 4); PEER_CE(5, 6);
        unsigned mine = 0u;
#pragma unroll
        for (int rd = 0; rd < 16; ++rd) {
            const unsigned m = row_max16(k[0]);
            mine = (li == rd) ? m : mine;
            const bool wn = (k[0] == m);
            k[0] = wn ? k[1] : k[0]; k[1] = wn ? k[2] : k[1]; k[2] = wn ? k[3] : k[2]; k[3] = wn ? k[4] : k[3];
            k[4] = wn ? k[5] : k[4]; k[5] = wn ? k[6] : k[5]; k[6] = wn ? k[7] : k[6]; k[7] = wn ? 0u : k[7];
        }
        const float sc = key_val(mine); const int ix = 127 - (int)(mine & 127u);
#pragma unroll
        for (int hsel = 0; hsel < 2; ++hsel) {
            const int adA = (32 * hsel + ci) << 2, adB = (32 * hsel + 16 + cj) << 2;
            const float a = bperm_f(adA, sc), bq = bperm_f(adB, sc);
            const int ia = __builtin_amdgcn_ds_bpermute(adA, ix), ib = __builtin_amdgcn_ds_bpermute(adB, ix);
            const float cs = a + bq;
            unsigned ck = __builtin_bit_cast(unsigned, cs); ck ^= (ck >> 31) ? 0xFFFFFFFFu : 0x80000000u; ck = cvalid ? ((ck & ~63u) | (unsigned)(63 - lane)) : 0u;
            int rank = 0;
#pragma unroll
            for (int c2 = 0; c2 < 50; ++c2) { const unsigned k2 = (unsigned)__builtin_amdgcn_readlane((int)ck, c2); rank += (int)(k2 > ck); }
            const bool sel = cvalid && rank < 16;
            const float mx = __builtin_bit_cast(float, __builtin_amdgcn_readlane(__builtin_bit_cast(int, cs), 0));
            const float ev = sel ? __builtin_amdgcn_exp2f((cs - mx) * 1.4426950408889634f) : 0.f;
            float sum = row_sum16(ev); sum += bperm_f(a16, sum); sum += bperm_f(a32, sum);
            if (sel) { const int hd = 2 * hp + hsel; widx[hd * 16 + rank] = (ia * 128 + ib) * 512  ; wgate[hd * 16 + rank] = ev * __builtin_amdgcn_rcpf(sum); }
        }
    }
}
#undef PEER_CE

constexpr float PEER_TAB_SCALE = 256.0f;
constexpr float PEER_V_SCALE = 32.0f;
#ifndef PEER_VARIANT
#define PEER_VARIANT 0
#endif
#ifndef PEER_R
#define PEER_R 16
#endif
#if PEER_R == 32
#define PEER_RM4 28
#elif PEER_R == 16
#define PEER_RM4 12
#elif PEER_R == 64
#define PEER_RM4 60
#endif
constexpr int PEER_NPROD = 2, PEER_NCONS = 8 - PEER_NPROD, PEER_CPP = PEER_NCONS / PEER_NPROD;
constexpr int PEER_FLAG_OFF = 12288, PEER_CCF_OFF = 12800, PEER_RING_OFF = 16384;
static_assert(PEER_RING_OFF + PEER_NCONS * PEER_R * 1024 <= MISC_OFF && PEER_R <= 64 && (PEER_R & (PEER_R - 1)) == 0 && PEER_NCONS % PEER_NPROD == 0 && PEER_NCONS * 2048 <= PEER_FLAG_OFF, "PEER LDS map");
DI void glds16(const void* gsrc, unsigned lds_dst) { unsigned keep;
    asm volatile("s_mov_b32 %0, m0\n\ts_mov_b32 m0, %2\n\ts_nop 0\n\tglobal_load_lds_dwordx4 %1, off\n\ts_mov_b32 m0, %0" : "=&s"(keep) : "v"(gsrc), "s"(lds_dst) : "memory"); }
DI void glds16s(const void* sbase, unsigned voff, unsigned lds_dst) { unsigned keep;
    asm volatile("s_mov_b32 %0, m0\n\ts_mov_b32 m0, %3\n\ts_nop 0\n\tglobal_load_lds_dwordx4 %1, %2\n\ts_mov_b32 m0, %0" : "=&s"(keep) : "v"(voff), "s"(sbase), "s"(lds_dst) : "memory"); }
#define PEER_STR2(x) #x
#define PEER_STR(x) PEER_STR2(x)
DI void peer_phase(Frame& F, int tg) {
    F.refresh();
    const int lane = F.lane, wv = F.wave;
    volatile LAS unsigned* flags = (volatile LAS unsigned*)(F.lds + PEER_FLAG_OFF);
    if (F.tid < 2 * PEER_NCONS) flags[F.tid] = 0u;
    __syncthreads();
    const int NPG = F.G * PEER_NPROD;
    if (wv < PEER_NPROD) {
        const int pg = F.vcu * PEER_NPROD + wv;
        int i = 0;
        for (int tl = pg; tl < TG; tl += NPG, ++i) {
            float tch0 = 0.f;
            if (tl + NPG < TG) tch0 = ((const float*)(F.ws + WS_S) + (size_t)(tl + NPG) * 2048)[lane * 32];
            const int cidx = wv * PEER_CPP + (i % PEER_CPP), slot = (i / PEER_CPP) & 1;
            LAS int* sidx = (LAS int*)(F.lds + cidx * 2048 + slot * 1024); LAS float* sgate = (LAS float*)(F.lds + cidx * 2048 + slot * 1024 + 512);
            while (flags[cidx * 2 + slot] != 0u) __builtin_amdgcn_s_sleep(2);
            asm volatile("" ::: "memory");
            peer_topk((const float*)(F.ws + WS_S) + (size_t)tl * 2048, sidx, sgate, lane);
            asm volatile("s_waitcnt lgkmcnt(0)" :: "v"(tch0) : "memory");
            if (lane == 0) flags[cidx * 2 + slot] = 1u;
        }
    } else {
        const unsigned char* Ub = F.ws + WS_U; const unsigned char* Vb = F.ws + WS_V; const unsigned lo16 = 16u * (unsigned)(lane & 31);
        const int a4 = (lane ^ 4) << 2, a8 = (lane ^ 8) << 2, a16 = (lane ^ 16) << 2, a32 = (lane ^ 32) << 2;
        const bool b0 = lane & 1, b1 = lane & 2, b2 = lane & 4, b3 = lane & 8; const int grp = lane >> 4;
        const int cidx = wv - PEER_NPROD, myprod = cidx / PEER_CPP, myr = cidx % PEER_CPP;
        LAS float* ccf = (LAS float*)(F.lds + PEER_CCF_OFF + cidx * 512);
        LAS unsigned char* ring = F.lds + PEER_RING_OFF + cidx * (PEER_R * 1024);
        const unsigned ringb = (unsigned)(uintptr_t)ring;
        const int pg = F.vcu * PEER_NPROD + myprod, TSTEP = NPG * PEER_CPP;
        int kslot = 0;
        for (int tl = pg + myr * NPG; tl < TG; tl += TSTEP, ++kslot) {
            const size_t t = (size_t)tg * TG + tl;
            float tch1 = 0.f, tch2 = 0.f, tch3 = 0.f;
            if (tl + TSTEP < TG) { const size_t tn = t + TSTEP; tch1 = (F.out + tn * 1024)[(lane & 31) * 32];
                tch2 = ((const float*)((const bf16*)(F.ws + WS_XG) + tn * 1024))[(lane & 15) * 32]; tch3 = ((const float*)(F.ws + WS_SSP) + tn * 16)[lane & 15]; }
            f32x2 hreg[8];
            { const bf16* xr = (const bf16*)(F.ws + WS_XG) + t * 1024 + 16 * lane; const u32x4 w0 = *(const u32x4*)xr, w1 = *(const u32x4*)(xr + 8);
#pragma unroll
              for (int q = 0; q < 4; ++q) { hreg[q] = (f32x2){bflo(w0[q]), bfhi(w0[q])}; hreg[4 + q] = (f32x2){bflo(w1[q]), bfhi(w1[q])}; } }
            const f32x4* sp = (const f32x4*)((const float*)(F.ws + WS_SSP) + t * 16);
            const f32x4 s0 = sp[0], s1 = sp[1], s2 = sp[2], s3 = sp[3];
            const float ssx = ((s0[0] + s0[1]) + (s0[2] + s0[3])) + ((s1[0] + s1[1]) + (s1[2] + s1[3])) + ((s2[0] + s2[1]) + (s2[2] + s2[3])) + ((s3[0] + s3[1]) + (s3[2] + s3[3]));
            const float ascale = __builtin_amdgcn_rsqf(ssx * (1.0f / 1024.0f) + EPS) * (1.0f / PEER_V_SCALE);
            asm volatile("s_waitcnt vmcnt(0)" :: "v"(tch1), "v"(tch2), "v"(tch3) : "memory");
            const int slot = kslot & 1;
            const LAS int* sidx = (const LAS int*)(F.lds + cidx * 2048 + slot * 1024); const LAS float* sgate = (const LAS float*)(F.lds + cidx * 2048 + slot * 1024 + 512);
            while (flags[cidx * 2 + slot] != 1u) __builtin_amdgcn_s_sleep(2);
            asm volatile("" ::: "memory");
            typedef int i32x4 __attribute__((ext_vector_type(4)));
#define PEER_ISSUE1(pp, tab, ea, eb) do { const unsigned voff_ = (unsigned)(lane < 32 ? __builtin_amdgcn_readfirstlane(ea) : __builtin_amdgcn_readfirstlane(eb)) + lo16; \
                glds16s((tab), voff_, (unsigned)__builtin_amdgcn_readfirstlane((int)(ringb + (unsigned)((pp) & (PEER_R - 1)) * 1024u))); } while (0)
#define PEER_ISSUE4(pp0) do { const int pp_ = (pp0); const int m_ = pp_ & 63; const unsigned char* tab_ = (pp_ < 64) ? Ub : Vb; const i32x4 ea_ = *(const LAS i32x4*)(sidx + 2 * m_), eb_ = *(const LAS i32x4*)(sidx + 2 * m_ + 4); \
                PEER_ISSUE1(pp_, tab_, ea_.x, ea_.y); PEER_ISSUE1(pp_ + 1, tab_, ea_.z, ea_.w); PEER_ISSUE1(pp_ + 2, tab_, eb_.x, eb_.y); PEER_ISSUE1(pp_ + 3, tab_, eb_.z, eb_.w); } while (0)
#define PEER_WAIT4() asm volatile("s_waitcnt vmcnt(" PEER_STR(PEER_RM4) ")" ::: "memory")
#define PEER_HSLOT(pp, half) (*(const LAS u32x2*)(ring + ((pp) & (PEER_R - 1)) * 1024 + (half) * 512 + 8 * lane))
#define PEER_CVT4(w, q, b) __builtin_amdgcn_cvt_scalef32_pk_f32_fp4(w[q], 1.0f, b)
#define PEER_DOT(dst, w) do { f32x2 acc_ = (f32x2){0.f, 0.f}; _Pragma("unroll") for (int q = 0; q < 2; ++q) { \
                acc_ = PEER_CVT4(w, q, 0) * hreg[4 * q + 0] + acc_; acc_ = PEER_CVT4(w, q, 1) * hreg[4 * q + 1] + acc_; acc_ = PEER_CVT4(w, q, 2) * hreg[4 * q + 2] + acc_; acc_ = PEER_CVT4(w, q, 3) * hreg[4 * q + 3] + acc_; } dst = acc_.x + acc_.y; } while (0)
#pragma unroll 2
            for (int pp = 0; pp < PEER_R; pp += 4) PEER_ISSUE4(pp);
            float dotA = 0.f, dotB = 0.f;
#pragma unroll 1
            for (int batch = 0; batch < 8; ++batch) {
                float p[16];
#pragma unroll
                for (int g = 0; g < 2; ++g) { const int pp0 = 8 * batch + 4 * g;
                    PEER_WAIT4();
                    const u32x2 w0 = PEER_HSLOT(pp0, 0), w1 = PEER_HSLOT(pp0, 1), w2 = PEER_HSLOT(pp0 + 1, 0), w3 = PEER_HSLOT(pp0 + 1, 1), w4 = PEER_HSLOT(pp0 + 2, 0), w5 = PEER_HSLOT(pp0 + 2, 1), w6 = PEER_HSLOT(pp0 + 3, 0), w7 = PEER_HSLOT(pp0 + 3, 1);
                    PEER_DOT(p[8 * g + 0], w0); PEER_DOT(p[8 * g + 1], w1); PEER_DOT(p[8 * g + 2], w2); PEER_DOT(p[8 * g + 3], w3);
                    PEER_DOT(p[8 * g + 4], w4); PEER_DOT(p[8 * g + 5], w5); PEER_DOT(p[8 * g + 6], w6); PEER_DOT(p[8 * g + 7], w7);
                    __builtin_amdgcn_sched_barrier(0); PEER_ISSUE4(pp0 + PEER_R); __builtin_amdgcn_sched_barrier(0); }
                float q8[8], q4[4], q2[2];
#pragma unroll
                for (int m = 0; m < 8; ++m) { const float keep = b0 ? p[2 * m + 1] : p[2 * m], send = b0 ? p[2 * m] : p[2 * m + 1]; q8[m] = keep + dpp_f<0xB1>(send); }
#pragma unroll
                for (int m = 0; m < 4; ++m) { const float keep = b1 ? q8[2 * m + 1] : q8[2 * m], send = b1 ? q8[2 * m] : q8[2 * m + 1]; q4[m] = keep + dpp_f<0x4E>(send); }
#pragma unroll
                for (int m = 0; m < 2; ++m) { const float keep = b2 ? q4[2 * m + 1] : q4[2 * m], send = b2 ? q4[2 * m] : q4[2 * m + 1]; q2[m] = keep + bperm_f(a4, send); }
                const float keep = b3 ? q2[1] : q2[0], send = b3 ? q2[0] : q2[1];
                float tot = keep + bperm_f(a8, send); tot += bperm_f(a16, tot); tot += bperm_f(a32, tot);
                dotA = (batch == grp) ? tot : dotA; dotB = (batch == grp + 4) ? tot : dotB;
            }
            { const float av = dotA * ascale; ccf[lane] = sgate[lane] * (0.5f * av * (1.0f + erff(av * 0.70710678118654752f))) * (1.0f / PEER_V_SCALE); }
            { const float av = dotB * ascale; ccf[64 + lane] = sgate[64 + lane] * (0.5f * av * (1.0f + erff(av * 0.70710678118654752f))) * (1.0f / PEER_V_SCALE); }
            f32x2 o2[8];
#pragma unroll
            for (int m = 0; m < 8; ++m) o2[m] = (f32x2){0.f, 0.f};
            asm volatile("s_waitcnt lgkmcnt(0)" ::: "memory");
#define PEER_AXPYV(w, c) do { const float cv_ = __builtin_bit_cast(float, __builtin_amdgcn_readfirstlane((c))); const f32x2 cc_ = (f32x2){cv_, cv_}; \
                _Pragma("unroll") for (int q = 0; q < 2; ++q) { \
                o2[4 * q + 0] = PEER_CVT4(w, q, 0) * cc_ + o2[4 * q + 0]; o2[4 * q + 1] = PEER_CVT4(w, q, 1) * cc_ + o2[4 * q + 1]; \
                o2[4 * q + 2] = PEER_CVT4(w, q, 2) * cc_ + o2[4 * q + 2]; o2[4 * q + 3] = PEER_CVT4(w, q, 3) * cc_ + o2[4 * q + 3]; } } while (0)
#define PEER_AXPYV8(mg) do { const int pp_ = 64 + 4 * (mg); const i32x4 ca_ = *(const LAS i32x4*)(ccf + 8 * (mg)), cb_ = *(const LAS i32x4*)(ccf + 8 * (mg) + 4); \
                const u32x2 w0 = PEER_HSLOT(pp_, 0), w1 = PEER_HSLOT(pp_, 1), w2 = PEER_HSLOT(pp_ + 1, 0), w3 = PEER_HSLOT(pp_ + 1, 1), w4 = PEER_HSLOT(pp_ + 2, 0), w5 = PEER_HSLOT(pp_ + 2, 1), w6 = PEER_HSLOT(pp_ + 3, 0), w7 = PEER_HSLOT(pp_ + 3, 1); \
                PEER_AXPYV(w0, ca_.x); PEER_AXPYV(w1, ca_.y); PEER_AXPYV(w2, ca_.z); PEER_AXPYV(w3, ca_.w); PEER_AXPYV(w4, cb_.x); PEER_AXPYV(w5, cb_.y); PEER_AXPYV(w6, cb_.z); PEER_AXPYV(w7, cb_.w); } while (0)
#pragma unroll 2
            for (int mg = 0; mg < (64 - PEER_R) / 4; ++mg) { PEER_WAIT4(); PEER_AXPYV8(mg); __builtin_amdgcn_sched_barrier(0); PEER_ISSUE4(64 + 4 * mg + PEER_R); __builtin_amdgcn_sched_barrier(0); }
            asm volatile("s_waitcnt vmcnt(0)" ::: "memory");
#pragma unroll 2
            for (int mg = (64 - PEER_R) / 4; mg < 16; ++mg) PEER_AXPYV8(mg);
#undef PEER_AXPYV8
#undef PEER_AXPYV
#undef PEER_DOT
#undef PEER_CVT4
#undef PEER_HSLOT
#undef PEER_WAIT4
#undef PEER_ISSUE4
#undef PEER_ISSUE1
            asm volatile("s_waitcnt lgkmcnt(0)" ::: "memory");
            if (lane == 0) flags[cidx * 2 + slot] = 0u;
            float* xo = F.out + t * 1024 + 16 * lane; const float* gfp = F.final_norm_g + 16 * lane;
            f32x4 a[4]; float ss = 0.f;
#pragma unroll
            for (int k = 0; k < 4; ++k) { a[k] = *(const f32x4*)(xo + 4 * k) + (f32x4){o2[2 * k].x, o2[2 * k].y, o2[2 * k + 1].x, o2[2 * k + 1].y};
                ss += (a[k].x * a[k].x + a[k].y * a[k].y) + (a[k].z * a[k].z + a[k].w * a[k].w); }
            ss = row_sum16(ss); ss += bperm_f(a16, ss); ss += bperm_f(a32, ss);
            const float rf = __builtin_amdgcn_rsqf(ss * (1.0f / 1024.0f) + EPS);
#pragma unroll
            for (int k = 0; k < 4; ++k) *(f32x4*)(xo + 4 * k) = a[k] * rf * *(const f32x4*)(gfp + 4 * k);
        }
    }
}

DI void convert_uv(Frame& F, int part, int nparts, int cu, int ncu) {
    F.refresh();
    const int gt = cu * 512 + F.tid, NGT = ncu * 512, per = (2 * 16384 * 64) / nparts;
    for (int id = part * per + gt; id < (part + 1) * per; id += NGT) {
        const int which = id >> 20, off = (id & ((1 << 20) - 1)) * 16;
        if (false) {
        } else {
            const float* src = (which ? F.peer_v : F.peer_u) + off; unsigned char* dst = F.ws + (which ? WS_V : WS_U) + off / 2;
            u32x2 o;
#pragma unroll
            for (int q = 0; q < 2; ++q) { const f32x4 v0 = *(const f32x4*)(src + 8 * q) * PEER_V_SCALE, v1 = *(const f32x4*)(src + 8 * q + 4) * PEER_V_SCALE;
                unsigned pk = __builtin_amdgcn_cvt_scalef32_pk_fp4_f32(0u, v0.x, v0.y, 1.0f, 0); pk = __builtin_amdgcn_cvt_scalef32_pk_fp4_f32(pk, v0.z, v0.w, 1.0f, 1);
                pk = __builtin_amdgcn_cvt_scalef32_pk_fp4_f32(pk, v1.x, v1.y, 1.0f, 2); pk = __builtin_amdgcn_cvt_scalef32_pk_fp4_f32(pk, v1.z, v1.w, 1.0f, 3); o[q] = pk; }
            *(u32x2*)dst = o;
        }
    }
}

constexpr int N_PHASES = 19;
struct Args { const float* in[17]; float* out; unsigned char* ws; int ph_lo, ph_hi; };

__global__ void __launch_bounds__(NWAVES * 64, 2) fwd_kernel(Args args) {
    extern __shared__ __attribute__((aligned(16))) unsigned char lds_raw[];
    Frame F;
    F.lds = (LAS unsigned char*)lds_raw;
    F.tid = threadIdx.x; F.lane = F.tid & 63; F.wave = __builtin_amdgcn_readfirstlane(F.tid >> 6);
    F.G = gridDim.x; { const int bx = blockIdx.x; F.vcu = (F.G % 8 == 0) ? (bx % 8) * (F.G / 8) + bx / 8 : bx; }
    F.x = args.in[0]; F.mem = args.in[1]; F.norm_mix_g = args.in[2]; F.w_in = args.in[3]; F.hg_lb = args.in[4]; F.hg_norm_g = args.in[5]; F.sc_conv_w = args.in[6];
    F.mem_norm_g = args.in[7]; F.w_mem_kv = args.in[8]; F.w_branch = args.in[9]; F.w_out = args.in[10]; F.norm_ffn_g = args.in[11]; F.peer_w_q = args.in[12];
    F.peer_sub_keys = args.in[13]; F.peer_u = args.in[14]; F.peer_v = args.in[15]; F.final_norm_g = args.in[16];
    F.out = args.out; F.ws = args.ws;
    volatile LAS unsigned* MISC = (volatile LAS unsigned*)(F.lds + MISC_OFF);
    for (int u = F.tid; u < (LDS_BYTES - MISC_OFF) / 4; u += NWAVES * 64) MISC[u] = 0u;
    __syncthreads();
    unsigned* barw = (unsigned*)(F.ws + WS_CTL) + CW_BAR;
    XcdBarrier bar; bar.bar = barw; bar.x = 0; bar.st = nullptr;
    const bool one_launch = (args.ph_hi - args.ph_lo) > 1;
    if (one_launch) bar = xcd_barrier_post(barw, MISC + 8);
    const int lo = args.ph_lo, hi = args.ph_hi;
#define IN(k) (lo <= (k) && (k) < hi)
#ifndef PMASK
#define PMASK 0x3ff
#endif
#define PC_(c) ((PMASK >> (c)) & 1)
#ifndef REP_MASK
#define REP_MASK 0
#endif
#define REPS(c) for (int rep_ = 0; rep_ < 1 + 2 * ((REP_MASK >> (c)) & 1); ++rep_)
#define SEAM(k) do { if (IN(k) && IN((k) + 1)) xcd_barrier(bar); } while (0)
    unsigned char* ws = F.ws;
    const int G = F.G, cid = (int)blockIdx.x;

    if (PC_(0) && IN(0)) { REPS(0) p0_prologue(F); } SEAM(0);

#pragma unroll 1
    for (int g = 0; g < NGRP; ++g) {
        const int pb = 1 + 6 * g;
        if (PC_(1) && IN(pb)) REPS(1) {
            pg8::InOrder S; S.init(TG, PC, G, cid); S.H = (const char*)(ws + WS_XG) + (size_t)g * TG * 1024 * 2; S.Win = (const char*)(ws + WS_WIN); S.Mn = (const char*)(ws + WS_MN); S.Wkv = (const char*)(ws + WS_WKV); S.n_extra = (g == 0) ? 64 : 0;
            pg8::EpiIn E{(bf16*)(ws + WS_PROJ), (bf16*)(ws + WS_KMEM), (bf16*)(ws + WS_VT)};
            pg8::gemm_phase<pg8::EpiIn, pg8::InOrder, true, true>(F.lds, pg8::Gemm{1024, 1024, 1024}, S, E);
            if (cid >= 128) convert_uv(F, g, NGRP, cid - 128, G - 128);
        } SEAM(pb);
        if (PC_(2) && IN(pb + 1)) REPS(2) {
            for (int it = F.vcu * 4; it < BG * 4 * NCHUNK; it += G * 4) { for (int k = 0; k < 4; ++k) hgrn_a_item(F, it + k, k < 3); }
            for (int it = F.vcu; it < BG * 4 * 8; it += G) attn_item(F, g, it);
            conv_phase(F);
        } SEAM(pb + 1);
        if (PC_(3) && IN(pb + 2)) { REPS(3) hgrn_scan(F); } SEAM(pb + 2);
        if (PC_(4) && IN(pb + 3)) REPS(4) { for (int it = F.vcu * 4; it < BG * 4 * NCHUNK; it += G * 4) { for (int k = 0; k < 4; ++k) hgrn_c_item(F, it + k, k < 3); } } SEAM(pb + 3);
        if (PC_(5) && IN(pb + 4)) REPS(5) {
            pg8::BranchOrder S; S.init(TG, 1024, G, cid); S.Y = (const char*)(ws + WS_YHG); S.Wb = (const char*)(ws + WS_WBR);
            pg8::EpiBranch E{(const bf16*)(ws + WS_PROJ), (bf16*)(ws + WS_MACC), (bf16*)(ws + WS_MERGED)};
            pg8::gemm_phase<pg8::EpiBranch, pg8::BranchOrder, true, true>(F.lds, pg8::Gemm{512, 512, 512}, S, E);
        } SEAM(pb + 4);
        if (PC_(6) && IN(pb + 5)) REPS(6) {
            pg8::PlainOrder S; S.init(TG, 1024, G, cid); S.A = (const char*)(ws + WS_MERGED); S.Bt = (const char*)(ws + WS_WOUT); S.a_tile = 256 * 1024 * 2; S.b_tile = 256 * 1024 * 2;
            pg8::EpiOut E{F.x + (size_t)g * TG * 1024, F.out + (size_t)g * TG * 1024, (bf16*)(ws + WS_XG) + (size_t)g * TG * 1024, F.norm_ffn_g, (float*)(ws + WS_SSP) + (size_t)g * TG * 16};
            pg8::gemm_phase<pg8::EpiOut, pg8::PlainOrder, true, true>(F.lds, pg8::Gemm{1024, 1024, 1024}, S, E);
        } SEAM(pb + 5);
    }
#pragma unroll 1
    for (int tg = 0; tg < NGRP; ++tg) {
        const int pb = 13 + 3 * tg;
        if (PC_(7) && IN(pb)) REPS(7) {
            pg8::PlainOrder S; S.init(TG, 2048, G, cid); S.A = (const char*)(ws + WS_XG) + (size_t)tg * TG * 1024 * 2; S.Bt = (const char*)(ws + WS_WQ); S.a_tile = 256 * 1024 * 2; S.b_tile = 256 * 1024 * 2;
            pg8::EpiQ E{(bf16*)(ws + WS_Q), 2048, (const float*)(ws + WS_SSP) + (size_t)tg * TG * 16};
            pg8::gemm_phase<pg8::EpiQ, pg8::PlainOrder, true, true>(F.lds, pg8::Gemm{1024, 1024, 1024}, S, E);
        } SEAM(pb);
        if (PC_(8) && IN(pb + 1)) REPS(8) {
            pg8::ScoreOrder S; S.init(TG, 2048, G, cid); S.Q = (const char*)(ws + WS_Q); S.Kbd = (const char*)(ws + WS_KBD);
            pg8::EpiF32 E{(float*)(ws + WS_S), 2048};
            pg8::gemm_phase<pg8::EpiF32, pg8::ScoreOrder, true, true>(F.lds, pg8::Gemm{2048, 256, 256}, S, E);
        } SEAM(pb + 1);
        if (PC_(9) && IN(pb + 2)) { peer_phase(F, tg); } SEAM(pb + 2);
    }
#undef IN
#undef SEAM
}

extern "C" void kernel_launch(void* const* d_in, const int* in_sizes, int n_in, void* d_out, int out_size, void* d_ws, size_t ws_size, hipStream_t stream) {
    static int ready = 0;
    if (ready == 0) {
        if (n_in != 17 || out_size != T_ALL * D_MODEL || ws_size < WS_END) { fprintf(stderr, "kernel_launch: unexpected shapes (n_in %d, out %d, ws %zu)\n", n_in, out_size, ws_size); ready = -1; return; }
        if (hipFuncSetAttribute((const void*)fwd_kernel, hipFuncAttributeMaxDynamicSharedMemorySize, LDS_BYTES) != hipSuccess) { fprintf(stderr, "kernel_launch: hipFuncSetAttribute failed\n"); ready = -1; return; }
        ready = 1;
    }
    if (ready < 0) return;
    (void)hipMemsetAsync((char*)d_ws + WS_CTL, 0, CTL_ZERO_BYTES, stream);
    Args a{};
    for (int i = 0; i < 17; ++i) a.in[i] = (const float*)d_in[i];
    a.out = (float*)d_out; a.ws = (unsigned char*)d_ws;
    const int grid = 256;
#if MK_N_LAUNCHES == 1
    a.ph_lo = 0; a.ph_hi = N_PHASES;
    hipLaunchKernelGGL(fwd_kernel, dim3(grid), dim3(NWAVES * 64), LDS_BYTES, stream, a);
#else
    for (int li = 0; li < N_PHASES; ++li) { a.ph_lo = li; a.ph_hi = li + 1; hipLaunchKernelGGL(fwd_kernel, dim3(grid), dim3(NWAVES * 64), LDS_BYTES, stream, a); }
#endif
}
```

```cpp
#include <hip/hip_runtime.h>
#include <cstdio>
#include <cstdint>

#ifndef MK_N_LAUNCHES
#define MK_N_LAUNCHES 1
#endif

#define LAS __attribute__((address_space(3)))
#define GAS __attribute__((address_space(1)))
typedef unsigned short bf16;
typedef short bf16x8 __attribute__((ext_vector_type(8)));
typedef short s16x4 __attribute__((ext_vector_type(4)));
typedef short v4i16_t __attribute__((ext_vector_type(4)));
typedef float f32x2 __attribute__((ext_vector_type(2)));
typedef float f32x4 __attribute__((ext_vector_type(4)));
typedef float f32x16 __attribute__((ext_vector_type(16)));
typedef unsigned u32x2 __attribute__((ext_vector_type(2)));
typedef unsigned u32x4 __attribute__((ext_vector_type(4)));
typedef __bf16 bf16x2_t __attribute__((ext_vector_type(2)));
typedef GAS unsigned gu32;
#define RLX_AGENT __ATOMIC_RELAXED, __HIP_MEMORY_SCOPE_AGENT
#define DI __device__ __forceinline__

constexpr int D_MODEL = 1024, BATCH = 16, SEQ = 2048, T_ALL = BATCH * SEQ;
constexpr int NGRP = 2, BG = BATCH / NGRP, TG = BG * SEQ;
constexpr int PC = 7680;
constexpr int C_HQ = 0, C_HI = 512, C_FF = 1024, C_FB = 1536, C_HG = 2048, C_SB = 2560, C_SC = 3072, C_SH = 3584, C_MQ = 4096, C_GATE = 4608;
constexpr int NMEM = 256, CHUNK = 64, NCHUNK = SEQ / CHUNK;
constexpr float EPS = 1e-6f;

constexpr size_t MiB = 1u << 20;
constexpr size_t WS_CTL = 0, CTL_ZERO_BYTES = 1 * MiB;
constexpr size_t WS_LB = 1 * MiB;
constexpr size_t WS_SSP = 2 * MiB;
constexpr size_t WS_DEC = 4 * MiB;
constexpr size_t WS_WIN = 5 * MiB, WS_WKV = 20 * MiB, WS_WBR = 22 * MiB, WS_WOUT = 25 * MiB, WS_WQ = 27 * MiB, WS_KBD = 31 * MiB;
constexpr size_t WS_MN = 32 * MiB, WS_KMEM = 40 * MiB, WS_VT = 44 * MiB;
constexpr size_t WS_XG = 48 * MiB;
constexpr size_t WS_YHG = 112 * MiB, WS_YSC = 128 * MiB, WS_YMX = 144 * MiB;
constexpr size_t WS_DS = 160 * MiB;
constexpr size_t WS_MACC = 160 * MiB;
constexpr size_t WS_MERGED = 224 * MiB;
constexpr size_t WS_PROJ = 256 * MiB;
constexpr size_t WS_U = 496 * MiB, WS_V = 504 * MiB;
constexpr size_t WS_Q = 176 * MiB;
constexpr size_t WS_S = 256 * MiB;
constexpr size_t WS_END = 512 * MiB;
constexpr size_t OUT_SST = 64 * MiB;

constexpr int LDS_BYTES = 160 * 1024;
constexpr int MISC_OFF = LDS_BYTES - 512;
constexpr int NWAVES = 8;

DI unsigned f2bf(float f) { unsigned u = __builtin_bit_cast(unsigned, f); return (u + 0x7fffu + ((u >> 16) & 1u)) >> 16; }
DI unsigned pk2(float lo, float hi) { return f2bf(lo) | (f2bf(hi) << 16); }
DI float bf2f(unsigned short b) { return __builtin_bit_cast(float, (unsigned)b << 16); }
DI float bflo(unsigned w) { return __builtin_bit_cast(float, w << 16); }
DI float bfhi(unsigned w) { return __builtin_bit_cast(float, w & 0xffff0000u); }
DI float wave_sum(float v) {
#pragma unroll
    for (int o = 1; o < 64; o <<= 1) v += __shfl_xor(v, o);
    return v;
}
DI unsigned cvtpk(float lo, float hi) { f32x2 v = {lo, hi}; bf16x2_t b = __builtin_convertvector(v, bf16x2_t); return __builtin_bit_cast(unsigned, b); }
template <int CTRL> DI unsigned dpp_u(unsigned v) { return (unsigned)__builtin_amdgcn_update_dpp(0, (int)v, CTRL, 0xF, 0xF, false); }
template <int CTRL> DI float dpp_f(float v) { return __builtin_bit_cast(float, __builtin_amdgcn_update_dpp(0, __builtin_bit_cast(int, v), CTRL, 0xF, 0xF, false)); }
DI float bperm_f(int addr, float v) { return __builtin_bit_cast(float, __builtin_amdgcn_ds_bpermute(addr, __builtin_bit_cast(int, v))); }
DI unsigned row_max16(unsigned m) { m = max(m, dpp_u<0xB1>(m)); m = max(m, dpp_u<0x4E>(m)); m = max(m, dpp_u<0x141>(m)); return max(m, dpp_u<0x140>(m)); }
DI float row_sum16(float v) { v += dpp_f<0xB1>(v); v += dpp_f<0x4E>(v); v += dpp_f<0x141>(v); return v + dpp_f<0x140>(v); }

DI float fast_sig(float z) { return __builtin_amdgcn_rcpf(1.0f + __builtin_amdgcn_exp2f(-1.4426950408889634f * z)); }
DI float sigmoidf_(float z) { return 1.0f / (1.0f + __expf(-z)); }

namespace pg8 {
constexpr int BM = 256, BK = 64, HALF = 128, HTB = HALF * BK * 2, STAGE_BYTES = 8 * HTB, NXCD = 8, WGM = 8;
__host__ __device__ __forceinline__ int lds_byte(int r, int c) { const int st = (r >> 4) * 2 + (c >> 5), rr = r & 15, cc = c & 31, ob = rr * 64 + cc * 2; return st * 1024 + (ob ^ (((ob >> 9) & 1) << 5)); }
__host__ __device__ __forceinline__ void stage_rc(int b, int& R, int& C) { const int st = b / 1024, sb = b % 1024, swz = sb ^ (((sb >> 9) & 1) << 5); R = (st >> 1) * 16 + swz / 64; C = (st & 1) * 32 + (swz % 64) / 2; }
__host__ __device__ __forceinline__ int perm32(int rho) { const int n = rho >> 4, i = rho & 15; return 8 * (i >> 2) + 4 * n + (i & 3); }

struct Unit { int pm, pn, z; };
struct Gemm { int lda, ldb, K; };

struct StaticOrder {
    int nM, nN, nwg, G, c;
    __device__ void init(int M, int N, int G_, int c_) { nM = M / BM; nN = N / BM; nwg = nM * nN; G = G_; c = c_; }
    __device__ bool tile(int i, Unit& u) const {
        const long L = (long)i * G + c; if (L >= nwg) return false;
        int wgid = (int)L; { const int q = nwg / NXCD, r = nwg % NXCD, xcd = wgid % NXCD, off = wgid / NXCD; wgid = (xcd < r ? xcd * (q + 1) : r * (q + 1) + (xcd - r) * q) + off; }
        const int nig = WGM * nN, gid = wgid / nig, fm = gid * WGM, gsz = (nM - fm) < WGM ? (nM - fm) : WGM;
        u.pm = fm + ((wgid % nig) % gsz); u.pn = (wgid % nig) / gsz; u.z = 0; return true;
    }
};

DI unsigned cvt_pk_bf16(float lo, float hi) { return cvtpk(lo, hi); }

template <class Epi, class Sched, bool ALIGN_EPI, bool SP2>
DI void gemm_phase(LAS unsigned char* lds, const Gemm g, const Sched& S, const Epi& E) {
    int tid_ = threadIdx.x; asm volatile("" : "+v"(tid_));
    const int tid = tid_, wid = __builtin_amdgcn_readfirstlane(tid >> 6), lane = tid & 63, wr = wid >> 2, wc = wid & 3, fr = lane & 15, fq = lane >> 4;
    int K_ = g.K; asm volatile("" : "+s"(K_));
    const int K = K_, nt = K / BK;
    unsigned voffA[2], voffB[2];
#pragma unroll
    for (int i = 0; i < 2; ++i) { int R, C; stage_rc(tid * 16 + i * 8192, R, C); const int Rb = Epi::PERM ? ((R & ~31) + perm32(R & 31)) : R;
        voffA[i] = (unsigned)(R * g.lda + C) * 2u; voffB[i] = (unsigned)(Rb * g.ldb + C) * 2u; }
    const size_t kstep = (size_t)(BK * 2);
    const size_t hA = (size_t)HALF * g.lda * 2, hB = (size_t)HALF * g.ldb * 2;
    const unsigned ldsw = (unsigned)wid * 1024u;
    const int aoff = lds_byte(wr * 64 + fr, fq * 8), boff = lds_byte(wc * 32 + fr, fq * 8);
#define PG8_SA(b, h) (((b) * 2 + (h)) * HTB)
#define PG8_SB(b, h) ((4 + (b) * 2 + (h)) * HTB)
#define PG8_STAGE(bufoff, gbase, voff) do { _Pragma("unroll") for (int _i = 0; _i < 2; ++_i) \
        __builtin_amdgcn_global_load_lds((const unsigned*)((const char*)(gbase) + (voff)[_i]), (LAS unsigned*)(lds + (bufoff) + ldsw + _i * 8192), 16, 0, 0); } while (0)
#define PG8_LDA(dst, b, h) do { _Pragma("unroll") for (int m = 0; m < 4; ++m) _Pragma("unroll") for (int k = 0; k < 2; ++k) dst[m][k] = *(const LAS bf16x8*)(lds + PG8_SA(b, h) + aoff + m * 2048 + k * 1024); } while (0)
#define PG8_LDB(dst, b, h) do { _Pragma("unroll") for (int n = 0; n < 2; ++n) _Pragma("unroll") for (int k = 0; k < 2; ++k) dst[n][k] = *(const LAS bf16x8*)(lds + PG8_SB(b, h) + boff + n * 2048 + k * 1024); } while (0)
#define PG8_MMA(ai, bj, At, Bt) do { __builtin_amdgcn_s_setprio(1); _Pragma("unroll") for (int m = 0; m < 4; ++m) _Pragma("unroll") for (int n = 0; n < 2; ++n) _Pragma("unroll") for (int k = 0; k < 2; ++k) \
        acc[ai][bj][m][n] = __builtin_amdgcn_mfma_f32_16x16x32_bf16(Bt[n][k], At[m][k], acc[ai][bj][m][n], 0, 0, 0); __builtin_amdgcn_s_setprio(0); } while (0)
#define PG8_WAIT_V(n) asm volatile("s_waitcnt vmcnt(" #n ")" ::: "memory")
#define PG8_WAIT_L(n) asm volatile("s_waitcnt lgkmcnt(" #n ")" ::: "memory")
#define PG8_BAR __builtin_amdgcn_s_barrier()
#define PG8_SCHED __builtin_amdgcn_sched_barrier(0)
    Unit cur, nxt; int ui = 0;
    if (!S.next(0, cur)) return;
    f32x4 acc[2][2][4][2];
#pragma unroll
    for (int a = 0; a < 2; ++a)
#pragma unroll
        for (int b = 0; b < 2; ++b)
#pragma unroll
            for (int m = 0; m < 4; ++m)
#pragma unroll
                for (int n = 0; n < 2; ++n) acc[a][b][m][n] = (f32x4){0.f, 0.f, 0.f, 0.f};
    bf16x8 At[4][2], B0[2][2], B1[2][2];
    const char* cA = S.a_base(cur); const char* cB = S.b_base(cur);
    if constexpr (SP2) {
        PG8_STAGE(PG8_SB(0, 0), cB, voffB); PG8_STAGE(PG8_SB(0, 1), cB + hB, voffB); PG8_STAGE(PG8_SA(0, 0), cA, voffA); PG8_STAGE(PG8_SA(0, 1), cA + hA, voffA);
        if (wr == 1) PG8_BAR;
        PG8_WAIT_V(2); PG8_BAR;
        PG8_STAGE(PG8_SB(1, 0), cB + kstep, voffB); PG8_STAGE(PG8_SA(1, 0), cA + kstep, voffA); PG8_STAGE(PG8_SB(1, 1), cB + hB + kstep, voffB);
        PG8_WAIT_V(6); PG8_BAR;
    } else {
        PG8_STAGE(PG8_SB(0, 0), cB, voffB); PG8_STAGE(PG8_SA(0, 0), cA, voffA); PG8_STAGE(PG8_SB(0, 1), cB + hB, voffB); PG8_STAGE(PG8_SA(0, 1), cA + hA, voffA);
        if (wr == 1) PG8_BAR;
        PG8_WAIT_V(4); PG8_BAR;
        PG8_STAGE(PG8_SB(1, 0), cB + kstep, voffB); PG8_STAGE(PG8_SA(1, 0), cA + kstep, voffA); PG8_STAGE(PG8_SB(1, 1), cB + hB + kstep, voffB);
        PG8_WAIT_V(6); PG8_BAR;
    }
    for (;;) {
        const bool has_next = S.next(ui + 1, nxt);
        const char* nA = has_next ? S.a_base(nxt) : cA; const char* nB = has_next ? S.b_base(nxt) : cB;
        for (int t = 0; t < nt; t += 2) {
            const bool last = (t == nt - 2);
            const char* a1 = cA + (size_t)(t + 1) * kstep;
            const char* a2 = last ? nA : cA + (size_t)(t + 2) * kstep; const char* b2 = last ? nB : cB + (size_t)(t + 2) * kstep;
            const char* a3 = a2 + kstep; const char* b3 = b2 + kstep;
            if constexpr (SP2) {
            PG8_LDB(B0, 0, 0); PG8_LDB(B1, 0, 1); PG8_SCHED; PG8_LDA(At, 0, 0); PG8_STAGE(PG8_SA(1, 1), a1 + hA, voffA);
            PG8_WAIT_V(8); PG8_WAIT_L(0); PG8_BAR; PG8_MMA(0, 0, At, B0); PG8_MMA(0, 1, At, B1); PG8_BAR; PG8_SCHED;
            PG8_LDA(At, 0, 1); PG8_STAGE(PG8_SB(0, 0), b2, voffB); PG8_STAGE(PG8_SB(0, 1), b2 + hB, voffB); PG8_STAGE(PG8_SA(0, 0), a2, voffA);
            PG8_WAIT_V(8); PG8_WAIT_L(0); PG8_BAR; PG8_MMA(1, 0, At, B0); PG8_MMA(1, 1, At, B1); PG8_BAR; PG8_SCHED;
            PG8_LDB(B0, 1, 0); PG8_LDB(B1, 1, 1); PG8_SCHED; PG8_LDA(At, 1, 0); PG8_STAGE(PG8_SA(0, 1), a2 + hA, voffA);
            PG8_WAIT_V(8); PG8_WAIT_L(0); PG8_BAR; PG8_MMA(0, 0, At, B0); PG8_MMA(0, 1, At, B1); PG8_BAR; PG8_SCHED;
            PG8_LDA(At, 1, 1); PG8_STAGE(PG8_SB(1, 0), b3, voffB); PG8_STAGE(PG8_SB(1, 1), b3 + hB, voffB); PG8_STAGE(PG8_SA(1, 0), a3, voffA);
            PG8_WAIT_V(8); PG8_WAIT_L(0); PG8_BAR; PG8_MMA(1, 0, At, B0); PG8_MMA(1, 1, At, B1); PG8_BAR; PG8_SCHED;
            } else {
            PG8_LDB(B0, 0, 0); PG8_SCHED; PG8_LDA(At, 0, 0); PG8_STAGE(PG8_SA(1, 1), a1 + hA, voffA);
            PG8_WAIT_L(8); PG8_BAR; PG8_WAIT_L(0); PG8_MMA(0, 0, At, B0); PG8_BAR; PG8_SCHED;
            PG8_LDB(B1, 0, 1); PG8_STAGE(PG8_SB(0, 0), b2, voffB);
            PG8_BAR; PG8_WAIT_L(0); PG8_MMA(0, 1, At, B1); PG8_BAR;
            PG8_LDA(At, 0, 1); PG8_STAGE(PG8_SA(0, 0), a2, voffA);
            PG8_BAR; PG8_WAIT_L(0); PG8_MMA(1, 0, At, B0); PG8_BAR; PG8_SCHED;
            PG8_STAGE(PG8_SB(0, 1), b2 + hB, voffB);
            PG8_WAIT_V(6); PG8_BAR; PG8_MMA(1, 1, At, B1); PG8_BAR;
            PG8_LDB(B0, 1, 0); PG8_SCHED; PG8_LDA(At, 1, 0); PG8_STAGE(PG8_SA(0, 1), a2 + hA, voffA);
            PG8_WAIT_L(8); PG8_BAR; PG8_WAIT_L(0); PG8_MMA(0, 0, At, B0); PG8_BAR; PG8_SCHED;
            PG8_LDB(B1, 1, 1); PG8_STAGE(PG8_SB(1, 0), b3, voffB);
            PG8_BAR; PG8_WAIT_L(0); PG8_MMA(0, 1, At, B1); PG8_BAR;
            PG8_LDA(At, 1, 1); PG8_STAGE(PG8_SA(1, 0), a3, voffA);
            PG8_BAR; PG8_WAIT_L(0); PG8_MMA(1, 0, At, B0); PG8_BAR; PG8_SCHED;
            PG8_STAGE(PG8_SB(1, 1), b3 + hB, voffB);
            PG8_WAIT_V(6); PG8_BAR; PG8_MMA(1, 1, At, B1); PG8_BAR;
            }
        }
        if constexpr (ALIGN_EPI) { if (wr == 0) PG8_BAR; }
        E(acc, cur, wr, wc, fr, fq);
        if (!has_next) break;
#pragma unroll
        for (int a = 0; a < 2; ++a)
#pragma unroll
            for (int b = 0; b < 2; ++b)
#pragma unroll
                for (int m = 0; m < 4; ++m)
#pragma unroll
                    for (int n = 0; n < 2; ++n) acc[a][b][m][n] = (f32x4){0.f, 0.f, 0.f, 0.f};
        cur = nxt; cA = nA; cB = nB; ++ui;
        if constexpr (ALIGN_EPI) { if (wr == 1) PG8_BAR; }
    }
    PG8_WAIT_V(0);
    if constexpr (!ALIGN_EPI) { if (wr == 0) PG8_BAR; }
    PG8_BAR;
#undef PG8_SA
#undef PG8_SB
#undef PG8_STAGE
#undef PG8_LDA
#undef PG8_LDB
#undef PG8_MMA
#undef PG8_WAIT_V
#undef PG8_WAIT_L
#undef PG8_BAR
#undef PG8_SCHED
}
}

namespace pg8 {
struct PlainOrder : StaticOrder {
    const char* A; const char* Bt; size_t a_tile, b_tile;
    __device__ bool next(int i, Unit& u) const { return tile(i, u); }
    DI const char* a_base(const Unit& u) const { return A + (size_t)u.pm * a_tile; }
    DI const char* b_base(const Unit& u) const { return Bt + (size_t)u.pn * b_tile; }
};
struct InOrder : StaticOrder {
    const char* H; const char* Win; const char* Mn; const char* Wkv; int n_extra;
    __device__ bool next(int i, Unit& u) const {
        const long L = (long)i * G + c;
        if (L >= (long)nwg + n_extra) return false;
        Unit t; t.pm = 0; t.pn = 0; t.z = 0;
        const bool main_tile = L < nwg;
        if (main_tile) (void)tile(i, t);
        const int e = (int)(L - nwg);
        const int pm1 = e >> 1, pn1 = e & 1, pm2 = (e - 32) >> 4, pn2 = (e - 32) & 15; const bool k1 = e < 32;
        u.pm = main_tile ? t.pm : (k1 ? pm1 : pm2); u.pn = main_tile ? t.pn : (k1 ? pn1 : pn2); u.z = main_tile ? 0 : (k1 ? 1 : 2);
        return true;
    }
    DI const char* a_base(const Unit& u) const { const long d1 = Mn - H, d2 = (Wkv + (size_t)512 * 1024 * 2) - H; return H + ((u.z == 1) ? d1 : 0L) + ((u.z == 2) ? d2 : 0L) + (size_t)u.pm * (256 * 1024 * 2); }
    DI const char* b_base(const Unit& u) const { const long d1 = Wkv - Win, d2 = Mn - Win; return Win + ((u.z == 1) ? d1 : 0L) + ((u.z == 2) ? d2 : 0L) + (size_t)u.pn * (256 * 1024 * 2); }
};
struct EpiIn {
    static constexpr bool PERM = true;
    bf16* proj; bf16* kmem; bf16* vt;
    DI void operator()(const f32x4 (&acc)[2][2][4][2], const Unit& u, int wr, int wc, int fr, int fq) const {
        const long dk = kmem - proj, dv = vt - proj; bf16* O = proj + ((u.z == 1) ? dk : 0L) + ((u.z == 2) ? dv : 0L); const int ldc = PC + ((u.z == 1) ? 512 - PC : 0) + ((u.z == 2) ? BATCH * NMEM - PC : 0);
        const int row0 = u.pm * BM + wr * 64 + fr, col0 = u.pn * BM + wc * 32 + 8 * fq;
#pragma unroll
        for (int ai = 0; ai < 2; ++ai)
#pragma unroll
            for (int m = 0; m < 4; ++m) { bf16* rowp = O + (size_t)(row0 + ai * HALF + m * 16) * ldc + col0;
#pragma unroll
                for (int bj = 0; bj < 2; ++bj) { const f32x4 v0 = acc[ai][bj][m][0], v1 = acc[ai][bj][m][1];
                    u32x4 w; w.x = cvt_pk_bf16(v0[0], v0[1]); w.y = cvt_pk_bf16(v0[2], v0[3]); w.z = cvt_pk_bf16(v1[0], v1[1]); w.w = cvt_pk_bf16(v1[2], v1[3]);
                    *(u32x4*)(rowp + bj * HALF) = w; } }
    }
};
struct BranchOrder : StaticOrder {
    const char* Y; const char* Wb;
    __device__ bool next(int i, Unit& u) const { if (!tile(i / 3, u)) return false; u.z = i % 3; return true; }
    DI const char* a_base(const Unit& u) const { return Y + (size_t)u.z * (16 * MiB) + (size_t)u.pm * (256 * 512 * 2); }
    DI const char* b_base(const Unit& u) const { return Wb + (size_t)u.z * (1024 * 512 * 2) + (size_t)u.pn * (256 * 512 * 2); }
};
struct ScoreOrder : StaticOrder {
    const char* Q; const char* Kbd;
    __device__ bool next(int i, Unit& u) const { return tile(i, u); }
    DI const char* a_base(const Unit& u) const { return Q + (size_t)u.pm * (256 * 2048 * 2) + (size_t)u.pn * 512; }
    DI const char* b_base(const Unit& u) const { return Kbd + (size_t)u.pn * (256 * 256 * 2); }
};

struct EpiBf16 {
    static constexpr bool PERM = true;
    bf16* O; int ldc;
    DI void operator()(const f32x4 (&acc)[2][2][4][2], const Unit& u, int wr, int wc, int fr, int fq) const {
        const int row0 = u.pm * BM + wr * 64 + fr, col0 = u.pn * BM + wc * 32 + 8 * fq;
#pragma unroll
        for (int ai = 0; ai < 2; ++ai)
#pragma unroll
            for (int m = 0; m < 4; ++m) { bf16* rowp = O + (size_t)(row0 + ai * HALF + m * 16) * ldc + col0;
#pragma unroll
                for (int bj = 0; bj < 2; ++bj) { const f32x4 v0 = acc[ai][bj][m][0], v1 = acc[ai][bj][m][1];
                    u32x4 w; w.x = cvt_pk_bf16(v0[0], v0[1]); w.y = cvt_pk_bf16(v0[2], v0[3]); w.z = cvt_pk_bf16(v1[0], v1[1]); w.w = cvt_pk_bf16(v1[2], v1[3]);
                    *(u32x4*)(rowp + bj * HALF) = w; } }
    }
};
struct EpiQ {
    static constexpr bool PERM = true;
    bf16* O; int ldc; const float* ssp;
    DI void operator()(const f32x4 (&acc)[2][2][4][2], const Unit& u, int wr, int wc, int fr, int fq) const {
        const int row0 = u.pm * BM + wr * 64 + fr, col0 = u.pn * BM + wc * 32 + 8 * fq;
#pragma unroll
        for (int ai = 0; ai < 2; ++ai)
#pragma unroll
            for (int m = 0; m < 4; ++m) { const int row = row0 + ai * HALF + m * 16; const f32x4* sp = (const f32x4*)(ssp + (size_t)row * 16);
                const f32x4 s0 = sp[0], s1 = sp[1], s2 = sp[2], s3 = sp[3];
                const float ss = ((s0[0] + s0[1]) + (s0[2] + s0[3])) + ((s1[0] + s1[1]) + (s1[2] + s1[3])) + ((s2[0] + s2[1]) + (s2[2] + s2[3])) + ((s3[0] + s3[1]) + (s3[2] + s3[3]));
                const float rs = 1.0f / sqrtf(ss * (1.0f / 1024.0f) + EPS);
                bf16* rowp = O + (size_t)row * ldc + col0;
#pragma unroll
                for (int bj = 0; bj < 2; ++bj) { const f32x4 v0 = acc[ai][bj][m][0] * rs, v1 = acc[ai][bj][m][1] * rs;
                    u32x4 w; w.x = cvt_pk_bf16(v0[0], v0[1]); w.y = cvt_pk_bf16(v0[2], v0[3]); w.z = cvt_pk_bf16(v1[0], v1[1]); w.w = cvt_pk_bf16(v1[2], v1[3]);
                    *(u32x4*)(rowp + bj * HALF) = w; }
                asm volatile("" ::: "memory"); }
    }
};
struct EpiF32 {
    static constexpr bool PERM = false;
    float* C; int ldc;
    DI void operator()(const f32x4 (&acc)[2][2][4][2], const Unit& u, int wr, int wc, int fr, int fq) const {
        const int row0 = u.pm * BM + wr * 64 + fr, col0 = u.pn * BM + wc * 32 + 4 * fq;
#pragma unroll
        for (int ai = 0; ai < 2; ++ai)
#pragma unroll
            for (int m = 0; m < 4; ++m) { float* rowp = C + (size_t)(row0 + ai * HALF + m * 16) * ldc + col0;
#pragma unroll
                for (int bj = 0; bj < 2; ++bj)
#pragma unroll
                    for (int n = 0; n < 2; ++n) *(f32x4*)(rowp + bj * HALF + n * 16) = acc[ai][bj][m][n]; }
    }
};
struct EpiBranch {
    static constexpr bool PERM = true;
    const bf16* proj; bf16* gbuf; bf16* merged;
    DI void operator()(const f32x4 (&acc)[2][2][4][2], const Unit& u, int wr, int wc, int fr, int fq) const {
        const int row0 = u.pm * BM + wr * 64 + fr, col0 = u.pn * BM + wc * 32 + 8 * fq;
#pragma unroll
        for (int ai = 0; ai < 2; ++ai)
#pragma unroll
            for (int m = 0; m < 4; ++m) { const int row = row0 + ai * HALF + m * 16;
#pragma unroll
                for (int bj = 0; bj < 2; ++bj) { const int col = col0 + bj * HALF;
                    const u32x4 gw = *(const u32x4*)(proj + (size_t)row * PC + C_GATE + u.z * 1024 + col);
                    f32x4 v0 = acc[ai][bj][m][0], v1 = acc[ai][bj][m][1];
                    v0[0] *= fast_sig(bflo(gw.x)); v0[1] *= fast_sig(bfhi(gw.x)); v0[2] *= fast_sig(bflo(gw.y)); v0[3] *= fast_sig(bfhi(gw.y));
                    v1[0] *= fast_sig(bflo(gw.z)); v1[1] *= fast_sig(bfhi(gw.z)); v1[2] *= fast_sig(bflo(gw.w)); v1[3] *= fast_sig(bfhi(gw.w));
                    const size_t off = (size_t)row * 1024 + col;
                    if (u.z == 2) { const u32x4 p0 = *(const u32x4*)(gbuf + off), p1 = *(const u32x4*)(gbuf + (size_t)TG * 1024 + off);
                        v0[0] += bflo(p0.x) + bflo(p1.x); v0[1] += bfhi(p0.x) + bfhi(p1.x); v0[2] += bflo(p0.y) + bflo(p1.y); v0[3] += bfhi(p0.y) + bfhi(p1.y);
                        v1[0] += bflo(p0.z) + bflo(p1.z); v1[1] += bfhi(p0.z) + bfhi(p1.z); v1[2] += bflo(p0.w) + bflo(p1.w); v1[3] += bfhi(p0.w) + bfhi(p1.w); }
                    u32x4 w; w.x = cvt_pk_bf16(v0[0], v0[1]); w.y = cvt_pk_bf16(v0[2], v0[3]); w.z = cvt_pk_bf16(v1[0], v1[1]); w.w = cvt_pk_bf16(v1[2], v1[3]);
                    *(u32x4*)((u.z == 2 ? merged : gbuf + (size_t)u.z * TG * 1024) + off) = w; }
                asm volatile("" ::: "memory"); }
    }
};
struct EpiOut {
    static constexpr bool PERM = true;
    const float* x; float* x1; bf16* xg; const float* gffn; float* ssp;
    DI void operator()(const f32x4 (&acc)[2][2][4][2], const Unit& u, int wr, int wc, int fr, int fq) const {
        const int row0 = u.pm * BM + wr * 64 + fr, col0 = u.pn * BM + wc * 32 + 8 * fq;
        f32x4 g0[2], g1[2];
#pragma unroll
        for (int bj = 0; bj < 2; ++bj) { g0[bj] = *(const f32x4*)(gffn + col0 + bj * HALF); g1[bj] = *(const f32x4*)(gffn + col0 + bj * HALF + 4); }
#pragma unroll
        for (int ai = 0; ai < 2; ++ai)
#pragma unroll
            for (int m = 0; m < 4; ++m) { const int row = row0 + ai * HALF + m * 16; float ss = 0.f;
#pragma unroll
                for (int bj = 0; bj < 2; ++bj) { const size_t off = (size_t)row * 1024 + col0 + bj * HALF;
                    const f32x4 v0 = acc[ai][bj][m][0] + *(const f32x4*)(x + off), v1 = acc[ai][bj][m][1] + *(const f32x4*)(x + off + 4);
                    *(f32x4*)(x1 + off) = v0; *(f32x4*)(x1 + off + 4) = v1;
                    ss += (v0[0] * v0[0] + v0[1] * v0[1]) + (v0[2] * v0[2] + v0[3] * v0[3]) + (v1[0] * v1[0] + v1[1] * v1[1]) + (v1[2] * v1[2] + v1[3] * v1[3]);
                    const f32x4 a = v0 * g0[bj], b = v1 * g1[bj];
                    u32x4 w; w.x = cvt_pk_bf16(a[0], a[1]); w.y = cvt_pk_bf16(a[2], a[3]); w.z = cvt_pk_bf16(b[0], b[1]); w.w = cvt_pk_bf16(b[2], b[3]);
                    *(u32x4*)(xg + off) = w; }
                ss += __shfl_xor(ss, 16); ss += __shfl_xor(ss, 32);
                if (fq == 0) ssp[(size_t)row * 16 + u.pn * 4 + wc] = ss;
                asm volatile("" ::: "memory"); }
    }
};
}

#define XB_TMO      128
#define XB_XCNT(j)  (256  + 64 * (j))
#define XB_XSUB(j)  (1280 + 64 * (j))
#define XB_XGEN(j)  (2304 + 64 * (j))
#define XB_TOP      3328
#define XB_TOPGEN   3392
#define XCD_BAR_WORDS 3456
#define XB_SPIN_CAP (1u << 18)
constexpr int CW_BAR = 4096;

DI unsigned xb_ld(unsigned* p)              { return __hip_atomic_load(p, __ATOMIC_RELAXED, __HIP_MEMORY_SCOPE_AGENT); }
DI unsigned xb_add(unsigned* p, unsigned v) { return __hip_atomic_fetch_add(p, v, __ATOMIC_RELAXED, __HIP_MEMORY_SCOPE_AGENT); }
DI unsigned xb_xcc_id() { return (unsigned)__builtin_amdgcn_s_getreg((3 << 11) | 20) & 0xFu; }
#define XB_SPIN(cond, bar) do { unsigned _sp = 0; while (cond) { __builtin_amdgcn_s_sleep(1); \
    if ((++_sp & 255u) == 0u) { if (xb_ld(&(bar)[XB_TMO])) break; if (_sp > XB_SPIN_CAP) { atomicAdd(&(bar)[XB_TMO], 1u); break; } } } } while (0)

struct XcdBarrier { unsigned* bar; unsigned x; volatile LAS unsigned* st; };

DI XcdBarrier xcd_barrier_post(unsigned* bar, volatile LAS unsigned* st) {
    XcdBarrier b; b.bar = bar; b.x = xb_xcc_id(); b.st = st;
    if (threadIdx.x == 0) (void)xb_add(&bar[XB_XCNT(b.x)], 1u);
    return b;
}
DI void xcd_barrier_complete(unsigned* bar, unsigned x, unsigned& nloc, unsigned& nx) {
    const unsigned G = gridDim.x * gridDim.y * gridDim.z;
    unsigned sum, cnt, mine, sp = 0u;
    for (;;) {
        sum = 0u; cnt = 0u; mine = 0u;
#pragma unroll
        for (unsigned j = 0; j < 16; ++j) { const unsigned c = xb_ld(&bar[XB_XCNT(j)]); sum += c; cnt += (c > 0u) ? 1u : 0u; mine = (j == x) ? c : mine; }
        if (sum == G) break;
        __builtin_amdgcn_s_sleep(1);
        if ((++sp & 255u) == 0u) { if (xb_ld(&bar[XB_TMO])) break; if (sp > XB_SPIN_CAP) { atomicAdd(&bar[XB_TMO], 1u); break; } }
    }
    nloc = mine > 0u ? mine : 1u; nx = cnt > 0u ? cnt : 1u;
}
DI void xcd_barrier(const XcdBarrier& b) {
    asm volatile("s_waitcnt vmcnt(0)" ::: "memory");
    __syncthreads();
    if (threadIdx.x == 0) {
        unsigned* bar = b.bar;
        __builtin_amdgcn_s_waitcnt(0);
        unsigned nloc = b.st[0], nx = b.st[1];
        if (nloc == 0u) { xcd_barrier_complete(bar, b.x, nloc, nx); b.st[0] = nloc; b.st[1] = nx; }
        const unsigned old = xb_add(&bar[XB_XSUB(b.x)], 1u);
        const unsigned gen = old / nloc;
        if (old + 1u == (gen + 1u) * nloc) {
            __builtin_amdgcn_fence(__ATOMIC_RELEASE, "agent");
            asm volatile("s_waitcnt vmcnt(0)" ::: "memory");
            const unsigned og = xb_add(&bar[XB_TOP], 1u);
            const unsigned tg = og / nx;
            if (og + 1u == (tg + 1u) * nx) xb_add(&bar[XB_TOPGEN], 1u);
            else XB_SPIN(xb_ld(&bar[XB_TOPGEN]) == tg, bar);
            __builtin_amdgcn_fence(__ATOMIC_ACQUIRE, "agent");
            xb_add(&bar[XB_XGEN(b.x)], 1u);
            asm volatile("s_waitcnt vmcnt(0)" ::: "memory");
        } else {
            XB_SPIN(xb_ld(&bar[XB_XGEN(b.x)]) == gen, bar);
            __builtin_amdgcn_fence(__ATOMIC_ACQUIRE, "agent");
            asm volatile("s_waitcnt vmcnt(0)" ::: "memory");
        }
    }
    __syncthreads();
}

struct Frame {
    LAS unsigned char* lds;
    int tid, lane, wave;
    DI void refresh() { int t = threadIdx.x; asm volatile("" : "+v"(t)); tid = t; lane = t & 63; wave = __builtin_amdgcn_readfirstlane(t >> 6); }
    int vcu, G;
    const float *x, *mem, *norm_mix_g, *w_in, *hg_lb, *hg_norm_g, *sc_conv_w, *mem_norm_g, *w_mem_kv, *w_branch, *w_out, *norm_ffn_g, *peer_w_q, *peer_sub_keys, *peer_u, *peer_v, *final_norm_g;
    float* out; unsigned char* ws;
};

DI void p0_transpose_item(const float* W, int K, int N, bf16* WT, LAS float* scr, int item, int lane) {
    const int nblk = N / 32, kb = item / nblk, nb = item % nblk, k0 = 64 * kb, n0 = 32 * nb;
#pragma unroll 8
    for (int i = 0; i < 32; ++i) { const int kk = 2 * i + (lane >> 5); scr[kk * 33 + (lane & 31)] = W[(size_t)(k0 + kk) * N + n0 + (lane & 31)]; }
    asm volatile("s_waitcnt lgkmcnt(0)" ::: "memory");
    const int c = lane & 7;
#pragma unroll
    for (int j = 0; j < 4; ++j) { const int n = (lane >> 3) + 8 * j; const LAS float* s = scr + (8 * c) * 33 + n;
        u32x4 o; o.x = pk2(s[0 * 33], s[1 * 33]); o.y = pk2(s[2 * 33], s[3 * 33]); o.z = pk2(s[4 * 33], s[5 * 33]); o.w = pk2(s[6 * 33], s[7 * 33]);
        *(u32x4*)(WT + (size_t)(n0 + n) * K + k0 + 8 * c) = o; }
    asm volatile("s_waitcnt lgkmcnt(0)" ::: "memory");
}
DI void rms_row_to_bf16(const float* xrow, const float* g, bf16* orow, int lane) {
    const f32x4* xr = (const f32x4*)xrow + lane; const f32x4* gr = (const f32x4*)g + lane;
    f32x4 v[4]; float s = 0.f;
#pragma unroll
    for (int j = 0; j < 4; ++j) { v[j] = xr[64 * j]; s += (v[j].x * v[j].x + v[j].y * v[j].y) + (v[j].z * v[j].z + v[j].w * v[j].w); }
    const float rstd = 1.0f / sqrtf(wave_sum(s) * (1.f / 1024.f) + EPS);
    unsigned long long* o8 = (unsigned long long*)orow + lane;
#pragma unroll
    for (int j = 0; j < 4; ++j) { const f32x4 gg = gr[64 * j]; const f32x4 y = v[j] * rstd * gg;
        o8[64 * j] = (unsigned long long)pk2(y.x, y.y) | ((unsigned long long)pk2(y.z, y.w) << 32); }
}
DI void p0_prologue(Frame& F) {
    F.refresh();
    LAS float* scr = (LAS float*)(F.lds + F.wave * 16384);
    const int gw = F.vcu * NWAVES + F.wave, NGW = F.G * NWAVES;
    unsigned char* ws = F.ws;
    constexpr int I_IN = (1024 / 64) * (PC / 32), I_KV = (1024 / 64) * (1024 / 32), I_BR = (512 / 64) * (1024 / 32), I_OUT = (1024 / 64) * (1024 / 32), I_Q = (1024 / 64) * (2048 / 32);
    constexpr int NITEMS = I_IN + I_KV + 3 * I_BR + I_OUT + I_Q;
    for (int it = gw; it < NITEMS; it += NGW) {
        int r = it;
        if (r < I_IN) { p0_transpose_item(F.w_in, 1024, PC, (bf16*)(ws + WS_WIN), scr, r, F.lane); continue; } r -= I_IN;
        if (r < I_KV) { p0_transpose_item(F.w_mem_kv, 1024, 1024, (bf16*)(ws + WS_WKV), scr, r, F.lane); continue; } r -= I_KV;
        if (r < 3 * I_BR) { const int n = r / I_BR; p0_transpose_item(F.w_branch + (size_t)n * 512 * 1024, 512, 1024, (bf16*)(ws + WS_WBR) + (size_t)n * 1024 * 512, scr, r % I_BR, F.lane); continue; } r -= 3 * I_BR;
        if (r < I_OUT) { p0_transpose_item(F.w_out, 1024, 1024, (bf16*)(ws + WS_WOUT), scr, r, F.lane); continue; } r -= I_OUT;
        p0_transpose_item(F.peer_w_q, 1024, 2048, (bf16*)(ws + WS_WQ), scr, r, F.lane);
    }
    const int gt = F.vcu * 512 + F.tid, NGT = F.G * 512;
    for (int it = gt; it < 8 * 256 * 32; it += NGT) {
        const int c8 = it & 31, row = (it >> 5) & 255, h = it >> 13, p = row >> 7, key = row & 127;
        u32x4 o = (u32x4){0u, 0u, 0u, 0u};
        if ((c8 >> 4) == p) { const float* s = F.peer_sub_keys + (((size_t)(h * 2 + p) * 128 + key) * 128 + (c8 & 15) * 8);
            const f32x4 a = *(const f32x4*)s, b = *(const f32x4*)(s + 4); o.x = pk2(a.x, a.y); o.y = pk2(a.z, a.w); o.z = pk2(b.x, b.y); o.w = pk2(b.z, b.w); }
        *(u32x4*)((bf16*)(ws + WS_KBD) + ((size_t)(h * 256 + row) * 256 + c8 * 8)) = o;
    }
    for (int it = gt; it < 1024; it += NGT) { const float a0 = F.hg_lb[it], a1 = F.hg_lb[1024 + it]; const float m = fmaxf(a0, a1); const float e0 = __expf(a0 - m), e1 = __expf(a1 - m);
        ((float*)(ws + WS_LB))[it] = e0 / (e0 + e1); }
    for (int m = gw; m < BATCH * NMEM; m += NGW) rms_row_to_bf16(F.mem + (size_t)m * 1024, F.mem_norm_g, (bf16*)(ws + WS_MN) + (size_t)m * 1024, F.lane);
    for (int m = gw; m < T_ALL; m += NGW) rms_row_to_bf16(F.x + (size_t)m * 1024, F.norm_mix_g, (bf16*)(ws + WS_XG) + (size_t)m * 1024, F.lane);
}

DI s16x4 tr16(const LAS unsigned char* p) { return __builtin_bit_cast(s16x4, __builtin_amdgcn_ds_read_tr16_b64_v4i16((LAS v4i16_t*)p)); }
DI bf16x8 cat8(s16x4 lo, s16x4 hi) { return __builtin_shufflevector(lo, hi, 0, 1, 2, 3, 4, 5, 6, 7); }
#define MFMA32(a, b, c) __builtin_amdgcn_mfma_f32_32x32x16_bf16((a), (b), (c), 0, 0, 0)
DI int crow(int reg, int h) { return (reg & 3) + 8 * (reg >> 2) + 4 * h; }
DI bf16x8 pack8(const f32x16& x, int s) {
    u32x4 p; p.x = cvtpk(x[8 * s], x[8 * s + 1]); p.y = cvtpk(x[8 * s + 2], x[8 * s + 3]); p.z = cvtpk(x[8 * s + 4], x[8 * s + 5]); p.w = cvtpk(x[8 * s + 6], x[8 * s + 7]);
    return __builtin_bit_cast(bf16x8, p);
}
constexpr int TS = 272;

DI void stage_tile(LAS unsigned char* tile, const bf16* src, int tid) {
#pragma unroll
    for (int i = 0; i < 2; ++i) { const int id = tid + 512 * i, c = id >> 4, ch = id & 15;
        *(LAS u32x4*)(tile + c * TS + ch * 16) = *(const u32x4*)(src + (size_t)c * PC + ch * 8); }
}
DI float touch_tile(const bf16* src, int i128) { return *(const float*)(src + (size_t)(i128 >> 1) * PC + (i128 & 1) * 64); }
DI void gate8(const LAS unsigned char* zt, int dp, int ts, f32x2 lb, f32x2 (&L)[8], f32x2 (&kk)[8], f32x2 (&lf)[8]) {
    f32x2 run = (f32x2){0.f, 0.f}; const f32x2 oml = 1.0f - lb;
#pragma unroll
    for (int i = 0; i < 8; ++i) { const unsigned w = *(const LAS unsigned*)(zt + (8 * ts + i) * TS + 4 * dp);
        const f32x2 sg = (f32x2){fast_sig(bflo(w)), fast_sig(bfhi(w))}; const f32x2 f = lb + oml * sg;
        lf[i] = (f32x2){__builtin_amdgcn_logf(f.x), __builtin_amdgcn_logf(f.y)}; kk[i] = oml * (1.0f - sg); run += lf[i]; L[i] = run; }
}
DI f32x2 exp2x2(f32x2 v) { return (f32x2){__builtin_amdgcn_exp2f(v.x), __builtin_amdgcn_exp2f(v.y)}; }
struct SliceSums { f32x2 offf, offb, glf, glb, greff, grefb; };
DI SliceSums slice_sums(const LAS float* tot, int dp, int ts) {
    SliceSums r; f32x2 tf[8], tb[8];
#pragma unroll
    for (int j = 0; j < 8; ++j) { tf[j] = *(const LAS f32x2*)(tot + j * 128 + 2 * dp); tb[j] = *(const LAS f32x2*)(tot + (8 + j) * 128 + 2 * dp); }
    r.offf = (f32x2){0.f, 0.f}; r.offb = (f32x2){0.f, 0.f};
#pragma unroll
    for (int j = 0; j < 8; ++j) { if (j < ts) r.offf += tf[j]; if (j > ts) r.offb += tb[j]; }
    r.greff = (tf[0] + tf[1]) + (tf[2] + tf[3]); r.glf = r.greff + ((tf[4] + tf[5]) + (tf[6] + tf[7]));
    r.grefb = (tb[4] + tb[5]) + (tb[6] + tb[7]); r.glb = r.grefb + ((tb[0] + tb[1]) + (tb[2] + tb[3]));
    return r;
}

DI void hgrn_a_item(Frame& F, int item, bool has_next) {
    F.refresh();
    constexpr int T_V = 0, T_KF = 17408, T_KB = 34816, TOT = 52224;
    LAS unsigned char* lds = F.lds;
    const int n = item & 31, h = (item >> 5) & 3, b = item >> 7;
    const bf16* proj = (const bf16*)(F.ws + WS_PROJ) + ((size_t)b * SEQ + n * CHUNK) * PC;
    const int tid = F.tid, dp = tid & 63, ts = F.wave;
    const float* lbp = (const float*)(F.ws + WS_LB);
    const f32x2 lbf = *(const f32x2*)(lbp + h * 128 + 2 * dp), lbb = *(const f32x2*)(lbp + 512 + h * 128 + 2 * dp);
    stage_tile(lds + T_V, proj + C_HI + h * 128, tid); stage_tile(lds + T_KF, proj + C_FF + h * 128, tid); stage_tile(lds + T_KB, proj + C_FB + h * 128, tid);
    float tch = 0.f;
    if (has_next) { const bf16* pn = proj + (size_t)CHUNK * PC + h * 128; const int i128 = tid & 127, wsel = tid >> 7; tch = touch_tile(pn + (wsel == 0 ? C_HI : wsel == 1 ? C_FF : C_FB), i128); }
    __syncthreads();
    f32x2 Lf[8], kf[8], lff[8], Lb[8], kb[8], lfb[8];
    gate8(lds + T_KF, dp, ts, lbf, Lf, kf, lff);
    gate8(lds + T_KB, dp, ts, lbb, Lb, kb, lfb);
    LAS float* tot = (LAS float*)(lds + TOT);
    *(LAS f32x2*)(tot + ts * 128 + 2 * dp) = Lf[7]; *(LAS f32x2*)(tot + (8 + ts) * 128 + 2 * dp) = Lb[7];
    asm volatile("" :: "v"(tch));
    __syncthreads();
    const SliceSums ss = slice_sums(tot, dp, ts);
    const f32x2 tbq = Lb[7];
#pragma unroll
    for (int i = 0; i < 8; ++i) { const int c = 8 * ts + i;
        const f32x2 G = ss.offf + Lf[i]; const f32x2 kd = kf[i] * exp2x2(ss.glf - G);
        const f32x2 Gb = ss.offb + (tbq - Lb[i] + lfb[i]); const f32x2 kdb = kb[i] * exp2x2(ss.glb - Gb);
        *(LAS unsigned*)(lds + T_KF + c * TS + 4 * dp) = cvtpk(kd.x, kd.y); *(LAS unsigned*)(lds + T_KB + c * TS + 4 * dp) = cvtpk(kdb.x, kdb.y); }
    if (ts == 0) { float* dec = (float*)(F.ws + WS_DEC) + (size_t)item * 256; *(f32x2*)(dec + 2 * dp) = exp2x2(ss.glf); *(f32x2*)(dec + 128 + 2 * dp) = exp2x2(ss.glb); }
    __syncthreads();
    const int w = F.wave, lane = F.lane, r = lane & 31, hh = lane >> 5, blk = (lane >> 4) & 1, q = (lane & 15) >> 2, p = lane & 3;
    const int dt = w >> 1, et0 = (w & 1) * 2;
#pragma unroll
    for (int dir = 0; dir < 2; ++dir) { const int TK = dir ? T_KB : T_KF;
#pragma unroll
        for (int e2 = 0; e2 < 2; ++e2) { const int et = et0 + e2; f32x16 acc;
#pragma unroll
            for (int i = 0; i < 16; ++i) acc[i] = 0.f;
#pragma unroll
            for (int ks = 0; ks < 4; ++ks) {
                const LAS unsigned char* ap = lds + TK + (16 * ks + 8 * hh + q) * TS + (32 * dt + 16 * blk + 4 * p) * 2;
                const LAS unsigned char* bp = lds + T_V + (16 * ks + 8 * hh + q) * TS + (32 * et + 16 * blk + 4 * p) * 2;
                const bf16x8 a = cat8(tr16(ap), tr16(ap + 4 * TS)), bq = cat8(tr16(bp), tr16(bp + 4 * TS));
                acc = MFMA32(a, bq, acc); }
            bf16* dsb = (bf16*)(F.ws + WS_DS) + ((size_t)(item * 2 + dir) * 128 + 32 * et + r) * 128 + 32 * dt + 4 * hh;
#pragma unroll
            for (int g4 = 0; g4 < 4; ++g4) { u32x2 wv; wv.x = cvtpk(acc[4 * g4], acc[4 * g4 + 1]); wv.y = cvtpk(acc[4 * g4 + 2], acc[4 * g4 + 3]); *(u32x2*)(dsb + 8 * g4) = wv; } } }
    __syncthreads();
}

DI void hgrn_scan(Frame& F) {
    F.refresh();
    const bf16* dS = (const bf16*)(F.ws + WS_DS); bf16* Sst = (bf16*)((unsigned char*)F.out + OUT_SST); const float* dec = (const float*)(F.ws + WS_DEC);
    const int gt = F.vcu * 512 + F.tid, NGT = F.G * 512;
    for (int id = gt; id < BG * 4 * 2 * 128 * 32; id += NGT) {
        const int d4 = id & 31, e = (id >> 5) & 127, dir = (id >> 12) & 1, bh = id >> 13;
        f32x4 S = (f32x4){0.f, 0.f, 0.f, 0.f};
#pragma unroll 4
        for (int s = 0; s < 32; ++s) { const int n = dir ? 31 - s : s, item = bh * 32 + n;
            const size_t off = ((size_t)(item * 2 + dir) * 128 + e) * 128 + d4 * 4;
            u32x2 o; o.x = cvtpk(S.x, S.y); o.y = cvtpk(S.z, S.w); *(u32x2*)(Sst + off) = o;
            const f32x4 dc = *(const f32x4*)(dec + (size_t)(item * 2 + dir) * 128 + d4 * 4);
            const u32x2 wv = *(const u32x2*)(dS + off);
            S.x = dc.x * S.x + bflo(wv.x); S.y = dc.y * S.y + bfhi(wv.x); S.z = dc.z * S.z + bflo(wv.y); S.w = dc.w * S.w + bfhi(wv.y); }
    }
}

DI void hgrn_c_item(Frame& F, int item, bool has_next) {
    F.refresh();
    constexpr int T_QRF = 0, T_KRF = 17408, T_QGF = 34816, T_QRB = 52224, T_KRB = 69632, T_QGB = 87040, T_V = 104448, TOT = 121856, O_OFF = 0, OS = 132;
    LAS unsigned char* lds = F.lds;
    const int n = item & 31, h = (item >> 5) & 3, b = item >> 7;
    const size_t row0 = (size_t)b * SEQ + n * CHUNK;
    const bf16* proj = (const bf16*)(F.ws + WS_PROJ) + row0 * PC;
    const int tid = F.tid, dp = tid & 63, ts = F.wave;
    const float* lbp = (const float*)(F.ws + WS_LB);
    const f32x2 lbf = *(const f32x2*)(lbp + h * 128 + 2 * dp), lbb = *(const f32x2*)(lbp + 512 + h * 128 + 2 * dp);
    stage_tile(lds + T_V, proj + C_HI + h * 128, tid); stage_tile(lds + T_KRF, proj + C_FF + h * 128, tid); stage_tile(lds + T_KRB, proj + C_FB + h * 128, tid); stage_tile(lds + T_QRF, proj + C_HQ + h * 128, tid);
    float tch = 0.f, tch2 = 0.f;
    if (has_next) { const bf16* pn = proj + (size_t)CHUNK * PC + h * 128; const int i128 = tid & 127, wsel = tid >> 7; tch = touch_tile(pn + (wsel == 0 ? C_HI : wsel == 1 ? C_FF : wsel == 2 ? C_FB : C_HQ), i128);
        tch2 = *(const float*)((const unsigned char*)F.out + OUT_SST + (size_t)(item + 1) * 65536 + (size_t)tid * 128); }
    __syncthreads();
    f32x2 qv[8];
#pragma unroll
    for (int i = 0; i < 8; ++i) { const unsigned w = *(const LAS unsigned*)(lds + T_QRF + (8 * ts + i) * TS + 4 * dp); const float z0 = bflo(w), z1 = bfhi(w); qv[i] = (f32x2){z0 * fast_sig(z0), z1 * fast_sig(z1)}; }
    f32x2 Lf[8], kf[8], lff[8], Lb[8], kb[8], lfb[8];
    gate8(lds + T_KRF, dp, ts, lbf, Lf, kf, lff);
    gate8(lds + T_KRB, dp, ts, lbb, Lb, kb, lfb);
    LAS float* tot = (LAS float*)(lds + TOT);
    *(LAS f32x2*)(tot + ts * 128 + 2 * dp) = Lf[7]; *(LAS f32x2*)(tot + (8 + ts) * 128 + 2 * dp) = Lb[7];
    asm volatile("" :: "v"(tch), "v"(tch2));
    __syncthreads();
    {
        const SliceSums ss = slice_sums(tot, dp, ts);
        const f32x2 tbq = Lb[7];
#pragma unroll
        for (int i = 0; i < 8; ++i) { const int c = 8 * ts + i; const int o = c * TS + 4 * dp;
            const f32x2 G = ss.offf + Lf[i]; const f32x2 x = G - ss.greff;
            const f32x2 qr = qv[i] * exp2x2(x), kr = kf[i] * exp2x2(-x), qg = qv[i] * exp2x2(G);
            *(LAS unsigned*)(lds + T_QRF + o) = cvtpk(qr.x, qr.y); *(LAS unsigned*)(lds + T_KRF + o) = cvtpk(kr.x, kr.y); *(LAS unsigned*)(lds + T_QGF + o) = cvtpk(qg.x, qg.y);
            const f32x2 Gb = ss.offb + (tbq - Lb[i] + lfb[i]); const f32x2 xb = Gb - ss.grefb;
            const f32x2 qrb = qv[i] * exp2x2(xb), krb = kb[i] * exp2x2(-xb), qgb = qv[i] * exp2x2(Gb);
            *(LAS unsigned*)(lds + T_QRB + o) = cvtpk(qrb.x, qrb.y); *(LAS unsigned*)(lds + T_KRB + o) = cvtpk(krb.x, krb.y); *(LAS unsigned*)(lds + T_QGB + o) = cvtpk(qgb.x, qgb.y); }
    }
    __syncthreads();
    const int w = F.wave, lane = F.lane, r = lane & 31, hh = lane >> 5, blk = (lane >> 4) & 1, q = (lane & 15) >> 2, p = lane & 3;
    const int ct = w >> 2, et = w & 3;
    const bf16* Sst = (const bf16*)((const unsigned char*)F.out + OUT_SST);
    f32x16 o;
#pragma unroll
    for (int i = 0; i < 16; ++i) o[i] = 0.f;
#pragma unroll
    for (int dir = 0; dir < 2; ++dir) { const int TQR = dir ? T_QRB : T_QRF, TKR = dir ? T_KRB : T_KRF, TQG = dir ? T_QGB : T_QGF;
#pragma unroll
        for (int st = 0; st < 2; ++st) {
            if (dir == 0 ? (st > ct) : (st < ct)) continue;
            f32x16 X;
#pragma unroll
            for (int i = 0; i < 16; ++i) X[i] = 0.f;
#pragma unroll
            for (int ks = 0; ks < 8; ++ks) { const bf16x8 a = *(const LAS bf16x8*)(lds + TKR + (32 * st + r) * TS + (16 * ks + 8 * hh) * 2), bq = *(const LAS bf16x8*)(lds + TQR + (32 * ct + r) * TS + (16 * ks + 8 * hh) * 2);
                X = MFMA32(a, bq, X); }
            const int cc = 32 * ct + r;
#pragma unroll
            for (int i = 0; i < 16; ++i) { const int s = 32 * st + crow(i, hh); const bool keep = dir == 0 ? (s <= cc) : (s >= cc); X[i] = keep ? X[i] : 0.f; }
#pragma unroll
            for (int s2 = 0; s2 < 2; ++s2) { const bf16x8 xs = pack8(X, s2);
                const LAS unsigned char* vp = lds + T_V + (32 * st + 16 * s2 + 4 * hh + q) * TS + (32 * et + 16 * blk + 4 * p) * 2;
                const bf16x8 pb = cat8(tr16(vp), tr16(vp + 8 * TS));
                o = MFMA32(xs, pb, o); }
        }
        const bf16* sp = Sst + ((size_t)(item * 2 + dir) * 128 + 32 * et + r) * 128 + 8 * hh;
#pragma unroll
        for (int ks = 0; ks < 8; ++ks) { const bf16x8 a = *(const LAS bf16x8*)(lds + TQG + (32 * ct + r) * TS + (16 * ks + 8 * hh) * 2); const bf16x8 bq = *(const bf16x8*)(sp + 16 * ks);
            o = MFMA32(a, bq, o); }
    }
    unsigned hw[8];
#pragma unroll
    for (int k = 0; k < 8; ++k) hw[k] = *(const unsigned*)(proj + (size_t)(8 * w + k) * PC + C_HG + h * 128 + 2 * lane);
    __syncthreads();
    LAS float* O = (LAS float*)(lds + O_OFF);
#pragma unroll
    for (int i = 0; i < 16; ++i) O[(32 * ct + crow(i, hh)) * OS + 32 * et + r] = o[i];
    __syncthreads();
    const f32x2 gn = *(const f32x2*)(F.hg_norm_g + h * 128 + 2 * lane);
    bf16* yhg = (bf16*)(F.ws + WS_YHG);
    const int a16 = (lane ^ 16) << 2, a32 = (lane ^ 32) << 2;
#pragma unroll
    for (int k = 0; k < 8; ++k) { const int c = 8 * w + k; const f32x2 v = *(const LAS f32x2*)(O + c * OS + 2 * lane);
        float ss = row_sum16(v.x * v.x + v.y * v.y); ss += bperm_f(a16, ss); ss += bperm_f(a32, ss);
        const float rstd = __builtin_amdgcn_rsqf(ss * (1.0f / 128.0f) + EPS);
        const float z0 = bflo(hw[k]), z1 = bfhi(hw[k]);
        const float y0 = v.x * rstd * gn.x * (z0 * fast_sig(z0)), y1 = v.y * rstd * gn.y * (z1 * fast_sig(z1));
        *(unsigned*)(yhg + (row0 + c) * 512 + h * 128 + 2 * lane) = cvtpk(y0, y1); }
    __syncthreads();
}

DI void attn_item(Frame& F, int g, int item) {
    F.refresh();
    constexpr int KS = 272, VS = 528, K_OFF = 0, V_OFF = 69632;
    LAS unsigned char* lds = F.lds;
    const int qb = item & 7, h = (item >> 3) & 3, b = item >> 5, bglob = g * BG + b;
    const bf16* Km = (const bf16*)(F.ws + WS_KMEM) + (size_t)bglob * 256 * 512 + h * 128;
    const bf16* VT = (const bf16*)(F.ws + WS_VT) + (size_t)(h * 128) * 4096 + bglob * 256;
    const int tid = F.tid;
#pragma unroll
    for (int i = 0; i < 8; ++i) { const int id = tid + 512 * i, key = id >> 4, ch = id & 15;
        *(LAS u32x4*)(lds + K_OFF + key * KS + ch * 16) = *(const u32x4*)(Km + (size_t)key * 512 + ch * 8); }
#pragma unroll
    for (int i = 0; i < 8; ++i) { const int id = tid + 512 * i, e = id >> 5, ch = id & 31;
        *(LAS u32x4*)(lds + V_OFF + e * VS + ch * 16) = *(const u32x4*)(VT + (size_t)e * 4096 + ch * 8); }
    __syncthreads();
    const int w = F.wave, lane = F.lane, r = lane & 31, hh = lane >> 5;
    const size_t qrow0 = (size_t)b * SEQ + qb * 256 + w * 32;
    const bf16* proj = (const bf16*)(F.ws + WS_PROJ);
    bf16x8 qf[8];
#pragma unroll
    for (int ks = 0; ks < 8; ++ks) qf[ks] = *(const bf16x8*)(proj + (qrow0 + r) * PC + C_MQ + h * 128 + 16 * ks + 8 * hh);
    const float scale = 0.08838834764831845f;
    float m_run = -INFINITY, l_run = 0.f;
#pragma unroll 1
    for (int kt = 0; kt < 8; ++kt) {
        f32x16 X;
#pragma unroll
        for (int i = 0; i < 16; ++i) X[i] = 0.f;
#pragma unroll
        for (int ks = 0; ks < 8; ++ks) { const bf16x8 a = *(const LAS bf16x8*)(lds + K_OFF + (32 * kt + r) * KS + (16 * ks + 8 * hh) * 2); X = MFMA32(a, qf[ks], X); }
        float tm = X[0];
#pragma unroll
        for (int i = 1; i < 16; ++i) tm = fmaxf(tm, X[i]);
        tm *= scale;
        const float mn = fmaxf(m_run, tm); float ls = 0.f;
#pragma unroll
        for (int i = 0; i < 16; ++i) ls += __expf(X[i] * scale - mn);
        l_run = l_run * __expf(m_run - mn) + ls; m_run = mn;
    }
    { const float mo = __shfl_xor(m_run, 32), lo = __shfl_xor(l_run, 32); const float m = fmaxf(m_run, mo);
      l_run = l_run * __expf(m_run - m) + lo * __expf(mo - m); m_run = m; }
    const float inv_l = 1.0f / l_run;
    f32x16 O[4];
#pragma unroll
    for (int e = 0; e < 4; ++e)
#pragma unroll
        for (int i = 0; i < 16; ++i) O[e][i] = 0.f;
#pragma unroll 1
    for (int kt = 0; kt < 8; ++kt) {
        f32x16 X;
#pragma unroll
        for (int i = 0; i < 16; ++i) X[i] = 0.f;
#pragma unroll
        for (int ks = 0; ks < 8; ++ks) { const bf16x8 a = *(const LAS bf16x8*)(lds + K_OFF + (32 * kt + r) * KS + (16 * ks + 8 * hh) * 2); X = MFMA32(a, qf[ks], X); }
#pragma unroll
        for (int i = 0; i < 16; ++i) X[i] = __expf(X[i] * scale - m_run) * inv_l;
#pragma unroll
        for (int s2 = 0; s2 < 2; ++s2) { const bf16x8 xs = pack8(X, s2);
#pragma unroll
            for (int e = 0; e < 4; ++e) { const LAS unsigned char* vp = lds + V_OFF + (32 * e + r) * VS + (32 * kt + 16 * s2 + 4 * hh) * 2;
                const bf16x8 pb = cat8(*(const LAS s16x4*)vp, *(const LAS s16x4*)(vp + 16));
                O[e] = MFMA32(xs, pb, O[e]); } }
    }
    bf16* ymx = (bf16*)(F.ws + WS_YMX);
#pragma unroll
    for (int e = 0; e < 4; ++e)
#pragma unroll
        for (int i = 0; i < 16; ++i) ymx[(qrow0 + crow(i, hh)) * 512 + h * 128 + 32 * e + r] = (bf16)f2bf(O[e][i]);
    __syncthreads();
}

DI void conv_phase(Frame& F) {
    F.refresh();
    const bf16* proj = (const bf16*)(F.ws + WS_PROJ); bf16* ysc = (bf16*)(F.ws + WS_YSC); const float* cw = F.sc_conv_w;
    const int gt = F.vcu * 512 + F.tid, NGT = F.G * 512;
    for (int id = gt; id < TG * 64; id += NGT) {
        const int c8 = id & 63, t = id >> 6, ts = t & (SEQ - 1);
        const bf16* pr = proj + (size_t)t * PC + c8 * 8;
        const u32x4 z4 = (u32x4){0u, 0u, 0u, 0u};
        const u32x4 sb = *(const u32x4*)(pr + C_SB), c1 = *(const u32x4*)(pr + C_SC), h1 = *(const u32x4*)(pr + C_SH);
        const u32x4 c0 = ts > 0 ? *(const u32x4*)(pr - PC + C_SC) : z4, h0 = ts > 0 ? *(const u32x4*)(pr - PC + C_SH) : z4;
        const u32x4 c2 = ts < SEQ - 1 ? *(const u32x4*)(pr + PC + C_SC) : z4, h2 = ts < SEQ - 1 ? *(const u32x4*)(pr + PC + C_SH) : z4;
        const f32x4 wa0 = *(const f32x4*)(cw + c8 * 8), wa1 = *(const f32x4*)(cw + c8 * 8 + 4), wb0 = *(const f32x4*)(cw + 512 + c8 * 8), wb1 = *(const f32x4*)(cw + 512 + c8 * 8 + 4),
                    wc0 = *(const f32x4*)(cw + 1024 + c8 * 8), wc1 = *(const f32x4*)(cw + 1024 + c8 * 8 + 4);
        float y[8];
#pragma unroll
        for (int k = 0; k < 4; ++k) {
            const float w0l = k < 2 ? wa0[2 * k] : wa1[2 * k - 4], w0h = k < 2 ? wa0[2 * k + 1] : wa1[2 * k - 3];
            const float w1l = k < 2 ? wb0[2 * k] : wb1[2 * k - 4], w1h = k < 2 ? wb0[2 * k + 1] : wb1[2 * k - 3];
            const float w2l = k < 2 ? wc0[2 * k] : wc1[2 * k - 4], w2h = k < 2 ? wc0[2 * k + 1] : wc1[2 * k - 3];
            y[2 * k]     = bflo(sb[k]) * (w0l * (bflo(c0[k]) * bflo(h0[k])) + w1l * (bflo(c1[k]) * bflo(h1[k])) + w2l * (bflo(c2[k]) * bflo(h2[k])));
            y[2 * k + 1] = bfhi(sb[k]) * (w0h * (bfhi(c0[k]) * bfhi(h0[k])) + w1h * (bfhi(c1[k]) * bfhi(h1[k])) + w2h * (bfhi(c2[k]) * bfhi(h2[k]))); }
        u32x4 o; o.x = cvtpk(y[0], y[1]); o.y = cvtpk(y[2], y[3]); o.z = cvtpk(y[4], y[5]); o.w = cvtpk(y[6], y[7]);
        *(u32x4*)(ysc + (size_t)t * 512 + c8 * 8) = o;
    }
}

DI unsigned ord_key(float v, int idx) { unsigned u = __builtin_bit_cast(unsigned, v); u ^= (u >> 31) ? 0xFFFFFFFFu : 0x80000000u; return (u & 0xFFFFFF80u) | (unsigned)(127 - idx); }
DI float key_val(unsigned k) { unsigned u = k & 0xFFFFFF80u; u = (u & 0x80000000u) ? (u ^ 0x80000000u) : ~u; return __builtin_bit_cast(float, u); }
DI float dot2bf(unsigned a, unsigned b, float c) { return __builtin_amdgcn_fdot2_f32_bf16(__builtin_bit_cast(bf16x2_t, a), __builtin_bit_cast(bf16x2_t, b), c, false); }
DI float dot8(const u32x4& a, const u32x4& b, float c) { c = dot2bf(a.x, b.x, c); c = dot2bf(a.y, b.y, c); c = dot2bf(a.z, b.z, c); return dot2bf(a.w, b.w, c); }
__host__ __device__ constexpr int cand_off(int i) { return i == 0 ? 0 : i == 1 ? 16 : i == 2 ? 24 : i == 3 ? 29 : i == 4 ? 33 : i == 5 ? 36 : i == 6 ? 38 : i == 7 ? 40 : 34 + i; }
__host__ __device__ constexpr int cand_i(int c) { return c < 16 ? 0 : c < 24 ? 1 : c < 29 ? 2 : c < 33 ? 3 : c < 36 ? 4 : c < 38 ? 5 : c < 40 ? 6 : c < 42 ? 7 : c - 34; }
__host__ __device__ constexpr int cand_pos(int c) { return cand_i(c) * 16 + (c - cand_off(cand_i(c))); }

#define PEER_CE(i, j) do { const unsigned hi_ = max(k[i], k[j]), lo_ = min(k[i], k[j]); k[i] = hi_; k[j] = lo_; } while (0)
DI void peer_topk(const float* srow, LAS int* widx, LAS float* wgate, int lane) {
    const int gq = lane >> 4, li = lane & 15;
    const int ci = cand_i(lane), cj = lane - cand_off(ci); const bool cvalid = lane < 50;
    const int a16 = (lane ^ 16) << 2, a32 = (lane ^ 32) << 2;
    const float* sl = srow + (gq >> 1) * 256 + (gq & 1) * 128 + li * 8;
    f32x4 nva = *(const f32x4*)sl, nvb = *(const f32x4*)(sl + 4);
#pragma unroll 1
    for (int hp = 0; hp < 4; ++hp) {
        const f32x4 va = nva, vb = nvb;
        if (hp < 3) { nva = *(const f32x4*)(sl + 512 * (hp + 1)); nvb = *(const f32x4*)(sl + 512 * (hp + 1) + 4); }
        unsigned k[8];
        k[0] = ord_key(va.x, li * 8 + 0); k[1] = ord_key(va.y, li * 8 + 1); k[2] = ord_key(va.z, li * 8 + 2); k[3] = ord_key(va.w, li * 8 + 3);
        k[4] = ord_key(vb.x, li * 8 + 4); k[5] = ord_key(vb.y, li * 8 + 5); k[6] = ord_key(vb.z, li * 8 + 6); k[7] = ord_key(vb.w, li * 8 + 7);
        PEER_CE(0, 1); PEER_CE(2, 3); PEER_CE(4, 5); PEER_CE(6, 7); PEER_CE(0, 2); PEER_CE(1, 3); PEER_CE(4, 6); PEER_CE(5, 7); PEER_CE(1, 2); PEER_CE(5, 6);
        PEER_CE(0, 4); PEER_CE(1, 5); PEER_CE(2, 6); PEER_CE(3, 7); PEER_CE(2, 4); PEER_CE(3, 5); PEER_CE(1, 2); PEER_CE(3, 4); PEER_CE(5, 6);
        unsigned mine = 0u;
#pragma unroll
        for (int rd = 0; rd < 16; ++rd) {
            const unsigned m = row_max16(k[0]);
            mine = (li == rd) ? m : mine;
            const bool wn = (k[0] == m);
            k[0] = wn ? k[1] : k[0]; k[1] = wn ? k[2] : k[1]; k[2] = wn ? k[3] : k[2]; k[3] = wn ? k[4] : k[3];
            k[4] = wn ? k[5] : k[4]; k[5] = wn ? k[6] : k[5]; k[6] = wn ? k[7] : k[6]; k[7] = wn ? 0u : k[7];
        }
        const float sc = key_val(mine); const int ix = 127 - (int)(mine & 127u);
#pragma unroll
        for (int hsel = 0; hsel < 2; ++hsel) {
            const int adA = (32 * hsel + ci) << 2, adB = (32 * hsel + 16 + cj) << 2;
            const float a = bperm_f(adA, sc), bq = bperm_f(adB, sc);
            const int ia = __builtin_amdgcn_ds_bpermute(adA, ix), ib = __builtin_amdgcn_ds_bpermute(adB, ix);
            const float cs = a + bq;
            unsigned ck = __builtin_bit_cast(unsigned, cs); ck ^= (ck >> 31) ? 0xFFFFFFFFu : 0x80000000u; ck = cvalid ? ((ck & ~63u) | (unsigned)(63 - lane)) : 0u;
            int rank = 0;
#pragma unroll
            for (int c2 = 0; c2 < 50; ++c2) { const unsigned k2 = (unsigned)__builtin_amdgcn_readlane((int)ck, c2); rank += (int)(k2 > ck); }
            const bool sel = cvalid && rank < 16;
            const float mx = __builtin_bit_cast(float, __builtin_amdgcn_readlane(__builtin_bit_cast(int, cs), 0));
            const float ev = sel ? __builtin_amdgcn_exp2f((cs - mx) * 1.4426950408889634f) : 0.f;
            float sum = row_sum16(ev); sum += bperm_f(a16, sum); sum += bperm_f(a32, sum);
            if (sel) { const int hd = 2 * hp + hsel; widx[hd * 16 + rank] = (ia * 128 + ib) * 512  ; wgate[hd * 16 + rank] = ev * __builtin_amdgcn_rcpf(sum); }
        }
    }
}
#undef PEER_CE

constexpr float PEER_QSTEP = 0.35f;
constexpr float PEER_U_SCALE = 32.0f / PEER_QSTEP;
constexpr float PEER_H_SCALE = 1.0f / PEER_QSTEP;
constexpr float PEER_V_SCALE = 32.0f;
#ifndef PEER_VARIANT
#define PEER_VARIANT 0
#endif
#ifndef PEER_R
#define PEER_R 16
#endif
#if PEER_R == 32
#define PEER_RM4 28
#elif PEER_R == 16
#define PEER_RM4 12
#elif PEER_R == 64
#define PEER_RM4 60
#endif
constexpr int PEER_NPROD = 2, PEER_NCONS = 8 - PEER_NPROD, PEER_CPP = PEER_NCONS / PEER_NPROD;
constexpr int PEER_FLAG_OFF = 12288, PEER_CCF_OFF = 12800, PEER_RING_OFF = 16384;
static_assert(PEER_RING_OFF + PEER_NCONS * PEER_R * 1024 <= MISC_OFF && PEER_R <= 64 && (PEER_R & (PEER_R - 1)) == 0 && PEER_NCONS % PEER_NPROD == 0 && PEER_NCONS * 2048 <= PEER_FLAG_OFF, "PEER LDS map");
DI void glds16(const void* gsrc, unsigned lds_dst) { unsigned keep;
    asm volatile("s_mov_b32 %0, m0\n\ts_mov_b32 m0, %2\n\ts_nop 0\n\tglobal_load_lds_dwordx4 %1, off\n\ts_mov_b32 m0, %0" : "=&s"(keep) : "v"(gsrc), "s"(lds_dst) : "memory"); }
DI void glds16s(const void* sbase, unsigned voff, unsigned lds_dst) { unsigned keep;
    asm volatile("s_mov_b32 %0, m0\n\ts_mov_b32 m0, %3\n\ts_nop 0\n\tglobal_load_lds_dwordx4 %1, %2\n\ts_mov_b32 m0, %0" : "=&s"(keep) : "v"(voff), "s"(sbase), "s"(lds_dst) : "memory"); }
#define PEER_STR2(x) #x
#define PEER_STR(x) PEER_STR2(x)
DI void peer_phase(Frame& F, int tg) {
    F.refresh();
    const int lane = F.lane, wv = F.wave;
    volatile LAS unsigned* flags = (volatile LAS unsigned*)(F.lds + PEER_FLAG_OFF);
    if (F.tid < 2 * PEER_NCONS) flags[F.tid] = 0u;
    __syncthreads();
    const int NPG = F.G * PEER_NPROD;
    if (wv < PEER_NPROD) {
        const int pg = F.vcu * PEER_NPROD + wv;
        int i = 0;
        for (int tl = pg; tl < TG; tl += NPG, ++i) {
            float tch0 = 0.f;
            if (tl + NPG < TG) tch0 = ((const float*)(F.ws + WS_S) + (size_t)(tl + NPG) * 2048)[lane * 32];
            const int cidx = wv * PEER_CPP + (i % PEER_CPP), slot = (i / PEER_CPP) & 1;
            LAS int* sidx = (LAS int*)(F.lds + cidx * 2048 + slot * 1024); LAS float* sgate = (LAS float*)(F.lds + cidx * 2048 + slot * 1024 + 512);
            while (flags[cidx * 2 + slot] != 0u) __builtin_amdgcn_s_sleep(2);
            asm volatile("" ::: "memory");
            peer_topk((const float*)(F.ws + WS_S) + (size_t)tl * 2048, sidx, sgate, lane);
            asm volatile("s_waitcnt lgkmcnt(0)" :: "v"(tch0) : "memory");
            if (lane == 0) flags[cidx * 2 + slot] = 1u;
        }
    } else {
        const unsigned char* Ub = F.ws + WS_U; const unsigned char* Vb = F.ws + WS_V; const unsigned lo16 = 16u * (unsigned)(lane & 31);
        const int a4 = (lane ^ 4) << 2, a8 = (lane ^ 8) << 2, a16 = (lane ^ 16) << 2, a32 = (lane ^ 32) << 2;
        const bool b0 = lane & 1, b1 = lane & 2, b2 = lane & 4, b3 = lane & 8; const int grp = lane >> 4;
        const int cidx = wv - PEER_NPROD, myprod = cidx / PEER_CPP, myr = cidx % PEER_CPP;
        LAS float* ccf = (LAS float*)(F.lds + PEER_CCF_OFF + cidx * 512);
        LAS unsigned char* ring = F.lds + PEER_RING_OFF + cidx * (PEER_R * 1024);
        const unsigned ringb = (unsigned)(uintptr_t)ring;
        const int pg = F.vcu * PEER_NPROD + myprod, TSTEP = NPG * PEER_CPP;
        int kslot = 0;
        for (int tl = pg + myr * NPG; tl < TG; tl += TSTEP, ++kslot) {
            const size_t t = (size_t)tg * TG + tl;
            float tch1 = 0.f, tch2 = 0.f, tch3 = 0.f;
            if (tl + TSTEP < TG) { const size_t tn = t + TSTEP; tch1 = (F.out + tn * 1024)[(lane & 31) * 32];
                tch2 = ((const float*)((const bf16*)(F.ws + WS_XG) + tn * 1024))[(lane & 15) * 32]; tch3 = ((const float*)(F.ws + WS_SSP) + tn * 16)[lane & 15]; }
            const f32x4* sp = (const f32x4*)((const float*)(F.ws + WS_SSP) + t * 16);
            const f32x4 s0 = sp[0], s1 = sp[1], s2 = sp[2], s3 = sp[3];
            const float ssx = ((s0[0] + s0[1]) + (s0[2] + s0[3])) + ((s1[0] + s1[1]) + (s1[2] + s1[3])) + ((s2[0] + s2[1]) + (s2[2] + s2[3])) + ((s3[0] + s3[1]) + (s3[2] + s3[3]));
            const float hs = __builtin_amdgcn_rsqf(ssx * (1.0f / 1024.0f) + EPS) * PEER_H_SCALE;
            int hq0, hq1;
            { const bf16* xr = (const bf16*)(F.ws + WS_XG) + t * 1024 + 16 * lane; const u32x4 w0 = *(const u32x4*)xr, w1 = *(const u32x4*)(xr + 8);
              unsigned a0 = 0u, a1 = 0u;
#pragma unroll
              for (int q = 0; q < 4; ++q) {
                  const int l0 = (int)__builtin_rintf(fminf(fmaxf(bflo(w0[q]) * hs, -7.f), 7.f)), h0 = (int)__builtin_rintf(fminf(fmaxf(bfhi(w0[q]) * hs, -7.f), 7.f));
                  const int l1 = (int)__builtin_rintf(fminf(fmaxf(bflo(w1[q]) * hs, -7.f), 7.f)), h1 = (int)__builtin_rintf(fminf(fmaxf(bfhi(w1[q]) * hs, -7.f), 7.f));
                  a0 |= ((unsigned)l0 & 15u) << (8 * q) | ((unsigned)h0 & 15u) << (8 * q + 4); a1 |= ((unsigned)l1 & 15u) << (8 * q) | ((unsigned)h1 & 15u) << (8 * q + 4); }
              hq0 = (int)a0; hq1 = (int)a1; }
            const float ascale = 1.0f / (PEER_H_SCALE * PEER_U_SCALE);
            asm volatile("s_waitcnt vmcnt(0)" :: "v"(tch1), "v"(tch2), "v"(tch3) : "memory");
            const int slot = kslot & 1;
            const LAS int* sidx = (const LAS int*)(F.lds + cidx * 2048 + slot * 1024); const LAS float* sgate = (const LAS float*)(F.lds + cidx * 2048 + slot * 1024 + 512);
            while (flags[cidx * 2 + slot] != 1u) __builtin_amdgcn_s_sleep(2);
            asm volatile("" ::: "memory");
            typedef int i32x4 __attribute__((ext_vector_type(4)));
#define PEER_ISSUE1(pp, tab, ea, eb) do { const unsigned voff_ = (unsigned)(lane < 32 ? __builtin_amdgcn_readfirstlane(ea) : __builtin_amdgcn_readfirstlane(eb)) + lo16; \
                glds16s((tab), voff_, (unsigned)__builtin_amdgcn_readfirstlane((int)(ringb + (unsigned)((pp) & (PEER_R - 1)) * 1024u))); } while (0)
#define PEER_ISSUE4(pp0) do { const int pp_ = (pp0); const int m_ = pp_ & 63; const unsigned char* tab_ = (pp_ < 64) ? Ub : Vb; const i32x4 ea_ = *(const LAS i32x4*)(sidx + 2 * m_), eb_ = *(const LAS i32x4*)(sidx + 2 * m_ + 4); \
                PEER_ISSUE1(pp_, tab_, ea_.x, ea_.y); PEER_ISSUE1(pp_ + 1, tab_, ea_.z, ea_.w); PEER_ISSUE1(pp_ + 2, tab_, eb_.x, eb_.y); PEER_ISSUE1(pp_ + 3, tab_, eb_.z, eb_.w); } while (0)
#define PEER_WAIT4() asm volatile("s_waitcnt vmcnt(" PEER_STR(PEER_RM4) ")" ::: "memory")
#define PEER_HSLOT(pp, half) (*(const LAS u32x2*)(ring + ((pp) & (PEER_R - 1)) * 1024 + (half) * 512 + 8 * lane))
#define PEER_CVT4(w, q, b) __builtin_amdgcn_cvt_scalef32_pk_f32_fp4(w[q], 1.0f, b)
#define PEER_DOT(dst, w) do { dst = (float)__builtin_amdgcn_sdot8(hq1, (int)w[1], __builtin_amdgcn_sdot8(hq0, (int)w[0], 0, false), false); } while (0)
#pragma unroll 2
            for (int pp = 0; pp < PEER_R; pp += 4) PEER_ISSUE4(pp);
            float dotA = 0.f, dotB = 0.f;
#pragma unroll 1
            for (int batch = 0; batch < 8; ++batch) {
                float p[16];
#pragma unroll
                for (int g = 0; g < 2; ++g) { const int pp0 = 8 * batch + 4 * g;
                    PEER_WAIT4();
                    const u32x2 w0 = PEER_HSLOT(pp0, 0), w1 = PEER_HSLOT(pp0, 1), w2 = PEER_HSLOT(pp0 + 1, 0), w3 = PEER_HSLOT(pp0 + 1, 1), w4 = PEER_HSLOT(pp0 + 2, 0), w5 = PEER_HSLOT(pp0 + 2, 1), w6 = PEER_HSLOT(pp0 + 3, 0), w7 = PEER_HSLOT(pp0 + 3, 1);
                    PEER_DOT(p[8 * g + 0], w0); PEER_DOT(p[8 * g + 1], w1); PEER_DOT(p[8 * g + 2], w2); PEER_DOT(p[8 * g + 3], w3);
                    PEER_DOT(p[8 * g + 4], w4); PEER_DOT(p[8 * g + 5], w5); PEER_DOT(p[8 * g + 6], w6); PEER_DOT(p[8 * g + 7], w7);
                    __builtin_amdgcn_sched_barrier(0); PEER_ISSUE4(pp0 + PEER_R); __builtin_amdgcn_sched_barrier(0); }
                float q8[8], q4[4], q2[2];
#pragma unroll
                for (int m = 0; m < 8; ++m) { const float keep = b0 ? p[2 * m + 1] : p[2 * m], send = b0 ? p[2 * m] : p[2 * m + 1]; q8[m] = keep + dpp_f<0xB1>(send); }
#pragma unroll
                for (int m = 0; m < 4; ++m) { const float keep = b1 ? q8[2 * m + 1] : q8[2 * m], send = b1 ? q8[2 * m] : q8[2 * m + 1]; q4[m] = keep + dpp_f<0x4E>(send); }
#pragma unroll
                for (int m = 0; m < 2; ++m) { const float keep = b2 ? q4[2 * m + 1] : q4[2 * m], send = b2 ? q4[2 * m] : q4[2 * m + 1]; q2[m] = keep + bperm_f(a4, send); }
                const float keep = b3 ? q2[1] : q2[0], send = b3 ? q2[0] : q2[1];
                float tot = keep + bperm_f(a8, send); tot += bperm_f(a16, tot); tot += bperm_f(a32, tot);
                dotA = (batch == grp) ? tot : dotA; dotB = (batch == grp + 4) ? tot : dotB;
            }
            { const float av = dotA * ascale; ccf[lane] = sgate[lane] * (0.5f * av * (1.0f + erff(av * 0.70710678118654752f))) * (1.0f / PEER_V_SCALE); }
            { const float av = dotB * ascale; ccf[64 + lane] = sgate[64 + lane] * (0.5f * av * (1.0f + erff(av * 0.70710678118654752f))) * (1.0f / PEER_V_SCALE); }
            f32x2 o2[8];
#pragma unroll
            for (int m = 0; m < 8; ++m) o2[m] = (f32x2){0.f, 0.f};
            asm volatile("s_waitcnt lgkmcnt(0)" ::: "memory");
#define PEER_AXPYV(w, c) do { const float cv_ = __builtin_bit_cast(float, __builtin_amdgcn_readfirstlane((c))); const f32x2 cc_ = (f32x2){cv_, cv_}; \
                _Pragma("unroll") for (int q = 0; q < 2; ++q) { \
                o2[4 * q + 0] = PEER_CVT4(w, q, 0) * cc_ + o2[4 * q + 0]; o2[4 * q + 1] = PEER_CVT4(w, q, 1) * cc_ + o2[4 * q + 1]; \
                o2[4 * q + 2] = PEER_CVT4(w, q, 2) * cc_ + o2[4 * q + 2]; o2[4 * q + 3] = PEER_CVT4(w, q, 3) * cc_ + o2[4 * q + 3]; } } while (0)
#define PEER_AXPYV8(mg) do { const int pp_ = 64 + 4 * (mg); const i32x4 ca_ = *(const LAS i32x4*)(ccf + 8 * (mg)), cb_ = *(const LAS i32x4*)(ccf + 8 * (mg) + 4); \
                const u32x2 w0 = PEER_HSLOT(pp_, 0), w1 = PEER_HSLOT(pp_, 1), w2 = PEER_HSLOT(pp_ + 1, 0), w3 = PEER_HSLOT(pp_ + 1, 1), w4 = PEER_HSLOT(pp_ + 2, 0), w5 = PEER_HSLOT(pp_ + 2, 1), w6 = PEER_HSLOT(pp_ + 3, 0), w7 = PEER_HSLOT(pp_ + 3, 1); \
                PEER_AXPYV(w0, ca_.x); PEER_AXPYV(w1, ca_.y); PEER_AXPYV(w2, ca_.z); PEER_AXPYV(w3, ca_.w); PEER_AXPYV(w4, cb_.x); PEER_AXPYV(w5, cb_.y); PEER_AXPYV(w6, cb_.z); PEER_AXPYV(w7, cb_.w); } while (0)
#pragma unroll 2
            for (int mg = 0; mg < (64 - PEER_R) / 4; ++mg) { PEER_WAIT4(); PEER_AXPYV8(mg); __builtin_amdgcn_sched_barrier(0); PEER_ISSUE4(64 + 4 * mg + PEER_R); __builtin_amdgcn_sched_barrier(0); }
            asm volatile("s_waitcnt vmcnt(0)" ::: "memory");
#pragma unroll 2
            for (int mg = (64 - PEER_R) / 4; mg < 16; ++mg) PEER_AXPYV8(mg);
#undef PEER_AXPYV8
#undef PEER_AXPYV
#undef PEER_DOT
#undef PEER_CVT4
#undef PEER_HSLOT
#undef PEER_WAIT4
#undef PEER_ISSUE4
#undef PEER_ISSUE1
            asm volatile("s_waitcnt lgkmcnt(0)" ::: "memory");
            if (lane == 0) flags[cidx * 2 + slot] = 0u;
            float* xo = F.out + t * 1024 + 16 * lane; const float* gfp = F.final_norm_g + 16 * lane;
            f32x4 a[4]; float ss = 0.f;
#pragma unroll
            for (int k = 0; k < 4; ++k) { a[k] = *(const f32x4*)(xo + 4 * k) + (f32x4){o2[2 * k].x, o2[2 * k].y, o2[2 * k + 1].x, o2[2 * k + 1].y};
                ss += (a[k].x * a[k].x + a[k].y * a[k].y) + (a[k].z * a[k].z + a[k].w * a[k].w); }
            ss = row_sum16(ss); ss += bperm_f(a16, ss); ss += bperm_f(a32, ss);
            const float rf = __builtin_amdgcn_rsqf(ss * (1.0f / 1024.0f) + EPS);
#pragma unroll
            for (int k = 0; k < 4; ++k) *(f32x4*)(xo + 4 * k) = a[k] * rf * *(const f32x4*)(gfp + 4 * k);
        }
    }
}

DI void convert_uv(Frame& F, int part, int nparts, int cu, int ncu) {
    F.refresh();
    const int gt = cu * 512 + F.tid, NGT = ncu * 512, per = (2 * 16384 * 64) / nparts;
    for (int id = part * per + gt; id < (part + 1) * per; id += NGT) {
        const int which = id >> 20, off = (id & ((1 << 20) - 1)) * 16;
        if (which == 0) {
            const float* src = F.peer_u + off; unsigned char* dst = F.ws + WS_U + off / 2;
            u32x2 o;
#pragma unroll
            for (int q = 0; q < 2; ++q) { const f32x4 v0 = *(const f32x4*)(src + 8 * q) * PEER_U_SCALE, v1 = *(const f32x4*)(src + 8 * q + 4) * PEER_U_SCALE; unsigned pk = 0u;
#pragma unroll
                for (int k = 0; k < 4; ++k) { pk |= ((unsigned)(int)__builtin_rintf(fminf(fmaxf(v0[k], -7.f), 7.f)) & 15u) << (4 * k); pk |= ((unsigned)(int)__builtin_rintf(fminf(fmaxf(v1[k], -7.f), 7.f)) & 15u) << (16 + 4 * k); }
                o[q] = pk; }
            *(u32x2*)dst = o;
        } else {
            const float* src = (which ? F.peer_v : F.peer_u) + off; unsigned char* dst = F.ws + (which ? WS_V : WS_U) + off / 2;
            u32x2 o;
#pragma unroll
            for (int q = 0; q < 2; ++q) { const f32x4 v0 = *(const f32x4*)(src + 8 * q) * PEER_V_SCALE, v1 = *(const f32x4*)(src + 8 * q + 4) * PEER_V_SCALE;
                unsigned pk = __builtin_amdgcn_cvt_scalef32_pk_fp4_f32(0u, v0.x, v0.y, 1.0f, 0); pk = __builtin_amdgcn_cvt_scalef32_pk_fp4_f32(pk, v0.z, v0.w, 1.0f, 1);
                pk = __builtin_amdgcn_cvt_scalef32_pk_fp4_f32(pk, v1.x, v1.y, 1.0f, 2); pk = __builtin_amdgcn_cvt_scalef32_pk_fp4_f32(pk, v1.z, v1.w, 1.0f, 3); o[q] = pk; }
            *(u32x2*)dst = o;
        }
    }
}

constexpr int N_PHASES = 19;
struct Args { const float* in[17]; float* out; unsigned char* ws; int ph_lo, ph_hi; };

__global__ void __launch_bounds__(NWAVES * 64, 2) fwd_kernel(Args args) {
    extern __shared__ __attribute__((aligned(16))) unsigned char lds_raw[];
    Frame F;
    F.lds = (LAS unsigned char*)lds_raw;
    F.tid = threadIdx.x; F.lane = F.tid & 63; F.wave = __builtin_amdgcn_readfirstlane(F.tid >> 6);
    F.G = gridDim.x; { const int bx = blockIdx.x; F.vcu = (F.G % 8 == 0) ? (bx % 8) * (F.G / 8) + bx / 8 : bx; }
    F.x = args.in[0]; F.mem = args.in[1]; F.norm_mix_g = args.in[2]; F.w_in = args.in[3]; F.hg_lb = args.in[4]; F.hg_norm_g = args.in[5]; F.sc_conv_w = args.in[6];
    F.mem_norm_g = args.in[7]; F.w_mem_kv = args.in[8]; F.w_branch = args.in[9]; F.w_out = args.in[10]; F.norm_ffn_g = args.in[11]; F.peer_w_q = args.in[12];
    F.peer_sub_keys = args.in[13]; F.peer_u = args.in[14]; F.peer_v = args.in[15]; F.final_norm_g = args.in[16];
    F.out = args.out; F.ws = args.ws;
    volatile LAS unsigned* MISC = (volatile LAS unsigned*)(F.lds + MISC_OFF);
    for (int u = F.tid; u < (LDS_BYTES - MISC_OFF) / 4; u += NWAVES * 64) MISC[u] = 0u;
    __syncthreads();
    unsigned* barw = (unsigned*)(F.ws + WS_CTL) + CW_BAR;
    XcdBarrier bar; bar.bar = barw; bar.x = 0; bar.st = nullptr;
    const bool one_launch = (args.ph_hi - args.ph_lo) > 1;
    if (one_launch) bar = xcd_barrier_post(barw, MISC + 8);
    const int lo = args.ph_lo, hi = args.ph_hi;
#define IN(k) (lo <= (k) && (k) < hi)
#ifndef PMASK
#define PMASK 0x3ff
#endif
#define PC_(c) ((PMASK >> (c)) & 1)
#ifndef REP_MASK
#define REP_MASK 0
#endif
#define REPS(c) for (int rep_ = 0; rep_ < 1 + 2 * ((REP_MASK >> (c)) & 1); ++rep_)
#define SEAM(k) do { if (IN(k) && IN((k) + 1)) xcd_barrier(bar); } while (0)
    unsigned char* ws = F.ws;
    const int G = F.G, cid = (int)blockIdx.x;

    if (PC_(0) && IN(0)) { REPS(0) p0_prologue(F); } SEAM(0);

#pragma unroll 1
    for (int g = 0; g < NGRP; ++g) {
        const int pb = 1 + 6 * g;
        if (PC_(1) && IN(pb)) REPS(1) {
            pg8::InOrder S; S.init(TG, PC, G, cid); S.H = (const char*)(ws + WS_XG) + (size_t)g * TG * 1024 * 2; S.Win = (const char*)(ws + WS_WIN); S.Mn = (const char*)(ws + WS_MN); S.Wkv = (const char*)(ws + WS_WKV); S.n_extra = (g == 0) ? 64 : 0;
            pg8::EpiIn E{(bf16*)(ws + WS_PROJ), (bf16*)(ws + WS_KMEM), (bf16*)(ws + WS_VT)};
            pg8::gemm_phase<pg8::EpiIn, pg8::InOrder, true, true>(F.lds, pg8::Gemm{1024, 1024, 1024}, S, E);
            if (cid >= 128) convert_uv(F, g, NGRP, cid - 128, G - 128);
        } SEAM(pb);
        if (PC_(2) && IN(pb + 1)) REPS(2) {
            for (int it = F.vcu * 4; it < BG * 4 * NCHUNK; it += G * 4) { for (int k = 0; k < 4; ++k) hgrn_a_item(F, it + k, k < 3); }
            for (int it = F.vcu; it < BG * 4 * 8; it += G) attn_item(F, g, it);
            conv_phase(F);
        } SEAM(pb + 1);
        if (PC_(3) && IN(pb + 2)) { REPS(3) hgrn_scan(F); } SEAM(pb + 2);
        if (PC_(4) && IN(pb + 3)) REPS(4) { for (int it = F.vcu * 4; it < BG * 4 * NCHUNK; it += G * 4) { for (int k = 0; k < 4; ++k) hgrn_c_item(F, it + k, k < 3); } } SEAM(pb + 3);
        if (PC_(5) && IN(pb + 4)) REPS(5) {
            pg8::BranchOrder S; S.init(TG, 1024, G, cid); S.Y = (const char*)(ws + WS_YHG); S.Wb = (const char*)(ws + WS_WBR);
            pg8::EpiBranch E{(const bf16*)(ws + WS_PROJ), (bf16*)(ws + WS_MACC), (bf16*)(ws + WS_MERGED)};
            pg8::gemm_phase<pg8::EpiBranch, pg8::BranchOrder, true, true>(F.lds, pg8::Gemm{512, 512, 512}, S, E);
        } SEAM(pb + 4);
        if (PC_(6) && IN(pb + 5)) REPS(6) {
            pg8::PlainOrder S; S.init(TG, 1024, G, cid); S.A = (const char*)(ws + WS_MERGED); S.Bt = (const char*)(ws + WS_WOUT); S.a_tile = 256 * 1024 * 2; S.b_tile = 256 * 1024 * 2;
            pg8::EpiOut E{F.x + (size_t)g * TG * 1024, F.out + (size_t)g * TG * 1024, (bf16*)(ws + WS_XG) + (size_t)g * TG * 1024, F.norm_ffn_g, (float*)(ws + WS_SSP) + (size_t)g * TG * 16};
            pg8::gemm_phase<pg8::EpiOut, pg8::PlainOrder, true, true>(F.lds, pg8::Gemm{1024, 1024, 1024}, S, E);
        } SEAM(pb + 5);
    }
#pragma unroll 1
    for (int tg = 0; tg < NGRP; ++tg) {
        const int pb = 13 + 3 * tg;
        if (PC_(7) && IN(pb)) REPS(7) {
            pg8::PlainOrder S; S.init(TG, 2048, G, cid); S.A = (const char*)(ws + WS_XG) + (size_t)tg * TG * 1024 * 2; S.Bt = (const char*)(ws + WS_WQ); S.a_tile = 256 * 1024 * 2; S.b_tile = 256 * 1024 * 2;
            pg8::EpiQ E{(bf16*)(ws + WS_Q), 2048, (const float*)(ws + WS_SSP) + (size_t)tg * TG * 16};
            pg8::gemm_phase<pg8::EpiQ, pg8::PlainOrder, true, true>(F.lds, pg8::Gemm{1024, 1024, 1024}, S, E);
        } SEAM(pb);
        if (PC_(8) && IN(pb + 1)) REPS(8) {
            pg8::ScoreOrder S; S.init(TG, 2048, G, cid); S.Q = (const char*)(ws + WS_Q); S.Kbd = (const char*)(ws + WS_KBD);
            pg8::EpiF32 E{(float*)(ws + WS_S), 2048};
            pg8::gemm_phase<pg8::EpiF32, pg8::ScoreOrder, true, true>(F.lds, pg8::Gemm{2048, 256, 256}, S, E);
        } SEAM(pb + 1);
        if (PC_(9) && IN(pb + 2)) { peer_phase(F, tg); } SEAM(pb + 2);
    }
#undef IN
#undef SEAM
}

extern "C" void kernel_launch(void* const* d_in, const int* in_sizes, int n_in, void* d_out, int out_size, void* d_ws, size_t ws_size, hipStream_t stream) {
    static int ready = 0;
    if (ready == 0) {
        if (n_in != 17 || out_size != T_ALL * D_MODEL || ws_size < WS_END) { fprintf(stderr, "kernel_launch: unexpected shapes (n_in %d, out %d, ws %zu)\n", n_in, out_size, ws_size); ready = -1; return; }
        if (hipFuncSetAttribute((const void*)fwd_kernel, hipFuncAttributeMaxDynamicSharedMemorySize, LDS_BYTES) != hipSuccess) { fprintf(stderr, "kernel_launch: hipFuncSetAttribute failed\n"); ready = -1; return; }
        ready = 1;
    }
    if (ready < 0) return;
    (void)hipMemsetAsync((char*)d_ws + WS_CTL, 0, CTL_ZERO_BYTES, stream);
    Args a{};
    for (int i = 0; i < 17; ++i) a.in[i] = (const float*)d_in[i];
    a.out = (float*)d_out; a.ws = (unsigned char*)d_ws;
    const int grid = 256;
#if MK_N_LAUNCHES == 1
    a.ph_lo = 0; a.ph_hi = N_PHASES;
    hipLaunchKernelGGL(fwd_kernel, dim3(grid), dim3(NWAVES * 64), LDS_BYTES, stream, a);
#else
    for (int li = 0; li < N_PHASES; ++li) { a.ph_lo = li; a.ph_hi = li + 1; hipLaunchKernelGGL(fwd_kernel, dim3(grid), dim3(NWAVES * 64), LDS_BYTES, stream, a); }
#endif
}
```

```cpp
#include <hip/hip_runtime.h>
#include <cstdio>
#include <cstdint>

#ifndef MK_N_LAUNCHES
#define MK_N_LAUNCHES 1
#endif

#define LAS __attribute__((address_space(3)))
#define GAS __attribute__((address_space(1)))
typedef unsigned short bf16;
typedef short bf16x8 __attribute__((ext_vector_type(8)));
typedef short s16x4 __attribute__((ext_vector_type(4)));
typedef short v4i16_t __attribute__((ext_vector_type(4)));
typedef float f32x2 __attribute__((ext_vector_type(2)));
typedef float f32x4 __attribute__((ext_vector_type(4)));
typedef float f32x16 __attribute__((ext_vector_type(16)));
typedef unsigned u32x2 __attribute__((ext_vector_type(2)));
typedef unsigned u32x4 __attribute__((ext_vector_type(4)));
typedef __bf16 bf16x2_t __attribute__((ext_vector_type(2)));
typedef GAS unsigned gu32;
#define RLX_AGENT __ATOMIC_RELAXED, __HIP_MEMORY_SCOPE_AGENT
#define DI __device__ __forceinline__

constexpr int D_MODEL = 1024, BATCH = 16, SEQ = 2048, T_ALL = BATCH * SEQ;
constexpr int NGRP = 2, BG = BATCH / NGRP, TG = BG * SEQ;
constexpr int PC = 7680;
constexpr int C_HQ = 0, C_HI = 512, C_FF = 1024, C_FB = 1536, C_HG = 2048, C_SB = 2560, C_SC = 3072, C_SH = 3584, C_MQ = 4096, C_GATE = 4608;
constexpr int NMEM = 256, CHUNK = 64, NCHUNK = SEQ / CHUNK;
constexpr float EPS = 1e-6f;

constexpr size_t MiB = 1u << 20;
constexpr size_t WS_CTL = 0, CTL_ZERO_BYTES = 1 * MiB;
constexpr size_t WS_LB = 1 * MiB;
constexpr size_t WS_SSP = 2 * MiB;
constexpr size_t WS_DEC = 4 * MiB;
constexpr size_t WS_WIN = 5 * MiB, WS_WKV = 20 * MiB, WS_WBR = 22 * MiB, WS_WOUT = 25 * MiB, WS_WQ = 27 * MiB, WS_KBD = 31 * MiB;
constexpr size_t WS_MN = 32 * MiB, WS_KMEM = 40 * MiB, WS_VT = 44 * MiB;
constexpr size_t WS_XG = 48 * MiB;
constexpr size_t WS_YHG = 112 * MiB, WS_YSC = 128 * MiB, WS_YMX = 144 * MiB;
constexpr size_t WS_DS = 160 * MiB;
constexpr size_t WS_MACC = 160 * MiB;
constexpr size_t WS_MERGED = 224 * MiB;
constexpr size_t WS_PROJ = 256 * MiB;
constexpr size_t WS_U = 496 * MiB, WS_V = 504 * MiB;
constexpr size_t WS_Q = 176 * MiB;
constexpr size_t WS_S = 256 * MiB;
constexpr size_t WS_END = 512 * MiB;
constexpr size_t OUT_SST = 64 * MiB;

constexpr int LDS_BYTES = 160 * 1024;
constexpr int MISC_OFF = LDS_BYTES - 512;
constexpr int NWAVES = 8;

DI unsigned f2bf(float f) { unsigned u = __builtin_bit_cast(unsigned, f); return (u + 0x7fffu + ((u >> 16) & 1u)) >> 16; }
DI unsigned pk2(float lo, float hi) { return f2bf(lo) | (f2bf(hi) << 16); }
DI float bf2f(unsigned short b) { return __builtin_bit_cast(float, (unsigned)b << 16); }
DI float bflo(unsigned w) { return __builtin_bit_cast(float, w << 16); }
DI float bfhi(unsigned w) { return __builtin_bit_cast(float, w & 0xffff0000u); }
DI float wave_sum(float v) {
#pragma unroll
    for (int o = 1; o < 64; o <<= 1) v += __shfl_xor(v, o);
    return v;
}
DI unsigned cvtpk(float lo, float hi) { f32x2 v = {lo, hi}; bf16x2_t b = __builtin_convertvector(v, bf16x2_t); return __builtin_bit_cast(unsigned, b); }
template <int CTRL> DI unsigned dpp_u(unsigned v) { return (unsigned)__builtin_amdgcn_update_dpp(0, (int)v, CTRL, 0xF, 0xF, false); }
template <int CTRL> DI float dpp_f(float v) { return __builtin_bit_cast(float, __builtin_amdgcn_update_dpp(0, __builtin_bit_cast(int, v), CTRL, 0xF, 0xF, false)); }
DI float bperm_f(int addr, float v) { return __builtin_bit_cast(float, __builtin_amdgcn_ds_bpermute(addr, __builtin_bit_cast(int, v))); }
DI unsigned row_max16(unsigned m) { m = max(m, dpp_u<0xB1>(m)); m = max(m, dpp_u<0x4E>(m)); m = max(m, dpp_u<0x141>(m)); return max(m, dpp_u<0x140>(m)); }
DI float row_sum16(float v) { v += dpp_f<0xB1>(v); v += dpp_f<0x4E>(v); v += dpp_f<0x141>(v); return v + dpp_f<0x140>(v); }

DI float fast_sig(float z) { return __builtin_amdgcn_rcpf(1.0f + __builtin_amdgcn_exp2f(-1.4426950408889634f * z)); }
DI float sigmoidf_(float z) { return 1.0f / (1.0f + __expf(-z)); }

namespace pg8 {
constexpr int BM = 256, BK = 64, HALF = 128, HTB = HALF * BK * 2, STAGE_BYTES = 8 * HTB, NXCD = 8, WGM = 8;
__host__ __device__ __forceinline__ int lds_byte(int r, int c) { const int st = (r >> 4) * 2 + (c >> 5), rr = r & 15, cc = c & 31, ob = rr * 64 + cc * 2; return st * 1024 + (ob ^ (((ob >> 9) & 1) << 5)); }
__host__ __device__ __forceinline__ void stage_rc(int b, int& R, int& C) { const int st = b / 1024, sb = b % 1024, swz = sb ^ (((sb >> 9) & 1) << 5); R = (st >> 1) * 16 + swz / 64; C = (st & 1) * 32 + (swz % 64) / 2; }
__host__ __device__ __forceinline__ int perm32(int rho) { const int n = rho >> 4, i = rho & 15; return 8 * (i >> 2) + 4 * n + (i & 3); }

struct Unit { int pm, pn, z; };
struct Gemm { int lda, ldb, K; };

struct StaticOrder {
    int nM, nN, nwg, G, c;
    __device__ void init(int M, int N, int G_, int c_) { nM = M / BM; nN = N / BM; nwg = nM * nN; G = G_; c = c_; }
    __device__ bool tile(int i, Unit& u) const {
        const long L = (long)i * G + c; if (L >= nwg) return false;
        int wgid = (int)L; { const int q = nwg / NXCD, r = nwg % NXCD, xcd = wgid % NXCD, off = wgid / NXCD; wgid = (xcd < r ? xcd * (q + 1) : r * (q + 1) + (xcd - r) * q) + off; }
        const int nig = WGM * nN, gid = wgid / nig, fm = gid * WGM, gsz = (nM - fm) < WGM ? (nM - fm) : WGM;
        u.pm = fm + ((wgid % nig) % gsz); u.pn = (wgid % nig) / gsz; u.z = 0; return true;
    }
};

DI unsigned cvt_pk_bf16(float lo, float hi) { return cvtpk(lo, hi); }

template <class Epi, class Sched, bool ALIGN_EPI, bool SP2>
DI void gemm_phase(LAS unsigned char* lds, const Gemm g, const Sched& S, const Epi& E) {
    int tid_ = threadIdx.x; asm volatile("" : "+v"(tid_));
    const int tid = tid_, wid = __builtin_amdgcn_readfirstlane(tid >> 6), lane = tid & 63, wr = wid >> 2, wc = wid & 3, fr = lane & 15, fq = lane >> 4;
    int K_ = g.K; asm volatile("" : "+s"(K_));
    const int K = K_, nt = K / BK;
    unsigned voffA[2], voffB[2];
#pragma unroll
    for (int i = 0; i < 2; ++i) { int R, C; stage_rc(tid * 16 + i * 8192, R, C); const int Rb = Epi::PERM ? ((R & ~31) + perm32(R & 31)) : R;
        voffA[i] = (unsigned)(R * g.lda + C) * 2u; voffB[i] = (unsigned)(Rb * g.ldb + C) * 2u; }
    const size_t kstep = (size_t)(BK * 2);
    const size_t hA = (size_t)HALF * g.lda * 2, hB = (size_t)HALF * g.ldb * 2;
    const unsigned ldsw = (unsigned)wid * 1024u;
    const int aoff = lds_byte(wr * 64 + fr, fq * 8), boff = lds_byte(wc * 32 + fr, fq * 8);
#define PG8_SA(b, h) (((b) * 2 + (h)) * HTB)
#define PG8_SB(b, h) ((4 + (b) * 2 + (h)) * HTB)
#define PG8_STAGE(bufoff, gbase, voff) do { _Pragma("unroll") for (int _i = 0; _i < 2; ++_i) \
        __builtin_amdgcn_global_load_lds((const unsigned*)((const char*)(gbase) + (voff)[_i]), (LAS unsigned*)(lds + (bufoff) + ldsw + _i * 8192), 16, 0, 0); } while (0)
#define PG8_LDA(dst, b, h) do { _Pragma("unroll") for (int m = 0; m < 4; ++m) _Pragma("unroll") for (int k = 0; k < 2; ++k) dst[m][k] = *(const LAS bf16x8*)(lds + PG8_SA(b, h) + aoff + m * 2048 + k * 1024); } while (0)
#define PG8_LDB(dst, b, h) do { _Pragma("unroll") for (int n = 0; n < 2; ++n) _Pragma("unroll") for (int k = 0; k < 2; ++k) dst[n][k] = *(const LAS bf16x8*)(lds + PG8_SB(b, h) + boff + n * 2048 + k * 1024); } while (0)
#define PG8_MMA(ai, bj, At, Bt) do { __builtin_amdgcn_s_setprio(1); _Pragma("unroll") for (int m = 0; m < 4; ++m) _Pragma("unroll") for (int n = 0; n < 2; ++n) _Pragma("unroll") for (int k = 0; k < 2; ++k) \
        acc[ai][bj][m][n] = __builtin_amdgcn_mfma_f32_16x16x32_bf16(Bt[n][k], At[m][k], acc[ai][bj][m][n], 0, 0, 0); __builtin_amdgcn_s_setprio(0); } while (0)
#define PG8_WAIT_V(n) asm volatile("s_waitcnt vmcnt(" #n ")" ::: "memory")
#define PG8_WAIT_L(n) asm volatile("s_waitcnt lgkmcnt(" #n ")" ::: "memory")
#define PG8_BAR __builtin_amdgcn_s_barrier()
#define PG8_SCHED __builtin_amdgcn_sched_barrier(0)
    Unit cur, nxt; int ui = 0;
    if (!S.next(0, cur)) return;
    f32x4 acc[2][2][4][2];
#pragma unroll
    for (int a = 0; a < 2; ++a)
#pragma unroll
        for (int b = 0; b < 2; ++b)
#pragma unroll
            for (int m = 0; m < 4; ++m)
#pragma unroll
                for (int n = 0; n < 2; ++n) acc[a][b][m][n] = (f32x4){0.f, 0.f, 0.f, 0.f};
    bf16x8 At[4][2], B0[2][2], B1[2][2];
    const char* cA = S.a_base(cur); const char* cB = S.b_base(cur);
    if constexpr (SP2) {
        PG8_STAGE(PG8_SB(0, 0), cB, voffB); PG8_STAGE(PG8_SB(0, 1), cB + hB, voffB); PG8_STAGE(PG8_SA(0, 0), cA, voffA); PG8_STAGE(PG8_SA(0, 1), cA + hA, voffA);
        if (wr == 1) PG8_BAR;
        PG8_WAIT_V(2); PG8_BAR;
        PG8_STAGE(PG8_SB(1, 0), cB + kstep, voffB); PG8_STAGE(PG8_SA(1, 0), cA + kstep, voffA); PG8_STAGE(PG8_SB(1, 1), cB + hB + kstep, voffB);
        PG8_WAIT_V(6); PG8_BAR;
    } else {
        PG8_STAGE(PG8_SB(0, 0), cB, voffB); PG8_STAGE(PG8_SA(0, 0), cA, voffA); PG8_STAGE(PG8_SB(0, 1), cB + hB, voffB); PG8_STAGE(PG8_SA(0, 1), cA + hA, voffA);
        if (wr == 1) PG8_BAR;
        PG8_WAIT_V(4); PG8_BAR;
        PG8_STAGE(PG8_SB(1, 0), cB + kstep, voffB); PG8_STAGE(PG8_SA(1, 0), cA + kstep, voffA); PG8_STAGE(PG8_SB(1, 1), cB + hB + kstep, voffB);
        PG8_WAIT_V(6); PG8_BAR;
    }
    for (;;) {
        const bool has_next = S.next(ui + 1, nxt);
        const char* nA = has_next ? S.a_base(nxt) : cA; const char* nB = has_next ? S.b_base(nxt) : cB;
        for (int t = 0; t < nt; t += 2) {
            const bool last = (t == nt - 2);
            const char* a1 = cA + (size_t)(t + 1) * kstep;
            const char* a2 = last ? nA : cA + (size_t)(t + 2) * kstep; const char* b2 = last ? nB : cB + (size_t)(t + 2) * kstep;
            const char* a3 = a2 + kstep; const char* b3 = b2 + kstep;
            if constexpr (SP2) {
            PG8_LDB(B0, 0, 0); PG8_LDB(B1, 0, 1); PG8_SCHED; PG8_LDA(At, 0, 0); PG8_STAGE(PG8_SA(1, 1), a1 + hA, voffA);
            PG8_WAIT_V(8); PG8_WAIT_L(0); PG8_BAR; PG8_MMA(0, 0, At, B0); PG8_MMA(0, 1, At, B1); PG8_BAR; PG8_SCHED;
            PG8_LDA(At, 0, 1); PG8_STAGE(PG8_SB(0, 0), b2, voffB); PG8_STAGE(PG8_SB(0, 1), b2 + hB, voffB); PG8_STAGE(PG8_SA(0, 0), a2, voffA);
            PG8_WAIT_V(8); PG8_WAIT_L(0); PG8_BAR; PG8_MMA(1, 0, At, B0); PG8_MMA(1, 1, At, B1); PG8_BAR; PG8_SCHED;
            PG8_LDB(B0, 1, 0); PG8_LDB(B1, 1, 1); PG8_SCHED; PG8_LDA(At, 1, 0); PG8_STAGE(PG8_SA(0, 1), a2 + hA, voffA);
            PG8_WAIT_V(8); PG8_WAIT_L(0); PG8_BAR; PG8_MMA(0, 0, At, B0); PG8_MMA(0, 1, At, B1); PG8_BAR; PG8_SCHED;
            PG8_LDA(At, 1, 1); PG8_STAGE(PG8_SB(1, 0), b3, voffB); PG8_STAGE(PG8_SB(1, 1), b3 + hB, voffB); PG8_STAGE(PG8_SA(1, 0), a3, voffA);
            PG8_WAIT_V(8); PG8_WAIT_L(0); PG8_BAR; PG8_MMA(1, 0, At, B0); PG8_MMA(1, 1, At, B1); PG8_BAR; PG8_SCHED;
            } else {
            PG8_LDB(B0, 0, 0); PG8_SCHED; PG8_LDA(At, 0, 0); PG8_STAGE(PG8_SA(1, 1), a1 + hA, voffA);
            PG8_WAIT_L(8); PG8_BAR; PG8_WAIT_L(0); PG8_MMA(0, 0, At, B0); PG8_BAR; PG8_SCHED;
            PG8_LDB(B1, 0, 1); PG8_STAGE(PG8_SB(0, 0), b2, voffB);
            PG8_BAR; PG8_WAIT_L(0); PG8_MMA(0, 1, At, B1); PG8_BAR;
            PG8_LDA(At, 0, 1); PG8_STAGE(PG8_SA(0, 0), a2, voffA);
            PG8_BAR; PG8_WAIT_L(0); PG8_MMA(1, 0, At, B0); PG8_BAR; PG8_SCHED;
            PG8_STAGE(PG8_SB(0, 1), b2 + hB, voffB);
            PG8_WAIT_V(6); PG8_BAR; PG8_MMA(1, 1, At, B1); PG8_BAR;
            PG8_LDB(B0, 1, 0); PG8_SCHED; PG8_LDA(At, 1, 0); PG8_STAGE(PG8_SA(0, 1), a2 + hA, voffA);
            PG8_WAIT_L(8); PG8_BAR; PG8_WAIT_L(0); PG8_MMA(0, 0, At, B0); PG8_BAR; PG8_SCHED;
            PG8_LDB(B1, 1, 1); PG8_STAGE(PG8_SB(1, 0), b3, voffB);
            PG8_BAR; PG8_WAIT_L(0); PG8_MMA(0, 1, At, B1); PG8_BAR;
            PG8_LDA(At, 1, 1); PG8_STAGE(PG8_SA(1, 0), a3, voffA);
            PG8_BAR; PG8_WAIT_L(0); PG8_MMA(1, 0, At, B0); PG8_BAR; PG8_SCHED;
            PG8_STAGE(PG8_SB(1, 1), b3 + hB, voffB);
            PG8_WAIT_V(6); PG8_BAR; PG8_MMA(1, 1, At, B1); PG8_BAR;
            }
        }
        if constexpr (ALIGN_EPI) { if (wr == 0) PG8_BAR; }
        E(acc, cur, wr, wc, fr, fq);
        if (!has_next) break;
#pragma unroll
        for (int a = 0; a < 2; ++a)
#pragma unroll
            for (int b = 0; b < 2; ++b)
#pragma unroll
                for (int m = 0; m < 4; ++m)
#pragma unroll
                    for (int n = 0; n < 2; ++n) acc[a][b][m][n] = (f32x4){0.f, 0.f, 0.f, 0.f};
        cur = nxt; cA = nA; cB = nB; ++ui;
        if constexpr (ALIGN_EPI) { if (wr == 1) PG8_BAR; }
    }
    PG8_WAIT_V(0);
    if constexpr (!ALIGN_EPI) { if (wr == 0) PG8_BAR; }
    PG8_BAR;
#undef PG8_SA
#undef PG8_SB
#undef PG8_STAGE
#undef PG8_LDA
#undef PG8_LDB
#undef PG8_MMA
#undef PG8_WAIT_V
#undef PG8_WAIT_L
#undef PG8_BAR
#undef PG8_SCHED
}
}

namespace pg8 {
struct PlainOrder : StaticOrder {
    const char* A; const char* Bt; size_t a_tile, b_tile;
    __device__ bool next(int i, Unit& u) const { return tile(i, u); }
    DI const char* a_base(const Unit& u) const { return A + (size_t)u.pm * a_tile; }
    DI const char* b_base(const Unit& u) const { return Bt + (size_t)u.pn * b_tile; }
};
struct InOrder : StaticOrder {
    const char* H; const char* Win; const char* Mn; const char* Wkv; int n_extra;
    __device__ bool next(int i, Unit& u) const {
        const long L = (long)i * G + c;
        if (L >= (long)nwg + n_extra) return false;
        Unit t; t.pm = 0; t.pn = 0; t.z = 0;
        const bool main_tile = L < nwg;
        if (main_tile) (void)tile(i, t);
        const int e = (int)(L - nwg);
        const int pm1 = e >> 1, pn1 = e & 1, pm2 = (e - 32) >> 4, pn2 = (e - 32) & 15; const bool k1 = e < 32;
        u.pm = main_tile ? t.pm : (k1 ? pm1 : pm2); u.pn = main_tile ? t.pn : (k1 ? pn1 : pn2); u.z = main_tile ? 0 : (k1 ? 1 : 2);
        return true;
    }
    DI const char* a_base(const Unit& u) const { const long d1 = Mn - H, d2 = (Wkv + (size_t)512 * 1024 * 2) - H; return H + ((u.z == 1) ? d1 : 0L) + ((u.z == 2) ? d2 : 0L) + (size_t)u.pm * (256 * 1024 * 2); }
    DI const char* b_base(const Unit& u) const { const long d1 = Wkv - Win, d2 = Mn - Win; return Win + ((u.z == 1) ? d1 : 0L) + ((u.z == 2) ? d2 : 0L) + (size_t)u.pn * (256 * 1024 * 2); }
};
struct EpiIn {
    static constexpr bool PERM = true;
    bf16* proj; bf16* kmem; bf16* vt;
    DI void operator()(const f32x4 (&acc)[2][2][4][2], const Unit& u, int wr, int wc, int fr, int fq) const {
        const long dk = kmem - proj, dv = vt - proj; bf16* O = proj + ((u.z == 1) ? dk : 0L) + ((u.z == 2) ? dv : 0L); const int ldc = PC + ((u.z == 1) ? 512 - PC : 0) + ((u.z == 2) ? BATCH * NMEM - PC : 0);
        const int row0 = u.pm * BM + wr * 64 + fr, col0 = u.pn * BM + wc * 32 + 8 * fq;
#pragma unroll
        for (int ai = 0; ai < 2; ++ai)
#pragma unroll
            for (int m = 0; m < 4; ++m) { bf16* rowp = O + (size_t)(row0 + ai * HALF + m * 16) * ldc + col0;
#pragma unroll
                for (int bj = 0; bj < 2; ++bj) { const f32x4 v0 = acc[ai][bj][m][0], v1 = acc[ai][bj][m][1];
                    u32x4 w; w.x = cvt_pk_bf16(v0[0], v0[1]); w.y = cvt_pk_bf16(v0[2], v0[3]); w.z = cvt_pk_bf16(v1[0], v1[1]); w.w = cvt_pk_bf16(v1[2], v1[3]);
                    *(u32x4*)(rowp + bj * HALF) = w; } }
    }
};
struct BranchOrder : StaticOrder {
    const char* Y; const char* Wb;
    __device__ bool next(int i, Unit& u) const { if (!tile(i / 3, u)) return false; u.z = i % 3; return true; }
    DI const char* a_base(const Unit& u) const { return Y + (size_t)u.z * (16 * MiB) + (size_t)u.pm * (256 * 512 * 2); }
    DI const char* b_base(const Unit& u) const { return Wb + (size_t)u.z * (1024 * 512 * 2) + (size_t)u.pn * (256 * 512 * 2); }
};
struct ScoreOrder : StaticOrder {
    const char* Q; const char* Kbd;
    __device__ bool next(int i, Unit& u) const { return tile(i, u); }
    DI const char* a_base(const Unit& u) const { return Q + (size_t)u.pm * (256 * 2048 * 2) + (size_t)u.pn * 512; }
    DI const char* b_base(const Unit& u) const { return Kbd + (size_t)u.pn * (256 * 256 * 2); }
};

struct EpiBf16 {
    static constexpr bool PERM = true;
    bf16* O; int ldc;
    DI void operator()(const f32x4 (&acc)[2][2][4][2], const Unit& u, int wr, int wc, int fr, int fq) const {
        const int row0 = u.pm * BM + wr * 64 + fr, col0 = u.pn * BM + wc * 32 + 8 * fq;
#pragma unroll
        for (int ai = 0; ai < 2; ++ai)
#pragma unroll
            for (int m = 0; m < 4; ++m) { bf16* rowp = O + (size_t)(row0 + ai * HALF + m * 16) * ldc + col0;
#pragma unroll
                for (int bj = 0; bj < 2; ++bj) { const f32x4 v0 = acc[ai][bj][m][0], v1 = acc[ai][bj][m][1];
                    u32x4 w; w.x = cvt_pk_bf16(v0[0], v0[1]); w.y = cvt_pk_bf16(v0[2], v0[3]); w.z = cvt_pk_bf16(v1[0], v1[1]); w.w = cvt_pk_bf16(v1[2], v1[3]);
                    *(u32x4*)(rowp + bj * HALF) = w; } }
    }
};
struct EpiQ {
    static constexpr bool PERM = true;
    bf16* O; int ldc; const float* ssp;
    DI void operator()(const f32x4 (&acc)[2][2][4][2], const Unit& u, int wr, int wc, int fr, int fq) const {
        const int row0 = u.pm * BM + wr * 64 + fr, col0 = u.pn * BM + wc * 32 + 8 * fq;
#pragma unroll
        for (int ai = 0; ai < 2; ++ai)
#pragma unroll
            for (int m = 0; m < 4; ++m) { const int row = row0 + ai * HALF + m * 16; const f32x4* sp = (const f32x4*)(ssp + (size_t)row * 16);
                const f32x4 s0 = sp[0], s1 = sp[1], s2 = sp[2], s3 = sp[3];
                const float ss = ((s0[0] + s0[1]) + (s0[2] + s0[3])) + ((s1[0] + s1[1]) + (s1[2] + s1[3])) + ((s2[0] + s2[1]) + (s2[2] + s2[3])) + ((s3[0] + s3[1]) + (s3[2] + s3[3]));
                const float rs = 1.0f / sqrtf(ss * (1.0f / 1024.0f) + EPS);
                bf16* rowp = O + (size_t)row * ldc + col0;
#pragma unroll
                for (int bj = 0; bj < 2; ++bj) { const f32x4 v0 = acc[ai][bj][m][0] * rs, v1 = acc[ai][bj][m][1] * rs;
                    u32x4 w; w.x = cvt_pk_bf16(v0[0], v0[1]); w.y = cvt_pk_bf16(v0[2], v0[3]); w.z = cvt_pk_bf16(v1[0], v1[1]); w.w = cvt_pk_bf16(v1[2], v1[3]);
                    *(u32x4*)(rowp + bj * HALF) = w; }
                asm volatile("" ::: "memory"); }
    }
};
struct EpiF32 {
    static constexpr bool PERM = false;
    float* C; int ldc;
    DI void operator()(const f32x4 (&acc)[2][2][4][2], const Unit& u, int wr, int wc, int fr, int fq) const {
        const int row0 = u.pm * BM + wr * 64 + fr, col0 = u.pn * BM + wc * 32 + 4 * fq;
#pragma unroll
        for (int ai = 0; ai < 2; ++ai)
#pragma unroll
            for (int m = 0; m < 4; ++m) { float* rowp = C + (size_t)(row0 + ai * HALF + m * 16) * ldc + col0;
#pragma unroll
                for (int bj = 0; bj < 2; ++bj)
#pragma unroll
                    for (int n = 0; n < 2; ++n) *(f32x4*)(rowp + bj * HALF + n * 16) = acc[ai][bj][m][n]; }
    }
};
struct EpiBranch {
    static constexpr bool PERM = true;
    const bf16* proj; bf16* gbuf; bf16* merged;
    DI void operator()(const f32x4 (&acc)[2][2][4][2], const Unit& u, int wr, int wc, int fr, int fq) const {
        const int row0 = u.pm * BM + wr * 64 + fr, col0 = u.pn * BM + wc * 32 + 8 * fq;
#pragma unroll
        for (int ai = 0; ai < 2; ++ai)
#pragma unroll
            for (int m = 0; m < 4; ++m) { const int row = row0 + ai * HALF + m * 16;
#pragma unroll
                for (int bj = 0; bj < 2; ++bj) { const int col = col0 + bj * HALF;
                    const u32x4 gw = *(const u32x4*)(proj + (size_t)row * PC + C_GATE + u.z * 1024 + col);
                    f32x4 v0 = acc[ai][bj][m][0], v1 = acc[ai][bj][m][1];
                    v0[0] *= fast_sig(bflo(gw.x)); v0[1] *= fast_sig(bfhi(gw.x)); v0[2] *= fast_sig(bflo(gw.y)); v0[3] *= fast_sig(bfhi(gw.y));
                    v1[0] *= fast_sig(bflo(gw.z)); v1[1] *= fast_sig(bfhi(gw.z)); v1[2] *= fast_sig(bflo(gw.w)); v1[3] *= fast_sig(bfhi(gw.w));
                    const size_t off = (size_t)row * 1024 + col;
                    if (u.z == 2) { const u32x4 p0 = *(const u32x4*)(gbuf + off), p1 = *(const u32x4*)(gbuf + (size_t)TG * 1024 + off);
                        v0[0] += bflo(p0.x) + bflo(p1.x); v0[1] += bfhi(p0.x) + bfhi(p1.x); v0[2] += bflo(p0.y) + bflo(p1.y); v0[3] += bfhi(p0.y) + bfhi(p1.y);
                        v1[0] += bflo(p0.z) + bflo(p1.z); v1[1] += bfhi(p0.z) + bfhi(p1.z); v1[2] += bflo(p0.w) + bflo(p1.w); v1[3] += bfhi(p0.w) + bfhi(p1.w); }
                    u32x4 w; w.x = cvt_pk_bf16(v0[0], v0[1]); w.y = cvt_pk_bf16(v0[2], v0[3]); w.z = cvt_pk_bf16(v1[0], v1[1]); w.w = cvt_pk_bf16(v1[2], v1[3]);
                    *(u32x4*)((u.z == 2 ? merged : gbuf + (size_t)u.z * TG * 1024) + off) = w; }
                asm volatile("" ::: "memory"); }
    }
};
struct EpiOut {
    static constexpr bool PERM = true;
    const float* x; float* x1; bf16* xg; const float* gffn; float* ssp;
    DI void operator()(const f32x4 (&acc)[2][2][4][2], const Unit& u, int wr, int wc, int fr, int fq) const {
        const int row0 = u.pm * BM + wr * 64 + fr, col0 = u.pn * BM + wc * 32 + 8 * fq;
        f32x4 g0[2], g1[2];
#pragma unroll
        for (int bj = 0; bj < 2; ++bj) { g0[bj] = *(const f32x4*)(gffn + col0 + bj * HALF); g1[bj] = *(const f32x4*)(gffn + col0 + bj * HALF + 4); }
#pragma unroll
        for (int ai = 0; ai < 2; ++ai)
#pragma unroll
            for (int m = 0; m < 4; ++m) { const int row = row0 + ai * HALF + m * 16; float ss = 0.f;
#pragma unroll
                for (int bj = 0; bj < 2; ++bj) { const size_t off = (size_t)row * 1024 + col0 + bj * HALF;
                    const f32x4 v0 = acc[ai][bj][m][0] + *(const f32x4*)(x + off), v1 = acc[ai][bj][m][1] + *(const f32x4*)(x + off + 4);
                    *(f32x4*)(x1 + off) = v0; *(f32x4*)(x1 + off + 4) = v1;
                    ss += (v0[0] * v0[0] + v0[1] * v0[1]) + (v0[2] * v0[2] + v0[3] * v0[3]) + (v1[0] * v1[0] + v1[1] * v1[1]) + (v1[2] * v1[2] + v1[3] * v1[3]);
                    const f32x4 a = v0 * g0[bj], b = v1 * g1[bj];
                    u32x4 w; w.x = cvt_pk_bf16(a[0], a[1]); w.y = cvt_pk_bf16(a[2], a[3]); w.z = cvt_pk_bf16(b[0], b[1]); w.w = cvt_pk_bf16(b[2], b[3]);
                    *(u32x4*)(xg + off) = w; }
                ss += __shfl_xor(ss, 16); ss += __shfl_xor(ss, 32);
                if (fq == 0) ssp[(size_t)row * 16 + u.pn * 4 + wc] = ss;
                asm volatile("" ::: "memory"); }
    }
};
}

#define XB_TMO      128
#define XB_XCNT(j)  (256  + 64 * (j))
#define XB_XSUB(j)  (1280 + 64 * (j))
#define XB_XGEN(j)  (2304 + 64 * (j))
#define XB_TOP      3328
#define XB_TOPGEN   3392
#define XCD_BAR_WORDS 3456
#define XB_SPIN_CAP (1u << 18)
constexpr int CW_BAR = 4096;

DI unsigned xb_ld(unsigned* p)              { return __hip_atomic_load(p, __ATOMIC_RELAXED, __HIP_MEMORY_SCOPE_AGENT); }
DI unsigned xb_add(unsigned* p, unsigned v) { return __hip_atomic_fetch_add(p, v, __ATOMIC_RELAXED, __HIP_MEMORY_SCOPE_AGENT); }
DI unsigned xb_xcc_id() { return (unsigned)__builtin_amdgcn_s_getreg((3 << 11) | 20) & 0xFu; }
#define XB_SPIN(cond, bar) do { unsigned _sp = 0; while (cond) { __builtin_amdgcn_s_sleep(1); \
    if ((++_sp & 255u) == 0u) { if (xb_ld(&(bar)[XB_TMO])) break; if (_sp > XB_SPIN_CAP) { atomicAdd(&(bar)[XB_TMO], 1u); break; } } } } while (0)

struct XcdBarrier { unsigned* bar; unsigned x; volatile LAS unsigned* st; };

DI XcdBarrier xcd_barrier_post(unsigned* bar, volatile LAS unsigned* st) {
    XcdBarrier b; b.bar = bar; b.x = xb_xcc_id(); b.st = st;
    if (threadIdx.x == 0) (void)xb_add(&bar[XB_XCNT(b.x)], 1u);
    return b;
}
DI void xcd_barrier_complete(unsigned* bar, unsigned x, unsigned& nloc, unsigned& nx) {
    const unsigned G = gridDim.x * gridDim.y * gridDim.z;
    unsigned sum, cnt, mine, sp = 0u;
    for (;;) {
        sum = 0u; cnt = 0u; mine = 0u;
#pragma unroll
        for (unsigned j = 0; j < 16; ++j) { const unsigned c = xb_ld(&bar[XB_XCNT(j)]); sum += c; cnt += (c > 0u) ? 1u : 0u; mine = (j == x) ? c : mine; }
        if (sum == G) break;
        __builtin_amdgcn_s_sleep(1);
        if ((++sp & 255u) == 0u) { if (xb_ld(&bar[XB_TMO])) break; if (sp > XB_SPIN_CAP) { atomicAdd(&bar[XB_TMO], 1u); break; } }
    }
    nloc = mine > 0u ? mine : 1u; nx = cnt > 0u ? cnt : 1u;
}
DI void xcd_barrier(const XcdBarrier& b) {
    asm volatile("s_waitcnt vmcnt(0)" ::: "memory");
    __syncthreads();
    if (threadIdx.x == 0) {
        unsigned* bar = b.bar;
        __builtin_amdgcn_s_waitcnt(0);
        unsigned nloc = b.st[0], nx = b.st[1];
        if (nloc == 0u) { xcd_barrier_complete(bar, b.x, nloc, nx); b.st[0] = nloc; b.st[1] = nx; }
        const unsigned old = xb_add(&bar[XB_XSUB(b.x)], 1u);
        const unsigned gen = old / nloc;
        if (old + 1u == (gen + 1u) * nloc) {
            __builtin_amdgcn_fence(__ATOMIC_RELEASE, "agent");
            asm volatile("s_waitcnt vmcnt(0)" ::: "memory");
            const unsigned og = xb_add(&bar[XB_TOP], 1u);
            const unsigned tg = og / nx;
            if (og + 1u == (tg + 1u) * nx) xb_add(&bar[XB_TOPGEN], 1u);
            else XB_SPIN(xb_ld(&bar[XB_TOPGEN]) == tg, bar);
            __builtin_amdgcn_fence(__ATOMIC_ACQUIRE, "agent");
            xb_add(&bar[XB_XGEN(b.x)], 1u);
            asm volatile("s_waitcnt vmcnt(0)" ::: "memory");
        } else {
            XB_SPIN(xb_ld(&bar[XB_XGEN(b.x)]) == gen, bar);
            __builtin_amdgcn_fence(__ATOMIC_ACQUIRE, "agent");
            asm volatile("s_waitcnt vmcnt(0)" ::: "memory");
        }
    }
    __syncthreads();
}

struct Frame {
    LAS unsigned char* lds;
    int tid, lane, wave;
    DI void refresh() { int t = threadIdx.x; asm volatile("" : "+v"(t)); tid = t; lane = t & 63; wave = __builtin_amdgcn_readfirstlane(t >> 6); }
    int vcu, G;
    const float *x, *mem, *norm_mix_g, *w_in, *hg_lb, *hg_norm_g, *sc_conv_w, *mem_norm_g, *w_mem_kv, *w_branch, *w_out, *norm_ffn_g, *peer_w_q, *peer_sub_keys, *peer_u, *peer_v, *final_norm_g;
    float* out; unsigned char* ws;
};

DI void p0_transpose_item(const float* W, int K, int N, bf16* WT, LAS float* scr, int item, int lane) {
    const int nblk = N / 32, kb = item / nblk, nb = item % nblk, k0 = 64 * kb, n0 = 32 * nb;
#pragma unroll 8
    for (int i = 0; i < 32; ++i) { const int kk = 2 * i + (lane >> 5); scr[kk * 33 + (lane & 31)] = W[(size_t)(k0 + kk) * N + n0 + (lane & 31)]; }
    asm volatile("s_waitcnt lgkmcnt(0)" ::: "memory");
    const int c = lane & 7;
#pragma unroll
    for (int j = 0; j < 4; ++j) { const int n = (lane >> 3) + 8 * j; const LAS float* s = scr + (8 * c) * 33 + n;
        u32x4 o; o.x = pk2(s[0 * 33], s[1 * 33]); o.y = pk2(s[2 * 33], s[3 * 33]); o.z = pk2(s[4 * 33], s[5 * 33]); o.w = pk2(s[6 * 33], s[7 * 33]);
        *(u32x4*)(WT + (size_t)(n0 + n) * K + k0 + 8 * c) = o; }
    asm volatile("s_waitcnt lgkmcnt(0)" ::: "memory");
}
DI void rms_row_to_bf16(const float* xrow, const float* g, bf16* orow, int lane) {
    const f32x4* xr = (const f32x4*)xrow + lane; const f32x4* gr = (const f32x4*)g + lane;
    f32x4 v[4]; float s = 0.f;
#pragma unroll
    for (int j = 0; j < 4; ++j) { v[j] = xr[64 * j]; s += (v[j].x * v[j].x + v[j].y * v[j].y) + (v[j].z * v[j].z + v[j].w * v[j].w); }
    const float rstd = 1.0f / sqrtf(wave_sum(s) * (1.f / 1024.f) + EPS);
    unsigned long long* o8 = (unsigned long long*)orow + lane;
#pragma unroll
    for (int j = 0; j < 4; ++j) { const f32x4 gg = gr[64 * j]; const f32x4 y = v[j] * rstd * gg;
        o8[64 * j] = (unsigned long long)pk2(y.x, y.y) | ((unsigned long long)pk2(y.z, y.w) << 32); }
}
DI void p0_prologue(Frame& F) {
    F.refresh();
    LAS float* scr = (LAS float*)(F.lds + F.wave * 16384);
    const int gw = F.vcu * NWAVES + F.wave, NGW = F.G * NWAVES;
    unsigned char* ws = F.ws;
    constexpr int I_IN = (1024 / 64) * (PC / 32), I_KV = (1024 / 64) * (1024 / 32), I_BR = (512 / 64) * (1024 / 32), I_OUT = (1024 / 64) * (1024 / 32), I_Q = (1024 / 64) * (2048 / 32);
    constexpr int NITEMS = I_IN + I_KV + 3 * I_BR + I_OUT + I_Q;
    for (int it = gw; it < NITEMS; it += NGW) {
        int r = it;
        if (r < I_IN) { p0_transpose_item(F.w_in, 1024, PC, (bf16*)(ws + WS_WIN), scr, r, F.lane); continue; } r -= I_IN;
        if (r < I_KV) { p0_transpose_item(F.w_mem_kv, 1024, 1024, (bf16*)(ws + WS_WKV), scr, r, F.lane); continue; } r -= I_KV;
        if (r < 3 * I_BR) { const int n = r / I_BR; p0_transpose_item(F.w_branch + (size_t)n * 512 * 1024, 512, 1024, (bf16*)(ws + WS_WBR) + (size_t)n * 1024 * 512, scr, r % I_BR, F.lane); continue; } r -= 3 * I_BR;
        if (r < I_OUT) { p0_transpose_item(F.w_out, 1024, 1024, (bf16*)(ws + WS_WOUT), scr, r, F.lane); continue; } r -= I_OUT;
        p0_transpose_item(F.peer_w_q, 1024, 2048, (bf16*)(ws + WS_WQ), scr, r, F.lane);
    }
    const int gt = F.vcu * 512 + F.tid, NGT = F.G * 512;
    for (int it = gt; it < 8 * 256 * 32; it += NGT) {
        const int c8 = it & 31, row = (it >> 5) & 255, h = it >> 13, p = row >> 7, key = row & 127;
        u32x4 o = (u32x4){0u, 0u, 0u, 0u};
        if ((c8 >> 4) == p) { const float* s = F.peer_sub_keys + (((size_t)(h * 2 + p) * 128 + key) * 128 + (c8 & 15) * 8);
            const f32x4 a = *(const f32x4*)s, b = *(const f32x4*)(s + 4); o.x = pk2(a.x, a.y); o.y = pk2(a.z, a.w); o.z = pk2(b.x, b.y); o.w = pk2(b.z, b.w); }
        *(u32x4*)((bf16*)(ws + WS_KBD) + ((size_t)(h * 256 + row) * 256 + c8 * 8)) = o;
    }
    for (int it = gt; it < 1024; it += NGT) { const float a0 = F.hg_lb[it], a1 = F.hg_lb[1024 + it]; const float m = fmaxf(a0, a1); const float e0 = __expf(a0 - m), e1 = __expf(a1 - m);
        ((float*)(ws + WS_LB))[it] = e0 / (e0 + e1); }
    for (int m = gw; m < BATCH * NMEM; m += NGW) rms_row_to_bf16(F.mem + (size_t)m * 1024, F.mem_norm_g, (bf16*)(ws + WS_MN) + (size_t)m * 1024, F.lane);
    for (int m = gw; m < T_ALL; m += NGW) rms_row_to_bf16(F.x + (size_t)m * 1024, F.norm_mix_g, (bf16*)(ws + WS_XG) + (size_t)m * 1024, F.lane);
}

DI s16x4 tr16(const LAS unsigned char* p) { return __builtin_bit_cast(s16x4, __builtin_amdgcn_ds_read_tr16_b64_v4i16((LAS v4i16_t*)p)); }
DI bf16x8 cat8(s16x4 lo, s16x4 hi) { return __builtin_shufflevector(lo, hi, 0, 1, 2, 3, 4, 5, 6, 7); }
#define MFMA32(a, b, c) __builtin_amdgcn_mfma_f32_32x32x16_bf16((a), (b), (c), 0, 0, 0)
DI int crow(int reg, int h) { return (reg & 3) + 8 * (reg >> 2) + 4 * h; }
DI bf16x8 pack8(const f32x16& x, int s) {
    u32x4 p; p.x = cvtpk(x[8 * s], x[8 * s + 1]); p.y = cvtpk(x[8 * s + 2], x[8 * s + 3]); p.z = cvtpk(x[8 * s + 4], x[8 * s + 5]); p.w = cvtpk(x[8 * s + 6], x[8 * s + 7]);
    return __builtin_bit_cast(bf16x8, p);
}
constexpr int TS = 272;

DI void stage_tile(LAS unsigned char* tile, const bf16* src, int tid) {
#pragma unroll
    for (int i = 0; i < 2; ++i) { const int id = tid + 512 * i, c = id >> 4, ch = id & 15;
        *(LAS u32x4*)(tile + c * TS + ch * 16) = *(const u32x4*)(src + (size_t)c * PC + ch * 8); }
}
DI float touch_tile(const bf16* src, int i128) { return *(const float*)(src + (size_t)(i128 >> 1) * PC + (i128 & 1) * 64); }
DI void gate8(const LAS unsigned char* zt, int dp, int ts, f32x2 lb, f32x2 (&L)[8], f32x2 (&kk)[8], f32x2 (&lf)[8]) {
    f32x2 run = (f32x2){0.f, 0.f}; const f32x2 oml = 1.0f - lb;
#pragma unroll
    for (int i = 0; i < 8; ++i) { const unsigned w = *(const LAS unsigned*)(zt + (8 * ts + i) * TS + 4 * dp);
        const f32x2 sg = (f32x2){fast_sig(bflo(w)), fast_sig(bfhi(w))}; const f32x2 f = lb + oml * sg;
        lf[i] = (f32x2){__builtin_amdgcn_logf(f.x), __builtin_amdgcn_logf(f.y)}; kk[i] = oml * (1.0f - sg); run += lf[i]; L[i] = run; }
}
DI f32x2 exp2x2(f32x2 v) { return (f32x2){__builtin_amdgcn_exp2f(v.x), __builtin_amdgcn_exp2f(v.y)}; }
struct SliceSums { f32x2 offf, offb, glf, glb, greff, grefb; };
DI SliceSums slice_sums(const LAS float* tot, int dp, int ts) {
    SliceSums r; f32x2 tf[8], tb[8];
#pragma unroll
    for (int j = 0; j < 8; ++j) { tf[j] = *(const LAS f32x2*)(tot + j * 128 + 2 * dp); tb[j] = *(const LAS f32x2*)(tot + (8 + j) * 128 + 2 * dp); }
    r.offf = (f32x2){0.f, 0.f}; r.offb = (f32x2){0.f, 0.f};
#pragma unroll
    for (int j = 0; j < 8; ++j) { if (j < ts) r.offf += tf[j]; if (j > ts) r.offb += tb[j]; }
    r.greff = (tf[0] + tf[1]) + (tf[2] + tf[3]); r.glf = r.greff + ((tf[4] + tf[5]) + (tf[6] + tf[7]));
    r.grefb = (tb[4] + tb[5]) + (tb[6] + tb[7]); r.glb = r.grefb + ((tb[0] + tb[1]) + (tb[2] + tb[3]));
    return r;
}

DI void hgrn_a_item(Frame& F, int item, bool has_next) {
    F.refresh();
    constexpr int T_V = 0, T_KF = 17408, T_KB = 34816, TOT = 52224;
    LAS unsigned char* lds = F.lds;
    const int n = item & 31, h = (item >> 5) & 3, b = item >> 7;
    const bf16* proj = (const bf16*)(F.ws + WS_PROJ) + ((size_t)b * SEQ + n * CHUNK) * PC;
    const int tid = F.tid, dp = tid & 63, ts = F.wave;
    const float* lbp = (const float*)(F.ws + WS_LB);
    const f32x2 lbf = *(const f32x2*)(lbp + h * 128 + 2 * dp), lbb = *(const f32x2*)(lbp + 512 + h * 128 + 2 * dp);
    stage_tile(lds + T_V, proj + C_HI + h * 128, tid); stage_tile(lds + T_KF, proj + C_FF + h * 128, tid); stage_tile(lds + T_KB, proj + C_FB + h * 128, tid);
    float tch = 0.f;
    if (has_next) { const bf16* pn = proj + (size_t)CHUNK * PC + h * 128; const int i128 = tid & 127, wsel = tid >> 7; tch = touch_tile(pn + (wsel == 0 ? C_HI : wsel == 1 ? C_FF : C_FB), i128); }
    __syncthreads();
    f32x2 Lf[8], kf[8], lff[8], Lb[8], kb[8], lfb[8];
    gate8(lds + T_KF, dp, ts, lbf, Lf, kf, lff);
    gate8(lds + T_KB, dp, ts, lbb, Lb, kb, lfb);
    LAS float* tot = (LAS float*)(lds + TOT);
    *(LAS f32x2*)(tot + ts * 128 + 2 * dp) = Lf[7]; *(LAS f32x2*)(tot + (8 + ts) * 128 + 2 * dp) = Lb[7];
    asm volatile("" :: "v"(tch));
    __syncthreads();
    const SliceSums ss = slice_sums(tot, dp, ts);
    const f32x2 tbq = Lb[7];
#pragma unroll
    for (int i = 0; i < 8; ++i) { const int c = 8 * ts + i;
        const f32x2 G = ss.offf + Lf[i]; const f32x2 kd = kf[i] * exp2x2(ss.glf - G);
        const f32x2 Gb = ss.offb + (tbq - Lb[i] + lfb[i]); const f32x2 kdb = kb[i] * exp2x2(ss.glb - Gb);
        *(LAS unsigned*)(lds + T_KF + c * TS + 4 * dp) = cvtpk(kd.x, kd.y); *(LAS unsigned*)(lds + T_KB + c * TS + 4 * dp) = cvtpk(kdb.x, kdb.y); }
    if (ts == 0) { float* dec = (float*)(F.ws + WS_DEC) + (size_t)item * 256; *(f32x2*)(dec + 2 * dp) = exp2x2(ss.glf); *(f32x2*)(dec + 128 + 2 * dp) = exp2x2(ss.glb); }
    __syncthreads();
    const int w = F.wave, lane = F.lane, r = lane & 31, hh = lane >> 5, blk = (lane >> 4) & 1, q = (lane & 15) >> 2, p = lane & 3;
    const int dt = w >> 1, et0 = (w & 1) * 2;
#pragma unroll
    for (int dir = 0; dir < 2; ++dir) { const int TK = dir ? T_KB : T_KF;
#pragma unroll
        for (int e2 = 0; e2 < 2; ++e2) { const int et = et0 + e2; f32x16 acc;
#pragma unroll
            for (int i = 0; i < 16; ++i) acc[i] = 0.f;
#pragma unroll
            for (int ks = 0; ks < 4; ++ks) {
                const LAS unsigned char* ap = lds + TK + (16 * ks + 8 * hh + q) * TS + (32 * dt + 16 * blk + 4 * p) * 2;
                const LAS unsigned char* bp = lds + T_V + (16 * ks + 8 * hh + q) * TS + (32 * et + 16 * blk + 4 * p) * 2;
                const bf16x8 a = cat8(tr16(ap), tr16(ap + 4 * TS)), bq = cat8(tr16(bp), tr16(bp + 4 * TS));
                acc = MFMA32(a, bq, acc); }
            bf16* dsb = (bf16*)(F.ws + WS_DS) + ((size_t)(item * 2 + dir) * 128 + 32 * et + r) * 128 + 32 * dt + 4 * hh;
#pragma unroll
            for (int g4 = 0; g4 < 4; ++g4) { u32x2 wv; wv.x = cvtpk(acc[4 * g4], acc[4 * g4 + 1]); wv.y = cvtpk(acc[4 * g4 + 2], acc[4 * g4 + 3]); *(u32x2*)(dsb + 8 * g4) = wv; } } }
    __syncthreads();
}

DI void hgrn_scan(Frame& F) {
    F.refresh();
    const bf16* dS = (const bf16*)(F.ws + WS_DS); bf16* Sst = (bf16*)((unsigned char*)F.out + OUT_SST); const float* dec = (const float*)(F.ws + WS_DEC);
    const int gt = F.vcu * 512 + F.tid, NGT = F.G * 512;
    for (int id = gt; id < BG * 4 * 2 * 128 * 32; id += NGT) {
        const int d4 = id & 31, e = (id >> 5) & 127, dir = (id >> 12) & 1, bh = id >> 13;
        f32x4 S = (f32x4){0.f, 0.f, 0.f, 0.f};
#pragma unroll 4
        for (int s = 0; s < 32; ++s) { const int n = dir ? 31 - s : s, item = bh * 32 + n;
            const size_t off = ((size_t)(item * 2 + dir) * 128 + e) * 128 + d4 * 4;
            u32x2 o; o.x = cvtpk(S.x, S.y); o.y = cvtpk(S.z, S.w); *(u32x2*)(Sst + off) = o;
            const f32x4 dc = *(const f32x4*)(dec + (size_t)(item * 2 + dir) * 128 + d4 * 4);
            const u32x2 wv = *(const u32x2*)(dS + off);
            S.x = dc.x * S.x + bflo(wv.x); S.y = dc.y * S.y + bfhi(wv.x); S.z = dc.z * S.z + bflo(wv.y); S.w = dc.w * S.w + bfhi(wv.y); }
    }
}

DI void hgrn_c_item(Frame& F, int item, bool has_next) {
    F.refresh();
    constexpr int T_QRF = 0, T_KRF = 17408, T_QGF = 34816, T_QRB = 52224, T_KRB = 69632, T_QGB = 87040, T_V = 104448, TOT = 121856, O_OFF = 0, OS = 132;
    LAS unsigned char* lds = F.lds;
    const int n = item & 31, h = (item >> 5) & 3, b = item >> 7;
    const size_t row0 = (size_t)b * SEQ + n * CHUNK;
    const bf16* proj = (const bf16*)(F.ws + WS_PROJ) + row0 * PC;
    const int tid = F.tid, dp = tid & 63, ts = F.wave;
    const float* lbp = (const float*)(F.ws + WS_LB);
    const f32x2 lbf = *(const f32x2*)(lbp + h * 128 + 2 * dp), lbb = *(const f32x2*)(lbp + 512 + h * 128 + 2 * dp);
    stage_tile(lds + T_V, proj + C_HI + h * 128, tid); stage_tile(lds + T_KRF, proj + C_FF + h * 128, tid); stage_tile(lds + T_KRB, proj + C_FB + h * 128, tid); stage_tile(lds + T_QRF, proj + C_HQ + h * 128, tid);
    float tch = 0.f, tch2 = 0.f;
    if (has_next) { const bf16* pn = proj + (size_t)CHUNK * PC + h * 128; const int i128 = tid & 127, wsel = tid >> 7; tch = touch_tile(pn + (wsel == 0 ? C_HI : wsel == 1 ? C_FF : wsel == 2 ? C_FB : C_HQ), i128);
        tch2 = *(const float*)((const unsigned char*)F.out + OUT_SST + (size_t)(item + 1) * 65536 + (size_t)tid * 128); }
    __syncthreads();
    f32x2 qv[8];
#pragma unroll
    for (int i = 0; i < 8; ++i) { const unsigned w = *(const LAS unsigned*)(lds + T_QRF + (8 * ts + i) * TS + 4 * dp); const float z0 = bflo(w), z1 = bfhi(w); qv[i] = (f32x2){z0 * fast_sig(z0), z1 * fast_sig(z1)}; }
    f32x2 Lf[8], kf[8], lff[8], Lb[8], kb[8], lfb[8];
    gate8(lds + T_KRF, dp, ts, lbf, Lf, kf, lff);
    gate8(lds + T_KRB, dp, ts, lbb, Lb, kb, lfb);
    LAS float* tot = (LAS float*)(lds + TOT);
    *(LAS f32x2*)(tot + ts * 128 + 2 * dp) = Lf[7]; *(LAS f32x2*)(tot + (8 + ts) * 128 + 2 * dp) = Lb[7];
    asm volatile("" :: "v"(tch), "v"(tch2));
    __syncthreads();
    {
        const SliceSums ss = slice_sums(tot, dp, ts);
        const f32x2 tbq = Lb[7];
#pragma unroll
        for (int i = 0; i < 8; ++i) { const int c = 8 * ts + i; const int o = c * TS + 4 * dp;
            const f32x2 G = ss.offf + Lf[i]; const f32x2 x = G - ss.greff;
            const f32x2 qr = qv[i] * exp2x2(x), kr = kf[i] * exp2x2(-x), qg = qv[i] * exp2x2(G);
            *(LAS unsigned*)(lds + T_QRF + o) = cvtpk(qr.x, qr.y); *(LAS unsigned*)(lds + T_KRF + o) = cvtpk(kr.x, kr.y); *(LAS unsigned*)(lds + T_QGF + o) = cvtpk(qg.x, qg.y);
            const f32x2 Gb = ss.offb + (tbq - Lb[i] + lfb[i]); const f32x2 xb = Gb - ss.grefb;
            const f32x2 qrb = qv[i] * exp2x2(xb), krb = kb[i] * exp2x2(-xb), qgb = qv[i] * exp2x2(Gb);
            *(LAS unsigned*)(lds + T_QRB + o) = cvtpk(qrb.x, qrb.y); *(LAS unsigned*)(lds + T_KRB + o) = cvtpk(krb.x, krb.y); *(LAS unsigned*)(lds + T_QGB + o) = cvtpk(qgb.x, qgb.y); }
    }
    __syncthreads();
    const int w = F.wave, lane = F.lane, r = lane & 31, hh = lane >> 5, blk = (lane >> 4) & 1, q = (lane & 15) >> 2, p = lane & 3;
    const int ct = w >> 2, et = w & 3;
    const bf16* Sst = (const bf16*)((const unsigned char*)F.out + OUT_SST);
    f32x16 o;
#pragma unroll
    for (int i = 0; i < 16; ++i) o[i] = 0.f;
#pragma unroll
    for (int dir = 0; dir < 2; ++dir) { const int TQR = dir ? T_QRB : T_QRF, TKR = dir ? T_KRB : T_KRF, TQG = dir ? T_QGB : T_QGF;
#pragma unroll
        for (int st = 0; st < 2; ++st) {
            if (dir == 0 ? (st > ct) : (st < ct)) continue;
            f32x16 X;
#pragma unroll
            for (int i = 0; i < 16; ++i) X[i] = 0.f;
#pragma unroll
            for (int ks = 0; ks < 8; ++ks) { const bf16x8 a = *(const LAS bf16x8*)(lds + TKR + (32 * st + r) * TS + (16 * ks + 8 * hh) * 2), bq = *(const LAS bf16x8*)(lds + TQR + (32 * ct + r) * TS + (16 * ks + 8 * hh) * 2);
                X = MFMA32(a, bq, X); }
            const int cc = 32 * ct + r;
#pragma unroll
            for (int i = 0; i < 16; ++i) { const int s = 32 * st + crow(i, hh); const bool keep = dir == 0 ? (s <= cc) : (s >= cc); X[i] = keep ? X[i] : 0.f; }
#pragma unroll
            for (int s2 = 0; s2 < 2; ++s2) { const bf16x8 xs = pack8(X, s2);
                const LAS unsigned char* vp = lds + T_V + (32 * st + 16 * s2 + 4 * hh + q) * TS + (32 * et + 16 * blk + 4 * p) * 2;
                const bf16x8 pb = cat8(tr16(vp), tr16(vp + 8 * TS));
                o = MFMA32(xs, pb, o); }
        }
        const bf16* sp = Sst + ((size_t)(item * 2 + dir) * 128 + 32 * et + r) * 128 + 8 * hh;
#pragma unroll
        for (int ks = 0; ks < 8; ++ks) { const bf16x8 a = *(const LAS bf16x8*)(lds + TQG + (32 * ct + r) * TS + (16 * ks + 8 * hh) * 2); const bf16x8 bq = *(const bf16x8*)(sp + 16 * ks);
            o = MFMA32(a, bq, o); }
    }
    unsigned hw[8];
#pragma unroll
    for (int k = 0; k < 8; ++k) hw[k] = *(const unsigned*)(proj + (size_t)(8 * w + k) * PC + C_HG + h * 128 + 2 * lane);
    __syncthreads();
    LAS float* O = (LAS float*)(lds + O_OFF);
#pragma unroll
    for (int i = 0; i < 16; ++i) O[(32 * ct + crow(i, hh)) * OS + 32 * et + r] = o[i];
    __syncthreads();
    const f32x2 gn = *(const f32x2*)(F.hg_norm_g + h * 128 + 2 * lane);
    bf16* yhg = (bf16*)(F.ws + WS_YHG);
    const int a16 = (lane ^ 16) << 2, a32 = (lane ^ 32) << 2;
#pragma unroll
    for (int k = 0; k < 8; ++k) { const int c = 8 * w + k; const f32x2 v = *(const LAS f32x2*)(O + c * OS + 2 * lane);
        float ss = row_sum16(v.x * v.x + v.y * v.y); ss += bperm_f(a16, ss); ss += bperm_f(a32, ss);
        const float rstd = __builtin_amdgcn_rsqf(ss * (1.0f / 128.0f) + EPS);
        const float z0 = bflo(hw[k]), z1 = bfhi(hw[k]);
        const float y0 = v.x * rstd * gn.x * (z0 * fast_sig(z0)), y1 = v.y * rstd * gn.y * (z1 * fast_sig(z1));
        *(unsigned*)(yhg + (row0 + c) * 512 + h * 128 + 2 * lane) = cvtpk(y0, y1); }
    __syncthreads();
}

DI void attn_item(Frame& F, int g, int item) {
    F.refresh();
    constexpr int KS = 272, VS = 528, K_OFF = 0, V_OFF = 69632;
    LAS unsigned char* lds = F.lds;
    const int qb = item & 7, h = (item >> 3) & 3, b = item >> 5, bglob = g * BG + b;
    const bf16* Km = (const bf16*)(F.ws + WS_KMEM) + (size_t)bglob * 256 * 512 + h * 128;
    const bf16* VT = (const bf16*)(F.ws + WS_VT) + (size_t)(h * 128) * 4096 + bglob * 256;
    const int tid = F.tid;
#pragma unroll
    for (int i = 0; i < 8; ++i) { const int id = tid + 512 * i, key = id >> 4, ch = id & 15;
        *(LAS u32x4*)(lds + K_OFF + key * KS + ch * 16) = *(const u32x4*)(Km + (size_t)key * 512 + ch * 8); }
#pragma unroll
    for (int i = 0; i < 8; ++i) { const int id = tid + 512 * i, e = id >> 5, ch = id & 31;
        *(LAS u32x4*)(lds + V_OFF + e * VS + ch * 16) = *(const u32x4*)(VT + (size_t)e * 4096 + ch * 8); }
    __syncthreads();
    const int w = F.wave, lane = F.lane, r = lane & 31, hh = lane >> 5;
    const size_t qrow0 = (size_t)b * SEQ + qb * 256 + w * 32;
    const bf16* proj = (const bf16*)(F.ws + WS_PROJ);
    bf16x8 qf[8];
#pragma unroll
    for (int ks = 0; ks < 8; ++ks) qf[ks] = *(const bf16x8*)(proj + (qrow0 + r) * PC + C_MQ + h * 128 + 16 * ks + 8 * hh);
    const float scale = 0.08838834764831845f;
    float m_run = -INFINITY, l_run = 0.f;
#pragma unroll 1
    for (int kt = 0; kt < 8; ++kt) {
        f32x16 X;
#pragma unroll
        for (int i = 0; i < 16; ++i) X[i] = 0.f;
#pragma unroll
        for (int ks = 0; ks < 8; ++ks) { const bf16x8 a = *(const LAS bf16x8*)(lds + K_OFF + (32 * kt + r) * KS + (16 * ks + 8 * hh) * 2); X = MFMA32(a, qf[ks], X); }
        float tm = X[0];
#pragma unroll
        for (int i = 1; i < 16; ++i) tm = fmaxf(tm, X[i]);
        tm *= scale;
        const float mn = fmaxf(m_run, tm); float ls = 0.f;
#pragma unroll
        for (int i = 0; i < 16; ++i) ls += __expf(X[i] * scale - mn);
        l_run = l_run * __expf(m_run - mn) + ls; m_run = mn;
    }
    { const float mo = __shfl_xor(m_run, 32), lo = __shfl_xor(l_run, 32); const float m = fmaxf(m_run, mo);
      l_run = l_run * __expf(m_run - m) + lo * __expf(mo - m); m_run = m; }
    const float inv_l = 1.0f / l_run;
    f32x16 O[4];
#pragma unroll
    for (int e = 0; e < 4; ++e)
#pragma unroll
        for (int i = 0; i < 16; ++i) O[e][i] = 0.f;
#pragma unroll 1
    for (int kt = 0; kt < 8; ++kt) {
        f32x16 X;
#pragma unroll
        for (int i = 0; i < 16; ++i) X[i] = 0.f;
#pragma unroll
        for (int ks = 0; ks < 8; ++ks) { const bf16x8 a = *(const LAS bf16x8*)(lds + K_OFF + (32 * kt + r) * KS + (16 * ks + 8 * hh) * 2); X = MFMA32(a, qf[ks], X); }
#pragma unroll
        for (int i = 0; i < 16; ++i) X[i] = __expf(X[i] * scale - m_run) * inv_l;
#pragma unroll
        for (int s2 = 0; s2 < 2; ++s2) { const bf16x8 xs = pack8(X, s2);
#pragma unroll
            for (int e = 0; e < 4; ++e) { const LAS unsigned char* vp = lds + V_OFF + (32 * e + r) * VS + (32 * kt + 16 * s2 + 4 * hh) * 2;
                const bf16x8 pb = cat8(*(const LAS s16x4*)vp, *(const LAS s16x4*)(vp + 16));
                O[e] = MFMA32(xs, pb, O[e]); } }
    }
    bf16* ymx = (bf16*)(F.ws + WS_YMX);
#pragma unroll
    for (int e = 0; e < 4; ++e)
#pragma unroll
        for (int i = 0; i < 16; ++i) ymx[(qrow0 + crow(i, hh)) * 512 + h * 128 + 32 * e + r] = (bf16)f2bf(O[e][i]);
    __syncthreads();
}

DI void conv_phase(Frame& F) {
    F.refresh();
    const bf16* proj = (const bf16*)(F.ws + WS_PROJ); bf16* ysc = (bf16*)(F.ws + WS_YSC); const float* cw = F.sc_conv_w;
    const int gt = F.vcu * 512 + F.tid, NGT = F.G * 512;
    for (int id = gt; id < TG * 64; id += NGT) {
        const int c8 = id & 63, t = id >> 6, ts = t & (SEQ - 1);
        const bf16* pr = proj + (size_t)t * PC + c8 * 8;
        const u32x4 z4 = (u32x4){0u, 0u, 0u, 0u};
        const u32x4 sb = *(const u32x4*)(pr + C_SB), c1 = *(const u32x4*)(pr + C_SC), h1 = *(const u32x4*)(pr + C_SH);
        const u32x4 c0 = ts > 0 ? *(const u32x4*)(pr - PC + C_SC) : z4, h0 = ts > 0 ? *(const u32x4*)(pr - PC + C_SH) : z4;
        const u32x4 c2 = ts < SEQ - 1 ? *(const u32x4*)(pr + PC + C_SC) : z4, h2 = ts < SEQ - 1 ? *(const u32x4*)(pr + PC + C_SH) : z4;
        const f32x4 wa0 = *(const f32x4*)(cw + c8 * 8), wa1 = *(const f32x4*)(cw + c8 * 8 + 4), wb0 = *(const f32x4*)(cw + 512 + c8 * 8), wb1 = *(const f32x4*)(cw + 512 + c8 * 8 + 4),
                    wc0 = *(const f32x4*)(cw + 1024 + c8 * 8), wc1 = *(const f32x4*)(cw + 1024 + c8 * 8 + 4);
        float y[8];
#pragma unroll
        for (int k = 0; k < 4; ++k) {
            const float w0l = k < 2 ? wa0[2 * k] : wa1[2 * k - 4], w0h = k < 2 ? wa0[2 * k + 1] : wa1[2 * k - 3];
            const float w1l = k < 2 ? wb0[2 * k] : wb1[2 * k - 4], w1h = k < 2 ? wb0[2 * k + 1] : wb1[2 * k - 3];
            const float w2l = k < 2 ? wc0[2 * k] : wc1[2 * k - 4], w2h = k < 2 ? wc0[2 * k + 1] : wc1[2 * k - 3];
            y[2 * k]     = bflo(sb[k]) * (w0l * (bflo(c0[k]) * bflo(h0[k])) + w1l * (bflo(c1[k]) * bflo(h1[k])) + w2l * (bflo(c2[k]) * bflo(h2[k])));
            y[2 * k + 1] = bfhi(sb[k]) * (w0h * (bfhi(c0[k]) * bfhi(h0[k])) + w1h * (bfhi(c1[k]) * bfhi(h1[k])) + w2h * (bfhi(c2[k]) * bfhi(h2[k]))); }
        u32x4 o; o.x = cvtpk(y[0], y[1]); o.y = cvtpk(y[2], y[3]); o.z = cvtpk(y[4], y[5]); o.w = cvtpk(y[6], y[7]);
        *(u32x4*)(ysc + (size_t)t * 512 + c8 * 8) = o;
    }
}

DI unsigned ord_key(float v, int idx) { unsigned u = __builtin_bit_cast(unsigned, v); u ^= (u >> 31) ? 0xFFFFFFFFu : 0x80000000u; return (u & 0xFFFFFF80u) | (unsigned)(127 - idx); }
DI float key_val(unsigned k) { unsigned u = k & 0xFFFFFF80u; u = (u & 0x80000000u) ? (u ^ 0x80000000u) : ~u; return __builtin_bit_cast(float, u); }
DI float dot2bf(unsigned a, unsigned b, float c) { return __builtin_amdgcn_fdot2_f32_bf16(__builtin_bit_cast(bf16x2_t, a), __builtin_bit_cast(bf16x2_t, b), c, false); }
DI float dot8(const u32x4& a, const u32x4& b, float c) { c = dot2bf(a.x, b.x, c); c = dot2bf(a.y, b.y, c); c = dot2bf(a.z, b.z, c); return dot2bf(a.w, b.w, c); }
__host__ __device__ constexpr int cand_off(int i) { return i == 0 ? 0 : i == 1 ? 16 : i == 2 ? 24 : i == 3 ? 29 : i == 4 ? 33 : i == 5 ? 36 : i == 6 ? 38 : i == 7 ? 40 : 34 + i; }
__host__ __device__ constexpr int cand_i(int c) { return c < 16 ? 0 : c < 24 ? 1 : c < 29 ? 2 : c < 33 ? 3 : c < 36 ? 4 : c < 38 ? 5 : c < 40 ? 6 : c < 42 ? 7 : c - 34; }
__host__ __device__ constexpr int cand_pos(int c) { return cand_i(c) * 16 + (c - cand_off(cand_i(c))); }

#define PEER_CE(i, j) do { const unsigned hi_ = max(k[i], k[j]), lo_ = min(k[i], k[j]); k[i] = hi_; k[j] = lo_; } while (0)
DI void peer_topk_first(const float* srow, LAS float* ssc, LAS int* six, int lane) {
    const int gq = lane >> 4, li = lane & 15;
    const float* sl = srow + (gq >> 1) * 256 + (gq & 1) * 128 + li * 8;
    f32x4 nva = *(const f32x4*)sl, nvb = *(const f32x4*)(sl + 4);
#pragma unroll 1
    for (int hp = 0; hp < 4; ++hp) {
        const f32x4 va = nva, vb = nvb;
        if (hp < 3) { nva = *(const f32x4*)(sl + 512 * (hp + 1)); nvb = *(const f32x4*)(sl + 512 * (hp + 1) + 4); }
        unsigned k[8];
        k[0] = ord_key(va.x, li * 8 + 0); k[1] = ord_key(va.y, li * 8 + 1); k[2] = ord_key(va.z, li * 8 + 2); k[3] = ord_key(va.w, li * 8 + 3);
        k[4] = ord_key(vb.x, li * 8 + 4); k[5] = ord_key(vb.y, li * 8 + 5); k[6] = ord_key(vb.z, li * 8 + 6); k[7] = ord_key(vb.w, li * 8 + 7);
        PEER_CE(0, 1); PEER_CE(2, 3); PEER_CE(4, 5); PEER_CE(6, 7); PEER_CE(0, 2); PEER_CE(1, 3); PEER_CE(4, 6); PEER_CE(5, 7); PEER_CE(1, 2); PEER_CE(5, 6);
        PEER_CE(0, 4); PEER_CE(1, 5); PEER_CE(2, 6); PEER_CE(3, 7); PEER_CE(2, 4); PEER_CE(3, 5); PEER_CE(1, 2); PEER_CE(3, 4); PEER_CE(5, 6);
        unsigned mine = 0u;
#pragma unroll
        for (int rd = 0; rd < 16; ++rd) {
            const unsigned m = row_max16(k[0]);
            mine = (li == rd) ? m : mine;
            const bool wn = (k[0] == m);
            k[0] = wn ? k[1] : k[0]; k[1] = wn ? k[2] : k[1]; k[2] = wn ? k[3] : k[2]; k[3] = wn ? k[4] : k[3];
            k[4] = wn ? k[5] : k[4]; k[5] = wn ? k[6] : k[5]; k[6] = wn ? k[7] : k[6]; k[7] = wn ? 0u : k[7];
        }
        const int o = ((2 * hp + (gq >> 1)) * 2 + (gq & 1)) * 16 + li;
        ssc[o] = key_val(mine); six[o] = 127 - (int)(mine & 127u);
    }
}
DI void peer_topk_second(const LAS float* ssc, const LAS int* six, LAS int* widx, LAS float* wgate, int lane, int emask) {
    const int ci = cand_i(lane), cj = lane - cand_off(ci); const bool cvalid = lane < 50;
    const int a16 = (lane ^ 16) << 2, a32 = (lane ^ 32) << 2;
#pragma unroll 2
    for (int hd = 0; hd < 8; ++hd) {
        const float a = ssc[(hd * 2) * 16 + ci], bq = ssc[(hd * 2 + 1) * 16 + cj];
        const int ia = six[(hd * 2) * 16 + ci], ib = six[(hd * 2 + 1) * 16 + cj];
        const float cs = a + bq;
        unsigned ck = __builtin_bit_cast(unsigned, cs); ck ^= (ck >> 31) ? 0xFFFFFFFFu : 0x80000000u; ck = cvalid ? ((ck & ~63u) | (unsigned)(63 - lane)) : 0u;
        int rank = 0;
#pragma unroll
        for (int c2 = 0; c2 < 50; ++c2) { const unsigned k2 = (unsigned)__builtin_amdgcn_readlane((int)ck, c2); rank += (int)(k2 > ck); }
        const bool sel = cvalid && rank < 16;
        const float mx = __builtin_bit_cast(float, __builtin_amdgcn_readlane(__builtin_bit_cast(int, cs), 0));
        const float ev = sel ? __builtin_amdgcn_exp2f((cs - mx) * 1.4426950408889634f) : 0.f;
        float sum = row_sum16(ev); sum += bperm_f(a16, sum); sum += bperm_f(a32, sum);
        if (sel) { widx[hd * 16 + rank] = ((ia * 128 + ib) & emask) * 512  ; wgate[hd * 16 + rank] = ev * __builtin_amdgcn_rcpf(sum); }
    }
}
#undef PEER_CE

constexpr float PEER_QSTEP = 0.35f;
constexpr float PEER_U_SCALE = 32.0f / PEER_QSTEP;
constexpr float PEER_UF4_SCALE = 64.0f;
constexpr float PEER_H4_SCALE = 2.0f;
#ifndef PROBE_NODMA
#define PROBE_NODMA 0
#endif
#ifndef PROBE_EMASK
#define PROBE_EMASK 16383
#endif
#ifndef PEER_VARIANT
#define PEER_VARIANT 0
#endif
#ifndef PEER_R
#define PEER_R 16
#endif
#if PEER_R == 32
#define PEER_RM4 28
#elif PEER_R == 16
#define PEER_RM4 12
#elif PEER_R == 64
#define PEER_RM4 60
#endif
constexpr int PEER_NPROD = 2, PEER_NCONS = 8 - PEER_NPROD, PEER_CPP = PEER_NCONS / PEER_NPROD;
constexpr int PEER_SLOT_BYTES = 2048;
constexpr int PEER_FLAG_OFF = PEER_NCONS * 2 * PEER_SLOT_BYTES, PEER_PRIV_OFF = PEER_FLAG_OFF + 64, PEER_PRIV_BYTES = 2560, PEER_RING_OFF = 40960;
static_assert(PEER_PRIV_OFF + PEER_NCONS * PEER_PRIV_BYTES <= PEER_RING_OFF && PEER_RING_OFF + PEER_NCONS * PEER_R * 1024 <= MISC_OFF && PEER_R <= 64 && (PEER_R & (PEER_R - 1)) == 0 && PEER_NCONS % PEER_NPROD == 0, "PEER LDS map");
DI void glds16(const void* gsrc, unsigned lds_dst) { unsigned keep;
    asm volatile("s_mov_b32 %0, m0\n\ts_mov_b32 m0, %2\n\ts_nop 0\n\tglobal_load_lds_dwordx4 %1, off\n\ts_mov_b32 m0, %0" : "=&s"(keep) : "v"(gsrc), "s"(lds_dst) : "memory"); }
DI void glds16s(const void* sbase, unsigned voff, unsigned lds_dst) { unsigned keep;
    asm volatile("s_mov_b32 %0, m0\n\ts_mov_b32 m0, %3\n\ts_nop 0\n\tglobal_load_lds_dwordx4 %1, %2\n\ts_mov_b32 m0, %0" : "=&s"(keep) : "v"(voff), "s"(sbase), "s"(lds_dst) : "memory"); }
DI void glds16s_x4(const void* sbase, unsigned v0, unsigned v1, unsigned v2, unsigned v3, unsigned lds_dst) { unsigned keep;
    asm volatile("s_mov_b32 %0, m0\n\ts_mov_b32 m0, %6\n\ts_nop 0\n\tglobal_load_lds_dwordx4 %1, %5\n\tglobal_load_lds_dwordx4 %2, %5 offset:1024\n\tglobal_load_lds_dwordx4 %3, %5 offset:2048\n\tglobal_load_lds_dwordx4 %4, %5 offset:3072\n\ts_mov_b32 m0, %0"
                 : "=&s"(keep) : "v"(v0), "v"(v1), "v"(v2), "v"(v3), "s"(sbase), "s"(lds_dst) : "memory"); }
#define PEER_STR2(x) #x
#define PEER_STR(x) PEER_STR2(x)
typedef int i32x4 __attribute__((ext_vector_type(4)));
typedef int i32x8 __attribute__((ext_vector_type(8)));
DI void peer_phase(Frame& F, int tg, bool dry) {
    F.refresh();
    __syncthreads();
    const int lane = F.lane, wv = F.wave;
    volatile LAS unsigned* flags = (volatile LAS unsigned*)(F.lds + PEER_FLAG_OFF);
    if (F.tid < 2 * PEER_NCONS) flags[F.tid] = 0u;
    __syncthreads();
    const int NPG = F.G * PEER_NPROD;
    if (wv < PEER_NPROD) {
        const int pg = F.vcu * PEER_NPROD + wv;
        int i = 0;
        for (int tl = pg; tl < TG; tl += NPG, ++i) {
            float tch0 = 0.f;
            if (tl + NPG < TG) tch0 = ((const float*)(F.ws + WS_S) + (size_t)(tl + NPG) * 2048)[lane * 32];
            const int cidx = wv * PEER_CPP + (i % PEER_CPP), slot = (i / PEER_CPP) & 1;
            LAS float* ssc = (LAS float*)(F.lds + (cidx * 2 + slot) * PEER_SLOT_BYTES); LAS int* six = (LAS int*)(F.lds + (cidx * 2 + slot) * PEER_SLOT_BYTES + 1024);
            while (flags[cidx * 2 + slot] != 0u) __builtin_amdgcn_s_sleep(2);
            asm volatile("" ::: "memory");
            peer_topk_first((const float*)(F.ws + WS_S) + (size_t)tl * 2048, ssc, six, lane);
            asm volatile("s_waitcnt lgkmcnt(0)" :: "v"(tch0) : "memory");
            if (lane == 0) flags[cidx * 2 + slot] = 1u;
        }
    } else {
        const unsigned char* Ub = F.ws + WS_U; const unsigned char* Vb = F.ws + WS_V; const unsigned lo16 = 16u * (unsigned)(lane & 31);
        const int a16 = (lane ^ 16) << 2, a32 = (lane ^ 32) << 2; const int grp = lane >> 4;
        const int cidx = wv - PEER_NPROD, myprod = cidx / PEER_CPP, myr = cidx % PEER_CPP;
        LAS int* sidx = (LAS int*)(F.lds + PEER_PRIV_OFF + cidx * PEER_PRIV_BYTES); LAS float* sgate = (LAS float*)(F.lds + PEER_PRIV_OFF + cidx * PEER_PRIV_BYTES + 512);
        LAS float* ccf = (LAS float*)(F.lds + PEER_PRIV_OFF + cidx * PEER_PRIV_BYTES + 1024);
        LAS unsigned char* ring = F.lds + PEER_RING_OFF + cidx * (PEER_R * 1024);
        const unsigned ringb = (unsigned)(uintptr_t)ring;
        LAS unsigned char* hrow = F.lds + PEER_PRIV_OFF + cidx * PEER_PRIV_BYTES + 1536;
        unsigned usw[4];
#pragma unroll
        for (int q = 0; q < 4; ++q) usw[q] = 16u * (unsigned)((lane & 31) ^ (2 * q + (lane >> 5))) + (4096u - 1024u * q);
        const LAS unsigned char* uadr[4];
#pragma unroll
        for (int j = 0; j < 4; ++j) uadr[j] = ring + (lane & 15) * 512 + 64 * (j ^ ((lane & 15) >> 2)) + 16 * (grp ^ (lane & 3));
        const int pg = F.vcu * PEER_NPROD + myprod, TSTEP = NPG * PEER_CPP;
        int kslot = 0;
        for (int tl = pg + myr * NPG; tl < TG; tl += TSTEP, ++kslot) {
            const size_t t = (size_t)tg * TG + tl;
            float tch1 = 0.f, tch2 = 0.f, tch3 = 0.f;
            if (tl + TSTEP < TG) { const size_t tn = t + TSTEP; tch1 = (F.out + tn * 1024)[(lane & 31) * 32];
                tch2 = ((const float*)((const bf16*)(F.ws + WS_XG) + tn * 1024))[(lane & 15) * 32]; tch3 = ((const float*)(F.ws + WS_SSP) + tn * 16)[lane & 15]; }
            const f32x4* sp = (const f32x4*)((const float*)(F.ws + WS_SSP) + t * 16);
            const f32x4 s0 = sp[0], s1 = sp[1], s2 = sp[2], s3 = sp[3];
            const float ssx = ((s0[0] + s0[1]) + (s0[2] + s0[3])) + ((s1[0] + s1[1]) + (s1[2] + s1[3])) + ((s2[0] + s2[1]) + (s2[2] + s2[3])) + ((s3[0] + s3[1]) + (s3[2] + s3[3]));
            const float hs = __builtin_amdgcn_rsqf(ssx * (1.0f / 1024.0f) + EPS) * PEER_H4_SCALE;
            { const bf16* xr = (const bf16*)(F.ws + WS_XG) + t * 1024 + 16 * lane; const u32x4 w0 = *(const u32x4*)xr, w1 = *(const u32x4*)(xr + 8);
              u32x2 hq;
              hq.x = __builtin_amdgcn_cvt_scalef32_pk_fp4_f32(0u, bflo(w0[0]) * hs, bfhi(w0[0]) * hs, 1.0f, 0); hq.x = __builtin_amdgcn_cvt_scalef32_pk_fp4_f32(hq.x, bflo(w0[1]) * hs, bfhi(w0[1]) * hs, 1.0f, 1);
              hq.x = __builtin_amdgcn_cvt_scalef32_pk_fp4_f32(hq.x, bflo(w0[2]) * hs, bfhi(w0[2]) * hs, 1.0f, 2); hq.x = __builtin_amdgcn_cvt_scalef32_pk_fp4_f32(hq.x, bflo(w0[3]) * hs, bfhi(w0[3]) * hs, 1.0f, 3);
              hq.y = __builtin_amdgcn_cvt_scalef32_pk_fp4_f32(0u, bflo(w1[0]) * hs, bfhi(w1[0]) * hs, 1.0f, 0); hq.y = __builtin_amdgcn_cvt_scalef32_pk_fp4_f32(hq.y, bflo(w1[1]) * hs, bfhi(w1[1]) * hs, 1.0f, 1);
              hq.y = __builtin_amdgcn_cvt_scalef32_pk_fp4_f32(hq.y, bflo(w1[2]) * hs, bfhi(w1[2]) * hs, 1.0f, 2); hq.y = __builtin_amdgcn_cvt_scalef32_pk_fp4_f32(hq.y, bflo(w1[3]) * hs, bfhi(w1[3]) * hs, 1.0f, 3);
              *(LAS u32x2*)(hrow + 8 * lane) = hq; }
            const float ascale = 1.0f / (PEER_H4_SCALE * PEER_UF4_SCALE);
            const int slot = kslot & 1;
            while (flags[cidx * 2 + slot] != 1u) __builtin_amdgcn_s_sleep(2);
            asm volatile("" ::: "memory");
            peer_topk_second((const LAS float*)(F.lds + (cidx * 2 + slot) * PEER_SLOT_BYTES), (const LAS int*)(F.lds + (cidx * 2 + slot) * PEER_SLOT_BYTES + 1024), sidx, sgate, lane, dry ? PROBE_EMASK : 16383);
            asm volatile("s_waitcnt lgkmcnt(0)" ::: "memory");
            if (lane == 0) flags[cidx * 2 + slot] = 0u;
#define PEER_ISSUE4V(pp0) do { if (PROBE_NODMA && dry) break; const int pp_ = (pp0); const LAS int* ip_ = sidx + 2 * (pp_ & 63) + (lane >> 5); \
                const unsigned v0_ = (unsigned)ip_[0] + lo16 + 4096u, v1_ = (unsigned)ip_[2] + lo16 + 3072u, v2_ = (unsigned)ip_[4] + lo16 + 2048u, v3_ = (unsigned)ip_[6] + lo16 + 1024u; \
                glds16s_x4(Vb - 4096, v0_, v1_, v2_, v3_, (unsigned)__builtin_amdgcn_readfirstlane((int)(ringb + (unsigned)(pp_ & (PEER_R - 1)) * 1024u))); } while (0)
#define PEER_ISSUE4U(pp0, hi8) do { if (PROBE_NODMA && dry) break; const int pp_ = (pp0); const LAS int* ip_ = sidx + 2 * pp_ + (lane >> 5); \
                const unsigned v0_ = (unsigned)ip_[0] + (usw[0] ^ (hi8)), v1_ = (unsigned)ip_[2] + (usw[1] ^ (hi8)), v2_ = (unsigned)ip_[4] + (usw[2] ^ (hi8)), v3_ = (unsigned)ip_[6] + (usw[3] ^ (hi8)); \
                glds16s_x4(Ub - 4096, v0_, v1_, v2_, v3_, (unsigned)__builtin_amdgcn_readfirstlane((int)(ringb + (unsigned)(pp_ & (PEER_R - 1)) * 1024u))); } while (0)
            PEER_ISSUE4U(0, 0u); PEER_ISSUE4U(4, 128u); PEER_ISSUE4U(8, 0u); PEER_ISSUE4U(12, 128u);
            i32x4 hA[8];
#pragma unroll
            for (int ks = 0; ks < 8; ++ks) hA[ks] = *(const LAS i32x4*)(hrow + 64 * ks + 16 * grp);
            float dotA = 0.f, dotB = 0.f;
#pragma unroll 1
            for (int tp = 0; tp < 4; ++tp) {
#pragma unroll
                for (int par = 0; par < 2; ++par) { const int tt = 2 * tp + par;
                    asm volatile("s_waitcnt vmcnt(8)" ::: "memory");
                    f32x4 acc = {0.f, 0.f, 0.f, 0.f};
#pragma unroll
                    for (int ks = 0; ks < 8; ++ks) { const i32x4 b_ = *(const LAS i32x4*)(uadr[ks & 3] + 256 * (ks >> 2) + 8192 * par);
                        const i32x8 b8_ = {b_.x, b_.y, b_.z, b_.w, 0, 0, 0, 0};
                        const i32x8 a8_ = {hA[ks].x, hA[ks].y, hA[ks].z, hA[ks].w, 0, 0, 0, 0};
                        acc = __builtin_amdgcn_mfma_scale_f32_16x16x128_f8f6f4(a8_, b8_, acc, 4  , 4  , 0, 127, 0, 127); }
                    dotA = (tt == grp) ? acc[0] : dotA; dotB = (tt == grp + 4) ? acc[0] : dotB;
                    __builtin_amdgcn_sched_barrier(0);
                    if (tp < 3) { PEER_ISSUE4U(8 * tt + 16, 0u); PEER_ISSUE4U(8 * tt + 20, 128u); } else { PEER_ISSUE4V(64 + 8 * par); PEER_ISSUE4V(64 + 8 * par + 4); }
                    __builtin_amdgcn_sched_barrier(0); }
            }
            { const float av = dotA * ascale; ccf[lane] = sgate[lane] * (0.5f * av * (1.0f + erff(av * 0.70710678118654752f))); }
            { const float av = dotB * ascale; ccf[64 + lane] = sgate[64 + lane] * (0.5f * av * (1.0f + erff(av * 0.70710678118654752f))); }
            asm volatile("s_waitcnt lgkmcnt(0)" ::: "memory");
            float* xo = F.out + t * 1024 + lane;
            float* xst = dry ? (float*)(F.ws + WS_PROJ + (128u << 20)) + (size_t)tl * 1024 + lane : xo;
            float xa[16];
#pragma unroll
            for (int cb = 0; cb < 16; ++cb) xa[cb] = xo[64 * cb];
            float oacc[16];
#pragma unroll
            for (int cb = 0; cb < 16; ++cb) oacc[cb] = 0.f;
            typedef int i32x2 __attribute__((ext_vector_type(2)));
#pragma unroll 1
            for (int vb = 0; vb < 8; ++vb) {
                if (vb < 7) asm volatile("s_waitcnt vmcnt(8)" ::: "memory"); else asm volatile("s_waitcnt vmcnt(0)" ::: "memory");
                const float cj = ccf[16 * vb + (lane & 15)];
                const float cmx = __builtin_bit_cast(float, row_max16(__builtin_bit_cast(unsigned, fabsf(cj))));
                const float qs = cmx > 0.f ? 7.0f * __builtin_amdgcn_rcpf(cmx) : 0.f;
                const unsigned cq = (unsigned)(int)__builtin_rintf(cj * qs) & 15u;
                unsigned clo = (lane & 8) ? 0u : cq << (4 * (lane & 7)), chi = (lane & 8) ? cq << (4 * (lane & 7)) : 0u;
                clo |= dpp_u<0xB1>(clo); clo |= dpp_u<0x4E>(clo); clo |= dpp_u<0x141>(clo); clo |= dpp_u<0x140>(clo);
                chi |= dpp_u<0xB1>(chi); chi |= dpp_u<0x4E>(chi); chi |= dpp_u<0x141>(chi); chi |= dpp_u<0x140>(chi);
                const float bsc = cmx * (1.0f / 7.0f);
                const LAS unsigned char* rowp = ring + (16 * (vb & 1) + (lane & 15)) * 512 + 8 * (lane >> 4);
#pragma unroll
                for (int cb = 0; cb < 16; ++cb) {
                    const i32x2 tr = __builtin_amdgcn_ds_read_tr4_b64_v2i32((LAS i32x2*)(rowp + 32 * cb));
                    const int ai = __builtin_amdgcn_sdot8((int)chi, tr.y, __builtin_amdgcn_sdot8((int)clo, tr.x, 0, false), false);
                    oacc[cb] += (float)ai * bsc;
                }
                if (vb < 6) { PEER_ISSUE4V(64 + 8 * vb + 16); PEER_ISSUE4V(64 + 8 * vb + 20); }
            }
#undef PEER_ISSUE4U
#undef PEER_ISSUE4V
            const float* gfp = F.final_norm_g + lane;
            float ss = 0.f;
#pragma unroll
            for (int cb = 0; cb < 16; ++cb) { xa[cb] = xa[cb] + oacc[cb] * (1.0f / PEER_U_SCALE); ss += xa[cb] * xa[cb]; }
            ss = row_sum16(ss); ss += bperm_f(a16, ss); ss += bperm_f(a32, ss);
            const float rf = __builtin_amdgcn_rsqf(ss * (1.0f / 1024.0f) + EPS);
#pragma unroll
            for (int cb = 0; cb < 16; ++cb) xst[64 * cb] = xa[cb] * rf * gfp[64 * cb];
            asm volatile("" :: "v"(tch1), "v"(tch2), "v"(tch3));
        }
    }
}

DI void convert_uv(Frame& F, int part, int nparts, int cu, int ncu) {
    F.refresh();
    const int gt = cu * 512 + F.tid, NGT = ncu * 512, per = (2 * 16384 * 64) / nparts;
    for (int id = part * per + gt; id < (part + 1) * per; id += NGT) {
        const int which = id >> 20, off = (id & ((1 << 20) - 1)) * 16;
        const float* src = (which ? F.peer_v : F.peer_u) + off; unsigned char* dst = F.ws + (which ? WS_V : WS_U) + off / 2;
        u32x2 o;
        if (which == 0) {
#pragma unroll
            for (int q = 0; q < 2; ++q) { const f32x4 v0 = *(const f32x4*)(src + 8 * q) * PEER_UF4_SCALE, v1 = *(const f32x4*)(src + 8 * q + 4) * PEER_UF4_SCALE;
                unsigned pk = __builtin_amdgcn_cvt_scalef32_pk_fp4_f32(0u, v0.x, v0.y, 1.0f, 0); pk = __builtin_amdgcn_cvt_scalef32_pk_fp4_f32(pk, v0.z, v0.w, 1.0f, 1);
                pk = __builtin_amdgcn_cvt_scalef32_pk_fp4_f32(pk, v1.x, v1.y, 1.0f, 2); pk = __builtin_amdgcn_cvt_scalef32_pk_fp4_f32(pk, v1.z, v1.w, 1.0f, 3); o[q] = pk; }
        } else {
#pragma unroll
            for (int q = 0; q < 2; ++q) { const f32x4 v0 = *(const f32x4*)(src + 8 * q) * PEER_U_SCALE, v1 = *(const f32x4*)(src + 8 * q + 4) * PEER_U_SCALE; unsigned pk = 0u;
#pragma unroll
                for (int k = 0; k < 4; ++k) { pk |= ((unsigned)(int)__builtin_rintf(fminf(fmaxf(v0[k], -7.f), 7.f)) & 15u) << (4 * k); pk |= ((unsigned)(int)__builtin_rintf(fminf(fmaxf(v1[k], -7.f), 7.f)) & 15u) << (16 + 4 * k); }
                o[q] = pk; }
        }
        *(u32x2*)dst = o;
    }
}

constexpr int N_PHASES = 19;
struct Args { const float* in[17]; float* out; unsigned char* ws; int ph_lo, ph_hi; };

__global__ void __launch_bounds__(NWAVES * 64, 2) fwd_kernel(Args args) {
    extern __shared__ __attribute__((aligned(16))) unsigned char lds_raw[];
    Frame F;
    F.lds = (LAS unsigned char*)lds_raw;
    F.tid = threadIdx.x; F.lane = F.tid & 63; F.wave = __builtin_amdgcn_readfirstlane(F.tid >> 6);
    F.G = gridDim.x; { const int bx = blockIdx.x; F.vcu = (F.G % 8 == 0) ? (bx % 8) * (F.G / 8) + bx / 8 : bx; }
    F.x = args.in[0]; F.mem = args.in[1]; F.norm_mix_g = args.in[2]; F.w_in = args.in[3]; F.hg_lb = args.in[4]; F.hg_norm_g = args.in[5]; F.sc_conv_w = args.in[6];
    F.mem_norm_g = args.in[7]; F.w_mem_kv = args.in[8]; F.w_branch = args.in[9]; F.w_out = args.in[10]; F.norm_ffn_g = args.in[11]; F.peer_w_q = args.in[12];
    F.peer_sub_keys = args.in[13]; F.peer_u = args.in[14]; F.peer_v = args.in[15]; F.final_norm_g = args.in[16];
    F.out = args.out; F.ws = args.ws;
    volatile LAS unsigned* MISC = (volatile LAS unsigned*)(F.lds + MISC_OFF);
    for (int u = F.tid; u < (LDS_BYTES - MISC_OFF) / 4; u += NWAVES * 64) MISC[u] = 0u;
    __syncthreads();
    unsigned* barw = (unsigned*)(F.ws + WS_CTL) + CW_BAR;
    XcdBarrier bar; bar.bar = barw; bar.x = 0; bar.st = nullptr;
    const bool one_launch = (args.ph_hi - args.ph_lo) > 1;
    if (one_launch) bar = xcd_barrier_post(barw, MISC + 8);
    const int lo = args.ph_lo, hi = args.ph_hi;
#define IN(k) (lo <= (k) && (k) < hi)
#ifndef PMASK
#define PMASK 0x3ff
#endif
#define PC_(c) ((PMASK >> (c)) & 1)
#ifndef REP_MASK
#define REP_MASK 0
#endif
#define REPS(c) for (int rep_ = 0; rep_ < 1 + 2 * ((REP_MASK >> (c)) & 1); ++rep_)
#define SEAM(k) do { if (IN(k) && IN((k) + 1)) xcd_barrier(bar); } while (0)
    unsigned char* ws = F.ws;
    const int G = F.G, cid = (int)blockIdx.x;

    if (PC_(0) && IN(0)) { REPS(0) p0_prologue(F); } SEAM(0);

#pragma unroll 1
    for (int g = 0; g < NGRP; ++g) {
        const int pb = 1 + 6 * g;
        if (PC_(1) && IN(pb)) REPS(1) {
            pg8::InOrder S; S.init(TG, PC, G, cid); S.H = (const char*)(ws + WS_XG) + (size_t)g * TG * 1024 * 2; S.Win = (const char*)(ws + WS_WIN); S.Mn = (const char*)(ws + WS_MN); S.Wkv = (const char*)(ws + WS_WKV); S.n_extra = (g == 0) ? 64 : 0;
            pg8::EpiIn E{(bf16*)(ws + WS_PROJ), (bf16*)(ws + WS_KMEM), (bf16*)(ws + WS_VT)};
            pg8::gemm_phase<pg8::EpiIn, pg8::InOrder, true, true>(F.lds, pg8::Gemm{1024, 1024, 1024}, S, E);
            if (cid >= 128) convert_uv(F, g, NGRP, cid - 128, G - 128);
        } SEAM(pb);
        if (PC_(2) && IN(pb + 1)) REPS(2) {
            for (int it = F.vcu * 4; it < BG * 4 * NCHUNK; it += G * 4) { for (int k = 0; k < 4; ++k) hgrn_a_item(F, it + k, k < 3); }
            for (int it = F.vcu; it < BG * 4 * 8; it += G) attn_item(F, g, it);
            conv_phase(F);
        } SEAM(pb + 1);
        if (PC_(3) && IN(pb + 2)) { REPS(3) hgrn_scan(F); } SEAM(pb + 2);
        if (PC_(4) && IN(pb + 3)) REPS(4) { for (int it = F.vcu * 4; it < BG * 4 * NCHUNK; it += G * 4) { for (int k = 0; k < 4; ++k) hgrn_c_item(F, it + k, k < 3); } } SEAM(pb + 3);
        if (PC_(5) && IN(pb + 4)) REPS(5) {
            pg8::BranchOrder S; S.init(TG, 1024, G, cid); S.Y = (const char*)(ws + WS_YHG); S.Wb = (const char*)(ws + WS_WBR);
            pg8::EpiBranch E{(const bf16*)(ws + WS_PROJ), (bf16*)(ws + WS_MACC), (bf16*)(ws + WS_MERGED)};
            pg8::gemm_phase<pg8::EpiBranch, pg8::BranchOrder, true, true>(F.lds, pg8::Gemm{512, 512, 512}, S, E);
        } SEAM(pb + 4);
        if (PC_(6) && IN(pb + 5)) REPS(6) {
            pg8::PlainOrder S; S.init(TG, 1024, G, cid); S.A = (const char*)(ws + WS_MERGED); S.Bt = (const char*)(ws + WS_WOUT); S.a_tile = 256 * 1024 * 2; S.b_tile = 256 * 1024 * 2;
            pg8::EpiOut E{F.x + (size_t)g * TG * 1024, F.out + (size_t)g * TG * 1024, (bf16*)(ws + WS_XG) + (size_t)g * TG * 1024, F.norm_ffn_g, (float*)(ws + WS_SSP) + (size_t)g * TG * 16};
            pg8::gemm_phase<pg8::EpiOut, pg8::PlainOrder, true, true>(F.lds, pg8::Gemm{1024, 1024, 1024}, S, E);
        } SEAM(pb + 5);
    }
#pragma unroll 1
    for (int tg = 0; tg < NGRP; ++tg) {
        const int pb = 13 + 3 * tg;
        if (PC_(7) && IN(pb)) REPS(7) {
            pg8::PlainOrder S; S.init(TG, 2048, G, cid); S.A = (const char*)(ws + WS_XG) + (size_t)tg * TG * 1024 * 2; S.Bt = (const char*)(ws + WS_WQ); S.a_tile = 256 * 1024 * 2; S.b_tile = 256 * 1024 * 2;
            pg8::EpiQ E{(bf16*)(ws + WS_Q), 2048, (const float*)(ws + WS_SSP) + (size_t)tg * TG * 16};
            pg8::gemm_phase<pg8::EpiQ, pg8::PlainOrder, true, true>(F.lds, pg8::Gemm{1024, 1024, 1024}, S, E);
        } SEAM(pb);
        if (PC_(8) && IN(pb + 1)) REPS(8) {
            pg8::ScoreOrder S; S.init(TG, 2048, G, cid); S.Q = (const char*)(ws + WS_Q); S.Kbd = (const char*)(ws + WS_KBD);
            pg8::EpiF32 E{(float*)(ws + WS_S), 2048};
            pg8::gemm_phase<pg8::EpiF32, pg8::ScoreOrder, true, true>(F.lds, pg8::Gemm{2048, 256, 256}, S, E);
        } SEAM(pb + 1);
        if (PC_(9) && IN(pb + 2)) { REPS(9) peer_phase(F, tg, rep_ < 2 * ((REP_MASK >> 9) & 1)); } SEAM(pb + 2);
    }
#undef IN
#undef SEAM
}

extern "C" void kernel_launch(void* const* d_in, const int* in_sizes, int n_in, void* d_out, int out_size, void* d_ws, size_t ws_size, hipStream_t stream) {
    static int ready = 0;
    if (ready == 0) {
        if (n_in != 17 || out_size != T_ALL * D_MODEL || ws_size < WS_END) { fprintf(stderr, "kernel_launch: unexpected shapes (n_in %d, out %d, ws %zu)\n", n_in, out_size, ws_size); ready = -1; return; }
        if (hipFuncSetAttribute((const void*)fwd_kernel, hipFuncAttributeMaxDynamicSharedMemorySize, LDS_BYTES) != hipSuccess) { fprintf(stderr, "kernel_launch: hipFuncSetAttribute failed\n"); ready = -1; return; }
        ready = 1;
    }
    if (ready < 0) return;
    (void)hipMemsetAsync((char*)d_ws + WS_CTL, 0, CTL_ZERO_BYTES, stream);
    Args a{};
    for (int i = 0; i < 17; ++i) a.in[i] = (const float*)d_in[i];
    a.out = (float*)d_out; a.ws = (unsigned char*)d_ws;
    const int grid = 256;
#if MK_N_LAUNCHES == 1
    a.ph_lo = 0; a.ph_hi = N_PHASES;
    hipLaunchKernelGGL(fwd_kernel, dim3(grid), dim3(NWAVES * 64), LDS_BYTES, stream, a);
#else
    for (int li = 0; li < N_PHASES; ++li) { a.ph_lo = li; a.ph_hi = li + 1; hipLaunchKernelGGL(fwd_kernel, dim3(grid), dim3(NWAVES * 64), LDS_BYTES, stream, a); }
#endif
}
```

```cpp
#include <hip/hip_runtime.h>
#include <cstdio>
#include <cstdint>

#ifndef MK_N_LAUNCHES
#define MK_N_LAUNCHES 1
#endif

#define LAS __attribute__((address_space(3)))
#define GAS __attribute__((address_space(1)))
typedef unsigned short bf16;
typedef short bf16x8 __attribute__((ext_vector_type(8)));
typedef short s16x4 __attribute__((ext_vector_type(4)));
typedef short v4i16_t __attribute__((ext_vector_type(4)));
typedef float f32x2 __attribute__((ext_vector_type(2)));
typedef float f32x4 __attribute__((ext_vector_type(4)));
typedef float f32x16 __attribute__((ext_vector_type(16)));
typedef unsigned u32x2 __attribute__((ext_vector_type(2)));
typedef unsigned u32x4 __attribute__((ext_vector_type(4)));
typedef __bf16 bf16x2_t __attribute__((ext_vector_type(2)));
typedef GAS unsigned gu32;
#define RLX_AGENT __ATOMIC_RELAXED, __HIP_MEMORY_SCOPE_AGENT
#define DI __device__ __forceinline__

constexpr int D_MODEL = 1024, BATCH = 16, SEQ = 2048, T_ALL = BATCH * SEQ;
constexpr int NGRP = 2, BG = BATCH / NGRP, TG = BG * SEQ;
constexpr int PC = 7680;
constexpr int C_HQ = 0, C_HI = 512, C_FF = 1024, C_FB = 1536, C_HG = 2048, C_SB = 2560, C_SC = 3072, C_SH = 3584, C_MQ = 4096, C_GATE = 4608;
constexpr int NMEM = 256, CHUNK = 64, NCHUNK = SEQ / CHUNK;
constexpr float EPS = 1e-6f;

constexpr size_t MiB = 1u << 20;
constexpr size_t WS_CTL = 0, CTL_ZERO_BYTES = 1 * MiB;
constexpr size_t WS_LB = 1 * MiB;
constexpr size_t WS_SSP = 2 * MiB;
constexpr size_t WS_DEC = 4 * MiB;
constexpr size_t WS_WIN = 5 * MiB, WS_WKV = 20 * MiB, WS_WBR = 22 * MiB, WS_WOUT = 25 * MiB, WS_WQ = 27 * MiB, WS_KBD = 31 * MiB;
constexpr size_t WS_MN = 32 * MiB, WS_KMEM = 40 * MiB, WS_VT = 44 * MiB;
constexpr size_t WS_XG = 48 * MiB;
constexpr size_t WS_YHG = 112 * MiB, WS_YSC = 128 * MiB, WS_YMX = 144 * MiB;
constexpr size_t WS_DS = 160 * MiB;
constexpr size_t WS_MACC = 160 * MiB;
constexpr size_t WS_MERGED = 224 * MiB;
constexpr size_t WS_PROJ = 256 * MiB;
constexpr size_t WS_U = 496 * MiB, WS_V = 504 * MiB;
constexpr size_t WS_Q = 176 * MiB;
constexpr size_t WS_S = 256 * MiB;
constexpr size_t WS_END = 512 * MiB;
constexpr size_t OUT_SST = 64 * MiB;

constexpr int LDS_BYTES = 160 * 1024;
constexpr int MISC_OFF = LDS_BYTES - 512;
constexpr int NWAVES = 8;

DI unsigned f2bf(float f) { unsigned u = __builtin_bit_cast(unsigned, f); return (u + 0x7fffu + ((u >> 16) & 1u)) >> 16; }
DI unsigned pk2(float lo, float hi) { return f2bf(lo) | (f2bf(hi) << 16); }
DI float bf2f(unsigned short b) { return __builtin_bit_cast(float, (unsigned)b << 16); }
DI float bflo(unsigned w) { return __builtin_bit_cast(float, w << 16); }
DI float bfhi(unsigned w) { return __builtin_bit_cast(float, w & 0xffff0000u); }
DI float wave_sum(float v) {
#pragma unroll
    for (int o = 1; o < 64; o <<= 1) v += __shfl_xor(v, o);
    return v;
}
DI unsigned cvtpk(float lo, float hi) { f32x2 v = {lo, hi}; bf16x2_t b = __builtin_convertvector(v, bf16x2_t); return __builtin_bit_cast(unsigned, b); }
template <int CTRL> DI unsigned dpp_u(unsigned v) { return (unsigned)__builtin_amdgcn_update_dpp(0, (int)v, CTRL, 0xF, 0xF, false); }
template <int CTRL> DI float dpp_f(float v) { return __builtin_bit_cast(float, __builtin_amdgcn_update_dpp(0, __builtin_bit_cast(int, v), CTRL, 0xF, 0xF, false)); }
DI float bperm_f(int addr, float v) { return __builtin_bit_cast(float, __builtin_amdgcn_ds_bpermute(addr, __builtin_bit_cast(int, v))); }
DI unsigned row_max16(unsigned m) { m = max(m, dpp_u<0xB1>(m)); m = max(m, dpp_u<0x4E>(m)); m = max(m, dpp_u<0x141>(m)); return max(m, dpp_u<0x140>(m)); }
DI float row_sum16(float v) { v += dpp_f<0xB1>(v); v += dpp_f<0x4E>(v); v += dpp_f<0x141>(v); return v + dpp_f<0x140>(v); }

DI float fast_sig(float z) { return __builtin_amdgcn_rcpf(1.0f + __builtin_amdgcn_exp2f(-1.4426950408889634f * z)); }
DI float sigmoidf_(float z) { return 1.0f / (1.0f + __expf(-z)); }

namespace pg8 {
constexpr int BM = 256, BK = 64, HALF = 128, HTB = HALF * BK * 2, STAGE_BYTES = 8 * HTB, NXCD = 8, WGM = 8;
__host__ __device__ __forceinline__ int lds_byte(int r, int c) { const int st = (r >> 4) * 2 + (c >> 5), rr = r & 15, cc = c & 31, ob = rr * 64 + cc * 2; return st * 1024 + (ob ^ (((ob >> 9) & 1) << 5)); }
__host__ __device__ __forceinline__ void stage_rc(int b, int& R, int& C) { const int st = b / 1024, sb = b % 1024, swz = sb ^ (((sb >> 9) & 1) << 5); R = (st >> 1) * 16 + swz / 64; C = (st & 1) * 32 + (swz % 64) / 2; }
__host__ __device__ __forceinline__ int perm32(int rho) { const int n = rho >> 4, i = rho & 15; return 8 * (i >> 2) + 4 * n + (i & 3); }

struct Unit { int pm, pn, z; };
struct Gemm { int lda, ldb, K; };

struct StaticOrder {
    int nM, nN, nwg, G, c;
    __device__ void init(int M, int N, int G_, int c_) { nM = M / BM; nN = N / BM; nwg = nM * nN; G = G_; c = c_; }
    __device__ bool tile(int i, Unit& u) const {
        const long L = (long)i * G + c; if (L >= nwg) return false;
        int wgid = (int)L; { const int q = nwg / NXCD, r = nwg % NXCD, xcd = wgid % NXCD, off = wgid / NXCD; wgid = (xcd < r ? xcd * (q + 1) : r * (q + 1) + (xcd - r) * q) + off; }
        const int nig = WGM * nN, gid = wgid / nig, fm = gid * WGM, gsz = (nM - fm) < WGM ? (nM - fm) : WGM;
        u.pm = fm + ((wgid % nig) % gsz); u.pn = (wgid % nig) / gsz; u.z = 0; return true;
    }
};

DI unsigned cvt_pk_bf16(float lo, float hi) { return cvtpk(lo, hi); }

template <class Epi, class Sched, bool ALIGN_EPI, bool SP2>
DI void gemm_phase(LAS unsigned char* lds, const Gemm g, const Sched& S, const Epi& E) {
    int tid_ = threadIdx.x; asm volatile("" : "+v"(tid_));
    const int tid = tid_, wid = __builtin_amdgcn_readfirstlane(tid >> 6), lane = tid & 63, wr = wid >> 2, wc = wid & 3, fr = lane & 15, fq = lane >> 4;
    int K_ = g.K; asm volatile("" : "+s"(K_));
    const int K = K_, nt = K / BK;
    unsigned voffA[2], voffB[2];
#pragma unroll
    for (int i = 0; i < 2; ++i) { int R, C; stage_rc(tid * 16 + i * 8192, R, C); const int Rb = Epi::PERM ? ((R & ~31) + perm32(R & 31)) : R;
        voffA[i] = (unsigned)(R * g.lda + C) * 2u; voffB[i] = (unsigned)(Rb * g.ldb + C) * 2u; }
    const size_t kstep = (size_t)(BK * 2);
    const size_t hA = (size_t)HALF * g.lda * 2, hB = (size_t)HALF * g.ldb * 2;
    const unsigned ldsw = (unsigned)wid * 1024u;
    const int aoff = lds_byte(wr * 64 + fr, fq * 8), boff = lds_byte(wc * 32 + fr, fq * 8);
#define PG8_SA(b, h) (((b) * 2 + (h)) * HTB)
#define PG8_SB(b, h) ((4 + (b) * 2 + (h)) * HTB)
#define PG8_STAGE(bufoff, gbase, voff) do { _Pragma("unroll") for (int _i = 0; _i < 2; ++_i) \
        __builtin_amdgcn_global_load_lds((const unsigned*)((const char*)(gbase) + (voff)[_i]), (LAS unsigned*)(lds + (bufoff) + ldsw + _i * 8192), 16, 0, 0); } while (0)
#define PG8_LDA(dst, b, h) do { _Pragma("unroll") for (int m = 0; m < 4; ++m) _Pragma("unroll") for (int k = 0; k < 2; ++k) dst[m][k] = *(const LAS bf16x8*)(lds + PG8_SA(b, h) + aoff + m * 2048 + k * 1024); } while (0)
#define PG8_LDB(dst, b, h) do { _Pragma("unroll") for (int n = 0; n < 2; ++n) _Pragma("unroll") for (int k = 0; k < 2; ++k) dst[n][k] = *(const LAS bf16x8*)(lds + PG8_SB(b, h) + boff + n * 2048 + k * 1024); } while (0)
#define PG8_MMA(ai, bj, At, Bt) do { __builtin_amdgcn_s_setprio(1); _Pragma("unroll") for (int m = 0; m < 4; ++m) _Pragma("unroll") for (int n = 0; n < 2; ++n) _Pragma("unroll") for (int k = 0; k < 2; ++k) \
        acc[ai][bj][m][n] = __builtin_amdgcn_mfma_f32_16x16x32_bf16(Bt[n][k], At[m][k], acc[ai][bj][m][n], 0, 0, 0); __builtin_amdgcn_s_setprio(0); } while (0)
#define PG8_WAIT_V(n) asm volatile("s_waitcnt vmcnt(" #n ")" ::: "memory")
#define PG8_WAIT_L(n) asm volatile("s_waitcnt lgkmcnt(" #n ")" ::: "memory")
#define PG8_BAR __builtin_amdgcn_s_barrier()
#define PG8_SCHED __builtin_amdgcn_sched_barrier(0)
    Unit cur, nxt; int ui = 0;
    if (!S.next(0, cur)) return;
    f32x4 acc[2][2][4][2];
#pragma unroll
    for (int a = 0; a < 2; ++a)
#pragma unroll
        for (int b = 0; b < 2; ++b)
#pragma unroll
            for (int m = 0; m < 4; ++m)
#pragma unroll
                for (int n = 0; n < 2; ++n) acc[a][b][m][n] = (f32x4){0.f, 0.f, 0.f, 0.f};
    bf16x8 At[4][2], B0[2][2], B1[2][2];
    const char* cA = S.a_base(cur); const char* cB = S.b_base(cur);
    if constexpr (SP2) {
        PG8_STAGE(PG8_SB(0, 0), cB, voffB); PG8_STAGE(PG8_SB(0, 1), cB + hB, voffB); PG8_STAGE(PG8_SA(0, 0), cA, voffA); PG8_STAGE(PG8_SA(0, 1), cA + hA, voffA);
        if (wr == 1) PG8_BAR;
        PG8_WAIT_V(2); PG8_BAR;
        PG8_STAGE(PG8_SB(1, 0), cB + kstep, voffB); PG8_STAGE(PG8_SA(1, 0), cA + kstep, voffA); PG8_STAGE(PG8_SB(1, 1), cB + hB + kstep, voffB);
        PG8_WAIT_V(6); PG8_BAR;
    } else {
        PG8_STAGE(PG8_SB(0, 0), cB, voffB); PG8_STAGE(PG8_SA(0, 0), cA, voffA); PG8_STAGE(PG8_SB(0, 1), cB + hB, voffB); PG8_STAGE(PG8_SA(0, 1), cA + hA, voffA);
        if (wr == 1) PG8_BAR;
        PG8_WAIT_V(4); PG8_BAR;
        PG8_STAGE(PG8_SB(1, 0), cB + kstep, voffB); PG8_STAGE(PG8_SA(1, 0), cA + kstep, voffA); PG8_STAGE(PG8_SB(1, 1), cB + hB + kstep, voffB);
        PG8_WAIT_V(6); PG8_BAR;
    }
    for (;;) {
        const bool has_next = S.next(ui + 1, nxt);
        const char* nA = has_next ? S.a_base(nxt) : cA; const char* nB = has_next ? S.b_base(nxt) : cB;
        for (int t = 0; t < nt; t += 2) {
            const bool last = (t == nt - 2);
            const char* a1 = cA + (size_t)(t + 1) * kstep;
            const char* a2 = last ? nA : cA + (size_t)(t + 2) * kstep; const char* b2 = last ? nB : cB + (size_t)(t + 2) * kstep;
            const char* a3 = a2 + kstep; const char* b3 = b2 + kstep;
            if constexpr (SP2) {
            PG8_LDB(B0, 0, 0); PG8_LDB(B1, 0, 1); PG8_SCHED; PG8_LDA(At, 0, 0); PG8_STAGE(PG8_SA(1, 1), a1 + hA, voffA);
            PG8_WAIT_V(8); PG8_WAIT_L(0); PG8_BAR; PG8_MMA(0, 0, At, B0); PG8_MMA(0, 1, At, B1); PG8_BAR; PG8_SCHED;
            PG8_LDA(At, 0, 1); PG8_STAGE(PG8_SB(0, 0), b2, voffB); PG8_STAGE(PG8_SB(0, 1), b2 + hB, voffB); PG8_STAGE(PG8_SA(0, 0), a2, voffA);
            PG8_WAIT_V(8); PG8_WAIT_L(0); PG8_BAR; PG8_MMA(1, 0, At, B0); PG8_MMA(1, 1, At, B1); PG8_BAR; PG8_SCHED;
            PG8_LDB(B0, 1, 0); PG8_LDB(B1, 1, 1); PG8_SCHED; PG8_LDA(At, 1, 0); PG8_STAGE(PG8_SA(0, 1), a2 + hA, voffA);
            PG8_WAIT_V(8); PG8_WAIT_L(0); PG8_BAR; PG8_MMA(0, 0, At, B0); PG8_MMA(0, 1, At, B1); PG8_BAR; PG8_SCHED;
            PG8_LDA(At, 1, 1); PG8_STAGE(PG8_SB(1, 0), b3, voffB); PG8_STAGE(PG8_SB(1, 1), b3 + hB, voffB); PG8_STAGE(PG8_SA(1, 0), a3, voffA);
            PG8_WAIT_V(8); PG8_WAIT_L(0); PG8_BAR; PG8_MMA(1, 0, At, B0); PG8_MMA(1, 1, At, B1); PG8_BAR; PG8_SCHED;
            } else {
            PG8_LDB(B0, 0, 0); PG8_SCHED; PG8_LDA(At, 0, 0); PG8_STAGE(PG8_SA(1, 1), a1 + hA, voffA);
            PG8_WAIT_L(8); PG8_BAR; PG8_WAIT_L(0); PG8_MMA(0, 0, At, B0); PG8_BAR; PG8_SCHED;
            PG8_LDB(B1, 0, 1); PG8_STAGE(PG8_SB(0, 0), b2, voffB);
            PG8_BAR; PG8_WAIT_L(0); PG8_MMA(0, 1, At, B1); PG8_BAR;
            PG8_LDA(At, 0, 1); PG8_STAGE(PG8_SA(0, 0), a2, voffA);
            PG8_BAR; PG8_WAIT_L(0); PG8_MMA(1, 0, At, B0); PG8_BAR; PG8_SCHED;
            PG8_STAGE(PG8_SB(0, 1), b2 + hB, voffB);
            PG8_WAIT_V(6); PG8_BAR; PG8_MMA(1, 1, At, B1); PG8_BAR;
            PG8_LDB(B0, 1, 0); PG8_SCHED; PG8_LDA(At, 1, 0); PG8_STAGE(PG8_SA(0, 1), a2 + hA, voffA);
            PG8_WAIT_L(8); PG8_BAR; PG8_WAIT_L(0); PG8_MMA(0, 0, At, B0); PG8_BAR; PG8_SCHED;
            PG8_LDB(B1, 1, 1); PG8_STAGE(PG8_SB(1, 0), b3, voffB);
            PG8_BAR; PG8_WAIT_L(0); PG8_MMA(0, 1, At, B1); PG8_BAR;
            PG8_LDA(At, 1, 1); PG8_STAGE(PG8_SA(1, 0), a3, voffA);
            PG8_BAR; PG8_WAIT_L(0); PG8_MMA(1, 0, At, B0); PG8_BAR; PG8_SCHED;
            PG8_STAGE(PG8_SB(1, 1), b3 + hB, voffB);
            PG8_WAIT_V(6); PG8_BAR; PG8_MMA(1, 1, At, B1); PG8_BAR;
            }
        }
        if constexpr (ALIGN_EPI) { if (wr == 0) PG8_BAR; }
        E(acc, cur, wr, wc, fr, fq);
        if (!has_next) break;
#pragma unroll
        for (int a = 0; a < 2; ++a)
#pragma unroll
            for (int b = 0; b < 2; ++b)
#pragma unroll
                for (int m = 0; m < 4; ++m)
#pragma unroll
                    for (int n = 0; n < 2; ++n) acc[a][b][m][n] = (f32x4){0.f, 0.f, 0.f, 0.f};
        cur = nxt; cA = nA; cB = nB; ++ui;
        if constexpr (ALIGN_EPI) { if (wr == 1) PG8_BAR; }
    }
    PG8_WAIT_V(0);
    if constexpr (!ALIGN_EPI) { if (wr == 0) PG8_BAR; }
    PG8_BAR;
#undef PG8_SA
#undef PG8_SB
#undef PG8_STAGE
#undef PG8_LDA
#undef PG8_LDB
#undef PG8_MMA
#undef PG8_WAIT_V
#undef PG8_WAIT_L
#undef PG8_BAR
#undef PG8_SCHED
}
}

namespace pg8 {
struct PlainOrder : StaticOrder {
    const char* A; const char* Bt; size_t a_tile, b_tile;
    __device__ bool next(int i, Unit& u) const { return tile(i, u); }
    DI const char* a_base(const Unit& u) const { return A + (size_t)u.pm * a_tile; }
    DI const char* b_base(const Unit& u) const { return Bt + (size_t)u.pn * b_tile; }
};
struct InOrder : StaticOrder {
    const char* H; const char* Win; const char* Mn; const char* Wkv; int n_extra;
    __device__ bool next(int i, Unit& u) const {
        const long L = (long)i * G + c;
        if (L >= (long)nwg + n_extra) return false;
        Unit t; t.pm = 0; t.pn = 0; t.z = 0;
        const bool main_tile = L < nwg;
        if (main_tile) (void)tile(i, t);
        const int e = (int)(L - nwg);
        const int pm1 = e >> 1, pn1 = e & 1, pm2 = (e - 32) >> 4, pn2 = (e - 32) & 15; const bool k1 = e < 32;
        u.pm = main_tile ? t.pm : (k1 ? pm1 : pm2); u.pn = main_tile ? t.pn : (k1 ? pn1 : pn2); u.z = main_tile ? 0 : (k1 ? 1 : 2);
        return true;
    }
    DI const char* a_base(const Unit& u) const { const long d1 = Mn - H, d2 = (Wkv + (size_t)512 * 1024 * 2) - H; return H + ((u.z == 1) ? d1 : 0L) + ((u.z == 2) ? d2 : 0L) + (size_t)u.pm * (256 * 1024 * 2); }
    DI const char* b_base(const Unit& u) const { const long d1 = Wkv - Win, d2 = Mn - Win; return Win + ((u.z == 1) ? d1 : 0L) + ((u.z == 2) ? d2 : 0L) + (size_t)u.pn * (256 * 1024 * 2); }
};
struct EpiIn {
    static constexpr bool PERM = true;
    bf16* proj; bf16* kmem; bf16* vt;
    DI void operator()(const f32x4 (&acc)[2][2][4][2], const Unit& u, int wr, int wc, int fr, int fq) const {
        const long dk = kmem - proj, dv = vt - proj; bf16* O = proj + ((u.z == 1) ? dk : 0L) + ((u.z == 2) ? dv : 0L); const int ldc = PC + ((u.z == 1) ? 512 - PC : 0) + ((u.z == 2) ? BATCH * NMEM - PC : 0);
        const int row0 = u.pm * BM + wr * 64 + fr, col0 = u.pn * BM + wc * 32 + 8 * fq;
#pragma unroll
        for (int ai = 0; ai < 2; ++ai)
#pragma unroll
            for (int m = 0; m < 4; ++m) { bf16* rowp = O + (size_t)(row0 + ai * HALF + m * 16) * ldc + col0;
#pragma unroll
                for (int bj = 0; bj < 2; ++bj) { const f32x4 v0 = acc[ai][bj][m][0], v1 = acc[ai][bj][m][1];
                    u32x4 w; w.x = cvt_pk_bf16(v0[0], v0[1]); w.y = cvt_pk_bf16(v0[2], v0[3]); w.z = cvt_pk_bf16(v1[0], v1[1]); w.w = cvt_pk_bf16(v1[2], v1[3]);
                    *(u32x4*)(rowp + bj * HALF) = w; } }
    }
};
struct BranchOrder : StaticOrder {
    const char* Y; const char* Wb;
    __device__ bool next(int i, Unit& u) const { if (!tile(i / 3, u)) return false; u.z = i % 3; return true; }
    DI const char* a_base(const Unit& u) const { return Y + (size_t)u.z * (16 * MiB) + (size_t)u.pm * (256 * 512 * 2); }
    DI const char* b_base(const Unit& u) const { return Wb + (size_t)u.z * (1024 * 512 * 2) + (size_t)u.pn * (256 * 512 * 2); }
};
struct ScoreOrder : StaticOrder {
    const char* Q; const char* Kbd;
    __device__ bool next(int i, Unit& u) const { return tile(i, u); }
    DI const char* a_base(const Unit& u) const { return Q + (size_t)u.pm * (256 * 2048 * 2) + (size_t)u.pn * 512; }
    DI const char* b_base(const Unit& u) const { return Kbd + (size_t)u.pn * (256 * 256 * 2); }
};

struct EpiBf16 {
    static constexpr bool PERM = true;
    bf16* O; int ldc;
    DI void operator()(const f32x4 (&acc)[2][2][4][2], const Unit& u, int wr, int wc, int fr, int fq) const {
        const int row0 = u.pm * BM + wr * 64 + fr, col0 = u.pn * BM + wc * 32 + 8 * fq;
#pragma unroll
        for (int ai = 0; ai < 2; ++ai)
#pragma unroll
            for (int m = 0; m < 4; ++m) { bf16* rowp = O + (size_t)(row0 + ai * HALF + m * 16) * ldc + col0;
#pragma unroll
                for (int bj = 0; bj < 2; ++bj) { const f32x4 v0 = acc[ai][bj][m][0], v1 = acc[ai][bj][m][1];
                    u32x4 w; w.x = cvt_pk_bf16(v0[0], v0[1]); w.y = cvt_pk_bf16(v0[2], v0[3]); w.z = cvt_pk_bf16(v1[0], v1[1]); w.w = cvt_pk_bf16(v1[2], v1[3]);
                    *(u32x4*)(rowp + bj * HALF) = w; } }
    }
};
struct EpiQ {
    static constexpr bool PERM = true;
    bf16* O; int ldc; const float* ssp;
    DI void operator()(const f32x4 (&acc)[2][2][4][2], const Unit& u, int wr, int wc, int fr, int fq) const {
        const int row0 = u.pm * BM + wr * 64 + fr, col0 = u.pn * BM + wc * 32 + 8 * fq;
#pragma unroll
        for (int ai = 0; ai < 2; ++ai)
#pragma unroll
            for (int m = 0; m < 4; ++m) { const int row = row0 + ai * HALF + m * 16; const f32x4* sp = (const f32x4*)(ssp + (size_t)row * 16);
                const f32x4 s0 = sp[0], s1 = sp[1], s2 = sp[2], s3 = sp[3];
                const float ss = ((s0[0] + s0[1]) + (s0[2] + s0[3])) + ((s1[0] + s1[1]) + (s1[2] + s1[3])) + ((s2[0] + s2[1]) + (s2[2] + s2[3])) + ((s3[0] + s3[1]) + (s3[2] + s3[3]));
                const float rs = 1.0f / sqrtf(ss * (1.0f / 1024.0f) + EPS);
                bf16* rowp = O + (size_t)row * ldc + col0;
#pragma unroll
                for (int bj = 0; bj < 2; ++bj) { const f32x4 v0 = acc[ai][bj][m][0] * rs, v1 = acc[ai][bj][m][1] * rs;
                    u32x4 w; w.x = cvt_pk_bf16(v0[0], v0[1]); w.y = cvt_pk_bf16(v0[2], v0[3]); w.z = cvt_pk_bf16(v1[0], v1[1]); w.w = cvt_pk_bf16(v1[2], v1[3]);
                    *(u32x4*)(rowp + bj * HALF) = w; }
                asm volatile("" ::: "memory"); }
    }
};
struct EpiF32 {
    static constexpr bool PERM = false;
    float* C; int ldc;
    DI void operator()(const f32x4 (&acc)[2][2][4][2], const Unit& u, int wr, int wc, int fr, int fq) const {
        const int row0 = u.pm * BM + wr * 64 + fr, col0 = u.pn * BM + wc * 32 + 4 * fq;
#pragma unroll
        for (int ai = 0; ai < 2; ++ai)
#pragma unroll
            for (int m = 0; m < 4; ++m) { float* rowp = C + (size_t)(row0 + ai * HALF + m * 16) * ldc + col0;
#pragma unroll
                for (int bj = 0; bj < 2; ++bj)
#pragma unroll
                    for (int n = 0; n < 2; ++n) *(f32x4*)(rowp + bj * HALF + n * 16) = acc[ai][bj][m][n]; }
    }
};
struct EpiBranch {
    static constexpr bool PERM = true;
    const bf16* proj; bf16* gbuf; bf16* merged;
    DI void operator()(const f32x4 (&acc)[2][2][4][2], const Unit& u, int wr, int wc, int fr, int fq) const {
        const int row0 = u.pm * BM + wr * 64 + fr, col0 = u.pn * BM + wc * 32 + 8 * fq;
#pragma unroll
        for (int ai = 0; ai < 2; ++ai)
#pragma unroll
            for (int m = 0; m < 4; ++m) { const int row = row0 + ai * HALF + m * 16;
#pragma unroll
                for (int bj = 0; bj < 2; ++bj) { const int col = col0 + bj * HALF;
                    const u32x4 gw = *(const u32x4*)(proj + (size_t)row * PC + C_GATE + u.z * 1024 + col);
                    f32x4 v0 = acc[ai][bj][m][0], v1 = acc[ai][bj][m][1];
                    v0[0] *= fast_sig(bflo(gw.x)); v0[1] *= fast_sig(bfhi(gw.x)); v0[2] *= fast_sig(bflo(gw.y)); v0[3] *= fast_sig(bfhi(gw.y));
                    v1[0] *= fast_sig(bflo(gw.z)); v1[1] *= fast_sig(bfhi(gw.z)); v1[2] *= fast_sig(bflo(gw.w)); v1[3] *= fast_sig(bfhi(gw.w));
                    const size_t off = (size_t)row * 1024 + col;
                    if (u.z == 2) { const u32x4 p0 = *(const u32x4*)(gbuf + off), p1 = *(const u32x4*)(gbuf + (size_t)TG * 1024 + off);
                        v0[0] += bflo(p0.x) + bflo(p1.x); v0[1] += bfhi(p0.x) + bfhi(p1.x); v0[2] += bflo(p0.y) + bflo(p1.y); v0[3] += bfhi(p0.y) + bfhi(p1.y);
                        v1[0] += bflo(p0.z) + bflo(p1.z); v1[1] += bfhi(p0.z) + bfhi(p1.z); v1[2] += bflo(p0.w) + bflo(p1.w); v1[3] += bfhi(p0.w) + bfhi(p1.w); }
                    u32x4 w; w.x = cvt_pk_bf16(v0[0], v0[1]); w.y = cvt_pk_bf16(v0[2], v0[3]); w.z = cvt_pk_bf16(v1[0], v1[1]); w.w = cvt_pk_bf16(v1[2], v1[3]);
                    *(u32x4*)((u.z == 2 ? merged : gbuf + (size_t)u.z * TG * 1024) + off) = w; }
                asm volatile("" ::: "memory"); }
    }
};
struct EpiOut {
    static constexpr bool PERM = true;
    const float* x; float* x1; bf16* xg; const float* gffn; float* ssp;
    DI void operator()(const f32x4 (&acc)[2][2][4][2], const Unit& u, int wr, int wc, int fr, int fq) const {
        const int row0 = u.pm * BM + wr * 64 + fr, col0 = u.pn * BM + wc * 32 + 8 * fq;
        f32x4 g0[2], g1[2];
#pragma unroll
        for (int bj = 0; bj < 2; ++bj) { g0[bj] = *(const f32x4*)(gffn + col0 + bj * HALF); g1[bj] = *(const f32x4*)(gffn + col0 + bj * HALF + 4); }
#pragma unroll
        for (int ai = 0; ai < 2; ++ai)
#pragma unroll
            for (int m = 0; m < 4; ++m) { const int row = row0 + ai * HALF + m * 16; float ss = 0.f;
#pragma unroll
                for (int bj = 0; bj < 2; ++bj) { const size_t off = (size_t)row * 1024 + col0 + bj * HALF;
                    const f32x4 v0 = acc[ai][bj][m][0] + *(const f32x4*)(x + off), v1 = acc[ai][bj][m][1] + *(const f32x4*)(x + off + 4);
                    *(f32x4*)(x1 + off) = v0; *(f32x4*)(x1 + off + 4) = v1;
                    ss += (v0[0] * v0[0] + v0[1] * v0[1]) + (v0[2] * v0[2] + v0[3] * v0[3]) + (v1[0] * v1[0] + v1[1] * v1[1]) + (v1[2] * v1[2] + v1[3] * v1[3]);
                    const f32x4 a = v0 * g0[bj], b = v1 * g1[bj];
                    u32x4 w; w.x = cvt_pk_bf16(a[0], a[1]); w.y = cvt_pk_bf16(a[2], a[3]); w.z = cvt_pk_bf16(b[0], b[1]); w.w = cvt_pk_bf16(b[2], b[3]);
                    *(u32x4*)(xg + off) = w; }
                ss += __shfl_xor(ss, 16); ss += __shfl_xor(ss, 32);
                if (fq == 0) ssp[(size_t)row * 16 + u.pn * 4 + wc] = ss;
                asm volatile("" ::: "memory"); }
    }
};
}

#define XB_TMO      128
#define XB_XCNT(j)  (256  + 64 * (j))
#define XB_XSUB(j)  (1280 + 64 * (j))
#define XB_XGEN(j)  (2304 + 64 * (j))
#define XB_TOP      3328
#define XB_TOPGEN   3392
#define XCD_BAR_WORDS 3456
#define XB_SPIN_CAP (1u << 18)
constexpr int CW_BAR = 4096;

DI unsigned xb_ld(unsigned* p)              { return __hip_atomic_load(p, __ATOMIC_RELAXED, __HIP_MEMORY_SCOPE_AGENT); }
DI unsigned xb_add(unsigned* p, unsigned v) { return __hip_atomic_fetch_add(p, v, __ATOMIC_RELAXED, __HIP_MEMORY_SCOPE_AGENT); }
DI unsigned xb_xcc_id() { return (unsigned)__builtin_amdgcn_s_getreg((3 << 11) | 20) & 0xFu; }
#define XB_SPIN(cond, bar) do { unsigned _sp = 0; while (cond) { __builtin_amdgcn_s_sleep(1); \
    if ((++_sp & 255u) == 0u) { if (xb_ld(&(bar)[XB_TMO])) break; if (_sp > XB_SPIN_CAP) { atomicAdd(&(bar)[XB_TMO], 1u); break; } } } } while (0)

struct XcdBarrier { unsigned* bar; unsigned x; volatile LAS unsigned* st; };

DI XcdBarrier xcd_barrier_post(unsigned* bar, volatile LAS unsigned* st) {
    XcdBarrier b; b.bar = bar; b.x = xb_xcc_id(); b.st = st;
    if (threadIdx.x == 0) (void)xb_add(&bar[XB_XCNT(b.x)], 1u);
    return b;
}
DI void xcd_barrier_complete(unsigned* bar, unsigned x, unsigned& nloc, unsigned& nx) {
    const unsigned G = gridDim.x * gridDim.y * gridDim.z;
    unsigned sum, cnt, mine, sp = 0u;
    for (;;) {
        sum = 0u; cnt = 0u; mine = 0u;
#pragma unroll
        for (unsigned j = 0; j < 16; ++j) { const unsigned c = xb_ld(&bar[XB_XCNT(j)]); sum += c; cnt += (c > 0u) ? 1u : 0u; mine = (j == x) ? c : mine; }
        if (sum == G) break;
        __builtin_amdgcn_s_sleep(1);
        if ((++sp & 255u) == 0u) { if (xb_ld(&bar[XB_TMO])) break; if (sp > XB_SPIN_CAP) { atomicAdd(&bar[XB_TMO], 1u); break; } }
    }
    nloc = mine > 0u ? mine : 1u; nx = cnt > 0u ? cnt : 1u;
}
DI void xcd_barrier(const XcdBarrier& b) {
    asm volatile("s_waitcnt vmcnt(0)" ::: "memory");
    __syncthreads();
    if (threadIdx.x == 0) {
        unsigned* bar = b.bar;
        __builtin_amdgcn_s_waitcnt(0);
        unsigned nloc = b.st[0], nx = b.st[1];
        if (nloc == 0u) { xcd_barrier_complete(bar, b.x, nloc, nx); b.st[0] = nloc; b.st[1] = nx; }
        const unsigned old = xb_add(&bar[XB_XSUB(b.x)], 1u);
        const unsigned gen = old / nloc;
        if (old + 1u == (gen + 1u) * nloc) {
            __builtin_amdgcn_fence(__ATOMIC_RELEASE, "agent");
            asm volatile("s_waitcnt vmcnt(0)" ::: "memory");
            const unsigned og = xb_add(&bar[XB_TOP], 1u);
            const unsigned tg = og / nx;
            if (og + 1u == (tg + 1u) * nx) xb_add(&bar[XB_TOPGEN], 1u);
            else XB_SPIN(xb_ld(&bar[XB_TOPGEN]) == tg, bar);
            __builtin_amdgcn_fence(__ATOMIC_ACQUIRE, "agent");
            xb_add(&bar[XB_XGEN(b.x)], 1u);
            asm volatile("s_waitcnt vmcnt(0)" ::: "memory");
        } else {
            XB_SPIN(xb_ld(&bar[XB_XGEN(b.x)]) == gen, bar);
            __builtin_amdgcn_fence(__ATOMIC_ACQUIRE, "agent");
            asm volatile("s_waitcnt vmcnt(0)" ::: "memory");
        }
    }
    __syncthreads();
}

struct Frame {
    LAS unsigned char* lds;
    int tid, lane, wave;
    DI void refresh() { int t = threadIdx.x; asm volatile("" : "+v"(t)); tid = t; lane = t & 63; wave = __builtin_amdgcn_readfirstlane(t >> 6); }
    int vcu, G;
    const float *x, *mem, *norm_mix_g, *w_in, *hg_lb, *hg_norm_g, *sc_conv_w, *mem_norm_g, *w_mem_kv, *w_branch, *w_out, *norm_ffn_g, *peer_w_q, *peer_sub_keys, *peer_u, *peer_v, *final_norm_g;
    float* out; unsigned char* ws;
};

DI void p0_transpose_item(const float* W, int K, int N, bf16* WT, LAS float* scr, int item, int lane) {
    const int nblk = N / 32, kb = item / nblk, nb = item % nblk, k0 = 64 * kb, n0 = 32 * nb;
#pragma unroll 8
    for (int i = 0; i < 32; ++i) { const int kk = 2 * i + (lane >> 5); scr[kk * 33 + (lane & 31)] = W[(size_t)(k0 + kk) * N + n0 + (lane & 31)]; }
    asm volatile("s_waitcnt lgkmcnt(0)" ::: "memory");
    const int c = lane & 7;
#pragma unroll
    for (int j = 0; j < 4; ++j) { const int n = (lane >> 3) + 8 * j; const LAS float* s = scr + (8 * c) * 33 + n;
        u32x4 o; o.x = pk2(s[0 * 33], s[1 * 33]); o.y = pk2(s[2 * 33], s[3 * 33]); o.z = pk2(s[4 * 33], s[5 * 33]); o.w = pk2(s[6 * 33], s[7 * 33]);
        *(u32x4*)(WT + (size_t)(n0 + n) * K + k0 + 8 * c) = o; }
    asm volatile("s_waitcnt lgkmcnt(0)" ::: "memory");
}
DI void rms_row_to_bf16(const float* xrow, const float* g, bf16* orow, int lane) {
    const f32x4* xr = (const f32x4*)xrow + lane; const f32x4* gr = (const f32x4*)g + lane;
    f32x4 v[4]; float s = 0.f;
#pragma unroll
    for (int j = 0; j < 4; ++j) { v[j] = xr[64 * j]; s += (v[j].x * v[j].x + v[j].y * v[j].y) + (v[j].z * v[j].z + v[j].w * v[j].w); }
    const float rstd = 1.0f / sqrtf(wave_sum(s) * (1.f / 1024.f) + EPS);
    unsigned long long* o8 = (unsigned long long*)orow + lane;
#pragma unroll
    for (int j = 0; j < 4; ++j) { const f32x4 gg = gr[64 * j]; const f32x4 y = v[j] * rstd * gg;
        o8[64 * j] = (unsigned long long)pk2(y.x, y.y) | ((unsigned long long)pk2(y.z, y.w) << 32); }
}
DI void p0_prologue(Frame& F) {
    F.refresh();
    LAS float* scr = (LAS float*)(F.lds + F.wave * 16384);
    const int gw = F.vcu * NWAVES + F.wave, NGW = F.G * NWAVES;
    unsigned char* ws = F.ws;
    constexpr int I_IN = (1024 / 64) * (PC / 32), I_KV = (1024 / 64) * (1024 / 32), I_BR = (512 / 64) * (1024 / 32), I_OUT = (1024 / 64) * (1024 / 32), I_Q = (1024 / 64) * (2048 / 32);
    constexpr int NITEMS = I_IN + I_KV + 3 * I_BR + I_OUT + I_Q;
    for (int it = gw; it < NITEMS; it += NGW) {
        int r = it;
        if (r < I_IN) { p0_transpose_item(F.w_in, 1024, PC, (bf16*)(ws + WS_WIN), scr, r, F.lane); continue; } r -= I_IN;
        if (r < I_KV) { p0_transpose_item(F.w_mem_kv, 1024, 1024, (bf16*)(ws + WS_WKV), scr, r, F.lane); continue; } r -= I_KV;
        if (r < 3 * I_BR) { const int n = r / I_BR; p0_transpose_item(F.w_branch + (size_t)n * 512 * 1024, 512, 1024, (bf16*)(ws + WS_WBR) + (size_t)n * 1024 * 512, scr, r % I_BR, F.lane); continue; } r -= 3 * I_BR;
        if (r < I_OUT) { p0_transpose_item(F.w_out, 1024, 1024, (bf16*)(ws + WS_WOUT), scr, r, F.lane); continue; } r -= I_OUT;
        p0_transpose_item(F.peer_w_q, 1024, 2048, (bf16*)(ws + WS_WQ), scr, r, F.lane);
    }
    const int gt = F.vcu * 512 + F.tid, NGT = F.G * 512;
    for (int it = gt; it < 8 * 256 * 32; it += NGT) {
        const int c8 = it & 31, row = (it >> 5) & 255, h = it >> 13, p = row >> 7, key = row & 127;
        u32x4 o = (u32x4){0u, 0u, 0u, 0u};
        if ((c8 >> 4) == p) { const float* s = F.peer_sub_keys + (((size_t)(h * 2 + p) * 128 + key) * 128 + (c8 & 15) * 8);
            const f32x4 a = *(const f32x4*)s, b = *(const f32x4*)(s + 4); o.x = pk2(a.x, a.y); o.y = pk2(a.z, a.w); o.z = pk2(b.x, b.y); o.w = pk2(b.z, b.w); }
        *(u32x4*)((bf16*)(ws + WS_KBD) + ((size_t)(h * 256 + row) * 256 + c8 * 8)) = o;
    }
    for (int it = gt; it < 1024; it += NGT) { const float a0 = F.hg_lb[it], a1 = F.hg_lb[1024 + it]; const float m = fmaxf(a0, a1); const float e0 = __expf(a0 - m), e1 = __expf(a1 - m);
        ((float*)(ws + WS_LB))[it] = e0 / (e0 + e1); }
    for (int m = gw; m < BATCH * NMEM; m += NGW) rms_row_to_bf16(F.mem + (size_t)m * 1024, F.mem_norm_g, (bf16*)(ws + WS_MN) + (size_t)m * 1024, F.lane);
    for (int m = gw; m < T_ALL; m += NGW) rms_row_to_bf16(F.x + (size_t)m * 1024, F.norm_mix_g, (bf16*)(ws + WS_XG) + (size_t)m * 1024, F.lane);
}

DI s16x4 tr16(const LAS unsigned char* p) { return __builtin_bit_cast(s16x4, __builtin_amdgcn_ds_read_tr16_b64_v4i16((LAS v4i16_t*)p)); }
DI bf16x8 cat8(s16x4 lo, s16x4 hi) { return __builtin_shufflevector(lo, hi, 0, 1, 2, 3, 4, 5, 6, 7); }
#define MFMA32(a, b, c) __builtin_amdgcn_mfma_f32_32x32x16_bf16((a), (b), (c), 0, 0, 0)
DI int crow(int reg, int h) { return (reg & 3) + 8 * (reg >> 2) + 4 * h; }
DI bf16x8 pack8(const f32x16& x, int s) {
    u32x4 p; p.x = cvtpk(x[8 * s], x[8 * s + 1]); p.y = cvtpk(x[8 * s + 2], x[8 * s + 3]); p.z = cvtpk(x[8 * s + 4], x[8 * s + 5]); p.w = cvtpk(x[8 * s + 6], x[8 * s + 7]);
    return __builtin_bit_cast(bf16x8, p);
}
constexpr int TS = 272;

DI void stage_tile(LAS unsigned char* tile, const bf16* src, int tid) {
#pragma unroll
    for (int i = 0; i < 2; ++i) { const int id = tid + 512 * i, c = id >> 4, ch = id & 15;
        *(LAS u32x4*)(tile + c * TS + ch * 16) = *(const u32x4*)(src + (size_t)c * PC + ch * 8); }
}
DI float touch_tile(const bf16* src, int i128) { return *(const float*)(src + (size_t)(i128 >> 1) * PC + (i128 & 1) * 64); }
DI void gate8(const LAS unsigned char* zt, int dp, int ts, f32x2 lb, f32x2 (&L)[8], f32x2 (&kk)[8], f32x2 (&lf)[8]) {
    f32x2 run = (f32x2){0.f, 0.f}; const f32x2 oml = 1.0f - lb;
#pragma unroll
    for (int i = 0; i < 8; ++i) { const unsigned w = *(const LAS unsigned*)(zt + (8 * ts + i) * TS + 4 * dp);
        const f32x2 sg = (f32x2){fast_sig(bflo(w)), fast_sig(bfhi(w))}; const f32x2 f = lb + oml * sg;
        lf[i] = (f32x2){__builtin_amdgcn_logf(f.x), __builtin_amdgcn_logf(f.y)}; kk[i] = oml * (1.0f - sg); run += lf[i]; L[i] = run; }
}
DI f32x2 exp2x2(f32x2 v) { return (f32x2){__builtin_amdgcn_exp2f(v.x), __builtin_amdgcn_exp2f(v.y)}; }
struct SliceSums { f32x2 offf, offb, glf, glb, greff, grefb; };
DI SliceSums slice_sums(const LAS float* tot, int dp, int ts) {
    SliceSums r; f32x2 tf[8], tb[8];
#pragma unroll
    for (int j = 0; j < 8; ++j) { tf[j] = *(const LAS f32x2*)(tot + j * 128 + 2 * dp); tb[j] = *(const LAS f32x2*)(tot + (8 + j) * 128 + 2 * dp); }
    r.offf = (f32x2){0.f, 0.f}; r.offb = (f32x2){0.f, 0.f};
#pragma unroll
    for (int j = 0; j < 8; ++j) { if (j < ts) r.offf += tf[j]; if (j > ts) r.offb += tb[j]; }
    r.greff = (tf[0] + tf[1]) + (tf[2] + tf[3]); r.glf = r.greff + ((tf[4] + tf[5]) + (tf[6] + tf[7]));
    r.grefb = (tb[4] + tb[5]) + (tb[6] + tb[7]); r.glb = r.grefb + ((tb[0] + tb[1]) + (tb[2] + tb[3]));
    return r;
}

DI void hgrn_a_item(Frame& F, int item, bool has_next) {
    F.refresh();
    constexpr int T_V = 0, T_KF = 17408, T_KB = 34816, TOT = 52224;
    LAS unsigned char* lds = F.lds;
    const int n = item & 31, h = (item >> 5) & 3, b = item >> 7;
    const bf16* proj = (const bf16*)(F.ws + WS_PROJ) + ((size_t)b * SEQ + n * CHUNK) * PC;
    const int tid = F.tid, dp = tid & 63, ts = F.wave;
    const float* lbp = (const float*)(F.ws + WS_LB);
    const f32x2 lbf = *(const f32x2*)(lbp + h * 128 + 2 * dp), lbb = *(const f32x2*)(lbp + 512 + h * 128 + 2 * dp);
    stage_tile(lds + T_V, proj + C_HI + h * 128, tid); stage_tile(lds + T_KF, proj + C_FF + h * 128, tid); stage_tile(lds + T_KB, proj + C_FB + h * 128, tid);
    float tch = 0.f;
    if (has_next) { const bf16* pn = proj + (size_t)CHUNK * PC + h * 128; const int i128 = tid & 127, wsel = tid >> 7; tch = touch_tile(pn + (wsel == 0 ? C_HI : wsel == 1 ? C_FF : C_FB), i128); }
    __syncthreads();
    f32x2 Lf[8], kf[8], lff[8], Lb[8], kb[8], lfb[8];
    gate8(lds + T_KF, dp, ts, lbf, Lf, kf, lff);
    gate8(lds + T_KB, dp, ts, lbb, Lb, kb, lfb);
    LAS float* tot = (LAS float*)(lds + TOT);
    *(LAS f32x2*)(tot + ts * 128 + 2 * dp) = Lf[7]; *(LAS f32x2*)(tot + (8 + ts) * 128 + 2 * dp) = Lb[7];
    asm volatile("" :: "v"(tch));
    __syncthreads();
    const SliceSums ss = slice_sums(tot, dp, ts);
    const f32x2 tbq = Lb[7];
#pragma unroll
    for (int i = 0; i < 8; ++i) { const int c = 8 * ts + i;
        const f32x2 G = ss.offf + Lf[i]; const f32x2 kd = kf[i] * exp2x2(ss.glf - G);
        const f32x2 Gb = ss.offb + (tbq - Lb[i] + lfb[i]); const f32x2 kdb = kb[i] * exp2x2(ss.glb - Gb);
        *(LAS unsigned*)(lds + T_KF + c * TS + 4 * dp) = cvtpk(kd.x, kd.y); *(LAS unsigned*)(lds + T_KB + c * TS + 4 * dp) = cvtpk(kdb.x, kdb.y); }
    if (ts == 0) { float* dec = (float*)(F.ws + WS_DEC) + (size_t)item * 256; *(f32x2*)(dec + 2 * dp) = exp2x2(ss.glf); *(f32x2*)(dec + 128 + 2 * dp) = exp2x2(ss.glb); }
    __syncthreads();
    const int w = F.wave, lane = F.lane, r = lane & 31, hh = lane >> 5, blk = (lane >> 4) & 1, q = (lane & 15) >> 2, p = lane & 3;
    const int dt = w >> 1, et0 = (w & 1) * 2;
#pragma unroll
    for (int dir = 0; dir < 2; ++dir) { const int TK = dir ? T_KB : T_KF;
#pragma unroll
        for (int e2 = 0; e2 < 2; ++e2) { const int et = et0 + e2; f32x16 acc;
#pragma unroll
            for (int i = 0; i < 16; ++i) acc[i] = 0.f;
#pragma unroll
            for (int ks = 0; ks < 4; ++ks) {
                const LAS unsigned char* ap = lds + TK + (16 * ks + 8 * hh + q) * TS + (32 * dt + 16 * blk + 4 * p) * 2;
                const LAS unsigned char* bp = lds + T_V + (16 * ks + 8 * hh + q) * TS + (32 * et + 16 * blk + 4 * p) * 2;
                const bf16x8 a = cat8(tr16(ap), tr16(ap + 4 * TS)), bq = cat8(tr16(bp), tr16(bp + 4 * TS));
                acc = MFMA32(a, bq, acc); }
            bf16* dsb = (bf16*)(F.ws + WS_DS) + ((size_t)(item * 2 + dir) * 128 + 32 * et + r) * 128 + 32 * dt + 4 * hh;
#pragma unroll
            for (int g4 = 0; g4 < 4; ++g4) { u32x2 wv; wv.x = cvtpk(acc[4 * g4], acc[4 * g4 + 1]); wv.y = cvtpk(acc[4 * g4 + 2], acc[4 * g4 + 3]); *(u32x2*)(dsb + 8 * g4) = wv; } } }
    __syncthreads();
}

DI void hgrn_scan(Frame& F) {
    F.refresh();
    const bf16* dS = (const bf16*)(F.ws + WS_DS); bf16* Sst = (bf16*)((unsigned char*)F.out + OUT_SST); const float* dec = (const float*)(F.ws + WS_DEC);
    const int gt = F.vcu * 512 + F.tid, NGT = F.G * 512;
    for (int id = gt; id < BG * 4 * 2 * 128 * 32; id += NGT) {
        const int d4 = id & 31, e = (id >> 5) & 127, dir = (id >> 12) & 1, bh = id >> 13;
        f32x4 S = (f32x4){0.f, 0.f, 0.f, 0.f};
#pragma unroll 4
        for (int s = 0; s < 32; ++s) { const int n = dir ? 31 - s : s, item = bh * 32 + n;
            const size_t off = ((size_t)(item * 2 + dir) * 128 + e) * 128 + d4 * 4;
            u32x2 o; o.x = cvtpk(S.x, S.y); o.y = cvtpk(S.z, S.w); *(u32x2*)(Sst + off) = o;
            const f32x4 dc = *(const f32x4*)(dec + (size_t)(item * 2 + dir) * 128 + d4 * 4);
            const u32x2 wv = *(const u32x2*)(dS + off);
            S.x = dc.x * S.x + bflo(wv.x); S.y = dc.y * S.y + bfhi(wv.x); S.z = dc.z * S.z + bflo(wv.y); S.w = dc.w * S.w + bfhi(wv.y); }
    }
}

DI void hgrn_c_item(Frame& F, int item, bool has_next) {
    F.refresh();
    constexpr int T_QRF = 0, T_KRF = 17408, T_QGF = 34816, T_QRB = 52224, T_KRB = 69632, T_QGB = 87040, T_V = 104448, TOT = 121856, O_OFF = 0, OS = 132;
    LAS unsigned char* lds = F.lds;
    const int n = item & 31, h = (item >> 5) & 3, b = item >> 7;
    const size_t row0 = (size_t)b * SEQ + n * CHUNK;
    const bf16* proj = (const bf16*)(F.ws + WS_PROJ) + row0 * PC;
    const int tid = F.tid, dp = tid & 63, ts = F.wave;
    const float* lbp = (const float*)(F.ws + WS_LB);
    const f32x2 lbf = *(const f32x2*)(lbp + h * 128 + 2 * dp), lbb = *(const f32x2*)(lbp + 512 + h * 128 + 2 * dp);
    stage_tile(lds + T_V, proj + C_HI + h * 128, tid); stage_tile(lds + T_KRF, proj + C_FF + h * 128, tid); stage_tile(lds + T_KRB, proj + C_FB + h * 128, tid); stage_tile(lds + T_QRF, proj + C_HQ + h * 128, tid);
    float tch = 0.f, tch2 = 0.f;
    if (has_next) { const bf16* pn = proj + (size_t)CHUNK * PC + h * 128; const int i128 = tid & 127, wsel = tid >> 7; tch = touch_tile(pn + (wsel == 0 ? C_HI : wsel == 1 ? C_FF : wsel == 2 ? C_FB : C_HQ), i128);
        tch2 = *(const float*)((const unsigned char*)F.out + OUT_SST + (size_t)(item + 1) * 65536 + (size_t)tid * 128); }
    __syncthreads();
    f32x2 qv[8];
#pragma unroll
    for (int i = 0; i < 8; ++i) { const unsigned w = *(const LAS unsigned*)(lds + T_QRF + (8 * ts + i) * TS + 4 * dp); const float z0 = bflo(w), z1 = bfhi(w); qv[i] = (f32x2){z0 * fast_sig(z0), z1 * fast_sig(z1)}; }
    f32x2 Lf[8], kf[8], lff[8], Lb[8], kb[8], lfb[8];
    gate8(lds + T_KRF, dp, ts, lbf, Lf, kf, lff);
    gate8(lds + T_KRB, dp, ts, lbb, Lb, kb, lfb);
    LAS float* tot = (LAS float*)(lds + TOT);
    *(LAS f32x2*)(tot + ts * 128 + 2 * dp) = Lf[7]; *(LAS f32x2*)(tot + (8 + ts) * 128 + 2 * dp) = Lb[7];
    asm volatile("" :: "v"(tch), "v"(tch2));
    __syncthreads();
    {
        const SliceSums ss = slice_sums(tot, dp, ts);
        const f32x2 tbq = Lb[7];
#pragma unroll
        for (int i = 0; i < 8; ++i) { const int c = 8 * ts + i; const int o = c * TS + 4 * dp;
            const f32x2 G = ss.offf + Lf[i]; const f32x2 x = G - ss.greff;
            const f32x2 qr = qv[i] * exp2x2(x), kr = kf[i] * exp2x2(-x), qg = qv[i] * exp2x2(G);
            *(LAS unsigned*)(lds + T_QRF + o) = cvtpk(qr.x, qr.y); *(LAS unsigned*)(lds + T_KRF + o) = cvtpk(kr.x, kr.y); *(LAS unsigned*)(lds + T_QGF + o) = cvtpk(qg.x, qg.y);
            const f32x2 Gb = ss.offb + (tbq - Lb[i] + lfb[i]); const f32x2 xb = Gb - ss.grefb;
            const f32x2 qrb = qv[i] * exp2x2(xb), krb = kb[i] * exp2x2(-xb), qgb = qv[i] * exp2x2(Gb);
            *(LAS unsigned*)(lds + T_QRB + o) = cvtpk(qrb.x, qrb.y); *(LAS unsigned*)(lds + T_KRB + o) = cvtpk(krb.x, krb.y); *(LAS unsigned*)(lds + T_QGB + o) = cvtpk(qgb.x, qgb.y); }
    }
    __syncthreads();
    const int w = F.wave, lane = F.lane, r = lane & 31, hh = lane >> 5, blk = (lane >> 4) & 1, q = (lane & 15) >> 2, p = lane & 3;
    const int ct = w >> 2, et = w & 3;
    const bf16* Sst = (const bf16*)((const unsigned char*)F.out + OUT_SST);
    f32x16 o;
#pragma unroll
    for (int i = 0; i < 16; ++i) o[i] = 0.f;
#pragma unroll
    for (int dir = 0; dir < 2; ++dir) { const int TQR = dir ? T_QRB : T_QRF, TKR = dir ? T_KRB : T_KRF, TQG = dir ? T_QGB : T_QGF;
#pragma unroll
        for (int st = 0; st < 2; ++st) {
            if (dir == 0 ? (st > ct) : (st < ct)) continue;
            f32x16 X;
#pragma unroll
            for (int i = 0; i < 16; ++i) X[i] = 0.f;
#pragma unroll
            for (int ks = 0; ks < 8; ++ks) { const bf16x8 a = *(const LAS bf16x8*)(lds + TKR + (32 * st + r) * TS + (16 * ks + 8 * hh) * 2), bq = *(const LAS bf16x8*)(lds + TQR + (32 * ct + r) * TS + (16 * ks + 8 * hh) * 2);
                X = MFMA32(a, bq, X); }
            const int cc = 32 * ct + r;
#pragma unroll
            for (int i = 0; i < 16; ++i) { const int s = 32 * st + crow(i, hh); const bool keep = dir == 0 ? (s <= cc) : (s >= cc); X[i] = keep ? X[i] : 0.f; }
#pragma unroll
            for (int s2 = 0; s2 < 2; ++s2) { const bf16x8 xs = pack8(X, s2);
                const LAS unsigned char* vp = lds + T_V + (32 * st + 16 * s2 + 4 * hh + q) * TS + (32 * et + 16 * blk + 4 * p) * 2;
                const bf16x8 pb = cat8(tr16(vp), tr16(vp + 8 * TS));
                o = MFMA32(xs, pb, o); }
        }
        const bf16* sp = Sst + ((size_t)(item * 2 + dir) * 128 + 32 * et + r) * 128 + 8 * hh;
#pragma unroll
        for (int ks = 0; ks < 8; ++ks) { const bf16x8 a = *(const LAS bf16x8*)(lds + TQG + (32 * ct + r) * TS + (16 * ks + 8 * hh) * 2); const bf16x8 bq = *(const bf16x8*)(sp + 16 * ks);
            o = MFMA32(a, bq, o); }
    }
    unsigned hw[8];
#pragma unroll
    for (int k = 0; k < 8; ++k) hw[k] = *(const unsigned*)(proj + (size_t)(8 * w + k) * PC + C_HG + h * 128 + 2 * lane);
    __syncthreads();
    LAS float* O = (LAS float*)(lds + O_OFF);
#pragma unroll
    for (int i = 0; i < 16; ++i) O[(32 * ct + crow(i, hh)) * OS + 32 * et + r] = o[i];
    __syncthreads();
    const f32x2 gn = *(const f32x2*)(F.hg_norm_g + h * 128 + 2 * lane);
    bf16* yhg = (bf16*)(F.ws + WS_YHG);
    const int a16 = (lane ^ 16) << 2, a32 = (lane ^ 32) << 2;
#pragma unroll
    for (int k = 0; k < 8; ++k) { const int c = 8 * w + k; const f32x2 v = *(const LAS f32x2*)(O + c * OS + 2 * lane);
        float ss = row_sum16(v.x * v.x + v.y * v.y); ss += bperm_f(a16, ss); ss += bperm_f(a32, ss);
        const float rstd = __builtin_amdgcn_rsqf(ss * (1.0f / 128.0f) + EPS);
        const float z0 = bflo(hw[k]), z1 = bfhi(hw[k]);
        const float y0 = v.x * rstd * gn.x * (z0 * fast_sig(z0)), y1 = v.y * rstd * gn.y * (z1 * fast_sig(z1));
        *(unsigned*)(yhg + (row0 + c) * 512 + h * 128 + 2 * lane) = cvtpk(y0, y1); }
    __syncthreads();
}

DI void attn_item(Frame& F, int g, int item) {
    F.refresh();
    constexpr int KS = 272, VS = 528, K_OFF = 0, V_OFF = 69632;
    LAS unsigned char* lds = F.lds;
    const int qb = item & 7, h = (item >> 3) & 3, b = item >> 5, bglob = g * BG + b;
    const bf16* Km = (const bf16*)(F.ws + WS_KMEM) + (size_t)bglob * 256 * 512 + h * 128;
    const bf16* VT = (const bf16*)(F.ws + WS_VT) + (size_t)(h * 128) * 4096 + bglob * 256;
    const int tid = F.tid;
#pragma unroll
    for (int i = 0; i < 8; ++i) { const int id = tid + 512 * i, key = id >> 4, ch = id & 15;
        *(LAS u32x4*)(lds + K_OFF + key * KS + ch * 16) = *(const u32x4*)(Km + (size_t)key * 512 + ch * 8); }
#pragma unroll
    for (int i = 0; i < 8; ++i) { const int id = tid + 512 * i, e = id >> 5, ch = id & 31;
        *(LAS u32x4*)(lds + V_OFF + e * VS + ch * 16) = *(const u32x4*)(VT + (size_t)e * 4096 + ch * 8); }
    __syncthreads();
    const int w = F.wave, lane = F.lane, r = lane & 31, hh = lane >> 5;
    const size_t qrow0 = (size_t)b * SEQ + qb * 256 + w * 32;
    const bf16* proj = (const bf16*)(F.ws + WS_PROJ);
    bf16x8 qf[8];
#pragma unroll
    for (int ks = 0; ks < 8; ++ks) qf[ks] = *(const bf16x8*)(proj + (qrow0 + r) * PC + C_MQ + h * 128 + 16 * ks + 8 * hh);
    const float scale = 0.08838834764831845f;
    float m_run = -INFINITY, l_run = 0.f;
#pragma unroll 1
    for (int kt = 0; kt < 8; ++kt) {
        f32x16 X;
#pragma unroll
        for (int i = 0; i < 16; ++i) X[i] = 0.f;
#pragma unroll
        for (int ks = 0; ks < 8; ++ks) { const bf16x8 a = *(const LAS bf16x8*)(lds + K_OFF + (32 * kt + r) * KS + (16 * ks + 8 * hh) * 2); X = MFMA32(a, qf[ks], X); }
        float tm = X[0];
#pragma unroll
        for (int i = 1; i < 16; ++i) tm = fmaxf(tm, X[i]);
        tm *= scale;
        const float mn = fmaxf(m_run, tm); float ls = 0.f;
#pragma unroll
        for (int i = 0; i < 16; ++i) ls += __expf(X[i] * scale - mn);
        l_run = l_run * __expf(m_run - mn) + ls; m_run = mn;
    }
    { const float mo = __shfl_xor(m_run, 32), lo = __shfl_xor(l_run, 32); const float m = fmaxf(m_run, mo);
      l_run = l_run * __expf(m_run - m) + lo * __expf(mo - m); m_run = m; }
    const float inv_l = 1.0f / l_run;
    f32x16 O[4];
#pragma unroll
    for (int e = 0; e < 4; ++e)
#pragma unroll
        for (int i = 0; i < 16; ++i) O[e][i] = 0.f;
#pragma unroll 1
    for (int kt = 0; kt < 8; ++kt) {
        f32x16 X;
#pragma unroll
        for (int i = 0; i < 16; ++i) X[i] = 0.f;
#pragma unroll
        for (int ks = 0; ks < 8; ++ks) { const bf16x8 a = *(const LAS bf16x8*)(lds + K_OFF + (32 * kt + r) * KS + (16 * ks + 8 * hh) * 2); X = MFMA32(a, qf[ks], X); }
#pragma unroll
        for (int i = 0; i < 16; ++i) X[i] = __expf(X[i] * scale - m_run) * inv_l;
#pragma unroll
        for (int s2 = 0; s2 < 2; ++s2) { const bf16x8 xs = pack8(X, s2);
#pragma unroll
            for (int e = 0; e < 4; ++e) { const LAS unsigned char* vp = lds + V_OFF + (32 * e + r) * VS + (32 * kt + 16 * s2 + 4 * hh) * 2;
                const bf16x8 pb = cat8(*(const LAS s16x4*)vp, *(const LAS s16x4*)(vp + 16));
                O[e] = MFMA32(xs, pb, O[e]); } }
    }
    bf16* ymx = (bf16*)(F.ws + WS_YMX);
#pragma unroll
    for (int e = 0; e < 4; ++e)
#pragma unroll
        for (int i = 0; i < 16; ++i) ymx[(qrow0 + crow(i, hh)) * 512 + h * 128 + 32 * e + r] = (bf16)f2bf(O[e][i]);
    __syncthreads();
}

DI void conv_phase(Frame& F) {
    F.refresh();
    const bf16* proj = (const bf16*)(F.ws + WS_PROJ); bf16* ysc = (bf16*)(F.ws + WS_YSC); const float* cw = F.sc_conv_w;
    const int gt = F.vcu * 512 + F.tid, NGT = F.G * 512;
    for (int id = gt; id < TG * 64; id += NGT) {
        const int c8 = id & 63, t = id >> 6, ts = t & (SEQ - 1);
        const bf16* pr = proj + (size_t)t * PC + c8 * 8;
        const u32x4 z4 = (u32x4){0u, 0u, 0u, 0u};
        const u32x4 sb = *(const u32x4*)(pr + C_SB), c1 = *(const u32x4*)(pr + C_SC), h1 = *(const u32x4*)(pr + C_SH);
        const u32x4 c0 = ts > 0 ? *(const u32x4*)(pr - PC + C_SC) : z4, h0 = ts > 0 ? *(const u32x4*)(pr - PC + C_SH) : z4;
        const u32x4 c2 = ts < SEQ - 1 ? *(const u32x4*)(pr + PC + C_SC) : z4, h2 = ts < SEQ - 1 ? *(const u32x4*)(pr + PC + C_SH) : z4;
        const f32x4 wa0 = *(const f32x4*)(cw + c8 * 8), wa1 = *(const f32x4*)(cw + c8 * 8 + 4), wb0 = *(const f32x4*)(cw + 512 + c8 * 8), wb1 = *(const f32x4*)(cw + 512 + c8 * 8 + 4),
                    wc0 = *(const f32x4*)(cw + 1024 + c8 * 8), wc1 = *(const f32x4*)(cw + 1024 + c8 * 8 + 4);
        float y[8];
#pragma unroll
        for (int k = 0; k < 4; ++k) {
            const float w0l = k < 2 ? wa0[2 * k] : wa1[2 * k - 4], w0h = k < 2 ? wa0[2 * k + 1] : wa1[2 * k - 3];
            const float w1l = k < 2 ? wb0[2 * k] : wb1[2 * k - 4], w1h = k < 2 ? wb0[2 * k + 1] : wb1[2 * k - 3];
            const float w2l = k < 2 ? wc0[2 * k] : wc1[2 * k - 4], w2h = k < 2 ? wc0[2 * k + 1] : wc1[2 * k - 3];
            y[2 * k]     = bflo(sb[k]) * (w0l * (bflo(c0[k]) * bflo(h0[k])) + w1l * (bflo(c1[k]) * bflo(h1[k])) + w2l * (bflo(c2[k]) * bflo(h2[k])));
            y[2 * k + 1] = bfhi(sb[k]) * (w0h * (bfhi(c0[k]) * bfhi(h0[k])) + w1h * (bfhi(c1[k]) * bfhi(h1[k])) + w2h * (bfhi(c2[k]) * bfhi(h2[k]))); }
        u32x4 o; o.x = cvtpk(y[0], y[1]); o.y = cvtpk(y[2], y[3]); o.z = cvtpk(y[4], y[5]); o.w = cvtpk(y[6], y[7]);
        *(u32x4*)(ysc + (size_t)t * 512 + c8 * 8) = o;
    }
}

DI unsigned ord_key(float v, int idx) { unsigned u = __builtin_bit_cast(unsigned, v); u ^= (u >> 31) ? 0xFFFFFFFFu : 0x80000000u; return (u & 0xFFFFFF80u) | (unsigned)(127 - idx); }
DI float key_val(unsigned k) { unsigned u = k & 0xFFFFFF80u; u = (u & 0x80000000u) ? (u ^ 0x80000000u) : ~u; return __builtin_bit_cast(float, u); }
DI float dot2bf(unsigned a, unsigned b, float c) { return __builtin_amdgcn_fdot2_f32_bf16(__builtin_bit_cast(bf16x2_t, a), __builtin_bit_cast(bf16x2_t, b), c, false); }
DI float dot8(const u32x4& a, const u32x4& b, float c) { c = dot2bf(a.x, b.x, c); c = dot2bf(a.y, b.y, c); c = dot2bf(a.z, b.z, c); return dot2bf(a.w, b.w, c); }
__host__ __device__ constexpr int cand_off(int i) { return i == 0 ? 0 : i == 1 ? 16 : i == 2 ? 24 : i == 3 ? 29 : i == 4 ? 33 : i == 5 ? 36 : i == 6 ? 38 : i == 7 ? 40 : 34 + i; }
__host__ __device__ constexpr int cand_i(int c) { return c < 16 ? 0 : c < 24 ? 1 : c < 29 ? 2 : c < 33 ? 3 : c < 36 ? 4 : c < 38 ? 5 : c < 40 ? 6 : c < 42 ? 7 : c - 34; }
__host__ __device__ constexpr int cand_pos(int c) { return cand_i(c) * 16 + (c - cand_off(cand_i(c))); }

#define PEER_CE(i, j) do { const unsigned hi_ = max(k[i], k[j]), lo_ = min(k[i], k[j]); k[i] = hi_; k[j] = lo_; } while (0)
DI void peer_topk_first(const float* srow, LAS float* ssc, LAS int* six, int lane) {
    const int gq = lane >> 4, li = lane & 15;
    const float* sl = srow + (gq >> 1) * 256 + (gq & 1) * 128 + li * 8;
    f32x4 nva = *(const f32x4*)sl, nvb = *(const f32x4*)(sl + 4);
#pragma unroll 1
    for (int hp = 0; hp < 4; ++hp) {
        const f32x4 va = nva, vb = nvb;
        if (hp < 3) { nva = *(const f32x4*)(sl + 512 * (hp + 1)); nvb = *(const f32x4*)(sl + 512 * (hp + 1) + 4); }
        unsigned k[8];
        k[0] = ord_key(va.x, li * 8 + 0); k[1] = ord_key(va.y, li * 8 + 1); k[2] = ord_key(va.z, li * 8 + 2); k[3] = ord_key(va.w, li * 8 + 3);
        k[4] = ord_key(vb.x, li * 8 + 4); k[5] = ord_key(vb.y, li * 8 + 5); k[6] = ord_key(vb.z, li * 8 + 6); k[7] = ord_key(vb.w, li * 8 + 7);
        PEER_CE(0, 1); PEER_CE(2, 3); PEER_CE(4, 5); PEER_CE(6, 7); PEER_CE(0, 2); PEER_CE(1, 3); PEER_CE(4, 6); PEER_CE(5, 7); PEER_CE(1, 2); PEER_CE(5, 6);
        PEER_CE(0, 4); PEER_CE(1, 5); PEER_CE(2, 6); PEER_CE(3, 7); PEER_CE(2, 4); PEER_CE(3, 5); PEER_CE(1, 2); PEER_CE(3, 4); PEER_CE(5, 6);
        unsigned mine = 0u;
#pragma unroll
        for (int rd = 0; rd < 16; ++rd) {
            const unsigned m = row_max16(k[0]);
            mine = (li == rd) ? m : mine;
            const bool wn = (k[0] == m);
            k[0] = wn ? k[1] : k[0]; k[1] = wn ? k[2] : k[1]; k[2] = wn ? k[3] : k[2]; k[3] = wn ? k[4] : k[3];
            k[4] = wn ? k[5] : k[4]; k[5] = wn ? k[6] : k[5]; k[6] = wn ? k[7] : k[6]; k[7] = wn ? 0u : k[7];
        }
        const int o = ((2 * hp + (gq >> 1)) * 2 + (gq & 1)) * 16 + li;
        ssc[o] = key_val(mine); six[o] = 127 - (int)(mine & 127u);
    }
}
DI void peer_topk_second(const LAS float* ssc, const LAS int* six, LAS int* widx, LAS float* wgate, int lane, int emask) {
    const int ci = cand_i(lane), cj = lane - cand_off(ci); const bool cvalid = lane < 50;
    const int a16 = (lane ^ 16) << 2, a32 = (lane ^ 32) << 2;
#pragma unroll 2
    for (int hd = 0; hd < 8; ++hd) {
        const float a = ssc[(hd * 2) * 16 + ci], bq = ssc[(hd * 2 + 1) * 16 + cj];
        const int ia = six[(hd * 2) * 16 + ci], ib = six[(hd * 2 + 1) * 16 + cj];
        const float cs = a + bq;
        unsigned ck = __builtin_bit_cast(unsigned, cs); ck ^= (ck >> 31) ? 0xFFFFFFFFu : 0x80000000u; ck = cvalid ? ((ck & ~63u) | (unsigned)(63 - lane)) : 0u;
        int rank = 0;
#pragma unroll
        for (int c2 = 0; c2 < 50; ++c2) { const unsigned k2 = (unsigned)__builtin_amdgcn_readlane((int)ck, c2); rank += (int)(k2 > ck); }
        const bool sel = cvalid && rank < 16;
        const float mx = __builtin_bit_cast(float, __builtin_amdgcn_readlane(__builtin_bit_cast(int, cs), 0));
        const float ev = sel ? __builtin_amdgcn_exp2f((cs - mx) * 1.4426950408889634f) : 0.f;
        float sum = row_sum16(ev); sum += bperm_f(a16, sum); sum += bperm_f(a32, sum);
        if (sel) { widx[hd * 16 + rank] = ((ia * 128 + ib) & emask) * 512  ; wgate[hd * 16 + rank] = ev * __builtin_amdgcn_rcpf(sum); }
    }
}
#undef PEER_CE

constexpr float PEER_QSTEP = 0.35f;
constexpr float PEER_U_SCALE = 32.0f / PEER_QSTEP;
constexpr float PEER_UF4_SCALE = 64.0f;
constexpr float PEER_H4_SCALE = 2.0f;
#ifndef PROBE_SKIP
#define PROBE_SKIP 0
#endif
#define PSKIP(b) ((PROBE_SKIP >> (b)) & 1 && dry)
#ifndef PROBE_NODMA
#define PROBE_NODMA 0
#endif
#ifndef PROBE_EMASK
#define PROBE_EMASK 16383
#endif
#ifndef PEER_VARIANT
#define PEER_VARIANT 0
#endif
#ifndef PEER_R
#define PEER_R 16
#endif
#if PEER_R == 32
#define PEER_RM4 28
#elif PEER_R == 16
#define PEER_RM4 12
#elif PEER_R == 64
#define PEER_RM4 60
#endif
constexpr int PEER_NPROD = 2, PEER_NCONS = 8 - PEER_NPROD, PEER_CPP = PEER_NCONS / PEER_NPROD;
constexpr int PEER_SLOT_BYTES = 2048;
constexpr int PEER_FLAG_OFF = PEER_NCONS * 2 * PEER_SLOT_BYTES, PEER_PRIV_OFF = PEER_FLAG_OFF + 64, PEER_PRIV_BYTES = 2560, PEER_RING_OFF = 40960;
static_assert(PEER_PRIV_OFF + PEER_NCONS * PEER_PRIV_BYTES <= PEER_RING_OFF && PEER_RING_OFF + PEER_NCONS * PEER_R * 1024 <= MISC_OFF && PEER_R <= 64 && (PEER_R & (PEER_R - 1)) == 0 && PEER_NCONS % PEER_NPROD == 0, "PEER LDS map");
DI void glds16(const void* gsrc, unsigned lds_dst) { unsigned keep;
    asm volatile("s_mov_b32 %0, m0\n\ts_mov_b32 m0, %2\n\ts_nop 0\n\tglobal_load_lds_dwordx4 %1, off\n\ts_mov_b32 m0, %0" : "=&s"(keep) : "v"(gsrc), "s"(lds_dst) : "memory"); }
DI void glds16s(const void* sbase, unsigned voff, unsigned lds_dst) { unsigned keep;
    asm volatile("s_mov_b32 %0, m0\n\ts_mov_b32 m0, %3\n\ts_nop 0\n\tglobal_load_lds_dwordx4 %1, %2\n\ts_mov_b32 m0, %0" : "=&s"(keep) : "v"(voff), "s"(sbase), "s"(lds_dst) : "memory"); }
DI void glds16s_x4(const void* sbase, unsigned v0, unsigned v1, unsigned v2, unsigned v3, unsigned lds_dst) { unsigned keep;
    asm volatile("s_mov_b32 %0, m0\n\ts_mov_b32 m0, %6\n\ts_nop 0\n\tglobal_load_lds_dwordx4 %1, %5\n\tglobal_load_lds_dwordx4 %2, %5 offset:1024\n\tglobal_load_lds_dwordx4 %3, %5 offset:2048\n\tglobal_load_lds_dwordx4 %4, %5 offset:3072\n\ts_mov_b32 m0, %0"
                 : "=&s"(keep) : "v"(v0), "v"(v1), "v"(v2), "v"(v3), "s"(sbase), "s"(lds_dst) : "memory"); }
#define PEER_STR2(x) #x
#define PEER_STR(x) PEER_STR2(x)
typedef int i32x4 __attribute__((ext_vector_type(4)));
typedef int i32x8 __attribute__((ext_vector_type(8)));
DI void peer_phase(Frame& F, int tg, bool dry) {
    F.refresh();
    __syncthreads();
    const int lane = F.lane, wv = F.wave;
    volatile LAS unsigned* flags = (volatile LAS unsigned*)(F.lds + PEER_FLAG_OFF);
    if (F.tid < 2 * PEER_NCONS) flags[F.tid] = 0u;
    __syncthreads();
    const int NPG = F.G * PEER_NPROD;
    if (wv < PEER_NPROD) {
        const int pg = F.vcu * PEER_NPROD + wv;
        int i = 0;
        for (int tl = pg; tl < TG; tl += NPG, ++i) {
            float tch0 = 0.f;
            if (tl + NPG < TG) tch0 = ((const float*)(F.ws + WS_S) + (size_t)(tl + NPG) * 2048)[lane * 32];
            const int cidx = wv * PEER_CPP + (i % PEER_CPP), slot = (i / PEER_CPP) & 1;
            LAS float* ssc = (LAS float*)(F.lds + (cidx * 2 + slot) * PEER_SLOT_BYTES); LAS int* six = (LAS int*)(F.lds + (cidx * 2 + slot) * PEER_SLOT_BYTES + 1024);
            while (flags[cidx * 2 + slot] != 0u) __builtin_amdgcn_s_sleep(2);
            asm volatile("" ::: "memory");
            if (!PSKIP(0)) peer_topk_first((const float*)(F.ws + WS_S) + (size_t)tl * 2048, ssc, six, lane);
            asm volatile("s_waitcnt lgkmcnt(0)" :: "v"(tch0) : "memory");
            if (lane == 0) flags[cidx * 2 + slot] = 1u;
        }
    } else {
        const unsigned char* Ub = F.ws + WS_U; const unsigned char* Vb = F.ws + WS_V; const unsigned lo16 = 16u * (unsigned)(lane & 31);
        const int a16 = (lane ^ 16) << 2, a32 = (lane ^ 32) << 2; const int grp = lane >> 4;
        const int cidx = wv - PEER_NPROD, myprod = cidx / PEER_CPP, myr = cidx % PEER_CPP;
        LAS int* sidx = (LAS int*)(F.lds + PEER_PRIV_OFF + cidx * PEER_PRIV_BYTES); LAS float* sgate = (LAS float*)(F.lds + PEER_PRIV_OFF + cidx * PEER_PRIV_BYTES + 512);
        LAS unsigned char* ring = F.lds + PEER_RING_OFF + cidx * (PEER_R * 1024);
        const unsigned ringb = (unsigned)(uintptr_t)ring;
        LAS unsigned char* hrow = F.lds + PEER_PRIV_OFF + cidx * PEER_PRIV_BYTES + 1536;
        unsigned usw[4];
#pragma unroll
        for (int q = 0; q < 4; ++q) usw[q] = 16u * (unsigned)((lane & 31) ^ (2 * q + (lane >> 5))) + (4096u - 1024u * q);
        const LAS unsigned char* uadr[4];
#pragma unroll
        for (int j = 0; j < 4; ++j) uadr[j] = ring + (lane & 15) * 512 + 64 * (j ^ ((lane & 15) >> 2)) + 16 * (grp ^ (lane & 3));
        const int pg = F.vcu * PEER_NPROD + myprod, TSTEP = NPG * PEER_CPP;
        int kslot = 0;
        for (int tl = pg + myr * NPG; tl < TG; tl += TSTEP, ++kslot) {
            const size_t t = (size_t)tg * TG + tl;
            float tch1 = 0.f, tch2 = 0.f, tch3 = 0.f;
            if (tl + TSTEP < TG) { const size_t tn = t + TSTEP; tch1 = (F.out + tn * 1024)[(lane & 31) * 32];
                tch2 = ((const float*)((const bf16*)(F.ws + WS_XG) + tn * 1024))[(lane & 15) * 32]; tch3 = ((const float*)(F.ws + WS_SSP) + tn * 16)[lane & 15]; }
            const f32x4* sp = (const f32x4*)((const float*)(F.ws + WS_SSP) + t * 16);
            const f32x4 s0 = sp[0], s1 = sp[1], s2 = sp[2], s3 = sp[3];
            const float ssx = ((s0[0] + s0[1]) + (s0[2] + s0[3])) + ((s1[0] + s1[1]) + (s1[2] + s1[3])) + ((s2[0] + s2[1]) + (s2[2] + s2[3])) + ((s3[0] + s3[1]) + (s3[2] + s3[3]));
            const float hs = __builtin_amdgcn_rsqf(ssx * (1.0f / 1024.0f) + EPS) * PEER_H4_SCALE;
            { const bf16* xr = (const bf16*)(F.ws + WS_XG) + t * 1024 + 16 * lane; const u32x4 w0 = *(const u32x4*)xr, w1 = *(const u32x4*)(xr + 8);
              u32x2 hq;
              hq.x = __builtin_amdgcn_cvt_scalef32_pk_fp4_f32(0u, bflo(w0[0]) * hs, bfhi(w0[0]) * hs, 1.0f, 0); hq.x = __builtin_amdgcn_cvt_scalef32_pk_fp4_f32(hq.x, bflo(w0[1]) * hs, bfhi(w0[1]) * hs, 1.0f, 1);
              hq.x = __builtin_amdgcn_cvt_scalef32_pk_fp4_f32(hq.x, bflo(w0[2]) * hs, bfhi(w0[2]) * hs, 1.0f, 2); hq.x = __builtin_amdgcn_cvt_scalef32_pk_fp4_f32(hq.x, bflo(w0[3]) * hs, bfhi(w0[3]) * hs, 1.0f, 3);
              hq.y = __builtin_amdgcn_cvt_scalef32_pk_fp4_f32(0u, bflo(w1[0]) * hs, bfhi(w1[0]) * hs, 1.0f, 0); hq.y = __builtin_amdgcn_cvt_scalef32_pk_fp4_f32(hq.y, bflo(w1[1]) * hs, bfhi(w1[1]) * hs, 1.0f, 1);
              hq.y = __builtin_amdgcn_cvt_scalef32_pk_fp4_f32(hq.y, bflo(w1[2]) * hs, bfhi(w1[2]) * hs, 1.0f, 2); hq.y = __builtin_amdgcn_cvt_scalef32_pk_fp4_f32(hq.y, bflo(w1[3]) * hs, bfhi(w1[3]) * hs, 1.0f, 3);
              *(LAS u32x2*)(hrow + 8 * lane) = hq; }
            const float ascale = 1.0f / (PEER_H4_SCALE * PEER_UF4_SCALE);
            const int slot = kslot & 1;
            while (flags[cidx * 2 + slot] != 1u) __builtin_amdgcn_s_sleep(2);
            asm volatile("" ::: "memory");
            if (!PSKIP(1)) peer_topk_second((const LAS float*)(F.lds + (cidx * 2 + slot) * PEER_SLOT_BYTES), (const LAS int*)(F.lds + (cidx * 2 + slot) * PEER_SLOT_BYTES + 1024), sidx, sgate, lane, dry ? PROBE_EMASK : 16383);
            asm volatile("s_waitcnt lgkmcnt(0)" ::: "memory");
            if (lane == 0) flags[cidx * 2 + slot] = 0u;
#define PEER_ISSUE4V(pp0) do { if (PROBE_NODMA && dry) break; const int pp_ = (pp0); const LAS int* ip_ = sidx + 2 * (pp_ & 63) + (lane >> 5); \
                const unsigned v0_ = (unsigned)ip_[0] + lo16 + 4096u, v1_ = (unsigned)ip_[2] + lo16 + 3072u, v2_ = (unsigned)ip_[4] + lo16 + 2048u, v3_ = (unsigned)ip_[6] + lo16 + 1024u; \
                glds16s_x4(Vb - 4096, v0_, v1_, v2_, v3_, (unsigned)__builtin_amdgcn_readfirstlane((int)(ringb + (unsigned)(pp_ & (PEER_R - 1)) * 1024u))); } while (0)
#define PEER_ISSUE4U(pp0, hi8) do { if (PROBE_NODMA && dry) break; const int pp_ = (pp0); const LAS int* ip_ = sidx + 2 * pp_ + (lane >> 5); \
                const unsigned v0_ = (unsigned)ip_[0] + (usw[0] ^ (hi8)), v1_ = (unsigned)ip_[2] + (usw[1] ^ (hi8)), v2_ = (unsigned)ip_[4] + (usw[2] ^ (hi8)), v3_ = (unsigned)ip_[6] + (usw[3] ^ (hi8)); \
                glds16s_x4(Ub - 4096, v0_, v1_, v2_, v3_, (unsigned)__builtin_amdgcn_readfirstlane((int)(ringb + (unsigned)(pp_ & (PEER_R - 1)) * 1024u))); } while (0)
            PEER_ISSUE4U(0, 0u); PEER_ISSUE4U(4, 128u); PEER_ISSUE4U(8, 0u); PEER_ISSUE4U(12, 128u);
            i32x4 hA[8];
#pragma unroll
            for (int ks = 0; ks < 8; ++ks) hA[ks] = *(const LAS i32x4*)(hrow + 64 * ks + 16 * grp);
            float dotA = 0.f, dotB = 0.f;
#pragma unroll 1
            for (int tp = PSKIP(2) ? 4 : 0; tp < 4; ++tp) {
#pragma unroll
                for (int par = 0; par < 2; ++par) { const int tt = 2 * tp + par;
                    asm volatile("s_waitcnt vmcnt(8)" ::: "memory");
                    f32x4 acc = {0.f, 0.f, 0.f, 0.f};
#pragma unroll
                    for (int ks = 0; ks < 8; ++ks) { const i32x4 b_ = *(const LAS i32x4*)(uadr[ks & 3] + 256 * (ks >> 2) + 8192 * par);
                        const i32x8 b8_ = {b_.x, b_.y, b_.z, b_.w, 0, 0, 0, 0};
                        const i32x8 a8_ = {hA[ks].x, hA[ks].y, hA[ks].z, hA[ks].w, 0, 0, 0, 0};
                        acc = __builtin_amdgcn_mfma_scale_f32_16x16x128_f8f6f4(a8_, b8_, acc, 4  , 4  , 0, 127, 0, 127); }
                    dotA = (tt == grp) ? acc[0] : dotA; dotB = (tt == grp + 4) ? acc[0] : dotB;
                    __builtin_amdgcn_sched_barrier(0);
                    if (tp < 3) { PEER_ISSUE4U(8 * tt + 16, 0u); PEER_ISSUE4U(8 * tt + 20, 128u); } else { PEER_ISSUE4V(64 + 8 * par); PEER_ISSUE4V(64 + 8 * par + 4); }
                    __builtin_amdgcn_sched_barrier(0); }
            }
            unsigned loA, hiA, loB, hiB; float bscA, bscB;
            { const float av = dotA * ascale, bv = dotB * ascale;
              const float cA = sgate[lane] * (0.5f * av * (1.0f + erff(av * 0.70710678118654752f))), cB = sgate[64 + lane] * (0.5f * bv * (1.0f + erff(bv * 0.70710678118654752f)));
              const float mxA = __builtin_bit_cast(float, row_max16(__builtin_bit_cast(unsigned, fabsf(cA)))), mxB = __builtin_bit_cast(float, row_max16(__builtin_bit_cast(unsigned, fabsf(cB))));
              const float qsA = mxA > 0.f ? 7.0f * __builtin_amdgcn_rcpf(mxA) : 0.f, qsB = mxB > 0.f ? 7.0f * __builtin_amdgcn_rcpf(mxB) : 0.f;
              const unsigned cqA = ((unsigned)(int)__builtin_rintf(cA * qsA) & 15u) << (4 * (lane & 7)), cqB = ((unsigned)(int)__builtin_rintf(cB * qsB) & 15u) << (4 * (lane & 7));
              loA = (lane & 8) ? 0u : cqA; hiA = (lane & 8) ? cqA : 0u; loB = (lane & 8) ? 0u : cqB; hiB = (lane & 8) ? cqB : 0u;
              loA |= dpp_u<0xB1>(loA); loA |= dpp_u<0x4E>(loA); loA |= dpp_u<0x141>(loA); loA |= dpp_u<0x140>(loA);
              hiA |= dpp_u<0xB1>(hiA); hiA |= dpp_u<0x4E>(hiA); hiA |= dpp_u<0x141>(hiA); hiA |= dpp_u<0x140>(hiA);
              loB |= dpp_u<0xB1>(loB); loB |= dpp_u<0x4E>(loB); loB |= dpp_u<0x141>(loB); loB |= dpp_u<0x140>(loB);
              hiB |= dpp_u<0xB1>(hiB); hiB |= dpp_u<0x4E>(hiB); hiB |= dpp_u<0x141>(hiB); hiB |= dpp_u<0x140>(hiB);
              bscA = mxA * (1.0f / 7.0f); bscB = mxB * (1.0f / 7.0f); }
            float* xo = F.out + t * 1024 + lane;
            float* xst = dry ? (float*)(F.ws + WS_PROJ + (128u << 20)) + (size_t)tl * 1024 + lane : xo;
            float xa[16];
#pragma unroll
            for (int cb = 0; cb < 16; ++cb) xa[cb] = xo[64 * cb];
            float oacc[16];
#pragma unroll
            for (int cb = 0; cb < 16; ++cb) oacc[cb] = 0.f;
            typedef int i32x2 __attribute__((ext_vector_type(2)));
#pragma unroll 1
            for (int vb = PSKIP(3) ? 8 : 0; vb < 8; ++vb) {
                if (vb < 7) asm volatile("s_waitcnt vmcnt(8)" ::: "memory"); else asm volatile("s_waitcnt vmcnt(0)" ::: "memory");
                const int sl_ = 16 * (vb & 3);
                const int clo = __builtin_amdgcn_readlane((int)(vb < 4 ? loA : loB), sl_), chi = __builtin_amdgcn_readlane((int)(vb < 4 ? hiA : hiB), sl_);
                const float bsc = __builtin_bit_cast(float, __builtin_amdgcn_readlane(__builtin_bit_cast(int, vb < 4 ? bscA : bscB), sl_));
                const LAS unsigned char* rowp = ring + (16 * (vb & 1) + (lane & 15)) * 512 + 8 * (lane >> 4);
#pragma unroll
                for (int cb = 0; cb < 16; ++cb) {
                    const i32x2 tr = __builtin_amdgcn_ds_read_tr4_b64_v2i32((LAS i32x2*)(rowp + 32 * cb));
                    const int ai = __builtin_amdgcn_sdot8(chi, tr.y, __builtin_amdgcn_sdot8(clo, tr.x, 0, false), false);
                    oacc[cb] += (float)ai * bsc;
                }
                if (vb < 6) { PEER_ISSUE4V(64 + 8 * vb + 16); PEER_ISSUE4V(64 + 8 * vb + 20); }
            }
#undef PEER_ISSUE4U
#undef PEER_ISSUE4V
            const float* gfp = F.final_norm_g + lane;
            float ss = 0.f;
#pragma unroll
            for (int cb = 0; cb < 16; ++cb) { xa[cb] = xa[cb] + oacc[cb] * (1.0f / PEER_U_SCALE); ss += xa[cb] * xa[cb]; }
            ss = row_sum16(ss); ss += bperm_f(a16, ss); ss += bperm_f(a32, ss);
            const float rf = __builtin_amdgcn_rsqf(ss * (1.0f / 1024.0f) + EPS);
#pragma unroll
            for (int cb = 0; cb < 16; ++cb) xst[64 * cb] = xa[cb] * rf * gfp[64 * cb];
            asm volatile("" :: "v"(tch1), "v"(tch2), "v"(tch3));
        }
    }
}

DI void convert_uv(Frame& F, int part, int nparts, int cu, int ncu) {
    F.refresh();
    const int gt = cu * 512 + F.tid, NGT = ncu * 512, per = (2 * 16384 * 64) / nparts;
    for (int id = part * per + gt; id < (part + 1) * per; id += NGT) {
        const int which = id >> 20, off = (id & ((1 << 20) - 1)) * 16;
        const float* src = (which ? F.peer_v : F.peer_u) + off; unsigned char* dst = F.ws + (which ? WS_V : WS_U) + off / 2;
        u32x2 o;
        if (which == 0) {
#pragma unroll
            for (int q = 0; q < 2; ++q) { const f32x4 v0 = *(const f32x4*)(src + 8 * q) * PEER_UF4_SCALE, v1 = *(const f32x4*)(src + 8 * q + 4) * PEER_UF4_SCALE;
                unsigned pk = __builtin_amdgcn_cvt_scalef32_pk_fp4_f32(0u, v0.x, v0.y, 1.0f, 0); pk = __builtin_amdgcn_cvt_scalef32_pk_fp4_f32(pk, v0.z, v0.w, 1.0f, 1);
                pk = __builtin_amdgcn_cvt_scalef32_pk_fp4_f32(pk, v1.x, v1.y, 1.0f, 2); pk = __builtin_amdgcn_cvt_scalef32_pk_fp4_f32(pk, v1.z, v1.w, 1.0f, 3); o[q] = pk; }
        } else {
#pragma unroll
            for (int q = 0; q < 2; ++q) { const f32x4 v0 = *(const f32x4*)(src + 8 * q) * PEER_U_SCALE, v1 = *(const f32x4*)(src + 8 * q + 4) * PEER_U_SCALE; unsigned pk = 0u;
#pragma unroll
                for (int k = 0; k < 4; ++k) { pk |= ((unsigned)(int)__builtin_rintf(fminf(fmaxf(v0[k], -7.f), 7.f)) & 15u) << (4 * k); pk |= ((unsigned)(int)__builtin_rintf(fminf(fmaxf(v1[k], -7.f), 7.f)) & 15u) << (16 + 4 * k); }
                o[q] = pk; }
        }
        *(u32x2*)dst = o;
    }
}

constexpr int N_PHASES = 19;
struct Args { const float* in[17]; float* out; unsigned char* ws; int ph_lo, ph_hi; };

__global__ void __launch_bounds__(NWAVES * 64, 2) fwd_kernel(Args args) {
    extern __shared__ __attribute__((aligned(16))) unsigned char lds_raw[];
    Frame F;
    F.lds = (LAS unsigned char*)lds_raw;
    F.tid = threadIdx.x; F.lane = F.tid & 63; F.wave = __builtin_amdgcn_readfirstlane(F.tid >> 6);
    F.G = gridDim.x; { const int bx = blockIdx.x; F.vcu = (F.G % 8 == 0) ? (bx % 8) * (F.G / 8) + bx / 8 : bx; }
    F.x = args.in[0]; F.mem = args.in[1]; F.norm_mix_g = args.in[2]; F.w_in = args.in[3]; F.hg_lb = args.in[4]; F.hg_norm_g = args.in[5]; F.sc_conv_w = args.in[6];
    F.mem_norm_g = args.in[7]; F.w_mem_kv = args.in[8]; F.w_branch = args.in[9]; F.w_out = args.in[10]; F.norm_ffn_g = args.in[11]; F.peer_w_q = args.in[12];
    F.peer_sub_keys = args.in[13]; F.peer_u = args.in[14]; F.peer_v = args.in[15]; F.final_norm_g = args.in[16];
    F.out = args.out; F.ws = args.ws;
    volatile LAS unsigned* MISC = (volatile LAS unsigned*)(F.lds + MISC_OFF);
    for (int u = F.tid; u < (LDS_BYTES - MISC_OFF) / 4; u += NWAVES * 64) MISC[u] = 0u;
    __syncthreads();
    unsigned* barw = (unsigned*)(F.ws + WS_CTL) + CW_BAR;
    XcdBarrier bar; bar.bar = barw; bar.x = 0; bar.st = nullptr;
    const bool one_launch = (args.ph_hi - args.ph_lo) > 1;
    if (one_launch) bar = xcd_barrier_post(barw, MISC + 8);
    const int lo = args.ph_lo, hi = args.ph_hi;
#define IN(k) (lo <= (k) && (k) < hi)
#ifndef PMASK
#define PMASK 0x3ff
#endif
#define PC_(c) ((PMASK >> (c)) & 1)
#ifndef REP_MASK
#define REP_MASK 0
#endif
#define REPS(c) for (int rep_ = 0; rep_ < 1 + 2 * ((REP_MASK >> (c)) & 1); ++rep_)
#define SEAM(k) do { if (IN(k) && IN((k) + 1)) xcd_barrier(bar); } while (0)
    unsigned char* ws = F.ws;
    const int G = F.G, cid = (int)blockIdx.x;

    if (PC_(0) && IN(0)) { REPS(0) p0_prologue(F); } SEAM(0);

#pragma unroll 1
    for (int g = 0; g < NGRP; ++g) {
        const int pb = 1 + 6 * g;
        if (PC_(1) && IN(pb)) REPS(1) {
            pg8::InOrder S; S.init(TG, PC, G, cid); S.H = (const char*)(ws + WS_XG) + (size_t)g * TG * 1024 * 2; S.Win = (const char*)(ws + WS_WIN); S.Mn = (const char*)(ws + WS_MN); S.Wkv = (const char*)(ws + WS_WKV); S.n_extra = (g == 0) ? 64 : 0;
            pg8::EpiIn E{(bf16*)(ws + WS_PROJ), (bf16*)(ws + WS_KMEM), (bf16*)(ws + WS_VT)};
            pg8::gemm_phase<pg8::EpiIn, pg8::InOrder, true, true>(F.lds, pg8::Gemm{1024, 1024, 1024}, S, E);
            if (cid >= 128) convert_uv(F, g, NGRP, cid - 128, G - 128);
        } SEAM(pb);
        if (PC_(2) && IN(pb + 1)) REPS(2) {
            for (int it = F.vcu * 4; it < BG * 4 * NCHUNK; it += G * 4) { for (int k = 0; k < 4; ++k) hgrn_a_item(F, it + k, k < 3); }
            for (int it = F.vcu; it < BG * 4 * 8; it += G) attn_item(F, g, it);
            conv_phase(F);
        } SEAM(pb + 1);
        if (PC_(3) && IN(pb + 2)) { REPS(3) hgrn_scan(F); } SEAM(pb + 2);
        if (PC_(4) && IN(pb + 3)) REPS(4) { for (int it = F.vcu * 4; it < BG * 4 * NCHUNK; it += G * 4) { for (int k = 0; k < 4; ++k) hgrn_c_item(F, it + k, k < 3); } } SEAM(pb + 3);
        if (PC_(5) && IN(pb + 4)) REPS(5) {
            pg8::BranchOrder S; S.init(TG, 1024, G, cid); S.Y = (const char*)(ws + WS_YHG); S.Wb = (const char*)(ws + WS_WBR);
            pg8::EpiBranch E{(const bf16*)(ws + WS_PROJ), (bf16*)(ws + WS_MACC), (bf16*)(ws + WS_MERGED)};
            pg8::gemm_phase<pg8::EpiBranch, pg8::BranchOrder, true, true>(F.lds, pg8::Gemm{512, 512, 512}, S, E);
        } SEAM(pb + 4);
        if (PC_(6) && IN(pb + 5)) REPS(6) {
            pg8::PlainOrder S; S.init(TG, 1024, G, cid); S.A = (const char*)(ws + WS_MERGED); S.Bt = (const char*)(ws + WS_WOUT); S.a_tile = 256 * 1024 * 2; S.b_tile = 256 * 1024 * 2;
            pg8::EpiOut E{F.x + (size_t)g * TG * 1024, F.out + (size_t)g * TG * 1024, (bf16*)(ws + WS_XG) + (size_t)g * TG * 1024, F.norm_ffn_g, (float*)(ws + WS_SSP) + (size_t)g * TG * 16};
            pg8::gemm_phase<pg8::EpiOut, pg8::PlainOrder, true, true>(F.lds, pg8::Gemm{1024, 1024, 1024}, S, E);
        } SEAM(pb + 5);
    }
#pragma unroll 1
    for (int tg = 0; tg < NGRP; ++tg) {
        const int pb = 13 + 3 * tg;
        if (PC_(7) && IN(pb)) REPS(7) {
            pg8::PlainOrder S; S.init(TG, 2048, G, cid); S.A = (const char*)(ws + WS_XG) + (size_t)tg * TG * 1024 * 2; S.Bt = (const char*)(ws + WS_WQ); S.a_tile = 256 * 1024 * 2; S.b_tile = 256 * 1024 * 2;
            pg8::EpiQ E{(bf16*)(ws + WS_Q), 2048, (const float*)(ws + WS_SSP) + (size_t)tg * TG * 16};
            pg8::gemm_phase<pg8::EpiQ, pg8::PlainOrder, true, true>(F.lds, pg8::Gemm{1024, 1024, 1024}, S, E);
        } SEAM(pb);
        if (PC_(8) && IN(pb + 1)) REPS(8) {
            pg8::ScoreOrder S; S.init(TG, 2048, G, cid); S.Q = (const char*)(ws + WS_Q); S.Kbd = (const char*)(ws + WS_KBD);
            pg8::EpiF32 E{(float*)(ws + WS_S), 2048};
            pg8::gemm_phase<pg8::EpiF32, pg8::ScoreOrder, true, true>(F.lds, pg8::Gemm{2048, 256, 256}, S, E);
        } SEAM(pb + 1);
        if (PC_(9) && IN(pb + 2)) { REPS(9) peer_phase(F, tg, rep_ < 2 * ((REP_MASK >> 9) & 1)); } SEAM(pb + 2);
    }
#undef IN
#undef SEAM
}

extern "C" void kernel_launch(void* const* d_in, const int* in_sizes, int n_in, void* d_out, int out_size, void* d_ws, size_t ws_size, hipStream_t stream) {
    static int ready = 0;
    if (ready == 0) {
        if (n_in != 17 || out_size != T_ALL * D_MODEL || ws_size < WS_END) { fprintf(stderr, "kernel_launch: unexpected shapes (n_in %d, out %d, ws %zu)\n", n_in, out_size, ws_size); ready = -1; return; }
        if (hipFuncSetAttribute((const void*)fwd_kernel, hipFuncAttributeMaxDynamicSharedMemorySize, LDS_BYTES) != hipSuccess) { fprintf(stderr, "kernel_launch: hipFuncSetAttribute failed\n"); ready = -1; return; }
        ready = 1;
    }
    if (ready < 0) return;
    (void)hipMemsetAsync((char*)d_ws + WS_CTL, 0, CTL_ZERO_BYTES, stream);
    Args a{};
    for (int i = 0; i < 17; ++i) a.in[i] = (const float*)d_in[i];
    a.out = (float*)d_out; a.ws = (unsigned char*)d_ws;
    const int grid = 256;
#if MK_N_LAUNCHES == 1
    a.ph_lo = 0; a.ph_hi = N_PHASES;
    hipLaunchKernelGGL(fwd_kernel, dim3(grid), dim3(NWAVES * 64), LDS_BYTES, stream, a);
#else
    for (int li = 0; li < N_PHASES; ++li) { a.ph_lo = li; a.ph_hi = li + 1; hipLaunchKernelGGL(fwd_kernel, dim3(grid), dim3(NWAVES * 64), LDS_BYTES, stream, a); }
#endif
}
```

```cpp
#include <hip/hip_runtime.h>
#include <cstdio>
#include <cstdint>

#ifndef MK_N_LAUNCHES
#define MK_N_LAUNCHES 1
#endif

#define LAS __attribute__((address_space(3)))
#define GAS __attribute__((address_space(1)))
typedef unsigned short bf16;
typedef short bf16x8 __attribute__((ext_vector_type(8)));
typedef short s16x4 __attribute__((ext_vector_type(4)));
typedef short v4i16_t __attribute__((ext_vector_type(4)));
typedef float f32x2 __attribute__((ext_vector_type(2)));
typedef float f32x4 __attribute__((ext_vector_type(4)));
typedef float f32x16 __attribute__((ext_vector_type(16)));
typedef unsigned u32x2 __attribute__((ext_vector_type(2)));
typedef unsigned u32x4 __attribute__((ext_vector_type(4)));
typedef __bf16 bf16x2_t __attribute__((ext_vector_type(2)));
typedef GAS unsigned gu32;
#define RLX_AGENT __ATOMIC_RELAXED, __HIP_MEMORY_SCOPE_AGENT
#define DI __device__ __forceinline__

constexpr int D_MODEL = 1024, BATCH = 16, SEQ = 2048, T_ALL = BATCH * SEQ;
constexpr int NGRP = 2, BG = BATCH / NGRP, TG = BG * SEQ;
constexpr int PC = 7680;
constexpr int C_HQ = 0, C_HI = 512, C_FF = 1024, C_FB = 1536, C_HG = 2048, C_SB = 2560, C_SC = 3072, C_SH = 3584, C_MQ = 4096, C_GATE = 4608;
constexpr int NMEM = 256, CHUNK = 64, NCHUNK = SEQ / CHUNK;
constexpr float EPS = 1e-6f;

constexpr size_t MiB = 1u << 20;
constexpr size_t WS_CTL = 0, CTL_ZERO_BYTES = 1 * MiB;
constexpr size_t WS_LB = 1 * MiB;
constexpr size_t WS_SSP = 2 * MiB;
constexpr size_t WS_DEC = 4 * MiB;
constexpr size_t WS_WIN = 5 * MiB, WS_WKV = 20 * MiB, WS_WBR = 22 * MiB, WS_WOUT = 25 * MiB, WS_WQ = 27 * MiB, WS_KBD = 31 * MiB;
constexpr size_t WS_MN = 32 * MiB, WS_KMEM = 40 * MiB, WS_VT = 44 * MiB;
constexpr size_t WS_XG = 48 * MiB;
constexpr size_t WS_YHG = 112 * MiB, WS_YSC = 128 * MiB, WS_YMX = 144 * MiB;
constexpr size_t WS_DS = 160 * MiB;
constexpr size_t WS_MACC = 160 * MiB;
constexpr size_t WS_MERGED = 224 * MiB;
constexpr size_t WS_PROJ = 256 * MiB;
constexpr size_t WS_U = 496 * MiB, WS_V = 504 * MiB;
constexpr size_t WS_Q = 176 * MiB;
constexpr size_t WS_S = 256 * MiB;
constexpr size_t WS_END = 512 * MiB;
constexpr size_t OUT_SST = 64 * MiB;

constexpr int LDS_BYTES = 160 * 1024;
constexpr int MISC_OFF = LDS_BYTES - 512;
constexpr int NWAVES = 8;

DI unsigned f2bf(float f) { unsigned u = __builtin_bit_cast(unsigned, f); return (u + 0x7fffu + ((u >> 16) & 1u)) >> 16; }
DI unsigned pk2(float lo, float hi) { return f2bf(lo) | (f2bf(hi) << 16); }
DI float bf2f(unsigned short b) { return __builtin_bit_cast(float, (unsigned)b << 16); }
DI float bflo(unsigned w) { return __builtin_bit_cast(float, w << 16); }
DI float bfhi(unsigned w) { return __builtin_bit_cast(float, w & 0xffff0000u); }
DI float wave_sum(float v) {
#pragma unroll
    for (int o = 1; o < 64; o <<= 1) v += __shfl_xor(v, o);
    return v;
}
DI unsigned cvtpk(float lo, float hi) { f32x2 v = {lo, hi}; bf16x2_t b = __builtin_convertvector(v, bf16x2_t); return __builtin_bit_cast(unsigned, b); }
template <int CTRL> DI unsigned dpp_u(unsigned v) { return (unsigned)__builtin_amdgcn_update_dpp(0, (int)v, CTRL, 0xF, 0xF, false); }
template <int CTRL> DI float dpp_f(float v) { return __builtin_bit_cast(float, __builtin_amdgcn_update_dpp(0, __builtin_bit_cast(int, v), CTRL, 0xF, 0xF, false)); }
DI float bperm_f(int addr, float v) { return __builtin_bit_cast(float, __builtin_amdgcn_ds_bpermute(addr, __builtin_bit_cast(int, v))); }
DI unsigned row_max16(unsigned m) { m = max(m, dpp_u<0xB1>(m)); m = max(m, dpp_u<0x4E>(m)); m = max(m, dpp_u<0x141>(m)); return max(m, dpp_u<0x140>(m)); }
DI float row_sum16(float v) { v += dpp_f<0xB1>(v); v += dpp_f<0x4E>(v); v += dpp_f<0x141>(v); return v + dpp_f<0x140>(v); }

DI float fast_sig(float z) { return __builtin_amdgcn_rcpf(1.0f + __builtin_amdgcn_exp2f(-1.4426950408889634f * z)); }
DI float sigmoidf_(float z) { return 1.0f / (1.0f + __expf(-z)); }

namespace pg8 {
constexpr int BM = 256, BK = 64, HALF = 128, HTB = HALF * BK * 2, STAGE_BYTES = 8 * HTB, NXCD = 8, WGM = 8;
__host__ __device__ __forceinline__ int lds_byte(int r, int c) { const int st = (r >> 4) * 2 + (c >> 5), rr = r & 15, cc = c & 31, ob = rr * 64 + cc * 2; return st * 1024 + (ob ^ (((ob >> 9) & 1) << 5)); }
__host__ __device__ __forceinline__ void stage_rc(int b, int& R, int& C) { const int st = b / 1024, sb = b % 1024, swz = sb ^ (((sb >> 9) & 1) << 5); R = (st >> 1) * 16 + swz / 64; C = (st & 1) * 32 + (swz % 64) / 2; }
__host__ __device__ __forceinline__ int perm32(int rho) { const int n = rho >> 4, i = rho & 15; return 8 * (i >> 2) + 4 * n + (i & 3); }

struct Unit { int pm, pn, z; };
struct Gemm { int lda, ldb, K; };

struct StaticOrder {
    int nM, nN, nwg, G, c;
    __device__ void init(int M, int N, int G_, int c_) { nM = M / BM; nN = N / BM; nwg = nM * nN; G = G_; c = c_; }
    __device__ bool tile(int i, Unit& u) const {
        const long L = (long)i * G + c; if (L >= nwg) return false;
        int wgid = (int)L; { const int q = nwg / NXCD, r = nwg % NXCD, xcd = wgid % NXCD, off = wgid / NXCD; wgid = (xcd < r ? xcd * (q + 1) : r * (q + 1) + (xcd - r) * q) + off; }
        const int nig = WGM * nN, gid = wgid / nig, fm = gid * WGM, gsz = (nM - fm) < WGM ? (nM - fm) : WGM;
        u.pm = fm + ((wgid % nig) % gsz); u.pn = (wgid % nig) / gsz; u.z = 0; return true;
    }
};

DI unsigned cvt_pk_bf16(float lo, float hi) { return cvtpk(lo, hi); }

template <class Epi, class Sched, bool ALIGN_EPI, bool SP2>
DI void gemm_phase(LAS unsigned char* lds, const Gemm g, const Sched& S, const Epi& E) {
    int tid_ = threadIdx.x; asm volatile("" : "+v"(tid_));
    const int tid = tid_, wid = __builtin_amdgcn_readfirstlane(tid >> 6), lane = tid & 63, wr = wid >> 2, wc = wid & 3, fr = lane & 15, fq = lane >> 4;
    int K_ = g.K; asm volatile("" : "+s"(K_));
    const int K = K_, nt = K / BK;
    unsigned voffA[2], voffB[2];
#pragma unroll
    for (int i = 0; i < 2; ++i) { int R, C; stage_rc(tid * 16 + i * 8192, R, C); const int Rb = Epi::PERM ? ((R & ~31) + perm32(R & 31)) : R;
        voffA[i] = (unsigned)(R * g.lda + C) * 2u; voffB[i] = (unsigned)(Rb * g.ldb + C) * 2u; }
    const size_t kstep = (size_t)(BK * 2);
    const size_t hA = (size_t)HALF * g.lda * 2, hB = (size_t)HALF * g.ldb * 2;
    const unsigned ldsw = (unsigned)wid * 1024u;
    const int aoff = lds_byte(wr * 64 + fr, fq * 8), boff = lds_byte(wc * 32 + fr, fq * 8);
#define PG8_SA(b, h) (((b) * 2 + (h)) * HTB)
#define PG8_SB(b, h) ((4 + (b) * 2 + (h)) * HTB)
#define PG8_STAGE(bufoff, gbase, voff) do { _Pragma("unroll") for (int _i = 0; _i < 2; ++_i) \
        __builtin_amdgcn_global_load_lds((const unsigned*)((const char*)(gbase) + (voff)[_i]), (LAS unsigned*)(lds + (bufoff) + ldsw + _i * 8192), 16, 0, 0); } while (0)
#define PG8_LDA(dst, b, h) do { _Pragma("unroll") for (int m = 0; m < 4; ++m) _Pragma("unroll") for (int k = 0; k < 2; ++k) dst[m][k] = *(const LAS bf16x8*)(lds + PG8_SA(b, h) + aoff + m * 2048 + k * 1024); } while (0)
#define PG8_LDB(dst, b, h) do { _Pragma("unroll") for (int n = 0; n < 2; ++n) _Pragma("unroll") for (int k = 0; k < 2; ++k) dst[n][k] = *(const LAS bf16x8*)(lds + PG8_SB(b, h) + boff + n * 2048 + k * 1024); } while (0)
#define PG8_MMA(ai, bj, At, Bt) do { __builtin_amdgcn_s_setprio(1); _Pragma("unroll") for (int m = 0; m < 4; ++m) _Pragma("unroll") for (int n = 0; n < 2; ++n) _Pragma("unroll") for (int k = 0; k < 2; ++k) \
        acc[ai][bj][m][n] = __builtin_amdgcn_mfma_f32_16x16x32_bf16(Bt[n][k], At[m][k], acc[ai][bj][m][n], 0, 0, 0); __builtin_amdgcn_s_setprio(0); } while (0)
#define PG8_WAIT_V(n) asm volatile("s_waitcnt vmcnt(" #n ")" ::: "memory")
#define PG8_WAIT_L(n) asm volatile("s_waitcnt lgkmcnt(" #n ")" ::: "memory")
#define PG8_BAR __builtin_amdgcn_s_barrier()
#define PG8_SCHED __builtin_amdgcn_sched_barrier(0)
    Unit cur, nxt; int ui = 0;
    if (!S.next(0, cur)) return;
    f32x4 acc[2][2][4][2];
#pragma unroll
    for (int a = 0; a < 2; ++a)
#pragma unroll
        for (int b = 0; b < 2; ++b)
#pragma unroll
            for (int m = 0; m < 4; ++m)
#pragma unroll
                for (int n = 0; n < 2; ++n) acc[a][b][m][n] = (f32x4){0.f, 0.f, 0.f, 0.f};
    bf16x8 At[4][2], B0[2][2], B1[2][2];
    const char* cA = S.a_base(cur); const char* cB = S.b_base(cur);
    if constexpr (SP2) {
        PG8_STAGE(PG8_SB(0, 0), cB, voffB); PG8_STAGE(PG8_SB(0, 1), cB + hB, voffB); PG8_STAGE(PG8_SA(0, 0), cA, voffA); PG8_STAGE(PG8_SA(0, 1), cA + hA, voffA);
        if (wr == 1) PG8_BAR;
        PG8_WAIT_V(2); PG8_BAR;
        PG8_STAGE(PG8_SB(1, 0), cB + kstep, voffB); PG8_STAGE(PG8_SA(1, 0), cA + kstep, voffA); PG8_STAGE(PG8_SB(1, 1), cB + hB + kstep, voffB);
        PG8_WAIT_V(6); PG8_BAR;
    } else {
        PG8_STAGE(PG8_SB(0, 0), cB, voffB); PG8_STAGE(PG8_SA(0, 0), cA, voffA); PG8_STAGE(PG8_SB(0, 1), cB + hB, voffB); PG8_STAGE(PG8_SA(0, 1), cA + hA, voffA);
        if (wr == 1) PG8_BAR;
        PG8_WAIT_V(4); PG8_BAR;
        PG8_STAGE(PG8_SB(1, 0), cB + kstep, voffB); PG8_STAGE(PG8_SA(1, 0), cA + kstep, voffA); PG8_STAGE(PG8_SB(1, 1), cB + hB + kstep, voffB);
        PG8_WAIT_V(6); PG8_BAR;
    }
    for (;;) {
        const bool has_next = S.next(ui + 1, nxt);
        const char* nA = has_next ? S.a_base(nxt) : cA; const char* nB = has_next ? S.b_base(nxt) : cB;
        for (int t = 0; t < nt; t += 2) {
            const bool last = (t == nt - 2);
            const char* a1 = cA + (size_t)(t + 1) * kstep;
            const char* a2 = last ? nA : cA + (size_t)(t + 2) * kstep; const char* b2 = last ? nB : cB + (size_t)(t + 2) * kstep;
            const char* a3 = a2 + kstep; const char* b3 = b2 + kstep;
            if constexpr (SP2) {
            PG8_LDB(B0, 0, 0); PG8_LDB(B1, 0, 1); PG8_SCHED; PG8_LDA(At, 0, 0); PG8_STAGE(PG8_SA(1, 1), a1 + hA, voffA);
            PG8_WAIT_V(8); PG8_WAIT_L(0); PG8_BAR; PG8_MMA(0, 0, At, B0); PG8_MMA(0, 1, At, B1); PG8_BAR; PG8_SCHED;
            PG8_LDA(At, 0, 1); PG8_STAGE(PG8_SB(0, 0), b2, voffB); PG8_STAGE(PG8_SB(0, 1), b2 + hB, voffB); PG8_STAGE(PG8_SA(0, 0), a2, voffA);
            PG8_WAIT_V(8); PG8_WAIT_L(0); PG8_BAR; PG8_MMA(1, 0, At, B0); PG8_MMA(1, 1, At, B1); PG8_BAR; PG8_SCHED;
            PG8_LDB(B0, 1, 0); PG8_LDB(B1, 1, 1); PG8_SCHED; PG8_LDA(At, 1, 0); PG8_STAGE(PG8_SA(0, 1), a2 + hA, voffA);
            PG8_WAIT_V(8); PG8_WAIT_L(0); PG8_BAR; PG8_MMA(0, 0, At, B0); PG8_MMA(0, 1, At, B1); PG8_BAR; PG8_SCHED;
            PG8_LDA(At, 1, 1); PG8_STAGE(PG8_SB(1, 0), b3, voffB); PG8_STAGE(PG8_SB(1, 1), b3 + hB, voffB); PG8_STAGE(PG8_SA(1, 0), a3, voffA);
            PG8_WAIT_V(8); PG8_WAIT_L(0); PG8_BAR; PG8_MMA(1, 0, At, B0); PG8_MMA(1, 1, At, B1); PG8_BAR; PG8_SCHED;
            } else {
            PG8_LDB(B0, 0, 0); PG8_SCHED; PG8_LDA(At, 0, 0); PG8_STAGE(PG8_SA(1, 1), a1 + hA, voffA);
            PG8_WAIT_L(8); PG8_BAR; PG8_WAIT_L(0); PG8_MMA(0, 0, At, B0); PG8_BAR; PG8_SCHED;
            PG8_LDB(B1, 0, 1); PG8_STAGE(PG8_SB(0, 0), b2, voffB);
            PG8_BAR; PG8_WAIT_L(0); PG8_MMA(0, 1, At, B1); PG8_BAR;
            PG8_LDA(At, 0, 1); PG8_STAGE(PG8_SA(0, 0), a2, voffA);
            PG8_BAR; PG8_WAIT_L(0); PG8_MMA(1, 0, At, B0); PG8_BAR; PG8_SCHED;
            PG8_STAGE(PG8_SB(0, 1), b2 + hB, voffB);
            PG8_WAIT_V(6); PG8_BAR; PG8_MMA(1, 1, At, B1); PG8_BAR;
            PG8_LDB(B0, 1, 0); PG8_SCHED; PG8_LDA(At, 1, 0); PG8_STAGE(PG8_SA(0, 1), a2 + hA, voffA);
            PG8_WAIT_L(8); PG8_BAR; PG8_WAIT_L(0); PG8_MMA(0, 0, At, B0); PG8_BAR; PG8_SCHED;
            PG8_LDB(B1, 1, 1); PG8_STAGE(PG8_SB(1, 0), b3, voffB);
            PG8_BAR; PG8_WAIT_L(0); PG8_MMA(0, 1, At, B1); PG8_BAR;
            PG8_LDA(At, 1, 1); PG8_STAGE(PG8_SA(1, 0), a3, voffA);
            PG8_BAR; PG8_WAIT_L(0); PG8_MMA(1, 0, At, B0); PG8_BAR; PG8_SCHED;
            PG8_STAGE(PG8_SB(1, 1), b3 + hB, voffB);
            PG8_WAIT_V(6); PG8_BAR; PG8_MMA(1, 1, At, B1); PG8_BAR;
            }
        }
        if constexpr (ALIGN_EPI) { if (wr == 0) PG8_BAR; }
        E(acc, cur, wr, wc, fr, fq);
        if (!has_next) break;
#pragma unroll
        for (int a = 0; a < 2; ++a)
#pragma unroll
            for (int b = 0; b < 2; ++b)
#pragma unroll
                for (int m = 0; m < 4; ++m)
#pragma unroll
                    for (int n = 0; n < 2; ++n) acc[a][b][m][n] = (f32x4){0.f, 0.f, 0.f, 0.f};
        cur = nxt; cA = nA; cB = nB; ++ui;
        if constexpr (ALIGN_EPI) { if (wr == 1) PG8_BAR; }
    }
    PG8_WAIT_V(0);
    if constexpr (!ALIGN_EPI) { if (wr == 0) PG8_BAR; }
    PG8_BAR;
#undef PG8_SA
#undef PG8_SB
#undef PG8_STAGE
#undef PG8_LDA
#undef PG8_LDB
#undef PG8_MMA
#undef PG8_WAIT_V
#undef PG8_WAIT_L
#undef PG8_BAR
#undef PG8_SCHED
}
}

namespace pg8 {
struct PlainOrder : StaticOrder {
    const char* A; const char* Bt; size_t a_tile, b_tile;
    __device__ bool next(int i, Unit& u) const { return tile(i, u); }
    DI const char* a_base(const Unit& u) const { return A + (size_t)u.pm * a_tile; }
    DI const char* b_base(const Unit& u) const { return Bt + (size_t)u.pn * b_tile; }
};
struct InOrder : StaticOrder {
    const char* H; const char* Win; const char* Mn; const char* Wkv; int n_extra;
    __device__ bool next(int i, Unit& u) const {
        const long L = (long)i * G + c;
        if (L >= (long)nwg + n_extra) return false;
        Unit t; t.pm = 0; t.pn = 0; t.z = 0;
        const bool main_tile = L < nwg;
        if (main_tile) (void)tile(i, t);
        const int e = (int)(L - nwg);
        const int pm1 = e >> 1, pn1 = e & 1, pm2 = (e - 32) >> 4, pn2 = (e - 32) & 15; const bool k1 = e < 32;
        u.pm = main_tile ? t.pm : (k1 ? pm1 : pm2); u.pn = main_tile ? t.pn : (k1 ? pn1 : pn2); u.z = main_tile ? 0 : (k1 ? 1 : 2);
        return true;
    }
    DI const char* a_base(const Unit& u) const { const long d1 = Mn - H, d2 = (Wkv + (size_t)512 * 1024 * 2) - H; return H + ((u.z == 1) ? d1 : 0L) + ((u.z == 2) ? d2 : 0L) + (size_t)u.pm * (256 * 1024 * 2); }
    DI const char* b_base(const Unit& u) const { const long d1 = Wkv - Win, d2 = Mn - Win; return Win + ((u.z == 1) ? d1 : 0L) + ((u.z == 2) ? d2 : 0L) + (size_t)u.pn * (256 * 1024 * 2); }
};
struct EpiIn {
    static constexpr bool PERM = true;
    bf16* proj; bf16* kmem; bf16* vt;
    DI void operator()(const f32x4 (&acc)[2][2][4][2], const Unit& u, int wr, int wc, int fr, int fq) const {
        const long dk = kmem - proj, dv = vt - proj; bf16* O = proj + ((u.z == 1) ? dk : 0L) + ((u.z == 2) ? dv : 0L); const int ldc = PC + ((u.z == 1) ? 512 - PC : 0) + ((u.z == 2) ? BATCH * NMEM - PC : 0);
        const int row0 = u.pm * BM + wr * 64 + fr, col0 = u.pn * BM + wc * 32 + 8 * fq;
#pragma unroll
        for (int ai = 0; ai < 2; ++ai)
#pragma unroll
            for (int m = 0; m < 4; ++m) { bf16* rowp = O + (size_t)(row0 + ai * HALF + m * 16) * ldc + col0;
#pragma unroll
                for (int bj = 0; bj < 2; ++bj) { const f32x4 v0 = acc[ai][bj][m][0], v1 = acc[ai][bj][m][1];
                    u32x4 w; w.x = cvt_pk_bf16(v0[0], v0[1]); w.y = cvt_pk_bf16(v0[2], v0[3]); w.z = cvt_pk_bf16(v1[0], v1[1]); w.w = cvt_pk_bf16(v1[2], v1[3]);
                    *(u32x4*)(rowp + bj * HALF) = w; } }
    }
};
struct BranchOrder : StaticOrder {
    const char* Y; const char* Wb;
    __device__ bool next(int i, Unit& u) const { if (!tile(i / 3, u)) return false; u.z = i % 3; return true; }
    DI const char* a_base(const Unit& u) const { return Y + (size_t)u.z * (16 * MiB) + (size_t)u.pm * (256 * 512 * 2); }
    DI const char* b_base(const Unit& u) const { return Wb + (size_t)u.z * (1024 * 512 * 2) + (size_t)u.pn * (256 * 512 * 2); }
};
struct ScoreOrder : StaticOrder {
    const char* Q; const char* Kbd;
    __device__ bool next(int i, Unit& u) const { return tile(i, u); }
    DI const char* a_base(const Unit& u) const { return Q + (size_t)u.pm * (256 * 2048 * 2) + (size_t)u.pn * 512; }
    DI const char* b_base(const Unit& u) const { return Kbd + (size_t)u.pn * (256 * 256 * 2); }
};

struct EpiBf16 {
    static constexpr bool PERM = true;
    bf16* O; int ldc;
    DI void operator()(const f32x4 (&acc)[2][2][4][2], const Unit& u, int wr, int wc, int fr, int fq) const {
        const int row0 = u.pm * BM + wr * 64 + fr, col0 = u.pn * BM + wc * 32 + 8 * fq;
#pragma unroll
        for (int ai = 0; ai < 2; ++ai)
#pragma unroll
            for (int m = 0; m < 4; ++m) { bf16* rowp = O + (size_t)(row0 + ai * HALF + m * 16) * ldc + col0;
#pragma unroll
                for (int bj = 0; bj < 2; ++bj) { const f32x4 v0 = acc[ai][bj][m][0], v1 = acc[ai][bj][m][1];
                    u32x4 w; w.x = cvt_pk_bf16(v0[0], v0[1]); w.y = cvt_pk_bf16(v0[2], v0[3]); w.z = cvt_pk_bf16(v1[0], v1[1]); w.w = cvt_pk_bf16(v1[2], v1[3]);
                    *(u32x4*)(rowp + bj * HALF) = w; } }
    }
};
struct EpiQ {
    static constexpr bool PERM = true;
    bf16* O; int ldc; const float* ssp;
    DI void operator()(const f32x4 (&acc)[2][2][4][2], const Unit& u, int wr, int wc, int fr, int fq) const {
        const int row0 = u.pm * BM + wr * 64 + fr, col0 = u.pn * BM + wc * 32 + 8 * fq;
#pragma unroll
        for (int ai = 0; ai < 2; ++ai)
#pragma unroll
            for (int m = 0; m < 4; ++m) { const int row = row0 + ai * HALF + m * 16; const f32x4* sp = (const f32x4*)(ssp + (size_t)row * 16);
                const f32x4 s0 = sp[0], s1 = sp[1], s2 = sp[2], s3 = sp[3];
                const float ss = ((s0[0] + s0[1]) + (s0[2] + s0[3])) + ((s1[0] + s1[1]) + (s1[2] + s1[3])) + ((s2[0] + s2[1]) + (s2[2] + s2[3])) + ((s3[0] + s3[1]) + (s3[2] + s3[3]));
                const float rs = 1.0f / sqrtf(ss * (1.0f / 1024.0f) + EPS);
                bf16* rowp = O + (size_t)row * ldc + col0;
#pragma unroll
                for (int bj = 0; bj < 2; ++bj) { const f32x4 v0 = acc[ai][bj][m][0] * rs, v1 = acc[ai][bj][m][1] * rs;
                    u32x4 w; w.x = cvt_pk_bf16(v0[0], v0[1]); w.y = cvt_pk_bf16(v0[2], v0[3]); w.z = cvt_pk_bf16(v1[0], v1[1]); w.w = cvt_pk_bf16(v1[2], v1[3]);
                    *(u32x4*)(rowp + bj * HALF) = w; }
                asm volatile("" ::: "memory"); }
    }
};
struct EpiF32 {
    static constexpr bool PERM = false;
    float* C; int ldc;
    DI void operator()(const f32x4 (&acc)[2][2][4][2], const Unit& u, int wr, int wc, int fr, int fq) const {
        const int row0 = u.pm * BM + wr * 64 + fr, col0 = u.pn * BM + wc * 32 + 4 * fq;
#pragma unroll
        for (int ai = 0; ai < 2; ++ai)
#pragma unroll
            for (int m = 0; m < 4; ++m) { float* rowp = C + (size_t)(row0 + ai * HALF + m * 16) * ldc + col0;
#pragma unroll
                for (int bj = 0; bj < 2; ++bj)
#pragma unroll
                    for (int n = 0; n < 2; ++n) *(f32x4*)(rowp + bj * HALF + n * 16) = acc[ai][bj][m][n]; }
    }
};
struct EpiBranch {
    static constexpr bool PERM = true;
    const bf16* proj; bf16* gbuf; bf16* merged;
    DI void operator()(const f32x4 (&acc)[2][2][4][2], const Unit& u, int wr, int wc, int fr, int fq) const {
        const int row0 = u.pm * BM + wr * 64 + fr, col0 = u.pn * BM + wc * 32 + 8 * fq;
#pragma unroll
        for (int ai = 0; ai < 2; ++ai)
#pragma unroll
            for (int m = 0; m < 4; ++m) { const int row = row0 + ai * HALF + m * 16;
#pragma unroll
                for (int bj = 0; bj < 2; ++bj) { const int col = col0 + bj * HALF;
                    const u32x4 gw = *(const u32x4*)(proj + (size_t)row * PC + C_GATE + u.z * 1024 + col);
                    f32x4 v0 = acc[ai][bj][m][0], v1 = acc[ai][bj][m][1];
                    v0[0] *= fast_sig(bflo(gw.x)); v0[1] *= fast_sig(bfhi(gw.x)); v0[2] *= fast_sig(bflo(gw.y)); v0[3] *= fast_sig(bfhi(gw.y));
                    v1[0] *= fast_sig(bflo(gw.z)); v1[1] *= fast_sig(bfhi(gw.z)); v1[2] *= fast_sig(bflo(gw.w)); v1[3] *= fast_sig(bfhi(gw.w));
                    const size_t off = (size_t)row * 1024 + col;
                    if (u.z == 2) { const u32x4 p0 = *(const u32x4*)(gbuf + off), p1 = *(const u32x4*)(gbuf + (size_t)TG * 1024 + off);
                        v0[0] += bflo(p0.x) + bflo(p1.x); v0[1] += bfhi(p0.x) + bfhi(p1.x); v0[2] += bflo(p0.y) + bflo(p1.y); v0[3] += bfhi(p0.y) + bfhi(p1.y);
                        v1[0] += bflo(p0.z) + bflo(p1.z); v1[1] += bfhi(p0.z) + bfhi(p1.z); v1[2] += bflo(p0.w) + bflo(p1.w); v1[3] += bfhi(p0.w) + bfhi(p1.w); }
                    u32x4 w; w.x = cvt_pk_bf16(v0[0], v0[1]); w.y = cvt_pk_bf16(v0[2], v0[3]); w.z = cvt_pk_bf16(v1[0], v1[1]); w.w = cvt_pk_bf16(v1[2], v1[3]);
                    *(u32x4*)((u.z == 2 ? merged : gbuf + (size_t)u.z * TG * 1024) + off) = w; }
                asm volatile("" ::: "memory"); }
    }
};
struct EpiOut {
    static constexpr bool PERM = true;
    const float* x; float* x1; bf16* xg; const float* gffn; float* ssp;
    DI void operator()(const f32x4 (&acc)[2][2][4][2], const Unit& u, int wr, int wc, int fr, int fq) const {
        const int row0 = u.pm * BM + wr * 64 + fr, col0 = u.pn * BM + wc * 32 + 8 * fq;
        f32x4 g0[2], g1[2];
#pragma unroll
        for (int bj = 0; bj < 2; ++bj) { g0[bj] = *(const f32x4*)(gffn + col0 + bj * HALF); g1[bj] = *(const f32x4*)(gffn + col0 + bj * HALF + 4); }
#pragma unroll
        for (int ai = 0; ai < 2; ++ai)
#pragma unroll
            for (int m = 0; m < 4; ++m) { const int row = row0 + ai * HALF + m * 16; float ss = 0.f;
#pragma unroll
                for (int bj = 0; bj < 2; ++bj) { const size_t off = (size_t)row * 1024 + col0 + bj * HALF;
                    const f32x4 v0 = acc[ai][bj][m][0] + *(const f32x4*)(x + off), v1 = acc[ai][bj][m][1] + *(const f32x4*)(x + off + 4);
                    *(f32x4*)(x1 + off) = v0; *(f32x4*)(x1 + off + 4) = v1;
                    ss += (v0[0] * v0[0] + v0[1] * v0[1]) + (v0[2] * v0[2] + v0[3] * v0[3]) + (v1[0] * v1[0] + v1[1] * v1[1]) + (v1[2] * v1[2] + v1[3] * v1[3]);
                    const f32x4 a = v0 * g0[bj], b = v1 * g1[bj];
                    u32x4 w; w.x = cvt_pk_bf16(a[0], a[1]); w.y = cvt_pk_bf16(a[2], a[3]); w.z = cvt_pk_bf16(b[0], b[1]); w.w = cvt_pk_bf16(b[2], b[3]);
                    *(u32x4*)(xg + off) = w; }
                ss += __shfl_xor(ss, 16); ss += __shfl_xor(ss, 32);
                if (fq == 0) ssp[(size_t)row * 16 + u.pn * 4 + wc] = ss;
                asm volatile("" ::: "memory"); }
    }
};
}

#define XB_TMO      128
#define XB_XCNT(j)  (256  + 64 * (j))
#define XB_XSUB(j)  (1280 + 64 * (j))
#define XB_XGEN(j)  (2304 + 64 * (j))
#define XB_TOP      3328
#define XB_TOPGEN   3392
#define XCD_BAR_WORDS 3456
#define XB_SPIN_CAP (1u << 18)
constexpr int CW_BAR = 4096;

DI unsigned xb_ld(unsigned* p)              { return __hip_atomic_load(p, __ATOMIC_RELAXED, __HIP_MEMORY_SCOPE_AGENT); }
DI unsigned xb_add(unsigned* p, unsigned v) { return __hip_atomic_fetch_add(p, v, __ATOMIC_RELAXED, __HIP_MEMORY_SCOPE_AGENT); }
DI unsigned xb_xcc_id() { return (unsigned)__builtin_amdgcn_s_getreg((3 << 11) | 20) & 0xFu; }
#define XB_SPIN(cond, bar) do { unsigned _sp = 0; while (cond) { __builtin_amdgcn_s_sleep(1); \
    if ((++_sp & 255u) == 0u) { if (xb_ld(&(bar)[XB_TMO])) break; if (_sp > XB_SPIN_CAP) { atomicAdd(&(bar)[XB_TMO], 1u); break; } } } } while (0)

struct XcdBarrier { unsigned* bar; unsigned x; volatile LAS unsigned* st; };

DI XcdBarrier xcd_barrier_post(unsigned* bar, volatile LAS unsigned* st) {
    XcdBarrier b; b.bar = bar; b.x = xb_xcc_id(); b.st = st;
    if (threadIdx.x == 0) (void)xb_add(&bar[XB_XCNT(b.x)], 1u);
    return b;
}
DI void xcd_barrier_complete(unsigned* bar, unsigned x, unsigned& nloc, unsigned& nx) {
    const unsigned G = gridDim.x * gridDim.y * gridDim.z;
    unsigned sum, cnt, mine, sp = 0u;
    for (;;) {
        sum = 0u; cnt = 0u; mine = 0u;
#pragma unroll
        for (unsigned j = 0; j < 16; ++j) { const unsigned c = xb_ld(&bar[XB_XCNT(j)]); sum += c; cnt += (c > 0u) ? 1u : 0u; mine = (j == x) ? c : mine; }
        if (sum == G) break;
        __builtin_amdgcn_s_sleep(1);
        if ((++sp & 255u) == 0u) { if (xb_ld(&bar[XB_TMO])) break; if (sp > XB_SPIN_CAP) { atomicAdd(&bar[XB_TMO], 1u); break; } }
    }
    nloc = mine > 0u ? mine : 1u; nx = cnt > 0u ? cnt : 1u;
}
DI void xcd_barrier(const XcdBarrier& b) {
    asm volatile("s_waitcnt vmcnt(0)" ::: "memory");
    __syncthreads();
    if (threadIdx.x == 0) {
        unsigned* bar = b.bar;
        __builtin_amdgcn_s_waitcnt(0);
        unsigned nloc = b.st[0], nx = b.st[1];
        if (nloc == 0u) { xcd_barrier_complete(bar, b.x, nloc, nx); b.st[0] = nloc; b.st[1] = nx; }
        const unsigned old = xb_add(&bar[XB_XSUB(b.x)], 1u);
        const unsigned gen = old / nloc;
        if (old + 1u == (gen + 1u) * nloc) {
            __builtin_amdgcn_fence(__ATOMIC_RELEASE, "agent");
            asm volatile("s_waitcnt vmcnt(0)" ::: "memory");
            const unsigned og = xb_add(&bar[XB_TOP], 1u);
            const unsigned tg = og / nx;
            if (og + 1u == (tg + 1u) * nx) xb_add(&bar[XB_TOPGEN], 1u);
            else XB_SPIN(xb_ld(&bar[XB_TOPGEN]) == tg, bar);
            __builtin_amdgcn_fence(__ATOMIC_ACQUIRE, "agent");
            xb_add(&bar[XB_XGEN(b.x)], 1u);
            asm volatile("s_waitcnt vmcnt(0)" ::: "memory");
        } else {
            XB_SPIN(xb_ld(&bar[XB_XGEN(b.x)]) == gen, bar);
            __builtin_amdgcn_fence(__ATOMIC_ACQUIRE, "agent");
            asm volatile("s_waitcnt vmcnt(0)" ::: "memory");
        }
    }
    __syncthreads();
}

struct Frame {
    LAS unsigned char* lds;
    int tid, lane, wave;
    DI void refresh() { int t = threadIdx.x; asm volatile("" : "+v"(t)); tid = t; lane = t & 63; wave = __builtin_amdgcn_readfirstlane(t >> 6); }
    int vcu, G;
    const float *x, *mem, *norm_mix_g, *w_in, *hg_lb, *hg_norm_g, *sc_conv_w, *mem_norm_g, *w_mem_kv, *w_branch, *w_out, *norm_ffn_g, *peer_w_q, *peer_sub_keys, *peer_u, *peer_v, *final_norm_g;
    float* out; unsigned char* ws;
};

DI void p0_transpose_item(const float* W, int K, int N, bf16* WT, LAS float* scr, int item, int lane) {
    const int nblk = N / 32, kb = item / nblk, nb = item % nblk, k0 = 64 * kb, n0 = 32 * nb;
#pragma unroll 8
    for (int i = 0; i < 32; ++i) { const int kk = 2 * i + (lane >> 5); scr[kk * 33 + (lane & 31)] = W[(size_t)(k0 + kk) * N + n0 + (lane & 31)]; }
    asm volatile("s_waitcnt lgkmcnt(0)" ::: "memory");
    const int c = lane & 7;
#pragma unroll
    for (int j = 0; j < 4; ++j) { const int n = (lane >> 3) + 8 * j; const LAS float* s = scr + (8 * c) * 33 + n;
        u32x4 o; o.x = pk2(s[0 * 33], s[1 * 33]); o.y = pk2(s[2 * 33], s[3 * 33]); o.z = pk2(s[4 * 33], s[5 * 33]); o.w = pk2(s[6 * 33], s[7 * 33]);
        *(u32x4*)(WT + (size_t)(n0 + n) * K + k0 + 8 * c) = o; }
    asm volatile("s_waitcnt lgkmcnt(0)" ::: "memory");
}
DI void rms_row_to_bf16(const float* xrow, const float* g, bf16* orow, int lane) {
    const f32x4* xr = (const f32x4*)xrow + lane; const f32x4* gr = (const f32x4*)g + lane;
    f32x4 v[4]; float s = 0.f;
#pragma unroll
    for (int j = 0; j < 4; ++j) { v[j] = xr[64 * j]; s += (v[j].x * v[j].x + v[j].y * v[j].y) + (v[j].z * v[j].z + v[j].w * v[j].w); }
    const float rstd = 1.0f / sqrtf(wave_sum(s) * (1.f / 1024.f) + EPS);
    unsigned long long* o8 = (unsigned long long*)orow + lane;
#pragma unroll
    for (int j = 0; j < 4; ++j) { const f32x4 gg = gr[64 * j]; const f32x4 y = v[j] * rstd * gg;
        o8[64 * j] = (unsigned long long)pk2(y.x, y.y) | ((unsigned long long)pk2(y.z, y.w) << 32); }
}
DI void p0_prologue(Frame& F) {
    F.refresh();
    LAS float* scr = (LAS float*)(F.lds + F.wave * 16384);
    const int gw = F.vcu * NWAVES + F.wave, NGW = F.G * NWAVES;
    unsigned char* ws = F.ws;
    constexpr int I_IN = (1024 / 64) * (PC / 32), I_KV = (1024 / 64) * (1024 / 32), I_BR = (512 / 64) * (1024 / 32), I_OUT = (1024 / 64) * (1024 / 32), I_Q = (1024 / 64) * (2048 / 32);
    constexpr int NITEMS = I_IN + I_KV + 3 * I_BR + I_OUT + I_Q;
    for (int it = gw; it < NITEMS; it += NGW) {
        int r = it;
        if (r < I_IN) { p0_transpose_item(F.w_in, 1024, PC, (bf16*)(ws + WS_WIN), scr, r, F.lane); continue; } r -= I_IN;
        if (r < I_KV) { p0_transpose_item(F.w_mem_kv, 1024, 1024, (bf16*)(ws + WS_WKV), scr, r, F.lane); continue; } r -= I_KV;
        if (r < 3 * I_BR) { const int n = r / I_BR; p0_transpose_item(F.w_branch + (size_t)n * 512 * 1024, 512, 1024, (bf16*)(ws + WS_WBR) + (size_t)n * 1024 * 512, scr, r % I_BR, F.lane); continue; } r -= 3 * I_BR;
        if (r < I_OUT) { p0_transpose_item(F.w_out, 1024, 1024, (bf16*)(ws + WS_WOUT), scr, r, F.lane); continue; } r -= I_OUT;
        p0_transpose_item(F.peer_w_q, 1024, 2048, (bf16*)(ws + WS_WQ), scr, r, F.lane);
    }
    const int gt = F.vcu * 512 + F.tid, NGT = F.G * 512;
    for (int it = gt; it < 8 * 256 * 32; it += NGT) {
        const int c8 = it & 31, row = (it >> 5) & 255, h = it >> 13, p = row >> 7, key = row & 127;
        u32x4 o = (u32x4){0u, 0u, 0u, 0u};
        if ((c8 >> 4) == p) { const float* s = F.peer_sub_keys + (((size_t)(h * 2 + p) * 128 + key) * 128 + (c8 & 15) * 8);
            const f32x4 a = *(const f32x4*)s, b = *(const f32x4*)(s + 4); o.x = pk2(a.x, a.y); o.y = pk2(a.z, a.w); o.z = pk2(b.x, b.y); o.w = pk2(b.z, b.w); }
        *(u32x4*)((bf16*)(ws + WS_KBD) + ((size_t)(h * 256 + row) * 256 + c8 * 8)) = o;
    }
    for (int it = gt; it < 1024; it += NGT) { const float a0 = F.hg_lb[it], a1 = F.hg_lb[1024 + it]; const float m = fmaxf(a0, a1); const float e0 = __expf(a0 - m), e1 = __expf(a1 - m);
        ((float*)(ws + WS_LB))[it] = e0 / (e0 + e1); }
    for (int m = gw; m < BATCH * NMEM; m += NGW) rms_row_to_bf16(F.mem + (size_t)m * 1024, F.mem_norm_g, (bf16*)(ws + WS_MN) + (size_t)m * 1024, F.lane);
    for (int m = gw; m < T_ALL; m += NGW) rms_row_to_bf16(F.x + (size_t)m * 1024, F.norm_mix_g, (bf16*)(ws + WS_XG) + (size_t)m * 1024, F.lane);
}

DI s16x4 tr16(const LAS unsigned char* p) { return __builtin_bit_cast(s16x4, __builtin_amdgcn_ds_read_tr16_b64_v4i16((LAS v4i16_t*)p)); }
DI bf16x8 cat8(s16x4 lo, s16x4 hi) { return __builtin_shufflevector(lo, hi, 0, 1, 2, 3, 4, 5, 6, 7); }
#define MFMA32(a, b, c) __builtin_amdgcn_mfma_f32_32x32x16_bf16((a), (b), (c), 0, 0, 0)
DI int crow(int reg, int h) { return (reg & 3) + 8 * (reg >> 2) + 4 * h; }
DI bf16x8 pack8(const f32x16& x, int s) {
    u32x4 p; p.x = cvtpk(x[8 * s], x[8 * s + 1]); p.y = cvtpk(x[8 * s + 2], x[8 * s + 3]); p.z = cvtpk(x[8 * s + 4], x[8 * s + 5]); p.w = cvtpk(x[8 * s + 6], x[8 * s + 7]);
    return __builtin_bit_cast(bf16x8, p);
}
constexpr int TS = 272;

DI void stage_tile(LAS unsigned char* tile, const bf16* src, int tid) {
#pragma unroll
    for (int i = 0; i < 2; ++i) { const int id = tid + 512 * i, c = id >> 4, ch = id & 15;
        *(LAS u32x4*)(tile + c * TS + ch * 16) = *(const u32x4*)(src + (size_t)c * PC + ch * 8); }
}
DI float touch_tile(const bf16* src, int i128) { return *(const float*)(src + (size_t)(i128 >> 1) * PC + (i128 & 1) * 64); }
DI void gate8(const LAS unsigned char* zt, int dp, int ts, f32x2 lb, f32x2 (&L)[8], f32x2 (&kk)[8], f32x2 (&lf)[8]) {
    f32x2 run = (f32x2){0.f, 0.f}; const f32x2 oml = 1.0f - lb;
#pragma unroll
    for (int i = 0; i < 8; ++i) { const unsigned w = *(const LAS unsigned*)(zt + (8 * ts + i) * TS + 4 * dp);
        const f32x2 sg = (f32x2){fast_sig(bflo(w)), fast_sig(bfhi(w))}; const f32x2 f = lb + oml * sg;
        lf[i] = (f32x2){__builtin_amdgcn_logf(f.x), __builtin_amdgcn_logf(f.y)}; kk[i] = oml * (1.0f - sg); run += lf[i]; L[i] = run; }
}
DI f32x2 exp2x2(f32x2 v) { return (f32x2){__builtin_amdgcn_exp2f(v.x), __builtin_amdgcn_exp2f(v.y)}; }
struct SliceSums { f32x2 offf, offb, glf, glb, greff, grefb; };
DI SliceSums slice_sums(const LAS float* tot, int dp, int ts) {
    SliceSums r; f32x2 tf[8], tb[8];
#pragma unroll
    for (int j = 0; j < 8; ++j) { tf[j] = *(const LAS f32x2*)(tot + j * 128 + 2 * dp); tb[j] = *(const LAS f32x2*)(tot + (8 + j) * 128 + 2 * dp); }
    r.offf = (f32x2){0.f, 0.f}; r.offb = (f32x2){0.f, 0.f};
#pragma unroll
    for (int j = 0; j < 8; ++j) { if (j < ts) r.offf += tf[j]; if (j > ts) r.offb += tb[j]; }
    r.greff = (tf[0] + tf[1]) + (tf[2] + tf[3]); r.glf = r.greff + ((tf[4] + tf[5]) + (tf[6] + tf[7]));
    r.grefb = (tb[4] + tb[5]) + (tb[6] + tb[7]); r.glb = r.grefb + ((tb[0] + tb[1]) + (tb[2] + tb[3]));
    return r;
}

DI void hgrn_a_item(Frame& F, int item, bool has_next) {
    F.refresh();
    constexpr int T_V = 0, T_KF = 17408, T_KB = 34816, TOT = 52224;
    LAS unsigned char* lds = F.lds;
    const int n = item & 31, h = (item >> 5) & 3, b = item >> 7;
    const bf16* proj = (const bf16*)(F.ws + WS_PROJ) + ((size_t)b * SEQ + n * CHUNK) * PC;
    const int tid = F.tid, dp = tid & 63, ts = F.wave;
    const float* lbp = (const float*)(F.ws + WS_LB);
    const f32x2 lbf = *(const f32x2*)(lbp + h * 128 + 2 * dp), lbb = *(const f32x2*)(lbp + 512 + h * 128 + 2 * dp);
    stage_tile(lds + T_V, proj + C_HI + h * 128, tid); stage_tile(lds + T_KF, proj + C_FF + h * 128, tid); stage_tile(lds + T_KB, proj + C_FB + h * 128, tid);
    float tch = 0.f;
    if (has_next) { const bf16* pn = proj + (size_t)CHUNK * PC + h * 128; const int i128 = tid & 127, wsel = tid >> 7; tch = touch_tile(pn + (wsel == 0 ? C_HI : wsel == 1 ? C_FF : C_FB), i128); }
    __syncthreads();
    f32x2 Lf[8], kf[8], lff[8], Lb[8], kb[8], lfb[8];
    gate8(lds + T_KF, dp, ts, lbf, Lf, kf, lff);
    gate8(lds + T_KB, dp, ts, lbb, Lb, kb, lfb);
    LAS float* tot = (LAS float*)(lds + TOT);
    *(LAS f32x2*)(tot + ts * 128 + 2 * dp) = Lf[7]; *(LAS f32x2*)(tot + (8 + ts) * 128 + 2 * dp) = Lb[7];
    asm volatile("" :: "v"(tch));
    __syncthreads();
    const SliceSums ss = slice_sums(tot, dp, ts);
    const f32x2 tbq = Lb[7];
#pragma unroll
    for (int i = 0; i < 8; ++i) { const int c = 8 * ts + i;
        const f32x2 G = ss.offf + Lf[i]; const f32x2 kd = kf[i] * exp2x2(ss.glf - G);
        const f32x2 Gb = ss.offb + (tbq - Lb[i] + lfb[i]); const f32x2 kdb = kb[i] * exp2x2(ss.glb - Gb);
        *(LAS unsigned*)(lds + T_KF + c * TS + 4 * dp) = cvtpk(kd.x, kd.y); *(LAS unsigned*)(lds + T_KB + c * TS + 4 * dp) = cvtpk(kdb.x, kdb.y); }
    if (ts == 0) { float* dec = (float*)(F.ws + WS_DEC) + (size_t)item * 256; *(f32x2*)(dec + 2 * dp) = exp2x2(ss.glf); *(f32x2*)(dec + 128 + 2 * dp) = exp2x2(ss.glb); }
    __syncthreads();
    const int w = F.wave, lane = F.lane, r = lane & 31, hh = lane >> 5, blk = (lane >> 4) & 1, q = (lane & 15) >> 2, p = lane & 3;
    const int dt = w >> 1, et0 = (w & 1) * 2;
#pragma unroll
    for (int dir = 0; dir < 2; ++dir) { const int TK = dir ? T_KB : T_KF;
#pragma unroll
        for (int e2 = 0; e2 < 2; ++e2) { const int et = et0 + e2; f32x16 acc;
#pragma unroll
            for (int i = 0; i < 16; ++i) acc[i] = 0.f;
#pragma unroll
            for (int ks = 0; ks < 4; ++ks) {
                const LAS unsigned char* ap = lds + TK + (16 * ks + 8 * hh + q) * TS + (32 * dt + 16 * blk + 4 * p) * 2;
                const LAS unsigned char* bp = lds + T_V + (16 * ks + 8 * hh + q) * TS + (32 * et + 16 * blk + 4 * p) * 2;
                const bf16x8 a = cat8(tr16(ap), tr16(ap + 4 * TS)), bq = cat8(tr16(bp), tr16(bp + 4 * TS));
                acc = MFMA32(a, bq, acc); }
            bf16* dsb = (bf16*)(F.ws + WS_DS) + ((size_t)(item * 2 + dir) * 128 + 32 * et + r) * 128 + 32 * dt + 4 * hh;
#pragma unroll
            for (int g4 = 0; g4 < 4; ++g4) { u32x2 wv; wv.x = cvtpk(acc[4 * g4], acc[4 * g4 + 1]); wv.y = cvtpk(acc[4 * g4 + 2], acc[4 * g4 + 3]); *(u32x2*)(dsb + 8 * g4) = wv; } } }
    __syncthreads();
}

DI void hgrn_scan(Frame& F) {
    F.refresh();
    const bf16* dS = (const bf16*)(F.ws + WS_DS); bf16* Sst = (bf16*)((unsigned char*)F.out + OUT_SST); const float* dec = (const float*)(F.ws + WS_DEC);
    const int gt = F.vcu * 512 + F.tid, NGT = F.G * 512;
    for (int id = gt; id < BG * 4 * 2 * 128 * 32; id += NGT) {
        const int d4 = id & 31, e = (id >> 5) & 127, dir = (id >> 12) & 1, bh = id >> 13;
        f32x4 S = (f32x4){0.f, 0.f, 0.f, 0.f};
#pragma unroll 4
        for (int s = 0; s < 32; ++s) { const int n = dir ? 31 - s : s, item = bh * 32 + n;
            const size_t off = ((size_t)(item * 2 + dir) * 128 + e) * 128 + d4 * 4;
            u32x2 o; o.x = cvtpk(S.x, S.y); o.y = cvtpk(S.z, S.w); *(u32x2*)(Sst + off) = o;
            const f32x4 dc = *(const f32x4*)(dec + (size_t)(item * 2 + dir) * 128 + d4 * 4);
            const u32x2 wv = *(const u32x2*)(dS + off);
            S.x = dc.x * S.x + bflo(wv.x); S.y = dc.y * S.y + bfhi(wv.x); S.z = dc.z * S.z + bflo(wv.y); S.w = dc.w * S.w + bfhi(wv.y); }
    }
}

DI void hgrn_c_item(Frame& F, int item, bool has_next) {
    F.refresh();
    constexpr int T_QRF = 0, T_KRF = 17408, T_QGF = 34816, T_QRB = 52224, T_KRB = 69632, T_QGB = 87040, T_V = 104448, TOT = 121856, O_OFF = 0, OS = 132;
    LAS unsigned char* lds = F.lds;
    const int n = item & 31, h = (item >> 5) & 3, b = item >> 7;
    const size_t row0 = (size_t)b * SEQ + n * CHUNK;
    const bf16* proj = (const bf16*)(F.ws + WS_PROJ) + row0 * PC;
    const int tid = F.tid, dp = tid & 63, ts = F.wave;
    const float* lbp = (const float*)(F.ws + WS_LB);
    const f32x2 lbf = *(const f32x2*)(lbp + h * 128 + 2 * dp), lbb = *(const f32x2*)(lbp + 512 + h * 128 + 2 * dp);
    stage_tile(lds + T_V, proj + C_HI + h * 128, tid); stage_tile(lds + T_KRF, proj + C_FF + h * 128, tid); stage_tile(lds + T_KRB, proj + C_FB + h * 128, tid); stage_tile(lds + T_QRF, proj + C_HQ + h * 128, tid);
    float tch = 0.f, tch2 = 0.f;
    if (has_next) { const bf16* pn = proj + (size_t)CHUNK * PC + h * 128; const int i128 = tid & 127, wsel = tid >> 7; tch = touch_tile(pn + (wsel == 0 ? C_HI : wsel == 1 ? C_FF : wsel == 2 ? C_FB : C_HQ), i128);
        tch2 = *(const float*)((const unsigned char*)F.out + OUT_SST + (size_t)(item + 1) * 65536 + (size_t)tid * 128); }
    __syncthreads();
    f32x2 qv[8];
#pragma unroll
    for (int i = 0; i < 8; ++i) { const unsigned w = *(const LAS unsigned*)(lds + T_QRF + (8 * ts + i) * TS + 4 * dp); const float z0 = bflo(w), z1 = bfhi(w); qv[i] = (f32x2){z0 * fast_sig(z0), z1 * fast_sig(z1)}; }
    f32x2 Lf[8], kf[8], lff[8], Lb[8], kb[8], lfb[8];
    gate8(lds + T_KRF, dp, ts, lbf, Lf, kf, lff);
    gate8(lds + T_KRB, dp, ts, lbb, Lb, kb, lfb);
    LAS float* tot = (LAS float*)(lds + TOT);
    *(LAS f32x2*)(tot + ts * 128 + 2 * dp) = Lf[7]; *(LAS f32x2*)(tot + (8 + ts) * 128 + 2 * dp) = Lb[7];
    asm volatile("" :: "v"(tch), "v"(tch2));
    __syncthreads();
    {
        const SliceSums ss = slice_sums(tot, dp, ts);
        const f32x2 tbq = Lb[7];
#pragma unroll
        for (int i = 0; i < 8; ++i) { const int c = 8 * ts + i; const int o = c * TS + 4 * dp;
            const f32x2 G = ss.offf + Lf[i]; const f32x2 x = G - ss.greff;
            const f32x2 qr = qv[i] * exp2x2(x), kr = kf[i] * exp2x2(-x), qg = qv[i] * exp2x2(G);
            *(LAS unsigned*)(lds + T_QRF + o) = cvtpk(qr.x, qr.y); *(LAS unsigned*)(lds + T_KRF + o) = cvtpk(kr.x, kr.y); *(LAS unsigned*)(lds + T_QGF + o) = cvtpk(qg.x, qg.y);
            const f32x2 Gb = ss.offb + (tbq - Lb[i] + lfb[i]); const f32x2 xb = Gb - ss.grefb;
            const f32x2 qrb = qv[i] * exp2x2(xb), krb = kb[i] * exp2x2(-xb), qgb = qv[i] * exp2x2(Gb);
            *(LAS unsigned*)(lds + T_QRB + o) = cvtpk(qrb.x, qrb.y); *(LAS unsigned*)(lds + T_KRB + o) = cvtpk(krb.x, krb.y); *(LAS unsigned*)(lds + T_QGB + o) = cvtpk(qgb.x, qgb.y); }
    }
    __syncthreads();
    const int w = F.wave, lane = F.lane, r = lane & 31, hh = lane >> 5, blk = (lane >> 4) & 1, q = (lane & 15) >> 2, p = lane & 3;
    const int ct = w >> 2, et = w & 3;
    const bf16* Sst = (const bf16*)((const unsigned char*)F.out + OUT_SST);
    f32x16 o;
#pragma unroll
    for (int i = 0; i < 16; ++i) o[i] = 0.f;
#pragma unroll
    for (int dir = 0; dir < 2; ++dir) { const int TQR = dir ? T_QRB : T_QRF, TKR = dir ? T_KRB : T_KRF, TQG = dir ? T_QGB : T_QGF;
#pragma unroll
        for (int st = 0; st < 2; ++st) {
            if (dir == 0 ? (st > ct) : (st < ct)) continue;
            f32x16 X;
#pragma unroll
            for (int i = 0; i < 16; ++i) X[i] = 0.f;
#pragma unroll
            for (int ks = 0; ks < 8; ++ks) { const bf16x8 a = *(const LAS bf16x8*)(lds + TKR + (32 * st + r) * TS + (16 * ks + 8 * hh) * 2), bq = *(const LAS bf16x8*)(lds + TQR + (32 * ct + r) * TS + (16 * ks + 8 * hh) * 2);
                X = MFMA32(a, bq, X); }
            const int cc = 32 * ct + r;
#pragma unroll
            for (int i = 0; i < 16; ++i) { const int s = 32 * st + crow(i, hh); const bool keep = dir == 0 ? (s <= cc) : (s >= cc); X[i] = keep ? X[i] : 0.f; }
#pragma unroll
            for (int s2 = 0; s2 < 2; ++s2) { const bf16x8 xs = pack8(X, s2);
                const LAS unsigned char* vp = lds + T_V + (32 * st + 16 * s2 + 4 * hh + q) * TS + (32 * et + 16 * blk + 4 * p) * 2;
                const bf16x8 pb = cat8(tr16(vp), tr16(vp + 8 * TS));
                o = MFMA32(xs, pb, o); }
        }
        const bf16* sp = Sst + ((size_t)(item * 2 + dir) * 128 + 32 * et + r) * 128 + 8 * hh;
#pragma unroll
        for (int ks = 0; ks < 8; ++ks) { const bf16x8 a = *(const LAS bf16x8*)(lds + TQG + (32 * ct + r) * TS + (16 * ks + 8 * hh) * 2); const bf16x8 bq = *(const bf16x8*)(sp + 16 * ks);
            o = MFMA32(a, bq, o); }
    }
    unsigned hw[8];
#pragma unroll
    for (int k = 0; k < 8; ++k) hw[k] = *(const unsigned*)(proj + (size_t)(8 * w + k) * PC + C_HG + h * 128 + 2 * lane);
    __syncthreads();
    LAS float* O = (LAS float*)(lds + O_OFF);
#pragma unroll
    for (int i = 0; i < 16; ++i) O[(32 * ct + crow(i, hh)) * OS + 32 * et + r] = o[i];
    __syncthreads();
    const f32x2 gn = *(const f32x2*)(F.hg_norm_g + h * 128 + 2 * lane);
    bf16* yhg = (bf16*)(F.ws + WS_YHG);
    const int a16 = (lane ^ 16) << 2, a32 = (lane ^ 32) << 2;
#pragma unroll
    for (int k = 0; k < 8; ++k) { const int c = 8 * w + k; const f32x2 v = *(const LAS f32x2*)(O + c * OS + 2 * lane);
        float ss = row_sum16(v.x * v.x + v.y * v.y); ss += bperm_f(a16, ss); ss += bperm_f(a32, ss);
        const float rstd = __builtin_amdgcn_rsqf(ss * (1.0f / 128.0f) + EPS);
        const float z0 = bflo(hw[k]), z1 = bfhi(hw[k]);
        const float y0 = v.x * rstd * gn.x * (z0 * fast_sig(z0)), y1 = v.y * rstd * gn.y * (z1 * fast_sig(z1));
        *(unsigned*)(yhg + (row0 + c) * 512 + h * 128 + 2 * lane) = cvtpk(y0, y1); }
    __syncthreads();
}

DI void attn_item(Frame& F, int g, int item) {
    F.refresh();
    constexpr int KS = 272, VS = 528, K_OFF = 0, V_OFF = 69632;
    LAS unsigned char* lds = F.lds;
    const int qb = item & 7, h = (item >> 3) & 3, b = item >> 5, bglob = g * BG + b;
    const bf16* Km = (const bf16*)(F.ws + WS_KMEM) + (size_t)bglob * 256 * 512 + h * 128;
    const bf16* VT = (const bf16*)(F.ws + WS_VT) + (size_t)(h * 128) * 4096 + bglob * 256;
    const int tid = F.tid;
#pragma unroll
    for (int i = 0; i < 8; ++i) { const int id = tid + 512 * i, key = id >> 4, ch = id & 15;
        *(LAS u32x4*)(lds + K_OFF + key * KS + ch * 16) = *(const u32x4*)(Km + (size_t)key * 512 + ch * 8); }
#pragma unroll
    for (int i = 0; i < 8; ++i) { const int id = tid + 512 * i, e = id >> 5, ch = id & 31;
        *(LAS u32x4*)(lds + V_OFF + e * VS + ch * 16) = *(const u32x4*)(VT + (size_t)e * 4096 + ch * 8); }
    __syncthreads();
    const int w = F.wave, lane = F.lane, r = lane & 31, hh = lane >> 5;
    const size_t qrow0 = (size_t)b * SEQ + qb * 256 + w * 32;
    const bf16* proj = (const bf16*)(F.ws + WS_PROJ);
    bf16x8 qf[8];
#pragma unroll
    for (int ks = 0; ks < 8; ++ks) qf[ks] = *(const bf16x8*)(proj + (qrow0 + r) * PC + C_MQ + h * 128 + 16 * ks + 8 * hh);
    const float scale = 0.08838834764831845f;
    float m_run = -INFINITY, l_run = 0.f;
#pragma unroll 1
    for (int kt = 0; kt < 8; ++kt) {
        f32x16 X;
#pragma unroll
        for (int i = 0; i < 16; ++i) X[i] = 0.f;
#pragma unroll
        for (int ks = 0; ks < 8; ++ks) { const bf16x8 a = *(const LAS bf16x8*)(lds + K_OFF + (32 * kt + r) * KS + (16 * ks + 8 * hh) * 2); X = MFMA32(a, qf[ks], X); }
        float tm = X[0];
#pragma unroll
        for (int i = 1; i < 16; ++i) tm = fmaxf(tm, X[i]);
        tm *= scale;
        const float mn = fmaxf(m_run, tm); float ls = 0.f;
#pragma unroll
        for (int i = 0; i < 16; ++i) ls += __expf(X[i] * scale - mn);
        l_run = l_run * __expf(m_run - mn) + ls; m_run = mn;
    }
    { const float mo = __shfl_xor(m_run, 32), lo = __shfl_xor(l_run, 32); const float m = fmaxf(m_run, mo);
      l_run = l_run * __expf(m_run - m) + lo * __expf(mo - m); m_run = m; }
    const float inv_l = 1.0f / l_run;
    f32x16 O[4];
#pragma unroll
    for (int e = 0; e < 4; ++e)
#pragma unroll
        for (int i = 0; i < 16; ++i) O[e][i] = 0.f;
#pragma unroll 1
    for (int kt = 0; kt < 8; ++kt) {
        f32x16 X;
#pragma unroll
        for (int i = 0; i < 16; ++i) X[i] = 0.f;
#pragma unroll
        for (int ks = 0; ks < 8; ++ks) { const bf16x8 a = *(const LAS bf16x8*)(lds + K_OFF + (32 * kt + r) * KS + (16 * ks + 8 * hh) * 2); X = MFMA32(a, qf[ks], X); }
#pragma unroll
        for (int i = 0; i < 16; ++i) X[i] = __expf(X[i] * scale - m_run) * inv_l;
#pragma unroll
        for (int s2 = 0; s2 < 2; ++s2) { const bf16x8 xs = pack8(X, s2);
#pragma unroll
            for (int e = 0; e < 4; ++e) { const LAS unsigned char* vp = lds + V_OFF + (32 * e + r) * VS + (32 * kt + 16 * s2 + 4 * hh) * 2;
                const bf16x8 pb = cat8(*(const LAS s16x4*)vp, *(const LAS s16x4*)(vp + 16));
                O[e] = MFMA32(xs, pb, O[e]); } }
    }
    bf16* ymx = (bf16*)(F.ws + WS_YMX);
#pragma unroll
    for (int e = 0; e < 4; ++e)
#pragma unroll
        for (int i = 0; i < 16; ++i) ymx[(qrow0 + crow(i, hh)) * 512 + h * 128 + 32 * e + r] = (bf16)f2bf(O[e][i]);
    __syncthreads();
}

DI void conv_phase(Frame& F) {
    F.refresh();
    const bf16* proj = (const bf16*)(F.ws + WS_PROJ); bf16* ysc = (bf16*)(F.ws + WS_YSC); const float* cw = F.sc_conv_w;
    const int gt = F.vcu * 512 + F.tid, NGT = F.G * 512;
    for (int id = gt; id < TG * 64; id += NGT) {
        const int c8 = id & 63, t = id >> 6, ts = t & (SEQ - 1);
        const bf16* pr = proj + (size_t)t * PC + c8 * 8;
        const u32x4 z4 = (u32x4){0u, 0u, 0u, 0u};
        const u32x4 sb = *(const u32x4*)(pr + C_SB), c1 = *(const u32x4*)(pr + C_SC), h1 = *(const u32x4*)(pr + C_SH);
        const u32x4 c0 = ts > 0 ? *(const u32x4*)(pr - PC + C_SC) : z4, h0 = ts > 0 ? *(const u32x4*)(pr - PC + C_SH) : z4;
        const u32x4 c2 = ts < SEQ - 1 ? *(const u32x4*)(pr + PC + C_SC) : z4, h2 = ts < SEQ - 1 ? *(const u32x4*)(pr + PC + C_SH) : z4;
        const f32x4 wa0 = *(const f32x4*)(cw + c8 * 8), wa1 = *(const f32x4*)(cw + c8 * 8 + 4), wb0 = *(const f32x4*)(cw + 512 + c8 * 8), wb1 = *(const f32x4*)(cw + 512 + c8 * 8 + 4),
                    wc0 = *(const f32x4*)(cw + 1024 + c8 * 8), wc1 = *(const f32x4*)(cw + 1024 + c8 * 8 + 4);
        float y[8];
#pragma unroll
        for (int k = 0; k < 4; ++k) {
            const float w0l = k < 2 ? wa0[2 * k] : wa1[2 * k - 4], w0h = k < 2 ? wa0[2 * k + 1] : wa1[2 * k - 3];
            const float w1l = k < 2 ? wb0[2 * k] : wb1[2 * k - 4], w1h = k < 2 ? wb0[2 * k + 1] : wb1[2 * k - 3];
            const float w2l = k < 2 ? wc0[2 * k] : wc1[2 * k - 4], w2h = k < 2 ? wc0[2 * k + 1] : wc1[2 * k - 3];
            y[2 * k]     = bflo(sb[k]) * (w0l * (bflo(c0[k]) * bflo(h0[k])) + w1l * (bflo(c1[k]) * bflo(h1[k])) + w2l * (bflo(c2[k]) * bflo(h2[k])));
            y[2 * k + 1] = bfhi(sb[k]) * (w0h * (bfhi(c0[k]) * bfhi(h0[k])) + w1h * (bfhi(c1[k]) * bfhi(h1[k])) + w2h * (bfhi(c2[k]) * bfhi(h2[k]))); }
        u32x4 o; o.x = cvtpk(y[0], y[1]); o.y = cvtpk(y[2], y[3]); o.z = cvtpk(y[4], y[5]); o.w = cvtpk(y[6], y[7]);
        *(u32x4*)(ysc + (size_t)t * 512 + c8 * 8) = o;
    }
}

DI unsigned ord_key(float v, int idx) { unsigned u = __builtin_bit_cast(unsigned, v); u ^= (u >> 31) ? 0xFFFFFFFFu : 0x80000000u; return (u & 0xFFFFFF80u) | (unsigned)(127 - idx); }
DI float key_val(unsigned k) { unsigned u = k & 0xFFFFFF80u; u = (u & 0x80000000u) ? (u ^ 0x80000000u) : ~u; return __builtin_bit_cast(float, u); }
DI float dot2bf(unsigned a, unsigned b, float c) { return __builtin_amdgcn_fdot2_f32_bf16(__builtin_bit_cast(bf16x2_t, a), __builtin_bit_cast(bf16x2_t, b), c, false); }
DI float dot8(const u32x4& a, const u32x4& b, float c) { c = dot2bf(a.x, b.x, c); c = dot2bf(a.y, b.y, c); c = dot2bf(a.z, b.z, c); return dot2bf(a.w, b.w, c); }
__host__ __device__ constexpr int cand_off(int i) { return i == 0 ? 0 : i == 1 ? 16 : i == 2 ? 24 : i == 3 ? 29 : i == 4 ? 33 : i == 5 ? 36 : i == 6 ? 38 : i == 7 ? 40 : 34 + i; }
__host__ __device__ constexpr int cand_i(int c) { return c < 16 ? 0 : c < 24 ? 1 : c < 29 ? 2 : c < 33 ? 3 : c < 36 ? 4 : c < 38 ? 5 : c < 40 ? 6 : c < 42 ? 7 : c - 34; }
__host__ __device__ constexpr int cand_pos(int c) { return cand_i(c) * 16 + (c - cand_off(cand_i(c))); }

#define PEER_CE(i, j) do { const unsigned hi_ = max(k[i], k[j]), lo_ = min(k[i], k[j]); k[i] = hi_; k[j] = lo_; } while (0)
DI void peer_topk_first(const float* srow, LAS float* ssc, LAS int* six, int lane) {
    const int gq = lane >> 4, li = lane & 15;
    const float* sl = srow + (gq >> 1) * 256 + (gq & 1) * 128 + li * 8;
    f32x4 nva = *(const f32x4*)sl, nvb = *(const f32x4*)(sl + 4);
#pragma unroll 1
    for (int hp = 0; hp < 4; ++hp) {
        const f32x4 va = nva, vb = nvb;
        if (hp < 3) { nva = *(const f32x4*)(sl + 512 * (hp + 1)); nvb = *(const f32x4*)(sl + 512 * (hp + 1) + 4); }
        unsigned k[8];
        k[0] = ord_key(va.x, li * 8 + 0); k[1] = ord_key(va.y, li * 8 + 1); k[2] = ord_key(va.z, li * 8 + 2); k[3] = ord_key(va.w, li * 8 + 3);
        k[4] = ord_key(vb.x, li * 8 + 4); k[5] = ord_key(vb.y, li * 8 + 5); k[6] = ord_key(vb.z, li * 8 + 6); k[7] = ord_key(vb.w, li * 8 + 7);
        PEER_CE(0, 1); PEER_CE(2, 3); PEER_CE(4, 5); PEER_CE(6, 7); PEER_CE(0, 2); PEER_CE(1, 3); PEER_CE(4, 6); PEER_CE(5, 7); PEER_CE(1, 2); PEER_CE(5, 6);
        PEER_CE(0, 4); PEER_CE(1, 5); PEER_CE(2, 6); PEER_CE(3, 7); PEER_CE(2, 4); PEER_CE(3, 5); PEER_CE(1, 2); PEER_CE(3, 4); PEER_CE(5, 6);
        unsigned mine = 0u;
#pragma unroll
        for (int rd = 0; rd < 16; ++rd) {
            const unsigned m = row_max16(k[0]);
            mine = (li == rd) ? m : mine;
            const bool wn = (k[0] == m);
            k[0] = wn ? k[1] : k[0]; k[1] = wn ? k[2] : k[1]; k[2] = wn ? k[3] : k[2]; k[3] = wn ? k[4] : k[3];
            k[4] = wn ? k[5] : k[4]; k[5] = wn ? k[6] : k[5]; k[6] = wn ? k[7] : k[6]; k[7] = wn ? 0u : k[7];
        }
        const int o = ((2 * hp + (gq >> 1)) * 2 + (gq & 1)) * 16 + li;
        ssc[o] = key_val(mine); six[o] = 127 - (int)(mine & 127u);
    }
}
DI void peer_topk_second(const LAS float* ssc, const LAS int* six, LAS int* widx, LAS float* wgate, int lane, int emask) {
    const int ci = cand_i(lane), cj = lane - cand_off(ci); const bool cvalid = lane < 50;
    const int a16 = (lane ^ 16) << 2, a32 = (lane ^ 32) << 2;
#pragma unroll 2
    for (int hd = 0; hd < 8; ++hd) {
        const float a = ssc[(hd * 2) * 16 + ci], bq = ssc[(hd * 2 + 1) * 16 + cj];
        const int ia = six[(hd * 2) * 16 + ci], ib = six[(hd * 2 + 1) * 16 + cj];
        const float cs = a + bq;
        unsigned ck = __builtin_bit_cast(unsigned, cs); ck ^= (ck >> 31) ? 0xFFFFFFFFu : 0x80000000u; ck = cvalid ? ((ck & ~63u) | (unsigned)(63 - lane)) : 0u;
        int rank = 0;
#pragma unroll
        for (int c2 = 0; c2 < 50; ++c2) { const unsigned k2 = (unsigned)__builtin_amdgcn_readlane((int)ck, c2); rank += (int)(k2 > ck); }
        const bool sel = cvalid && rank < 16;
        const float mx = __builtin_bit_cast(float, __builtin_amdgcn_readlane(__builtin_bit_cast(int, cs), 0));
        const float ev = sel ? __builtin_amdgcn_exp2f((cs - mx) * 1.4426950408889634f) : 0.f;
        float sum = row_sum16(ev); sum += bperm_f(a16, sum); sum += bperm_f(a32, sum);
        if (sel) { widx[hd * 16 + rank] = ((ia * 128 + ib) & emask) * 512  ; wgate[hd * 16 + rank] = ev * __builtin_amdgcn_rcpf(sum); }
    }
}
#undef PEER_CE

constexpr float PEER_QSTEP = 0.35f;
constexpr float PEER_U_SCALE = 32.0f / PEER_QSTEP;
constexpr float PEER_UF4_SCALE = 64.0f;
constexpr float PEER_H4_SCALE = 2.0f;
#ifndef PROBE_SKIP
#define PROBE_SKIP 0
#endif
#define PSKIP(b) ((PROBE_SKIP >> (b)) & 1 && dry)
#ifndef PROBE_NODMA
#define PROBE_NODMA 0
#endif
#ifndef PROBE_EMASK
#define PROBE_EMASK 16383
#endif
#ifndef PEER_VARIANT
#define PEER_VARIANT 0
#endif
#ifndef PEER_R
#define PEER_R 16
#endif
#if PEER_R == 32
#define PEER_RM4 28
#elif PEER_R == 16
#define PEER_RM4 12
#elif PEER_R == 64
#define PEER_RM4 60
#endif
constexpr int PEER_NPROD = 2, PEER_NCONS = 8 - PEER_NPROD, PEER_CPP = PEER_NCONS / PEER_NPROD;
constexpr int PEER_NQ = 2 * PEER_NCONS;
constexpr int PEER_SLOT_BYTES = 2048;
constexpr int PEER_FLAG_OFF = PEER_NQ * PEER_SLOT_BYTES, PEER_PRIV_OFF = PEER_FLAG_OFF + 64, PEER_PRIV_BYTES = 2560, PEER_RING_OFF = 40960;
static_assert(PEER_PRIV_OFF + PEER_NCONS * PEER_PRIV_BYTES <= PEER_RING_OFF && PEER_RING_OFF + PEER_NCONS * PEER_R * 1024 <= MISC_OFF && PEER_R <= 64 && (PEER_R & (PEER_R - 1)) == 0 && PEER_NCONS % PEER_NPROD == 0, "PEER LDS map");
DI void glds16(const void* gsrc, unsigned lds_dst) { unsigned keep;
    asm volatile("s_mov_b32 %0, m0\n\ts_mov_b32 m0, %2\n\ts_nop 0\n\tglobal_load_lds_dwordx4 %1, off\n\ts_mov_b32 m0, %0" : "=&s"(keep) : "v"(gsrc), "s"(lds_dst) : "memory"); }
DI void glds16s(const void* sbase, unsigned voff, unsigned lds_dst) { unsigned keep;
    asm volatile("s_mov_b32 %0, m0\n\ts_mov_b32 m0, %3\n\ts_nop 0\n\tglobal_load_lds_dwordx4 %1, %2\n\ts_mov_b32 m0, %0" : "=&s"(keep) : "v"(voff), "s"(sbase), "s"(lds_dst) : "memory"); }
DI void glds16s_x4(const void* sbase, unsigned v0, unsigned v1, unsigned v2, unsigned v3, unsigned lds_dst) { unsigned keep;
    asm volatile("s_mov_b32 %0, m0\n\ts_mov_b32 m0, %6\n\ts_nop 0\n\tglobal_load_lds_dwordx4 %1, %5\n\tglobal_load_lds_dwordx4 %2, %5 offset:1024\n\tglobal_load_lds_dwordx4 %3, %5 offset:2048\n\tglobal_load_lds_dwordx4 %4, %5 offset:3072\n\ts_mov_b32 m0, %0"
                 : "=&s"(keep) : "v"(v0), "v"(v1), "v"(v2), "v"(v3), "s"(sbase), "s"(lds_dst) : "memory"); }
#define PEER_STR2(x) #x
#define PEER_STR(x) PEER_STR2(x)
typedef int i32x4 __attribute__((ext_vector_type(4)));
typedef int i32x8 __attribute__((ext_vector_type(8)));
DI void peer_phase(Frame& F, int tg, bool dry) {
    F.refresh();
    __syncthreads();
    const int lane = F.lane, wv = F.wave;
    volatile LAS unsigned* flags = (volatile LAS unsigned*)(F.lds + PEER_FLAG_OFF);
    if (F.tid <= PEER_NQ) flags[F.tid] = 0u;
    __syncthreads();
    const int NPG = F.G * PEER_NPROD;
    if (wv < PEER_NPROD) {
        const int pg = F.vcu * PEER_NPROD + wv;
        int i = 0;
        for (int tl = pg; tl < TG; tl += NPG, ++i) {
            float tch0 = 0.f;
            if (tl + NPG < TG) tch0 = ((const float*)(F.ws + WS_S) + (size_t)(tl + NPG) * 2048)[lane * 32];
            const int q = PEER_NPROD * i + wv, slot = q % PEER_NQ;
            LAS float* ssc = (LAS float*)(F.lds + slot * PEER_SLOT_BYTES); LAS int* six = (LAS int*)(F.lds + slot * PEER_SLOT_BYTES + 1024);
            while (flags[slot] != 0u) __builtin_amdgcn_s_sleep(2);
            asm volatile("" ::: "memory");
            if (!PSKIP(0)) peer_topk_first((const float*)(F.ws + WS_S) + (size_t)tl * 2048, ssc, six, lane);
            asm volatile("s_waitcnt lgkmcnt(0)" :: "v"(tch0) : "memory");
            if (lane == 0) flags[slot] = (unsigned)q + 1u;
        }
    } else {
        const unsigned char* Ub = F.ws + WS_U; const unsigned char* Vb = F.ws + WS_V; const unsigned lo16 = 16u * (unsigned)(lane & 31);
        const int a16 = (lane ^ 16) << 2, a32 = (lane ^ 32) << 2; const int grp = lane >> 4;
        const int cidx = wv - PEER_NPROD;
        LAS int* sidx = (LAS int*)(F.lds + PEER_PRIV_OFF + cidx * PEER_PRIV_BYTES); LAS float* sgate = (LAS float*)(F.lds + PEER_PRIV_OFF + cidx * PEER_PRIV_BYTES + 512);
        LAS unsigned char* ring = F.lds + PEER_RING_OFF + cidx * (PEER_R * 1024);
        const unsigned ringb = (unsigned)(uintptr_t)ring;
        LAS unsigned char* hrow = F.lds + PEER_PRIV_OFF + cidx * PEER_PRIV_BYTES + 1536;
        unsigned usw[4];
#pragma unroll
        for (int q = 0; q < 4; ++q) usw[q] = 16u * (unsigned)((lane & 31) ^ (2 * q + (lane >> 5))) + (4096u - 1024u * q);
        const LAS unsigned char* uadr[4];
#pragma unroll
        for (int j = 0; j < 4; ++j) uadr[j] = ring + (lane & 15) * 512 + 64 * (j ^ ((lane & 15) >> 2)) + 16 * (grp ^ (lane & 3));
        const int NQTOK = PEER_NPROD * (TG / NPG);
        for (;;) {
            int q = 0;
            if (lane == 0) q = (int)__hip_atomic_fetch_add((LAS unsigned*)(F.lds + PEER_FLAG_OFF) + PEER_NQ, 1u, __ATOMIC_RELAXED, __HIP_MEMORY_SCOPE_WORKGROUP);
            q = __builtin_amdgcn_readfirstlane(q);
            if (q >= NQTOK) break;
            const int tl = F.vcu * PEER_NPROD + (q % PEER_NPROD) + (q / PEER_NPROD) * NPG;
            const size_t t = (size_t)tg * TG + tl;
            float tch1 = 0.f, tch2 = 0.f, tch3 = 0.f;
            if (q + PEER_NCONS < NQTOK) { const int qn = q + PEER_NCONS; const size_t tn = (size_t)tg * TG + F.vcu * PEER_NPROD + (qn % PEER_NPROD) + (qn / PEER_NPROD) * NPG; tch1 = (F.out + tn * 1024)[(lane & 31) * 32];
                tch2 = ((const float*)((const bf16*)(F.ws + WS_XG) + tn * 1024))[(lane & 15) * 32]; tch3 = ((const float*)(F.ws + WS_SSP) + tn * 16)[lane & 15]; }
            const f32x4* sp = (const f32x4*)((const float*)(F.ws + WS_SSP) + t * 16);
            const f32x4 s0 = sp[0], s1 = sp[1], s2 = sp[2], s3 = sp[3];
            const float ssx = ((s0[0] + s0[1]) + (s0[2] + s0[3])) + ((s1[0] + s1[1]) + (s1[2] + s1[3])) + ((s2[0] + s2[1]) + (s2[2] + s2[3])) + ((s3[0] + s3[1]) + (s3[2] + s3[3]));
            const float hs = __builtin_amdgcn_rsqf(ssx * (1.0f / 1024.0f) + EPS) * PEER_H4_SCALE;
            { const bf16* xr = (const bf16*)(F.ws + WS_XG) + t * 1024 + 16 * lane; const u32x4 w0 = *(const u32x4*)xr, w1 = *(const u32x4*)(xr + 8);
              u32x2 hq;
              hq.x = __builtin_amdgcn_cvt_scalef32_pk_fp4_f32(0u, bflo(w0[0]) * hs, bfhi(w0[0]) * hs, 1.0f, 0); hq.x = __builtin_amdgcn_cvt_scalef32_pk_fp4_f32(hq.x, bflo(w0[1]) * hs, bfhi(w0[1]) * hs, 1.0f, 1);
              hq.x = __builtin_amdgcn_cvt_scalef32_pk_fp4_f32(hq.x, bflo(w0[2]) * hs, bfhi(w0[2]) * hs, 1.0f, 2); hq.x = __builtin_amdgcn_cvt_scalef32_pk_fp4_f32(hq.x, bflo(w0[3]) * hs, bfhi(w0[3]) * hs, 1.0f, 3);
              hq.y = __builtin_amdgcn_cvt_scalef32_pk_fp4_f32(0u, bflo(w1[0]) * hs, bfhi(w1[0]) * hs, 1.0f, 0); hq.y = __builtin_amdgcn_cvt_scalef32_pk_fp4_f32(hq.y, bflo(w1[1]) * hs, bfhi(w1[1]) * hs, 1.0f, 1);
              hq.y = __builtin_amdgcn_cvt_scalef32_pk_fp4_f32(hq.y, bflo(w1[2]) * hs, bfhi(w1[2]) * hs, 1.0f, 2); hq.y = __builtin_amdgcn_cvt_scalef32_pk_fp4_f32(hq.y, bflo(w1[3]) * hs, bfhi(w1[3]) * hs, 1.0f, 3);
              *(LAS u32x2*)(hrow + 8 * lane) = hq; }
            const float ascale = 1.0f / (PEER_H4_SCALE * PEER_UF4_SCALE);
            const int slot = q % PEER_NQ;
            while (flags[slot] != (unsigned)q + 1u) __builtin_amdgcn_s_sleep(2);
            asm volatile("" ::: "memory");
            if (!PSKIP(1)) peer_topk_second((const LAS float*)(F.lds + slot * PEER_SLOT_BYTES), (const LAS int*)(F.lds + slot * PEER_SLOT_BYTES + 1024), sidx, sgate, lane, dry ? PROBE_EMASK : 16383);
            asm volatile("s_waitcnt lgkmcnt(0)" ::: "memory");
            if (lane == 0) flags[slot] = 0u;
#define PEER_ISSUE4V(pp0) do { if (PROBE_NODMA && dry) break; const int pp_ = (pp0); const LAS int* ip_ = sidx + 2 * (pp_ & 63) + (lane >> 5); \
                const unsigned v0_ = (unsigned)ip_[0] + lo16 + 4096u, v1_ = (unsigned)ip_[2] + lo16 + 3072u, v2_ = (unsigned)ip_[4] + lo16 + 2048u, v3_ = (unsigned)ip_[6] + lo16 + 1024u; \
                glds16s_x4(Vb - 4096, v0_, v1_, v2_, v3_, (unsigned)__builtin_amdgcn_readfirstlane((int)(ringb + (unsigned)(pp_ & (PEER_R - 1)) * 1024u))); } while (0)
#define PEER_ISSUE4U(pp0, hi8) do { if (PROBE_NODMA && dry) break; const int pp_ = (pp0); const LAS int* ip_ = sidx + 2 * pp_ + (lane >> 5); \
                const unsigned v0_ = (unsigned)ip_[0] + (usw[0] ^ (hi8)), v1_ = (unsigned)ip_[2] + (usw[1] ^ (hi8)), v2_ = (unsigned)ip_[4] + (usw[2] ^ (hi8)), v3_ = (unsigned)ip_[6] + (usw[3] ^ (hi8)); \
                glds16s_x4(Ub - 4096, v0_, v1_, v2_, v3_, (unsigned)__builtin_amdgcn_readfirstlane((int)(ringb + (unsigned)(pp_ & (PEER_R - 1)) * 1024u))); } while (0)
            PEER_ISSUE4U(0, 0u); PEER_ISSUE4U(4, 128u); PEER_ISSUE4U(8, 0u); PEER_ISSUE4U(12, 128u);
            i32x4 hA[8];
#pragma unroll
            for (int ks = 0; ks < 8; ++ks) hA[ks] = *(const LAS i32x4*)(hrow + 64 * ks + 16 * grp);
            float dotA = 0.f, dotB = 0.f;
#pragma unroll 1
            for (int tp = PSKIP(2) ? 4 : 0; tp < 4; ++tp) {
#pragma unroll
                for (int par = 0; par < 2; ++par) { const int tt = 2 * tp + par;
                    asm volatile("s_waitcnt vmcnt(8)" ::: "memory");
                    f32x4 acc = {0.f, 0.f, 0.f, 0.f};
#pragma unroll
                    for (int ks = 0; ks < 8; ++ks) { const i32x4 b_ = *(const LAS i32x4*)(uadr[ks & 3] + 256 * (ks >> 2) + 8192 * par);
                        const i32x8 b8_ = {b_.x, b_.y, b_.z, b_.w, 0, 0, 0, 0};
                        const i32x8 a8_ = {hA[ks].x, hA[ks].y, hA[ks].z, hA[ks].w, 0, 0, 0, 0};
                        acc = __builtin_amdgcn_mfma_scale_f32_16x16x128_f8f6f4(a8_, b8_, acc, 4  , 4  , 0, 127, 0, 127); }
                    dotA = (tt == grp) ? acc[0] : dotA; dotB = (tt == grp + 4) ? acc[0] : dotB;
                    __builtin_amdgcn_sched_barrier(0);
                    if (tp < 3) { PEER_ISSUE4U(8 * tt + 16, 0u); PEER_ISSUE4U(8 * tt + 20, 128u); } else { PEER_ISSUE4V(64 + 8 * par); PEER_ISSUE4V(64 + 8 * par + 4); }
                    __builtin_amdgcn_sched_barrier(0); }
            }
            unsigned loA, hiA, loB, hiB; float bscA, bscB;
            { const float av = dotA * ascale, bv = dotB * ascale;
              const float cA = sgate[lane] * (0.5f * av * (1.0f + erff(av * 0.70710678118654752f))), cB = sgate[64 + lane] * (0.5f * bv * (1.0f + erff(bv * 0.70710678118654752f)));
              const float mxA = __builtin_bit_cast(float, row_max16(__builtin_bit_cast(unsigned, fabsf(cA)))), mxB = __builtin_bit_cast(float, row_max16(__builtin_bit_cast(unsigned, fabsf(cB))));
              const float qsA = mxA > 0.f ? 7.0f * __builtin_amdgcn_rcpf(mxA) : 0.f, qsB = mxB > 0.f ? 7.0f * __builtin_amdgcn_rcpf(mxB) : 0.f;
              const unsigned cqA = ((unsigned)(int)__builtin_rintf(cA * qsA) & 15u) << (4 * (lane & 7)), cqB = ((unsigned)(int)__builtin_rintf(cB * qsB) & 15u) << (4 * (lane & 7));
              loA = (lane & 8) ? 0u : cqA; hiA = (lane & 8) ? cqA : 0u; loB = (lane & 8) ? 0u : cqB; hiB = (lane & 8) ? cqB : 0u;
              loA |= dpp_u<0xB1>(loA); loA |= dpp_u<0x4E>(loA); loA |= dpp_u<0x141>(loA); loA |= dpp_u<0x140>(loA);
              hiA |= dpp_u<0xB1>(hiA); hiA |= dpp_u<0x4E>(hiA); hiA |= dpp_u<0x141>(hiA); hiA |= dpp_u<0x140>(hiA);
              loB |= dpp_u<0xB1>(loB); loB |= dpp_u<0x4E>(loB); loB |= dpp_u<0x141>(loB); loB |= dpp_u<0x140>(loB);
              hiB |= dpp_u<0xB1>(hiB); hiB |= dpp_u<0x4E>(hiB); hiB |= dpp_u<0x141>(hiB); hiB |= dpp_u<0x140>(hiB);
              bscA = mxA * (1.0f / 7.0f); bscB = mxB * (1.0f / 7.0f); }
            float* xo = F.out + t * 1024 + lane;
            float* xst = dry ? (float*)(F.ws + WS_PROJ + (128u << 20)) + (size_t)tl * 1024 + lane : xo;
            float xa[16];
#pragma unroll
            for (int cb = 0; cb < 16; ++cb) xa[cb] = xo[64 * cb];
            float oacc[16];
#pragma unroll
            for (int cb = 0; cb < 16; ++cb) oacc[cb] = 0.f;
            typedef int i32x2 __attribute__((ext_vector_type(2)));
#pragma unroll 1
            for (int vb = PSKIP(3) ? 8 : 0; vb < 8; ++vb) {
                if (vb < 7) asm volatile("s_waitcnt vmcnt(8)" ::: "memory"); else asm volatile("s_waitcnt vmcnt(0)" ::: "memory");
                const int sl_ = 16 * (vb & 3);
                const int clo = __builtin_amdgcn_readlane((int)(vb < 4 ? loA : loB), sl_), chi = __builtin_amdgcn_readlane((int)(vb < 4 ? hiA : hiB), sl_);
                const float bsc = __builtin_bit_cast(float, __builtin_amdgcn_readlane(__builtin_bit_cast(int, vb < 4 ? bscA : bscB), sl_));
                const LAS unsigned char* rowp = ring + (16 * (vb & 1) + (lane & 15)) * 512 + 8 * (lane >> 4);
#pragma unroll
                for (int cb = 0; cb < 16; ++cb) {
                    const i32x2 tr = __builtin_amdgcn_ds_read_tr4_b64_v2i32((LAS i32x2*)(rowp + 32 * cb));
                    const int ai = __builtin_amdgcn_sdot8(chi, tr.y, __builtin_amdgcn_sdot8(clo, tr.x, 0, false), false);
                    oacc[cb] += (float)ai * bsc;
                }
                if (vb < 6) { PEER_ISSUE4V(64 + 8 * vb + 16); PEER_ISSUE4V(64 + 8 * vb + 20); }
            }
#undef PEER_ISSUE4U
#undef PEER_ISSUE4V
            const float* gfp = F.final_norm_g + lane;
            float ss = 0.f;
#pragma unroll
            for (int cb = 0; cb < 16; ++cb) { xa[cb] = xa[cb] + oacc[cb] * (1.0f / PEER_U_SCALE); ss += xa[cb] * xa[cb]; }
            ss = row_sum16(ss); ss += bperm_f(a16, ss); ss += bperm_f(a32, ss);
            const float rf = __builtin_amdgcn_rsqf(ss * (1.0f / 1024.0f) + EPS);
#pragma unroll
            for (int cb = 0; cb < 16; ++cb) xst[64 * cb] = xa[cb] * rf * gfp[64 * cb];
            asm volatile("" :: "v"(tch1), "v"(tch2), "v"(tch3));
        }
    }
}

DI void convert_uv(Frame& F, int part, int nparts, int cu, int ncu) {
    F.refresh();
    const int gt = cu * 512 + F.tid, NGT = ncu * 512, per = (2 * 16384 * 64) / nparts;
    for (int id = part * per + gt; id < (part + 1) * per; id += NGT) {
        const int which = id >> 20, off = (id & ((1 << 20) - 1)) * 16;
        const float* src = (which ? F.peer_v : F.peer_u) + off; unsigned char* dst = F.ws + (which ? WS_V : WS_U) + off / 2;
        u32x2 o;
        if (which == 0) {
#pragma unroll
            for (int q = 0; q < 2; ++q) { const f32x4 v0 = *(const f32x4*)(src + 8 * q) * PEER_UF4_SCALE, v1 = *(const f32x4*)(src + 8 * q + 4) * PEER_UF4_SCALE;
                unsigned pk = __builtin_amdgcn_cvt_scalef32_pk_fp4_f32(0u, v0.x, v0.y, 1.0f, 0); pk = __builtin_amdgcn_cvt_scalef32_pk_fp4_f32(pk, v0.z, v0.w, 1.0f, 1);
                pk = __builtin_amdgcn_cvt_scalef32_pk_fp4_f32(pk, v1.x, v1.y, 1.0f, 2); pk = __builtin_amdgcn_cvt_scalef32_pk_fp4_f32(pk, v1.z, v1.w, 1.0f, 3); o[q] = pk; }
        } else {
#pragma unroll
            for (int q = 0; q < 2; ++q) { const f32x4 v0 = *(const f32x4*)(src + 8 * q) * PEER_U_SCALE, v1 = *(const f32x4*)(src + 8 * q + 4) * PEER_U_SCALE; unsigned pk = 0u;
#pragma unroll
                for (int k = 0; k < 4; ++k) { pk |= ((unsigned)(int)__builtin_rintf(fminf(fmaxf(v0[k], -7.f), 7.f)) & 15u) << (4 * k); pk |= ((unsigned)(int)__builtin_rintf(fminf(fmaxf(v1[k], -7.f), 7.f)) & 15u) << (16 + 4 * k); }
                o[q] = pk; }
        }
        *(u32x2*)dst = o;
    }
}

constexpr int N_PHASES = 19;
struct Args { const float* in[17]; float* out; unsigned char* ws; int ph_lo, ph_hi; };

__global__ void __launch_bounds__(NWAVES * 64, 2) fwd_kernel(Args args) {
    extern __shared__ __attribute__((aligned(16))) unsigned char lds_raw[];
    Frame F;
    F.lds = (LAS unsigned char*)lds_raw;
    F.tid = threadIdx.x; F.lane = F.tid & 63; F.wave = __builtin_amdgcn_readfirstlane(F.tid >> 6);
    F.G = gridDim.x; { const int bx = blockIdx.x; F.vcu = (F.G % 8 == 0) ? (bx % 8) * (F.G / 8) + bx / 8 : bx; }
    F.x = args.in[0]; F.mem = args.in[1]; F.norm_mix_g = args.in[2]; F.w_in = args.in[3]; F.hg_lb = args.in[4]; F.hg_norm_g = args.in[5]; F.sc_conv_w = args.in[6];
    F.mem_norm_g = args.in[7]; F.w_mem_kv = args.in[8]; F.w_branch = args.in[9]; F.w_out = args.in[10]; F.norm_ffn_g = args.in[11]; F.peer_w_q = args.in[12];
    F.peer_sub_keys = args.in[13]; F.peer_u = args.in[14]; F.peer_v = args.in[15]; F.final_norm_g = args.in[16];
    F.out = args.out; F.ws = args.ws;
    volatile LAS unsigned* MISC = (volatile LAS unsigned*)(F.lds + MISC_OFF);
    for (int u = F.tid; u < (LDS_BYTES - MISC_OFF) / 4; u += NWAVES * 64) MISC[u] = 0u;
    __syncthreads();
    unsigned* barw = (unsigned*)(F.ws + WS_CTL) + CW_BAR;
    XcdBarrier bar; bar.bar = barw; bar.x = 0; bar.st = nullptr;
    const bool one_launch = (args.ph_hi - args.ph_lo) > 1;
    if (one_launch) bar = xcd_barrier_post(barw, MISC + 8);
    const int lo = args.ph_lo, hi = args.ph_hi;
#define IN(k) (lo <= (k) && (k) < hi)
#ifndef PMASK
#define PMASK 0x3ff
#endif
#define PC_(c) ((PMASK >> (c)) & 1)
#ifndef REP_MASK
#define REP_MASK 0
#endif
#define REPS(c) for (int rep_ = 0; rep_ < 1 + 2 * ((REP_MASK >> (c)) & 1); ++rep_)
#define SEAM(k) do { if (IN(k) && IN((k) + 1)) xcd_barrier(bar); } while (0)
    unsigned char* ws = F.ws;
    const int G = F.G, cid = (int)blockIdx.x;

    if (PC_(0) && IN(0)) { REPS(0) p0_prologue(F); } SEAM(0);

#pragma unroll 1
    for (int g = 0; g < NGRP; ++g) {
        const int pb = 1 + 6 * g;
        if (PC_(1) && IN(pb)) REPS(1) {
            pg8::InOrder S; S.init(TG, PC, G, cid); S.H = (const char*)(ws + WS_XG) + (size_t)g * TG * 1024 * 2; S.Win = (const char*)(ws + WS_WIN); S.Mn = (const char*)(ws + WS_MN); S.Wkv = (const char*)(ws + WS_WKV); S.n_extra = (g == 0) ? 64 : 0;
            pg8::EpiIn E{(bf16*)(ws + WS_PROJ), (bf16*)(ws + WS_KMEM), (bf16*)(ws + WS_VT)};
            pg8::gemm_phase<pg8::EpiIn, pg8::InOrder, true, true>(F.lds, pg8::Gemm{1024, 1024, 1024}, S, E);
            if (cid >= 128) convert_uv(F, g, NGRP, cid - 128, G - 128);
        } SEAM(pb);
        if (PC_(2) && IN(pb + 1)) REPS(2) {
            for (int it = F.vcu * 4; it < BG * 4 * NCHUNK; it += G * 4) { for (int k = 0; k < 4; ++k) hgrn_a_item(F, it + k, k < 3); }
            for (int it = F.vcu; it < BG * 4 * 8; it += G) attn_item(F, g, it);
            conv_phase(F);
        } SEAM(pb + 1);
        if (PC_(3) && IN(pb + 2)) { REPS(3) hgrn_scan(F); } SEAM(pb + 2);
        if (PC_(4) && IN(pb + 3)) REPS(4) { for (int it = F.vcu * 4; it < BG * 4 * NCHUNK; it += G * 4) { for (int k = 0; k < 4; ++k) hgrn_c_item(F, it + k, k < 3); } } SEAM(pb + 3);
        if (PC_(5) && IN(pb + 4)) REPS(5) {
            pg8::BranchOrder S; S.init(TG, 1024, G, cid); S.Y = (const char*)(ws + WS_YHG); S.Wb = (const char*)(ws + WS_WBR);
            pg8::EpiBranch E{(const bf16*)(ws + WS_PROJ), (bf16*)(ws + WS_MACC), (bf16*)(ws + WS_MERGED)};
            pg8::gemm_phase<pg8::EpiBranch, pg8::BranchOrder, true, true>(F.lds, pg8::Gemm{512, 512, 512}, S, E);
        } SEAM(pb + 4);
        if (PC_(6) && IN(pb + 5)) REPS(6) {
            pg8::PlainOrder S; S.init(TG, 1024, G, cid); S.A = (const char*)(ws + WS_MERGED); S.Bt = (const char*)(ws + WS_WOUT); S.a_tile = 256 * 1024 * 2; S.b_tile = 256 * 1024 * 2;
            pg8::EpiOut E{F.x + (size_t)g * TG * 1024, F.out + (size_t)g * TG * 1024, (bf16*)(ws + WS_XG) + (size_t)g * TG * 1024, F.norm_ffn_g, (float*)(ws + WS_SSP) + (size_t)g * TG * 16};
            pg8::gemm_phase<pg8::EpiOut, pg8::PlainOrder, true, true>(F.lds, pg8::Gemm{1024, 1024, 1024}, S, E);
        } SEAM(pb + 5);
    }
#pragma unroll 1
    for (int tg = 0; tg < NGRP; ++tg) {
        const int pb = 13 + 3 * tg;
        if (PC_(7) && IN(pb)) REPS(7) {
            pg8::PlainOrder S; S.init(TG, 2048, G, cid); S.A = (const char*)(ws + WS_XG) + (size_t)tg * TG * 1024 * 2; S.Bt = (const char*)(ws + WS_WQ); S.a_tile = 256 * 1024 * 2; S.b_tile = 256 * 1024 * 2;
            pg8::EpiQ E{(bf16*)(ws + WS_Q), 2048, (const float*)(ws + WS_SSP) + (size_t)tg * TG * 16};
            pg8::gemm_phase<pg8::EpiQ, pg8::PlainOrder, true, true>(F.lds, pg8::Gemm{1024, 1024, 1024}, S, E);
        } SEAM(pb);
        if (PC_(8) && IN(pb + 1)) REPS(8) {
            pg8::ScoreOrder S; S.init(TG, 2048, G, cid); S.Q = (const char*)(ws + WS_Q); S.Kbd = (const char*)(ws + WS_KBD);
            pg8::EpiF32 E{(float*)(ws + WS_S), 2048};
            pg8::gemm_phase<pg8::EpiF32, pg8::ScoreOrder, true, true>(F.lds, pg8::Gemm{2048, 256, 256}, S, E);
        } SEAM(pb + 1);
        if (PC_(9) && IN(pb + 2)) { REPS(9) peer_phase(F, tg, rep_ < 2 * ((REP_MASK >> 9) & 1)); } SEAM(pb + 2);
    }
#undef IN
#undef SEAM
}

extern "C" void kernel_launch(void* const* d_in, const int* in_sizes, int n_in, void* d_out, int out_size, void* d_ws, size_t ws_size, hipStream_t stream) {
    static int ready = 0;
    if (ready == 0) {
        if (n_in != 17 || out_size != T_ALL * D_MODEL || ws_size < WS_END) { fprintf(stderr, "kernel_launch: unexpected shapes (n_in %d, out %d, ws %zu)\n", n_in, out_size, ws_size); ready = -1; return; }
        if (hipFuncSetAttribute((const void*)fwd_kernel, hipFuncAttributeMaxDynamicSharedMemorySize, LDS_BYTES) != hipSuccess) { fprintf(stderr, "kernel_launch: hipFuncSetAttribute failed\n"); ready = -1; return; }
        ready = 1;
    }
    if (ready < 0) return;
    (void)hipMemsetAsync((char*)d_ws + WS_CTL, 0, CTL_ZERO_BYTES, stream);
    Args a{};
    for (int i = 0; i < 17; ++i) a.in[i] = (const float*)d_in[i];
    a.out = (float*)d_out; a.ws = (unsigned char*)d_ws;
    const int grid = 256;
#if MK_N_LAUNCHES == 1
    a.ph_lo = 0; a.ph_hi = N_PHASES;
    hipLaunchKernelGGL(fwd_kernel, dim3(grid), dim3(NWAVES * 64), LDS_BYTES, stream, a);
#else
    for (int li = 0; li < N_PHASES; ++li) { a.ph_lo = li; a.ph_hi = li + 1; hipLaunchKernelGGL(fwd_kernel, dim3(grid), dim3(NWAVES * 64), LDS_BYTES, stream, a); }
#endif
}
```

```cpp
#include <hip/hip_runtime.h>
#include <cstdio>
#include <cstdint>

#ifndef MK_N_LAUNCHES
#define MK_N_LAUNCHES 1
#endif

#define LAS __attribute__((address_space(3)))
#define GAS __attribute__((address_space(1)))
typedef unsigned short bf16;
typedef short bf16x8 __attribute__((ext_vector_type(8)));
typedef short s16x4 __attribute__((ext_vector_type(4)));
typedef short v4i16_t __attribute__((ext_vector_type(4)));
typedef float f32x2 __attribute__((ext_vector_type(2)));
typedef float f32x4 __attribute__((ext_vector_type(4)));
typedef float f32x16 __attribute__((ext_vector_type(16)));
typedef unsigned u32x2 __attribute__((ext_vector_type(2)));
typedef unsigned u32x4 __attribute__((ext_vector_type(4)));
typedef __bf16 bf16x2_t __attribute__((ext_vector_type(2)));
typedef GAS unsigned gu32;
#define RLX_AGENT __ATOMIC_RELAXED, __HIP_MEMORY_SCOPE_AGENT
#define DI __device__ __forceinline__

constexpr int D_MODEL = 1024, BATCH = 16, SEQ = 2048, T_ALL = BATCH * SEQ;
constexpr int NGRP = 2, BG = BATCH / NGRP, TG = BG * SEQ;
constexpr int PC = 7680;
constexpr int C_HQ = 0, C_HI = 512, C_FF = 1024, C_FB = 1536, C_HG = 2048, C_SB = 2560, C_SC = 3072, C_SH = 3584, C_MQ = 4096, C_GATE = 4608;
constexpr int NMEM = 256, CHUNK = 64, NCHUNK = SEQ / CHUNK;
constexpr float EPS = 1e-6f;

constexpr size_t MiB = 1u << 20;
constexpr size_t WS_CTL = 0, CTL_ZERO_BYTES = 1 * MiB;
constexpr size_t WS_LB = 1 * MiB;
constexpr size_t WS_SSP = 2 * MiB;
constexpr size_t WS_DEC = 4 * MiB;
constexpr size_t WS_WIN = 5 * MiB, WS_WKV = 20 * MiB, WS_WBR = 22 * MiB, WS_WOUT = 25 * MiB, WS_WQ = 27 * MiB, WS_KBD = 31 * MiB;
constexpr size_t WS_MN = 32 * MiB, WS_KMEM = 40 * MiB, WS_VT = 44 * MiB;
constexpr size_t WS_XG = 48 * MiB;
constexpr size_t WS_YHG = 112 * MiB, WS_YSC = 128 * MiB, WS_YMX = 144 * MiB;
constexpr size_t WS_DS = 160 * MiB;
constexpr size_t WS_MACC = 160 * MiB;
constexpr size_t WS_MERGED = 224 * MiB;
constexpr size_t WS_PROJ = 256 * MiB;
constexpr size_t WS_U = 496 * MiB, WS_V = 504 * MiB;
constexpr size_t WS_Q = 176 * MiB;
constexpr size_t WS_S = 256 * MiB;
constexpr size_t WS_END = 512 * MiB;
constexpr size_t OUT_SST = 64 * MiB;

constexpr int LDS_BYTES = 160 * 1024;
constexpr int MISC_OFF = LDS_BYTES - 512;
constexpr int NWAVES = 8;

DI unsigned f2bf(float f) { unsigned u = __builtin_bit_cast(unsigned, f); return (u + 0x7fffu + ((u >> 16) & 1u)) >> 16; }
DI unsigned pk2(float lo, float hi) { return f2bf(lo) | (f2bf(hi) << 16); }
DI float bf2f(unsigned short b) { return __builtin_bit_cast(float, (unsigned)b << 16); }
DI float bflo(unsigned w) { return __builtin_bit_cast(float, w << 16); }
DI float bfhi(unsigned w) { return __builtin_bit_cast(float, w & 0xffff0000u); }
DI float wave_sum(float v) {
#pragma unroll
    for (int o = 1; o < 64; o <<= 1) v += __shfl_xor(v, o);
    return v;
}
DI unsigned cvtpk(float lo, float hi) { f32x2 v = {lo, hi}; bf16x2_t b = __builtin_convertvector(v, bf16x2_t); return __builtin_bit_cast(unsigned, b); }
template <int CTRL> DI unsigned dpp_u(unsigned v) { return (unsigned)__builtin_amdgcn_update_dpp(0, (int)v, CTRL, 0xF, 0xF, false); }
template <int CTRL> DI float dpp_f(float v) { return __builtin_bit_cast(float, __builtin_amdgcn_update_dpp(0, __builtin_bit_cast(int, v), CTRL, 0xF, 0xF, false)); }
DI float bperm_f(int addr, float v) { return __builtin_bit_cast(float, __builtin_amdgcn_ds_bpermute(addr, __builtin_bit_cast(int, v))); }
DI unsigned row_max16(unsigned m) { m = max(m, dpp_u<0xB1>(m)); m = max(m, dpp_u<0x4E>(m)); m = max(m, dpp_u<0x141>(m)); return max(m, dpp_u<0x140>(m)); }
DI float row_sum16(float v) { v += dpp_f<0xB1>(v); v += dpp_f<0x4E>(v); v += dpp_f<0x141>(v); return v + dpp_f<0x140>(v); }

DI float fast_sig(float z) { return __builtin_amdgcn_rcpf(1.0f + __builtin_amdgcn_exp2f(-1.4426950408889634f * z)); }
DI float sigmoidf_(float z) { return 1.0f / (1.0f + __expf(-z)); }

namespace pg8 {
constexpr int BM = 256, BK = 64, HALF = 128, HTB = HALF * BK * 2, STAGE_BYTES = 8 * HTB, NXCD = 8, WGM = 8;
__host__ __device__ __forceinline__ int lds_byte(int r, int c) { const int st = (r >> 4) * 2 + (c >> 5), rr = r & 15, cc = c & 31, ob = rr * 64 + cc * 2; return st * 1024 + (ob ^ (((ob >> 9) & 1) << 5)); }
__host__ __device__ __forceinline__ void stage_rc(int b, int& R, int& C) { const int st = b / 1024, sb = b % 1024, swz = sb ^ (((sb >> 9) & 1) << 5); R = (st >> 1) * 16 + swz / 64; C = (st & 1) * 32 + (swz % 64) / 2; }
__host__ __device__ __forceinline__ int perm32(int rho) { const int n = rho >> 4, i = rho & 15; return 8 * (i >> 2) + 4 * n + (i & 3); }

struct Unit { int pm, pn, z; };
struct Gemm { int lda, ldb, K; };

struct StaticOrder {
    int nM, nN, nwg, G, c;
    __device__ void init(int M, int N, int G_, int c_) { nM = M / BM; nN = N / BM; nwg = nM * nN; G = G_; c = c_; }
    __device__ bool tile(int i, Unit& u) const {
        const long L = (long)i * G + c; if (L >= nwg) return false;
        int wgid = (int)L; { const int q = nwg / NXCD, r = nwg % NXCD, xcd = wgid % NXCD, off = wgid / NXCD; wgid = (xcd < r ? xcd * (q + 1) : r * (q + 1) + (xcd - r) * q) + off; }
        const int nig = WGM * nN, gid = wgid / nig, fm = gid * WGM, gsz = (nM - fm) < WGM ? (nM - fm) : WGM;
        u.pm = fm + ((wgid % nig) % gsz); u.pn = (wgid % nig) / gsz; u.z = 0; return true;
    }
};

DI unsigned cvt_pk_bf16(float lo, float hi) { return cvtpk(lo, hi); }

template <class Epi, class Sched, bool ALIGN_EPI, bool SP2>
DI void gemm_phase(LAS unsigned char* lds, const Gemm g, const Sched& S, const Epi& E) {
    int tid_ = threadIdx.x; asm volatile("" : "+v"(tid_));
    const int tid = tid_, wid = __builtin_amdgcn_readfirstlane(tid >> 6), lane = tid & 63, wr = wid >> 2, wc = wid & 3, fr = lane & 15, fq = lane >> 4;
    int K_ = g.K; asm volatile("" : "+s"(K_));
    const int K = K_, nt = K / BK;
    unsigned voffA[2], voffB[2];
#pragma unroll
    for (int i = 0; i < 2; ++i) { int R, C; stage_rc(tid * 16 + i * 8192, R, C); const int Rb = Epi::PERM ? ((R & ~31) + perm32(R & 31)) : R;
        voffA[i] = (unsigned)(R * g.lda + C) * 2u; voffB[i] = (unsigned)(Rb * g.ldb + C) * 2u; }
    const size_t kstep = (size_t)(BK * 2);
    const size_t hA = (size_t)HALF * g.lda * 2, hB = (size_t)HALF * g.ldb * 2;
    const unsigned ldsw = (unsigned)wid * 1024u;
    const int aoff = lds_byte(wr * 64 + fr, fq * 8), boff = lds_byte(wc * 32 + fr, fq * 8);
#define PG8_SA(b, h) (((b) * 2 + (h)) * HTB)
#define PG8_SB(b, h) ((4 + (b) * 2 + (h)) * HTB)
#define PG8_STAGE(bufoff, gbase, voff) do { _Pragma("unroll") for (int _i = 0; _i < 2; ++_i) \
        __builtin_amdgcn_global_load_lds((const unsigned*)((const char*)(gbase) + (voff)[_i]), (LAS unsigned*)(lds + (bufoff) + ldsw + _i * 8192), 16, 0, 0); } while (0)
#define PG8_LDA(dst, b, h) do { _Pragma("unroll") for (int m = 0; m < 4; ++m) _Pragma("unroll") for (int k = 0; k < 2; ++k) dst[m][k] = *(const LAS bf16x8*)(lds + PG8_SA(b, h) + aoff + m * 2048 + k * 1024); } while (0)
#define PG8_LDB(dst, b, h) do { _Pragma("unroll") for (int n = 0; n < 2; ++n) _Pragma("unroll") for (int k = 0; k < 2; ++k) dst[n][k] = *(const LAS bf16x8*)(lds + PG8_SB(b, h) + boff + n * 2048 + k * 1024); } while (0)
#define PG8_MMA(ai, bj, At, Bt) do { __builtin_amdgcn_s_setprio(1); _Pragma("unroll") for (int m = 0; m < 4; ++m) _Pragma("unroll") for (int n = 0; n < 2; ++n) _Pragma("unroll") for (int k = 0; k < 2; ++k) \
        acc[ai][bj][m][n] = __builtin_amdgcn_mfma_f32_16x16x32_bf16(Bt[n][k], At[m][k], acc[ai][bj][m][n], 0, 0, 0); __builtin_amdgcn_s_setprio(0); } while (0)
#define PG8_WAIT_V(n) asm volatile("s_waitcnt vmcnt(" #n ")" ::: "memory")
#define PG8_WAIT_L(n) asm volatile("s_waitcnt lgkmcnt(" #n ")" ::: "memory")
#define PG8_BAR __builtin_amdgcn_s_barrier()
#define PG8_SCHED __builtin_amdgcn_sched_barrier(0)
    Unit cur, nxt; int ui = 0;
    if (!S.next(0, cur)) return;
    f32x4 acc[2][2][4][2];
#pragma unroll
    for (int a = 0; a < 2; ++a)
#pragma unroll
        for (int b = 0; b < 2; ++b)
#pragma unroll
            for (int m = 0; m < 4; ++m)
#pragma unroll
                for (int n = 0; n < 2; ++n) acc[a][b][m][n] = (f32x4){0.f, 0.f, 0.f, 0.f};
    bf16x8 At[4][2], B0[2][2], B1[2][2];
    const char* cA = S.a_base(cur); const char* cB = S.b_base(cur);
    if constexpr (SP2) {
        PG8_STAGE(PG8_SB(0, 0), cB, voffB); PG8_STAGE(PG8_SB(0, 1), cB + hB, voffB); PG8_STAGE(PG8_SA(0, 0), cA, voffA); PG8_STAGE(PG8_SA(0, 1), cA + hA, voffA);
        if (wr == 1) PG8_BAR;
        PG8_WAIT_V(2); PG8_BAR;
        PG8_STAGE(PG8_SB(1, 0), cB + kstep, voffB); PG8_STAGE(PG8_SA(1, 0), cA + kstep, voffA); PG8_STAGE(PG8_SB(1, 1), cB + hB + kstep, voffB);
        PG8_WAIT_V(6); PG8_BAR;
    } else {
        PG8_STAGE(PG8_SB(0, 0), cB, voffB); PG8_STAGE(PG8_SA(0, 0), cA, voffA); PG8_STAGE(PG8_SB(0, 1), cB + hB, voffB); PG8_STAGE(PG8_SA(0, 1), cA + hA, voffA);
        if (wr == 1) PG8_BAR;
        PG8_WAIT_V(4); PG8_BAR;
        PG8_STAGE(PG8_SB(1, 0), cB + kstep, voffB); PG8_STAGE(PG8_SA(1, 0), cA + kstep, voffA); PG8_STAGE(PG8_SB(1, 1), cB + hB + kstep, voffB);
        PG8_WAIT_V(6); PG8_BAR;
    }
    for (;;) {
        const bool has_next = S.next(ui + 1, nxt);
        const char* nA = has_next ? S.a_base(nxt) : cA; const char* nB = has_next ? S.b_base(nxt) : cB;
        for (int t = 0; t < nt; t += 2) {
            const bool last = (t == nt - 2);
            const char* a1 = cA + (size_t)(t + 1) * kstep;
            const char* a2 = last ? nA : cA + (size_t)(t + 2) * kstep; const char* b2 = last ? nB : cB + (size_t)(t + 2) * kstep;
            const char* a3 = a2 + kstep; const char* b3 = b2 + kstep;
            if constexpr (SP2) {
            PG8_LDB(B0, 0, 0); PG8_LDB(B1, 0, 1); PG8_SCHED; PG8_LDA(At, 0, 0); PG8_STAGE(PG8_SA(1, 1), a1 + hA, voffA);
            PG8_WAIT_V(8); PG8_WAIT_L(0); PG8_BAR; PG8_MMA(0, 0, At, B0); PG8_MMA(0, 1, At, B1); PG8_BAR; PG8_SCHED;
            PG8_LDA(At, 0, 1); PG8_STAGE(PG8_SB(0, 0), b2, voffB); PG8_STAGE(PG8_SB(0, 1), b2 + hB, voffB); PG8_STAGE(PG8_SA(0, 0), a2, voffA);
            PG8_WAIT_V(8); PG8_WAIT_L(0); PG8_BAR; PG8_MMA(1, 0, At, B0); PG8_MMA(1, 1, At, B1); PG8_BAR; PG8_SCHED;
            PG8_LDB(B0, 1, 0); PG8_LDB(B1, 1, 1); PG8_SCHED; PG8_LDA(At, 1, 0); PG8_STAGE(PG8_SA(0, 1), a2 + hA, voffA);
            PG8_WAIT_V(8); PG8_WAIT_L(0); PG8_BAR; PG8_MMA(0, 0, At, B0); PG8_MMA(0, 1, At, B1); PG8_BAR; PG8_SCHED;
            PG8_LDA(At, 1, 1); PG8_STAGE(PG8_SB(1, 0), b3, voffB); PG8_STAGE(PG8_SB(1, 1), b3 + hB, voffB); PG8_STAGE(PG8_SA(1, 0), a3, voffA);
            PG8_WAIT_V(8); PG8_WAIT_L(0); PG8_BAR; PG8_MMA(1, 0, At, B0); PG8_MMA(1, 1, At, B1); PG8_BAR; PG8_SCHED;
            } else {
            PG8_LDB(B0, 0, 0); PG8_SCHED; PG8_LDA(At, 0, 0); PG8_STAGE(PG8_SA(1, 1), a1 + hA, voffA);
            PG8_WAIT_L(8); PG8_BAR; PG8_WAIT_L(0); PG8_MMA(0, 0, At, B0); PG8_BAR; PG8_SCHED;
            PG8_LDB(B1, 0, 1); PG8_STAGE(PG8_SB(0, 0), b2, voffB);
            PG8_BAR; PG8_WAIT_L(0); PG8_MMA(0, 1, At, B1); PG8_BAR;
            PG8_LDA(At, 0, 1); PG8_STAGE(PG8_SA(0, 0), a2, voffA);
            PG8_BAR; PG8_WAIT_L(0); PG8_MMA(1, 0, At, B0); PG8_BAR; PG8_SCHED;
            PG8_STAGE(PG8_SB(0, 1), b2 + hB, voffB);
            PG8_WAIT_V(6); PG8_BAR; PG8_MMA(1, 1, At, B1); PG8_BAR;
            PG8_LDB(B0, 1, 0); PG8_SCHED; PG8_LDA(At, 1, 0); PG8_STAGE(PG8_SA(0, 1), a2 + hA, voffA);
            PG8_WAIT_L(8); PG8_BAR; PG8_WAIT_L(0); PG8_MMA(0, 0, At, B0); PG8_BAR; PG8_SCHED;
            PG8_LDB(B1, 1, 1); PG8_STAGE(PG8_SB(1, 0), b3, voffB);
            PG8_BAR; PG8_WAIT_L(0); PG8_MMA(0, 1, At, B1); PG8_BAR;
            PG8_LDA(At, 1, 1); PG8_STAGE(PG8_SA(1, 0), a3, voffA);
            PG8_BAR; PG8_WAIT_L(0); PG8_MMA(1, 0, At, B0); PG8_BAR; PG8_SCHED;
            PG8_STAGE(PG8_SB(1, 1), b3 + hB, voffB);
            PG8_WAIT_V(6); PG8_BAR; PG8_MMA(1, 1, At, B1); PG8_BAR;
            }
        }
        if constexpr (ALIGN_EPI) { if (wr == 0) PG8_BAR; }
        E(acc, cur, wr, wc, fr, fq);
        if (!has_next) break;
#pragma unroll
        for (int a = 0; a < 2; ++a)
#pragma unroll
            for (int b = 0; b < 2; ++b)
#pragma unroll
                for (int m = 0; m < 4; ++m)
#pragma unroll
                    for (int n = 0; n < 2; ++n) acc[a][b][m][n] = (f32x4){0.f, 0.f, 0.f, 0.f};
        cur = nxt; cA = nA; cB = nB; ++ui;
        if constexpr (ALIGN_EPI) { if (wr == 1) PG8_BAR; }
    }
    PG8_WAIT_V(0);
    if constexpr (!ALIGN_EPI) { if (wr == 0) PG8_BAR; }
    PG8_BAR;
#undef PG8_SA
#undef PG8_SB
#undef PG8_STAGE
#undef PG8_LDA
#undef PG8_LDB
#undef PG8_MMA
#undef PG8_WAIT_V
#undef PG8_WAIT_L
#undef PG8_BAR
#undef PG8_SCHED
}
}

namespace pg8 {
struct PlainOrder : StaticOrder {
    const char* A; const char* Bt; size_t a_tile, b_tile;
    __device__ bool next(int i, Unit& u) const { return tile(i, u); }
    DI const char* a_base(const Unit& u) const { return A + (size_t)u.pm * a_tile; }
    DI const char* b_base(const Unit& u) const { return Bt + (size_t)u.pn * b_tile; }
};
struct InOrder : StaticOrder {
    const char* H; const char* Win; const char* Mn; const char* Wkv; int n_extra;
    __device__ bool next(int i, Unit& u) const {
        const long L = (long)i * G + c;
        if (L >= (long)nwg + n_extra) return false;
        Unit t; t.pm = 0; t.pn = 0; t.z = 0;
        const bool main_tile = L < nwg;
        if (main_tile) (void)tile(i, t);
        const int e = (int)(L - nwg);
        const int pm1 = e >> 1, pn1 = e & 1, pm2 = (e - 32) >> 4, pn2 = (e - 32) & 15; const bool k1 = e < 32;
        u.pm = main_tile ? t.pm : (k1 ? pm1 : pm2); u.pn = main_tile ? t.pn : (k1 ? pn1 : pn2); u.z = main_tile ? 0 : (k1 ? 1 : 2);
        return true;
    }
    DI const char* a_base(const Unit& u) const { const long d1 = Mn - H, d2 = (Wkv + (size_t)512 * 1024 * 2) - H; return H + ((u.z == 1) ? d1 : 0L) + ((u.z == 2) ? d2 : 0L) + (size_t)u.pm * (256 * 1024 * 2); }
    DI const char* b_base(const Unit& u) const { const long d1 = Wkv - Win, d2 = Mn - Win; return Win + ((u.z == 1) ? d1 : 0L) + ((u.z == 2) ? d2 : 0L) + (size_t)u.pn * (256 * 1024 * 2); }
};
struct EpiIn {
    static constexpr bool PERM = true;
    bf16* proj; bf16* kmem; bf16* vt;
    DI void operator()(const f32x4 (&acc)[2][2][4][2], const Unit& u, int wr, int wc, int fr, int fq) const {
        const long dk = kmem - proj, dv = vt - proj; bf16* O = proj + ((u.z == 1) ? dk : 0L) + ((u.z == 2) ? dv : 0L); const int ldc = PC + ((u.z == 1) ? 512 - PC : 0) + ((u.z == 2) ? BATCH * NMEM - PC : 0);
        const int row0 = u.pm * BM + wr * 64 + fr, col0 = u.pn * BM + wc * 32 + 8 * fq;
#pragma unroll
        for (int ai = 0; ai < 2; ++ai)
#pragma unroll
            for (int m = 0; m < 4; ++m) { bf16* rowp = O + (size_t)(row0 + ai * HALF + m * 16) * ldc + col0;
#pragma unroll
                for (int bj = 0; bj < 2; ++bj) { const f32x4 v0 = acc[ai][bj][m][0], v1 = acc[ai][bj][m][1];
                    u32x4 w; w.x = cvt_pk_bf16(v0[0], v0[1]); w.y = cvt_pk_bf16(v0[2], v0[3]); w.z = cvt_pk_bf16(v1[0], v1[1]); w.w = cvt_pk_bf16(v1[2], v1[3]);
                    *(u32x4*)(rowp + bj * HALF) = w; } }
    }
};
struct BranchOrder : StaticOrder {
    const char* Y; const char* Wb;
    __device__ bool next(int i, Unit& u) const { if (!tile(i / 3, u)) return false; u.z = i % 3; return true; }
    DI const char* a_base(const Unit& u) const { return Y + (size_t)u.z * (16 * MiB) + (size_t)u.pm * (256 * 512 * 2); }
    DI const char* b_base(const Unit& u) const { return Wb + (size_t)u.z * (1024 * 512 * 2) + (size_t)u.pn * (256 * 512 * 2); }
};
struct ScoreOrder : StaticOrder {
    const char* Q; const char* Kbd;
    __device__ bool next(int i, Unit& u) const { return tile(i, u); }
    DI const char* a_base(const Unit& u) const { return Q + (size_t)u.pm * (256 * 2048 * 2) + (size_t)u.pn * 512; }
    DI const char* b_base(const Unit& u) const { return Kbd + (size_t)u.pn * (256 * 256 * 2); }
};

struct EpiBf16 {
    static constexpr bool PERM = true;
    bf16* O; int ldc;
    DI void operator()(const f32x4 (&acc)[2][2][4][2], const Unit& u, int wr, int wc, int fr, int fq) const {
        const int row0 = u.pm * BM + wr * 64 + fr, col0 = u.pn * BM + wc * 32 + 8 * fq;
#pragma unroll
        for (int ai = 0; ai < 2; ++ai)
#pragma unroll
            for (int m = 0; m < 4; ++m) { bf16* rowp = O + (size_t)(row0 + ai * HALF + m * 16) * ldc + col0;
#pragma unroll
                for (int bj = 0; bj < 2; ++bj) { const f32x4 v0 = acc[ai][bj][m][0], v1 = acc[ai][bj][m][1];
                    u32x4 w; w.x = cvt_pk_bf16(v0[0], v0[1]); w.y = cvt_pk_bf16(v0[2], v0[3]); w.z = cvt_pk_bf16(v1[0], v1[1]); w.w = cvt_pk_bf16(v1[2], v1[3]);
                    *(u32x4*)(rowp + bj * HALF) = w; } }
    }
};
struct EpiQ {
    static constexpr bool PERM = true;
    bf16* O; int ldc; const float* ssp;
    DI void operator()(const f32x4 (&acc)[2][2][4][2], const Unit& u, int wr, int wc, int fr, int fq) const {
        const int row0 = u.pm * BM + wr * 64 + fr, col0 = u.pn * BM + wc * 32 + 8 * fq;
#pragma unroll
        for (int ai = 0; ai < 2; ++ai)
#pragma unroll
            for (int m = 0; m < 4; ++m) { const int row = row0 + ai * HALF + m * 16; const f32x4* sp = (const f32x4*)(ssp + (size_t)row * 16);
                const f32x4 s0 = sp[0], s1 = sp[1], s2 = sp[2], s3 = sp[3];
                const float ss = ((s0[0] + s0[1]) + (s0[2] + s0[3])) + ((s1[0] + s1[1]) + (s1[2] + s1[3])) + ((s2[0] + s2[1]) + (s2[2] + s2[3])) + ((s3[0] + s3[1]) + (s3[2] + s3[3]));
                const float rs = 1.0f / sqrtf(ss * (1.0f / 1024.0f) + EPS);
                bf16* rowp = O + (size_t)row * ldc + col0;
#pragma unroll
                for (int bj = 0; bj < 2; ++bj) { const f32x4 v0 = acc[ai][bj][m][0] * rs, v1 = acc[ai][bj][m][1] * rs;
                    u32x4 w; w.x = cvt_pk_bf16(v0[0], v0[1]); w.y = cvt_pk_bf16(v0[2], v0[3]); w.z = cvt_pk_bf16(v1[0], v1[1]); w.w = cvt_pk_bf16(v1[2], v1[3]);
                    *(u32x4*)(rowp + bj * HALF) = w; }
                asm volatile("" ::: "memory"); }
    }
};
struct EpiF32 {
    static constexpr bool PERM = false;
    float* C; int ldc;
    DI void operator()(const f32x4 (&acc)[2][2][4][2], const Unit& u, int wr, int wc, int fr, int fq) const {
        const int row0 = u.pm * BM + wr * 64 + fr, col0 = u.pn * BM + wc * 32 + 4 * fq;
#pragma unroll
        for (int ai = 0; ai < 2; ++ai)
#pragma unroll
            for (int m = 0; m < 4; ++m) { float* rowp = C + (size_t)(row0 + ai * HALF + m * 16) * ldc + col0;
#pragma unroll
                for (int bj = 0; bj < 2; ++bj)
#pragma unroll
                    for (int n = 0; n < 2; ++n) *(f32x4*)(rowp + bj * HALF + n * 16) = acc[ai][bj][m][n]; }
    }
};
struct EpiBranch {
    static constexpr bool PERM = true;
    const bf16* proj; bf16* gbuf; bf16* merged;
    DI void operator()(const f32x4 (&acc)[2][2][4][2], const Unit& u, int wr, int wc, int fr, int fq) const {
        const int row0 = u.pm * BM + wr * 64 + fr, col0 = u.pn * BM + wc * 32 + 8 * fq;
#pragma unroll
        for (int ai = 0; ai < 2; ++ai)
#pragma unroll
            for (int m = 0; m < 4; ++m) { const int row = row0 + ai * HALF + m * 16;
#pragma unroll
                for (int bj = 0; bj < 2; ++bj) { const int col = col0 + bj * HALF;
                    const u32x4 gw = *(const u32x4*)(proj + (size_t)row * PC + C_GATE + u.z * 1024 + col);
                    f32x4 v0 = acc[ai][bj][m][0], v1 = acc[ai][bj][m][1];
                    v0[0] *= fast_sig(bflo(gw.x)); v0[1] *= fast_sig(bfhi(gw.x)); v0[2] *= fast_sig(bflo(gw.y)); v0[3] *= fast_sig(bfhi(gw.y));
                    v1[0] *= fast_sig(bflo(gw.z)); v1[1] *= fast_sig(bfhi(gw.z)); v1[2] *= fast_sig(bflo(gw.w)); v1[3] *= fast_sig(bfhi(gw.w));
                    const size_t off = (size_t)row * 1024 + col;
                    if (u.z == 2) { const u32x4 p0 = *(const u32x4*)(gbuf + off), p1 = *(const u32x4*)(gbuf + (size_t)TG * 1024 + off);
                        v0[0] += bflo(p0.x) + bflo(p1.x); v0[1] += bfhi(p0.x) + bfhi(p1.x); v0[2] += bflo(p0.y) + bflo(p1.y); v0[3] += bfhi(p0.y) + bfhi(p1.y);
                        v1[0] += bflo(p0.z) + bflo(p1.z); v1[1] += bfhi(p0.z) + bfhi(p1.z); v1[2] += bflo(p0.w) + bflo(p1.w); v1[3] += bfhi(p0.w) + bfhi(p1.w); }
                    u32x4 w; w.x = cvt_pk_bf16(v0[0], v0[1]); w.y = cvt_pk_bf16(v0[2], v0[3]); w.z = cvt_pk_bf16(v1[0], v1[1]); w.w = cvt_pk_bf16(v1[2], v1[3]);
                    *(u32x4*)((u.z == 2 ? merged : gbuf + (size_t)u.z * TG * 1024) + off) = w; }
                asm volatile("" ::: "memory"); }
    }
};
struct EpiOut {
    static constexpr bool PERM = true;
    const float* x; float* x1; bf16* xg; const float* gffn; float* ssp;
    DI void operator()(const f32x4 (&acc)[2][2][4][2], const Unit& u, int wr, int wc, int fr, int fq) const {
        const int row0 = u.pm * BM + wr * 64 + fr, col0 = u.pn * BM + wc * 32 + 8 * fq;
        f32x4 g0[2], g1[2];
#pragma unroll
        for (int bj = 0; bj < 2; ++bj) { g0[bj] = *(const f32x4*)(gffn + col0 + bj * HALF); g1[bj] = *(const f32x4*)(gffn + col0 + bj * HALF + 4); }
#pragma unroll
        for (int ai = 0; ai < 2; ++ai)
#pragma unroll
            for (int m = 0; m < 4; ++m) { const int row = row0 + ai * HALF + m * 16; float ss = 0.f;
#pragma unroll
                for (int bj = 0; bj < 2; ++bj) { const size_t off = (size_t)row * 1024 + col0 + bj * HALF;
                    const f32x4 v0 = acc[ai][bj][m][0] + *(const f32x4*)(x + off), v1 = acc[ai][bj][m][1] + *(const f32x4*)(x + off + 4);
                    *(f32x4*)(x1 + off) = v0; *(f32x4*)(x1 + off + 4) = v1;
                    ss += (v0[0] * v0[0] + v0[1] * v0[1]) + (v0[2] * v0[2] + v0[3] * v0[3]) + (v1[0] * v1[0] + v1[1] * v1[1]) + (v1[2] * v1[2] + v1[3] * v1[3]);
                    const f32x4 a = v0 * g0[bj], b = v1 * g1[bj];
                    u32x4 w; w.x = cvt_pk_bf16(a[0], a[1]); w.y = cvt_pk_bf16(a[2], a[3]); w.z = cvt_pk_bf16(b[0], b[1]); w.w = cvt_pk_bf16(b[2], b[3]);
                    *(u32x4*)(xg + off) = w; }
                ss += __shfl_xor(ss, 16); ss += __shfl_xor(ss, 32);
                if (fq == 0) ssp[(size_t)row * 16 + u.pn * 4 + wc] = ss;
                asm volatile("" ::: "memory"); }
    }
};
}

#define XB_TMO      128
#define XB_XCNT(j)  (256  + 64 * (j))
#define XB_XSUB(j)  (1280 + 64 * (j))
#define XB_XGEN(j)  (2304 + 64 * (j))
#define XB_TOP      3328
#define XB_TOPGEN   3392
#define XCD_BAR_WORDS 3456
#define XB_SPIN_CAP (1u << 18)
constexpr int CW_BAR = 4096;

DI unsigned xb_ld(unsigned* p)              { return __hip_atomic_load(p, __ATOMIC_RELAXED, __HIP_MEMORY_SCOPE_AGENT); }
DI unsigned xb_add(unsigned* p, unsigned v) { return __hip_atomic_fetch_add(p, v, __ATOMIC_RELAXED, __HIP_MEMORY_SCOPE_AGENT); }
DI unsigned xb_xcc_id() { return (unsigned)__builtin_amdgcn_s_getreg((3 << 11) | 20) & 0xFu; }
#define XB_SPIN(cond, bar) do { unsigned _sp = 0; while (cond) { __builtin_amdgcn_s_sleep(1); \
    if ((++_sp & 255u) == 0u) { if (xb_ld(&(bar)[XB_TMO])) break; if (_sp > XB_SPIN_CAP) { atomicAdd(&(bar)[XB_TMO], 1u); break; } } } } while (0)

struct XcdBarrier { unsigned* bar; unsigned x; volatile LAS unsigned* st; };

DI XcdBarrier xcd_barrier_post(unsigned* bar, volatile LAS unsigned* st) {
    XcdBarrier b; b.bar = bar; b.x = xb_xcc_id(); b.st = st;
    if (threadIdx.x == 0) (void)xb_add(&bar[XB_XCNT(b.x)], 1u);
    return b;
}
DI void xcd_barrier_complete(unsigned* bar, unsigned x, unsigned& nloc, unsigned& nx) {
    const unsigned G = gridDim.x * gridDim.y * gridDim.z;
    unsigned sum, cnt, mine, sp = 0u;
    for (;;) {
        sum = 0u; cnt = 0u; mine = 0u;
#pragma unroll
        for (unsigned j = 0; j < 16; ++j) { const unsigned c = xb_ld(&bar[XB_XCNT(j)]); sum += c; cnt += (c > 0u) ? 1u : 0u; mine = (j == x) ? c : mine; }
        if (sum == G) break;
        __builtin_amdgcn_s_sleep(1);
        if ((++sp & 255u) == 0u) { if (xb_ld(&bar[XB_TMO])) break; if (sp > XB_SPIN_CAP) { atomicAdd(&bar[XB_TMO], 1u); break; } }
    }
    nloc = mine > 0u ? mine : 1u; nx = cnt > 0u ? cnt : 1u;
}
DI void xcd_barrier(const XcdBarrier& b) {
    asm volatile("s_waitcnt vmcnt(0)" ::: "memory");
    __syncthreads();
    if (threadIdx.x == 0) {
        unsigned* bar = b.bar;
        __builtin_amdgcn_s_waitcnt(0);
        unsigned nloc = b.st[0], nx = b.st[1];
        if (nloc == 0u) { xcd_barrier_complete(bar, b.x, nloc, nx); b.st[0] = nloc; b.st[1] = nx; }
        const unsigned old = xb_add(&bar[XB_XSUB(b.x)], 1u);
        const unsigned gen = old / nloc;
        if (old + 1u == (gen + 1u) * nloc) {
            __builtin_amdgcn_fence(__ATOMIC_RELEASE, "agent");
            asm volatile("s_waitcnt vmcnt(0)" ::: "memory");
            const unsigned og = xb_add(&bar[XB_TOP], 1u);
            const unsigned tg = og / nx;
            if (og + 1u == (tg + 1u) * nx) xb_add(&bar[XB_TOPGEN], 1u);
            else XB_SPIN(xb_ld(&bar[XB_TOPGEN]) == tg, bar);
            __builtin_amdgcn_fence(__ATOMIC_ACQUIRE, "agent");
            xb_add(&bar[XB_XGEN(b.x)], 1u);
            asm volatile("s_waitcnt vmcnt(0)" ::: "memory");
        } else {
            XB_SPIN(xb_ld(&bar[XB_XGEN(b.x)]) == gen, bar);
            __builtin_amdgcn_fence(__ATOMIC_ACQUIRE, "agent");
            asm volatile("s_waitcnt vmcnt(0)" ::: "memory");
        }
    }
    __syncthreads();
}

struct Frame {
    LAS unsigned char* lds;
    int tid, lane, wave;
    DI void refresh() { int t = threadIdx.x; asm volatile("" : "+v"(t)); tid = t; lane = t & 63; wave = __builtin_amdgcn_readfirstlane(t >> 6); }
    int vcu, G;
    const float *x, *mem, *norm_mix_g, *w_in, *hg_lb, *hg_norm_g, *sc_conv_w, *mem_norm_g, *w_mem_kv, *w_branch, *w_out, *norm_ffn_g, *peer_w_q, *peer_sub_keys, *peer_u, *peer_v, *final_norm_g;
    float* out; unsigned char* ws;
};

DI void p0_transpose_item(const float* W, int K, int N, bf16* WT, LAS float* scr, int item, int lane) {
    const int nblk = N / 32, kb = item / nblk, nb = item % nblk, k0 = 64 * kb, n0 = 32 * nb;
#pragma unroll 8
    for (int i = 0; i < 32; ++i) { const int kk = 2 * i + (lane >> 5); scr[kk * 33 + (lane & 31)] = W[(size_t)(k0 + kk) * N + n0 + (lane & 31)]; }
    asm volatile("s_waitcnt lgkmcnt(0)" ::: "memory");
    const int c = lane & 7;
#pragma unroll
    for (int j = 0; j < 4; ++j) { const int n = (lane >> 3) + 8 * j; const LAS float* s = scr + (8 * c) * 33 + n;
        u32x4 o; o.x = pk2(s[0 * 33], s[1 * 33]); o.y = pk2(s[2 * 33], s[3 * 33]); o.z = pk2(s[4 * 33], s[5 * 33]); o.w = pk2(s[6 * 33], s[7 * 33]);
        *(u32x4*)(WT + (size_t)(n0 + n) * K + k0 + 8 * c) = o; }
    asm volatile("s_waitcnt lgkmcnt(0)" ::: "memory");
}
DI void rms_row_to_bf16(const float* xrow, const float* g, bf16* orow, int lane) {
    const f32x4* xr = (const f32x4*)xrow + lane; const f32x4* gr = (const f32x4*)g + lane;
    f32x4 v[4]; float s = 0.f;
#pragma unroll
    for (int j = 0; j < 4; ++j) { v[j] = xr[64 * j]; s += (v[j].x * v[j].x + v[j].y * v[j].y) + (v[j].z * v[j].z + v[j].w * v[j].w); }
    const float rstd = 1.0f / sqrtf(wave_sum(s) * (1.f / 1024.f) + EPS);
    unsigned long long* o8 = (unsigned long long*)orow + lane;
#pragma unroll
    for (int j = 0; j < 4; ++j) { const f32x4 gg = gr[64 * j]; const f32x4 y = v[j] * rstd * gg;
        o8[64 * j] = (unsigned long long)pk2(y.x, y.y) | ((unsigned long long)pk2(y.z, y.w) << 32); }
}
DI void p0_prologue(Frame& F) {
    F.refresh();
    LAS float* scr = (LAS float*)(F.lds + F.wave * 16384);
    const int gw = F.vcu * NWAVES + F.wave, NGW = F.G * NWAVES;
    unsigned char* ws = F.ws;
    constexpr int I_IN = (1024 / 64) * (PC / 32), I_KV = (1024 / 64) * (1024 / 32), I_BR = (512 / 64) * (1024 / 32), I_OUT = (1024 / 64) * (1024 / 32), I_Q = (1024 / 64) * (2048 / 32);
    constexpr int NITEMS = I_IN + I_KV + 3 * I_BR + I_OUT + I_Q;
    for (int it = gw; it < NITEMS; it += NGW) {
        int r = it;
        if (r < I_IN) { p0_transpose_item(F.w_in, 1024, PC, (bf16*)(ws + WS_WIN), scr, r, F.lane); continue; } r -= I_IN;
        if (r < I_KV) { p0_transpose_item(F.w_mem_kv, 1024, 1024, (bf16*)(ws + WS_WKV), scr, r, F.lane); continue; } r -= I_KV;
        if (r < 3 * I_BR) { const int n = r / I_BR; p0_transpose_item(F.w_branch + (size_t)n * 512 * 1024, 512, 1024, (bf16*)(ws + WS_WBR) + (size_t)n * 1024 * 512, scr, r % I_BR, F.lane); continue; } r -= 3 * I_BR;
        if (r < I_OUT) { p0_transpose_item(F.w_out, 1024, 1024, (bf16*)(ws + WS_WOUT), scr, r, F.lane); continue; } r -= I_OUT;
        p0_transpose_item(F.peer_w_q, 1024, 2048, (bf16*)(ws + WS_WQ), scr, r, F.lane);
    }
    const int gt = F.vcu * 512 + F.tid, NGT = F.G * 512;
    for (int it = gt; it < 8 * 256 * 32; it += NGT) {
        const int c8 = it & 31, row = (it >> 5) & 255, h = it >> 13, p = row >> 7, key = row & 127;
        u32x4 o = (u32x4){0u, 0u, 0u, 0u};
        if ((c8 >> 4) == p) { const float* s = F.peer_sub_keys + (((size_t)(h * 2 + p) * 128 + key) * 128 + (c8 & 15) * 8);
            const f32x4 a = *(const f32x4*)s, b = *(const f32x4*)(s + 4); o.x = pk2(a.x, a.y); o.y = pk2(a.z, a.w); o.z = pk2(b.x, b.y); o.w = pk2(b.z, b.w); }
        *(u32x4*)((bf16*)(ws + WS_KBD) + ((size_t)(h * 256 + row) * 256 + c8 * 8)) = o;
    }
    for (int it = gt; it < 1024; it += NGT) { const float a0 = F.hg_lb[it], a1 = F.hg_lb[1024 + it]; const float m = fmaxf(a0, a1); const float e0 = __expf(a0 - m), e1 = __expf(a1 - m);
        ((float*)(ws + WS_LB))[it] = e0 / (e0 + e1); }
    for (int m = gw; m < BATCH * NMEM; m += NGW) rms_row_to_bf16(F.mem + (size_t)m * 1024, F.mem_norm_g, (bf16*)(ws + WS_MN) + (size_t)m * 1024, F.lane);
    for (int m = gw; m < T_ALL; m += NGW) rms_row_to_bf16(F.x + (size_t)m * 1024, F.norm_mix_g, (bf16*)(ws + WS_XG) + (size_t)m * 1024, F.lane);
}

DI s16x4 tr16(const LAS unsigned char* p) { return __builtin_bit_cast(s16x4, __builtin_amdgcn_ds_read_tr16_b64_v4i16((LAS v4i16_t*)p)); }
DI bf16x8 cat8(s16x4 lo, s16x4 hi) { return __builtin_shufflevector(lo, hi, 0, 1, 2, 3, 4, 5, 6, 7); }
#define MFMA32(a, b, c) __builtin_amdgcn_mfma_f32_32x32x16_bf16((a), (b), (c), 0, 0, 0)
DI int crow(int reg, int h) { return (reg & 3) + 8 * (reg >> 2) + 4 * h; }
DI bf16x8 pack8(const f32x16& x, int s) {
    u32x4 p; p.x = cvtpk(x[8 * s], x[8 * s + 1]); p.y = cvtpk(x[8 * s + 2], x[8 * s + 3]); p.z = cvtpk(x[8 * s + 4], x[8 * s + 5]); p.w = cvtpk(x[8 * s + 6], x[8 * s + 7]);
    return __builtin_bit_cast(bf16x8, p);
}
constexpr int TS = 272;

DI void stage_tile(LAS unsigned char* tile, const bf16* src, int tid) {
#pragma unroll
    for (int i = 0; i < 2; ++i) { const int id = tid + 512 * i, c = id >> 4, ch = id & 15;
        *(LAS u32x4*)(tile + c * TS + ch * 16) = *(const u32x4*)(src + (size_t)c * PC + ch * 8); }
}
DI float touch_tile(const bf16* src, int i128) { return *(const float*)(src + (size_t)(i128 >> 1) * PC + (i128 & 1) * 64); }
DI void gate8(const LAS unsigned char* zt, int dp, int ts, f32x2 lb, f32x2 (&L)[8], f32x2 (&kk)[8], f32x2 (&lf)[8]) {
    f32x2 run = (f32x2){0.f, 0.f}; const f32x2 oml = 1.0f - lb;
#pragma unroll
    for (int i = 0; i < 8; ++i) { const unsigned w = *(const LAS unsigned*)(zt + (8 * ts + i) * TS + 4 * dp);
        const f32x2 sg = (f32x2){fast_sig(bflo(w)), fast_sig(bfhi(w))}; const f32x2 f = lb + oml * sg;
        lf[i] = (f32x2){__builtin_amdgcn_logf(f.x), __builtin_amdgcn_logf(f.y)}; kk[i] = oml * (1.0f - sg); run += lf[i]; L[i] = run; }
}
DI f32x2 exp2x2(f32x2 v) { return (f32x2){__builtin_amdgcn_exp2f(v.x), __builtin_amdgcn_exp2f(v.y)}; }
struct SliceSums { f32x2 offf, offb, glf, glb, greff, grefb; };
DI SliceSums slice_sums(const LAS float* tot, int dp, int ts) {
    SliceSums r; f32x2 tf[8], tb[8];
#pragma unroll
    for (int j = 0; j < 8; ++j) { tf[j] = *(const LAS f32x2*)(tot + j * 128 + 2 * dp); tb[j] = *(const LAS f32x2*)(tot + (8 + j) * 128 + 2 * dp); }
    r.offf = (f32x2){0.f, 0.f}; r.offb = (f32x2){0.f, 0.f};
#pragma unroll
    for (int j = 0; j < 8; ++j) { if (j < ts) r.offf += tf[j]; if (j > ts) r.offb += tb[j]; }
    r.greff = (tf[0] + tf[1]) + (tf[2] + tf[3]); r.glf = r.greff + ((tf[4] + tf[5]) + (tf[6] + tf[7]));
    r.grefb = (tb[4] + tb[5]) + (tb[6] + tb[7]); r.glb = r.grefb + ((tb[0] + tb[1]) + (tb[2] + tb[3]));
    return r;
}

DI void hgrn_a_item(Frame& F, int item, bool has_next) {
    F.refresh();
    constexpr int T_V = 0, T_KF = 17408, T_KB = 34816, TOT = 52224;
    LAS unsigned char* lds = F.lds;
    const int n = item & 31, h = (item >> 5) & 3, b = item >> 7;
    const bf16* proj = (const bf16*)(F.ws + WS_PROJ) + ((size_t)b * SEQ + n * CHUNK) * PC;
    const int tid = F.tid, dp = tid & 63, ts = F.wave;
    const float* lbp = (const float*)(F.ws + WS_LB);
    const f32x2 lbf = *(const f32x2*)(lbp + h * 128 + 2 * dp), lbb = *(const f32x2*)(lbp + 512 + h * 128 + 2 * dp);
    stage_tile(lds + T_V, proj + C_HI + h * 128, tid); stage_tile(lds + T_KF, proj + C_FF + h * 128, tid); stage_tile(lds + T_KB, proj + C_FB + h * 128, tid);
    float tch = 0.f;
    if (has_next) { const bf16* pn = proj + (size_t)CHUNK * PC + h * 128; const int i128 = tid & 127, wsel = tid >> 7; tch = touch_tile(pn + (wsel == 0 ? C_HI : wsel == 1 ? C_FF : C_FB), i128); }
    __syncthreads();
    f32x2 Lf[8], kf[8], lff[8], Lb[8], kb[8], lfb[8];
    gate8(lds + T_KF, dp, ts, lbf, Lf, kf, lff);
    gate8(lds + T_KB, dp, ts, lbb, Lb, kb, lfb);
    LAS float* tot = (LAS float*)(lds + TOT);
    *(LAS f32x2*)(tot + ts * 128 + 2 * dp) = Lf[7]; *(LAS f32x2*)(tot + (8 + ts) * 128 + 2 * dp) = Lb[7];
    asm volatile("" :: "v"(tch));
    __syncthreads();
    const SliceSums ss = slice_sums(tot, dp, ts);
    const f32x2 tbq = Lb[7];
#pragma unroll
    for (int i = 0; i < 8; ++i) { const int c = 8 * ts + i;
        const f32x2 G = ss.offf + Lf[i]; const f32x2 kd = kf[i] * exp2x2(ss.glf - G);
        const f32x2 Gb = ss.offb + (tbq - Lb[i] + lfb[i]); const f32x2 kdb = kb[i] * exp2x2(ss.glb - Gb);
        *(LAS unsigned*)(lds + T_KF + c * TS + 4 * dp) = cvtpk(kd.x, kd.y); *(LAS unsigned*)(lds + T_KB + c * TS + 4 * dp) = cvtpk(kdb.x, kdb.y); }
    if (ts == 0) { float* dec = (float*)(F.ws + WS_DEC) + (size_t)item * 256; *(f32x2*)(dec + 2 * dp) = exp2x2(ss.glf); *(f32x2*)(dec + 128 + 2 * dp) = exp2x2(ss.glb); }
    __syncthreads();
    const int w = F.wave, lane = F.lane, r = lane & 31, hh = lane >> 5, blk = (lane >> 4) & 1, q = (lane & 15) >> 2, p = lane & 3;
    const int dt = w >> 1, et0 = (w & 1) * 2;
#pragma unroll
    for (int dir = 0; dir < 2; ++dir) { const int TK = dir ? T_KB : T_KF;
#pragma unroll
        for (int e2 = 0; e2 < 2; ++e2) { const int et = et0 + e2; f32x16 acc;
#pragma unroll
            for (int i = 0; i < 16; ++i) acc[i] = 0.f;
#pragma unroll
            for (int ks = 0; ks < 4; ++ks) {
                const LAS unsigned char* ap = lds + TK + (16 * ks + 8 * hh + q) * TS + (32 * dt + 16 * blk + 4 * p) * 2;
                const LAS unsigned char* bp = lds + T_V + (16 * ks + 8 * hh + q) * TS + (32 * et + 16 * blk + 4 * p) * 2;
                const bf16x8 a = cat8(tr16(ap), tr16(ap + 4 * TS)), bq = cat8(tr16(bp), tr16(bp + 4 * TS));
                acc = MFMA32(a, bq, acc); }
            bf16* dsb = (bf16*)(F.ws + WS_DS) + ((size_t)(item * 2 + dir) * 128 + 32 * et + r) * 128 + 32 * dt + 4 * hh;
#pragma unroll
            for (int g4 = 0; g4 < 4; ++g4) { u32x2 wv; wv.x = cvtpk(acc[4 * g4], acc[4 * g4 + 1]); wv.y = cvtpk(acc[4 * g4 + 2], acc[4 * g4 + 3]); *(u32x2*)(dsb + 8 * g4) = wv; } } }
    __syncthreads();
}

DI void hgrn_scan(Frame& F) {
    F.refresh();
    const bf16* dS = (const bf16*)(F.ws + WS_DS); bf16* Sst = (bf16*)((unsigned char*)F.out + OUT_SST); const float* dec = (const float*)(F.ws + WS_DEC);
    const int gt = F.vcu * 512 + F.tid, NGT = F.G * 512;
    for (int id = gt; id < BG * 4 * 2 * 128 * 32; id += NGT) {
        const int d4 = id & 31, e = (id >> 5) & 127, dir = (id >> 12) & 1, bh = id >> 13;
        f32x4 S = (f32x4){0.f, 0.f, 0.f, 0.f};
#pragma unroll 4
        for (int s = 0; s < 32; ++s) { const int n = dir ? 31 - s : s, item = bh * 32 + n;
            const size_t off = ((size_t)(item * 2 + dir) * 128 + e) * 128 + d4 * 4;
            u32x2 o; o.x = cvtpk(S.x, S.y); o.y = cvtpk(S.z, S.w); *(u32x2*)(Sst + off) = o;
            const f32x4 dc = *(const f32x4*)(dec + (size_t)(item * 2 + dir) * 128 + d4 * 4);
            const u32x2 wv = *(const u32x2*)(dS + off);
            S.x = dc.x * S.x + bflo(wv.x); S.y = dc.y * S.y + bfhi(wv.x); S.z = dc.z * S.z + bflo(wv.y); S.w = dc.w * S.w + bfhi(wv.y); }
    }
}

DI void hgrn_c_item(Frame& F, int item, bool has_next) {
    F.refresh();
    constexpr int T_QRF = 0, T_KRF = 17408, T_QGF = 34816, T_QRB = 52224, T_KRB = 69632, T_QGB = 87040, T_V = 104448, TOT = 121856, O_OFF = 0, OS = 132;
    LAS unsigned char* lds = F.lds;
    const int n = item & 31, h = (item >> 5) & 3, b = item >> 7;
    const size_t row0 = (size_t)b * SEQ + n * CHUNK;
    const bf16* proj = (const bf16*)(F.ws + WS_PROJ) + row0 * PC;
    const int tid = F.tid, dp = tid & 63, ts = F.wave;
    const float* lbp = (const float*)(F.ws + WS_LB);
    const f32x2 lbf = *(const f32x2*)(lbp + h * 128 + 2 * dp), lbb = *(const f32x2*)(lbp + 512 + h * 128 + 2 * dp);
    stage_tile(lds + T_V, proj + C_HI + h * 128, tid); stage_tile(lds + T_KRF, proj + C_FF + h * 128, tid); stage_tile(lds + T_KRB, proj + C_FB + h * 128, tid); stage_tile(lds + T_QRF, proj + C_HQ + h * 128, tid);
    float tch = 0.f, tch2 = 0.f;
    if (has_next) { const bf16* pn = proj + (size_t)CHUNK * PC + h * 128; const int i128 = tid & 127, wsel = tid >> 7; tch = touch_tile(pn + (wsel == 0 ? C_HI : wsel == 1 ? C_FF : wsel == 2 ? C_FB : C_HQ), i128);
        tch2 = *(const float*)((const unsigned char*)F.out + OUT_SST + (size_t)(item + 1) * 65536 + (size_t)tid * 128); }
    __syncthreads();
    f32x2 qv[8];
#pragma unroll
    for (int i = 0; i < 8; ++i) { const unsigned w = *(const LAS unsigned*)(lds + T_QRF + (8 * ts + i) * TS + 4 * dp); const float z0 = bflo(w), z1 = bfhi(w); qv[i] = (f32x2){z0 * fast_sig(z0), z1 * fast_sig(z1)}; }
    f32x2 Lf[8], kf[8], lff[8], Lb[8], kb[8], lfb[8];
    gate8(lds + T_KRF, dp, ts, lbf, Lf, kf, lff);
    gate8(lds + T_KRB, dp, ts, lbb, Lb, kb, lfb);
    LAS float* tot = (LAS float*)(lds + TOT);
    *(LAS f32x2*)(tot + ts * 128 + 2 * dp) = Lf[7]; *(LAS f32x2*)(tot + (8 + ts) * 128 + 2 * dp) = Lb[7];
    asm volatile("" :: "v"(tch), "v"(tch2));
    __syncthreads();
    {
        const SliceSums ss = slice_sums(tot, dp, ts);
        const f32x2 tbq = Lb[7];
#pragma unroll
        for (int i = 0; i < 8; ++i) { const int c = 8 * ts + i; const int o = c * TS + 4 * dp;
            const f32x2 G = ss.offf + Lf[i]; const f32x2 x = G - ss.greff;
            const f32x2 qr = qv[i] * exp2x2(x), kr = kf[i] * exp2x2(-x), qg = qv[i] * exp2x2(G);
            *(LAS unsigned*)(lds + T_QRF + o) = cvtpk(qr.x, qr.y); *(LAS unsigned*)(lds + T_KRF + o) = cvtpk(kr.x, kr.y); *(LAS unsigned*)(lds + T_QGF + o) = cvtpk(qg.x, qg.y);
            const f32x2 Gb = ss.offb + (tbq - Lb[i] + lfb[i]); const f32x2 xb = Gb - ss.grefb;
            const f32x2 qrb = qv[i] * exp2x2(xb), krb = kb[i] * exp2x2(-xb), qgb = qv[i] * exp2x2(Gb);
            *(LAS unsigned*)(lds + T_QRB + o) = cvtpk(qrb.x, qrb.y); *(LAS unsigned*)(lds + T_KRB + o) = cvtpk(krb.x, krb.y); *(LAS unsigned*)(lds + T_QGB + o) = cvtpk(qgb.x, qgb.y); }
    }
    __syncthreads();
    const int w = F.wave, lane = F.lane, r = lane & 31, hh = lane >> 5, blk = (lane >> 4) & 1, q = (lane & 15) >> 2, p = lane & 3;
    const int ct = w >> 2, et = w & 3;
    const bf16* Sst = (const bf16*)((const unsigned char*)F.out + OUT_SST);
    f32x16 o;
#pragma unroll
    for (int i = 0; i < 16; ++i) o[i] = 0.f;
#pragma unroll
    for (int dir = 0; dir < 2; ++dir) { const int TQR = dir ? T_QRB : T_QRF, TKR = dir ? T_KRB : T_KRF, TQG = dir ? T_QGB : T_QGF;
#pragma unroll
        for (int st = 0; st < 2; ++st) {
            if (dir == 0 ? (st > ct) : (st < ct)) continue;
            f32x16 X;
#pragma unroll
            for (int i = 0; i < 16; ++i) X[i] = 0.f;
#pragma unroll
            for (int ks = 0; ks < 8; ++ks) { const bf16x8 a = *(const LAS bf16x8*)(lds + TKR + (32 * st + r) * TS + (16 * ks + 8 * hh) * 2), bq = *(const LAS bf16x8*)(lds + TQR + (32 * ct + r) * TS + (16 * ks + 8 * hh) * 2);
                X = MFMA32(a, bq, X); }
            const int cc = 32 * ct + r;
#pragma unroll
            for (int i = 0; i < 16; ++i) { const int s = 32 * st + crow(i, hh); const bool keep = dir == 0 ? (s <= cc) : (s >= cc); X[i] = keep ? X[i] : 0.f; }
#pragma unroll
            for (int s2 = 0; s2 < 2; ++s2) { const bf16x8 xs = pack8(X, s2);
                const LAS unsigned char* vp = lds + T_V + (32 * st + 16 * s2 + 4 * hh + q) * TS + (32 * et + 16 * blk + 4 * p) * 2;
                const bf16x8 pb = cat8(tr16(vp), tr16(vp + 8 * TS));
                o = MFMA32(xs, pb, o); }
        }
        const bf16* sp = Sst + ((size_t)(item * 2 + dir) * 128 + 32 * et + r) * 128 + 8 * hh;
#pragma unroll
        for (int ks = 0; ks < 8; ++ks) { const bf16x8 a = *(const LAS bf16x8*)(lds + TQG + (32 * ct + r) * TS + (16 * ks + 8 * hh) * 2); const bf16x8 bq = *(const bf16x8*)(sp + 16 * ks);
            o = MFMA32(a, bq, o); }
    }
    unsigned hw[8];
#pragma unroll
    for (int k = 0; k < 8; ++k) hw[k] = *(const unsigned*)(proj + (size_t)(8 * w + k) * PC + C_HG + h * 128 + 2 * lane);
    __syncthreads();
    LAS float* O = (LAS float*)(lds + O_OFF);
#pragma unroll
    for (int i = 0; i < 16; ++i) O[(32 * ct + crow(i, hh)) * OS + 32 * et + r] = o[i];
    __syncthreads();
    const f32x2 gn = *(const f32x2*)(F.hg_norm_g + h * 128 + 2 * lane);
    bf16* yhg = (bf16*)(F.ws + WS_YHG);
    const int a16 = (lane ^ 16) << 2, a32 = (lane ^ 32) << 2;
#pragma unroll
    for (int k = 0; k < 8; ++k) { const int c = 8 * w + k; const f32x2 v = *(const LAS f32x2*)(O + c * OS + 2 * lane);
        float ss = row_sum16(v.x * v.x + v.y * v.y); ss += bperm_f(a16, ss); ss += bperm_f(a32, ss);
        const float rstd = __builtin_amdgcn_rsqf(ss * (1.0f / 128.0f) + EPS);
        const float z0 = bflo(hw[k]), z1 = bfhi(hw[k]);
        const float y0 = v.x * rstd * gn.x * (z0 * fast_sig(z0)), y1 = v.y * rstd * gn.y * (z1 * fast_sig(z1));
        *(unsigned*)(yhg + (row0 + c) * 512 + h * 128 + 2 * lane) = cvtpk(y0, y1); }
    __syncthreads();
}

DI void attn_item(Frame& F, int g, int item) {
    F.refresh();
    constexpr int KS = 272, VS = 528, K_OFF = 0, V_OFF = 69632;
    LAS unsigned char* lds = F.lds;
    const int qb = item & 7, h = (item >> 3) & 3, b = item >> 5, bglob = g * BG + b;
    const bf16* Km = (const bf16*)(F.ws + WS_KMEM) + (size_t)bglob * 256 * 512 + h * 128;
    const bf16* VT = (const bf16*)(F.ws + WS_VT) + (size_t)(h * 128) * 4096 + bglob * 256;
    const int tid = F.tid;
#pragma unroll
    for (int i = 0; i < 8; ++i) { const int id = tid + 512 * i, key = id >> 4, ch = id & 15;
        *(LAS u32x4*)(lds + K_OFF + key * KS + ch * 16) = *(const u32x4*)(Km + (size_t)key * 512 + ch * 8); }
#pragma unroll
    for (int i = 0; i < 8; ++i) { const int id = tid + 512 * i, e = id >> 5, ch = id & 31;
        *(LAS u32x4*)(lds + V_OFF + e * VS + ch * 16) = *(const u32x4*)(VT + (size_t)e * 4096 + ch * 8); }
    __syncthreads();
    const int w = F.wave, lane = F.lane, r = lane & 31, hh = lane >> 5;
    const size_t qrow0 = (size_t)b * SEQ + qb * 256 + w * 32;
    const bf16* proj = (const bf16*)(F.ws + WS_PROJ);
    bf16x8 qf[8];
#pragma unroll
    for (int ks = 0; ks < 8; ++ks) qf[ks] = *(const bf16x8*)(proj + (qrow0 + r) * PC + C_MQ + h * 128 + 16 * ks + 8 * hh);
    const float scale = 0.08838834764831845f;
    float m_run = -INFINITY, l_run = 0.f;
#pragma unroll 1
    for (int kt = 0; kt < 8; ++kt) {
        f32x16 X;
#pragma unroll
        for (int i = 0; i < 16; ++i) X[i] = 0.f;
#pragma unroll
        for (int ks = 0; ks < 8; ++ks) { const bf16x8 a = *(const LAS bf16x8*)(lds + K_OFF + (32 * kt + r) * KS + (16 * ks + 8 * hh) * 2); X = MFMA32(a, qf[ks], X); }
        float tm = X[0];
#pragma unroll
        for (int i = 1; i < 16; ++i) tm = fmaxf(tm, X[i]);
        tm *= scale;
        const float mn = fmaxf(m_run, tm); float ls = 0.f;
#pragma unroll
        for (int i = 0; i < 16; ++i) ls += __expf(X[i] * scale - mn);
        l_run = l_run * __expf(m_run - mn) + ls; m_run = mn;
    }
    { const float mo = __shfl_xor(m_run, 32), lo = __shfl_xor(l_run, 32); const float m = fmaxf(m_run, mo);
      l_run = l_run * __expf(m_run - m) + lo * __expf(mo - m); m_run = m; }
    const float inv_l = 1.0f / l_run;
    f32x16 O[4];
#pragma unroll
    for (int e = 0; e < 4; ++e)
#pragma unroll
        for (int i = 0; i < 16; ++i) O[e][i] = 0.f;
#pragma unroll 1
    for (int kt = 0; kt < 8; ++kt) {
        f32x16 X;
#pragma unroll
        for (int i = 0; i < 16; ++i) X[i] = 0.f;
#pragma unroll
        for (int ks = 0; ks < 8; ++ks) { const bf16x8 a = *(const LAS bf16x8*)(lds + K_OFF + (32 * kt + r) * KS + (16 * ks + 8 * hh) * 2); X = MFMA32(a, qf[ks], X); }
#pragma unroll
        for (int i = 0; i < 16; ++i) X[i] = __expf(X[i] * scale - m_run) * inv_l;
#pragma unroll
        for (int s2 = 0; s2 < 2; ++s2) { const bf16x8 xs = pack8(X, s2);
#pragma unroll
            for (int e = 0; e < 4; ++e) { const LAS unsigned char* vp = lds + V_OFF + (32 * e + r) * VS + (32 * kt + 16 * s2 + 4 * hh) * 2;
                const bf16x8 pb = cat8(*(const LAS s16x4*)vp, *(const LAS s16x4*)(vp + 16));
                O[e] = MFMA32(xs, pb, O[e]); } }
    }
    bf16* ymx = (bf16*)(F.ws + WS_YMX);
#pragma unroll
    for (int e = 0; e < 4; ++e)
#pragma unroll
        for (int i = 0; i < 16; ++i) ymx[(qrow0 + crow(i, hh)) * 512 + h * 128 + 32 * e + r] = (bf16)f2bf(O[e][i]);
    __syncthreads();
}

DI void conv_phase(Frame& F) {
    F.refresh();
    const bf16* proj = (const bf16*)(F.ws + WS_PROJ); bf16* ysc = (bf16*)(F.ws + WS_YSC); const float* cw = F.sc_conv_w;
    const int gt = F.vcu * 512 + F.tid, NGT = F.G * 512;
    for (int id = gt; id < TG * 64; id += NGT) {
        const int c8 = id & 63, t = id >> 6, ts = t & (SEQ - 1);
        const bf16* pr = proj + (size_t)t * PC + c8 * 8;
        const u32x4 z4 = (u32x4){0u, 0u, 0u, 0u};
        const u32x4 sb = *(const u32x4*)(pr + C_SB), c1 = *(const u32x4*)(pr + C_SC), h1 = *(const u32x4*)(pr + C_SH);
        const u32x4 c0 = ts > 0 ? *(const u32x4*)(pr - PC + C_SC) : z4, h0 = ts > 0 ? *(const u32x4*)(pr - PC + C_SH) : z4;
        const u32x4 c2 = ts < SEQ - 1 ? *(const u32x4*)(pr + PC + C_SC) : z4, h2 = ts < SEQ - 1 ? *(const u32x4*)(pr + PC + C_SH) : z4;
        const f32x4 wa0 = *(const f32x4*)(cw + c8 * 8), wa1 = *(const f32x4*)(cw + c8 * 8 + 4), wb0 = *(const f32x4*)(cw + 512 + c8 * 8), wb1 = *(const f32x4*)(cw + 512 + c8 * 8 + 4),
                    wc0 = *(const f32x4*)(cw + 1024 + c8 * 8), wc1 = *(const f32x4*)(cw + 1024 + c8 * 8 + 4);
        float y[8];
#pragma unroll
        for (int k = 0; k < 4; ++k) {
            const float w0l = k < 2 ? wa0[2 * k] : wa1[2 * k - 4], w0h = k < 2 ? wa0[2 * k + 1] : wa1[2 * k - 3];
            const float w1l = k < 2 ? wb0[2 * k] : wb1[2 * k - 4], w1h = k < 2 ? wb0[2 * k + 1] : wb1[2 * k - 3];
            const float w2l = k < 2 ? wc0[2 * k] : wc1[2 * k - 4], w2h = k < 2 ? wc0[2 * k + 1] : wc1[2 * k - 3];
            y[2 * k]     = bflo(sb[k]) * (w0l * (bflo(c0[k]) * bflo(h0[k])) + w1l * (bflo(c1[k]) * bflo(h1[k])) + w2l * (bflo(c2[k]) * bflo(h2[k])));
            y[2 * k + 1] = bfhi(sb[k]) * (w0h * (bfhi(c0[k]) * bfhi(h0[k])) + w1h * (bfhi(c1[k]) * bfhi(h1[k])) + w2h * (bfhi(c2[k]) * bfhi(h2[k]))); }
        u32x4 o; o.x = cvtpk(y[0], y[1]); o.y = cvtpk(y[2], y[3]); o.z = cvtpk(y[4], y[5]); o.w = cvtpk(y[6], y[7]);
        *(u32x4*)(ysc + (size_t)t * 512 + c8 * 8) = o;
    }
}

DI unsigned ord_key(float v, int idx) { unsigned u = __builtin_bit_cast(unsigned, v); u ^= (u >> 31) ? 0xFFFFFFFFu : 0x80000000u; return (u & 0xFFFFFF80u) | (unsigned)(127 - idx); }
DI float key_val(unsigned k) { unsigned u = k & 0xFFFFFF80u; u = (u & 0x80000000u) ? (u ^ 0x80000000u) : ~u; return __builtin_bit_cast(float, u); }
DI float dot2bf(unsigned a, unsigned b, float c) { return __builtin_amdgcn_fdot2_f32_bf16(__builtin_bit_cast(bf16x2_t, a), __builtin_bit_cast(bf16x2_t, b), c, false); }
DI float dot8(const u32x4& a, const u32x4& b, float c) { c = dot2bf(a.x, b.x, c); c = dot2bf(a.y, b.y, c); c = dot2bf(a.z, b.z, c); return dot2bf(a.w, b.w, c); }
__host__ __device__ constexpr int cand_off(int i) { return i == 0 ? 0 : i == 1 ? 16 : i == 2 ? 24 : i == 3 ? 29 : i == 4 ? 33 : i == 5 ? 36 : i == 6 ? 38 : i == 7 ? 40 : 34 + i; }
__host__ __device__ constexpr int cand_i(int c) { return c < 16 ? 0 : c < 24 ? 1 : c < 29 ? 2 : c < 33 ? 3 : c < 36 ? 4 : c < 38 ? 5 : c < 40 ? 6 : c < 42 ? 7 : c - 34; }
__host__ __device__ constexpr int cand_pos(int c) { return cand_i(c) * 16 + (c - cand_off(cand_i(c))); }

#define PEER_CE(i, j) do { const unsigned hi_ = max(k[i], k[j]), lo_ = min(k[i], k[j]); k[i] = hi_; k[j] = lo_; } while (0)
DI void peer_topk_first(const float* srow, LAS float* ssc, LAS int* six, int lane) {
    const int gq = lane >> 4, li = lane & 15;
    const float* sl = srow + (gq >> 1) * 256 + (gq & 1) * 128 + li * 8;
    f32x4 nva = *(const f32x4*)sl, nvb = *(const f32x4*)(sl + 4);
#pragma unroll 1
    for (int hp = 0; hp < 4; ++hp) {
        const f32x4 va = nva, vb = nvb;
        if (hp < 3) { nva = *(const f32x4*)(sl + 512 * (hp + 1)); nvb = *(const f32x4*)(sl + 512 * (hp + 1) + 4); }
        unsigned k[8];
        k[0] = ord_key(va.x, li * 8 + 0); k[1] = ord_key(va.y, li * 8 + 1); k[2] = ord_key(va.z, li * 8 + 2); k[3] = ord_key(va.w, li * 8 + 3);
        k[4] = ord_key(vb.x, li * 8 + 4); k[5] = ord_key(vb.y, li * 8 + 5); k[6] = ord_key(vb.z, li * 8 + 6); k[7] = ord_key(vb.w, li * 8 + 7);
        PEER_CE(0, 1); PEER_CE(2, 3); PEER_CE(4, 5); PEER_CE(6, 7); PEER_CE(0, 2); PEER_CE(1, 3); PEER_CE(4, 6); PEER_CE(5, 7); PEER_CE(1, 2); PEER_CE(5, 6);
        PEER_CE(0, 4); PEER_CE(1, 5); PEER_CE(2, 6); PEER_CE(3, 7); PEER_CE(2, 4); PEER_CE(3, 5); PEER_CE(1, 2); PEER_CE(3, 4); PEER_CE(5, 6);
        unsigned mine = 0u;
#pragma unroll
        for (int rd = 0; rd < 16; ++rd) {
            const unsigned m = row_max16(k[0]);
            mine = (li == rd) ? m : mine;
            const bool wn = (k[0] == m);
            k[0] = wn ? k[1] : k[0]; k[1] = wn ? k[2] : k[1]; k[2] = wn ? k[3] : k[2]; k[3] = wn ? k[4] : k[3];
            k[4] = wn ? k[5] : k[4]; k[5] = wn ? k[6] : k[5]; k[6] = wn ? k[7] : k[6]; k[7] = wn ? 0u : k[7];
        }
        const int o = ((2 * hp + (gq >> 1)) * 2 + (gq & 1)) * 16 + li;
        ssc[o] = key_val(mine); six[o] = 127 - (int)(mine & 127u);
    }
}
DI void peer_topk_second(const LAS float* ssc, const LAS int* six, LAS int* widx, LAS float* wgate, int lane, int emask, int hd_lo, int hd_hi) {
    const int ci = cand_i(lane), cj = lane - cand_off(ci); const bool cvalid = lane < 50;
    const int a16 = (lane ^ 16) << 2, a32 = (lane ^ 32) << 2;
#pragma unroll 2
    for (int hd = hd_lo; hd < hd_hi; ++hd) {
        const float a = ssc[(hd * 2) * 16 + ci], bq = ssc[(hd * 2 + 1) * 16 + cj];
        const int ia = six[(hd * 2) * 16 + ci], ib = six[(hd * 2 + 1) * 16 + cj];
        const float cs = a + bq;
        unsigned ck = __builtin_bit_cast(unsigned, cs); ck ^= (ck >> 31) ? 0xFFFFFFFFu : 0x80000000u; ck = cvalid ? ((ck & ~63u) | (unsigned)(63 - lane)) : 0u;
        int rank = 0;
#pragma unroll
        for (int c2 = 0; c2 < 50; ++c2) { const unsigned k2 = (unsigned)__builtin_amdgcn_readlane((int)ck, c2); rank += (int)(k2 > ck); }
        const bool sel = cvalid && rank < 16;
        const float mx = __builtin_bit_cast(float, __builtin_amdgcn_readlane(__builtin_bit_cast(int, cs), 0));
        const float ev = sel ? __builtin_amdgcn_exp2f((cs - mx) * 1.4426950408889634f) : 0.f;
        float sum = row_sum16(ev); sum += bperm_f(a16, sum); sum += bperm_f(a32, sum);
        if (sel) { widx[hd * 16 + rank] = ((ia * 128 + ib) & emask) * 512  ; wgate[hd * 16 + rank] = ev * __builtin_amdgcn_rcpf(sum); }
    }
}
#undef PEER_CE

constexpr float PEER_QSTEP = 0.35f;
constexpr float PEER_U_SCALE = 32.0f / PEER_QSTEP;
constexpr float PEER_UF4_SCALE = 64.0f;
constexpr float PEER_H4_SCALE = 2.0f;
#ifndef PROBE_SKIP
#define PROBE_SKIP 0
#endif
#define PSKIP(b) ((PROBE_SKIP >> (b)) & 1 && dry)
#ifndef PROBE_NODMA
#define PROBE_NODMA 0
#endif
#ifndef PROBE_EMASK
#define PROBE_EMASK 16383
#endif
#ifndef PEER_VARIANT
#define PEER_VARIANT 0
#endif
#ifndef PEER_R
#define PEER_R 16
#endif
#if PEER_R == 32
#define PEER_RM4 28
#elif PEER_R == 16
#define PEER_RM4 12
#elif PEER_R == 64
#define PEER_RM4 60
#endif
constexpr int PEER_NPROD = 2, PEER_NCONS = 8 - PEER_NPROD, PEER_CPP = PEER_NCONS / PEER_NPROD;
constexpr int PEER_NQ = 2 * PEER_NCONS;
#ifndef PEER_HP
#define PEER_HP 5
#endif
constexpr int PEER_SLOT_BYTES = 3072;
constexpr int PEER_FLAG_OFF = PEER_NQ * PEER_SLOT_BYTES, PEER_PRIV_OFF = PEER_FLAG_OFF + 64, PEER_PRIV_BYTES = 2560, PEER_RING_OFF = 53248;
static_assert(PEER_PRIV_OFF + PEER_NCONS * PEER_PRIV_BYTES <= PEER_RING_OFF && PEER_RING_OFF + PEER_NCONS * PEER_R * 1024 <= MISC_OFF && PEER_R <= 64 && (PEER_R & (PEER_R - 1)) == 0 && PEER_NCONS % PEER_NPROD == 0, "PEER LDS map");
DI void glds16(const void* gsrc, unsigned lds_dst) { unsigned keep;
    asm volatile("s_mov_b32 %0, m0\n\ts_mov_b32 m0, %2\n\ts_nop 0\n\tglobal_load_lds_dwordx4 %1, off\n\ts_mov_b32 m0, %0" : "=&s"(keep) : "v"(gsrc), "s"(lds_dst) : "memory"); }
DI void glds16s(const void* sbase, unsigned voff, unsigned lds_dst) { unsigned keep;
    asm volatile("s_mov_b32 %0, m0\n\ts_mov_b32 m0, %3\n\ts_nop 0\n\tglobal_load_lds_dwordx4 %1, %2\n\ts_mov_b32 m0, %0" : "=&s"(keep) : "v"(voff), "s"(sbase), "s"(lds_dst) : "memory"); }
DI void glds16s_x4(const void* sbase, unsigned v0, unsigned v1, unsigned v2, unsigned v3, unsigned lds_dst) { unsigned keep;
    asm volatile("s_mov_b32 %0, m0\n\ts_mov_b32 m0, %6\n\ts_nop 0\n\tglobal_load_lds_dwordx4 %1, %5\n\tglobal_load_lds_dwordx4 %2, %5 offset:1024\n\tglobal_load_lds_dwordx4 %3, %5 offset:2048\n\tglobal_load_lds_dwordx4 %4, %5 offset:3072\n\ts_mov_b32 m0, %0"
                 : "=&s"(keep) : "v"(v0), "v"(v1), "v"(v2), "v"(v3), "s"(sbase), "s"(lds_dst) : "memory"); }
#define PEER_STR2(x) #x
#define PEER_STR(x) PEER_STR2(x)
typedef int i32x4 __attribute__((ext_vector_type(4)));
typedef int i32x8 __attribute__((ext_vector_type(8)));
DI void peer_phase(Frame& F, int tg, bool dry) {
    F.refresh();
    __syncthreads();
    const int lane = F.lane, wv = F.wave;
    volatile LAS unsigned* flags = (volatile LAS unsigned*)(F.lds + PEER_FLAG_OFF);
    if (F.tid <= PEER_NQ) flags[F.tid] = 0u;
    __syncthreads();
    const int NPG = F.G * PEER_NPROD;
    if (wv < PEER_NPROD) {
        const int pg = F.vcu * PEER_NPROD + wv;
        int i = 0;
        for (int tl = pg; tl < TG; tl += NPG, ++i) {
            float tch0 = 0.f;
            if (tl + NPG < TG) tch0 = ((const float*)(F.ws + WS_S) + (size_t)(tl + NPG) * 2048)[lane * 32];
            const int q = PEER_NPROD * i + wv, slot = q % PEER_NQ;
            LAS float* ssc = (LAS float*)(F.lds + slot * PEER_SLOT_BYTES); LAS int* six = (LAS int*)(F.lds + slot * PEER_SLOT_BYTES + 1024);
            while (flags[slot] != 0u) __builtin_amdgcn_s_sleep(2);
            asm volatile("" ::: "memory");
            if (!PSKIP(0)) peer_topk_first((const float*)(F.ws + WS_S) + (size_t)tl * 2048, ssc, six, lane);
            if (PEER_HP > 0 && !PSKIP(1)) peer_topk_second(ssc, six, (LAS int*)(F.lds + slot * PEER_SLOT_BYTES + 2048), (LAS float*)(F.lds + slot * PEER_SLOT_BYTES + 2560), lane, dry ? PROBE_EMASK : 16383, 0, PEER_HP);
            asm volatile("s_waitcnt lgkmcnt(0)" :: "v"(tch0) : "memory");
            if (lane == 0) flags[slot] = (unsigned)q + 1u;
        }
    } else {
        const unsigned char* Ub = F.ws + WS_U; const unsigned char* Vb = F.ws + WS_V; const unsigned lo16 = 16u * (unsigned)(lane & 31);
        const int a16 = (lane ^ 16) << 2, a32 = (lane ^ 32) << 2; const int grp = lane >> 4;
        const int cidx = wv - PEER_NPROD;
        LAS int* sidx = (LAS int*)(F.lds + PEER_PRIV_OFF + cidx * PEER_PRIV_BYTES); LAS float* sgate = (LAS float*)(F.lds + PEER_PRIV_OFF + cidx * PEER_PRIV_BYTES + 512);
        LAS unsigned char* ring = F.lds + PEER_RING_OFF + cidx * (PEER_R * 1024);
        const unsigned ringb = (unsigned)(uintptr_t)ring;
        LAS unsigned char* hrow = F.lds + PEER_PRIV_OFF + cidx * PEER_PRIV_BYTES + 1536;
        unsigned usw[4];
#pragma unroll
        for (int q = 0; q < 4; ++q) usw[q] = 16u * (unsigned)((lane & 31) ^ (2 * q + (lane >> 5))) + (4096u - 1024u * q);
        const LAS unsigned char* uadr[4];
#pragma unroll
        for (int j = 0; j < 4; ++j) uadr[j] = ring + (lane & 15) * 512 + 64 * (j ^ ((lane & 15) >> 2)) + 16 * (grp ^ (lane & 3));
        const int NQTOK = PEER_NPROD * (TG / NPG);
        for (;;) {
            int q = 0;
            if (lane == 0) q = (int)__hip_atomic_fetch_add((LAS unsigned*)(F.lds + PEER_FLAG_OFF) + PEER_NQ, 1u, __ATOMIC_RELAXED, __HIP_MEMORY_SCOPE_WORKGROUP);
            q = __builtin_amdgcn_readfirstlane(q);
            if (q >= NQTOK) break;
            const int tl = F.vcu * PEER_NPROD + (q % PEER_NPROD) + (q / PEER_NPROD) * NPG;
            const size_t t = (size_t)tg * TG + tl;
            float tch1 = 0.f, tch2 = 0.f, tch3 = 0.f;
            if (q + PEER_NCONS < NQTOK) { const int qn = q + PEER_NCONS; const size_t tn = (size_t)tg * TG + F.vcu * PEER_NPROD + (qn % PEER_NPROD) + (qn / PEER_NPROD) * NPG; tch1 = (F.out + tn * 1024)[(lane & 31) * 32];
                tch2 = ((const float*)((const bf16*)(F.ws + WS_XG) + tn * 1024))[(lane & 15) * 32]; tch3 = ((const float*)(F.ws + WS_SSP) + tn * 16)[lane & 15]; }
            const f32x4* sp = (const f32x4*)((const float*)(F.ws + WS_SSP) + t * 16);
            const f32x4 s0 = sp[0], s1 = sp[1], s2 = sp[2], s3 = sp[3];
            const float ssx = ((s0[0] + s0[1]) + (s0[2] + s0[3])) + ((s1[0] + s1[1]) + (s1[2] + s1[3])) + ((s2[0] + s2[1]) + (s2[2] + s2[3])) + ((s3[0] + s3[1]) + (s3[2] + s3[3]));
            const float hs = __builtin_amdgcn_rsqf(ssx * (1.0f / 1024.0f) + EPS) * PEER_H4_SCALE;
            { const bf16* xr = (const bf16*)(F.ws + WS_XG) + t * 1024 + 16 * lane; const u32x4 w0 = *(const u32x4*)xr, w1 = *(const u32x4*)(xr + 8);
              u32x2 hq;
              hq.x = __builtin_amdgcn_cvt_scalef32_pk_fp4_f32(0u, bflo(w0[0]) * hs, bfhi(w0[0]) * hs, 1.0f, 0); hq.x = __builtin_amdgcn_cvt_scalef32_pk_fp4_f32(hq.x, bflo(w0[1]) * hs, bfhi(w0[1]) * hs, 1.0f, 1);
              hq.x = __builtin_amdgcn_cvt_scalef32_pk_fp4_f32(hq.x, bflo(w0[2]) * hs, bfhi(w0[2]) * hs, 1.0f, 2); hq.x = __builtin_amdgcn_cvt_scalef32_pk_fp4_f32(hq.x, bflo(w0[3]) * hs, bfhi(w0[3]) * hs, 1.0f, 3);
              hq.y = __builtin_amdgcn_cvt_scalef32_pk_fp4_f32(0u, bflo(w1[0]) * hs, bfhi(w1[0]) * hs, 1.0f, 0); hq.y = __builtin_amdgcn_cvt_scalef32_pk_fp4_f32(hq.y, bflo(w1[1]) * hs, bfhi(w1[1]) * hs, 1.0f, 1);
              hq.y = __builtin_amdgcn_cvt_scalef32_pk_fp4_f32(hq.y, bflo(w1[2]) * hs, bfhi(w1[2]) * hs, 1.0f, 2); hq.y = __builtin_amdgcn_cvt_scalef32_pk_fp4_f32(hq.y, bflo(w1[3]) * hs, bfhi(w1[3]) * hs, 1.0f, 3);
              *(LAS u32x2*)(hrow + 8 * lane) = hq; }
            const float ascale = 1.0f / (PEER_H4_SCALE * PEER_UF4_SCALE);
            const int slot = q % PEER_NQ;
            while (flags[slot] != (unsigned)q + 1u) __builtin_amdgcn_s_sleep(2);
            asm volatile("" ::: "memory");
            if (PEER_HP > 0) { if (lane < 16 * PEER_HP) { sidx[lane] = ((const LAS int*)(F.lds + slot * PEER_SLOT_BYTES + 2048))[lane]; sgate[lane] = ((const LAS float*)(F.lds + slot * PEER_SLOT_BYTES + 2560))[lane]; }
                if (PEER_HP > 4 && lane < 16 * PEER_HP - 64) { sidx[64 + lane] = ((const LAS int*)(F.lds + slot * PEER_SLOT_BYTES + 2048))[64 + lane]; sgate[64 + lane] = ((const LAS float*)(F.lds + slot * PEER_SLOT_BYTES + 2560))[64 + lane]; } }
            if (PEER_HP < 8 && !PSKIP(1)) peer_topk_second((const LAS float*)(F.lds + slot * PEER_SLOT_BYTES), (const LAS int*)(F.lds + slot * PEER_SLOT_BYTES + 1024), sidx, sgate, lane, dry ? PROBE_EMASK : 16383, PEER_HP, 8);
            asm volatile("s_waitcnt lgkmcnt(0)" ::: "memory");
            if (lane == 0) flags[slot] = 0u;
#define PEER_ISSUE4V(pp0) do { if (PROBE_NODMA && dry) break; const int pp_ = (pp0); const LAS int* ip_ = sidx + 2 * (pp_ & 63) + (lane >> 5); \
                const unsigned v0_ = (unsigned)ip_[0] + lo16 + 4096u, v1_ = (unsigned)ip_[2] + lo16 + 3072u, v2_ = (unsigned)ip_[4] + lo16 + 2048u, v3_ = (unsigned)ip_[6] + lo16 + 1024u; \
                glds16s_x4(Vb - 4096, v0_, v1_, v2_, v3_, (unsigned)__builtin_amdgcn_readfirstlane((int)(ringb + (unsigned)(pp_ & (PEER_R - 1)) * 1024u))); } while (0)
#define PEER_ISSUE4U(pp0, hi8) do { if (PROBE_NODMA && dry) break; const int pp_ = (pp0); const LAS int* ip_ = sidx + 2 * pp_ + (lane >> 5); \
                const unsigned v0_ = (unsigned)ip_[0] + (usw[0] ^ (hi8)), v1_ = (unsigned)ip_[2] + (usw[1] ^ (hi8)), v2_ = (unsigned)ip_[4] + (usw[2] ^ (hi8)), v3_ = (unsigned)ip_[6] + (usw[3] ^ (hi8)); \
                glds16s_x4(Ub - 4096, v0_, v1_, v2_, v3_, (unsigned)__builtin_amdgcn_readfirstlane((int)(ringb + (unsigned)(pp_ & (PEER_R - 1)) * 1024u))); } while (0)
            PEER_ISSUE4U(0, 0u); PEER_ISSUE4U(4, 128u); PEER_ISSUE4U(8, 0u); PEER_ISSUE4U(12, 128u);
            i32x4 hA[8];
#pragma unroll
            for (int ks = 0; ks < 8; ++ks) hA[ks] = *(const LAS i32x4*)(hrow + 64 * ks + 16 * grp);
            float dotA = 0.f, dotB = 0.f;
#pragma unroll 1
            for (int tp = PSKIP(2) ? 4 : 0; tp < 4; ++tp) {
#pragma unroll
                for (int par = 0; par < 2; ++par) { const int tt = 2 * tp + par;
                    asm volatile("s_waitcnt vmcnt(8)" ::: "memory");
                    f32x4 acc = {0.f, 0.f, 0.f, 0.f};
#pragma unroll
                    for (int ks = 0; ks < 8; ++ks) { const i32x4 b_ = *(const LAS i32x4*)(uadr[ks & 3] + 256 * (ks >> 2) + 8192 * par);
                        const i32x8 b8_ = {b_.x, b_.y, b_.z, b_.w, 0, 0, 0, 0};
                        const i32x8 a8_ = {hA[ks].x, hA[ks].y, hA[ks].z, hA[ks].w, 0, 0, 0, 0};
                        acc = __builtin_amdgcn_mfma_scale_f32_16x16x128_f8f6f4(a8_, b8_, acc, 4  , 4  , 0, 127, 0, 127); }
                    dotA = (tt == grp) ? acc[0] : dotA; dotB = (tt == grp + 4) ? acc[0] : dotB;
                    __builtin_amdgcn_sched_barrier(0);
                    if (tp < 3) { PEER_ISSUE4U(8 * tt + 16, 0u); PEER_ISSUE4U(8 * tt + 20, 128u); } else { PEER_ISSUE4V(64 + 8 * par); PEER_ISSUE4V(64 + 8 * par + 4); }
                    __builtin_amdgcn_sched_barrier(0); }
            }
            unsigned loA, hiA, loB, hiB; float bscA, bscB;
            { const float av = dotA * ascale, bv = dotB * ascale;
              const float cA = sgate[lane] * (0.5f * av * (1.0f + erff(av * 0.70710678118654752f))), cB = sgate[64 + lane] * (0.5f * bv * (1.0f + erff(bv * 0.70710678118654752f)));
              const float mxA = __builtin_bit_cast(float, row_max16(__builtin_bit_cast(unsigned, fabsf(cA)))), mxB = __builtin_bit_cast(float, row_max16(__builtin_bit_cast(unsigned, fabsf(cB))));
              const float qsA = mxA > 0.f ? 7.0f * __builtin_amdgcn_rcpf(mxA) : 0.f, qsB = mxB > 0.f ? 7.0f * __builtin_amdgcn_rcpf(mxB) : 0.f;
              const unsigned cqA = ((unsigned)(int)__builtin_rintf(cA * qsA) & 15u) << (4 * (lane & 7)), cqB = ((unsigned)(int)__builtin_rintf(cB * qsB) & 15u) << (4 * (lane & 7));
              loA = (lane & 8) ? 0u : cqA; hiA = (lane & 8) ? cqA : 0u; loB = (lane & 8) ? 0u : cqB; hiB = (lane & 8) ? cqB : 0u;
              loA |= dpp_u<0xB1>(loA); loA |= dpp_u<0x4E>(loA); loA |= dpp_u<0x141>(loA); loA |= dpp_u<0x140>(loA);
              hiA |= dpp_u<0xB1>(hiA); hiA |= dpp_u<0x4E>(hiA); hiA |= dpp_u<0x141>(hiA); hiA |= dpp_u<0x140>(hiA);
              loB |= dpp_u<0xB1>(loB); loB |= dpp_u<0x4E>(loB); loB |= dpp_u<0x141>(loB); loB |= dpp_u<0x140>(loB);
              hiB |= dpp_u<0xB1>(hiB); hiB |= dpp_u<0x4E>(hiB); hiB |= dpp_u<0x141>(hiB); hiB |= dpp_u<0x140>(hiB);
              bscA = mxA * (1.0f / 7.0f); bscB = mxB * (1.0f / 7.0f); }
            float* xo = F.out + t * 1024 + lane;
            float* xst = dry ? (float*)(F.ws + WS_PROJ + (128u << 20)) + (size_t)tl * 1024 + lane : xo;
            float xa[16];
#pragma unroll
            for (int cb = 0; cb < 16; ++cb) xa[cb] = xo[64 * cb];
            float oacc[16];
#pragma unroll
            for (int cb = 0; cb < 16; ++cb) oacc[cb] = 0.f;
            typedef int i32x2 __attribute__((ext_vector_type(2)));
#pragma unroll 1
            for (int vb = PSKIP(3) ? 8 : 0; vb < 8; ++vb) {
                if (vb < 7) asm volatile("s_waitcnt vmcnt(8)" ::: "memory"); else asm volatile("s_waitcnt vmcnt(0)" ::: "memory");
                const int sl_ = 16 * (vb & 3);
                const int clo = __builtin_amdgcn_readlane((int)(vb < 4 ? loA : loB), sl_), chi = __builtin_amdgcn_readlane((int)(vb < 4 ? hiA : hiB), sl_);
                const float bsc = __builtin_bit_cast(float, __builtin_amdgcn_readlane(__builtin_bit_cast(int, vb < 4 ? bscA : bscB), sl_));
                const LAS unsigned char* rowp = ring + (16 * (vb & 1) + (lane & 15)) * 512 + 8 * (lane >> 4);
#pragma unroll
                for (int cb = 0; cb < 16; ++cb) {
                    const i32x2 tr = __builtin_amdgcn_ds_read_tr4_b64_v2i32((LAS i32x2*)(rowp + 32 * cb));
                    const int ai = __builtin_amdgcn_sdot8(chi, tr.y, __builtin_amdgcn_sdot8(clo, tr.x, 0, false), false);
                    oacc[cb] += (float)ai * bsc;
                }
                if (vb < 6) { PEER_ISSUE4V(64 + 8 * vb + 16); PEER_ISSUE4V(64 + 8 * vb + 20); }
            }
#undef PEER_ISSUE4U
#undef PEER_ISSUE4V
            const float* gfp = F.final_norm_g + lane;
            float ss = 0.f;
#pragma unroll
            for (int cb = 0; cb < 16; ++cb) { xa[cb] = xa[cb] + oacc[cb] * (1.0f / PEER_U_SCALE); ss += xa[cb] * xa[cb]; }
            ss = row_sum16(ss); ss += bperm_f(a16, ss); ss += bperm_f(a32, ss);
            const float rf = __builtin_amdgcn_rsqf(ss * (1.0f / 1024.0f) + EPS);
#pragma unroll
            for (int cb = 0; cb < 16; ++cb) xst[64 * cb] = xa[cb] * rf * gfp[64 * cb];
            asm volatile("" :: "v"(tch1), "v"(tch2), "v"(tch3));
        }
    }
}

DI void convert_uv(Frame& F, int part, int nparts, int cu, int ncu) {
    F.refresh();
    const int gt = cu * 512 + F.tid, NGT = ncu * 512, per = (2 * 16384 * 64) / nparts;
    for (int id = part * per + gt; id < (part + 1) * per; id += NGT) {
        const int which = id >> 20, off = (id & ((1 << 20) - 1)) * 16;
        const float* src = (which ? F.peer_v : F.peer_u) + off; unsigned char* dst = F.ws + (which ? WS_V : WS_U) + off / 2;
        u32x2 o;
        if (which == 0) {
#pragma unroll
            for (int q = 0; q < 2; ++q) { const f32x4 v0 = *(const f32x4*)(src + 8 * q) * PEER_UF4_SCALE, v1 = *(const f32x4*)(src + 8 * q + 4) * PEER_UF4_SCALE;
                unsigned pk = __builtin_amdgcn_cvt_scalef32_pk_fp4_f32(0u, v0.x, v0.y, 1.0f, 0); pk = __builtin_amdgcn_cvt_scalef32_pk_fp4_f32(pk, v0.z, v0.w, 1.0f, 1);
                pk = __builtin_amdgcn_cvt_scalef32_pk_fp4_f32(pk, v1.x, v1.y, 1.0f, 2); pk = __builtin_amdgcn_cvt_scalef32_pk_fp4_f32(pk, v1.z, v1.w, 1.0f, 3); o[q] = pk; }
        } else {
#pragma unroll
            for (int q = 0; q < 2; ++q) { const f32x4 v0 = *(const f32x4*)(src + 8 * q) * PEER_U_SCALE, v1 = *(const f32x4*)(src + 8 * q + 4) * PEER_U_SCALE; unsigned pk = 0u;
#pragma unroll
                for (int k = 0; k < 4; ++k) { pk |= ((unsigned)(int)__builtin_rintf(fminf(fmaxf(v0[k], -7.f), 7.f)) & 15u) << (4 * k); pk |= ((unsigned)(int)__builtin_rintf(fminf(fmaxf(v1[k], -7.f), 7.f)) & 15u) << (16 + 4 * k); }
                o[q] = pk; }
        }
        *(u32x2*)dst = o;
    }
}

constexpr int N_PHASES = 19;
struct Args { const float* in[17]; float* out; unsigned char* ws; int ph_lo, ph_hi; };

__global__ void __launch_bounds__(NWAVES * 64, 2) fwd_kernel(Args args) {
    extern __shared__ __attribute__((aligned(16))) unsigned char lds_raw[];
    Frame F;
    F.lds = (LAS unsigned char*)lds_raw;
    F.tid = threadIdx.x; F.lane = F.tid & 63; F.wave = __builtin_amdgcn_readfirstlane(F.tid >> 6);
    F.G = gridDim.x; { const int bx = blockIdx.x; F.vcu = (F.G % 8 == 0) ? (bx % 8) * (F.G / 8) + bx / 8 : bx; }
    F.x = args.in[0]; F.mem = args.in[1]; F.norm_mix_g = args.in[2]; F.w_in = args.in[3]; F.hg_lb = args.in[4]; F.hg_norm_g = args.in[5]; F.sc_conv_w = args.in[6];
    F.mem_norm_g = args.in[7]; F.w_mem_kv = args.in[8]; F.w_branch = args.in[9]; F.w_out = args.in[10]; F.norm_ffn_g = args.in[11]; F.peer_w_q = args.in[12];
    F.peer_sub_keys = args.in[13]; F.peer_u = args.in[14]; F.peer_v = args.in[15]; F.final_norm_g = args.in[16];
    F.out = args.out; F.ws = args.ws;
    volatile LAS unsigned* MISC = (volatile LAS unsigned*)(F.lds + MISC_OFF);
    for (int u = F.tid; u < (LDS_BYTES - MISC_OFF) / 4; u += NWAVES * 64) MISC[u] = 0u;
    __syncthreads();
    unsigned* barw = (unsigned*)(F.ws + WS_CTL) + CW_BAR;
    XcdBarrier bar; bar.bar = barw; bar.x = 0; bar.st = nullptr;
    const bool one_launch = (args.ph_hi - args.ph_lo) > 1;
    if (one_launch) bar = xcd_barrier_post(barw, MISC + 8);
    const int lo = args.ph_lo, hi = args.ph_hi;
#define IN(k) (lo <= (k) && (k) < hi)
#ifndef PMASK
#define PMASK 0x3ff
#endif
#define PC_(c) ((PMASK >> (c)) & 1)
#ifndef REP_MASK
#define REP_MASK 0
#endif
#define REPS(c) for (int rep_ = 0; rep_ < 1 + 2 * ((REP_MASK >> (c)) & 1); ++rep_)
#define SEAM(k) do { if (IN(k) && IN((k) + 1)) xcd_barrier(bar); } while (0)
    unsigned char* ws = F.ws;
    const int G = F.G, cid = (int)blockIdx.x;

    if (PC_(0) && IN(0)) { REPS(0) p0_prologue(F); } SEAM(0);

#pragma unroll 1
    for (int g = 0; g < NGRP; ++g) {
        const int pb = 1 + 6 * g;
        if (PC_(1) && IN(pb)) REPS(1) {
            pg8::InOrder S; S.init(TG, PC, G, cid); S.H = (const char*)(ws + WS_XG) + (size_t)g * TG * 1024 * 2; S.Win = (const char*)(ws + WS_WIN); S.Mn = (const char*)(ws + WS_MN); S.Wkv = (const char*)(ws + WS_WKV); S.n_extra = (g == 0) ? 64 : 0;
            pg8::EpiIn E{(bf16*)(ws + WS_PROJ), (bf16*)(ws + WS_KMEM), (bf16*)(ws + WS_VT)};
            pg8::gemm_phase<pg8::EpiIn, pg8::InOrder, true, true>(F.lds, pg8::Gemm{1024, 1024, 1024}, S, E);
            if (cid >= 128) convert_uv(F, g, NGRP, cid - 128, G - 128);
        } SEAM(pb);
        if (PC_(2) && IN(pb + 1)) REPS(2) {
            for (int it = F.vcu * 4; it < BG * 4 * NCHUNK; it += G * 4) { for (int k = 0; k < 4; ++k) hgrn_a_item(F, it + k, k < 3); }
            for (int it = F.vcu; it < BG * 4 * 8; it += G) attn_item(F, g, it);
            conv_phase(F);
        } SEAM(pb + 1);
        if (PC_(3) && IN(pb + 2)) { REPS(3) hgrn_scan(F); } SEAM(pb + 2);
        if (PC_(4) && IN(pb + 3)) REPS(4) { for (int it = F.vcu * 4; it < BG * 4 * NCHUNK; it += G * 4) { for (int k = 0; k < 4; ++k) hgrn_c_item(F, it + k, k < 3); } } SEAM(pb + 3);
        if (PC_(5) && IN(pb + 4)) REPS(5) {
            pg8::BranchOrder S; S.init(TG, 1024, G, cid); S.Y = (const char*)(ws + WS_YHG); S.Wb = (const char*)(ws + WS_WBR);
            pg8::EpiBranch E{(const bf16*)(ws + WS_PROJ), (bf16*)(ws + WS_MACC), (bf16*)(ws + WS_MERGED)};
            pg8::gemm_phase<pg8::EpiBranch, pg8::BranchOrder, true, true>(F.lds, pg8::Gemm{512, 512, 512}, S, E);
        } SEAM(pb + 4);
        if (PC_(6) && IN(pb + 5)) REPS(6) {
            pg8::PlainOrder S; S.init(TG, 1024, G, cid); S.A = (const char*)(ws + WS_MERGED); S.Bt = (const char*)(ws + WS_WOUT); S.a_tile = 256 * 1024 * 2; S.b_tile = 256 * 1024 * 2;
            pg8::EpiOut E{F.x + (size_t)g * TG * 1024, F.out + (size_t)g * TG * 1024, (bf16*)(ws + WS_XG) + (size_t)g * TG * 1024, F.norm_ffn_g, (float*)(ws + WS_SSP) + (size_t)g * TG * 16};
            pg8::gemm_phase<pg8::EpiOut, pg8::PlainOrder, true, true>(F.lds, pg8::Gemm{1024, 1024, 1024}, S, E);
        } SEAM(pb + 5);
    }
#pragma unroll 1
    for (int tg = 0; tg < NGRP; ++tg) {
        const int pb = 13 + 3 * tg;
        if (PC_(7) && IN(pb)) REPS(7) {
            pg8::PlainOrder S; S.init(TG, 2048, G, cid); S.A = (const char*)(ws + WS_XG) + (size_t)tg * TG * 1024 * 2; S.Bt = (const char*)(ws + WS_WQ); S.a_tile = 256 * 1024 * 2; S.b_tile = 256 * 1024 * 2;
            pg8::EpiQ E{(bf16*)(ws + WS_Q), 2048, (const float*)(ws + WS_SSP) + (size_t)tg * TG * 16};
            pg8::gemm_phase<pg8::EpiQ, pg8::PlainOrder, true, true>(F.lds, pg8::Gemm{1024, 1024, 1024}, S, E);
        } SEAM(pb);
        if (PC_(8) && IN(pb + 1)) REPS(8) {
            pg8::ScoreOrder S; S.init(TG, 2048, G, cid); S.Q = (const char*)(ws + WS_Q); S.Kbd = (const char*)(ws + WS_KBD);
            pg8::EpiF32 E{(float*)(ws + WS_S), 2048};
            pg8::gemm_phase<pg8::EpiF32, pg8::ScoreOrder, true, true>(F.lds, pg8::Gemm{2048, 256, 256}, S, E);
        } SEAM(pb + 1);
        if (PC_(9) && IN(pb + 2)) { REPS(9) peer_phase(F, tg, rep_ < 2 * ((REP_MASK >> 9) & 1)); } SEAM(pb + 2);
    }
#undef IN
#undef SEAM
}

extern "C" void kernel_launch(void* const* d_in, const int* in_sizes, int n_in, void* d_out, int out_size, void* d_ws, size_t ws_size, hipStream_t stream) {
    static int ready = 0;
    if (ready == 0) {
        if (n_in != 17 || out_size != T_ALL * D_MODEL || ws_size < WS_END) { fprintf(stderr, "kernel_launch: unexpected shapes (n_in %d, out %d, ws %zu)\n", n_in, out_size, ws_size); ready = -1; return; }
        if (hipFuncSetAttribute((const void*)fwd_kernel, hipFuncAttributeMaxDynamicSharedMemorySize, LDS_BYTES) != hipSuccess) { fprintf(stderr, "kernel_launch: hipFuncSetAttribute failed\n"); ready = -1; return; }
        ready = 1;
    }
    if (ready < 0) return;
    (void)hipMemsetAsync((char*)d_ws + WS_CTL, 0, CTL_ZERO_BYTES, stream);
    Args a{};
    for (int i = 0; i < 17; ++i) a.in[i] = (const float*)d_in[i];
    a.out = (float*)d_out; a.ws = (unsigned char*)d_ws;
    const int grid = 256;
#if MK_N_LAUNCHES == 1
    a.ph_lo = 0; a.ph_hi = N_PHASES;
    hipLaunchKernelGGL(fwd_kernel, dim3(grid), dim3(NWAVES * 64), LDS_BYTES, stream, a);
#else
    for (int li = 0; li < N_PHASES; ++li) { a.ph_lo = li; a.ph_hi = li + 1; hipLaunchKernelGGL(fwd_kernel, dim3(grid), dim3(NWAVES * 64), LDS_BYTES, stream, a); }
#endif
}
```

```cpp
#include <hip/hip_runtime.h>
#include <cstdio>
#include <cstdint>

#ifndef MK_N_LAUNCHES
#define MK_N_LAUNCHES 1
#endif

#define LAS __attribute__((address_space(3)))
#define GAS __attribute__((address_space(1)))
typedef unsigned short bf16;
typedef short bf16x8 __attribute__((ext_vector_type(8)));
typedef short s16x4 __attribute__((ext_vector_type(4)));
typedef short v4i16_t __attribute__((ext_vector_type(4)));
typedef float f32x2 __attribute__((ext_vector_type(2)));
typedef float f32x4 __attribute__((ext_vector_type(4)));
typedef float f32x16 __attribute__((ext_vector_type(16)));
typedef unsigned u32x2 __attribute__((ext_vector_type(2)));
typedef unsigned u32x4 __attribute__((ext_vector_type(4)));
typedef __bf16 bf16x2_t __attribute__((ext_vector_type(2)));
typedef GAS unsigned gu32;
#define RLX_AGENT __ATOMIC_RELAXED, __HIP_MEMORY_SCOPE_AGENT
#define DI __device__ __forceinline__

constexpr int D_MODEL = 1024, BATCH = 16, SEQ = 2048, T_ALL = BATCH * SEQ;
constexpr int NGRP = 2, BG = BATCH / NGRP, TG = BG * SEQ;
constexpr int PC = 7680;
constexpr int C_HQ = 0, C_HI = 512, C_FF = 1024, C_FB = 1536, C_HG = 2048, C_SB = 2560, C_SC = 3072, C_SH = 3584, C_MQ = 4096, C_GATE = 4608;
constexpr int NMEM = 256, CHUNK = 64, NCHUNK = SEQ / CHUNK;
constexpr float EPS = 1e-6f;

constexpr size_t MiB = 1u << 20;
constexpr size_t WS_CTL = 0, CTL_ZERO_BYTES = 1 * MiB;
constexpr size_t WS_LB = 1 * MiB;
constexpr size_t WS_SSP = 2 * MiB;
constexpr size_t WS_DEC = 4 * MiB;
constexpr size_t WS_WIN = 5 * MiB, WS_WKV = 20 * MiB, WS_WBR = 22 * MiB, WS_WOUT = 25 * MiB, WS_WQ = 27 * MiB, WS_KBD = 31 * MiB;
constexpr size_t WS_MN = 32 * MiB, WS_KMEM = 40 * MiB, WS_VT = 44 * MiB;
constexpr size_t WS_XG = 48 * MiB;
constexpr size_t WS_YHG = 112 * MiB, WS_YSC = 128 * MiB, WS_YMX = 144 * MiB;
constexpr size_t WS_DS = 160 * MiB;
constexpr size_t WS_MACC = 160 * MiB;
constexpr size_t WS_MERGED = 224 * MiB;
constexpr size_t WS_PROJ = 256 * MiB;
constexpr size_t WS_U = 496 * MiB, WS_V = 504 * MiB;
constexpr size_t WS_Q = 176 * MiB;
constexpr size_t WS_S = 256 * MiB;
constexpr size_t WS_END = 512 * MiB;
constexpr size_t OUT_SST = 64 * MiB;

constexpr int LDS_BYTES = 160 * 1024;
constexpr int MISC_OFF = LDS_BYTES - 512;
constexpr int NWAVES = 8;

DI unsigned f2bf(float f) { unsigned u = __builtin_bit_cast(unsigned, f); return (u + 0x7fffu + ((u >> 16) & 1u)) >> 16; }
DI unsigned pk2(float lo, float hi) { return f2bf(lo) | (f2bf(hi) << 16); }
DI float bf2f(unsigned short b) { return __builtin_bit_cast(float, (unsigned)b << 16); }
DI float bflo(unsigned w) { return __builtin_bit_cast(float, w << 16); }
DI float bfhi(unsigned w) { return __builtin_bit_cast(float, w & 0xffff0000u); }
DI float wave_sum(float v) {
#pragma unroll
    for (int o = 1; o < 64; o <<= 1) v += __shfl_xor(v, o);
    return v;
}
DI unsigned cvtpk(float lo, float hi) { f32x2 v = {lo, hi}; bf16x2_t b = __builtin_convertvector(v, bf16x2_t); return __builtin_bit_cast(unsigned, b); }
template <int CTRL> DI unsigned dpp_u(unsigned v) { return (unsigned)__builtin_amdgcn_update_dpp(0, (int)v, CTRL, 0xF, 0xF, false); }
template <int CTRL> DI float dpp_f(float v) { return __builtin_bit_cast(float, __builtin_amdgcn_update_dpp(0, __builtin_bit_cast(int, v), CTRL, 0xF, 0xF, false)); }
DI float bperm_f(int addr, float v) { return __builtin_bit_cast(float, __builtin_amdgcn_ds_bpermute(addr, __builtin_bit_cast(int, v))); }
DI unsigned row_max16(unsigned m) { m = max(m, dpp_u<0xB1>(m)); m = max(m, dpp_u<0x4E>(m)); m = max(m, dpp_u<0x141>(m)); return max(m, dpp_u<0x140>(m)); }
DI float row_sum16(float v) { v += dpp_f<0xB1>(v); v += dpp_f<0x4E>(v); v += dpp_f<0x141>(v); return v + dpp_f<0x140>(v); }

DI float fast_sig(float z) { return __builtin_amdgcn_rcpf(1.0f + __builtin_amdgcn_exp2f(-1.4426950408889634f * z)); }
DI float sigmoidf_(float z) { return 1.0f / (1.0f + __expf(-z)); }

namespace pg8 {
constexpr int BM = 256, BK = 64, HALF = 128, HTB = HALF * BK * 2, STAGE_BYTES = 8 * HTB, NXCD = 8, WGM = 8;
__host__ __device__ __forceinline__ int lds_byte(int r, int c) { const int st = (r >> 4) * 2 + (c >> 5), rr = r & 15, cc = c & 31, ob = rr * 64 + cc * 2; return st * 1024 + (ob ^ (((ob >> 9) & 1) << 5)); }
__host__ __device__ __forceinline__ void stage_rc(int b, int& R, int& C) { const int st = b / 1024, sb = b % 1024, swz = sb ^ (((sb >> 9) & 1) << 5); R = (st >> 1) * 16 + swz / 64; C = (st & 1) * 32 + (swz % 64) / 2; }
__host__ __device__ __forceinline__ int perm32(int rho) { const int n = rho >> 4, i = rho & 15; return 8 * (i >> 2) + 4 * n + (i & 3); }

struct Unit { int pm, pn, z; };
struct Gemm { int lda, ldb, K; };

struct StaticOrder {
    int nM, nN, nwg, G, c;
    __device__ void init(int M, int N, int G_, int c_) { nM = M / BM; nN = N / BM; nwg = nM * nN; G = G_; c = c_; }
    __device__ bool tile(int i, Unit& u) const {
        const long L = (long)i * G + c; if (L >= nwg) return false;
        int wgid = (int)L; { const int q = nwg / NXCD, r = nwg % NXCD, xcd = wgid % NXCD, off = wgid / NXCD; wgid = (xcd < r ? xcd * (q + 1) : r * (q + 1) + (xcd - r) * q) + off; }
        const int nig = WGM * nN, gid = wgid / nig, fm = gid * WGM, gsz = (nM - fm) < WGM ? (nM - fm) : WGM;
        u.pm = fm + ((wgid % nig) % gsz); u.pn = (wgid % nig) / gsz; u.z = 0; return true;
    }
};

DI unsigned cvt_pk_bf16(float lo, float hi) { return cvtpk(lo, hi); }

template <class Epi, class Sched, bool ALIGN_EPI, bool SP2>
DI void gemm_phase(LAS unsigned char* lds, const Gemm g, const Sched& S, const Epi& E) {
    int tid_ = threadIdx.x; asm volatile("" : "+v"(tid_));
    const int tid = tid_, wid = __builtin_amdgcn_readfirstlane(tid >> 6), lane = tid & 63, wr = wid >> 2, wc = wid & 3, fr = lane & 15, fq = lane >> 4;
    int K_ = g.K; asm volatile("" : "+s"(K_));
    const int K = K_, nt = K / BK;
    unsigned voffA[2], voffB[2];
#pragma unroll
    for (int i = 0; i < 2; ++i) { int R, C; stage_rc(tid * 16 + i * 8192, R, C); const int Rb = Epi::PERM ? ((R & ~31) + perm32(R & 31)) : R;
        voffA[i] = (unsigned)(R * g.lda + C) * 2u; voffB[i] = (unsigned)(Rb * g.ldb + C) * 2u; }
    const size_t kstep = (size_t)(BK * 2);
    const size_t hA = (size_t)HALF * g.lda * 2, hB = (size_t)HALF * g.ldb * 2;
    const unsigned ldsw = (unsigned)wid * 1024u;
    const int aoff = lds_byte(wr * 64 + fr, fq * 8), boff = lds_byte(wc * 32 + fr, fq * 8);
#define PG8_SA(b, h) (((b) * 2 + (h)) * HTB)
#define PG8_SB(b, h) ((4 + (b) * 2 + (h)) * HTB)
#define PG8_STAGE(bufoff, gbase, voff) do { _Pragma("unroll") for (int _i = 0; _i < 2; ++_i) \
        __builtin_amdgcn_global_load_lds((const unsigned*)((const char*)(gbase) + (voff)[_i]), (LAS unsigned*)(lds + (bufoff) + ldsw + _i * 8192), 16, 0, 0); } while (0)
#define PG8_LDA(dst, b, h) do { _Pragma("unroll") for (int m = 0; m < 4; ++m) _Pragma("unroll") for (int k = 0; k < 2; ++k) dst[m][k] = *(const LAS bf16x8*)(lds + PG8_SA(b, h) + aoff + m * 2048 + k * 1024); } while (0)
#define PG8_LDB(dst, b, h) do { _Pragma("unroll") for (int n = 0; n < 2; ++n) _Pragma("unroll") for (int k = 0; k < 2; ++k) dst[n][k] = *(const LAS bf16x8*)(lds + PG8_SB(b, h) + boff + n * 2048 + k * 1024); } while (0)
#define PG8_MMA(ai, bj, At, Bt) do { __builtin_amdgcn_s_setprio(1); _Pragma("unroll") for (int m = 0; m < 4; ++m) _Pragma("unroll") for (int n = 0; n < 2; ++n) _Pragma("unroll") for (int k = 0; k < 2; ++k) \
        acc[ai][bj][m][n] = __builtin_amdgcn_mfma_f32_16x16x32_bf16(Bt[n][k], At[m][k], acc[ai][bj][m][n], 0, 0, 0); __builtin_amdgcn_s_setprio(0); } while (0)
#define PG8_WAIT_V(n) asm volatile("s_waitcnt vmcnt(" #n ")" ::: "memory")
#define PG8_WAIT_L(n) asm volatile("s_waitcnt lgkmcnt(" #n ")" ::: "memory")
#define PG8_BAR __builtin_amdgcn_s_barrier()
#define PG8_SCHED __builtin_amdgcn_sched_barrier(0)
    Unit cur, nxt; int ui = 0;
    if (!S.next(0, cur)) return;
    f32x4 acc[2][2][4][2];
#pragma unroll
    for (int a = 0; a < 2; ++a)
#pragma unroll
        for (int b = 0; b < 2; ++b)
#pragma unroll
            for (int m = 0; m < 4; ++m)
#pragma unroll
                for (int n = 0; n < 2; ++n) acc[a][b][m][n] = (f32x4){0.f, 0.f, 0.f, 0.f};
    bf16x8 At[4][2], B0[2][2], B1[2][2];
    const char* cA = S.a_base(cur); const char* cB = S.b_base(cur);
    if constexpr (SP2) {
        PG8_STAGE(PG8_SB(0, 0), cB, voffB); PG8_STAGE(PG8_SB(0, 1), cB + hB, voffB); PG8_STAGE(PG8_SA(0, 0), cA, voffA); PG8_STAGE(PG8_SA(0, 1), cA + hA, voffA);
        if (wr == 1) PG8_BAR;
        PG8_WAIT_V(2); PG8_BAR;
        PG8_STAGE(PG8_SB(1, 0), cB + kstep, voffB); PG8_STAGE(PG8_SA(1, 0), cA + kstep, voffA); PG8_STAGE(PG8_SB(1, 1), cB + hB + kstep, voffB);
        PG8_WAIT_V(6); PG8_BAR;
    } else {
        PG8_STAGE(PG8_SB(0, 0), cB, voffB); PG8_STAGE(PG8_SA(0, 0), cA, voffA); PG8_STAGE(PG8_SB(0, 1), cB + hB, voffB); PG8_STAGE(PG8_SA(0, 1), cA + hA, voffA);
        if (wr == 1) PG8_BAR;
        PG8_WAIT_V(4); PG8_BAR;
        PG8_STAGE(PG8_SB(1, 0), cB + kstep, voffB); PG8_STAGE(PG8_SA(1, 0), cA + kstep, voffA); PG8_STAGE(PG8_SB(1, 1), cB + hB + kstep, voffB);
        PG8_WAIT_V(6); PG8_BAR;
    }
    for (;;) {
        const bool has_next = S.next(ui + 1, nxt);
        const char* nA = has_next ? S.a_base(nxt) : cA; const char* nB = has_next ? S.b_base(nxt) : cB;
        for (int t = 0; t < nt; t += 2) {
            const bool last = (t == nt - 2);
            const char* a1 = cA + (size_t)(t + 1) * kstep;
            const char* a2 = last ? nA : cA + (size_t)(t + 2) * kstep; const char* b2 = last ? nB : cB + (size_t)(t + 2) * kstep;
            const char* a3 = a2 + kstep; const char* b3 = b2 + kstep;
            if constexpr (SP2) {
            PG8_LDB(B0, 0, 0); PG8_LDB(B1, 0, 1); PG8_SCHED; PG8_LDA(At, 0, 0); PG8_STAGE(PG8_SA(1, 1), a1 + hA, voffA);
            PG8_WAIT_V(8); PG8_WAIT_L(0); PG8_BAR; PG8_MMA(0, 0, At, B0); PG8_MMA(0, 1, At, B1); PG8_BAR; PG8_SCHED;
            PG8_LDA(At, 0, 1); PG8_STAGE(PG8_SB(0, 0), b2, voffB); PG8_STAGE(PG8_SB(0, 1), b2 + hB, voffB); PG8_STAGE(PG8_SA(0, 0), a2, voffA);
            PG8_WAIT_V(8); PG8_WAIT_L(0); PG8_BAR; PG8_MMA(1, 0, At, B0); PG8_MMA(1, 1, At, B1); PG8_BAR; PG8_SCHED;
            PG8_LDB(B0, 1, 0); PG8_LDB(B1, 1, 1); PG8_SCHED; PG8_LDA(At, 1, 0); PG8_STAGE(PG8_SA(0, 1), a2 + hA, voffA);
            PG8_WAIT_V(8); PG8_WAIT_L(0); PG8_BAR; PG8_MMA(0, 0, At, B0); PG8_MMA(0, 1, At, B1); PG8_BAR; PG8_SCHED;
            PG8_LDA(At, 1, 1); PG8_STAGE(PG8_SB(1, 0), b3, voffB); PG8_STAGE(PG8_SB(1, 1), b3 + hB, voffB); PG8_STAGE(PG8_SA(1, 0), a3, voffA);
            PG8_WAIT_V(8); PG8_WAIT_L(0); PG8_BAR; PG8_MMA(1, 0, At, B0); PG8_MMA(1, 1, At, B1); PG8_BAR; PG8_SCHED;
            } else {
            PG8_LDB(B0, 0, 0); PG8_SCHED; PG8_LDA(At, 0, 0); PG8_STAGE(PG8_SA(1, 1), a1 + hA, voffA);
            PG8_WAIT_L(8); PG8_BAR; PG8_WAIT_L(0); PG8_MMA(0, 0, At, B0); PG8_BAR; PG8_SCHED;
            PG8_LDB(B1, 0, 1); PG8_STAGE(PG8_SB(0, 0), b2, voffB);
            PG8_BAR; PG8_WAIT_L(0); PG8_MMA(0, 1, At, B1); PG8_BAR;
            PG8_LDA(At, 0, 1); PG8_STAGE(PG8_SA(0, 0), a2, voffA);
            PG8_BAR; PG8_WAIT_L(0); PG8_MMA(1, 0, At, B0); PG8_BAR; PG8_SCHED;
            PG8_STAGE(PG8_SB(0, 1), b2 + hB, voffB);
            PG8_WAIT_V(6); PG8_BAR; PG8_MMA(1, 1, At, B1); PG8_BAR;
            PG8_LDB(B0, 1, 0); PG8_SCHED; PG8_LDA(At, 1, 0); PG8_STAGE(PG8_SA(0, 1), a2 + hA, voffA);
            PG8_WAIT_L(8); PG8_BAR; PG8_WAIT_L(0); PG8_MMA(0, 0, At, B0); PG8_BAR; PG8_SCHED;
            PG8_LDB(B1, 1, 1); PG8_STAGE(PG8_SB(1, 0), b3, voffB);
            PG8_BAR; PG8_WAIT_L(0); PG8_MMA(0, 1, At, B1); PG8_BAR;
            PG8_LDA(At, 1, 1); PG8_STAGE(PG8_SA(1, 0), a3, voffA);
            PG8_BAR; PG8_WAIT_L(0); PG8_MMA(1, 0, At, B0); PG8_BAR; PG8_SCHED;
            PG8_STAGE(PG8_SB(1, 1), b3 + hB, voffB);
            PG8_WAIT_V(6); PG8_BAR; PG8_MMA(1, 1, At, B1); PG8_BAR;
            }
        }
        if constexpr (ALIGN_EPI) { if (wr == 0) PG8_BAR; }
        E(acc, cur, wr, wc, fr, fq);
        if (!has_next) break;
#pragma unroll
        for (int a = 0; a < 2; ++a)
#pragma unroll
            for (int b = 0; b < 2; ++b)
#pragma unroll
                for (int m = 0; m < 4; ++m)
#pragma unroll
                    for (int n = 0; n < 2; ++n) acc[a][b][m][n] = (f32x4){0.f, 0.f, 0.f, 0.f};
        cur = nxt; cA = nA; cB = nB; ++ui;
        if constexpr (ALIGN_EPI) { if (wr == 1) PG8_BAR; }
    }
    PG8_WAIT_V(0);
    if constexpr (!ALIGN_EPI) { if (wr == 0) PG8_BAR; }
    PG8_BAR;
#undef PG8_SA
#undef PG8_SB
#undef PG8_STAGE
#undef PG8_LDA
#undef PG8_LDB
#undef PG8_MMA
#undef PG8_WAIT_V
#undef PG8_WAIT_L
#undef PG8_BAR
#undef PG8_SCHED
}
}

namespace pg8 {
struct PlainOrder : StaticOrder {
    const char* A; const char* Bt; size_t a_tile, b_tile;
    __device__ bool next(int i, Unit& u) const { return tile(i, u); }
    DI const char* a_base(const Unit& u) const { return A + (size_t)u.pm * a_tile; }
    DI const char* b_base(const Unit& u) const { return Bt + (size_t)u.pn * b_tile; }
};
struct InOrder : StaticOrder {
    const char* H; const char* Win; const char* Mn; const char* Wkv; int n_extra;
    __device__ bool next(int i, Unit& u) const {
        const long L = (long)i * G + c;
        if (L >= (long)nwg + n_extra) return false;
        Unit t; t.pm = 0; t.pn = 0; t.z = 0;
        const bool main_tile = L < nwg;
        if (main_tile) (void)tile(i, t);
        const int e = (int)(L - nwg);
        const int pm1 = e >> 1, pn1 = e & 1, pm2 = (e - 32) >> 4, pn2 = (e - 32) & 15; const bool k1 = e < 32;
        u.pm = main_tile ? t.pm : (k1 ? pm1 : pm2); u.pn = main_tile ? t.pn : (k1 ? pn1 : pn2); u.z = main_tile ? 0 : (k1 ? 1 : 2);
        return true;
    }
    DI const char* a_base(const Unit& u) const { const long d1 = Mn - H, d2 = (Wkv + (size_t)512 * 1024 * 2) - H; return H + ((u.z == 1) ? d1 : 0L) + ((u.z == 2) ? d2 : 0L) + (size_t)u.pm * (256 * 1024 * 2); }
    DI const char* b_base(const Unit& u) const { const long d1 = Wkv - Win, d2 = Mn - Win; return Win + ((u.z == 1) ? d1 : 0L) + ((u.z == 2) ? d2 : 0L) + (size_t)u.pn * (256 * 1024 * 2); }
};
struct EpiIn {
    static constexpr bool PERM = true;
    bf16* proj; bf16* kmem; bf16* vt;
    DI void operator()(const f32x4 (&acc)[2][2][4][2], const Unit& u, int wr, int wc, int fr, int fq) const {
        const long dk = kmem - proj, dv = vt - proj; bf16* O = proj + ((u.z == 1) ? dk : 0L) + ((u.z == 2) ? dv : 0L); const int ldc = PC + ((u.z == 1) ? 512 - PC : 0) + ((u.z == 2) ? BATCH * NMEM - PC : 0);
        const int row0 = u.pm * BM + wr * 64 + fr, col0 = u.pn * BM + wc * 32 + 8 * fq;
#pragma unroll
        for (int ai = 0; ai < 2; ++ai)
#pragma unroll
            for (int m = 0; m < 4; ++m) { bf16* rowp = O + (size_t)(row0 + ai * HALF + m * 16) * ldc + col0;
#pragma unroll
                for (int bj = 0; bj < 2; ++bj) { const f32x4 v0 = acc[ai][bj][m][0], v1 = acc[ai][bj][m][1];
                    u32x4 w; w.x = cvt_pk_bf16(v0[0], v0[1]); w.y = cvt_pk_bf16(v0[2], v0[3]); w.z = cvt_pk_bf16(v1[0], v1[1]); w.w = cvt_pk_bf16(v1[2], v1[3]);
                    *(u32x4*)(rowp + bj * HALF) = w; } }
    }
};
struct BranchOrder : StaticOrder {
    const char* Y; const char* Wb;
    __device__ bool next(int i, Unit& u) const { if (!tile(i / 3, u)) return false; u.z = i % 3; return true; }
    DI const char* a_base(const Unit& u) const { return Y + (size_t)u.z * (16 * MiB) + (size_t)u.pm * (256 * 512 * 2); }
    DI const char* b_base(const Unit& u) const { return Wb + (size_t)u.z * (1024 * 512 * 2) + (size_t)u.pn * (256 * 512 * 2); }
};
struct ScoreOrder : StaticOrder {
    const char* Q; const char* Kbd;
    __device__ bool next(int i, Unit& u) const { return tile(i, u); }
    DI const char* a_base(const Unit& u) const { return Q + (size_t)u.pm * (256 * 2048 * 2) + (size_t)u.pn * 512; }
    DI const char* b_base(const Unit& u) const { return Kbd + (size_t)u.pn * (256 * 256 * 2); }
};

struct EpiBf16 {
    static constexpr bool PERM = true;
    bf16* O; int ldc;
    DI void operator()(const f32x4 (&acc)[2][2][4][2], const Unit& u, int wr, int wc, int fr, int fq) const {
        const int row0 = u.pm * BM + wr * 64 + fr, col0 = u.pn * BM + wc * 32 + 8 * fq;
#pragma unroll
        for (int ai = 0; ai < 2; ++ai)
#pragma unroll
            for (int m = 0; m < 4; ++m) { bf16* rowp = O + (size_t)(row0 + ai * HALF + m * 16) * ldc + col0;
#pragma unroll
                for (int bj = 0; bj < 2; ++bj) { const f32x4 v0 = acc[ai][bj][m][0], v1 = acc[ai][bj][m][1];
                    u32x4 w; w.x = cvt_pk_bf16(v0[0], v0[1]); w.y = cvt_pk_bf16(v0[2], v0[3]); w.z = cvt_pk_bf16(v1[0], v1[1]); w.w = cvt_pk_bf16(v1[2], v1[3]);
                    *(u32x4*)(rowp + bj * HALF) = w; } }
    }
};
struct EpiQ {
    static constexpr bool PERM = true;
    bf16* O; int ldc; const float* ssp;
    DI void operator()(const f32x4 (&acc)[2][2][4][2], const Unit& u, int wr, int wc, int fr, int fq) const {
        const int row0 = u.pm * BM + wr * 64 + fr, col0 = u.pn * BM + wc * 32 + 8 * fq;
#pragma unroll
        for (int ai = 0; ai < 2; ++ai)
#pragma unroll
            for (int m = 0; m < 4; ++m) { const int row = row0 + ai * HALF + m * 16; const f32x4* sp = (const f32x4*)(ssp + (size_t)row * 16);
                const f32x4 s0 = sp[0], s1 = sp[1], s2 = sp[2], s3 = sp[3];
                const float ss = ((s0[0] + s0[1]) + (s0[2] + s0[3])) + ((s1[0] + s1[1]) + (s1[2] + s1[3])) + ((s2[0] + s2[1]) + (s2[2] + s2[3])) + ((s3[0] + s3[1]) + (s3[2] + s3[3]));
                const float rs = 1.0f / sqrtf(ss * (1.0f / 1024.0f) + EPS);
                bf16* rowp = O + (size_t)row * ldc + col0;
#pragma unroll
                for (int bj = 0; bj < 2; ++bj) { const f32x4 v0 = acc[ai][bj][m][0] * rs, v1 = acc[ai][bj][m][1] * rs;
                    u32x4 w; w.x = cvt_pk_bf16(v0[0], v0[1]); w.y = cvt_pk_bf16(v0[2], v0[3]); w.z = cvt_pk_bf16(v1[0], v1[1]); w.w = cvt_pk_bf16(v1[2], v1[3]);
                    *(u32x4*)(rowp + bj * HALF) = w; }
                asm volatile("" ::: "memory"); }
    }
};
struct EpiF32 {
    static constexpr bool PERM = false;
    float* C; int ldc;
    DI void operator()(const f32x4 (&acc)[2][2][4][2], const Unit& u, int wr, int wc, int fr, int fq) const {
        const int row0 = u.pm * BM + wr * 64 + fr, col0 = u.pn * BM + wc * 32 + 4 * fq;
#pragma unroll
        for (int ai = 0; ai < 2; ++ai)
#pragma unroll
            for (int m = 0; m < 4; ++m) { float* rowp = C + (size_t)(row0 + ai * HALF + m * 16) * ldc + col0;
#pragma unroll
                for (int bj = 0; bj < 2; ++bj)
#pragma unroll
                    for (int n = 0; n < 2; ++n) *(f32x4*)(rowp + bj * HALF + n * 16) = acc[ai][bj][m][n]; }
    }
};
struct EpiBranch {
    static constexpr bool PERM = true;
    const bf16* proj; bf16* gbuf; bf16* merged;
    DI void operator()(const f32x4 (&acc)[2][2][4][2], const Unit& u, int wr, int wc, int fr, int fq) const {
        const int row0 = u.pm * BM + wr * 64 + fr, col0 = u.pn * BM + wc * 32 + 8 * fq;
#pragma unroll
        for (int ai = 0; ai < 2; ++ai)
#pragma unroll
            for (int m = 0; m < 4; ++m) { const int row = row0 + ai * HALF + m * 16;
#pragma unroll
                for (int bj = 0; bj < 2; ++bj) { const int col = col0 + bj * HALF;
                    const u32x4 gw = *(const u32x4*)(proj + (size_t)row * PC + C_GATE + u.z * 1024 + col);
                    f32x4 v0 = acc[ai][bj][m][0], v1 = acc[ai][bj][m][1];
                    v0[0] *= fast_sig(bflo(gw.x)); v0[1] *= fast_sig(bfhi(gw.x)); v0[2] *= fast_sig(bflo(gw.y)); v0[3] *= fast_sig(bfhi(gw.y));
                    v1[0] *= fast_sig(bflo(gw.z)); v1[1] *= fast_sig(bfhi(gw.z)); v1[2] *= fast_sig(bflo(gw.w)); v1[3] *= fast_sig(bfhi(gw.w));
                    const size_t off = (size_t)row * 1024 + col;
                    if (u.z == 2) { const u32x4 p0 = *(const u32x4*)(gbuf + off), p1 = *(const u32x4*)(gbuf + (size_t)TG * 1024 + off);
                        v0[0] += bflo(p0.x) + bflo(p1.x); v0[1] += bfhi(p0.x) + bfhi(p1.x); v0[2] += bflo(p0.y) + bflo(p1.y); v0[3] += bfhi(p0.y) + bfhi(p1.y);
                        v1[0] += bflo(p0.z) + bflo(p1.z); v1[1] += bfhi(p0.z) + bfhi(p1.z); v1[2] += bflo(p0.w) + bflo(p1.w); v1[3] += bfhi(p0.w) + bfhi(p1.w); }
                    u32x4 w; w.x = cvt_pk_bf16(v0[0], v0[1]); w.y = cvt_pk_bf16(v0[2], v0[3]); w.z = cvt_pk_bf16(v1[0], v1[1]); w.w = cvt_pk_bf16(v1[2], v1[3]);
                    *(u32x4*)((u.z == 2 ? merged : gbuf + (size_t)u.z * TG * 1024) + off) = w; }
                asm volatile("" ::: "memory"); }
    }
};
struct EpiOut {
    static constexpr bool PERM = true;
    const float* x; float* x1; bf16* xg; const float* gffn; float* ssp;
    DI void operator()(const f32x4 (&acc)[2][2][4][2], const Unit& u, int wr, int wc, int fr, int fq) const {
        const int row0 = u.pm * BM + wr * 64 + fr, col0 = u.pn * BM + wc * 32 + 8 * fq;
        f32x4 g0[2], g1[2];
#pragma unroll
        for (int bj = 0; bj < 2; ++bj) { g0[bj] = *(const f32x4*)(gffn + col0 + bj * HALF); g1[bj] = *(const f32x4*)(gffn + col0 + bj * HALF + 4); }
#pragma unroll
        for (int ai = 0; ai < 2; ++ai)
#pragma unroll
            for (int m = 0; m < 4; ++m) { const int row = row0 + ai * HALF + m * 16; float ss = 0.f;
#pragma unroll
                for (int bj = 0; bj < 2; ++bj) { const size_t off = (size_t)row * 1024 + col0 + bj * HALF;
                    const f32x4 v0 = acc[ai][bj][m][0] + *(const f32x4*)(x + off), v1 = acc[ai][bj][m][1] + *(const f32x4*)(x + off + 4);
                    *(f32x4*)(x1 + off) = v0; *(f32x4*)(x1 + off + 4) = v1;
                    ss += (v0[0] * v0[0] + v0[1] * v0[1]) + (v0[2] * v0[2] + v0[3] * v0[3]) + (v1[0] * v1[0] + v1[1] * v1[1]) + (v1[2] * v1[2] + v1[3] * v1[3]);
                    const f32x4 a = v0 * g0[bj], b = v1 * g1[bj];
                    u32x4 w; w.x = cvt_pk_bf16(a[0], a[1]); w.y = cvt_pk_bf16(a[2], a[3]); w.z = cvt_pk_bf16(b[0], b[1]); w.w = cvt_pk_bf16(b[2], b[3]);
                    *(u32x4*)(xg + off) = w; }
                ss += __shfl_xor(ss, 16); ss += __shfl_xor(ss, 32);
                if (fq == 0) ssp[(size_t)row * 16 + u.pn * 4 + wc] = ss;
                asm volatile("" ::: "memory"); }
    }
};
}

#define XB_TMO      128
#define XB_XCNT(j)  (256  + 64 * (j))
#define XB_XSUB(j)  (1280 + 64 * (j))
#define XB_XGEN(j)  (2304 + 64 * (j))
#define XB_TOP      3328
#define XB_TOPGEN   3392
#define XCD_BAR_WORDS 3456
#define XB_SPIN_CAP (1u << 18)
constexpr int CW_BAR = 4096;

DI unsigned xb_ld(unsigned* p)              { return __hip_atomic_load(p, __ATOMIC_RELAXED, __HIP_MEMORY_SCOPE_AGENT); }
DI unsigned xb_add(unsigned* p, unsigned v) { return __hip_atomic_fetch_add(p, v, __ATOMIC_RELAXED, __HIP_MEMORY_SCOPE_AGENT); }
DI unsigned xb_xcc_id() { return (unsigned)__builtin_amdgcn_s_getreg((3 << 11) | 20) & 0xFu; }
#define XB_SPIN(cond, bar) do { unsigned _sp = 0; while (cond) { __builtin_amdgcn_s_sleep(1); \
    if ((++_sp & 255u) == 0u) { if (xb_ld(&(bar)[XB_TMO])) break; if (_sp > XB_SPIN_CAP) { atomicAdd(&(bar)[XB_TMO], 1u); break; } } } } while (0)

struct XcdBarrier { unsigned* bar; unsigned x; volatile LAS unsigned* st; };

DI XcdBarrier xcd_barrier_post(unsigned* bar, volatile LAS unsigned* st) {
    XcdBarrier b; b.bar = bar; b.x = xb_xcc_id(); b.st = st;
    if (threadIdx.x == 0) (void)xb_add(&bar[XB_XCNT(b.x)], 1u);
    return b;
}
DI void xcd_barrier_complete(unsigned* bar, unsigned x, unsigned& nloc, unsigned& nx) {
    const unsigned G = gridDim.x * gridDim.y * gridDim.z;
    unsigned sum, cnt, mine, sp = 0u;
    for (;;) {
        sum = 0u; cnt = 0u; mine = 0u;
#pragma unroll
        for (unsigned j = 0; j < 16; ++j) { const unsigned c = xb_ld(&bar[XB_XCNT(j)]); sum += c; cnt += (c > 0u) ? 1u : 0u; mine = (j == x) ? c : mine; }
        if (sum == G) break;
        __builtin_amdgcn_s_sleep(1);
        if ((++sp & 255u) == 0u) { if (xb_ld(&bar[XB_TMO])) break; if (sp > XB_SPIN_CAP) { atomicAdd(&bar[XB_TMO], 1u); break; } }
    }
    nloc = mine > 0u ? mine : 1u; nx = cnt > 0u ? cnt : 1u;
}
DI void xcd_barrier(const XcdBarrier& b) {
    asm volatile("s_waitcnt vmcnt(0)" ::: "memory");
    __syncthreads();
    if (threadIdx.x == 0) {
        unsigned* bar = b.bar;
        __builtin_amdgcn_s_waitcnt(0);
        unsigned nloc = b.st[0], nx = b.st[1];
        if (nloc == 0u) { xcd_barrier_complete(bar, b.x, nloc, nx); b.st[0] = nloc; b.st[1] = nx; }
        const unsigned old = xb_add(&bar[XB_XSUB(b.x)], 1u);
        const unsigned gen = old / nloc;
        if (old + 1u == (gen + 1u) * nloc) {
            __builtin_amdgcn_fence(__ATOMIC_RELEASE, "agent");
            asm volatile("s_waitcnt vmcnt(0)" ::: "memory");
            const unsigned og = xb_add(&bar[XB_TOP], 1u);
            const unsigned tg = og / nx;
            if (og + 1u == (tg + 1u) * nx) xb_add(&bar[XB_TOPGEN], 1u);
            else XB_SPIN(xb_ld(&bar[XB_TOPGEN]) == tg, bar);
            __builtin_amdgcn_fence(__ATOMIC_ACQUIRE, "agent");
            xb_add(&bar[XB_XGEN(b.x)], 1u);
            asm volatile("s_waitcnt vmcnt(0)" ::: "memory");
        } else {
            XB_SPIN(xb_ld(&bar[XB_XGEN(b.x)]) == gen, bar);
            __builtin_amdgcn_fence(__ATOMIC_ACQUIRE, "agent");
            asm volatile("s_waitcnt vmcnt(0)" ::: "memory");
        }
    }
    __syncthreads();
}

struct Frame {
    LAS unsigned char* lds;
    int tid, lane, wave;
    DI void refresh() { int t = threadIdx.x; asm volatile("" : "+v"(t)); tid = t; lane = t & 63; wave = __builtin_amdgcn_readfirstlane(t >> 6); }
    int vcu, G;
    const float *x, *mem, *norm_mix_g, *w_in, *hg_lb, *hg_norm_g, *sc_conv_w, *mem_norm_g, *w_mem_kv, *w_branch, *w_out, *norm_ffn_g, *peer_w_q, *peer_sub_keys, *peer_u, *peer_v, *final_norm_g;
    float* out; unsigned char* ws;
};

DI void p0_transpose_item(const float* W, int K, int N, bf16* WT, LAS float* scr, int item, int lane) {
    const int nblk = N / 32, kb = item / nblk, nb = item % nblk, k0 = 64 * kb, n0 = 32 * nb;
#pragma unroll 8
    for (int i = 0; i < 32; ++i) { const int kk = 2 * i + (lane >> 5); scr[kk * 33 + (lane & 31)] = W[(size_t)(k0 + kk) * N + n0 + (lane & 31)]; }
    asm volatile("s_waitcnt lgkmcnt(0)" ::: "memory");
    const int c = lane & 7;
#pragma unroll
    for (int j = 0; j < 4; ++j) { const int n = (lane >> 3) + 8 * j; const LAS float* s = scr + (8 * c) * 33 + n;
        u32x4 o; o.x = pk2(s[0 * 33], s[1 * 33]); o.y = pk2(s[2 * 33], s[3 * 33]); o.z = pk2(s[4 * 33], s[5 * 33]); o.w = pk2(s[6 * 33], s[7 * 33]);
        *(u32x4*)(WT + (size_t)(n0 + n) * K + k0 + 8 * c) = o; }
    asm volatile("s_waitcnt lgkmcnt(0)" ::: "memory");
}
DI void rms_row_to_bf16(const float* xrow, const float* g, bf16* orow, int lane) {
    const f32x4* xr = (const f32x4*)xrow + lane; const f32x4* gr = (const f32x4*)g + lane;
    f32x4 v[4]; float s = 0.f;
#pragma unroll
    for (int j = 0; j < 4; ++j) { v[j] = xr[64 * j]; s += (v[j].x * v[j].x + v[j].y * v[j].y) + (v[j].z * v[j].z + v[j].w * v[j].w); }
    const float rstd = 1.0f / sqrtf(wave_sum(s) * (1.f / 1024.f) + EPS);
    unsigned long long* o8 = (unsigned long long*)orow + lane;
#pragma unroll
    for (int j = 0; j < 4; ++j) { const f32x4 gg = gr[64 * j]; const f32x4 y = v[j] * rstd * gg;
        o8[64 * j] = (unsigned long long)pk2(y.x, y.y) | ((unsigned long long)pk2(y.z, y.w) << 32); }
}
DI void p0_prologue(Frame& F) {
    F.refresh();
    LAS float* scr = (LAS float*)(F.lds + F.wave * 16384);
    const int gw = F.vcu * NWAVES + F.wave, NGW = F.G * NWAVES;
    unsigned char* ws = F.ws;
    constexpr int I_IN = (1024 / 64) * (PC / 32), I_KV = (1024 / 64) * (1024 / 32), I_BR = (512 / 64) * (1024 / 32), I_OUT = (1024 / 64) * (1024 / 32), I_Q = (1024 / 64) * (2048 / 32);
    constexpr int NITEMS = I_IN + I_KV + 3 * I_BR + I_OUT + I_Q;
    for (int it = gw; it < NITEMS; it += NGW) {
        int r = it;
        if (r < I_IN) { p0_transpose_item(F.w_in, 1024, PC, (bf16*)(ws + WS_WIN), scr, r, F.lane); continue; } r -= I_IN;
        if (r < I_KV) { p0_transpose_item(F.w_mem_kv, 1024, 1024, (bf16*)(ws + WS_WKV), scr, r, F.lane); continue; } r -= I_KV;
        if (r < 3 * I_BR) { const int n = r / I_BR; p0_transpose_item(F.w_branch + (size_t)n * 512 * 1024, 512, 1024, (bf16*)(ws + WS_WBR) + (size_t)n * 1024 * 512, scr, r % I_BR, F.lane); continue; } r -= 3 * I_BR;
        if (r < I_OUT) { p0_transpose_item(F.w_out, 1024, 1024, (bf16*)(ws + WS_WOUT), scr, r, F.lane); continue; } r -= I_OUT;
        p0_transpose_item(F.peer_w_q, 1024, 2048, (bf16*)(ws + WS_WQ), scr, r, F.lane);
    }
    const int gt = F.vcu * 512 + F.tid, NGT = F.G * 512;
    for (int it = gt; it < 8 * 256 * 32; it += NGT) {
        const int c8 = it & 31, row = (it >> 5) & 255, h = it >> 13, p = row >> 7, key = row & 127;
        u32x4 o = (u32x4){0u, 0u, 0u, 0u};
        if ((c8 >> 4) == p) { const float* s = F.peer_sub_keys + (((size_t)(h * 2 + p) * 128 + key) * 128 + (c8 & 15) * 8);
            const f32x4 a = *(const f32x4*)s, b = *(const f32x4*)(s + 4); o.x = pk2(a.x, a.y); o.y = pk2(a.z, a.w); o.z = pk2(b.x, b.y); o.w = pk2(b.z, b.w); }
        *(u32x4*)((bf16*)(ws + WS_KBD) + ((size_t)(h * 256 + row) * 256 + c8 * 8)) = o;
    }
    for (int it = gt; it < 1024; it += NGT) { const float a0 = F.hg_lb[it], a1 = F.hg_lb[1024 + it]; const float m = fmaxf(a0, a1); const float e0 = __expf(a0 - m), e1 = __expf(a1 - m);
        ((float*)(ws + WS_LB))[it] = e0 / (e0 + e1); }
    for (int m = gw; m < BATCH * NMEM; m += NGW) rms_row_to_bf16(F.mem + (size_t)m * 1024, F.mem_norm_g, (bf16*)(ws + WS_MN) + (size_t)m * 1024, F.lane);
    for (int m = gw; m < T_ALL; m += NGW) rms_row_to_bf16(F.x + (size_t)m * 1024, F.norm_mix_g, (bf16*)(ws + WS_XG) + (size_t)m * 1024, F.lane);
}

DI s16x4 tr16(const LAS unsigned char* p) { return __builtin_bit_cast(s16x4, __builtin_amdgcn_ds_read_tr16_b64_v4i16((LAS v4i16_t*)p)); }
DI bf16x8 cat8(s16x4 lo, s16x4 hi) { return __builtin_shufflevector(lo, hi, 0, 1, 2, 3, 4, 5, 6, 7); }
#define MFMA32(a, b, c) __builtin_amdgcn_mfma_f32_32x32x16_bf16((a), (b), (c), 0, 0, 0)
DI int crow(int reg, int h) { return (reg & 3) + 8 * (reg >> 2) + 4 * h; }
DI bf16x8 pack8(const f32x16& x, int s) {
    u32x4 p; p.x = cvtpk(x[8 * s], x[8 * s + 1]); p.y = cvtpk(x[8 * s + 2], x[8 * s + 3]); p.z = cvtpk(x[8 * s + 4], x[8 * s + 5]); p.w = cvtpk(x[8 * s + 6], x[8 * s + 7]);
    return __builtin_bit_cast(bf16x8, p);
}
constexpr int TS = 272;

DI void stage_tile(LAS unsigned char* tile, const bf16* src, int tid) {
#pragma unroll
    for (int i = 0; i < 2; ++i) { const int id = tid + 512 * i, c = id >> 4, ch = id & 15;
        *(LAS u32x4*)(tile + c * TS + ch * 16) = *(const u32x4*)(src + (size_t)c * PC + ch * 8); }
}
DI float touch_tile(const bf16* src, int i128) { return *(const float*)(src + (size_t)(i128 >> 1) * PC + (i128 & 1) * 64); }
DI void gate8(const LAS unsigned char* zt, int dp, int ts, f32x2 lb, f32x2 (&L)[8], f32x2 (&kk)[8], f32x2 (&lf)[8]) {
    f32x2 run = (f32x2){0.f, 0.f}; const f32x2 oml = 1.0f - lb;
#pragma unroll
    for (int i = 0; i < 8; ++i) { const unsigned w = *(const LAS unsigned*)(zt + (8 * ts + i) * TS + 4 * dp);
        const f32x2 sg = (f32x2){fast_sig(bflo(w)), fast_sig(bfhi(w))}; const f32x2 f = lb + oml * sg;
        lf[i] = (f32x2){__builtin_amdgcn_logf(f.x), __builtin_amdgcn_logf(f.y)}; kk[i] = oml * (1.0f - sg); run += lf[i]; L[i] = run; }
}
DI f32x2 exp2x2(f32x2 v) { return (f32x2){__builtin_amdgcn_exp2f(v.x), __builtin_amdgcn_exp2f(v.y)}; }
struct SliceSums { f32x2 offf, offb, glf, glb, greff, grefb; };
DI SliceSums slice_sums(const LAS float* tot, int dp, int ts) {
    SliceSums r; f32x2 tf[8], tb[8];
#pragma unroll
    for (int j = 0; j < 8; ++j) { tf[j] = *(const LAS f32x2*)(tot + j * 128 + 2 * dp); tb[j] = *(const LAS f32x2*)(tot + (8 + j) * 128 + 2 * dp); }
    r.offf = (f32x2){0.f, 0.f}; r.offb = (f32x2){0.f, 0.f};
#pragma unroll
    for (int j = 0; j < 8; ++j) { if (j < ts) r.offf += tf[j]; if (j > ts) r.offb += tb[j]; }
    r.greff = (tf[0] + tf[1]) + (tf[2] + tf[3]); r.glf = r.greff + ((tf[4] + tf[5]) + (tf[6] + tf[7]));
    r.grefb = (tb[4] + tb[5]) + (tb[6] + tb[7]); r.glb = r.grefb + ((tb[0] + tb[1]) + (tb[2] + tb[3]));
    return r;
}

DI void hgrn_a_item(Frame& F, int item, bool has_next) {
    F.refresh();
    constexpr int T_V = 0, T_KF = 17408, T_KB = 34816, TOT = 52224;
    LAS unsigned char* lds = F.lds;
    const int n = item & 31, h = (item >> 5) & 3, b = item >> 7;
    const bf16* proj = (const bf16*)(F.ws + WS_PROJ) + ((size_t)b * SEQ + n * CHUNK) * PC;
    const int tid = F.tid, dp = tid & 63, ts = F.wave;
    const float* lbp = (const float*)(F.ws + WS_LB);
    const f32x2 lbf = *(const f32x2*)(lbp + h * 128 + 2 * dp), lbb = *(const f32x2*)(lbp + 512 + h * 128 + 2 * dp);
    stage_tile(lds + T_V, proj + C_HI + h * 128, tid); stage_tile(lds + T_KF, proj + C_FF + h * 128, tid); stage_tile(lds + T_KB, proj + C_FB + h * 128, tid);
    float tch = 0.f;
    if (has_next) { const bf16* pn = proj + (size_t)CHUNK * PC + h * 128; const int i128 = tid & 127, wsel = tid >> 7; tch = touch_tile(pn + (wsel == 0 ? C_HI : wsel == 1 ? C_FF : C_FB), i128); }
    __syncthreads();
    f32x2 Lf[8], kf[8], lff[8], Lb[8], kb[8], lfb[8];
    gate8(lds + T_KF, dp, ts, lbf, Lf, kf, lff);
    gate8(lds + T_KB, dp, ts, lbb, Lb, kb, lfb);
    LAS float* tot = (LAS float*)(lds + TOT);
    *(LAS f32x2*)(tot + ts * 128 + 2 * dp) = Lf[7]; *(LAS f32x2*)(tot + (8 + ts) * 128 + 2 * dp) = Lb[7];
    asm volatile("" :: "v"(tch));
    __syncthreads();
    const SliceSums ss = slice_sums(tot, dp, ts);
    const f32x2 tbq = Lb[7];
#pragma unroll
    for (int i = 0; i < 8; ++i) { const int c = 8 * ts + i;
        const f32x2 G = ss.offf + Lf[i]; const f32x2 kd = kf[i] * exp2x2(ss.glf - G);
        const f32x2 Gb = ss.offb + (tbq - Lb[i] + lfb[i]); const f32x2 kdb = kb[i] * exp2x2(ss.glb - Gb);
        *(LAS unsigned*)(lds + T_KF + c * TS + 4 * dp) = cvtpk(kd.x, kd.y); *(LAS unsigned*)(lds + T_KB + c * TS + 4 * dp) = cvtpk(kdb.x, kdb.y); }
    if (ts == 0) { float* dec = (float*)(F.ws + WS_DEC) + (size_t)item * 256; *(f32x2*)(dec + 2 * dp) = exp2x2(ss.glf); *(f32x2*)(dec + 128 + 2 * dp) = exp2x2(ss.glb); }
    __syncthreads();
    const int w = F.wave, lane = F.lane, r = lane & 31, hh = lane >> 5, blk = (lane >> 4) & 1, q = (lane & 15) >> 2, p = lane & 3;
    const int dt = w >> 1, et0 = (w & 1) * 2;
#pragma unroll
    for (int dir = 0; dir < 2; ++dir) { const int TK = dir ? T_KB : T_KF;
#pragma unroll
        for (int e2 = 0; e2 < 2; ++e2) { const int et = et0 + e2; f32x16 acc;
#pragma unroll
            for (int i = 0; i < 16; ++i) acc[i] = 0.f;
#pragma unroll
            for (int ks = 0; ks < 4; ++ks) {
                const LAS unsigned char* ap = lds + TK + (16 * ks + 8 * hh + q) * TS + (32 * dt + 16 * blk + 4 * p) * 2;
                const LAS unsigned char* bp = lds + T_V + (16 * ks + 8 * hh + q) * TS + (32 * et + 16 * blk + 4 * p) * 2;
                const bf16x8 a = cat8(tr16(ap), tr16(ap + 4 * TS)), bq = cat8(tr16(bp), tr16(bp + 4 * TS));
                acc = MFMA32(a, bq, acc); }
            bf16* dsb = (bf16*)(F.ws + WS_DS) + ((size_t)(item * 2 + dir) * 128 + 32 * et + r) * 128 + 32 * dt + 4 * hh;
#pragma unroll
            for (int g4 = 0; g4 < 4; ++g4) { u32x2 wv; wv.x = cvtpk(acc[4 * g4], acc[4 * g4 + 1]); wv.y = cvtpk(acc[4 * g4 + 2], acc[4 * g4 + 3]); *(u32x2*)(dsb + 8 * g4) = wv; } } }
    __syncthreads();
}

DI void hgrn_scan(Frame& F) {
    F.refresh();
    const bf16* dS = (const bf16*)(F.ws + WS_DS); bf16* Sst = (bf16*)((unsigned char*)F.out + OUT_SST); const float* dec = (const float*)(F.ws + WS_DEC);
    const int gt = F.vcu * 512 + F.tid, NGT = F.G * 512;
    for (int id = gt; id < BG * 4 * 2 * 128 * 32; id += NGT) {
        const int d4 = id & 31, e = (id >> 5) & 127, dir = (id >> 12) & 1, bh = id >> 13;
        f32x4 S = (f32x4){0.f, 0.f, 0.f, 0.f};
#pragma unroll 4
        for (int s = 0; s < 32; ++s) { const int n = dir ? 31 - s : s, item = bh * 32 + n;
            const size_t off = ((size_t)(item * 2 + dir) * 128 + e) * 128 + d4 * 4;
            u32x2 o; o.x = cvtpk(S.x, S.y); o.y = cvtpk(S.z, S.w); *(u32x2*)(Sst + off) = o;
            const f32x4 dc = *(const f32x4*)(dec + (size_t)(item * 2 + dir) * 128 + d4 * 4);
            const u32x2 wv = *(const u32x2*)(dS + off);
            S.x = dc.x * S.x + bflo(wv.x); S.y = dc.y * S.y + bfhi(wv.x); S.z = dc.z * S.z + bflo(wv.y); S.w = dc.w * S.w + bfhi(wv.y); }
    }
}

DI void hgrn_c_item(Frame& F, int item, bool has_next) {
    F.refresh();
    constexpr int T_QRF = 0, T_KRF = 17408, T_QGF = 34816, T_QRB = 52224, T_KRB = 69632, T_QGB = 87040, T_V = 104448, TOT = 121856, O_OFF = 0, OS = 132;
    LAS unsigned char* lds = F.lds;
    const int n = item & 31, h = (item >> 5) & 3, b = item >> 7;
    const size_t row0 = (size_t)b * SEQ + n * CHUNK;
    const bf16* proj = (const bf16*)(F.ws + WS_PROJ) + row0 * PC;
    const int tid = F.tid, dp = tid & 63, ts = F.wave;
    const float* lbp = (const float*)(F.ws + WS_LB);
    const f32x2 lbf = *(const f32x2*)(lbp + h * 128 + 2 * dp), lbb = *(const f32x2*)(lbp + 512 + h * 128 + 2 * dp);
    stage_tile(lds + T_V, proj + C_HI + h * 128, tid); stage_tile(lds + T_KRF, proj + C_FF + h * 128, tid); stage_tile(lds + T_KRB, proj + C_FB + h * 128, tid); stage_tile(lds + T_QRF, proj + C_HQ + h * 128, tid);
    float tch = 0.f, tch2 = 0.f;
    if (has_next) { const bf16* pn = proj + (size_t)CHUNK * PC + h * 128; const int i128 = tid & 127, wsel = tid >> 7; tch = touch_tile(pn + (wsel == 0 ? C_HI : wsel == 1 ? C_FF : wsel == 2 ? C_FB : C_HQ), i128);
        tch2 = *(const float*)((const unsigned char*)F.out + OUT_SST + (size_t)(item + 1) * 65536 + (size_t)tid * 128); }
    __syncthreads();
    f32x2 qv[8];
#pragma unroll
    for (int i = 0; i < 8; ++i) { const unsigned w = *(const LAS unsigned*)(lds + T_QRF + (8 * ts + i) * TS + 4 * dp); const float z0 = bflo(w), z1 = bfhi(w); qv[i] = (f32x2){z0 * fast_sig(z0), z1 * fast_sig(z1)}; }
    f32x2 Lf[8], kf[8], lff[8], Lb[8], kb[8], lfb[8];
    gate8(lds + T_KRF, dp, ts, lbf, Lf, kf, lff);
    gate8(lds + T_KRB, dp, ts, lbb, Lb, kb, lfb);
    LAS float* tot = (LAS float*)(lds + TOT);
    *(LAS f32x2*)(tot + ts * 128 + 2 * dp) = Lf[7]; *(LAS f32x2*)(tot + (8 + ts) * 128 + 2 * dp) = Lb[7];
    asm volatile("" :: "v"(tch), "v"(tch2));
    __syncthreads();
    {
        const SliceSums ss = slice_sums(tot, dp, ts);
        const f32x2 tbq = Lb[7];
#pragma unroll
        for (int i = 0; i < 8; ++i) { const int c = 8 * ts + i; const int o = c * TS + 4 * dp;
            const f32x2 G = ss.offf + Lf[i]; const f32x2 x = G - ss.greff;
            const f32x2 qr = qv[i] * exp2x2(x), kr = kf[i] * exp2x2(-x), qg = qv[i] * exp2x2(G);
            *(LAS unsigned*)(lds + T_QRF + o) = cvtpk(qr.x, qr.y); *(LAS unsigned*)(lds + T_KRF + o) = cvtpk(kr.x, kr.y); *(LAS unsigned*)(lds + T_QGF + o) = cvtpk(qg.x, qg.y);
            const f32x2 Gb = ss.offb + (tbq - Lb[i] + lfb[i]); const f32x2 xb = Gb - ss.grefb;
            const f32x2 qrb = qv[i] * exp2x2(xb), krb = kb[i] * exp2x2(-xb), qgb = qv[i] * exp2x2(Gb);
            *(LAS unsigned*)(lds + T_QRB + o) = cvtpk(qrb.x, qrb.y); *(LAS unsigned*)(lds + T_KRB + o) = cvtpk(krb.x, krb.y); *(LAS unsigned*)(lds + T_QGB + o) = cvtpk(qgb.x, qgb.y); }
    }
    __syncthreads();
    const int w = F.wave, lane = F.lane, r = lane & 31, hh = lane >> 5, blk = (lane >> 4) & 1, q = (lane & 15) >> 2, p = lane & 3;
    const int ct = w >> 2, et = w & 3;
    const bf16* Sst = (const bf16*)((const unsigned char*)F.out + OUT_SST);
    f32x16 o;
#pragma unroll
    for (int i = 0; i < 16; ++i) o[i] = 0.f;
#pragma unroll
    for (int dir = 0; dir < 2; ++dir) { const int TQR = dir ? T_QRB : T_QRF, TKR = dir ? T_KRB : T_KRF, TQG = dir ? T_QGB : T_QGF;
#pragma unroll
        for (int st = 0; st < 2; ++st) {
            if (dir == 0 ? (st > ct) : (st < ct)) continue;
            f32x16 X;
#pragma unroll
            for (int i = 0; i < 16; ++i) X[i] = 0.f;
#pragma unroll
            for (int ks = 0; ks < 8; ++ks) { const bf16x8 a = *(const LAS bf16x8*)(lds + TKR + (32 * st + r) * TS + (16 * ks + 8 * hh) * 2), bq = *(const LAS bf16x8*)(lds + TQR + (32 * ct + r) * TS + (16 * ks + 8 * hh) * 2);
                X = MFMA32(a, bq, X); }
            const int cc = 32 * ct + r;
#pragma unroll
            for (int i = 0; i < 16; ++i) { const int s = 32 * st + crow(i, hh); const bool keep = dir == 0 ? (s <= cc) : (s >= cc); X[i] = keep ? X[i] : 0.f; }
#pragma unroll
            for (int s2 = 0; s2 < 2; ++s2) { const bf16x8 xs = pack8(X, s2);
                const LAS unsigned char* vp = lds + T_V + (32 * st + 16 * s2 + 4 * hh + q) * TS + (32 * et + 16 * blk + 4 * p) * 2;
                const bf16x8 pb = cat8(tr16(vp), tr16(vp + 8 * TS));
                o = MFMA32(xs, pb, o); }
        }
        const bf16* sp = Sst + ((size_t)(item * 2 + dir) * 128 + 32 * et + r) * 128 + 8 * hh;
#pragma unroll
        for (int ks = 0; ks < 8; ++ks) { const bf16x8 a = *(const LAS bf16x8*)(lds + TQG + (32 * ct + r) * TS + (16 * ks + 8 * hh) * 2); const bf16x8 bq = *(const bf16x8*)(sp + 16 * ks);
            o = MFMA32(a, bq, o); }
    }
    unsigned hw[8];
#pragma unroll
    for (int k = 0; k < 8; ++k) hw[k] = *(const unsigned*)(proj + (size_t)(8 * w + k) * PC + C_HG + h * 128 + 2 * lane);
    __syncthreads();
    LAS float* O = (LAS float*)(lds + O_OFF);
#pragma unroll
    for (int i = 0; i < 16; ++i) O[(32 * ct + crow(i, hh)) * OS + 32 * et + r] = o[i];
    __syncthreads();
    const f32x2 gn = *(const f32x2*)(F.hg_norm_g + h * 128 + 2 * lane);
    bf16* yhg = (bf16*)(F.ws + WS_YHG);
    const int a16 = (lane ^ 16) << 2, a32 = (lane ^ 32) << 2;
#pragma unroll
    for (int k = 0; k < 8; ++k) { const int c = 8 * w + k; const f32x2 v = *(const LAS f32x2*)(O + c * OS + 2 * lane);
        float ss = row_sum16(v.x * v.x + v.y * v.y); ss += bperm_f(a16, ss); ss += bperm_f(a32, ss);
        const float rstd = __builtin_amdgcn_rsqf(ss * (1.0f / 128.0f) + EPS);
        const float z0 = bflo(hw[k]), z1 = bfhi(hw[k]);
        const float y0 = v.x * rstd * gn.x * (z0 * fast_sig(z0)), y1 = v.y * rstd * gn.y * (z1 * fast_sig(z1));
        *(unsigned*)(yhg + (row0 + c) * 512 + h * 128 + 2 * lane) = cvtpk(y0, y1); }
    __syncthreads();
}

DI void attn_item(Frame& F, int g, int item) {
    F.refresh();
    constexpr int KS = 272, VS = 528, K_OFF = 0, V_OFF = 69632;
    LAS unsigned char* lds = F.lds;
    const int qb = item & 7, h = (item >> 3) & 3, b = item >> 5, bglob = g * BG + b;
    const bf16* Km = (const bf16*)(F.ws + WS_KMEM) + (size_t)bglob * 256 * 512 + h * 128;
    const bf16* VT = (const bf16*)(F.ws + WS_VT) + (size_t)(h * 128) * 4096 + bglob * 256;
    const int tid = F.tid;
#pragma unroll
    for (int i = 0; i < 8; ++i) { const int id = tid + 512 * i, key = id >> 4, ch = id & 15;
        *(LAS u32x4*)(lds + K_OFF + key * KS + ch * 16) = *(const u32x4*)(Km + (size_t)key * 512 + ch * 8); }
#pragma unroll
    for (int i = 0; i < 8; ++i) { const int id = tid + 512 * i, e = id >> 5, ch = id & 31;
        *(LAS u32x4*)(lds + V_OFF + e * VS + ch * 16) = *(const u32x4*)(VT + (size_t)e * 4096 + ch * 8); }
    __syncthreads();
    const int w = F.wave, lane = F.lane, r = lane & 31, hh = lane >> 5;
    const size_t qrow0 = (size_t)b * SEQ + qb * 256 + w * 32;
    const bf16* proj = (const bf16*)(F.ws + WS_PROJ);
    bf16x8 qf[8];
#pragma unroll
    for (int ks = 0; ks < 8; ++ks) qf[ks] = *(const bf16x8*)(proj + (qrow0 + r) * PC + C_MQ + h * 128 + 16 * ks + 8 * hh);
    const float scale = 0.08838834764831845f;
    float m_run = -INFINITY, l_run = 0.f;
#pragma unroll 1
    for (int kt = 0; kt < 8; ++kt) {
        f32x16 X;
#pragma unroll
        for (int i = 0; i < 16; ++i) X[i] = 0.f;
#pragma unroll
        for (int ks = 0; ks < 8; ++ks) { const bf16x8 a = *(const LAS bf16x8*)(lds + K_OFF + (32 * kt + r) * KS + (16 * ks + 8 * hh) * 2); X = MFMA32(a, qf[ks], X); }
        float tm = X[0];
#pragma unroll
        for (int i = 1; i < 16; ++i) tm = fmaxf(tm, X[i]);
        tm *= scale;
        const float mn = fmaxf(m_run, tm); float ls = 0.f;
#pragma unroll
        for (int i = 0; i < 16; ++i) ls += __expf(X[i] * scale - mn);
        l_run = l_run * __expf(m_run - mn) + ls; m_run = mn;
    }
    { const float mo = __shfl_xor(m_run, 32), lo = __shfl_xor(l_run, 32); const float m = fmaxf(m_run, mo);
      l_run = l_run * __expf(m_run - m) + lo * __expf(mo - m); m_run = m; }
    const float inv_l = 1.0f / l_run;
    f32x16 O[4];
#pragma unroll
    for (int e = 0; e < 4; ++e)
#pragma unroll
        for (int i = 0; i < 16; ++i) O[e][i] = 0.f;
#pragma unroll 1
    for (int kt = 0; kt < 8; ++kt) {
        f32x16 X;
#pragma unroll
        for (int i = 0; i < 16; ++i) X[i] = 0.f;
#pragma unroll
        for (int ks = 0; ks < 8; ++ks) { const bf16x8 a = *(const LAS bf16x8*)(lds + K_OFF + (32 * kt + r) * KS + (16 * ks + 8 * hh) * 2); X = MFMA32(a, qf[ks], X); }
#pragma unroll
        for (int i = 0; i < 16; ++i) X[i] = __expf(X[i] * scale - m_run) * inv_l;
#pragma unroll
        for (int s2 = 0; s2 < 2; ++s2) { const bf16x8 xs = pack8(X, s2);
#pragma unroll
            for (int e = 0; e < 4; ++e) { const LAS unsigned char* vp = lds + V_OFF + (32 * e + r) * VS + (32 * kt + 16 * s2 + 4 * hh) * 2;
                const bf16x8 pb = cat8(*(const LAS s16x4*)vp, *(const LAS s16x4*)(vp + 16));
                O[e] = MFMA32(xs, pb, O[e]); } }
    }
    bf16* ymx = (bf16*)(F.ws + WS_YMX);
#pragma unroll
    for (int e = 0; e < 4; ++e)
#pragma unroll
        for (int i = 0; i < 16; ++i) ymx[(qrow0 + crow(i, hh)) * 512 + h * 128 + 32 * e + r] = (bf16)f2bf(O[e][i]);
    __syncthreads();
}

DI void conv_phase(Frame& F) {
    F.refresh();
    const bf16* proj = (const bf16*)(F.ws + WS_PROJ); bf16* ysc = (bf16*)(F.ws + WS_YSC); const float* cw = F.sc_conv_w;
    const int gt = F.vcu * 512 + F.tid, NGT = F.G * 512;
    for (int id = gt; id < TG * 64; id += NGT) {
        const int c8 = id & 63, t = id >> 6, ts = t & (SEQ - 1);
        const bf16* pr = proj + (size_t)t * PC + c8 * 8;
        const u32x4 z4 = (u32x4){0u, 0u, 0u, 0u};
        const u32x4 sb = *(const u32x4*)(pr + C_SB), c1 = *(const u32x4*)(pr + C_SC), h1 = *(const u32x4*)(pr + C_SH);
        const u32x4 c0 = ts > 0 ? *(const u32x4*)(pr - PC + C_SC) : z4, h0 = ts > 0 ? *(const u32x4*)(pr - PC + C_SH) : z4;
        const u32x4 c2 = ts < SEQ - 1 ? *(const u32x4*)(pr + PC + C_SC) : z4, h2 = ts < SEQ - 1 ? *(const u32x4*)(pr + PC + C_SH) : z4;
        const f32x4 wa0 = *(const f32x4*)(cw + c8 * 8), wa1 = *(const f32x4*)(cw + c8 * 8 + 4), wb0 = *(const f32x4*)(cw + 512 + c8 * 8), wb1 = *(const f32x4*)(cw + 512 + c8 * 8 + 4),
                    wc0 = *(const f32x4*)(cw + 1024 + c8 * 8), wc1 = *(const f32x4*)(cw + 1024 + c8 * 8 + 4);
        float y[8];
#pragma unroll
        for (int k = 0; k < 4; ++k) {
            const float w0l = k < 2 ? wa0[2 * k] : wa1[2 * k - 4], w0h = k < 2 ? wa0[2 * k + 1] : wa1[2 * k - 3];
            const float w1l = k < 2 ? wb0[2 * k] : wb1[2 * k - 4], w1h = k < 2 ? wb0[2 * k + 1] : wb1[2 * k - 3];
            const float w2l = k < 2 ? wc0[2 * k] : wc1[2 * k - 4], w2h = k < 2 ? wc0[2 * k + 1] : wc1[2 * k - 3];
            y[2 * k]     = bflo(sb[k]) * (w0l * (bflo(c0[k]) * bflo(h0[k])) + w1l * (bflo(c1[k]) * bflo(h1[k])) + w2l * (bflo(c2[k]) * bflo(h2[k])));
            y[2 * k + 1] = bfhi(sb[k]) * (w0h * (bfhi(c0[k]) * bfhi(h0[k])) + w1h * (bfhi(c1[k]) * bfhi(h1[k])) + w2h * (bfhi(c2[k]) * bfhi(h2[k]))); }
        u32x4 o; o.x = cvtpk(y[0], y[1]); o.y = cvtpk(y[2], y[3]); o.z = cvtpk(y[4], y[5]); o.w = cvtpk(y[6], y[7]);
        *(u32x4*)(ysc + (size_t)t * 512 + c8 * 8) = o;
    }
}

DI unsigned ord_key(float v, int idx) { unsigned u = __builtin_bit_cast(unsigned, v); u ^= (u >> 31) ? 0xFFFFFFFFu : 0x80000000u; return (u & 0xFFFFFF80u) | (unsigned)(127 - idx); }
DI float key_val(unsigned k) { unsigned u = k & 0xFFFFFF80u; u = (u & 0x80000000u) ? (u ^ 0x80000000u) : ~u; return __builtin_bit_cast(float, u); }
DI float dot2bf(unsigned a, unsigned b, float c) { return __builtin_amdgcn_fdot2_f32_bf16(__builtin_bit_cast(bf16x2_t, a), __builtin_bit_cast(bf16x2_t, b), c, false); }
DI float dot8(const u32x4& a, const u32x4& b, float c) { c = dot2bf(a.x, b.x, c); c = dot2bf(a.y, b.y, c); c = dot2bf(a.z, b.z, c); return dot2bf(a.w, b.w, c); }
__host__ __device__ constexpr int cand_off(int i) { return i == 0 ? 0 : i == 1 ? 16 : i == 2 ? 24 : i == 3 ? 29 : i == 4 ? 33 : i == 5 ? 36 : i == 6 ? 38 : i == 7 ? 40 : 34 + i; }
__host__ __device__ constexpr int cand_i(int c) { return c < 16 ? 0 : c < 24 ? 1 : c < 29 ? 2 : c < 33 ? 3 : c < 36 ? 4 : c < 38 ? 5 : c < 40 ? 6 : c < 42 ? 7 : c - 34; }
__host__ __device__ constexpr int cand_pos(int c) { return cand_i(c) * 16 + (c - cand_off(cand_i(c))); }

#define PEER_CE(i, j) do { const unsigned hi_ = max(k[i], k[j]), lo_ = min(k[i], k[j]); k[i] = hi_; k[j] = lo_; } while (0)
DI void peer_topk_first(const float* srow, LAS float* ssc, LAS int* six, int lane) {
    const int gq = lane >> 4, li = lane & 15;
    const float* sl = srow + (gq >> 1) * 256 + (gq & 1) * 128 + li * 8;
    f32x4 nva = *(const f32x4*)sl, nvb = *(const f32x4*)(sl + 4);
#pragma unroll 1
    for (int hp = 0; hp < 4; ++hp) {
        const f32x4 va = nva, vb = nvb;
        if (hp < 3) { nva = *(const f32x4*)(sl + 512 * (hp + 1)); nvb = *(const f32x4*)(sl + 512 * (hp + 1) + 4); }
        unsigned k[8];
        k[0] = ord_key(va.x, li * 8 + 0); k[1] = ord_key(va.y, li * 8 + 1); k[2] = ord_key(va.z, li * 8 + 2); k[3] = ord_key(va.w, li * 8 + 3);
        k[4] = ord_key(vb.x, li * 8 + 4); k[5] = ord_key(vb.y, li * 8 + 5); k[6] = ord_key(vb.z, li * 8 + 6); k[7] = ord_key(vb.w, li * 8 + 7);
        PEER_CE(0, 1); PEER_CE(2, 3); PEER_CE(4, 5); PEER_CE(6, 7); PEER_CE(0, 2); PEER_CE(1, 3); PEER_CE(4, 6); PEER_CE(5, 7); PEER_CE(1, 2); PEER_CE(5, 6);
        PEER_CE(0, 4); PEER_CE(1, 5); PEER_CE(2, 6); PEER_CE(3, 7); PEER_CE(2, 4); PEER_CE(3, 5); PEER_CE(1, 2); PEER_CE(3, 4); PEER_CE(5, 6);
        unsigned mine = 0u;
#pragma unroll
        for (int rd = 0; rd < 16; ++rd) {
            const unsigned m = row_max16(k[0]);
            mine = (li == rd) ? m : mine;
            const bool wn = (k[0] == m);
            k[0] = wn ? k[1] : k[0]; k[1] = wn ? k[2] : k[1]; k[2] = wn ? k[3] : k[2]; k[3] = wn ? k[4] : k[3];
            k[4] = wn ? k[5] : k[4]; k[5] = wn ? k[6] : k[5]; k[6] = wn ? k[7] : k[6]; k[7] = wn ? 0u : k[7];
        }
        const int o = ((2 * hp + (gq >> 1)) * 2 + (gq & 1)) * 16 + li;
        ssc[o] = key_val(mine); six[o] = 127 - (int)(mine & 127u);
    }
}
DI void peer_topk_second(const LAS float* ssc, const LAS int* six, LAS int* widx, LAS float* wgate, int lane, int emask, int hd_lo, int hd_hi) {
    const int ci = cand_i(lane), cj = lane - cand_off(ci); const bool cvalid = lane < 50;
    const int a16 = (lane ^ 16) << 2, a32 = (lane ^ 32) << 2;
#pragma unroll 2
    for (int hd = hd_lo; hd < hd_hi; ++hd) {
        const float a = ssc[(hd * 2) * 16 + ci], bq = ssc[(hd * 2 + 1) * 16 + cj];
        const int ia = six[(hd * 2) * 16 + ci], ib = six[(hd * 2 + 1) * 16 + cj];
        const float cs = a + bq;
        unsigned ck = __builtin_bit_cast(unsigned, cs); ck ^= (ck >> 31) ? 0xFFFFFFFFu : 0x80000000u; ck = cvalid ? ((ck & ~63u) | (unsigned)(63 - lane)) : 0u;
        int rank = 0;
#pragma unroll
        for (int c2 = 0; c2 < 50; ++c2) { const unsigned k2 = (unsigned)__builtin_amdgcn_readlane((int)ck, c2); rank += (int)(k2 > ck); }
        const bool sel = cvalid && rank < 16;
        const float mx = __builtin_bit_cast(float, __builtin_amdgcn_readlane(__builtin_bit_cast(int, cs), 0));
        const float ev = sel ? __builtin_amdgcn_exp2f((cs - mx) * 1.4426950408889634f) : 0.f;
        float sum = row_sum16(ev); sum += bperm_f(a16, sum); sum += bperm_f(a32, sum);
        if (sel) { widx[hd * 16 + rank] = ((ia * 128 + ib) & emask) * 512  ; wgate[hd * 16 + rank] = ev * __builtin_amdgcn_rcpf(sum); }
    }
}
#undef PEER_CE

constexpr float PEER_QSTEP = 0.35f;
constexpr float PEER_U_SCALE = 32.0f / PEER_QSTEP;
constexpr float PEER_UF4_SCALE = 64.0f;
constexpr float PEER_H4_SCALE = 2.0f;
#ifndef PROBE_SKIP
#define PROBE_SKIP 0
#endif
#define PSKIP(b) ((PROBE_SKIP >> (b)) & 1 && dry)
#ifndef PROBE_NODMA
#define PROBE_NODMA 0
#endif
#ifndef PROBE_EMASK
#define PROBE_EMASK 16383
#endif
#ifndef PEER_VARIANT
#define PEER_VARIANT 0
#endif
#ifndef PEER_R
#define PEER_R 16
#endif
#if PEER_R == 32
#define PEER_RM4 28
#elif PEER_R == 16
#define PEER_RM4 12
#elif PEER_R == 64
#define PEER_RM4 60
#endif
constexpr int PEER_NPROD = 2, PEER_NCONS = 8 - PEER_NPROD, PEER_CPP = PEER_NCONS / PEER_NPROD;
constexpr int PEER_NQ = 2 * PEER_NCONS;
#ifndef PEER_HP
#define PEER_HP 5
#endif
constexpr int PEER_SLOT_BYTES = 3072;
constexpr int PEER_FLAG_OFF = PEER_NQ * PEER_SLOT_BYTES, PEER_PRIV_OFF = PEER_FLAG_OFF + 64, PEER_PRIV_BYTES = 2560, PEER_RING_OFF = 53248;
static_assert(PEER_PRIV_OFF + PEER_NCONS * PEER_PRIV_BYTES <= PEER_RING_OFF && PEER_RING_OFF + PEER_NCONS * PEER_R * 1024 <= MISC_OFF && PEER_R <= 64 && (PEER_R & (PEER_R - 1)) == 0 && PEER_NCONS % PEER_NPROD == 0, "PEER LDS map");
DI void glds16(const void* gsrc, unsigned lds_dst) { unsigned keep;
    asm volatile("s_mov_b32 %0, m0\n\ts_mov_b32 m0, %2\n\ts_nop 0\n\tglobal_load_lds_dwordx4 %1, off\n\ts_mov_b32 m0, %0" : "=&s"(keep) : "v"(gsrc), "s"(lds_dst) : "memory"); }
DI void glds16s(const void* sbase, unsigned voff, unsigned lds_dst) { unsigned keep;
    asm volatile("s_mov_b32 %0, m0\n\ts_mov_b32 m0, %3\n\ts_nop 0\n\tglobal_load_lds_dwordx4 %1, %2\n\ts_mov_b32 m0, %0" : "=&s"(keep) : "v"(voff), "s"(sbase), "s"(lds_dst) : "memory"); }
DI void glds16s_x4(const void* sbase, unsigned v0, unsigned v1, unsigned v2, unsigned v3, unsigned lds_dst) { unsigned keep;
    asm volatile("s_mov_b32 %0, m0\n\ts_mov_b32 m0, %6\n\ts_nop 0\n\tglobal_load_lds_dwordx4 %1, %5\n\tglobal_load_lds_dwordx4 %2, %5 offset:1024\n\tglobal_load_lds_dwordx4 %3, %5 offset:2048\n\tglobal_load_lds_dwordx4 %4, %5 offset:3072\n\ts_mov_b32 m0, %0"
                 : "=&s"(keep) : "v"(v0), "v"(v1), "v"(v2), "v"(v3), "s"(sbase), "s"(lds_dst) : "memory"); }
#define PEER_STR2(x) #x
#define PEER_STR(x) PEER_STR2(x)
typedef int i32x4 __attribute__((ext_vector_type(4)));
typedef int i32x8 __attribute__((ext_vector_type(8)));
DI void peer_phase(Frame& F, int tg, bool dry) {
    F.refresh();
    __syncthreads();
    const int lane = F.lane, wv = F.wave;
    volatile LAS unsigned* flags = (volatile LAS unsigned*)(F.lds + PEER_FLAG_OFF);
    if (F.tid <= PEER_NQ) flags[F.tid] = 0u;
    __syncthreads();
    const int NPG = F.G * PEER_NPROD;
    if (wv < PEER_NPROD) {
        const int pg = F.vcu * PEER_NPROD + wv;
        int i = 0;
        for (int tl = pg; tl < TG; tl += NPG, ++i) {
            float tch0 = 0.f;
            if (tl + NPG < TG) tch0 = ((const float*)(F.ws + WS_S) + (size_t)(tl + NPG) * 2048)[lane * 32];
            const int q = PEER_NPROD * i + wv, slot = q % PEER_NQ;
            LAS float* ssc = (LAS float*)(F.lds + slot * PEER_SLOT_BYTES); LAS int* six = (LAS int*)(F.lds + slot * PEER_SLOT_BYTES + 1024);
            while (flags[slot] != 0u) __builtin_amdgcn_s_sleep(2);
            asm volatile("" ::: "memory");
            if (!PSKIP(0)) peer_topk_first((const float*)(F.ws + WS_S) + (size_t)tl * 2048, ssc, six, lane);
            if (PEER_HP > 0 && !PSKIP(1)) peer_topk_second(ssc, six, (LAS int*)(F.lds + slot * PEER_SLOT_BYTES + 2048), (LAS float*)(F.lds + slot * PEER_SLOT_BYTES + 2560), lane, dry ? PROBE_EMASK : 16383, 0, PEER_HP);
            asm volatile("s_waitcnt lgkmcnt(0)" :: "v"(tch0) : "memory");
            if (lane == 0) flags[slot] = (unsigned)q + 1u;
        }
    } else {
        const unsigned char* Ub = F.ws + WS_U; const unsigned char* Vb = F.ws + WS_V; const unsigned lo16 = 16u * (unsigned)(lane & 31);
        const int a16 = (lane ^ 16) << 2, a32 = (lane ^ 32) << 2; const int grp = lane >> 4;
        const int cidx = wv - PEER_NPROD;
        LAS int* sidx = (LAS int*)(F.lds + PEER_PRIV_OFF + cidx * PEER_PRIV_BYTES); LAS float* sgate = (LAS float*)(F.lds + PEER_PRIV_OFF + cidx * PEER_PRIV_BYTES + 512);
        LAS unsigned char* ring = F.lds + PEER_RING_OFF + cidx * (PEER_R * 1024);
        const unsigned ringb = (unsigned)(uintptr_t)ring;
        LAS unsigned char* hrow = F.lds + PEER_PRIV_OFF + cidx * PEER_PRIV_BYTES + 1536;
        unsigned usw[4];
#pragma unroll
        for (int q = 0; q < 4; ++q) usw[q] = 16u * (unsigned)((lane & 31) ^ (2 * q + (lane >> 5))) + (4096u - 1024u * q);
        const LAS unsigned char* uadr[4];
#pragma unroll
        for (int j = 0; j < 4; ++j) uadr[j] = ring + (lane & 15) * 512 + 64 * (j ^ ((lane & 15) >> 2)) + 16 * (grp ^ (lane & 3));
        const int NQTOK = PEER_NPROD * (TG / NPG);
        float gf[16];
#pragma unroll
        for (int cb = 0; cb < 16; ++cb) gf[cb] = F.final_norm_g[lane + 64 * cb];
#define PEER_TICKET(qv) do { int q_ = 0; if (lane == 0) q_ = (int)__hip_atomic_fetch_add((LAS unsigned*)(F.lds + PEER_FLAG_OFF) + PEER_NQ, 1u, __ATOMIC_RELAXED, __HIP_MEMORY_SCOPE_WORKGROUP); qv = __builtin_amdgcn_readfirstlane(q_); } while (0)
#define PEER_TOKEN(qv) ((size_t)tg * TG + (size_t)(F.vcu * PEER_NPROD + ((qv) % PEER_NPROD) + ((qv) / PEER_NPROD) * NPG))
#define PEER_PREFETCH(qv) do { if ((qv) < NQTOK) { const size_t tp_ = PEER_TOKEN(qv); pssp = ((const float*)(F.ws + WS_SSP) + tp_ * 16)[lane & 15]; \
                const bf16* xr_ = (const bf16*)(F.ws + WS_XG) + tp_ * 1024 + 16 * lane; pw0 = *(const u32x4*)xr_; pw1 = *(const u32x4*)(xr_ + 8); } } while (0)
        float pssp = 0.f; u32x4 pw0 = {0u, 0u, 0u, 0u}, pw1 = {0u, 0u, 0u, 0u};
        int q; PEER_TICKET(q); PEER_PREFETCH(q);
        for (;;) {
            if (q >= NQTOK) break;
            const int tl = F.vcu * PEER_NPROD + (q % PEER_NPROD) + (q / PEER_NPROD) * NPG;
            const size_t t = (size_t)tg * TG + tl;
            float tch1 = 0.f, tch2 = 0.f, tch3 = 0.f;
            if (q + PEER_NCONS < NQTOK) { const size_t tn = PEER_TOKEN(q + PEER_NCONS); tch1 = (F.out + tn * 1024)[(lane & 31) * 32];
                tch2 = ((const float*)((const bf16*)(F.ws + WS_XG) + tn * 1024))[(lane & 15) * 32]; tch3 = ((const float*)(F.ws + WS_SSP) + tn * 16)[lane & 15]; }
            const float hs = __builtin_amdgcn_rsqf(row_sum16(pssp) * (1.0f / 1024.0f) + EPS) * PEER_H4_SCALE;
            { const u32x4 w0 = pw0, w1 = pw1;
              u32x2 hq;
              hq.x = __builtin_amdgcn_cvt_scalef32_pk_fp4_f32(0u, bflo(w0[0]) * hs, bfhi(w0[0]) * hs, 1.0f, 0); hq.x = __builtin_amdgcn_cvt_scalef32_pk_fp4_f32(hq.x, bflo(w0[1]) * hs, bfhi(w0[1]) * hs, 1.0f, 1);
              hq.x = __builtin_amdgcn_cvt_scalef32_pk_fp4_f32(hq.x, bflo(w0[2]) * hs, bfhi(w0[2]) * hs, 1.0f, 2); hq.x = __builtin_amdgcn_cvt_scalef32_pk_fp4_f32(hq.x, bflo(w0[3]) * hs, bfhi(w0[3]) * hs, 1.0f, 3);
              hq.y = __builtin_amdgcn_cvt_scalef32_pk_fp4_f32(0u, bflo(w1[0]) * hs, bfhi(w1[0]) * hs, 1.0f, 0); hq.y = __builtin_amdgcn_cvt_scalef32_pk_fp4_f32(hq.y, bflo(w1[1]) * hs, bfhi(w1[1]) * hs, 1.0f, 1);
              hq.y = __builtin_amdgcn_cvt_scalef32_pk_fp4_f32(hq.y, bflo(w1[2]) * hs, bfhi(w1[2]) * hs, 1.0f, 2); hq.y = __builtin_amdgcn_cvt_scalef32_pk_fp4_f32(hq.y, bflo(w1[3]) * hs, bfhi(w1[3]) * hs, 1.0f, 3);
              *(LAS u32x2*)(hrow + 8 * lane) = hq; }
            const float ascale = 1.0f / (PEER_H4_SCALE * PEER_UF4_SCALE);
            const int slot = q % PEER_NQ;
            while (flags[slot] != (unsigned)q + 1u) __builtin_amdgcn_s_sleep(2);
            asm volatile("" ::: "memory");
            if (PEER_HP > 0) { if (lane < 16 * PEER_HP) { sidx[lane] = ((const LAS int*)(F.lds + slot * PEER_SLOT_BYTES + 2048))[lane]; sgate[lane] = ((const LAS float*)(F.lds + slot * PEER_SLOT_BYTES + 2560))[lane]; }
                if (PEER_HP > 4 && lane < 16 * PEER_HP - 64) { sidx[64 + lane] = ((const LAS int*)(F.lds + slot * PEER_SLOT_BYTES + 2048))[64 + lane]; sgate[64 + lane] = ((const LAS float*)(F.lds + slot * PEER_SLOT_BYTES + 2560))[64 + lane]; } }
            if (PEER_HP < 8 && !PSKIP(1)) peer_topk_second((const LAS float*)(F.lds + slot * PEER_SLOT_BYTES), (const LAS int*)(F.lds + slot * PEER_SLOT_BYTES + 1024), sidx, sgate, lane, dry ? PROBE_EMASK : 16383, PEER_HP, 8);
            asm volatile("s_waitcnt lgkmcnt(0)" ::: "memory");
            if (lane == 0) flags[slot] = 0u;
#define PEER_LOADIDX(tile) do { const LAS int* ip_ = sidx + 16 * (tile) + (lane >> 5); _Pragma("unroll") for (int j_ = 0; j_ < 8; ++j_) nx[j_] = (unsigned)ip_[2 * j_]; } while (0)
#define PEER_ISSUE8U(tile) do { if (PROBE_NODMA && dry) break; const unsigned rs_ = (unsigned)__builtin_amdgcn_readfirstlane((int)(ringb + (unsigned)((tile) & 1) * 8192u)); \
                glds16s_x4(Ub - 4096, nx[0] + usw[0], nx[1] + usw[1], nx[2] + usw[2], nx[3] + usw[3], rs_); \
                glds16s_x4(Ub - 4096, nx[4] + (usw[0] ^ 128u), nx[5] + (usw[1] ^ 128u), nx[6] + (usw[2] ^ 128u), nx[7] + (usw[3] ^ 128u), rs_ + 4096u); } while (0)
#define PEER_ISSUE8V(tile) do { if (PROBE_NODMA && dry) break; const unsigned rs_ = (unsigned)__builtin_amdgcn_readfirstlane((int)(ringb + (unsigned)((tile) & 1) * 8192u)); \
                glds16s_x4(Vb - 4096, nx[0] + lo16 + 4096u, nx[1] + lo16 + 3072u, nx[2] + lo16 + 2048u, nx[3] + lo16 + 1024u, rs_); \
                glds16s_x4(Vb - 4096, nx[4] + lo16 + 4096u, nx[5] + lo16 + 3072u, nx[6] + lo16 + 2048u, nx[7] + lo16 + 1024u, rs_ + 4096u); } while (0)
            unsigned nx[8];
            PEER_LOADIDX(0); PEER_ISSUE8U(0); PEER_LOADIDX(1); PEER_ISSUE8U(1); PEER_LOADIDX(2);
            i32x4 hA[8];
#pragma unroll
            for (int ks = 0; ks < 8; ++ks) hA[ks] = *(const LAS i32x4*)(hrow + 64 * ks + 16 * grp);
            float dotA = 0.f, dotB = 0.f;
#pragma unroll 1
            for (int tp = PSKIP(2) ? 4 : 0; tp < 4; ++tp) {
#pragma unroll
                for (int par = 0; par < 2; ++par) { const int tt = 2 * tp + par;
                    asm volatile("s_waitcnt vmcnt(8)" ::: "memory");
                    f32x4 acc = {0.f, 0.f, 0.f, 0.f};
#pragma unroll
                    for (int ks = 0; ks < 8; ++ks) { const i32x4 b_ = *(const LAS i32x4*)(uadr[ks & 3] + 256 * (ks >> 2) + 8192 * par);
                        const i32x8 b8_ = {b_.x, b_.y, b_.z, b_.w, 0, 0, 0, 0};
                        const i32x8 a8_ = {hA[ks].x, hA[ks].y, hA[ks].z, hA[ks].w, 0, 0, 0, 0};
                        acc = __builtin_amdgcn_mfma_scale_f32_16x16x128_f8f6f4(a8_, b8_, acc, 4  , 4  , 0, 127, 0, 127); }
                    dotA = (tt == grp) ? acc[0] : dotA; dotB = (tt == grp + 4) ? acc[0] : dotB;
                    __builtin_amdgcn_sched_barrier(0);
                    if (tp < 3) PEER_ISSUE8U(tt + 2); else PEER_ISSUE8V(tt + 2);
                    PEER_LOADIDX((tt + 3) & 7);
                    __builtin_amdgcn_sched_barrier(0); }
            }
            unsigned loA, hiA, loB, hiB; float bscA, bscB;
            { const float av = dotA * ascale, bv = dotB * ascale;
              const float cA = sgate[lane] * (0.5f * av * (1.0f + erff(av * 0.70710678118654752f))), cB = sgate[64 + lane] * (0.5f * bv * (1.0f + erff(bv * 0.70710678118654752f)));
              const float mxA = __builtin_bit_cast(float, row_max16(__builtin_bit_cast(unsigned, fabsf(cA)))), mxB = __builtin_bit_cast(float, row_max16(__builtin_bit_cast(unsigned, fabsf(cB))));
              const float qsA = mxA > 0.f ? 7.0f * __builtin_amdgcn_rcpf(mxA) : 0.f, qsB = mxB > 0.f ? 7.0f * __builtin_amdgcn_rcpf(mxB) : 0.f;
              const unsigned cqA = ((unsigned)(int)__builtin_rintf(cA * qsA) & 15u) << (4 * (lane & 7)), cqB = ((unsigned)(int)__builtin_rintf(cB * qsB) & 15u) << (4 * (lane & 7));
              loA = (lane & 8) ? 0u : cqA; hiA = (lane & 8) ? cqA : 0u; loB = (lane & 8) ? 0u : cqB; hiB = (lane & 8) ? cqB : 0u;
              loA |= dpp_u<0xB1>(loA); loA |= dpp_u<0x4E>(loA); loA |= dpp_u<0x141>(loA); loA |= dpp_u<0x140>(loA);
              hiA |= dpp_u<0xB1>(hiA); hiA |= dpp_u<0x4E>(hiA); hiA |= dpp_u<0x141>(hiA); hiA |= dpp_u<0x140>(hiA);
              loB |= dpp_u<0xB1>(loB); loB |= dpp_u<0x4E>(loB); loB |= dpp_u<0x141>(loB); loB |= dpp_u<0x140>(loB);
              hiB |= dpp_u<0xB1>(hiB); hiB |= dpp_u<0x4E>(hiB); hiB |= dpp_u<0x141>(hiB); hiB |= dpp_u<0x140>(hiB);
              bscA = mxA * (1.0f / 7.0f); bscB = mxB * (1.0f / 7.0f); }
            float* xo = F.out + t * 1024 + lane;
            float* xst = dry ? (float*)(F.ws + WS_PROJ + (128u << 20)) + (size_t)tl * 1024 + lane : xo;
            float xa[16];
#pragma unroll
            for (int cb = 0; cb < 16; ++cb) xa[cb] = xo[64 * cb];
            const bool early = q + 2 * PEER_NCONS < NQTOK;
            int qn = 0; if (early) { PEER_TICKET(qn); PEER_PREFETCH(qn); }
            float oacc[16];
#pragma unroll
            for (int cb = 0; cb < 16; ++cb) oacc[cb] = 0.f;
            typedef int i32x2 __attribute__((ext_vector_type(2)));
#pragma unroll 1
            for (int vb = PSKIP(3) ? 8 : 0; vb < 8; ++vb) {
                if (vb < 7) asm volatile("s_waitcnt vmcnt(8)" ::: "memory"); else asm volatile("s_waitcnt vmcnt(0)" ::: "memory");
                const int sl_ = 16 * (vb & 3);
                const int clo = __builtin_amdgcn_readlane((int)(vb < 4 ? loA : loB), sl_), chi = __builtin_amdgcn_readlane((int)(vb < 4 ? hiA : hiB), sl_);
                const float bsc = __builtin_bit_cast(float, __builtin_amdgcn_readlane(__builtin_bit_cast(int, vb < 4 ? bscA : bscB), sl_));
                const LAS unsigned char* rowp = ring + (16 * (vb & 1) + (lane & 15)) * 512 + 8 * (lane >> 4);
#pragma unroll
                for (int cb = 0; cb < 16; ++cb) {
                    const i32x2 tr = __builtin_amdgcn_ds_read_tr4_b64_v2i32((LAS i32x2*)(rowp + 32 * cb));
                    const int ai = __builtin_amdgcn_sdot8(chi, tr.y, __builtin_amdgcn_sdot8(clo, tr.x, 0, false), false);
                    oacc[cb] += (float)ai * bsc;
                }
                if (vb < 6) { PEER_ISSUE8V(vb + 2); PEER_LOADIDX((vb + 3) & 7); }
            }
#undef PEER_ISSUE8U
#undef PEER_ISSUE8V
#undef PEER_LOADIDX
            float ss = 0.f;
#pragma unroll
            for (int cb = 0; cb < 16; ++cb) { xa[cb] = xa[cb] + oacc[cb] * (1.0f / PEER_U_SCALE); ss += xa[cb] * xa[cb]; }
            ss = row_sum16(ss); ss += bperm_f(a16, ss); ss += bperm_f(a32, ss);
            const float rf = __builtin_amdgcn_rsqf(ss * (1.0f / 1024.0f) + EPS);
#pragma unroll
            for (int cb = 0; cb < 16; ++cb) xst[64 * cb] = xa[cb] * rf * gf[cb];
            asm volatile("" :: "v"(tch1), "v"(tch2), "v"(tch3));
            if (!early) { PEER_TICKET(qn); PEER_PREFETCH(qn); }
            q = qn;
        }
    }
}

DI void convert_uv(Frame& F, int part, int nparts, int cu, int ncu) {
    F.refresh();
    const int gt = cu * 512 + F.tid, NGT = ncu * 512, per = (2 * 16384 * 64) / nparts;
    for (int id = part * per + gt; id < (part + 1) * per; id += NGT) {
        const int which = id >> 20, off = (id & ((1 << 20) - 1)) * 16;
        const float* src = (which ? F.peer_v : F.peer_u) + off; unsigned char* dst = F.ws + (which ? WS_V : WS_U) + off / 2;
        u32x2 o;
        if (which == 0) {
#pragma unroll
            for (int q = 0; q < 2; ++q) { const f32x4 v0 = *(const f32x4*)(src + 8 * q) * PEER_UF4_SCALE, v1 = *(const f32x4*)(src + 8 * q + 4) * PEER_UF4_SCALE;
                unsigned pk = __builtin_amdgcn_cvt_scalef32_pk_fp4_f32(0u, v0.x, v0.y, 1.0f, 0); pk = __builtin_amdgcn_cvt_scalef32_pk_fp4_f32(pk, v0.z, v0.w, 1.0f, 1);
                pk = __builtin_amdgcn_cvt_scalef32_pk_fp4_f32(pk, v1.x, v1.y, 1.0f, 2); pk = __builtin_amdgcn_cvt_scalef32_pk_fp4_f32(pk, v1.z, v1.w, 1.0f, 3); o[q] = pk; }
        } else {
#pragma unroll
            for (int q = 0; q < 2; ++q) { const f32x4 v0 = *(const f32x4*)(src + 8 * q) * PEER_U_SCALE, v1 = *(const f32x4*)(src + 8 * q + 4) * PEER_U_SCALE; unsigned pk = 0u;
#pragma unroll
                for (int k = 0; k < 4; ++k) { pk |= ((unsigned)(int)__builtin_rintf(fminf(fmaxf(v0[k], -7.f), 7.f)) & 15u) << (4 * k); pk |= ((unsigned)(int)__builtin_rintf(fminf(fmaxf(v1[k], -7.f), 7.f)) & 15u) << (16 + 4 * k); }
                o[q] = pk; }
        }
        *(u32x2*)dst = o;
    }
}

constexpr int N_PHASES = 19;
struct Args { const float* in[17]; float* out; unsigned char* ws; int ph_lo, ph_hi; };

__global__ void __launch_bounds__(NWAVES * 64, 2) fwd_kernel(Args args) {
    extern __shared__ __attribute__((aligned(16))) unsigned char lds_raw[];
    Frame F;
    F.lds = (LAS unsigned char*)lds_raw;
    F.tid = threadIdx.x; F.lane = F.tid & 63; F.wave = __builtin_amdgcn_readfirstlane(F.tid >> 6);
    F.G = gridDim.x; { const int bx = blockIdx.x; F.vcu = (F.G % 8 == 0) ? (bx % 8) * (F.G / 8) + bx / 8 : bx; }
    F.x = args.in[0]; F.mem = args.in[1]; F.norm_mix_g = args.in[2]; F.w_in = args.in[3]; F.hg_lb = args.in[4]; F.hg_norm_g = args.in[5]; F.sc_conv_w = args.in[6];
    F.mem_norm_g = args.in[7]; F.w_mem_kv = args.in[8]; F.w_branch = args.in[9]; F.w_out = args.in[10]; F.norm_ffn_g = args.in[11]; F.peer_w_q = args.in[12];
    F.peer_sub_keys = args.in[13]; F.peer_u = args.in[14]; F.peer_v = args.in[15]; F.final_norm_g = args.in[16];
    F.out = args.out; F.ws = args.ws;
    volatile LAS unsigned* MISC = (volatile LAS unsigned*)(F.lds + MISC_OFF);
    for (int u = F.tid; u < (LDS_BYTES - MISC_OFF) / 4; u += NWAVES * 64) MISC[u] = 0u;
    __syncthreads();
    unsigned* barw = (unsigned*)(F.ws + WS_CTL) + CW_BAR;
    XcdBarrier bar; bar.bar = barw; bar.x = 0; bar.st = nullptr;
    const bool one_launch = (args.ph_hi - args.ph_lo) > 1;
    if (one_launch) bar = xcd_barrier_post(barw, MISC + 8);
    const int lo = args.ph_lo, hi = args.ph_hi;
#define IN(k) (lo <= (k) && (k) < hi)
#ifndef PMASK
#define PMASK 0x3ff
#endif
#define PC_(c) ((PMASK >> (c)) & 1)
#ifndef REP_MASK
#define REP_MASK 0
#endif
#define REPS(c) for (int rep_ = 0; rep_ < 1 + 2 * ((REP_MASK >> (c)) & 1); ++rep_)
#define SEAM(k) do { if (IN(k) && IN((k) + 1)) xcd_barrier(bar); } while (0)
    unsigned char* ws = F.ws;
    const int G = F.G, cid = (int)blockIdx.x;

    if (PC_(0) && IN(0)) { REPS(0) p0_prologue(F); } SEAM(0);

#pragma unroll 1
    for (int g = 0; g < NGRP; ++g) {
        const int pb = 1 + 6 * g;
        if (PC_(1) && IN(pb)) REPS(1) {
            pg8::InOrder S; S.init(TG, PC, G, cid); S.H = (const char*)(ws + WS_XG) + (size_t)g * TG * 1024 * 2; S.Win = (const char*)(ws + WS_WIN); S.Mn = (const char*)(ws + WS_MN); S.Wkv = (const char*)(ws + WS_WKV); S.n_extra = (g == 0) ? 64 : 0;
            pg8::EpiIn E{(bf16*)(ws + WS_PROJ), (bf16*)(ws + WS_KMEM), (bf16*)(ws + WS_VT)};
            pg8::gemm_phase<pg8::EpiIn, pg8::InOrder, true, true>(F.lds, pg8::Gemm{1024, 1024, 1024}, S, E);
            if (cid >= 128) convert_uv(F, g, NGRP, cid - 128, G - 128);
        } SEAM(pb);
        if (PC_(2) && IN(pb + 1)) REPS(2) {
            for (int it = F.vcu * 4; it < BG * 4 * NCHUNK; it += G * 4) { for (int k = 0; k < 4; ++k) hgrn_a_item(F, it + k, k < 3); }
            for (int it = F.vcu; it < BG * 4 * 8; it += G) attn_item(F, g, it);
            conv_phase(F);
        } SEAM(pb + 1);
        if (PC_(3) && IN(pb + 2)) { REPS(3) hgrn_scan(F); } SEAM(pb + 2);
        if (PC_(4) && IN(pb + 3)) REPS(4) { for (int it = F.vcu * 4; it < BG * 4 * NCHUNK; it += G * 4) { for (int k = 0; k < 4; ++k) hgrn_c_item(F, it + k, k < 3); } } SEAM(pb + 3);
        if (PC_(5) && IN(pb + 4)) REPS(5) {
            pg8::BranchOrder S; S.init(TG, 1024, G, cid); S.Y = (const char*)(ws + WS_YHG); S.Wb = (const char*)(ws + WS_WBR);
            pg8::EpiBranch E{(const bf16*)(ws + WS_PROJ), (bf16*)(ws + WS_MACC), (bf16*)(ws + WS_MERGED)};
            pg8::gemm_phase<pg8::EpiBranch, pg8::BranchOrder, true, true>(F.lds, pg8::Gemm{512, 512, 512}, S, E);
        } SEAM(pb + 4);
        if (PC_(6) && IN(pb + 5)) REPS(6) {
            pg8::PlainOrder S; S.init(TG, 1024, G, cid); S.A = (const char*)(ws + WS_MERGED); S.Bt = (const char*)(ws + WS_WOUT); S.a_tile = 256 * 1024 * 2; S.b_tile = 256 * 1024 * 2;
            pg8::EpiOut E{F.x + (size_t)g * TG * 1024, F.out + (size_t)g * TG * 1024, (bf16*)(ws + WS_XG) + (size_t)g * TG * 1024, F.norm_ffn_g, (float*)(ws + WS_SSP) + (size_t)g * TG * 16};
            pg8::gemm_phase<pg8::EpiOut, pg8::PlainOrder, true, true>(F.lds, pg8::Gemm{1024, 1024, 1024}, S, E);
        } SEAM(pb + 5);
    }
#pragma unroll 1
    for (int tg = 0; tg < NGRP; ++tg) {
        const int pb = 13 + 3 * tg;
        if (PC_(7) && IN(pb)) REPS(7) {
            pg8::PlainOrder S; S.init(TG, 2048, G, cid); S.A = (const char*)(ws + WS_XG) + (size_t)tg * TG * 1024 * 2; S.Bt = (const char*)(ws + WS_WQ); S.a_tile = 256 * 1024 * 2; S.b_tile = 256 * 1024 * 2;
            pg8::EpiQ E{(bf16*)(ws + WS_Q), 2048, (const float*)(ws + WS_SSP) + (size_t)tg * TG * 16};
            pg8::gemm_phase<pg8::EpiQ, pg8::PlainOrder, true, true>(F.lds, pg8::Gemm{1024, 1024, 1024}, S, E);
        } SEAM(pb);
        if (PC_(8) && IN(pb + 1)) REPS(8) {
            pg8::ScoreOrder S; S.init(TG, 2048, G, cid); S.Q = (const char*)(ws + WS_Q); S.Kbd = (const char*)(ws + WS_KBD);
            pg8::EpiF32 E{(float*)(ws + WS_S), 2048};
            pg8::gemm_phase<pg8::EpiF32, pg8::ScoreOrder, true, true>(F.lds, pg8::Gemm{2048, 256, 256}, S, E);
        } SEAM(pb + 1);
        if (PC_(9) && IN(pb + 2)) { REPS(9) peer_phase(F, tg, rep_ < 2 * ((REP_MASK >> 9) & 1)); } SEAM(pb + 2);
    }
#undef IN
#undef SEAM
}

extern "C" void kernel_launch(void* const* d_in, const int* in_sizes, int n_in, void* d_out, int out_size, void* d_ws, size_t ws_size, hipStream_t stream) {
    static int ready = 0;
    if (ready == 0) {
        if (n_in != 17 || out_size != T_ALL * D_MODEL || ws_size < WS_END) { fprintf(stderr, "kernel_launch: unexpected shapes (n_in %d, out %d, ws %zu)\n", n_in, out_size, ws_size); ready = -1; return; }
        if (hipFuncSetAttribute((const void*)fwd_kernel, hipFuncAttributeMaxDynamicSharedMemorySize, LDS_BYTES) != hipSuccess) { fprintf(stderr, "kernel_launch: hipFuncSetAttribute failed\n"); ready = -1; return; }
        ready = 1;
    }
    if (ready < 0) return;
    (void)hipMemsetAsync((char*)d_ws + WS_CTL, 0, CTL_ZERO_BYTES, stream);
    Args a{};
    for (int i = 0; i < 17; ++i) a.in[i] = (const float*)d_in[i];
    a.out = (float*)d_out; a.ws = (unsigned char*)d_ws;
    const int grid = 256;
#if MK_N_LAUNCHES == 1
    a.ph_lo = 0; a.ph_hi = N_PHASES;
    hipLaunchKernelGGL(fwd_kernel, dim3(grid), dim3(NWAVES * 64), LDS_BYTES, stream, a);
#else
    for (int li = 0; li < N_PHASES; ++li) { a.ph_lo = li; a.ph_hi = li + 1; hipLaunchKernelGGL(fwd_kernel, dim3(grid), dim3(NWAVES * 64), LDS_BYTES, stream, a); }
#endif
}
```

```cpp
#include <hip/hip_runtime.h>
#include <cstdio>
#include <cstdint>

#ifndef MK_N_LAUNCHES
#define MK_N_LAUNCHES 1
#endif

#define LAS __attribute__((address_space(3)))
#define GAS __attribute__((address_space(1)))
typedef unsigned short bf16;
typedef short bf16x8 __attribute__((ext_vector_type(8)));
typedef short s16x4 __attribute__((ext_vector_type(4)));
typedef short v4i16_t __attribute__((ext_vector_type(4)));
typedef float f32x2 __attribute__((ext_vector_type(2)));
typedef float f32x4 __attribute__((ext_vector_type(4)));
typedef float f32x16 __attribute__((ext_vector_type(16)));
typedef unsigned u32x2 __attribute__((ext_vector_type(2)));
typedef unsigned u32x4 __attribute__((ext_vector_type(4)));
typedef __bf16 bf16x2_t __attribute__((ext_vector_type(2)));
typedef GAS unsigned gu32;
#define RLX_AGENT __ATOMIC_RELAXED, __HIP_MEMORY_SCOPE_AGENT
#define DI __device__ __forceinline__

constexpr int D_MODEL = 1024, BATCH = 16, SEQ = 2048, T_ALL = BATCH * SEQ;
constexpr int NGRP = 2, BG = BATCH / NGRP, TG = BG * SEQ;
constexpr int PC = 7680;
constexpr int C_HQ = 0, C_HI = 512, C_FF = 1024, C_FB = 1536, C_HG = 2048, C_SB = 2560, C_SC = 3072, C_SH = 3584, C_MQ = 4096, C_GATE = 4608;
constexpr int NMEM = 256, CHUNK = 64, NCHUNK = SEQ / CHUNK;
constexpr float EPS = 1e-6f;

constexpr size_t MiB = 1u << 20;
constexpr size_t WS_CTL = 0, CTL_ZERO_BYTES = 1 * MiB;
constexpr size_t WS_LB = 1 * MiB;
constexpr size_t WS_SSP = 2 * MiB;
constexpr size_t WS_DEC = 4 * MiB;
constexpr size_t WS_WIN = 5 * MiB, WS_WKV = 20 * MiB, WS_WBR = 22 * MiB, WS_WOUT = 25 * MiB, WS_WQ = 27 * MiB, WS_KBD = 31 * MiB;
constexpr size_t WS_MN = 32 * MiB, WS_KMEM = 40 * MiB, WS_VT = 44 * MiB;
constexpr size_t WS_XG = 48 * MiB;
constexpr size_t WS_YHG = 112 * MiB, WS_YSC = 128 * MiB, WS_YMX = 144 * MiB;
constexpr size_t WS_DS = 160 * MiB;
constexpr size_t WS_MACC = 160 * MiB;
constexpr size_t WS_MERGED = 224 * MiB;
constexpr size_t WS_PROJ = 256 * MiB;
constexpr size_t WS_U = 496 * MiB, WS_V = 504 * MiB;
constexpr size_t WS_Q = 176 * MiB;
constexpr size_t WS_S = 256 * MiB;
constexpr size_t WS_END = 512 * MiB;
constexpr size_t OUT_SST = 64 * MiB;

constexpr int LDS_BYTES = 160 * 1024;
constexpr int MISC_OFF = LDS_BYTES - 512;
constexpr int NWAVES = 8;

DI unsigned f2bf(float f) { unsigned u = __builtin_bit_cast(unsigned, f); return (u + 0x7fffu + ((u >> 16) & 1u)) >> 16; }
DI unsigned pk2(float lo, float hi) { return f2bf(lo) | (f2bf(hi) << 16); }
DI float bf2f(unsigned short b) { return __builtin_bit_cast(float, (unsigned)b << 16); }
DI float bflo(unsigned w) { return __builtin_bit_cast(float, w << 16); }
DI float bfhi(unsigned w) { return __builtin_bit_cast(float, w & 0xffff0000u); }
DI float wave_sum(float v) {
#pragma unroll
    for (int o = 1; o < 64; o <<= 1) v += __shfl_xor(v, o);
    return v;
}
DI unsigned cvtpk(float lo, float hi) { f32x2 v = {lo, hi}; bf16x2_t b = __builtin_convertvector(v, bf16x2_t); return __builtin_bit_cast(unsigned, b); }
template <int CTRL> DI unsigned dpp_u(unsigned v) { return (unsigned)__builtin_amdgcn_update_dpp(0, (int)v, CTRL, 0xF, 0xF, false); }
template <int CTRL> DI float dpp_f(float v) { return __builtin_bit_cast(float, __builtin_amdgcn_update_dpp(0, __builtin_bit_cast(int, v), CTRL, 0xF, 0xF, false)); }
DI float bperm_f(int addr, float v) { return __builtin_bit_cast(float, __builtin_amdgcn_ds_bpermute(addr, __builtin_bit_cast(int, v))); }
DI unsigned row_max16(unsigned m) { m = max(m, dpp_u<0xB1>(m)); m = max(m, dpp_u<0x4E>(m)); m = max(m, dpp_u<0x141>(m)); return max(m, dpp_u<0x140>(m)); }
DI float row_sum16(float v) { v += dpp_f<0xB1>(v); v += dpp_f<0x4E>(v); v += dpp_f<0x141>(v); return v + dpp_f<0x140>(v); }

DI float fast_sig(float z) { return __builtin_amdgcn_rcpf(1.0f + __builtin_amdgcn_exp2f(-1.4426950408889634f * z)); }
DI float sigmoidf_(float z) { return 1.0f / (1.0f + __expf(-z)); }

namespace pg8 {
constexpr int BM = 256, BK = 64, HALF = 128, HTB = HALF * BK * 2, STAGE_BYTES = 8 * HTB, NXCD = 8, WGM = 8;
__host__ __device__ __forceinline__ int lds_byte(int r, int c) { const int st = (r >> 4) * 2 + (c >> 5), rr = r & 15, cc = c & 31, ob = rr * 64 + cc * 2; return st * 1024 + (ob ^ (((ob >> 9) & 1) << 5)); }
__host__ __device__ __forceinline__ void stage_rc(int b, int& R, int& C) { const int st = b / 1024, sb = b % 1024, swz = sb ^ (((sb >> 9) & 1) << 5); R = (st >> 1) * 16 + swz / 64; C = (st & 1) * 32 + (swz % 64) / 2; }
__host__ __device__ __forceinline__ int perm32(int rho) { const int n = rho >> 4, i = rho & 15; return 8 * (i >> 2) + 4 * n + (i & 3); }

struct Unit { int pm, pn, z; };
struct Gemm { int lda, ldb, K; };

struct StaticOrder {
    int nM, nN, nwg, G, c;
    __device__ void init(int M, int N, int G_, int c_) { nM = M / BM; nN = N / BM; nwg = nM * nN; G = G_; c = c_; }
    __device__ bool tile(int i, Unit& u) const {
        const long L = (long)i * G + c; if (L >= nwg) return false;
        int wgid = (int)L; { const int q = nwg / NXCD, r = nwg % NXCD, xcd = wgid % NXCD, off = wgid / NXCD; wgid = (xcd < r ? xcd * (q + 1) : r * (q + 1) + (xcd - r) * q) + off; }
        const int nig = WGM * nN, gid = wgid / nig, fm = gid * WGM, gsz = (nM - fm) < WGM ? (nM - fm) : WGM;
        u.pm = fm + ((wgid % nig) % gsz); u.pn = (wgid % nig) / gsz; u.z = 0; return true;
    }
};

DI unsigned cvt_pk_bf16(float lo, float hi) { return cvtpk(lo, hi); }

template <class Epi, class Sched, bool ALIGN_EPI, bool SP2>
DI void gemm_phase(LAS unsigned char* lds, const Gemm g, const Sched& S, const Epi& E) {
    int tid_ = threadIdx.x; asm volatile("" : "+v"(tid_));
    const int tid = tid_, wid = __builtin_amdgcn_readfirstlane(tid >> 6), lane = tid & 63, wr = wid >> 2, wc = wid & 3, fr = lane & 15, fq = lane >> 4;
    int K_ = g.K; asm volatile("" : "+s"(K_));
    const int K = K_, nt = K / BK;
    unsigned voffA[2], voffB[2];
#pragma unroll
    for (int i = 0; i < 2; ++i) { int R, C; stage_rc(tid * 16 + i * 8192, R, C); const int Rb = Epi::PERM ? ((R & ~31) + perm32(R & 31)) : R;
        voffA[i] = (unsigned)(R * g.lda + C) * 2u; voffB[i] = (unsigned)(Rb * g.ldb + C) * 2u; }
    const size_t kstep = (size_t)(BK * 2);
    const size_t hA = (size_t)HALF * g.lda * 2, hB = (size_t)HALF * g.ldb * 2;
    const unsigned ldsw = (unsigned)wid * 1024u;
    const int aoff = lds_byte(wr * 64 + fr, fq * 8), boff = lds_byte(wc * 32 + fr, fq * 8);
#define PG8_SA(b, h) (((b) * 2 + (h)) * HTB)
#define PG8_SB(b, h) ((4 + (b) * 2 + (h)) * HTB)
#define PG8_STAGE(bufoff, gbase, voff) do { _Pragma("unroll") for (int _i = 0; _i < 2; ++_i) \
        __builtin_amdgcn_global_load_lds((const unsigned*)((const char*)(gbase) + (voff)[_i]), (LAS unsigned*)(lds + (bufoff) + ldsw + _i * 8192), 16, 0, 0); } while (0)
#define PG8_LDA(dst, b, h) do { _Pragma("unroll") for (int m = 0; m < 4; ++m) _Pragma("unroll") for (int k = 0; k < 2; ++k) dst[m][k] = *(const LAS bf16x8*)(lds + PG8_SA(b, h) + aoff + m * 2048 + k * 1024); } while (0)
#define PG8_LDB(dst, b, h) do { _Pragma("unroll") for (int n = 0; n < 2; ++n) _Pragma("unroll") for (int k = 0; k < 2; ++k) dst[n][k] = *(const LAS bf16x8*)(lds + PG8_SB(b, h) + boff + n * 2048 + k * 1024); } while (0)
#define PG8_MMA(ai, bj, At, Bt) do { __builtin_amdgcn_s_setprio(1); _Pragma("unroll") for (int m = 0; m < 4; ++m) _Pragma("unroll") for (int n = 0; n < 2; ++n) _Pragma("unroll") for (int k = 0; k < 2; ++k) \
        acc[ai][bj][m][n] = __builtin_amdgcn_mfma_f32_16x16x32_bf16(Bt[n][k], At[m][k], acc[ai][bj][m][n], 0, 0, 0); __builtin_amdgcn_s_setprio(0); } while (0)
#define PG8_WAIT_V(n) asm volatile("s_waitcnt vmcnt(" #n ")" ::: "memory")
#define PG8_WAIT_L(n) asm volatile("s_waitcnt lgkmcnt(" #n ")" ::: "memory")
#define PG8_BAR __builtin_amdgcn_s_barrier()
#define PG8_SCHED __builtin_amdgcn_sched_barrier(0)
    Unit cur, nxt; int ui = 0;
    if (!S.next(0, cur)) return;
    f32x4 acc[2][2][4][2];
#pragma unroll
    for (int a = 0; a < 2; ++a)
#pragma unroll
        for (int b = 0; b < 2; ++b)
#pragma unroll
            for (int m = 0; m < 4; ++m)
#pragma unroll
                for (int n = 0; n < 2; ++n) acc[a][b][m][n] = (f32x4){0.f, 0.f, 0.f, 0.f};
    bf16x8 At[4][2], B0[2][2], B1[2][2];
    const char* cA = S.a_base(cur); const char* cB = S.b_base(cur);
    if constexpr (SP2) {
        PG8_STAGE(PG8_SB(0, 0), cB, voffB); PG8_STAGE(PG8_SB(0, 1), cB + hB, voffB); PG8_STAGE(PG8_SA(0, 0), cA, voffA); PG8_STAGE(PG8_SA(0, 1), cA + hA, voffA);
        if (wr == 1) PG8_BAR;
        PG8_WAIT_V(2); PG8_BAR;
        PG8_STAGE(PG8_SB(1, 0), cB + kstep, voffB); PG8_STAGE(PG8_SA(1, 0), cA + kstep, voffA); PG8_STAGE(PG8_SB(1, 1), cB + hB + kstep, voffB);
        PG8_WAIT_V(6); PG8_BAR;
    } else {
        PG8_STAGE(PG8_SB(0, 0), cB, voffB); PG8_STAGE(PG8_SA(0, 0), cA, voffA); PG8_STAGE(PG8_SB(0, 1), cB + hB, voffB); PG8_STAGE(PG8_SA(0, 1), cA + hA, voffA);
        if (wr == 1) PG8_BAR;
        PG8_WAIT_V(4); PG8_BAR;
        PG8_STAGE(PG8_SB(1, 0), cB + kstep, voffB); PG8_STAGE(PG8_SA(1, 0), cA + kstep, voffA); PG8_STAGE(PG8_SB(1, 1), cB + hB + kstep, voffB);
        PG8_WAIT_V(6); PG8_BAR;
    }
    for (;;) {
        const bool has_next = S.next(ui + 1, nxt);
        const char* nA = has_next ? S.a_base(nxt) : cA; const char* nB = has_next ? S.b_base(nxt) : cB;
        for (int t = 0; t < nt; t += 2) {
            const bool last = (t == nt - 2);
            const char* a1 = cA + (size_t)(t + 1) * kstep;
            const char* a2 = last ? nA : cA + (size_t)(t + 2) * kstep; const char* b2 = last ? nB : cB + (size_t)(t + 2) * kstep;
            const char* a3 = a2 + kstep; const char* b3 = b2 + kstep;
            if constexpr (SP2) {
            PG8_LDB(B0, 0, 0); PG8_LDB(B1, 0, 1); PG8_SCHED; PG8_LDA(At, 0, 0); PG8_STAGE(PG8_SA(1, 1), a1 + hA, voffA);
            PG8_WAIT_V(8); PG8_WAIT_L(0); PG8_BAR; PG8_MMA(0, 0, At, B0); PG8_MMA(0, 1, At, B1); PG8_BAR; PG8_SCHED;
            PG8_LDA(At, 0, 1); PG8_STAGE(PG8_SB(0, 0), b2, voffB); PG8_STAGE(PG8_SB(0, 1), b2 + hB, voffB); PG8_STAGE(PG8_SA(0, 0), a2, voffA);
            PG8_WAIT_V(8); PG8_WAIT_L(0); PG8_BAR; PG8_MMA(1, 0, At, B0); PG8_MMA(1, 1, At, B1); PG8_BAR; PG8_SCHED;
            PG8_LDB(B0, 1, 0); PG8_LDB(B1, 1, 1); PG8_SCHED; PG8_LDA(At, 1, 0); PG8_STAGE(PG8_SA(0, 1), a2 + hA, voffA);
            PG8_WAIT_V(8); PG8_WAIT_L(0); PG8_BAR; PG8_MMA(0, 0, At, B0); PG8_MMA(0, 1, At, B1); PG8_BAR; PG8_SCHED;
            PG8_LDA(At, 1, 1); PG8_STAGE(PG8_SB(1, 0), b3, voffB); PG8_STAGE(PG8_SB(1, 1), b3 + hB, voffB); PG8_STAGE(PG8_SA(1, 0), a3, voffA);
            PG8_WAIT_V(8); PG8_WAIT_L(0); PG8_BAR; PG8_MMA(1, 0, At, B0); PG8_MMA(1, 1, At, B1); PG8_BAR; PG8_SCHED;
            } else {
            PG8_LDB(B0, 0, 0); PG8_SCHED; PG8_LDA(At, 0, 0); PG8_STAGE(PG8_SA(1, 1), a1 + hA, voffA);
            PG8_WAIT_L(8); PG8_BAR; PG8_WAIT_L(0); PG8_MMA(0, 0, At, B0); PG8_BAR; PG8_SCHED;
            PG8_LDB(B1, 0, 1); PG8_STAGE(PG8_SB(0, 0), b2, voffB);
            PG8_BAR; PG8_WAIT_L(0); PG8_MMA(0, 1, At, B1); PG8_BAR;
            PG8_LDA(At, 0, 1); PG8_STAGE(PG8_SA(0, 0), a2, voffA);
            PG8_BAR; PG8_WAIT_L(0); PG8_MMA(1, 0, At, B0); PG8_BAR; PG8_SCHED;
            PG8_STAGE(PG8_SB(0, 1), b2 + hB, voffB);
            PG8_WAIT_V(6); PG8_BAR; PG8_MMA(1, 1, At, B1); PG8_BAR;
            PG8_LDB(B0, 1, 0); PG8_SCHED; PG8_LDA(At, 1, 0); PG8_STAGE(PG8_SA(0, 1), a2 + hA, voffA);
            PG8_WAIT_L(8); PG8_BAR; PG8_WAIT_L(0); PG8_MMA(0, 0, At, B0); PG8_BAR; PG8_SCHED;
            PG8_LDB(B1, 1, 1); PG8_STAGE(PG8_SB(1, 0), b3, voffB);
            PG8_BAR; PG8_WAIT_L(0); PG8_MMA(0, 1, At, B1); PG8_BAR;
            PG8_LDA(At, 1, 1); PG8_STAGE(PG8_SA(1, 0), a3, voffA);
            PG8_BAR; PG8_WAIT_L(0); PG8_MMA(1, 0, At, B0); PG8_BAR; PG8_SCHED;
            PG8_STAGE(PG8_SB(1, 1), b3 + hB, voffB);
            PG8_WAIT_V(6); PG8_BAR; PG8_MMA(1, 1, At, B1); PG8_BAR;
            }
        }
        if constexpr (ALIGN_EPI) { if (wr == 0) PG8_BAR; }
        E(acc, cur, wr, wc, fr, fq);
        if (!has_next) break;
#pragma unroll
        for (int a = 0; a < 2; ++a)
#pragma unroll
            for (int b = 0; b < 2; ++b)
#pragma unroll
                for (int m = 0; m < 4; ++m)
#pragma unroll
                    for (int n = 0; n < 2; ++n) acc[a][b][m][n] = (f32x4){0.f, 0.f, 0.f, 0.f};
        cur = nxt; cA = nA; cB = nB; ++ui;
        if constexpr (ALIGN_EPI) { if (wr == 1) PG8_BAR; }
    }
    PG8_WAIT_V(0);
    if constexpr (!ALIGN_EPI) { if (wr == 0) PG8_BAR; }
    PG8_BAR;
#undef PG8_SA
#undef PG8_SB
#undef PG8_STAGE
#undef PG8_LDA
#undef PG8_LDB
#undef PG8_MMA
#undef PG8_WAIT_V
#undef PG8_WAIT_L
#undef PG8_BAR
#undef PG8_SCHED
}
}

namespace pg8 {
struct PlainOrder : StaticOrder {
    const char* A; const char* Bt; size_t a_tile, b_tile;
    __device__ bool next(int i, Unit& u) const { return tile(i, u); }
    DI const char* a_base(const Unit& u) const { return A + (size_t)u.pm * a_tile; }
    DI const char* b_base(const Unit& u) const { return Bt + (size_t)u.pn * b_tile; }
};
struct InOrder : StaticOrder {
    const char* H; const char* Win; const char* Mn; const char* Wkv; int n_extra;
    __device__ bool next(int i, Unit& u) const {
        const long L = (long)i * G + c;
        if (L >= (long)nwg + n_extra) return false;
        Unit t; t.pm = 0; t.pn = 0; t.z = 0;
        const bool main_tile = L < nwg;
        if (main_tile) (void)tile(i, t);
        const int e = (int)(L - nwg);
        const int pm1 = e >> 1, pn1 = e & 1, pm2 = (e - 32) >> 4, pn2 = (e - 32) & 15; const bool k1 = e < 32;
        u.pm = main_tile ? t.pm : (k1 ? pm1 : pm2); u.pn = main_tile ? t.pn : (k1 ? pn1 : pn2); u.z = main_tile ? 0 : (k1 ? 1 : 2);
        return true;
    }
    DI const char* a_base(const Unit& u) const { const long d1 = Mn - H, d2 = (Wkv + (size_t)512 * 1024 * 2) - H; return H + ((u.z == 1) ? d1 : 0L) + ((u.z == 2) ? d2 : 0L) + (size_t)u.pm * (256 * 1024 * 2); }
    DI const char* b_base(const Unit& u) const { const long d1 = Wkv - Win, d2 = Mn - Win; return Win + ((u.z == 1) ? d1 : 0L) + ((u.z == 2) ? d2 : 0L) + (size_t)u.pn * (256 * 1024 * 2); }
};
struct EpiIn {
    static constexpr bool PERM = true;
    bf16* proj; bf16* kmem; bf16* vt;
    DI void operator()(const f32x4 (&acc)[2][2][4][2], const Unit& u, int wr, int wc, int fr, int fq) const {
        const long dk = kmem - proj, dv = vt - proj; bf16* O = proj + ((u.z == 1) ? dk : 0L) + ((u.z == 2) ? dv : 0L); const int ldc = PC + ((u.z == 1) ? 512 - PC : 0) + ((u.z == 2) ? BATCH * NMEM - PC : 0);
        const int row0 = u.pm * BM + wr * 64 + fr, col0 = u.pn * BM + wc * 32 + 8 * fq;
#pragma unroll
        for (int ai = 0; ai < 2; ++ai)
#pragma unroll
            for (int m = 0; m < 4; ++m) { bf16* rowp = O + (size_t)(row0 + ai * HALF + m * 16) * ldc + col0;
#pragma unroll
                for (int bj = 0; bj < 2; ++bj) { const f32x4 v0 = acc[ai][bj][m][0], v1 = acc[ai][bj][m][1];
                    u32x4 w; w.x = cvt_pk_bf16(v0[0], v0[1]); w.y = cvt_pk_bf16(v0[2], v0[3]); w.z = cvt_pk_bf16(v1[0], v1[1]); w.w = cvt_pk_bf16(v1[2], v1[3]);
                    *(u32x4*)(rowp + bj * HALF) = w; } }
    }
};
struct BranchOrder : StaticOrder {
    const char* Y; const char* Wb;
    __device__ bool next(int i, Unit& u) const { if (!tile(i / 3, u)) return false; u.z = i % 3; return true; }
    DI const char* a_base(const Unit& u) const { return Y + (size_t)u.z * (16 * MiB) + (size_t)u.pm * (256 * 512 * 2); }
    DI const char* b_base(const Unit& u) const { return Wb + (size_t)u.z * (1024 * 512 * 2) + (size_t)u.pn * (256 * 512 * 2); }
};
struct ScoreOrder : StaticOrder {
    const char* Q; const char* Kbd;
    __device__ bool next(int i, Unit& u) const { return tile(i, u); }
    DI const char* a_base(const Unit& u) const { return Q + (size_t)u.pm * (256 * 2048 * 2) + (size_t)u.pn * 512; }
    DI const char* b_base(const Unit& u) const { return Kbd + (size_t)u.pn * (256 * 256 * 2); }
};

struct EpiBf16 {
    static constexpr bool PERM = true;
    bf16* O; int ldc;
    DI void operator()(const f32x4 (&acc)[2][2][4][2], const Unit& u, int wr, int wc, int fr, int fq) const {
        const int row0 = u.pm * BM + wr * 64 + fr, col0 = u.pn * BM + wc * 32 + 8 * fq;
#pragma unroll
        for (int ai = 0; ai < 2; ++ai)
#pragma unroll
            for (int m = 0; m < 4; ++m) { bf16* rowp = O + (size_t)(row0 + ai * HALF + m * 16) * ldc + col0;
#pragma unroll
                for (int bj = 0; bj < 2; ++bj) { const f32x4 v0 = acc[ai][bj][m][0], v1 = acc[ai][bj][m][1];
                    u32x4 w; w.x = cvt_pk_bf16(v0[0], v0[1]); w.y = cvt_pk_bf16(v0[2], v0[3]); w.z = cvt_pk_bf16(v1[0], v1[1]); w.w = cvt_pk_bf16(v1[2], v1[3]);
                    *(u32x4*)(rowp + bj * HALF) = w; } }
    }
};
struct EpiQ {
    static constexpr bool PERM = true;
    bf16* O; int ldc; const float* ssp;
    DI void operator()(const f32x4 (&acc)[2][2][4][2], const Unit& u, int wr, int wc, int fr, int fq) const {
        const int row0 = u.pm * BM + wr * 64 + fr, col0 = u.pn * BM + wc * 32 + 8 * fq;
#pragma unroll
        for (int ai = 0; ai < 2; ++ai)
#pragma unroll
            for (int m = 0; m < 4; ++m) { const int row = row0 + ai * HALF + m * 16; const f32x4* sp = (const f32x4*)(ssp + (size_t)row * 16);
                const f32x4 s0 = sp[0], s1 = sp[1], s2 = sp[2], s3 = sp[3];
                const float ss = ((s0[0] + s0[1]) + (s0[2] + s0[3])) + ((s1[0] + s1[1]) + (s1[2] + s1[3])) + ((s2[0] + s2[1]) + (s2[2] + s2[3])) + ((s3[0] + s3[1]) + (s3[2] + s3[3]));
                const float rs = 1.0f / sqrtf(ss * (1.0f / 1024.0f) + EPS);
                bf16* rowp = O + (size_t)row * ldc + col0;
#pragma unroll
                for (int bj = 0; bj < 2; ++bj) { const f32x4 v0 = acc[ai][bj][m][0] * rs, v1 = acc[ai][bj][m][1] * rs;
                    u32x4 w; w.x = cvt_pk_bf16(v0[0], v0[1]); w.y = cvt_pk_bf16(v0[2], v0[3]); w.z = cvt_pk_bf16(v1[0], v1[1]); w.w = cvt_pk_bf16(v1[2], v1[3]);
                    *(u32x4*)(rowp + bj * HALF) = w; }
                asm volatile("" ::: "memory"); }
    }
};
struct EpiF32 {
    static constexpr bool PERM = false;
    float* C; int ldc;
    DI void operator()(const f32x4 (&acc)[2][2][4][2], const Unit& u, int wr, int wc, int fr, int fq) const {
        const int row0 = u.pm * BM + wr * 64 + fr, col0 = u.pn * BM + wc * 32 + 4 * fq;
#pragma unroll
        for (int ai = 0; ai < 2; ++ai)
#pragma unroll
            for (int m = 0; m < 4; ++m) { float* rowp = C + (size_t)(row0 + ai * HALF + m * 16) * ldc + col0;
#pragma unroll
                for (int bj = 0; bj < 2; ++bj)
#pragma unroll
                    for (int n = 0; n < 2; ++n) *(f32x4*)(rowp + bj * HALF + n * 16) = acc[ai][bj][m][n]; }
    }
};
struct EpiBranch {
    static constexpr bool PERM = true;
    const bf16* proj; bf16* gbuf; bf16* merged;
    DI void operator()(const f32x4 (&acc)[2][2][4][2], const Unit& u, int wr, int wc, int fr, int fq) const {
        const int row0 = u.pm * BM + wr * 64 + fr, col0 = u.pn * BM + wc * 32 + 8 * fq;
#pragma unroll
        for (int ai = 0; ai < 2; ++ai)
#pragma unroll
            for (int m = 0; m < 4; ++m) { const int row = row0 + ai * HALF + m * 16;
#pragma unroll
                for (int bj = 0; bj < 2; ++bj) { const int col = col0 + bj * HALF;
                    const u32x4 gw = *(const u32x4*)(proj + (size_t)row * PC + C_GATE + u.z * 1024 + col);
                    f32x4 v0 = acc[ai][bj][m][0], v1 = acc[ai][bj][m][1];
                    v0[0] *= fast_sig(bflo(gw.x)); v0[1] *= fast_sig(bfhi(gw.x)); v0[2] *= fast_sig(bflo(gw.y)); v0[3] *= fast_sig(bfhi(gw.y));
                    v1[0] *= fast_sig(bflo(gw.z)); v1[1] *= fast_sig(bfhi(gw.z)); v1[2] *= fast_sig(bflo(gw.w)); v1[3] *= fast_sig(bfhi(gw.w));
                    const size_t off = (size_t)row * 1024 + col;
                    if (u.z == 2) { const u32x4 p0 = *(const u32x4*)(gbuf + off), p1 = *(const u32x4*)(gbuf + (size_t)TG * 1024 + off);
                        v0[0] += bflo(p0.x) + bflo(p1.x); v0[1] += bfhi(p0.x) + bfhi(p1.x); v0[2] += bflo(p0.y) + bflo(p1.y); v0[3] += bfhi(p0.y) + bfhi(p1.y);
                        v1[0] += bflo(p0.z) + bflo(p1.z); v1[1] += bfhi(p0.z) + bfhi(p1.z); v1[2] += bflo(p0.w) + bflo(p1.w); v1[3] += bfhi(p0.w) + bfhi(p1.w); }
                    u32x4 w; w.x = cvt_pk_bf16(v0[0], v0[1]); w.y = cvt_pk_bf16(v0[2], v0[3]); w.z = cvt_pk_bf16(v1[0], v1[1]); w.w = cvt_pk_bf16(v1[2], v1[3]);
                    *(u32x4*)((u.z == 2 ? merged : gbuf + (size_t)u.z * TG * 1024) + off) = w; }
                asm volatile("" ::: "memory"); }
    }
};
struct EpiOut {
    static constexpr bool PERM = true;
    const float* x; float* x1; bf16* xg; const float* gffn; float* ssp;
    DI void operator()(const f32x4 (&acc)[2][2][4][2], const Unit& u, int wr, int wc, int fr, int fq) const {
        const int row0 = u.pm * BM + wr * 64 + fr, col0 = u.pn * BM + wc * 32 + 8 * fq;
        f32x4 g0[2], g1[2];
#pragma unroll
        for (int bj = 0; bj < 2; ++bj) { g0[bj] = *(const f32x4*)(gffn + col0 + bj * HALF); g1[bj] = *(const f32x4*)(gffn + col0 + bj * HALF + 4); }
#pragma unroll
        for (int ai = 0; ai < 2; ++ai)
#pragma unroll
            for (int m = 0; m < 4; ++m) { const int row = row0 + ai * HALF + m * 16; float ss = 0.f;
#pragma unroll
                for (int bj = 0; bj < 2; ++bj) { const size_t off = (size_t)row * 1024 + col0 + bj * HALF;
                    const f32x4 v0 = acc[ai][bj][m][0] + *(const f32x4*)(x + off), v1 = acc[ai][bj][m][1] + *(const f32x4*)(x + off + 4);
                    *(f32x4*)(x1 + off) = v0; *(f32x4*)(x1 + off + 4) = v1;
                    ss += (v0[0] * v0[0] + v0[1] * v0[1]) + (v0[2] * v0[2] + v0[3] * v0[3]) + (v1[0] * v1[0] + v1[1] * v1[1]) + (v1[2] * v1[2] + v1[3] * v1[3]);
                    const f32x4 a = v0 * g0[bj], b = v1 * g1[bj];
                    u32x4 w; w.x = cvt_pk_bf16(a[0], a[1]); w.y = cvt_pk_bf16(a[2], a[3]); w.z = cvt_pk_bf16(b[0], b[1]); w.w = cvt_pk_bf16(b[2], b[3]);
                    *(u32x4*)(xg + off) = w; }
                ss += __shfl_xor(ss, 16); ss += __shfl_xor(ss, 32);
                if (fq == 0) ssp[(size_t)row * 16 + u.pn * 4 + wc] = ss;
                asm volatile("" ::: "memory"); }
    }
};
}

#define XB_TMO      128
#define XB_XCNT(j)  (256  + 64 * (j))
#define XB_XSUB(j)  (1280 + 64 * (j))
#define XB_XGEN(j)  (2304 + 64 * (j))
#define XB_TOP      3328
#define XB_TOPGEN   3392
#define XCD_BAR_WORDS 3456
#define XB_SPIN_CAP (1u << 18)
constexpr int CW_BAR = 4096;

DI unsigned xb_ld(unsigned* p)              { return __hip_atomic_load(p, __ATOMIC_RELAXED, __HIP_MEMORY_SCOPE_AGENT); }
DI unsigned xb_add(unsigned* p, unsigned v) { return __hip_atomic_fetch_add(p, v, __ATOMIC_RELAXED, __HIP_MEMORY_SCOPE_AGENT); }
DI unsigned xb_xcc_id() { return (unsigned)__builtin_amdgcn_s_getreg((3 << 11) | 20) & 0xFu; }
#define XB_SPIN(cond, bar) do { unsigned _sp = 0; while (cond) { __builtin_amdgcn_s_sleep(1); \
    if ((++_sp & 255u) == 0u) { if (xb_ld(&(bar)[XB_TMO])) break; if (_sp > XB_SPIN_CAP) { atomicAdd(&(bar)[XB_TMO], 1u); break; } } } } while (0)

struct XcdBarrier { unsigned* bar; unsigned x; volatile LAS unsigned* st; };

DI XcdBarrier xcd_barrier_post(unsigned* bar, volatile LAS unsigned* st) {
    XcdBarrier b; b.bar = bar; b.x = xb_xcc_id(); b.st = st;
    if (threadIdx.x == 0) (void)xb_add(&bar[XB_XCNT(b.x)], 1u);
    return b;
}
DI void xcd_barrier_complete(unsigned* bar, unsigned x, unsigned& nloc, unsigned& nx) {
    const unsigned G = gridDim.x * gridDim.y * gridDim.z;
    unsigned sum, cnt, mine, sp = 0u;
    for (;;) {
        sum = 0u; cnt = 0u; mine = 0u;
#pragma unroll
        for (unsigned j = 0; j < 16; ++j) { const unsigned c = xb_ld(&bar[XB_XCNT(j)]); sum += c; cnt += (c > 0u) ? 1u : 0u; mine = (j == x) ? c : mine; }
        if (sum == G) break;
        __builtin_amdgcn_s_sleep(1);
        if ((++sp & 255u) == 0u) { if (xb_ld(&bar[XB_TMO])) break; if (sp > XB_SPIN_CAP) { atomicAdd(&bar[XB_TMO], 1u); break; } }
    }
    nloc = mine > 0u ? mine : 1u; nx = cnt > 0u ? cnt : 1u;
}
DI void xcd_barrier(const XcdBarrier& b) {
    asm volatile("s_waitcnt vmcnt(0)" ::: "memory");
    __syncthreads();
    if (threadIdx.x == 0) {
        unsigned* bar = b.bar;
        __builtin_amdgcn_s_waitcnt(0);
        unsigned nloc = b.st[0], nx = b.st[1];
        if (nloc == 0u) { xcd_barrier_complete(bar, b.x, nloc, nx); b.st[0] = nloc; b.st[1] = nx; }
        const unsigned old = xb_add(&bar[XB_XSUB(b.x)], 1u);
        const unsigned gen = old / nloc;
        if (old + 1u == (gen + 1u) * nloc) {
            __builtin_amdgcn_fence(__ATOMIC_RELEASE, "agent");
            asm volatile("s_waitcnt vmcnt(0)" ::: "memory");
            const unsigned og = xb_add(&bar[XB_TOP], 1u);
            const unsigned tg = og / nx;
            if (og + 1u == (tg + 1u) * nx) xb_add(&bar[XB_TOPGEN], 1u);
            else XB_SPIN(xb_ld(&bar[XB_TOPGEN]) == tg, bar);
            __builtin_amdgcn_fence(__ATOMIC_ACQUIRE, "agent");
            xb_add(&bar[XB_XGEN(b.x)], 1u);
            asm volatile("s_waitcnt vmcnt(0)" ::: "memory");
        } else {
            XB_SPIN(xb_ld(&bar[XB_XGEN(b.x)]) == gen, bar);
            __builtin_amdgcn_fence(__ATOMIC_ACQUIRE, "agent");
            asm volatile("s_waitcnt vmcnt(0)" ::: "memory");
        }
    }
    __syncthreads();
}

struct Frame {
    LAS unsigned char* lds;
    int tid, lane, wave;
    DI void refresh() { int t = threadIdx.x; asm volatile("" : "+v"(t)); tid = t; lane = t & 63; wave = __builtin_amdgcn_readfirstlane(t >> 6); }
    int vcu, G;
    const float *x, *mem, *norm_mix_g, *w_in, *hg_lb, *hg_norm_g, *sc_conv_w, *mem_norm_g, *w_mem_kv, *w_branch, *w_out, *norm_ffn_g, *peer_w_q, *peer_sub_keys, *peer_u, *peer_v, *final_norm_g;
    float* out; unsigned char* ws;
};

DI void p0_transpose_item(const float* W, int K, int N, bf16* WT, LAS float* scr, int item, int lane) {
    const int nblk = N / 32, kb = item / nblk, nb = item % nblk, k0 = 64 * kb, n0 = 32 * nb;
#pragma unroll 8
    for (int i = 0; i < 32; ++i) { const int kk = 2 * i + (lane >> 5); scr[kk * 33 + (lane & 31)] = W[(size_t)(k0 + kk) * N + n0 + (lane & 31)]; }
    asm volatile("s_waitcnt lgkmcnt(0)" ::: "memory");
    const int c = lane & 7;
#pragma unroll
    for (int j = 0; j < 4; ++j) { const int n = (lane >> 3) + 8 * j; const LAS float* s = scr + (8 * c) * 33 + n;
        u32x4 o; o.x = pk2(s[0 * 33], s[1 * 33]); o.y = pk2(s[2 * 33], s[3 * 33]); o.z = pk2(s[4 * 33], s[5 * 33]); o.w = pk2(s[6 * 33], s[7 * 33]);
        *(u32x4*)(WT + (size_t)(n0 + n) * K + k0 + 8 * c) = o; }
    asm volatile("s_waitcnt lgkmcnt(0)" ::: "memory");
}
DI void rms_row_to_bf16(const float* xrow, const float* g, bf16* orow, int lane) {
    const f32x4* xr = (const f32x4*)xrow + lane; const f32x4* gr = (const f32x4*)g + lane;
    f32x4 v[4]; float s = 0.f;
#pragma unroll
    for (int j = 0; j < 4; ++j) { v[j] = xr[64 * j]; s += (v[j].x * v[j].x + v[j].y * v[j].y) + (v[j].z * v[j].z + v[j].w * v[j].w); }
    const float rstd = 1.0f / sqrtf(wave_sum(s) * (1.f / 1024.f) + EPS);
    unsigned long long* o8 = (unsigned long long*)orow + lane;
#pragma unroll
    for (int j = 0; j < 4; ++j) { const f32x4 gg = gr[64 * j]; const f32x4 y = v[j] * rstd * gg;
        o8[64 * j] = (unsigned long long)pk2(y.x, y.y) | ((unsigned long long)pk2(y.z, y.w) << 32); }
}
DI void p0_prologue(Frame& F) {
    F.refresh();
    LAS float* scr = (LAS float*)(F.lds + F.wave * 16384);
    const int gw = F.vcu * NWAVES + F.wave, NGW = F.G * NWAVES;
    unsigned char* ws = F.ws;
    constexpr int I_IN = (1024 / 64) * (PC / 32), I_KV = (1024 / 64) * (1024 / 32), I_BR = (512 / 64) * (1024 / 32), I_OUT = (1024 / 64) * (1024 / 32), I_Q = (1024 / 64) * (2048 / 32);
    constexpr int NITEMS = I_IN + I_KV + 3 * I_BR + I_OUT + I_Q;
    for (int it = gw; it < NITEMS; it += NGW) {
        int r = it;
        if (r < I_IN) { p0_transpose_item(F.w_in, 1024, PC, (bf16*)(ws + WS_WIN), scr, r, F.lane); continue; } r -= I_IN;
        if (r < I_KV) { p0_transpose_item(F.w_mem_kv, 1024, 1024, (bf16*)(ws + WS_WKV), scr, r, F.lane); continue; } r -= I_KV;
        if (r < 3 * I_BR) { const int n = r / I_BR; p0_transpose_item(F.w_branch + (size_t)n * 512 * 1024, 512, 1024, (bf16*)(ws + WS_WBR) + (size_t)n * 1024 * 512, scr, r % I_BR, F.lane); continue; } r -= 3 * I_BR;
        if (r < I_OUT) { p0_transpose_item(F.w_out, 1024, 1024, (bf16*)(ws + WS_WOUT), scr, r, F.lane); continue; } r -= I_OUT;
        p0_transpose_item(F.peer_w_q, 1024, 2048, (bf16*)(ws + WS_WQ), scr, r, F.lane);
    }
    const int gt = F.vcu * 512 + F.tid, NGT = F.G * 512;
    for (int it = gt; it < 8 * 256 * 32; it += NGT) {
        const int c8 = it & 31, row = (it >> 5) & 255, h = it >> 13, p = row >> 7, key = row & 127;
        u32x4 o = (u32x4){0u, 0u, 0u, 0u};
        if ((c8 >> 4) == p) { const float* s = F.peer_sub_keys + (((size_t)(h * 2 + p) * 128 + key) * 128 + (c8 & 15) * 8);
            const f32x4 a = *(const f32x4*)s, b = *(const f32x4*)(s + 4); o.x = pk2(a.x, a.y); o.y = pk2(a.z, a.w); o.z = pk2(b.x, b.y); o.w = pk2(b.z, b.w); }
        *(u32x4*)((bf16*)(ws + WS_KBD) + ((size_t)(h * 256 + row) * 256 + c8 * 8)) = o;
    }
    for (int it = gt; it < 1024; it += NGT) { const float a0 = F.hg_lb[it], a1 = F.hg_lb[1024 + it]; const float m = fmaxf(a0, a1); const float e0 = __expf(a0 - m), e1 = __expf(a1 - m);
        ((float*)(ws + WS_LB))[it] = e0 / (e0 + e1); }
    for (int m = gw; m < BATCH * NMEM; m += NGW) rms_row_to_bf16(F.mem + (size_t)m * 1024, F.mem_norm_g, (bf16*)(ws + WS_MN) + (size_t)m * 1024, F.lane);
    for (int m = gw; m < T_ALL; m += NGW) rms_row_to_bf16(F.x + (size_t)m * 1024, F.norm_mix_g, (bf16*)(ws + WS_XG) + (size_t)m * 1024, F.lane);
}

DI s16x4 tr16(const LAS unsigned char* p) { return __builtin_bit_cast(s16x4, __builtin_amdgcn_ds_read_tr16_b64_v4i16((LAS v4i16_t*)p)); }
DI bf16x8 cat8(s16x4 lo, s16x4 hi) { return __builtin_shufflevector(lo, hi, 0, 1, 2, 3, 4, 5, 6, 7); }
#define MFMA32(a, b, c) __builtin_amdgcn_mfma_f32_32x32x16_bf16((a), (b), (c), 0, 0, 0)
DI int crow(int reg, int h) { return (reg & 3) + 8 * (reg >> 2) + 4 * h; }
DI bf16x8 pack8(const f32x16& x, int s) {
    u32x4 p; p.x = cvtpk(x[8 * s], x[8 * s + 1]); p.y = cvtpk(x[8 * s + 2], x[8 * s + 3]); p.z = cvtpk(x[8 * s + 4], x[8 * s + 5]); p.w = cvtpk(x[8 * s + 6], x[8 * s + 7]);
    return __builtin_bit_cast(bf16x8, p);
}
constexpr int TS = 272;

DI void stage_tile(LAS unsigned char* tile, const bf16* src, int tid) {
#pragma unroll
    for (int i = 0; i < 2; ++i) { const int id = tid + 512 * i, c = id >> 4, ch = id & 15;
        *(LAS u32x4*)(tile + c * TS + ch * 16) = *(const u32x4*)(src + (size_t)c * PC + ch * 8); }
}
DI float touch_tile(const bf16* src, int i128) { return *(const float*)(src + (size_t)(i128 >> 1) * PC + (i128 & 1) * 64); }
DI void gate8(const LAS unsigned char* zt, int dp, int ts, f32x2 lb, f32x2 (&L)[8], f32x2 (&kk)[8], f32x2 (&lf)[8]) {
    f32x2 run = (f32x2){0.f, 0.f}; const f32x2 oml = 1.0f - lb;
#pragma unroll
    for (int i = 0; i < 8; ++i) { const unsigned w = *(const LAS unsigned*)(zt + (8 * ts + i) * TS + 4 * dp);
        const f32x2 sg = (f32x2){fast_sig(bflo(w)), fast_sig(bfhi(w))}; const f32x2 f = lb + oml * sg;
        lf[i] = (f32x2){__builtin_amdgcn_logf(f.x), __builtin_amdgcn_logf(f.y)}; kk[i] = oml * (1.0f - sg); run += lf[i]; L[i] = run; }
}
DI f32x2 exp2x2(f32x2 v) { return (f32x2){__builtin_amdgcn_exp2f(v.x), __builtin_amdgcn_exp2f(v.y)}; }
struct SliceSums { f32x2 offf, offb, glf, glb, greff, grefb; };
DI SliceSums slice_sums(const LAS float* tot, int dp, int ts) {
    SliceSums r; f32x2 tf[8], tb[8];
#pragma unroll
    for (int j = 0; j < 8; ++j) { tf[j] = *(const LAS f32x2*)(tot + j * 128 + 2 * dp); tb[j] = *(const LAS f32x2*)(tot + (8 + j) * 128 + 2 * dp); }
    r.offf = (f32x2){0.f, 0.f}; r.offb = (f32x2){0.f, 0.f};
#pragma unroll
    for (int j = 0; j < 8; ++j) { if (j < ts) r.offf += tf[j]; if (j > ts) r.offb += tb[j]; }
    r.greff = (tf[0] + tf[1]) + (tf[2] + tf[3]); r.glf = r.greff + ((tf[4] + tf[5]) + (tf[6] + tf[7]));
    r.grefb = (tb[4] + tb[5]) + (tb[6] + tb[7]); r.glb = r.grefb + ((tb[0] + tb[1]) + (tb[2] + tb[3]));
    return r;
}

DI void hgrn_a_item(Frame& F, int item, bool has_next) {
    F.refresh();
    constexpr int T_V = 0, T_KF = 17408, T_KB = 34816, TOT = 52224;
    LAS unsigned char* lds = F.lds;
    const int n = item & 31, h = (item >> 5) & 3, b = item >> 7;
    const bf16* proj = (const bf16*)(F.ws + WS_PROJ) + ((size_t)b * SEQ + n * CHUNK) * PC;
    const int tid = F.tid, dp = tid & 63, ts = F.wave;
    const float* lbp = (const float*)(F.ws + WS_LB);
    const f32x2 lbf = *(const f32x2*)(lbp + h * 128 + 2 * dp), lbb = *(const f32x2*)(lbp + 512 + h * 128 + 2 * dp);
    stage_tile(lds + T_V, proj + C_HI + h * 128, tid); stage_tile(lds + T_KF, proj + C_FF + h * 128, tid); stage_tile(lds + T_KB, proj + C_FB + h * 128, tid);
    float tch = 0.f;
    if (has_next) { const bf16* pn = proj + (size_t)CHUNK * PC + h * 128; const int i128 = tid & 127, wsel = tid >> 7; tch = touch_tile(pn + (wsel == 0 ? C_HI : wsel == 1 ? C_FF : C_FB), i128); }
    __syncthreads();
    f32x2 Lf[8], kf[8], lff[8], Lb[8], kb[8], lfb[8];
    gate8(lds + T_KF, dp, ts, lbf, Lf, kf, lff);
    gate8(lds + T_KB, dp, ts, lbb, Lb, kb, lfb);
    LAS float* tot = (LAS float*)(lds + TOT);
    *(LAS f32x2*)(tot + ts * 128 + 2 * dp) = Lf[7]; *(LAS f32x2*)(tot + (8 + ts) * 128 + 2 * dp) = Lb[7];
    asm volatile("" :: "v"(tch));
    __syncthreads();
    const SliceSums ss = slice_sums(tot, dp, ts);
    const f32x2 tbq = Lb[7];
#pragma unroll
    for (int i = 0; i < 8; ++i) { const int c = 8 * ts + i;
        const f32x2 G = ss.offf + Lf[i]; const f32x2 kd = kf[i] * exp2x2(ss.glf - G);
        const f32x2 Gb = ss.offb + (tbq - Lb[i] + lfb[i]); const f32x2 kdb = kb[i] * exp2x2(ss.glb - Gb);
        *(LAS unsigned*)(lds + T_KF + c * TS + 4 * dp) = cvtpk(kd.x, kd.y); *(LAS unsigned*)(lds + T_KB + c * TS + 4 * dp) = cvtpk(kdb.x, kdb.y); }
    if (ts == 0) { float* dec = (float*)(F.ws + WS_DEC) + (size_t)item * 256; *(f32x2*)(dec + 2 * dp) = exp2x2(ss.glf); *(f32x2*)(dec + 128 + 2 * dp) = exp2x2(ss.glb); }
    __syncthreads();
    const int w = F.wave, lane = F.lane, r = lane & 31, hh = lane >> 5, blk = (lane >> 4) & 1, q = (lane & 15) >> 2, p = lane & 3;
    const int dt = w >> 1, et0 = (w & 1) * 2;
#pragma unroll
    for (int dir = 0; dir < 2; ++dir) { const int TK = dir ? T_KB : T_KF;
#pragma unroll
        for (int e2 = 0; e2 < 2; ++e2) { const int et = et0 + e2; f32x16 acc;
#pragma unroll
            for (int i = 0; i < 16; ++i) acc[i] = 0.f;
#pragma unroll
            for (int ks = 0; ks < 4; ++ks) {
                const LAS unsigned char* ap = lds + TK + (16 * ks + 8 * hh + q) * TS + (32 * dt + 16 * blk + 4 * p) * 2;
                const LAS unsigned char* bp = lds + T_V + (16 * ks + 8 * hh + q) * TS + (32 * et + 16 * blk + 4 * p) * 2;
                const bf16x8 a = cat8(tr16(ap), tr16(ap + 4 * TS)), bq = cat8(tr16(bp), tr16(bp + 4 * TS));
                acc = MFMA32(a, bq, acc); }
            bf16* dsb = (bf16*)(F.ws + WS_DS) + ((size_t)(item * 2 + dir) * 128 + 32 * et + r) * 128 + 32 * dt + 4 * hh;
#pragma unroll
            for (int g4 = 0; g4 < 4; ++g4) { u32x2 wv; wv.x = cvtpk(acc[4 * g4], acc[4 * g4 + 1]); wv.y = cvtpk(acc[4 * g4 + 2], acc[4 * g4 + 3]); *(u32x2*)(dsb + 8 * g4) = wv; } } }
    __syncthreads();
}

DI void hgrn_scan(Frame& F) {
    F.refresh();
    const bf16* dS = (const bf16*)(F.ws + WS_DS); bf16* Sst = (bf16*)((unsigned char*)F.out + OUT_SST); const float* dec = (const float*)(F.ws + WS_DEC);
    const int gt = F.vcu * 512 + F.tid, NGT = F.G * 512;
    for (int id = gt; id < BG * 4 * 2 * 128 * 32; id += NGT) {
        const int d4 = id & 31, e = (id >> 5) & 127, dir = (id >> 12) & 1, bh = id >> 13;
        f32x4 S = (f32x4){0.f, 0.f, 0.f, 0.f};
#pragma unroll 4
        for (int s = 0; s < 32; ++s) { const int n = dir ? 31 - s : s, item = bh * 32 + n;
            const size_t off = ((size_t)(item * 2 + dir) * 128 + e) * 128 + d4 * 4;
            u32x2 o; o.x = cvtpk(S.x, S.y); o.y = cvtpk(S.z, S.w); *(u32x2*)(Sst + off) = o;
            const f32x4 dc = *(const f32x4*)(dec + (size_t)(item * 2 + dir) * 128 + d4 * 4);
            const u32x2 wv = *(const u32x2*)(dS + off);
            S.x = dc.x * S.x + bflo(wv.x); S.y = dc.y * S.y + bfhi(wv.x); S.z = dc.z * S.z + bflo(wv.y); S.w = dc.w * S.w + bfhi(wv.y); }
    }
}

DI void hgrn_c_item(Frame& F, int item, bool has_next) {
    F.refresh();
    constexpr int T_QRF = 0, T_KRF = 17408, T_QGF = 34816, T_QRB = 52224, T_KRB = 69632, T_QGB = 87040, T_V = 104448, TOT = 121856, O_OFF = 0, OS = 132;
    LAS unsigned char* lds = F.lds;
    const int n = item & 31, h = (item >> 5) & 3, b = item >> 7;
    const size_t row0 = (size_t)b * SEQ + n * CHUNK;
    const bf16* proj = (const bf16*)(F.ws + WS_PROJ) + row0 * PC;
    const int tid = F.tid, dp = tid & 63, ts = F.wave;
    const float* lbp = (const float*)(F.ws + WS_LB);
    const f32x2 lbf = *(const f32x2*)(lbp + h * 128 + 2 * dp), lbb = *(const f32x2*)(lbp + 512 + h * 128 + 2 * dp);
    stage_tile(lds + T_V, proj + C_HI + h * 128, tid); stage_tile(lds + T_KRF, proj + C_FF + h * 128, tid); stage_tile(lds + T_KRB, proj + C_FB + h * 128, tid); stage_tile(lds + T_QRF, proj + C_HQ + h * 128, tid);
    float tch = 0.f, tch2 = 0.f;
    if (has_next) { const bf16* pn = proj + (size_t)CHUNK * PC + h * 128; const int i128 = tid & 127, wsel = tid >> 7; tch = touch_tile(pn + (wsel == 0 ? C_HI : wsel == 1 ? C_FF : wsel == 2 ? C_FB : C_HQ), i128);
        tch2 = *(const float*)((const unsigned char*)F.out + OUT_SST + (size_t)(item + 1) * 65536 + (size_t)tid * 128); }
    __syncthreads();
    f32x2 qv[8];
#pragma unroll
    for (int i = 0; i < 8; ++i) { const unsigned w = *(const LAS unsigned*)(lds + T_QRF + (8 * ts + i) * TS + 4 * dp); const float z0 = bflo(w), z1 = bfhi(w); qv[i] = (f32x2){z0 * fast_sig(z0), z1 * fast_sig(z1)}; }
    f32x2 Lf[8], kf[8], lff[8], Lb[8], kb[8], lfb[8];
    gate8(lds + T_KRF, dp, ts, lbf, Lf, kf, lff);
    gate8(lds + T_KRB, dp, ts, lbb, Lb, kb, lfb);
    LAS float* tot = (LAS float*)(lds + TOT);
    *(LAS f32x2*)(tot + ts * 128 + 2 * dp) = Lf[7]; *(LAS f32x2*)(tot + (8 + ts) * 128 + 2 * dp) = Lb[7];
    asm volatile("" :: "v"(tch), "v"(tch2));
    __syncthreads();
    {
        const SliceSums ss = slice_sums(tot, dp, ts);
        const f32x2 tbq = Lb[7];
#pragma unroll
        for (int i = 0; i < 8; ++i) { const int c = 8 * ts + i; const int o = c * TS + 4 * dp;
            const f32x2 G = ss.offf + Lf[i]; const f32x2 x = G - ss.greff;
            const f32x2 qr = qv[i] * exp2x2(x), kr = kf[i] * exp2x2(-x), qg = qv[i] * exp2x2(G);
            *(LAS unsigned*)(lds + T_QRF + o) = cvtpk(qr.x, qr.y); *(LAS unsigned*)(lds + T_KRF + o) = cvtpk(kr.x, kr.y); *(LAS unsigned*)(lds + T_QGF + o) = cvtpk(qg.x, qg.y);
            const f32x2 Gb = ss.offb + (tbq - Lb[i] + lfb[i]); const f32x2 xb = Gb - ss.grefb;
            const f32x2 qrb = qv[i] * exp2x2(xb), krb = kb[i] * exp2x2(-xb), qgb = qv[i] * exp2x2(Gb);
            *(LAS unsigned*)(lds + T_QRB + o) = cvtpk(qrb.x, qrb.y); *(LAS unsigned*)(lds + T_KRB + o) = cvtpk(krb.x, krb.y); *(LAS unsigned*)(lds + T_QGB + o) = cvtpk(qgb.x, qgb.y); }
    }
    __syncthreads();
    const int w = F.wave, lane = F.lane, r = lane & 31, hh = lane >> 5, blk = (lane >> 4) & 1, q = (lane & 15) >> 2, p = lane & 3;
    const int ct = w >> 2, et = w & 3;
    const bf16* Sst = (const bf16*)((const unsigned char*)F.out + OUT_SST);
    f32x16 o;
#pragma unroll
    for (int i = 0; i < 16; ++i) o[i] = 0.f;
#pragma unroll
    for (int dir = 0; dir < 2; ++dir) { const int TQR = dir ? T_QRB : T_QRF, TKR = dir ? T_KRB : T_KRF, TQG = dir ? T_QGB : T_QGF;
#pragma unroll
        for (int st = 0; st < 2; ++st) {
            if (dir == 0 ? (st > ct) : (st < ct)) continue;
            f32x16 X;
#pragma unroll
            for (int i = 0; i < 16; ++i) X[i] = 0.f;
#pragma unroll
            for (int ks = 0; ks < 8; ++ks) { const bf16x8 a = *(const LAS bf16x8*)(lds + TKR + (32 * st + r) * TS + (16 * ks + 8 * hh) * 2), bq = *(const LAS bf16x8*)(lds + TQR + (32 * ct + r) * TS + (16 * ks + 8 * hh) * 2);
                X = MFMA32(a, bq, X); }
            const int cc = 32 * ct + r;
#pragma unroll
            for (int i = 0; i < 16; ++i) { const int s = 32 * st + crow(i, hh); const bool keep = dir == 0 ? (s <= cc) : (s >= cc); X[i] = keep ? X[i] : 0.f; }
#pragma unroll
            for (int s2 = 0; s2 < 2; ++s2) { const bf16x8 xs = pack8(X, s2);
                const LAS unsigned char* vp = lds + T_V + (32 * st + 16 * s2 + 4 * hh + q) * TS + (32 * et + 16 * blk + 4 * p) * 2;
                const bf16x8 pb = cat8(tr16(vp), tr16(vp + 8 * TS));
                o = MFMA32(xs, pb, o); }
        }
        const bf16* sp = Sst + ((size_t)(item * 2 + dir) * 128 + 32 * et + r) * 128 + 8 * hh;
#pragma unroll
        for (int ks = 0; ks < 8; ++ks) { const bf16x8 a = *(const LAS bf16x8*)(lds + TQG + (32 * ct + r) * TS + (16 * ks + 8 * hh) * 2); const bf16x8 bq = *(const bf16x8*)(sp + 16 * ks);
            o = MFMA32(a, bq, o); }
    }
    unsigned hw[8];
#pragma unroll
    for (int k = 0; k < 8; ++k) hw[k] = *(const unsigned*)(proj + (size_t)(8 * w + k) * PC + C_HG + h * 128 + 2 * lane);
    __syncthreads();
    LAS float* O = (LAS float*)(lds + O_OFF);
#pragma unroll
    for (int i = 0; i < 16; ++i) O[(32 * ct + crow(i, hh)) * OS + 32 * et + r] = o[i];
    __syncthreads();
    const f32x2 gn = *(const f32x2*)(F.hg_norm_g + h * 128 + 2 * lane);
    bf16* yhg = (bf16*)(F.ws + WS_YHG);
    const int a16 = (lane ^ 16) << 2, a32 = (lane ^ 32) << 2;
#pragma unroll
    for (int k = 0; k < 8; ++k) { const int c = 8 * w + k; const f32x2 v = *(const LAS f32x2*)(O + c * OS + 2 * lane);
        float ss = row_sum16(v.x * v.x + v.y * v.y); ss += bperm_f(a16, ss); ss += bperm_f(a32, ss);
        const float rstd = __builtin_amdgcn_rsqf(ss * (1.0f / 128.0f) + EPS);
        const float z0 = bflo(hw[k]), z1 = bfhi(hw[k]);
        const float y0 = v.x * rstd * gn.x * (z0 * fast_sig(z0)), y1 = v.y * rstd * gn.y * (z1 * fast_sig(z1));
        *(unsigned*)(yhg + (row0 + c) * 512 + h * 128 + 2 * lane) = cvtpk(y0, y1); }
    __syncthreads();
}

DI void attn_item(Frame& F, int g, int item) {
    F.refresh();
    constexpr int KS = 272, VS = 528, K_OFF = 0, V_OFF = 69632;
    LAS unsigned char* lds = F.lds;
    const int qb = item & 7, h = (item >> 3) & 3, b = item >> 5, bglob = g * BG + b;
    const bf16* Km = (const bf16*)(F.ws + WS_KMEM) + (size_t)bglob * 256 * 512 + h * 128;
    const bf16* VT = (const bf16*)(F.ws + WS_VT) + (size_t)(h * 128) * 4096 + bglob * 256;
    const int tid = F.tid;
#pragma unroll
    for (int i = 0; i < 8; ++i) { const int id = tid + 512 * i, key = id >> 4, ch = id & 15;
        *(LAS u32x4*)(lds + K_OFF + key * KS + ch * 16) = *(const u32x4*)(Km + (size_t)key * 512 + ch * 8); }
#pragma unroll
    for (int i = 0; i < 8; ++i) { const int id = tid + 512 * i, e = id >> 5, ch = id & 31;
        *(LAS u32x4*)(lds + V_OFF + e * VS + ch * 16) = *(const u32x4*)(VT + (size_t)e * 4096 + ch * 8); }
    __syncthreads();
    const int w = F.wave, lane = F.lane, r = lane & 31, hh = lane >> 5;
    const size_t qrow0 = (size_t)b * SEQ + qb * 256 + w * 32;
    const bf16* proj = (const bf16*)(F.ws + WS_PROJ);
    bf16x8 qf[8];
#pragma unroll
    for (int ks = 0; ks < 8; ++ks) qf[ks] = *(const bf16x8*)(proj + (qrow0 + r) * PC + C_MQ + h * 128 + 16 * ks + 8 * hh);
    const float scale = 0.08838834764831845f;
    float m_run = -INFINITY, l_run = 0.f;
#pragma unroll 1
    for (int kt = 0; kt < 8; ++kt) {
        f32x16 X;
#pragma unroll
        for (int i = 0; i < 16; ++i) X[i] = 0.f;
#pragma unroll
        for (int ks = 0; ks < 8; ++ks) { const bf16x8 a = *(const LAS bf16x8*)(lds + K_OFF + (32 * kt + r) * KS + (16 * ks + 8 * hh) * 2); X = MFMA32(a, qf[ks], X); }
        float tm = X[0];
#pragma unroll
        for (int i = 1; i < 16; ++i) tm = fmaxf(tm, X[i]);
        tm *= scale;
        const float mn = fmaxf(m_run, tm); float ls = 0.f;
#pragma unroll
        for (int i = 0; i < 16; ++i) ls += __expf(X[i] * scale - mn);
        l_run = l_run * __expf(m_run - mn) + ls; m_run = mn;
    }
    { const float mo = __shfl_xor(m_run, 32), lo = __shfl_xor(l_run, 32); const float m = fmaxf(m_run, mo);
      l_run = l_run * __expf(m_run - m) + lo * __expf(mo - m); m_run = m; }
    const float inv_l = 1.0f / l_run;
    f32x16 O[4];
#pragma unroll
    for (int e = 0; e < 4; ++e)
#pragma unroll
        for (int i = 0; i < 16; ++i) O[e][i] = 0.f;
#pragma unroll 1
    for (int kt = 0; kt < 8; ++kt) {
        f32x16 X;
#pragma unroll
        for (int i = 0; i < 16; ++i) X[i] = 0.f;
#pragma unroll
        for (int ks = 0; ks < 8; ++ks) { const bf16x8 a = *(const LAS bf16x8*)(lds + K_OFF + (32 * kt + r) * KS + (16 * ks + 8 * hh) * 2); X = MFMA32(a, qf[ks], X); }
#pragma unroll
        for (int i = 0; i < 16; ++i) X[i] = __expf(X[i] * scale - m_run) * inv_l;
#pragma unroll
        for (int s2 = 0; s2 < 2; ++s2) { const bf16x8 xs = pack8(X, s2);
#pragma unroll
            for (int e = 0; e < 4; ++e) { const LAS unsigned char* vp = lds + V_OFF + (32 * e + r) * VS + (32 * kt + 16 * s2 + 4 * hh) * 2;
                const bf16x8 pb = cat8(*(const LAS s16x4*)vp, *(const LAS s16x4*)(vp + 16));
                O[e] = MFMA32(xs, pb, O[e]); } }
    }
    bf16* ymx = (bf16*)(F.ws + WS_YMX);
#pragma unroll
    for (int e = 0; e < 4; ++e)
#pragma unroll
        for (int i = 0; i < 16; ++i) ymx[(qrow0 + crow(i, hh)) * 512 + h * 128 + 32 * e + r] = (bf16)f2bf(O[e][i]);
    __syncthreads();
}

DI void conv_phase(Frame& F) {
    F.refresh();
    const bf16* proj = (const bf16*)(F.ws + WS_PROJ); bf16* ysc = (bf16*)(F.ws + WS_YSC); const float* cw = F.sc_conv_w;
    const int gt = F.vcu * 512 + F.tid, NGT = F.G * 512;
    for (int id = gt; id < TG * 64; id += NGT) {
        const int c8 = id & 63, t = id >> 6, ts = t & (SEQ - 1);
        const bf16* pr = proj + (size_t)t * PC + c8 * 8;
        const u32x4 z4 = (u32x4){0u, 0u, 0u, 0u};
        const u32x4 sb = *(const u32x4*)(pr + C_SB), c1 = *(const u32x4*)(pr + C_SC), h1 = *(const u32x4*)(pr + C_SH);
        const u32x4 c0 = ts > 0 ? *(const u32x4*)(pr - PC + C_SC) : z4, h0 = ts > 0 ? *(const u32x4*)(pr - PC + C_SH) : z4;
        const u32x4 c2 = ts < SEQ - 1 ? *(const u32x4*)(pr + PC + C_SC) : z4, h2 = ts < SEQ - 1 ? *(const u32x4*)(pr + PC + C_SH) : z4;
        const f32x4 wa0 = *(const f32x4*)(cw + c8 * 8), wa1 = *(const f32x4*)(cw + c8 * 8 + 4), wb0 = *(const f32x4*)(cw + 512 + c8 * 8), wb1 = *(const f32x4*)(cw + 512 + c8 * 8 + 4),
                    wc0 = *(const f32x4*)(cw + 1024 + c8 * 8), wc1 = *(const f32x4*)(cw + 1024 + c8 * 8 + 4);
        float y[8];
#pragma unroll
        for (int k = 0; k < 4; ++k) {
            const float w0l = k < 2 ? wa0[2 * k] : wa1[2 * k - 4], w0h = k < 2 ? wa0[2 * k + 1] : wa1[2 * k - 3];
            const float w1l = k < 2 ? wb0[2 * k] : wb1[2 * k - 4], w1h = k < 2 ? wb0[2 * k + 1] : wb1[2 * k - 3];
            const float w2l = k < 2 ? wc0[2 * k] : wc1[2 * k - 4], w2h = k < 2 ? wc0[2 * k + 1] : wc1[2 * k - 3];
            y[2 * k]     = bflo(sb[k]) * (w0l * (bflo(c0[k]) * bflo(h0[k])) + w1l * (bflo(c1[k]) * bflo(h1[k])) + w2l * (bflo(c2[k]) * bflo(h2[k])));
            y[2 * k + 1] = bfhi(sb[k]) * (w0h * (bfhi(c0[k]) * bfhi(h0[k])) + w1h * (bfhi(c1[k]) * bfhi(h1[k])) + w2h * (bfhi(c2[k]) * bfhi(h2[k]))); }
        u32x4 o; o.x = cvtpk(y[0], y[1]); o.y = cvtpk(y[2], y[3]); o.z = cvtpk(y[4], y[5]); o.w = cvtpk(y[6], y[7]);
        *(u32x4*)(ysc + (size_t)t * 512 + c8 * 8) = o;
    }
}

DI unsigned ord_key(float v, int idx) { unsigned u = __builtin_bit_cast(unsigned, v); u ^= (u >> 31) ? 0xFFFFFFFFu : 0x80000000u; return (u & 0xFFFFFF80u) | (unsigned)(127 - idx); }
DI float key_val(unsigned k) { unsigned u = k & 0xFFFFFF80u; u = (u & 0x80000000u) ? (u ^ 0x80000000u) : ~u; return __builtin_bit_cast(float, u); }
DI float dot2bf(unsigned a, unsigned b, float c) { return __builtin_amdgcn_fdot2_f32_bf16(__builtin_bit_cast(bf16x2_t, a), __builtin_bit_cast(bf16x2_t, b), c, false); }
DI float dot8(const u32x4& a, const u32x4& b, float c) { c = dot2bf(a.x, b.x, c); c = dot2bf(a.y, b.y, c); c = dot2bf(a.z, b.z, c); return dot2bf(a.w, b.w, c); }
__host__ __device__ constexpr int cand_off(int i) { return i == 0 ? 0 : i == 1 ? 16 : i == 2 ? 24 : i == 3 ? 29 : i == 4 ? 33 : i == 5 ? 36 : i == 6 ? 38 : i == 7 ? 40 : 34 + i; }
__host__ __device__ constexpr int cand_i(int c) { return c < 16 ? 0 : c < 24 ? 1 : c < 29 ? 2 : c < 33 ? 3 : c < 36 ? 4 : c < 38 ? 5 : c < 40 ? 6 : c < 42 ? 7 : c - 34; }
__host__ __device__ constexpr int cand_pos(int c) { return cand_i(c) * 16 + (c - cand_off(cand_i(c))); }

#define PEER_CE(i, j) do { const unsigned hi_ = max(k[i], k[j]), lo_ = min(k[i], k[j]); k[i] = hi_; k[j] = lo_; } while (0)
DI void peer_topk_first(const float* srow, LAS float* ssc, LAS int* six, int lane) {
    const int gq = lane >> 4, li = lane & 15;
    const float* sl = srow + (gq >> 1) * 256 + (gq & 1) * 128 + li * 8;
    f32x4 nva = *(const f32x4*)sl, nvb = *(const f32x4*)(sl + 4);
#pragma unroll 1
    for (int hp = 0; hp < 4; ++hp) {
        const f32x4 va = nva, vb = nvb;
        if (hp < 3) { nva = *(const f32x4*)(sl + 512 * (hp + 1)); nvb = *(const f32x4*)(sl + 512 * (hp + 1) + 4); }
        unsigned k[8];
        k[0] = ord_key(va.x, li * 8 + 0); k[1] = ord_key(va.y, li * 8 + 1); k[2] = ord_key(va.z, li * 8 + 2); k[3] = ord_key(va.w, li * 8 + 3);
        k[4] = ord_key(vb.x, li * 8 + 4); k[5] = ord_key(vb.y, li * 8 + 5); k[6] = ord_key(vb.z, li * 8 + 6); k[7] = ord_key(vb.w, li * 8 + 7);
        PEER_CE(0, 1); PEER_CE(2, 3); PEER_CE(4, 5); PEER_CE(6, 7); PEER_CE(0, 2); PEER_CE(1, 3); PEER_CE(4, 6); PEER_CE(5, 7); PEER_CE(1, 2); PEER_CE(5, 6);
        PEER_CE(0, 4); PEER_CE(1, 5); PEER_CE(2, 6); PEER_CE(3, 7); PEER_CE(2, 4); PEER_CE(3, 5); PEER_CE(1, 2); PEER_CE(3, 4); PEER_CE(5, 6);
        unsigned mine = 0u;
#pragma unroll
        for (int rd = 0; rd < 16; ++rd) {
            const unsigned m = row_max16(k[0]);
            mine = (li == rd) ? m : mine;
            const bool wn = (k[0] == m);
            k[0] = wn ? k[1] : k[0]; k[1] = wn ? k[2] : k[1]; k[2] = wn ? k[3] : k[2]; k[3] = wn ? k[4] : k[3];
            k[4] = wn ? k[5] : k[4]; k[5] = wn ? k[6] : k[5]; k[6] = wn ? k[7] : k[6]; k[7] = wn ? 0u : k[7];
        }
        const int o = ((2 * hp + (gq >> 1)) * 2 + (gq & 1)) * 16 + li;
        ssc[o] = key_val(mine); six[o] = 127 - (int)(mine & 127u);
    }
}
DI void peer_topk_second(const LAS float* ssc, const LAS int* six, LAS int* widx, LAS float* wgate, int lane, int emask, int hd_lo, int hd_hi) {
    const int grp = lane >> 4, li = lane & 15;
    const int ri = li <= 1 ? 0 : li <= 8 ? li - 1 : 8, j0 = li == 1 ? 8 : 0;
    const int L = li <= 2 ? 8 : li == 3 ? 5 : li == 4 ? 4 : li == 5 ? 3 : li <= 8 ? 2 : li == 9 ? 8 : 0;
    const bool tail = li >= 9;
    const unsigned tag0 = tail ? 255u - 128u : 255u - (unsigned)(16 * ri + j0), tstep = tail ? 16u : 1u;
#pragma unroll 1
    for (int hd0 = hd_lo; hd0 < hd_hi; hd0 += 4) {
        const int hd = hd0 + grp;
        const LAS float* A = ssc + (hd * 2) * 16; const LAS float* B = A + 16;
        const LAS float* xp = tail ? A + 8 : B + j0;
        const float y = tail ? B[0] : A[ri];
        const f32x4 x0 = *(const LAS f32x4*)xp, x1 = *(const LAS f32x4*)(xp + 4);
        unsigned k[8];
#pragma unroll
        for (int jj = 0; jj < 8; ++jj) { const float v = (jj < 4 ? x0[jj & 3] : x1[jj & 3]) + y; unsigned u = __builtin_bit_cast(unsigned, v); u ^= (u >> 31) ? 0xFFFFFFFFu : 0x80000000u;
            k[jj] = jj < L ? ((u & 0xFFFFFF00u) | (tag0 - (unsigned)jj * tstep)) : 0u; }
        unsigned mine = 0u;
#pragma unroll
        for (int rd = 0; rd < 16; ++rd) {
            const unsigned m = row_max16(k[0]);
            mine = (li == rd) ? m : mine;
            const bool wn = (k[0] == m);
            k[0] = wn ? k[1] : k[0]; k[1] = wn ? k[2] : k[1]; k[2] = wn ? k[3] : k[2]; k[3] = wn ? k[4] : k[3];
            k[4] = wn ? k[5] : k[4]; k[5] = wn ? k[6] : k[5]; k[6] = wn ? k[7] : k[6]; k[7] = wn ? 0u : k[7];
        }
        const int tg_ = 255 - (int)(mine & 255u), ci = tg_ >> 4, cj = tg_ & 15;
        const float cs = A[ci] + B[cj];
        const int ia = six[(hd * 2) * 16 + ci], ib = six[(hd * 2 + 1) * 16 + cj];
        float mx = cs; mx = fmaxf(mx, dpp_f<0xB1>(mx)); mx = fmaxf(mx, dpp_f<0x4E>(mx)); mx = fmaxf(mx, dpp_f<0x141>(mx)); mx = fmaxf(mx, dpp_f<0x140>(mx));
        const float ev = __builtin_amdgcn_exp2f((cs - mx) * 1.4426950408889634f);
        const float sum = row_sum16(ev);
        if (hd < hd_hi) { widx[hd * 16 + li] = ((ia * 128 + ib) & emask) * 512  ; wgate[hd * 16 + li] = ev * __builtin_amdgcn_rcpf(sum); }
    }
}
#undef PEER_CE

constexpr float PEER_QSTEP = 0.35f;
constexpr float PEER_U_SCALE = 32.0f / PEER_QSTEP;
constexpr float PEER_UF4_SCALE = 64.0f;
constexpr float PEER_H4_SCALE = 2.0f;
#ifndef PROBE_SKIP
#define PROBE_SKIP 0
#endif
#define PSKIP(b) ((PROBE_SKIP >> (b)) & 1 && dry)
#ifndef PROBE_NODMA
#define PROBE_NODMA 0
#endif
#ifndef PROBE_EMASK
#define PROBE_EMASK 16383
#endif
#ifndef PEER_VARIANT
#define PEER_VARIANT 0
#endif
#ifndef PEER_R
#define PEER_R 16
#endif
#if PEER_R == 32
#define PEER_RM4 28
#elif PEER_R == 16
#define PEER_RM4 12
#elif PEER_R == 64
#define PEER_RM4 60
#endif
constexpr int PEER_NPROD = 2, PEER_NCONS = 8 - PEER_NPROD, PEER_CPP = PEER_NCONS / PEER_NPROD;
constexpr int PEER_NQ = 2 * PEER_NCONS;
#ifndef PEER_HP
#define PEER_HP 0
#endif
constexpr int PEER_SLOT_BYTES = 3072;
constexpr int PEER_FLAG_OFF = PEER_NQ * PEER_SLOT_BYTES, PEER_PRIV_OFF = PEER_FLAG_OFF + 64, PEER_PRIV_BYTES = 2560, PEER_RING_OFF = 53248;
static_assert(PEER_PRIV_OFF + PEER_NCONS * PEER_PRIV_BYTES <= PEER_RING_OFF && PEER_RING_OFF + PEER_NCONS * PEER_R * 1024 <= MISC_OFF && PEER_R <= 64 && (PEER_R & (PEER_R - 1)) == 0 && PEER_NCONS % PEER_NPROD == 0, "PEER LDS map");
DI void glds16(const void* gsrc, unsigned lds_dst) { unsigned keep;
    asm volatile("s_mov_b32 %0, m0\n\ts_mov_b32 m0, %2\n\ts_nop 0\n\tglobal_load_lds_dwordx4 %1, off\n\ts_mov_b32 m0, %0" : "=&s"(keep) : "v"(gsrc), "s"(lds_dst) : "memory"); }
DI void glds16s(const void* sbase, unsigned voff, unsigned lds_dst) { unsigned keep;
    asm volatile("s_mov_b32 %0, m0\n\ts_mov_b32 m0, %3\n\ts_nop 0\n\tglobal_load_lds_dwordx4 %1, %2\n\ts_mov_b32 m0, %0" : "=&s"(keep) : "v"(voff), "s"(sbase), "s"(lds_dst) : "memory"); }
DI void glds16s_x4(const void* sbase, unsigned v0, unsigned v1, unsigned v2, unsigned v3, unsigned lds_dst) { unsigned keep;
    asm volatile("s_mov_b32 %0, m0\n\ts_mov_b32 m0, %6\n\ts_nop 0\n\tglobal_load_lds_dwordx4 %1, %5\n\tglobal_load_lds_dwordx4 %2, %5 offset:1024\n\tglobal_load_lds_dwordx4 %3, %5 offset:2048\n\tglobal_load_lds_dwordx4 %4, %5 offset:3072\n\ts_mov_b32 m0, %0"
                 : "=&s"(keep) : "v"(v0), "v"(v1), "v"(v2), "v"(v3), "s"(sbase), "s"(lds_dst) : "memory"); }
#define PEER_STR2(x) #x
#define PEER_STR(x) PEER_STR2(x)
typedef int i32x4 __attribute__((ext_vector_type(4)));
typedef int i32x8 __attribute__((ext_vector_type(8)));
DI void peer_phase(Frame& F, int tg, bool dry) {
    F.refresh();
    __syncthreads();
    const int lane = F.lane, wv = F.wave;
    volatile LAS unsigned* flags = (volatile LAS unsigned*)(F.lds + PEER_FLAG_OFF);
    if (F.tid <= PEER_NQ) flags[F.tid] = 0u;
    __syncthreads();
    const int NPG = F.G * PEER_NPROD;
    if (wv < PEER_NPROD) {
        const int pg = F.vcu * PEER_NPROD + wv;
        int i = 0;
        for (int tl = pg; tl < TG; tl += NPG, ++i) {
            float tch0 = 0.f;
            if (tl + NPG < TG) tch0 = ((const float*)(F.ws + WS_S) + (size_t)(tl + NPG) * 2048)[lane * 32];
            const int q = PEER_NPROD * i + wv, slot = q % PEER_NQ;
            LAS float* ssc = (LAS float*)(F.lds + slot * PEER_SLOT_BYTES); LAS int* six = (LAS int*)(F.lds + slot * PEER_SLOT_BYTES + 1024);
            while (flags[slot] != 0u) __builtin_amdgcn_s_sleep(2);
            asm volatile("" ::: "memory");
            if (!PSKIP(0)) peer_topk_first((const float*)(F.ws + WS_S) + (size_t)tl * 2048, ssc, six, lane);
            if (PEER_HP > 0 && !PSKIP(1)) peer_topk_second(ssc, six, (LAS int*)(F.lds + slot * PEER_SLOT_BYTES + 2048), (LAS float*)(F.lds + slot * PEER_SLOT_BYTES + 2560), lane, dry ? PROBE_EMASK : 16383, 0, PEER_HP);
            asm volatile("s_waitcnt lgkmcnt(0)" :: "v"(tch0) : "memory");
            if (lane == 0) flags[slot] = (unsigned)q + 1u;
        }
    } else {
        const unsigned char* Ub = F.ws + WS_U; const unsigned char* Vb = F.ws + WS_V; const unsigned lo16 = 16u * (unsigned)(lane & 31);
        const int a16 = (lane ^ 16) << 2, a32 = (lane ^ 32) << 2; const int grp = lane >> 4;
        const int cidx = wv - PEER_NPROD;
        LAS int* sidx = (LAS int*)(F.lds + PEER_PRIV_OFF + cidx * PEER_PRIV_BYTES); LAS float* sgate = (LAS float*)(F.lds + PEER_PRIV_OFF + cidx * PEER_PRIV_BYTES + 512);
        LAS unsigned char* ring = F.lds + PEER_RING_OFF + cidx * (PEER_R * 1024);
        const unsigned ringb = (unsigned)(uintptr_t)ring;
        LAS unsigned char* hrow = F.lds + PEER_PRIV_OFF + cidx * PEER_PRIV_BYTES + 1536;
        unsigned usw[4];
#pragma unroll
        for (int q = 0; q < 4; ++q) usw[q] = 16u * (unsigned)((lane & 31) ^ (2 * q + (lane >> 5))) + (4096u - 1024u * q);
        const LAS unsigned char* uadr[4];
#pragma unroll
        for (int j = 0; j < 4; ++j) uadr[j] = ring + (lane & 15) * 512 + 64 * (j ^ ((lane & 15) >> 2)) + 16 * (grp ^ (lane & 3));
        const int NQTOK = PEER_NPROD * (TG / NPG);
        float gf[16];
#pragma unroll
        for (int cb = 0; cb < 16; ++cb) gf[cb] = F.final_norm_g[lane + 64 * cb];
#define PEER_TICKET(qv) do { int q_ = 0; if (lane == 0) q_ = (int)__hip_atomic_fetch_add((LAS unsigned*)(F.lds + PEER_FLAG_OFF) + PEER_NQ, 1u, __ATOMIC_RELAXED, __HIP_MEMORY_SCOPE_WORKGROUP); qv = __builtin_amdgcn_readfirstlane(q_); } while (0)
#define PEER_TOKEN(qv) ((size_t)tg * TG + (size_t)(F.vcu * PEER_NPROD + ((qv) % PEER_NPROD) + ((qv) / PEER_NPROD) * NPG))
#define PEER_PREFETCH(qv) do { if ((qv) < NQTOK) { const size_t tp_ = PEER_TOKEN(qv); pssp = ((const float*)(F.ws + WS_SSP) + tp_ * 16)[lane & 15]; \
                const bf16* xr_ = (const bf16*)(F.ws + WS_XG) + tp_ * 1024 + 16 * lane; pw0 = *(const u32x4*)xr_; pw1 = *(const u32x4*)(xr_ + 8); } } while (0)
        float pssp = 0.f; u32x4 pw0 = {0u, 0u, 0u, 0u}, pw1 = {0u, 0u, 0u, 0u};
        int q; PEER_TICKET(q); PEER_PREFETCH(q);
        for (;;) {
            if (q >= NQTOK) break;
            const int tl = F.vcu * PEER_NPROD + (q % PEER_NPROD) + (q / PEER_NPROD) * NPG;
            const size_t t = (size_t)tg * TG + tl;
            float tch1 = 0.f, tch2 = 0.f, tch3 = 0.f;
            if (q + PEER_NCONS < NQTOK) { const size_t tn = PEER_TOKEN(q + PEER_NCONS); tch1 = (F.out + tn * 1024)[(lane & 31) * 32];
                tch2 = ((const float*)((const bf16*)(F.ws + WS_XG) + tn * 1024))[(lane & 15) * 32]; tch3 = ((const float*)(F.ws + WS_SSP) + tn * 16)[lane & 15]; }
            const float hs = __builtin_amdgcn_rsqf(row_sum16(pssp) * (1.0f / 1024.0f) + EPS) * PEER_H4_SCALE;
            { const u32x4 w0 = pw0, w1 = pw1;
              u32x2 hq;
              hq.x = __builtin_amdgcn_cvt_scalef32_pk_fp4_f32(0u, bflo(w0[0]) * hs, bfhi(w0[0]) * hs, 1.0f, 0); hq.x = __builtin_amdgcn_cvt_scalef32_pk_fp4_f32(hq.x, bflo(w0[1]) * hs, bfhi(w0[1]) * hs, 1.0f, 1);
              hq.x = __builtin_amdgcn_cvt_scalef32_pk_fp4_f32(hq.x, bflo(w0[2]) * hs, bfhi(w0[2]) * hs, 1.0f, 2); hq.x = __builtin_amdgcn_cvt_scalef32_pk_fp4_f32(hq.x, bflo(w0[3]) * hs, bfhi(w0[3]) * hs, 1.0f, 3);
              hq.y = __builtin_amdgcn_cvt_scalef32_pk_fp4_f32(0u, bflo(w1[0]) * hs, bfhi(w1[0]) * hs, 1.0f, 0); hq.y = __builtin_amdgcn_cvt_scalef32_pk_fp4_f32(hq.y, bflo(w1[1]) * hs, bfhi(w1[1]) * hs, 1.0f, 1);
              hq.y = __builtin_amdgcn_cvt_scalef32_pk_fp4_f32(hq.y, bflo(w1[2]) * hs, bfhi(w1[2]) * hs, 1.0f, 2); hq.y = __builtin_amdgcn_cvt_scalef32_pk_fp4_f32(hq.y, bflo(w1[3]) * hs, bfhi(w1[3]) * hs, 1.0f, 3);
              *(LAS u32x2*)(hrow + 8 * lane) = hq; }
            const float ascale = 1.0f / (PEER_H4_SCALE * PEER_UF4_SCALE);
            const int slot = q % PEER_NQ;
            while (flags[slot] != (unsigned)q + 1u) __builtin_amdgcn_s_sleep(2);
            asm volatile("" ::: "memory");
            if (PEER_HP > 0) { if (lane < 16 * PEER_HP) { sidx[lane] = ((const LAS int*)(F.lds + slot * PEER_SLOT_BYTES + 2048))[lane]; sgate[lane] = ((const LAS float*)(F.lds + slot * PEER_SLOT_BYTES + 2560))[lane]; }
                if (PEER_HP > 4 && lane < 16 * PEER_HP - 64) { sidx[64 + lane] = ((const LAS int*)(F.lds + slot * PEER_SLOT_BYTES + 2048))[64 + lane]; sgate[64 + lane] = ((const LAS float*)(F.lds + slot * PEER_SLOT_BYTES + 2560))[64 + lane]; } }
            if (PEER_HP < 8 && !PSKIP(1)) peer_topk_second((const LAS float*)(F.lds + slot * PEER_SLOT_BYTES), (const LAS int*)(F.lds + slot * PEER_SLOT_BYTES + 1024), sidx, sgate, lane, dry ? PROBE_EMASK : 16383, PEER_HP, 8);
            asm volatile("s_waitcnt lgkmcnt(0)" ::: "memory");
            if (lane == 0) flags[slot] = 0u;
#define PEER_LOADIDX(tile) do { const LAS int* ip_ = sidx + 16 * (tile) + (lane >> 5); _Pragma("unroll") for (int j_ = 0; j_ < 8; ++j_) nx[j_] = (unsigned)ip_[2 * j_]; } while (0)
#define PEER_ISSUE8U(tile) do { if (PROBE_NODMA && dry) break; const unsigned rs_ = (unsigned)__builtin_amdgcn_readfirstlane((int)(ringb + (unsigned)((tile) & 1) * 8192u)); \
                glds16s_x4(Ub - 4096, nx[0] + usw[0], nx[1] + usw[1], nx[2] + usw[2], nx[3] + usw[3], rs_); \
                glds16s_x4(Ub - 4096, nx[4] + (usw[0] ^ 128u), nx[5] + (usw[1] ^ 128u), nx[6] + (usw[2] ^ 128u), nx[7] + (usw[3] ^ 128u), rs_ + 4096u); } while (0)
#define PEER_ISSUE8V(tile) do { if (PROBE_NODMA && dry) break; const unsigned rs_ = (unsigned)__builtin_amdgcn_readfirstlane((int)(ringb + (unsigned)((tile) & 1) * 8192u)); \
                glds16s_x4(Vb - 4096, nx[0] + lo16 + 4096u, nx[1] + lo16 + 3072u, nx[2] + lo16 + 2048u, nx[3] + lo16 + 1024u, rs_); \
                glds16s_x4(Vb - 4096, nx[4] + lo16 + 4096u, nx[5] + lo16 + 3072u, nx[6] + lo16 + 2048u, nx[7] + lo16 + 1024u, rs_ + 4096u); } while (0)
            unsigned nx[8];
            PEER_LOADIDX(0); PEER_ISSUE8U(0); PEER_LOADIDX(1); PEER_ISSUE8U(1); PEER_LOADIDX(2);
            i32x4 hA[8];
#pragma unroll
            for (int ks = 0; ks < 8; ++ks) hA[ks] = *(const LAS i32x4*)(hrow + 64 * ks + 16 * grp);
            float dotA = 0.f, dotB = 0.f;
#pragma unroll 1
            for (int tp = PSKIP(2) ? 4 : 0; tp < 4; ++tp) {
#pragma unroll
                for (int par = 0; par < 2; ++par) { const int tt = 2 * tp + par;
                    asm volatile("s_waitcnt vmcnt(8)" ::: "memory");
                    f32x4 acc = {0.f, 0.f, 0.f, 0.f};
#pragma unroll
                    for (int ks = 0; ks < 8; ++ks) { const i32x4 b_ = *(const LAS i32x4*)(uadr[ks & 3] + 256 * (ks >> 2) + 8192 * par);
                        const i32x8 b8_ = {b_.x, b_.y, b_.z, b_.w, 0, 0, 0, 0};
                        const i32x8 a8_ = {hA[ks].x, hA[ks].y, hA[ks].z, hA[ks].w, 0, 0, 0, 0};
                        acc = __builtin_amdgcn_mfma_scale_f32_16x16x128_f8f6f4(a8_, b8_, acc, 4  , 4  , 0, 127, 0, 127); }
                    dotA = (tt == grp) ? acc[0] : dotA; dotB = (tt == grp + 4) ? acc[0] : dotB;
                    __builtin_amdgcn_sched_barrier(0);
                    if (tp < 3) PEER_ISSUE8U(tt + 2); else PEER_ISSUE8V(tt + 2);
                    PEER_LOADIDX((tt + 3) & 7);
                    __builtin_amdgcn_sched_barrier(0); }
            }
            unsigned loA, hiA, loB, hiB; float bscA, bscB;
            { const float av = dotA * ascale, bv = dotB * ascale;
              const float cA = sgate[lane] * (0.5f * av * (1.0f + erff(av * 0.70710678118654752f))), cB = sgate[64 + lane] * (0.5f * bv * (1.0f + erff(bv * 0.70710678118654752f)));
              const float mxA = __builtin_bit_cast(float, row_max16(__builtin_bit_cast(unsigned, fabsf(cA)))), mxB = __builtin_bit_cast(float, row_max16(__builtin_bit_cast(unsigned, fabsf(cB))));
              const float qsA = mxA > 0.f ? 7.0f * __builtin_amdgcn_rcpf(mxA) : 0.f, qsB = mxB > 0.f ? 7.0f * __builtin_amdgcn_rcpf(mxB) : 0.f;
              const unsigned cqA = ((unsigned)(int)__builtin_rintf(cA * qsA) & 15u) << (4 * (lane & 7)), cqB = ((unsigned)(int)__builtin_rintf(cB * qsB) & 15u) << (4 * (lane & 7));
              loA = (lane & 8) ? 0u : cqA; hiA = (lane & 8) ? cqA : 0u; loB = (lane & 8) ? 0u : cqB; hiB = (lane & 8) ? cqB : 0u;
              loA |= dpp_u<0xB1>(loA); loA |= dpp_u<0x4E>(loA); loA |= dpp_u<0x141>(loA); loA |= dpp_u<0x140>(loA);
              hiA |= dpp_u<0xB1>(hiA); hiA |= dpp_u<0x4E>(hiA); hiA |= dpp_u<0x141>(hiA); hiA |= dpp_u<0x140>(hiA);
              loB |= dpp_u<0xB1>(loB); loB |= dpp_u<0x4E>(loB); loB |= dpp_u<0x141>(loB); loB |= dpp_u<0x140>(loB);
              hiB |= dpp_u<0xB1>(hiB); hiB |= dpp_u<0x4E>(hiB); hiB |= dpp_u<0x141>(hiB); hiB |= dpp_u<0x140>(hiB);
              bscA = mxA * (1.0f / 7.0f); bscB = mxB * (1.0f / 7.0f); }
            float* xo = F.out + t * 1024 + lane;
            float* xst = dry ? (float*)(F.ws + WS_PROJ + (128u << 20)) + (size_t)tl * 1024 + lane : xo;
            float xa[16];
#pragma unroll
            for (int cb = 0; cb < 16; ++cb) xa[cb] = xo[64 * cb];
            const bool early = q + 2 * PEER_NCONS < NQTOK;
            int qn = 0; if (early) { PEER_TICKET(qn); PEER_PREFETCH(qn); }
            float oacc[16];
#pragma unroll
            for (int cb = 0; cb < 16; ++cb) oacc[cb] = 0.f;
            typedef int i32x2 __attribute__((ext_vector_type(2)));
#pragma unroll 1
            for (int vb = PSKIP(3) ? 8 : 0; vb < 8; ++vb) {
                if (vb < 7) asm volatile("s_waitcnt vmcnt(8)" ::: "memory"); else asm volatile("s_waitcnt vmcnt(0)" ::: "memory");
                const int sl_ = 16 * (vb & 3);
                const int clo = __builtin_amdgcn_readlane((int)(vb < 4 ? loA : loB), sl_), chi = __builtin_amdgcn_readlane((int)(vb < 4 ? hiA : hiB), sl_);
                const float bsc = __builtin_bit_cast(float, __builtin_amdgcn_readlane(__builtin_bit_cast(int, vb < 4 ? bscA : bscB), sl_));
                const LAS unsigned char* rowp = ring + (16 * (vb & 1) + (lane & 15)) * 512 + 8 * (lane >> 4);
#pragma unroll
                for (int cb = 0; cb < 16; ++cb) {
                    const i32x2 tr = __builtin_amdgcn_ds_read_tr4_b64_v2i32((LAS i32x2*)(rowp + 32 * cb));
                    const int ai = __builtin_amdgcn_sdot8(chi, tr.y, __builtin_amdgcn_sdot8(clo, tr.x, 0, false), false);
                    oacc[cb] += (float)ai * bsc;
                }
                if (vb < 6) { PEER_ISSUE8V(vb + 2); PEER_LOADIDX((vb + 3) & 7); }
            }
#undef PEER_ISSUE8U
#undef PEER_ISSUE8V
#undef PEER_LOADIDX
            float ss = 0.f;
#pragma unroll
            for (int cb = 0; cb < 16; ++cb) { xa[cb] = xa[cb] + oacc[cb] * (1.0f / PEER_U_SCALE); ss += xa[cb] * xa[cb]; }
            ss = row_sum16(ss); ss += bperm_f(a16, ss); ss += bperm_f(a32, ss);
            const float rf = __builtin_amdgcn_rsqf(ss * (1.0f / 1024.0f) + EPS);
#pragma unroll
            for (int cb = 0; cb < 16; ++cb) xst[64 * cb] = xa[cb] * rf * gf[cb];
            asm volatile("" :: "v"(tch1), "v"(tch2), "v"(tch3));
            if (!early) { PEER_TICKET(qn); PEER_PREFETCH(qn); }
            q = qn;
        }
    }
}

DI void convert_uv(Frame& F, int part, int nparts, int cu, int ncu) {
    F.refresh();
    const int gt = cu * 512 + F.tid, NGT = ncu * 512, per = (2 * 16384 * 64) / nparts;
    for (int id = part * per + gt; id < (part + 1) * per; id += NGT) {
        const int which = id >> 20, off = (id & ((1 << 20) - 1)) * 16;
        const float* src = (which ? F.peer_v : F.peer_u) + off; unsigned char* dst = F.ws + (which ? WS_V : WS_U) + off / 2;
        u32x2 o;
        if (which == 0) {
#pragma unroll
            for (int q = 0; q < 2; ++q) { const f32x4 v0 = *(const f32x4*)(src + 8 * q) * PEER_UF4_SCALE, v1 = *(const f32x4*)(src + 8 * q + 4) * PEER_UF4_SCALE;
                unsigned pk = __builtin_amdgcn_cvt_scalef32_pk_fp4_f32(0u, v0.x, v0.y, 1.0f, 0); pk = __builtin_amdgcn_cvt_scalef32_pk_fp4_f32(pk, v0.z, v0.w, 1.0f, 1);
                pk = __builtin_amdgcn_cvt_scalef32_pk_fp4_f32(pk, v1.x, v1.y, 1.0f, 2); pk = __builtin_amdgcn_cvt_scalef32_pk_fp4_f32(pk, v1.z, v1.w, 1.0f, 3); o[q] = pk; }
        } else {
#pragma unroll
            for (int q = 0; q < 2; ++q) { const f32x4 v0 = *(const f32x4*)(src + 8 * q) * PEER_U_SCALE, v1 = *(const f32x4*)(src + 8 * q + 4) * PEER_U_SCALE; unsigned pk = 0u;
#pragma unroll
                for (int k = 0; k < 4; ++k) { pk |= ((unsigned)(int)__builtin_rintf(fminf(fmaxf(v0[k], -7.f), 7.f)) & 15u) << (4 * k); pk |= ((unsigned)(int)__builtin_rintf(fminf(fmaxf(v1[k], -7.f), 7.f)) & 15u) << (16 + 4 * k); }
                o[q] = pk; }
        }
        *(u32x2*)dst = o;
    }
}

constexpr int N_PHASES = 19;
struct Args { const float* in[17]; float* out; unsigned char* ws; int ph_lo, ph_hi; };

__global__ void __launch_bounds__(NWAVES * 64, 2) fwd_kernel(Args args) {
    extern __shared__ __attribute__((aligned(16))) unsigned char lds_raw[];
    Frame F;
    F.lds = (LAS unsigned char*)lds_raw;
    F.tid = threadIdx.x; F.lane = F.tid & 63; F.wave = __builtin_amdgcn_readfirstlane(F.tid >> 6);
    F.G = gridDim.x; { const int bx = blockIdx.x; F.vcu = (F.G % 8 == 0) ? (bx % 8) * (F.G / 8) + bx / 8 : bx; }
    F.x = args.in[0]; F.mem = args.in[1]; F.norm_mix_g = args.in[2]; F.w_in = args.in[3]; F.hg_lb = args.in[4]; F.hg_norm_g = args.in[5]; F.sc_conv_w = args.in[6];
    F.mem_norm_g = args.in[7]; F.w_mem_kv = args.in[8]; F.w_branch = args.in[9]; F.w_out = args.in[10]; F.norm_ffn_g = args.in[11]; F.peer_w_q = args.in[12];
    F.peer_sub_keys = args.in[13]; F.peer_u = args.in[14]; F.peer_v = args.in[15]; F.final_norm_g = args.in[16];
    F.out = args.out; F.ws = args.ws;
    volatile LAS unsigned* MISC = (volatile LAS unsigned*)(F.lds + MISC_OFF);
    for (int u = F.tid; u < (LDS_BYTES - MISC_OFF) / 4; u += NWAVES * 64) MISC[u] = 0u;
    __syncthreads();
    unsigned* barw = (unsigned*)(F.ws + WS_CTL) + CW_BAR;
    XcdBarrier bar; bar.bar = barw; bar.x = 0; bar.st = nullptr;
    const bool one_launch = (args.ph_hi - args.ph_lo) > 1;
    if (one_launch) bar = xcd_barrier_post(barw, MISC + 8);
    const int lo = args.ph_lo, hi = args.ph_hi;
#define IN(k) (lo <= (k) && (k) < hi)
#ifndef PMASK
#define PMASK 0x3ff
#endif
#define PC_(c) ((PMASK >> (c)) & 1)
#ifndef REP_MASK
#define REP_MASK 0
#endif
#define REPS(c) for (int rep_ = 0; rep_ < 1 + 2 * ((REP_MASK >> (c)) & 1); ++rep_)
#define SEAM(k) do { if (IN(k) && IN((k) + 1)) xcd_barrier(bar); } while (0)
    unsigned char* ws = F.ws;
    const int G = F.G, cid = (int)blockIdx.x;

    if (PC_(0) && IN(0)) { REPS(0) p0_prologue(F); } SEAM(0);

#pragma unroll 1
    for (int g = 0; g < NGRP; ++g) {
        const int pb = 1 + 6 * g;
        if (PC_(1) && IN(pb)) REPS(1) {
            pg8::InOrder S; S.init(TG, PC, G, cid); S.H = (const char*)(ws + WS_XG) + (size_t)g * TG * 1024 * 2; S.Win = (const char*)(ws + WS_WIN); S.Mn = (const char*)(ws + WS_MN); S.Wkv = (const char*)(ws + WS_WKV); S.n_extra = (g == 0) ? 64 : 0;
            pg8::EpiIn E{(bf16*)(ws + WS_PROJ), (bf16*)(ws + WS_KMEM), (bf16*)(ws + WS_VT)};
            pg8::gemm_phase<pg8::EpiIn, pg8::InOrder, true, true>(F.lds, pg8::Gemm{1024, 1024, 1024}, S, E);
            if (cid >= 128) convert_uv(F, g, NGRP, cid - 128, G - 128);
        } SEAM(pb);
        if (PC_(2) && IN(pb + 1)) REPS(2) {
            for (int it = F.vcu * 4; it < BG * 4 * NCHUNK; it += G * 4) { for (int k = 0; k < 4; ++k) hgrn_a_item(F, it + k, k < 3); }
            for (int it = F.vcu; it < BG * 4 * 8; it += G) attn_item(F, g, it);
            conv_phase(F);
        } SEAM(pb + 1);
        if (PC_(3) && IN(pb + 2)) { REPS(3) hgrn_scan(F); } SEAM(pb + 2);
        if (PC_(4) && IN(pb + 3)) REPS(4) { for (int it = F.vcu * 4; it < BG * 4 * NCHUNK; it += G * 4) { for (int k = 0; k < 4; ++k) hgrn_c_item(F, it + k, k < 3); } } SEAM(pb + 3);
        if (PC_(5) && IN(pb + 4)) REPS(5) {
            pg8::BranchOrder S; S.init(TG, 1024, G, cid); S.Y = (const char*)(ws + WS_YHG); S.Wb = (const char*)(ws + WS_WBR);
            pg8::EpiBranch E{(const bf16*)(ws + WS_PROJ), (bf16*)(ws + WS_MACC), (bf16*)(ws + WS_MERGED)};
            pg8::gemm_phase<pg8::EpiBranch, pg8::BranchOrder, true, true>(F.lds, pg8::Gemm{512, 512, 512}, S, E);
        } SEAM(pb + 4);
        if (PC_(6) && IN(pb + 5)) REPS(6) {
            pg8::PlainOrder S; S.init(TG, 1024, G, cid); S.A = (const char*)(ws + WS_MERGED); S.Bt = (const char*)(ws + WS_WOUT); S.a_tile = 256 * 1024 * 2; S.b_tile = 256 * 1024 * 2;
            pg8::EpiOut E{F.x + (size_t)g * TG * 1024, F.out + (size_t)g * TG * 1024, (bf16*)(ws + WS_XG) + (size_t)g * TG * 1024, F.norm_ffn_g, (float*)(ws + WS_SSP) + (size_t)g * TG * 16};
            pg8::gemm_phase<pg8::EpiOut, pg8::PlainOrder, true, true>(F.lds, pg8::Gemm{1024, 1024, 1024}, S, E);
        } SEAM(pb + 5);
    }
#pragma unroll 1
    for (int tg = 0; tg < NGRP; ++tg) {
        const int pb = 13 + 3 * tg;
        if (PC_(7) && IN(pb)) REPS(7) {
            pg8::PlainOrder S; S.init(TG, 2048, G, cid); S.A = (const char*)(ws + WS_XG) + (size_t)tg * TG * 1024 * 2; S.Bt = (const char*)(ws + WS_WQ); S.a_tile = 256 * 1024 * 2; S.b_tile = 256 * 1024 * 2;
            pg8::EpiQ E{(bf16*)(ws + WS_Q), 2048, (const float*)(ws + WS_SSP) + (size_t)tg * TG * 16};
            pg8::gemm_phase<pg8::EpiQ, pg8::PlainOrder, true, true>(F.lds, pg8::Gemm{1024, 1024, 1024}, S, E);
        } SEAM(pb);
        if (PC_(8) && IN(pb + 1)) REPS(8) {
            pg8::ScoreOrder S; S.init(TG, 2048, G, cid); S.Q = (const char*)(ws + WS_Q); S.Kbd = (const char*)(ws + WS_KBD);
            pg8::EpiF32 E{(float*)(ws + WS_S), 2048};
            pg8::gemm_phase<pg8::EpiF32, pg8::ScoreOrder, true, true>(F.lds, pg8::Gemm{2048, 256, 256}, S, E);
        } SEAM(pb + 1);
        if (PC_(9) && IN(pb + 2)) { REPS(9) peer_phase(F, tg, rep_ < 2 * ((REP_MASK >> 9) & 1)); } SEAM(pb + 2);
    }
#undef IN
#undef SEAM
}

extern "C" void kernel_launch(void* const* d_in, const int* in_sizes, int n_in, void* d_out, int out_size, void* d_ws, size_t ws_size, hipStream_t stream) {
    static int ready = 0;
    if (ready == 0) {
        if (n_in != 17 || out_size != T_ALL * D_MODEL || ws_size < WS_END) { fprintf(stderr, "kernel_launch: unexpected shapes (n_in %d, out %d, ws %zu)\n", n_in, out_size, ws_size); ready = -1; return; }
        if (hipFuncSetAttribute((const void*)fwd_kernel, hipFuncAttributeMaxDynamicSharedMemorySize, LDS_BYTES) != hipSuccess) { fprintf(stderr, "kernel_launch: hipFuncSetAttribute failed\n"); ready = -1; return; }
        ready = 1;
    }
    if (ready < 0) return;
    (void)hipMemsetAsync((char*)d_ws + WS_CTL, 0, CTL_ZERO_BYTES, stream);
    Args a{};
    for (int i = 0; i < 17; ++i) a.in[i] = (const float*)d_in[i];
    a.out = (float*)d_out; a.ws = (unsigned char*)d_ws;
    const int grid = 256;
#if MK_N_LAUNCHES == 1
    a.ph_lo = 0; a.ph_hi = N_PHASES;
    hipLaunchKernelGGL(fwd_kernel, dim3(grid), dim3(NWAVES * 64), LDS_BYTES, stream, a);
#else
    for (int li = 0; li < N_PHASES; ++li) { a.ph_lo = li; a.ph_hi = li + 1; hipLaunchKernelGGL(fwd_kernel, dim3(grid), dim3(NWAVES * 64), LDS_BYTES, stream, a); }
#endif
}
```

```cpp
#include <hip/hip_runtime.h>
#include <cstdio>
#include <cstdint>

#ifndef MK_N_LAUNCHES
#define MK_N_LAUNCHES 1
#endif

#define LAS __attribute__((address_space(3)))
#define GAS __attribute__((address_space(1)))
typedef unsigned short bf16;
typedef short bf16x8 __attribute__((ext_vector_type(8)));
typedef short s16x4 __attribute__((ext_vector_type(4)));
typedef short v4i16_t __attribute__((ext_vector_type(4)));
typedef float f32x2 __attribute__((ext_vector_type(2)));
typedef float f32x4 __attribute__((ext_vector_type(4)));
typedef float f32x16 __attribute__((ext_vector_type(16)));
typedef unsigned u32x2 __attribute__((ext_vector_type(2)));
typedef unsigned u32x4 __attribute__((ext_vector_type(4)));
typedef __bf16 bf16x2_t __attribute__((ext_vector_type(2)));
typedef GAS unsigned gu32;
#define RLX_AGENT __ATOMIC_RELAXED, __HIP_MEMORY_SCOPE_AGENT
#define DI __device__ __forceinline__

constexpr int D_MODEL = 1024, BATCH = 16, SEQ = 2048, T_ALL = BATCH * SEQ;
constexpr int NGRP = 2, BG = BATCH / NGRP, TG = BG * SEQ;
constexpr int PC = 7680;
constexpr int C_HQ = 0, C_HI = 512, C_FF = 1024, C_FB = 1536, C_HG = 2048, C_SB = 2560, C_SC = 3072, C_SH = 3584, C_MQ = 4096, C_GATE = 4608;
constexpr int NMEM = 256, CHUNK = 64, NCHUNK = SEQ / CHUNK;
constexpr float EPS = 1e-6f;

constexpr size_t MiB = 1u << 20;
constexpr size_t WS_CTL = 0, CTL_ZERO_BYTES = 1 * MiB;
constexpr size_t WS_LB = 1 * MiB;
constexpr size_t WS_SSP = 2 * MiB;
constexpr size_t WS_DEC = 4 * MiB;
constexpr size_t WS_WIN = 5 * MiB, WS_WKV = 20 * MiB, WS_WBR = 22 * MiB, WS_WOUT = 25 * MiB, WS_WQ = 27 * MiB, WS_KBD = 31 * MiB;
constexpr size_t WS_MN = 32 * MiB, WS_KMEM = 40 * MiB, WS_VT = 44 * MiB;
constexpr size_t WS_XG = 48 * MiB;
constexpr size_t WS_YHG = 112 * MiB, WS_YSC = 128 * MiB, WS_YMX = 144 * MiB;
constexpr size_t WS_DS = 160 * MiB;
constexpr size_t WS_MACC = 160 * MiB;
constexpr size_t WS_MERGED = 224 * MiB;
constexpr size_t WS_PROJ = 256 * MiB;
constexpr size_t WS_U = 496 * MiB, WS_V = 504 * MiB;
constexpr size_t WS_Q = 176 * MiB;
constexpr size_t WS_S = 256 * MiB;
constexpr size_t WS_PL = 448 * MiB;
constexpr size_t WS_END = 512 * MiB;
constexpr size_t OUT_SST = 64 * MiB;

constexpr int LDS_BYTES = 160 * 1024;
constexpr int MISC_OFF = LDS_BYTES - 512;
constexpr int NWAVES = 8;

DI unsigned f2bf(float f) { unsigned u = __builtin_bit_cast(unsigned, f); return (u + 0x7fffu + ((u >> 16) & 1u)) >> 16; }
DI unsigned pk2(float lo, float hi) { return f2bf(lo) | (f2bf(hi) << 16); }
DI float bf2f(unsigned short b) { return __builtin_bit_cast(float, (unsigned)b << 16); }
DI float bflo(unsigned w) { return __builtin_bit_cast(float, w << 16); }
DI float bfhi(unsigned w) { return __builtin_bit_cast(float, w & 0xffff0000u); }
DI float wave_sum(float v) {
#pragma unroll
    for (int o = 1; o < 64; o <<= 1) v += __shfl_xor(v, o);
    return v;
}
DI unsigned cvtpk(float lo, float hi) { f32x2 v = {lo, hi}; bf16x2_t b = __builtin_convertvector(v, bf16x2_t); return __builtin_bit_cast(unsigned, b); }
template <int CTRL> DI unsigned dpp_u(unsigned v) { return (unsigned)__builtin_amdgcn_update_dpp(0, (int)v, CTRL, 0xF, 0xF, false); }
template <int CTRL> DI float dpp_f(float v) { return __builtin_bit_cast(float, __builtin_amdgcn_update_dpp(0, __builtin_bit_cast(int, v), CTRL, 0xF, 0xF, false)); }
DI float bperm_f(int addr, float v) { return __builtin_bit_cast(float, __builtin_amdgcn_ds_bpermute(addr, __builtin_bit_cast(int, v))); }
DI unsigned row_max16(unsigned m) { m = max(m, dpp_u<0xB1>(m)); m = max(m, dpp_u<0x4E>(m)); m = max(m, dpp_u<0x141>(m)); return max(m, dpp_u<0x140>(m)); }
DI float row_sum16(float v) { v += dpp_f<0xB1>(v); v += dpp_f<0x4E>(v); v += dpp_f<0x141>(v); return v + dpp_f<0x140>(v); }

DI float fast_sig(float z) { return __builtin_amdgcn_rcpf(1.0f + __builtin_amdgcn_exp2f(-1.4426950408889634f * z)); }
DI float sigmoidf_(float z) { return 1.0f / (1.0f + __expf(-z)); }

namespace pg8 {
constexpr int BM = 256, BK = 64, HALF = 128, HTB = HALF * BK * 2, STAGE_BYTES = 8 * HTB, NXCD = 8, WGM = 8;
__host__ __device__ __forceinline__ int lds_byte(int r, int c) { const int st = (r >> 4) * 2 + (c >> 5), rr = r & 15, cc = c & 31, ob = rr * 64 + cc * 2; return st * 1024 + (ob ^ (((ob >> 9) & 1) << 5)); }
__host__ __device__ __forceinline__ void stage_rc(int b, int& R, int& C) { const int st = b / 1024, sb = b % 1024, swz = sb ^ (((sb >> 9) & 1) << 5); R = (st >> 1) * 16 + swz / 64; C = (st & 1) * 32 + (swz % 64) / 2; }
__host__ __device__ __forceinline__ int perm32(int rho) { const int n = rho >> 4, i = rho & 15; return 8 * (i >> 2) + 4 * n + (i & 3); }

struct Unit { int pm, pn, z; };
struct Gemm { int lda, ldb, K; };

struct StaticOrder {
    int nM, nN, nwg, G, c;
    __device__ void init(int M, int N, int G_, int c_) { nM = M / BM; nN = N / BM; nwg = nM * nN; G = G_; c = c_; }
    __device__ bool tile(int i, Unit& u) const {
        const long L = (long)i * G + c; if (L >= nwg) return false;
        int wgid = (int)L; { const int q = nwg / NXCD, r = nwg % NXCD, xcd = wgid % NXCD, off = wgid / NXCD; wgid = (xcd < r ? xcd * (q + 1) : r * (q + 1) + (xcd - r) * q) + off; }
        const int nig = WGM * nN, gid = wgid / nig, fm = gid * WGM, gsz = (nM - fm) < WGM ? (nM - fm) : WGM;
        u.pm = fm + ((wgid % nig) % gsz); u.pn = (wgid % nig) / gsz; u.z = 0; return true;
    }
};

DI unsigned cvt_pk_bf16(float lo, float hi) { return cvtpk(lo, hi); }

template <class Epi, class Sched, bool ALIGN_EPI, bool SP2>
DI void gemm_phase(LAS unsigned char* lds, const Gemm g, const Sched& S, const Epi& E) {
    int tid_ = threadIdx.x; asm volatile("" : "+v"(tid_));
    const int tid = tid_, wid = __builtin_amdgcn_readfirstlane(tid >> 6), lane = tid & 63, wr = wid >> 2, wc = wid & 3, fr = lane & 15, fq = lane >> 4;
    int K_ = g.K; asm volatile("" : "+s"(K_));
    const int K = K_, nt = K / BK;
    unsigned voffA[2], voffB[2];
#pragma unroll
    for (int i = 0; i < 2; ++i) { int R, C; stage_rc(tid * 16 + i * 8192, R, C); const int Rb = Epi::PERM ? ((R & ~31) + perm32(R & 31)) : R;
        voffA[i] = (unsigned)(R * g.lda + C) * 2u; voffB[i] = (unsigned)(Rb * g.ldb + C) * 2u; }
    const size_t kstep = (size_t)(BK * 2);
    const size_t hA = (size_t)HALF * g.lda * 2, hB = (size_t)HALF * g.ldb * 2;
    const unsigned ldsw = (unsigned)wid * 1024u;
    const int aoff = lds_byte(wr * 64 + fr, fq * 8), boff = lds_byte(wc * 32 + fr, fq * 8);
#define PG8_SA(b, h) (((b) * 2 + (h)) * HTB)
#define PG8_SB(b, h) ((4 + (b) * 2 + (h)) * HTB)
#define PG8_STAGE(bufoff, gbase, voff) do { _Pragma("unroll") for (int _i = 0; _i < 2; ++_i) \
        __builtin_amdgcn_global_load_lds((const unsigned*)((const char*)(gbase) + (voff)[_i]), (LAS unsigned*)(lds + (bufoff) + ldsw + _i * 8192), 16, 0, 0); } while (0)
#define PG8_LDA(dst, b, h) do { _Pragma("unroll") for (int m = 0; m < 4; ++m) _Pragma("unroll") for (int k = 0; k < 2; ++k) dst[m][k] = *(const LAS bf16x8*)(lds + PG8_SA(b, h) + aoff + m * 2048 + k * 1024); } while (0)
#define PG8_LDB(dst, b, h) do { _Pragma("unroll") for (int n = 0; n < 2; ++n) _Pragma("unroll") for (int k = 0; k < 2; ++k) dst[n][k] = *(const LAS bf16x8*)(lds + PG8_SB(b, h) + boff + n * 2048 + k * 1024); } while (0)
#define PG8_MMA(ai, bj, At, Bt) do { __builtin_amdgcn_s_setprio(1); _Pragma("unroll") for (int m = 0; m < 4; ++m) _Pragma("unroll") for (int n = 0; n < 2; ++n) _Pragma("unroll") for (int k = 0; k < 2; ++k) \
        acc[ai][bj][m][n] = __builtin_amdgcn_mfma_f32_16x16x32_bf16(Bt[n][k], At[m][k], acc[ai][bj][m][n], 0, 0, 0); __builtin_amdgcn_s_setprio(0); } while (0)
#define PG8_WAIT_V(n) asm volatile("s_waitcnt vmcnt(" #n ")" ::: "memory")
#define PG8_WAIT_L(n) asm volatile("s_waitcnt lgkmcnt(" #n ")" ::: "memory")
#define PG8_BAR __builtin_amdgcn_s_barrier()
#define PG8_SCHED __builtin_amdgcn_sched_barrier(0)
    Unit cur, nxt; int ui = 0;
    if (!S.next(0, cur)) return;
    f32x4 acc[2][2][4][2];
#pragma unroll
    for (int a = 0; a < 2; ++a)
#pragma unroll
        for (int b = 0; b < 2; ++b)
#pragma unroll
            for (int m = 0; m < 4; ++m)
#pragma unroll
                for (int n = 0; n < 2; ++n) acc[a][b][m][n] = (f32x4){0.f, 0.f, 0.f, 0.f};
    bf16x8 At[4][2], B0[2][2], B1[2][2];
    const char* cA = S.a_base(cur); const char* cB = S.b_base(cur);
    if constexpr (SP2) {
        PG8_STAGE(PG8_SB(0, 0), cB, voffB); PG8_STAGE(PG8_SB(0, 1), cB + hB, voffB); PG8_STAGE(PG8_SA(0, 0), cA, voffA); PG8_STAGE(PG8_SA(0, 1), cA + hA, voffA);
        if (wr == 1) PG8_BAR;
        PG8_WAIT_V(2); PG8_BAR;
        PG8_STAGE(PG8_SB(1, 0), cB + kstep, voffB); PG8_STAGE(PG8_SA(1, 0), cA + kstep, voffA); PG8_STAGE(PG8_SB(1, 1), cB + hB + kstep, voffB);
        PG8_WAIT_V(6); PG8_BAR;
    } else {
        PG8_STAGE(PG8_SB(0, 0), cB, voffB); PG8_STAGE(PG8_SA(0, 0), cA, voffA); PG8_STAGE(PG8_SB(0, 1), cB + hB, voffB); PG8_STAGE(PG8_SA(0, 1), cA + hA, voffA);
        if (wr == 1) PG8_BAR;
        PG8_WAIT_V(4); PG8_BAR;
        PG8_STAGE(PG8_SB(1, 0), cB + kstep, voffB); PG8_STAGE(PG8_SA(1, 0), cA + kstep, voffA); PG8_STAGE(PG8_SB(1, 1), cB + hB + kstep, voffB);
        PG8_WAIT_V(6); PG8_BAR;
    }
    for (;;) {
        const bool has_next = S.next(ui + 1, nxt);
        const char* nA = has_next ? S.a_base(nxt) : cA; const char* nB = has_next ? S.b_base(nxt) : cB;
        for (int t = 0; t < nt; t += 2) {
            const bool last = (t == nt - 2);
            const char* a1 = cA + (size_t)(t + 1) * kstep;
            const char* a2 = last ? nA : cA + (size_t)(t + 2) * kstep; const char* b2 = last ? nB : cB + (size_t)(t + 2) * kstep;
            const char* a3 = a2 + kstep; const char* b3 = b2 + kstep;
            if constexpr (SP2) {
            PG8_LDB(B0, 0, 0); PG8_LDB(B1, 0, 1); PG8_SCHED; PG8_LDA(At, 0, 0); PG8_STAGE(PG8_SA(1, 1), a1 + hA, voffA);
            PG8_WAIT_V(8); PG8_WAIT_L(0); PG8_BAR; PG8_MMA(0, 0, At, B0); PG8_MMA(0, 1, At, B1); PG8_BAR; PG8_SCHED;
            PG8_LDA(At, 0, 1); PG8_STAGE(PG8_SB(0, 0), b2, voffB); PG8_STAGE(PG8_SB(0, 1), b2 + hB, voffB); PG8_STAGE(PG8_SA(0, 0), a2, voffA);
            PG8_WAIT_V(8); PG8_WAIT_L(0); PG8_BAR; PG8_MMA(1, 0, At, B0); PG8_MMA(1, 1, At, B1); PG8_BAR; PG8_SCHED;
            PG8_LDB(B0, 1, 0); PG8_LDB(B1, 1, 1); PG8_SCHED; PG8_LDA(At, 1, 0); PG8_STAGE(PG8_SA(0, 1), a2 + hA, voffA);
            PG8_WAIT_V(8); PG8_WAIT_L(0); PG8_BAR; PG8_MMA(0, 0, At, B0); PG8_MMA(0, 1, At, B1); PG8_BAR; PG8_SCHED;
            PG8_LDA(At, 1, 1); PG8_STAGE(PG8_SB(1, 0), b3, voffB); PG8_STAGE(PG8_SB(1, 1), b3 + hB, voffB); PG8_STAGE(PG8_SA(1, 0), a3, voffA);
            PG8_WAIT_V(8); PG8_WAIT_L(0); PG8_BAR; PG8_MMA(1, 0, At, B0); PG8_MMA(1, 1, At, B1); PG8_BAR; PG8_SCHED;
            } else {
            PG8_LDB(B0, 0, 0); PG8_SCHED; PG8_LDA(At, 0, 0); PG8_STAGE(PG8_SA(1, 1), a1 + hA, voffA);
            PG8_WAIT_L(8); PG8_BAR; PG8_WAIT_L(0); PG8_MMA(0, 0, At, B0); PG8_BAR; PG8_SCHED;
            PG8_LDB(B1, 0, 1); PG8_STAGE(PG8_SB(0, 0), b2, voffB);
            PG8_BAR; PG8_WAIT_L(0); PG8_MMA(0, 1, At, B1); PG8_BAR;
            PG8_LDA(At, 0, 1); PG8_STAGE(PG8_SA(0, 0), a2, voffA);
            PG8_BAR; PG8_WAIT_L(0); PG8_MMA(1, 0, At, B0); PG8_BAR; PG8_SCHED;
            PG8_STAGE(PG8_SB(0, 1), b2 + hB, voffB);
            PG8_WAIT_V(6); PG8_BAR; PG8_MMA(1, 1, At, B1); PG8_BAR;
            PG8_LDB(B0, 1, 0); PG8_SCHED; PG8_LDA(At, 1, 0); PG8_STAGE(PG8_SA(0, 1), a2 + hA, voffA);
            PG8_WAIT_L(8); PG8_BAR; PG8_WAIT_L(0); PG8_MMA(0, 0, At, B0); PG8_BAR; PG8_SCHED;
            PG8_LDB(B1, 1, 1); PG8_STAGE(PG8_SB(1, 0), b3, voffB);
            PG8_BAR; PG8_WAIT_L(0); PG8_MMA(0, 1, At, B1); PG8_BAR;
            PG8_LDA(At, 1, 1); PG8_STAGE(PG8_SA(1, 0), a3, voffA);
            PG8_BAR; PG8_WAIT_L(0); PG8_MMA(1, 0, At, B0); PG8_BAR; PG8_SCHED;
            PG8_STAGE(PG8_SB(1, 1), b3 + hB, voffB);
            PG8_WAIT_V(6); PG8_BAR; PG8_MMA(1, 1, At, B1); PG8_BAR;
            }
        }
        if constexpr (ALIGN_EPI) { if (wr == 0) PG8_BAR; }
        E(acc, cur, wr, wc, fr, fq);
        if (!has_next) break;
#pragma unroll
        for (int a = 0; a < 2; ++a)
#pragma unroll
            for (int b = 0; b < 2; ++b)
#pragma unroll
                for (int m = 0; m < 4; ++m)
#pragma unroll
                    for (int n = 0; n < 2; ++n) acc[a][b][m][n] = (f32x4){0.f, 0.f, 0.f, 0.f};
        cur = nxt; cA = nA; cB = nB; ++ui;
        if constexpr (ALIGN_EPI) { if (wr == 1) PG8_BAR; }
    }
    PG8_WAIT_V(0);
    if constexpr (!ALIGN_EPI) { if (wr == 0) PG8_BAR; }
    PG8_BAR;
#undef PG8_SA
#undef PG8_SB
#undef PG8_STAGE
#undef PG8_LDA
#undef PG8_LDB
#undef PG8_MMA
#undef PG8_WAIT_V
#undef PG8_WAIT_L
#undef PG8_BAR
#undef PG8_SCHED
}
}

namespace pg8 {
struct PlainOrder : StaticOrder {
    const char* A; const char* Bt; size_t a_tile, b_tile;
    __device__ bool next(int i, Unit& u) const { return tile(i, u); }
    DI const char* a_base(const Unit& u) const { return A + (size_t)u.pm * a_tile; }
    DI const char* b_base(const Unit& u) const { return Bt + (size_t)u.pn * b_tile; }
};
struct InOrder : StaticOrder {
    const char* H; const char* Win; const char* Mn; const char* Wkv; int n_extra;
    __device__ bool next(int i, Unit& u) const {
        const long L = (long)i * G + c;
        if (L >= (long)nwg + n_extra) return false;
        Unit t; t.pm = 0; t.pn = 0; t.z = 0;
        const bool main_tile = L < nwg;
        if (main_tile) (void)tile(i, t);
        const int e = (int)(L - nwg);
        const int pm1 = e >> 1, pn1 = e & 1, pm2 = (e - 32) >> 4, pn2 = (e - 32) & 15; const bool k1 = e < 32;
        u.pm = main_tile ? t.pm : (k1 ? pm1 : pm2); u.pn = main_tile ? t.pn : (k1 ? pn1 : pn2); u.z = main_tile ? 0 : (k1 ? 1 : 2);
        return true;
    }
    DI const char* a_base(const Unit& u) const { const long d1 = Mn - H, d2 = (Wkv + (size_t)512 * 1024 * 2) - H; return H + ((u.z == 1) ? d1 : 0L) + ((u.z == 2) ? d2 : 0L) + (size_t)u.pm * (256 * 1024 * 2); }
    DI const char* b_base(const Unit& u) const { const long d1 = Wkv - Win, d2 = Mn - Win; return Win + ((u.z == 1) ? d1 : 0L) + ((u.z == 2) ? d2 : 0L) + (size_t)u.pn * (256 * 1024 * 2); }
};
struct EpiIn {
    static constexpr bool PERM = true;
    bf16* proj; bf16* kmem; bf16* vt;
    DI void operator()(const f32x4 (&acc)[2][2][4][2], const Unit& u, int wr, int wc, int fr, int fq) const {
        const long dk = kmem - proj, dv = vt - proj; bf16* O = proj + ((u.z == 1) ? dk : 0L) + ((u.z == 2) ? dv : 0L); const int ldc = PC + ((u.z == 1) ? 512 - PC : 0) + ((u.z == 2) ? BATCH * NMEM - PC : 0);
        const int row0 = u.pm * BM + wr * 64 + fr, col0 = u.pn * BM + wc * 32 + 8 * fq;
#pragma unroll
        for (int ai = 0; ai < 2; ++ai)
#pragma unroll
            for (int m = 0; m < 4; ++m) { bf16* rowp = O + (size_t)(row0 + ai * HALF + m * 16) * ldc + col0;
#pragma unroll
                for (int bj = 0; bj < 2; ++bj) { const f32x4 v0 = acc[ai][bj][m][0], v1 = acc[ai][bj][m][1];
                    u32x4 w; w.x = cvt_pk_bf16(v0[0], v0[1]); w.y = cvt_pk_bf16(v0[2], v0[3]); w.z = cvt_pk_bf16(v1[0], v1[1]); w.w = cvt_pk_bf16(v1[2], v1[3]);
                    *(u32x4*)(rowp + bj * HALF) = w; } }
    }
};
struct BranchOrder : StaticOrder {
    const char* Y; const char* Wb;
    __device__ bool next(int i, Unit& u) const { if (!tile(i / 3, u)) return false; u.z = i % 3; return true; }
    DI const char* a_base(const Unit& u) const { return Y + (size_t)u.z * (16 * MiB) + (size_t)u.pm * (256 * 512 * 2); }
    DI const char* b_base(const Unit& u) const { return Wb + (size_t)u.z * (1024 * 512 * 2) + (size_t)u.pn * (256 * 512 * 2); }
};
struct ScoreOrder : StaticOrder {
    const char* Q; const char* Kbd;
    __device__ bool next(int i, Unit& u) const { return tile(i, u); }
    DI const char* a_base(const Unit& u) const { return Q + (size_t)u.pm * (256 * 2048 * 2) + (size_t)u.pn * 512; }
    DI const char* b_base(const Unit& u) const { return Kbd + (size_t)u.pn * (256 * 256 * 2); }
};

struct EpiBf16 {
    static constexpr bool PERM = true;
    bf16* O; int ldc;
    DI void operator()(const f32x4 (&acc)[2][2][4][2], const Unit& u, int wr, int wc, int fr, int fq) const {
        const int row0 = u.pm * BM + wr * 64 + fr, col0 = u.pn * BM + wc * 32 + 8 * fq;
#pragma unroll
        for (int ai = 0; ai < 2; ++ai)
#pragma unroll
            for (int m = 0; m < 4; ++m) { bf16* rowp = O + (size_t)(row0 + ai * HALF + m * 16) * ldc + col0;
#pragma unroll
                for (int bj = 0; bj < 2; ++bj) { const f32x4 v0 = acc[ai][bj][m][0], v1 = acc[ai][bj][m][1];
                    u32x4 w; w.x = cvt_pk_bf16(v0[0], v0[1]); w.y = cvt_pk_bf16(v0[2], v0[3]); w.z = cvt_pk_bf16(v1[0], v1[1]); w.w = cvt_pk_bf16(v1[2], v1[3]);
                    *(u32x4*)(rowp + bj * HALF) = w; } }
    }
};
struct EpiQ {
    static constexpr bool PERM = true;
    bf16* O; int ldc; const float* ssp;
    DI void operator()(const f32x4 (&acc)[2][2][4][2], const Unit& u, int wr, int wc, int fr, int fq) const {
        const int row0 = u.pm * BM + wr * 64 + fr, col0 = u.pn * BM + wc * 32 + 8 * fq;
#pragma unroll
        for (int ai = 0; ai < 2; ++ai)
#pragma unroll
            for (int m = 0; m < 4; ++m) { const int row = row0 + ai * HALF + m * 16; const f32x4* sp = (const f32x4*)(ssp + (size_t)row * 16);
                const f32x4 s0 = sp[0], s1 = sp[1], s2 = sp[2], s3 = sp[3];
                const float ss = ((s0[0] + s0[1]) + (s0[2] + s0[3])) + ((s1[0] + s1[1]) + (s1[2] + s1[3])) + ((s2[0] + s2[1]) + (s2[2] + s2[3])) + ((s3[0] + s3[1]) + (s3[2] + s3[3]));
                const float rs = 1.0f / sqrtf(ss * (1.0f / 1024.0f) + EPS);
                bf16* rowp = O + (size_t)row * ldc + col0;
#pragma unroll
                for (int bj = 0; bj < 2; ++bj) { const f32x4 v0 = acc[ai][bj][m][0] * rs, v1 = acc[ai][bj][m][1] * rs;
                    u32x4 w; w.x = cvt_pk_bf16(v0[0], v0[1]); w.y = cvt_pk_bf16(v0[2], v0[3]); w.z = cvt_pk_bf16(v1[0], v1[1]); w.w = cvt_pk_bf16(v1[2], v1[3]);
                    *(u32x4*)(rowp + bj * HALF) = w; }
                asm volatile("" ::: "memory"); }
    }
};
struct EpiF32 {
    static constexpr bool PERM = false;
    float* C; int ldc;
    DI void operator()(const f32x4 (&acc)[2][2][4][2], const Unit& u, int wr, int wc, int fr, int fq) const {
        const int row0 = u.pm * BM + wr * 64 + fr, col0 = u.pn * BM + wc * 32 + 4 * fq;
#pragma unroll
        for (int ai = 0; ai < 2; ++ai)
#pragma unroll
            for (int m = 0; m < 4; ++m) { float* rowp = C + (size_t)(row0 + ai * HALF + m * 16) * ldc + col0;
#pragma unroll
                for (int bj = 0; bj < 2; ++bj)
#pragma unroll
                    for (int n = 0; n < 2; ++n) *(f32x4*)(rowp + bj * HALF + n * 16) = acc[ai][bj][m][n]; }
    }
};
struct EpiBranch {
    static constexpr bool PERM = true;
    const bf16* proj; bf16* gbuf; bf16* merged;
    DI void operator()(const f32x4 (&acc)[2][2][4][2], const Unit& u, int wr, int wc, int fr, int fq) const {
        const int row0 = u.pm * BM + wr * 64 + fr, col0 = u.pn * BM + wc * 32 + 8 * fq;
#pragma unroll
        for (int ai = 0; ai < 2; ++ai)
#pragma unroll
            for (int m = 0; m < 4; ++m) { const int row = row0 + ai * HALF + m * 16;
#pragma unroll
                for (int bj = 0; bj < 2; ++bj) { const int col = col0 + bj * HALF;
                    const u32x4 gw = *(const u32x4*)(proj + (size_t)row * PC + C_GATE + u.z * 1024 + col);
                    f32x4 v0 = acc[ai][bj][m][0], v1 = acc[ai][bj][m][1];
                    v0[0] *= fast_sig(bflo(gw.x)); v0[1] *= fast_sig(bfhi(gw.x)); v0[2] *= fast_sig(bflo(gw.y)); v0[3] *= fast_sig(bfhi(gw.y));
                    v1[0] *= fast_sig(bflo(gw.z)); v1[1] *= fast_sig(bfhi(gw.z)); v1[2] *= fast_sig(bflo(gw.w)); v1[3] *= fast_sig(bfhi(gw.w));
                    const size_t off = (size_t)row * 1024 + col;
                    if (u.z == 2) { const u32x4 p0 = *(const u32x4*)(gbuf + off), p1 = *(const u32x4*)(gbuf + (size_t)TG * 1024 + off);
                        v0[0] += bflo(p0.x) + bflo(p1.x); v0[1] += bfhi(p0.x) + bfhi(p1.x); v0[2] += bflo(p0.y) + bflo(p1.y); v0[3] += bfhi(p0.y) + bfhi(p1.y);
                        v1[0] += bflo(p0.z) + bflo(p1.z); v1[1] += bfhi(p0.z) + bfhi(p1.z); v1[2] += bflo(p0.w) + bflo(p1.w); v1[3] += bfhi(p0.w) + bfhi(p1.w); }
                    u32x4 w; w.x = cvt_pk_bf16(v0[0], v0[1]); w.y = cvt_pk_bf16(v0[2], v0[3]); w.z = cvt_pk_bf16(v1[0], v1[1]); w.w = cvt_pk_bf16(v1[2], v1[3]);
                    *(u32x4*)((u.z == 2 ? merged : gbuf + (size_t)u.z * TG * 1024) + off) = w; }
                asm volatile("" ::: "memory"); }
    }
};
struct EpiOut {
    static constexpr bool PERM = true;
    const float* x; float* x1; bf16* xg; const float* gffn; float* ssp;
    DI void operator()(const f32x4 (&acc)[2][2][4][2], const Unit& u, int wr, int wc, int fr, int fq) const {
        const int row0 = u.pm * BM + wr * 64 + fr, col0 = u.pn * BM + wc * 32 + 8 * fq;
        f32x4 g0[2], g1[2];
#pragma unroll
        for (int bj = 0; bj < 2; ++bj) { g0[bj] = *(const f32x4*)(gffn + col0 + bj * HALF); g1[bj] = *(const f32x4*)(gffn + col0 + bj * HALF + 4); }
#pragma unroll
        for (int ai = 0; ai < 2; ++ai)
#pragma unroll
            for (int m = 0; m < 4; ++m) { const int row = row0 + ai * HALF + m * 16; float ss = 0.f;
#pragma unroll
                for (int bj = 0; bj < 2; ++bj) { const size_t off = (size_t)row * 1024 + col0 + bj * HALF;
                    const f32x4 v0 = acc[ai][bj][m][0] + *(const f32x4*)(x + off), v1 = acc[ai][bj][m][1] + *(const f32x4*)(x + off + 4);
                    *(f32x4*)(x1 + off) = v0; *(f32x4*)(x1 + off + 4) = v1;
                    ss += (v0[0] * v0[0] + v0[1] * v0[1]) + (v0[2] * v0[2] + v0[3] * v0[3]) + (v1[0] * v1[0] + v1[1] * v1[1]) + (v1[2] * v1[2] + v1[3] * v1[3]);
                    const f32x4 a = v0 * g0[bj], b = v1 * g1[bj];
                    u32x4 w; w.x = cvt_pk_bf16(a[0], a[1]); w.y = cvt_pk_bf16(a[2], a[3]); w.z = cvt_pk_bf16(b[0], b[1]); w.w = cvt_pk_bf16(b[2], b[3]);
                    *(u32x4*)(xg + off) = w; }
                ss += __shfl_xor(ss, 16); ss += __shfl_xor(ss, 32);
                if (fq == 0) ssp[(size_t)row * 16 + u.pn * 4 + wc] = ss;
                asm volatile("" ::: "memory"); }
    }
};
}

#define XB_TMO      128
#define XB_XCNT(j)  (256  + 64 * (j))
#define XB_XSUB(j)  (1280 + 64 * (j))
#define XB_XGEN(j)  (2304 + 64 * (j))
#define XB_TOP      3328
#define XB_TOPGEN   3392
#define XCD_BAR_WORDS 3456
#define XB_SPIN_CAP (1u << 18)
constexpr int CW_BAR = 4096;

DI unsigned xb_ld(unsigned* p)              { return __hip_atomic_load(p, __ATOMIC_RELAXED, __HIP_MEMORY_SCOPE_AGENT); }
DI unsigned xb_add(unsigned* p, unsigned v) { return __hip_atomic_fetch_add(p, v, __ATOMIC_RELAXED, __HIP_MEMORY_SCOPE_AGENT); }
DI unsigned xb_xcc_id() { return (unsigned)__builtin_amdgcn_s_getreg((3 << 11) | 20) & 0xFu; }
#define XB_SPIN(cond, bar) do { unsigned _sp = 0; while (cond) { __builtin_amdgcn_s_sleep(1); \
    if ((++_sp & 255u) == 0u) { if (xb_ld(&(bar)[XB_TMO])) break; if (_sp > XB_SPIN_CAP) { atomicAdd(&(bar)[XB_TMO], 1u); break; } } } } while (0)

struct XcdBarrier { unsigned* bar; unsigned x; volatile LAS unsigned* st; };

DI XcdBarrier xcd_barrier_post(unsigned* bar, volatile LAS unsigned* st) {
    XcdBarrier b; b.bar = bar; b.x = xb_xcc_id(); b.st = st;
    if (threadIdx.x == 0) (void)xb_add(&bar[XB_XCNT(b.x)], 1u);
    return b;
}
DI void xcd_barrier_complete(unsigned* bar, unsigned x, unsigned& nloc, unsigned& nx) {
    const unsigned G = gridDim.x * gridDim.y * gridDim.z;
    unsigned sum, cnt, mine, sp = 0u;
    for (;;) {
        sum = 0u; cnt = 0u; mine = 0u;
#pragma unroll
        for (unsigned j = 0; j < 16; ++j) { const unsigned c = xb_ld(&bar[XB_XCNT(j)]); sum += c; cnt += (c > 0u) ? 1u : 0u; mine = (j == x) ? c : mine; }
        if (sum == G) break;
        __builtin_amdgcn_s_sleep(1);
        if ((++sp & 255u) == 0u) { if (xb_ld(&bar[XB_TMO])) break; if (sp > XB_SPIN_CAP) { atomicAdd(&bar[XB_TMO], 1u); break; } }
    }
    nloc = mine > 0u ? mine : 1u; nx = cnt > 0u ? cnt : 1u;
}
DI void xcd_barrier(const XcdBarrier& b) {
    asm volatile("s_waitcnt vmcnt(0)" ::: "memory");
    __syncthreads();
    if (threadIdx.x == 0) {
        unsigned* bar = b.bar;
        __builtin_amdgcn_s_waitcnt(0);
        unsigned nloc = b.st[0], nx = b.st[1];
        if (nloc == 0u) { xcd_barrier_complete(bar, b.x, nloc, nx); b.st[0] = nloc; b.st[1] = nx; }
        const unsigned old = xb_add(&bar[XB_XSUB(b.x)], 1u);
        const unsigned gen = old / nloc;
        if (old + 1u == (gen + 1u) * nloc) {
            __builtin_amdgcn_fence(__ATOMIC_RELEASE, "agent");
            asm volatile("s_waitcnt vmcnt(0)" ::: "memory");
            const unsigned og = xb_add(&bar[XB_TOP], 1u);
            const unsigned tg = og / nx;
            if (og + 1u == (tg + 1u) * nx) xb_add(&bar[XB_TOPGEN], 1u);
            else XB_SPIN(xb_ld(&bar[XB_TOPGEN]) == tg, bar);
            __builtin_amdgcn_fence(__ATOMIC_ACQUIRE, "agent");
            xb_add(&bar[XB_XGEN(b.x)], 1u);
            asm volatile("s_waitcnt vmcnt(0)" ::: "memory");
        } else {
            XB_SPIN(xb_ld(&bar[XB_XGEN(b.x)]) == gen, bar);
            __builtin_amdgcn_fence(__ATOMIC_ACQUIRE, "agent");
            asm volatile("s_waitcnt vmcnt(0)" ::: "memory");
        }
    }
    __syncthreads();
}

struct Frame {
    LAS unsigned char* lds;
    int tid, lane, wave;
    DI void refresh() { int t = threadIdx.x; asm volatile("" : "+v"(t)); tid = t; lane = t & 63; wave = __builtin_amdgcn_readfirstlane(t >> 6); }
    int vcu, G;
    const float *x, *mem, *norm_mix_g, *w_in, *hg_lb, *hg_norm_g, *sc_conv_w, *mem_norm_g, *w_mem_kv, *w_branch, *w_out, *norm_ffn_g, *peer_w_q, *peer_sub_keys, *peer_u, *peer_v, *final_norm_g;
    float* out; unsigned char* ws;
};

DI void p0_transpose_item(const float* W, int K, int N, bf16* WT, LAS float* scr, int item, int lane) {
    const int nblk = N / 32, kb = item / nblk, nb = item % nblk, k0 = 64 * kb, n0 = 32 * nb;
#pragma unroll 8
    for (int i = 0; i < 32; ++i) { const int kk = 2 * i + (lane >> 5); scr[kk * 33 + (lane & 31)] = W[(size_t)(k0 + kk) * N + n0 + (lane & 31)]; }
    asm volatile("s_waitcnt lgkmcnt(0)" ::: "memory");
    const int c = lane & 7;
#pragma unroll
    for (int j = 0; j < 4; ++j) { const int n = (lane >> 3) + 8 * j; const LAS float* s = scr + (8 * c) * 33 + n;
        u32x4 o; o.x = pk2(s[0 * 33], s[1 * 33]); o.y = pk2(s[2 * 33], s[3 * 33]); o.z = pk2(s[4 * 33], s[5 * 33]); o.w = pk2(s[6 * 33], s[7 * 33]);
        *(u32x4*)(WT + (size_t)(n0 + n) * K + k0 + 8 * c) = o; }
    asm volatile("s_waitcnt lgkmcnt(0)" ::: "memory");
}
DI void rms_row_to_bf16(const float* xrow, const float* g, bf16* orow, int lane) {
    const f32x4* xr = (const f32x4*)xrow + lane; const f32x4* gr = (const f32x4*)g + lane;
    f32x4 v[4]; float s = 0.f;
#pragma unroll
    for (int j = 0; j < 4; ++j) { v[j] = xr[64 * j]; s += (v[j].x * v[j].x + v[j].y * v[j].y) + (v[j].z * v[j].z + v[j].w * v[j].w); }
    const float rstd = 1.0f / sqrtf(wave_sum(s) * (1.f / 1024.f) + EPS);
    unsigned long long* o8 = (unsigned long long*)orow + lane;
#pragma unroll
    for (int j = 0; j < 4; ++j) { const f32x4 gg = gr[64 * j]; const f32x4 y = v[j] * rstd * gg;
        o8[64 * j] = (unsigned long long)pk2(y.x, y.y) | ((unsigned long long)pk2(y.z, y.w) << 32); }
}
DI void p0_prologue(Frame& F) {
    F.refresh();
    LAS float* scr = (LAS float*)(F.lds + F.wave * 16384);
    const int gw = F.vcu * NWAVES + F.wave, NGW = F.G * NWAVES;
    unsigned char* ws = F.ws;
    constexpr int I_IN = (1024 / 64) * (PC / 32), I_KV = (1024 / 64) * (1024 / 32), I_BR = (512 / 64) * (1024 / 32), I_OUT = (1024 / 64) * (1024 / 32), I_Q = (1024 / 64) * (2048 / 32);
    constexpr int NITEMS = I_IN + I_KV + 3 * I_BR + I_OUT + I_Q;
    for (int it = gw; it < NITEMS; it += NGW) {
        int r = it;
        if (r < I_IN) { p0_transpose_item(F.w_in, 1024, PC, (bf16*)(ws + WS_WIN), scr, r, F.lane); continue; } r -= I_IN;
        if (r < I_KV) { p0_transpose_item(F.w_mem_kv, 1024, 1024, (bf16*)(ws + WS_WKV), scr, r, F.lane); continue; } r -= I_KV;
        if (r < 3 * I_BR) { const int n = r / I_BR; p0_transpose_item(F.w_branch + (size_t)n * 512 * 1024, 512, 1024, (bf16*)(ws + WS_WBR) + (size_t)n * 1024 * 512, scr, r % I_BR, F.lane); continue; } r -= 3 * I_BR;
        if (r < I_OUT) { p0_transpose_item(F.w_out, 1024, 1024, (bf16*)(ws + WS_WOUT), scr, r, F.lane); continue; } r -= I_OUT;
        p0_transpose_item(F.peer_w_q, 1024, 2048, (bf16*)(ws + WS_WQ), scr, r, F.lane);
    }
    const int gt = F.vcu * 512 + F.tid, NGT = F.G * 512;
    for (int it = gt; it < 8 * 256 * 32; it += NGT) {
        const int c8 = it & 31, row = (it >> 5) & 255, h = it >> 13, p = row >> 7, key = row & 127;
        u32x4 o = (u32x4){0u, 0u, 0u, 0u};
        if ((c8 >> 4) == p) { const float* s = F.peer_sub_keys + (((size_t)(h * 2 + p) * 128 + key) * 128 + (c8 & 15) * 8);
            const f32x4 a = *(const f32x4*)s, b = *(const f32x4*)(s + 4); o.x = pk2(a.x, a.y); o.y = pk2(a.z, a.w); o.z = pk2(b.x, b.y); o.w = pk2(b.z, b.w); }
        *(u32x4*)((bf16*)(ws + WS_KBD) + ((size_t)(h * 256 + row) * 256 + c8 * 8)) = o;
    }
    for (int it = gt; it < 1024; it += NGT) { const float a0 = F.hg_lb[it], a1 = F.hg_lb[1024 + it]; const float m = fmaxf(a0, a1); const float e0 = __expf(a0 - m), e1 = __expf(a1 - m);
        ((float*)(ws + WS_LB))[it] = e0 / (e0 + e1); }
    for (int m = gw; m < BATCH * NMEM; m += NGW) rms_row_to_bf16(F.mem + (size_t)m * 1024, F.mem_norm_g, (bf16*)(ws + WS_MN) + (size_t)m * 1024, F.lane);
    for (int m = gw; m < T_ALL; m += NGW) rms_row_to_bf16(F.x + (size_t)m * 1024, F.norm_mix_g, (bf16*)(ws + WS_XG) + (size_t)m * 1024, F.lane);
}

DI s16x4 tr16(const LAS unsigned char* p) { return __builtin_bit_cast(s16x4, __builtin_amdgcn_ds_read_tr16_b64_v4i16((LAS v4i16_t*)p)); }
DI bf16x8 cat8(s16x4 lo, s16x4 hi) { return __builtin_shufflevector(lo, hi, 0, 1, 2, 3, 4, 5, 6, 7); }
#define MFMA32(a, b, c) __builtin_amdgcn_mfma_f32_32x32x16_bf16((a), (b), (c), 0, 0, 0)
DI int crow(int reg, int h) { return (reg & 3) + 8 * (reg >> 2) + 4 * h; }
DI bf16x8 pack8(const f32x16& x, int s) {
    u32x4 p; p.x = cvtpk(x[8 * s], x[8 * s + 1]); p.y = cvtpk(x[8 * s + 2], x[8 * s + 3]); p.z = cvtpk(x[8 * s + 4], x[8 * s + 5]); p.w = cvtpk(x[8 * s + 6], x[8 * s + 7]);
    return __builtin_bit_cast(bf16x8, p);
}
constexpr int TS = 272;

DI void stage_tile(LAS unsigned char* tile, const bf16* src, int tid) {
#pragma unroll
    for (int i = 0; i < 2; ++i) { const int id = tid + 512 * i, c = id >> 4, ch = id & 15;
        *(LAS u32x4*)(tile + c * TS + ch * 16) = *(const u32x4*)(src + (size_t)c * PC + ch * 8); }
}
DI float touch_tile(const bf16* src, int i128) { return *(const float*)(src + (size_t)(i128 >> 1) * PC + (i128 & 1) * 64); }
DI void gate8(const LAS unsigned char* zt, int dp, int ts, f32x2 lb, f32x2 (&L)[8], f32x2 (&kk)[8], f32x2 (&lf)[8]) {
    f32x2 run = (f32x2){0.f, 0.f}; const f32x2 oml = 1.0f - lb;
#pragma unroll
    for (int i = 0; i < 8; ++i) { const unsigned w = *(const LAS unsigned*)(zt + (8 * ts + i) * TS + 4 * dp);
        const f32x2 sg = (f32x2){fast_sig(bflo(w)), fast_sig(bfhi(w))}; const f32x2 f = lb + oml * sg;
        lf[i] = (f32x2){__builtin_amdgcn_logf(f.x), __builtin_amdgcn_logf(f.y)}; kk[i] = oml * (1.0f - sg); run += lf[i]; L[i] = run; }
}
DI f32x2 exp2x2(f32x2 v) { return (f32x2){__builtin_amdgcn_exp2f(v.x), __builtin_amdgcn_exp2f(v.y)}; }
struct SliceSums { f32x2 offf, offb, glf, glb, greff, grefb; };
DI SliceSums slice_sums(const LAS float* tot, int dp, int ts) {
    SliceSums r; f32x2 tf[8], tb[8];
#pragma unroll
    for (int j = 0; j < 8; ++j) { tf[j] = *(const LAS f32x2*)(tot + j * 128 + 2 * dp); tb[j] = *(const LAS f32x2*)(tot + (8 + j) * 128 + 2 * dp); }
    r.offf = (f32x2){0.f, 0.f}; r.offb = (f32x2){0.f, 0.f};
#pragma unroll
    for (int j = 0; j < 8; ++j) { if (j < ts) r.offf += tf[j]; if (j > ts) r.offb += tb[j]; }
    r.greff = (tf[0] + tf[1]) + (tf[2] + tf[3]); r.glf = r.greff + ((tf[4] + tf[5]) + (tf[6] + tf[7]));
    r.grefb = (tb[4] + tb[5]) + (tb[6] + tb[7]); r.glb = r.grefb + ((tb[0] + tb[1]) + (tb[2] + tb[3]));
    return r;
}

DI void hgrn_a_item(Frame& F, int item, bool has_next) {
    F.refresh();
    constexpr int T_V = 0, T_KF = 17408, T_KB = 34816, TOT = 52224;
    LAS unsigned char* lds = F.lds;
    const int n = item & 31, h = (item >> 5) & 3, b = item >> 7;
    const bf16* proj = (const bf16*)(F.ws + WS_PROJ) + ((size_t)b * SEQ + n * CHUNK) * PC;
    const int tid = F.tid, dp = tid & 63, ts = F.wave;
    const float* lbp = (const float*)(F.ws + WS_LB);
    const f32x2 lbf = *(const f32x2*)(lbp + h * 128 + 2 * dp), lbb = *(const f32x2*)(lbp + 512 + h * 128 + 2 * dp);
    stage_tile(lds + T_V, proj + C_HI + h * 128, tid); stage_tile(lds + T_KF, proj + C_FF + h * 128, tid); stage_tile(lds + T_KB, proj + C_FB + h * 128, tid);
    float tch = 0.f;
    if (has_next) { const bf16* pn = proj + (size_t)CHUNK * PC + h * 128; const int i128 = tid & 127, wsel = tid >> 7; tch = touch_tile(pn + (wsel == 0 ? C_HI : wsel == 1 ? C_FF : C_FB), i128); }
    __syncthreads();
    f32x2 Lf[8], kf[8], lff[8], Lb[8], kb[8], lfb[8];
    gate8(lds + T_KF, dp, ts, lbf, Lf, kf, lff);
    gate8(lds + T_KB, dp, ts, lbb, Lb, kb, lfb);
    LAS float* tot = (LAS float*)(lds + TOT);
    *(LAS f32x2*)(tot + ts * 128 + 2 * dp) = Lf[7]; *(LAS f32x2*)(tot + (8 + ts) * 128 + 2 * dp) = Lb[7];
    asm volatile("" :: "v"(tch));
    __syncthreads();
    const SliceSums ss = slice_sums(tot, dp, ts);
    const f32x2 tbq = Lb[7];
#pragma unroll
    for (int i = 0; i < 8; ++i) { const int c = 8 * ts + i;
        const f32x2 G = ss.offf + Lf[i]; const f32x2 kd = kf[i] * exp2x2(ss.glf - G);
        const f32x2 Gb = ss.offb + (tbq - Lb[i] + lfb[i]); const f32x2 kdb = kb[i] * exp2x2(ss.glb - Gb);
        *(LAS unsigned*)(lds + T_KF + c * TS + 4 * dp) = cvtpk(kd.x, kd.y); *(LAS unsigned*)(lds + T_KB + c * TS + 4 * dp) = cvtpk(kdb.x, kdb.y); }
    if (ts == 0) { float* dec = (float*)(F.ws + WS_DEC) + (size_t)item * 256; *(f32x2*)(dec + 2 * dp) = exp2x2(ss.glf); *(f32x2*)(dec + 128 + 2 * dp) = exp2x2(ss.glb); }
    __syncthreads();
    const int w = F.wave, lane = F.lane, r = lane & 31, hh = lane >> 5, blk = (lane >> 4) & 1, q = (lane & 15) >> 2, p = lane & 3;
    const int dt = w >> 1, et0 = (w & 1) * 2;
#pragma unroll
    for (int dir = 0; dir < 2; ++dir) { const int TK = dir ? T_KB : T_KF;
#pragma unroll
        for (int e2 = 0; e2 < 2; ++e2) { const int et = et0 + e2; f32x16 acc;
#pragma unroll
            for (int i = 0; i < 16; ++i) acc[i] = 0.f;
#pragma unroll
            for (int ks = 0; ks < 4; ++ks) {
                const LAS unsigned char* ap = lds + TK + (16 * ks + 8 * hh + q) * TS + (32 * dt + 16 * blk + 4 * p) * 2;
                const LAS unsigned char* bp = lds + T_V + (16 * ks + 8 * hh + q) * TS + (32 * et + 16 * blk + 4 * p) * 2;
                const bf16x8 a = cat8(tr16(ap), tr16(ap + 4 * TS)), bq = cat8(tr16(bp), tr16(bp + 4 * TS));
                acc = MFMA32(a, bq, acc); }
            bf16* dsb = (bf16*)(F.ws + WS_DS) + ((size_t)(item * 2 + dir) * 128 + 32 * et + r) * 128 + 32 * dt + 4 * hh;
#pragma unroll
            for (int g4 = 0; g4 < 4; ++g4) { u32x2 wv; wv.x = cvtpk(acc[4 * g4], acc[4 * g4 + 1]); wv.y = cvtpk(acc[4 * g4 + 2], acc[4 * g4 + 3]); *(u32x2*)(dsb + 8 * g4) = wv; } } }
    __syncthreads();
}

DI void hgrn_scan(Frame& F) {
    F.refresh();
    const bf16* dS = (const bf16*)(F.ws + WS_DS); bf16* Sst = (bf16*)((unsigned char*)F.out + OUT_SST); const float* dec = (const float*)(F.ws + WS_DEC);
    const int gt = F.vcu * 512 + F.tid, NGT = F.G * 512;
    for (int id = gt; id < BG * 4 * 2 * 128 * 32; id += NGT) {
        const int d4 = id & 31, e = (id >> 5) & 127, dir = (id >> 12) & 1, bh = id >> 13;
        f32x4 S = (f32x4){0.f, 0.f, 0.f, 0.f};
#pragma unroll 4
        for (int s = 0; s < 32; ++s) { const int n = dir ? 31 - s : s, item = bh * 32 + n;
            const size_t off = ((size_t)(item * 2 + dir) * 128 + e) * 128 + d4 * 4;
            u32x2 o; o.x = cvtpk(S.x, S.y); o.y = cvtpk(S.z, S.w); *(u32x2*)(Sst + off) = o;
            const f32x4 dc = *(const f32x4*)(dec + (size_t)(item * 2 + dir) * 128 + d4 * 4);
            const u32x2 wv = *(const u32x2*)(dS + off);
            S.x = dc.x * S.x + bflo(wv.x); S.y = dc.y * S.y + bfhi(wv.x); S.z = dc.z * S.z + bflo(wv.y); S.w = dc.w * S.w + bfhi(wv.y); }
    }
}

DI void hgrn_c_item(Frame& F, int item, bool has_next) {
    F.refresh();
    constexpr int T_QRF = 0, T_KRF = 17408, T_QGF = 34816, T_QRB = 52224, T_KRB = 69632, T_QGB = 87040, T_V = 104448, TOT = 121856, O_OFF = 0, OS = 132;
    LAS unsigned char* lds = F.lds;
    const int n = item & 31, h = (item >> 5) & 3, b = item >> 7;
    const size_t row0 = (size_t)b * SEQ + n * CHUNK;
    const bf16* proj = (const bf16*)(F.ws + WS_PROJ) + row0 * PC;
    const int tid = F.tid, dp = tid & 63, ts = F.wave;
    const float* lbp = (const float*)(F.ws + WS_LB);
    const f32x2 lbf = *(const f32x2*)(lbp + h * 128 + 2 * dp), lbb = *(const f32x2*)(lbp + 512 + h * 128 + 2 * dp);
    stage_tile(lds + T_V, proj + C_HI + h * 128, tid); stage_tile(lds + T_KRF, proj + C_FF + h * 128, tid); stage_tile(lds + T_KRB, proj + C_FB + h * 128, tid); stage_tile(lds + T_QRF, proj + C_HQ + h * 128, tid);
    float tch = 0.f, tch2 = 0.f;
    if (has_next) { const bf16* pn = proj + (size_t)CHUNK * PC + h * 128; const int i128 = tid & 127, wsel = tid >> 7; tch = touch_tile(pn + (wsel == 0 ? C_HI : wsel == 1 ? C_FF : wsel == 2 ? C_FB : C_HQ), i128);
        tch2 = *(const float*)((const unsigned char*)F.out + OUT_SST + (size_t)(item + 1) * 65536 + (size_t)tid * 128); }
    __syncthreads();
    f32x2 qv[8];
#pragma unroll
    for (int i = 0; i < 8; ++i) { const unsigned w = *(const LAS unsigned*)(lds + T_QRF + (8 * ts + i) * TS + 4 * dp); const float z0 = bflo(w), z1 = bfhi(w); qv[i] = (f32x2){z0 * fast_sig(z0), z1 * fast_sig(z1)}; }
    f32x2 Lf[8], kf[8], lff[8], Lb[8], kb[8], lfb[8];
    gate8(lds + T_KRF, dp, ts, lbf, Lf, kf, lff);
    gate8(lds + T_KRB, dp, ts, lbb, Lb, kb, lfb);
    LAS float* tot = (LAS float*)(lds + TOT);
    *(LAS f32x2*)(tot + ts * 128 + 2 * dp) = Lf[7]; *(LAS f32x2*)(tot + (8 + ts) * 128 + 2 * dp) = Lb[7];
    asm volatile("" :: "v"(tch), "v"(tch2));
    __syncthreads();
    {
        const SliceSums ss = slice_sums(tot, dp, ts);
        const f32x2 tbq = Lb[7];
#pragma unroll
        for (int i = 0; i < 8; ++i) { const int c = 8 * ts + i; const int o = c * TS + 4 * dp;
            const f32x2 G = ss.offf + Lf[i]; const f32x2 x = G - ss.greff;
            const f32x2 qr = qv[i] * exp2x2(x), kr = kf[i] * exp2x2(-x), qg = qv[i] * exp2x2(G);
            *(LAS unsigned*)(lds + T_QRF + o) = cvtpk(qr.x, qr.y); *(LAS unsigned*)(lds + T_KRF + o) = cvtpk(kr.x, kr.y); *(LAS unsigned*)(lds + T_QGF + o) = cvtpk(qg.x, qg.y);
            const f32x2 Gb = ss.offb + (tbq - Lb[i] + lfb[i]); const f32x2 xb = Gb - ss.grefb;
            const f32x2 qrb = qv[i] * exp2x2(xb), krb = kb[i] * exp2x2(-xb), qgb = qv[i] * exp2x2(Gb);
            *(LAS unsigned*)(lds + T_QRB + o) = cvtpk(qrb.x, qrb.y); *(LAS unsigned*)(lds + T_KRB + o) = cvtpk(krb.x, krb.y); *(LAS unsigned*)(lds + T_QGB + o) = cvtpk(qgb.x, qgb.y); }
    }
    __syncthreads();
    const int w = F.wave, lane = F.lane, r = lane & 31, hh = lane >> 5, blk = (lane >> 4) & 1, q = (lane & 15) >> 2, p = lane & 3;
    const int ct = w >> 2, et = w & 3;
    const bf16* Sst = (const bf16*)((const unsigned char*)F.out + OUT_SST);
    f32x16 o;
#pragma unroll
    for (int i = 0; i < 16; ++i) o[i] = 0.f;
#pragma unroll
    for (int dir = 0; dir < 2; ++dir) { const int TQR = dir ? T_QRB : T_QRF, TKR = dir ? T_KRB : T_KRF, TQG = dir ? T_QGB : T_QGF;
#pragma unroll
        for (int st = 0; st < 2; ++st) {
            if (dir == 0 ? (st > ct) : (st < ct)) continue;
            f32x16 X;
#pragma unroll
            for (int i = 0; i < 16; ++i) X[i] = 0.f;
#pragma unroll
            for (int ks = 0; ks < 8; ++ks) { const bf16x8 a = *(const LAS bf16x8*)(lds + TKR + (32 * st + r) * TS + (16 * ks + 8 * hh) * 2), bq = *(const LAS bf16x8*)(lds + TQR + (32 * ct + r) * TS + (16 * ks + 8 * hh) * 2);
                X = MFMA32(a, bq, X); }
            const int cc = 32 * ct + r;
#pragma unroll
            for (int i = 0; i < 16; ++i) { const int s = 32 * st + crow(i, hh); const bool keep = dir == 0 ? (s <= cc) : (s >= cc); X[i] = keep ? X[i] : 0.f; }
#pragma unroll
            for (int s2 = 0; s2 < 2; ++s2) { const bf16x8 xs = pack8(X, s2);
                const LAS unsigned char* vp = lds + T_V + (32 * st + 16 * s2 + 4 * hh + q) * TS + (32 * et + 16 * blk + 4 * p) * 2;
                const bf16x8 pb = cat8(tr16(vp), tr16(vp + 8 * TS));
                o = MFMA32(xs, pb, o); }
        }
        const bf16* sp = Sst + ((size_t)(item * 2 + dir) * 128 + 32 * et + r) * 128 + 8 * hh;
#pragma unroll
        for (int ks = 0; ks < 8; ++ks) { const bf16x8 a = *(const LAS bf16x8*)(lds + TQG + (32 * ct + r) * TS + (16 * ks + 8 * hh) * 2); const bf16x8 bq = *(const bf16x8*)(sp + 16 * ks);
            o = MFMA32(a, bq, o); }
    }
    unsigned hw[8];
#pragma unroll
    for (int k = 0; k < 8; ++k) hw[k] = *(const unsigned*)(proj + (size_t)(8 * w + k) * PC + C_HG + h * 128 + 2 * lane);
    __syncthreads();
    LAS float* O = (LAS float*)(lds + O_OFF);
#pragma unroll
    for (int i = 0; i < 16; ++i) O[(32 * ct + crow(i, hh)) * OS + 32 * et + r] = o[i];
    __syncthreads();
    const f32x2 gn = *(const f32x2*)(F.hg_norm_g + h * 128 + 2 * lane);
    bf16* yhg = (bf16*)(F.ws + WS_YHG);
    const int a16 = (lane ^ 16) << 2, a32 = (lane ^ 32) << 2;
#pragma unroll
    for (int k = 0; k < 8; ++k) { const int c = 8 * w + k; const f32x2 v = *(const LAS f32x2*)(O + c * OS + 2 * lane);
        float ss = row_sum16(v.x * v.x + v.y * v.y); ss += bperm_f(a16, ss); ss += bperm_f(a32, ss);
        const float rstd = __builtin_amdgcn_rsqf(ss * (1.0f / 128.0f) + EPS);
        const float z0 = bflo(hw[k]), z1 = bfhi(hw[k]);
        const float y0 = v.x * rstd * gn.x * (z0 * fast_sig(z0)), y1 = v.y * rstd * gn.y * (z1 * fast_sig(z1));
        *(unsigned*)(yhg + (row0 + c) * 512 + h * 128 + 2 * lane) = cvtpk(y0, y1); }
    __syncthreads();
}

DI void attn_item(Frame& F, int g, int item) {
    F.refresh();
    constexpr int KS = 272, VS = 528, K_OFF = 0, V_OFF = 69632;
    LAS unsigned char* lds = F.lds;
    const int qb = item & 7, h = (item >> 3) & 3, b = item >> 5, bglob = g * BG + b;
    const bf16* Km = (const bf16*)(F.ws + WS_KMEM) + (size_t)bglob * 256 * 512 + h * 128;
    const bf16* VT = (const bf16*)(F.ws + WS_VT) + (size_t)(h * 128) * 4096 + bglob * 256;
    const int tid = F.tid;
#pragma unroll
    for (int i = 0; i < 8; ++i) { const int id = tid + 512 * i, key = id >> 4, ch = id & 15;
        *(LAS u32x4*)(lds + K_OFF + key * KS + ch * 16) = *(const u32x4*)(Km + (size_t)key * 512 + ch * 8); }
#pragma unroll
    for (int i = 0; i < 8; ++i) { const int id = tid + 512 * i, e = id >> 5, ch = id & 31;
        *(LAS u32x4*)(lds + V_OFF + e * VS + ch * 16) = *(const u32x4*)(VT + (size_t)e * 4096 + ch * 8); }
    __syncthreads();
    const int w = F.wave, lane = F.lane, r = lane & 31, hh = lane >> 5;
    const size_t qrow0 = (size_t)b * SEQ + qb * 256 + w * 32;
    const bf16* proj = (const bf16*)(F.ws + WS_PROJ);
    bf16x8 qf[8];
#pragma unroll
    for (int ks = 0; ks < 8; ++ks) qf[ks] = *(const bf16x8*)(proj + (qrow0 + r) * PC + C_MQ + h * 128 + 16 * ks + 8 * hh);
    const float scale = 0.08838834764831845f;
    float m_run = -INFINITY, l_run = 0.f;
#pragma unroll 1
    for (int kt = 0; kt < 8; ++kt) {
        f32x16 X;
#pragma unroll
        for (int i = 0; i < 16; ++i) X[i] = 0.f;
#pragma unroll
        for (int ks = 0; ks < 8; ++ks) { const bf16x8 a = *(const LAS bf16x8*)(lds + K_OFF + (32 * kt + r) * KS + (16 * ks + 8 * hh) * 2); X = MFMA32(a, qf[ks], X); }
        float tm = X[0];
#pragma unroll
        for (int i = 1; i < 16; ++i) tm = fmaxf(tm, X[i]);
        tm *= scale;
        const float mn = fmaxf(m_run, tm); float ls = 0.f;
#pragma unroll
        for (int i = 0; i < 16; ++i) ls += __expf(X[i] * scale - mn);
        l_run = l_run * __expf(m_run - mn) + ls; m_run = mn;
    }
    { const float mo = __shfl_xor(m_run, 32), lo = __shfl_xor(l_run, 32); const float m = fmaxf(m_run, mo);
      l_run = l_run * __expf(m_run - m) + lo * __expf(mo - m); m_run = m; }
    const float inv_l = 1.0f / l_run;
    f32x16 O[4];
#pragma unroll
    for (int e = 0; e < 4; ++e)
#pragma unroll
        for (int i = 0; i < 16; ++i) O[e][i] = 0.f;
#pragma unroll 1
    for (int kt = 0; kt < 8; ++kt) {
        f32x16 X;
#pragma unroll
        for (int i = 0; i < 16; ++i) X[i] = 0.f;
#pragma unroll
        for (int ks = 0; ks < 8; ++ks) { const bf16x8 a = *(const LAS bf16x8*)(lds + K_OFF + (32 * kt + r) * KS + (16 * ks + 8 * hh) * 2); X = MFMA32(a, qf[ks], X); }
#pragma unroll
        for (int i = 0; i < 16; ++i) X[i] = __expf(X[i] * scale - m_run) * inv_l;
#pragma unroll
        for (int s2 = 0; s2 < 2; ++s2) { const bf16x8 xs = pack8(X, s2);
#pragma unroll
            for (int e = 0; e < 4; ++e) { const LAS unsigned char* vp = lds + V_OFF + (32 * e + r) * VS + (32 * kt + 16 * s2 + 4 * hh) * 2;
                const bf16x8 pb = cat8(*(const LAS s16x4*)vp, *(const LAS s16x4*)(vp + 16));
                O[e] = MFMA32(xs, pb, O[e]); } }
    }
    bf16* ymx = (bf16*)(F.ws + WS_YMX);
#pragma unroll
    for (int e = 0; e < 4; ++e)
#pragma unroll
        for (int i = 0; i < 16; ++i) ymx[(qrow0 + crow(i, hh)) * 512 + h * 128 + 32 * e + r] = (bf16)f2bf(O[e][i]);
    __syncthreads();
}

DI void conv_phase(Frame& F) {
    F.refresh();
    const bf16* proj = (const bf16*)(F.ws + WS_PROJ); bf16* ysc = (bf16*)(F.ws + WS_YSC); const float* cw = F.sc_conv_w;
    const int gt = F.vcu * 512 + F.tid, NGT = F.G * 512;
    for (int id = gt; id < TG * 64; id += NGT) {
        const int c8 = id & 63, t = id >> 6, ts = t & (SEQ - 1);
        const bf16* pr = proj + (size_t)t * PC + c8 * 8;
        const u32x4 z4 = (u32x4){0u, 0u, 0u, 0u};
        const u32x4 sb = *(const u32x4*)(pr + C_SB), c1 = *(const u32x4*)(pr + C_SC), h1 = *(const u32x4*)(pr + C_SH);
        const u32x4 c0 = ts > 0 ? *(const u32x4*)(pr - PC + C_SC) : z4, h0 = ts > 0 ? *(const u32x4*)(pr - PC + C_SH) : z4;
        const u32x4 c2 = ts < SEQ - 1 ? *(const u32x4*)(pr + PC + C_SC) : z4, h2 = ts < SEQ - 1 ? *(const u32x4*)(pr + PC + C_SH) : z4;
        const f32x4 wa0 = *(const f32x4*)(cw + c8 * 8), wa1 = *(const f32x4*)(cw + c8 * 8 + 4), wb0 = *(const f32x4*)(cw + 512 + c8 * 8), wb1 = *(const f32x4*)(cw + 512 + c8 * 8 + 4),
                    wc0 = *(const f32x4*)(cw + 1024 + c8 * 8), wc1 = *(const f32x4*)(cw + 1024 + c8 * 8 + 4);
        float y[8];
#pragma unroll
        for (int k = 0; k < 4; ++k) {
            const float w0l = k < 2 ? wa0[2 * k] : wa1[2 * k - 4], w0h = k < 2 ? wa0[2 * k + 1] : wa1[2 * k - 3];
            const float w1l = k < 2 ? wb0[2 * k] : wb1[2 * k - 4], w1h = k < 2 ? wb0[2 * k + 1] : wb1[2 * k - 3];
            const float w2l = k < 2 ? wc0[2 * k] : wc1[2 * k - 4], w2h = k < 2 ? wc0[2 * k + 1] : wc1[2 * k - 3];
            y[2 * k]     = bflo(sb[k]) * (w0l * (bflo(c0[k]) * bflo(h0[k])) + w1l * (bflo(c1[k]) * bflo(h1[k])) + w2l * (bflo(c2[k]) * bflo(h2[k])));
            y[2 * k + 1] = bfhi(sb[k]) * (w0h * (bfhi(c0[k]) * bfhi(h0[k])) + w1h * (bfhi(c1[k]) * bfhi(h1[k])) + w2h * (bfhi(c2[k]) * bfhi(h2[k]))); }
        u32x4 o; o.x = cvtpk(y[0], y[1]); o.y = cvtpk(y[2], y[3]); o.z = cvtpk(y[4], y[5]); o.w = cvtpk(y[6], y[7]);
        *(u32x4*)(ysc + (size_t)t * 512 + c8 * 8) = o;
    }
}

DI unsigned ord_key(float v, int idx) { unsigned u = __builtin_bit_cast(unsigned, v); u ^= (u >> 31) ? 0xFFFFFFFFu : 0x80000000u; return (u & 0xFFFFFF80u) | (unsigned)(127 - idx); }
DI float key_val(unsigned k) { unsigned u = k & 0xFFFFFF80u; u = (u & 0x80000000u) ? (u ^ 0x80000000u) : ~u; return __builtin_bit_cast(float, u); }
DI float dot2bf(unsigned a, unsigned b, float c) { return __builtin_amdgcn_fdot2_f32_bf16(__builtin_bit_cast(bf16x2_t, a), __builtin_bit_cast(bf16x2_t, b), c, false); }
DI float dot8(const u32x4& a, const u32x4& b, float c) { c = dot2bf(a.x, b.x, c); c = dot2bf(a.y, b.y, c); c = dot2bf(a.z, b.z, c); return dot2bf(a.w, b.w, c); }
__host__ __device__ constexpr int cand_off(int i) { return i == 0 ? 0 : i == 1 ? 16 : i == 2 ? 24 : i == 3 ? 29 : i == 4 ? 33 : i == 5 ? 36 : i == 6 ? 38 : i == 7 ? 40 : 34 + i; }
__host__ __device__ constexpr int cand_i(int c) { return c < 16 ? 0 : c < 24 ? 1 : c < 29 ? 2 : c < 33 ? 3 : c < 36 ? 4 : c < 38 ? 5 : c < 40 ? 6 : c < 42 ? 7 : c - 34; }
__host__ __device__ constexpr int cand_pos(int c) { return cand_i(c) * 16 + (c - cand_off(cand_i(c))); }

#define PEER_CE(i, j) do { const unsigned hi_ = max(k[i], k[j]), lo_ = min(k[i], k[j]); k[i] = hi_; k[j] = lo_; } while (0)
DI void peer_topk_first(const float* srow, LAS float* ssc, LAS unsigned char* six, int lane) {
    const int gq = lane >> 4, li = lane & 15;
    const float* sl = srow + (gq >> 1) * 256 + (gq & 1) * 128 + li * 8;
    f32x4 nva = *(const f32x4*)sl, nvb = *(const f32x4*)(sl + 4);
#pragma unroll 1
    for (int hp = 0; hp < 4; ++hp) {
        const f32x4 va = nva, vb = nvb;
        if (hp < 3) { nva = *(const f32x4*)(sl + 512 * (hp + 1)); nvb = *(const f32x4*)(sl + 512 * (hp + 1) + 4); }
        unsigned k[8];
        k[0] = ord_key(va.x, li * 8 + 0); k[1] = ord_key(va.y, li * 8 + 1); k[2] = ord_key(va.z, li * 8 + 2); k[3] = ord_key(va.w, li * 8 + 3);
        k[4] = ord_key(vb.x, li * 8 + 4); k[5] = ord_key(vb.y, li * 8 + 5); k[6] = ord_key(vb.z, li * 8 + 6); k[7] = ord_key(vb.w, li * 8 + 7);
        PEER_CE(0, 1); PEER_CE(2, 3); PEER_CE(4, 5); PEER_CE(6, 7); PEER_CE(0, 2); PEER_CE(1, 3); PEER_CE(4, 6); PEER_CE(5, 7); PEER_CE(1, 2); PEER_CE(5, 6);
        PEER_CE(0, 4); PEER_CE(1, 5); PEER_CE(2, 6); PEER_CE(3, 7); PEER_CE(2, 4); PEER_CE(3, 5); PEER_CE(1, 2); PEER_CE(3, 4); PEER_CE(5, 6);
        unsigned mine = 0u;
#pragma unroll
        for (int rd = 0; rd < 16; ++rd) {
            const unsigned m = row_max16(k[0]);
            mine = (li == rd) ? m : mine;
            const bool wn = (k[0] == m);
            k[0] = wn ? k[1] : k[0]; k[1] = wn ? k[2] : k[1]; k[2] = wn ? k[3] : k[2]; k[3] = wn ? k[4] : k[3];
            k[4] = wn ? k[5] : k[4]; k[5] = wn ? k[6] : k[5]; k[6] = wn ? k[7] : k[6]; k[7] = wn ? 0u : k[7];
        }
        const int o = ((2 * hp + (gq >> 1)) * 2 + (gq & 1)) * 16 + li;
        ssc[o] = key_val(mine); six[o] = (unsigned char)(127u - (mine & 127u));
    }
}
DI void peer_topk_second(const LAS float* ssc, const LAS unsigned char* six, LAS int* widx, LAS float* wgate, int lane, int emask, int hd_lo, int hd_hi) {
    const int grp = lane >> 4, li = lane & 15;
    const int ri = li <= 1 ? 0 : li <= 8 ? li - 1 : 8, j0 = li == 1 ? 8 : 0;
    const int L = li <= 2 ? 8 : li == 3 ? 5 : li == 4 ? 4 : li == 5 ? 3 : li <= 8 ? 2 : li == 9 ? 8 : 0;
    const bool tail = li >= 9;
    const unsigned tag0 = tail ? 255u - 128u : 255u - (unsigned)(16 * ri + j0), tstep = tail ? 16u : 1u;
#pragma unroll 1
    for (int hd0 = hd_lo; hd0 < hd_hi; hd0 += 4) {
        const int hd = hd0 + grp;
        const LAS float* A = ssc + (hd * 2) * 16; const LAS float* B = A + 16;
        const LAS float* xp = tail ? A + 8 : B + j0;
        const float y = tail ? B[0] : A[ri];
        const f32x4 x0 = *(const LAS f32x4*)xp, x1 = *(const LAS f32x4*)(xp + 4);
        unsigned k[8];
#pragma unroll
        for (int jj = 0; jj < 8; ++jj) { const float v = (jj < 4 ? x0[jj & 3] : x1[jj & 3]) + y; unsigned u = __builtin_bit_cast(unsigned, v); u ^= (u >> 31) ? 0xFFFFFFFFu : 0x80000000u;
            k[jj] = jj < L ? ((u & 0xFFFFFF00u) | (tag0 - (unsigned)jj * tstep)) : 0u; }
        unsigned mine = 0u;
#pragma unroll
        for (int rd = 0; rd < 16; ++rd) {
            const unsigned m = row_max16(k[0]);
            mine = (li == rd) ? m : mine;
            const bool wn = (k[0] == m);
            k[0] = wn ? k[1] : k[0]; k[1] = wn ? k[2] : k[1]; k[2] = wn ? k[3] : k[2]; k[3] = wn ? k[4] : k[3];
            k[4] = wn ? k[5] : k[4]; k[5] = wn ? k[6] : k[5]; k[6] = wn ? k[7] : k[6]; k[7] = wn ? 0u : k[7];
        }
        const int tg_ = 255 - (int)(mine & 255u), ci = tg_ >> 4, cj = tg_ & 15;
        const float cs = A[ci] + B[cj];
        const int ia = (int)six[(hd * 2) * 16 + ci], ib = (int)six[(hd * 2 + 1) * 16 + cj];
        float mx = cs; mx = fmaxf(mx, dpp_f<0xB1>(mx)); mx = fmaxf(mx, dpp_f<0x4E>(mx)); mx = fmaxf(mx, dpp_f<0x141>(mx)); mx = fmaxf(mx, dpp_f<0x140>(mx));
        const float ev = __builtin_amdgcn_exp2f((cs - mx) * 1.4426950408889634f);
        const float sum = row_sum16(ev);
        if (hd < hd_hi) { widx[hd * 16 + li] = ((ia * 128 + ib) & emask) * 512  ; wgate[hd * 16 + li] = ev * __builtin_amdgcn_rcpf(sum); }
    }
}
#undef PEER_CE

constexpr float PEER_QSTEP = 0.35f;
constexpr float PEER_U_SCALE = 32.0f / PEER_QSTEP;
constexpr float PEER_UF4_SCALE = 64.0f;
constexpr float PEER_H4_SCALE = 2.0f;
#ifndef PEER_VACT
#define PEER_VACT 8
#endif
#ifndef PROBE_VMASK
#define PROBE_VMASK 0xFFFFFFFFu
#endif
constexpr int PEER_REC_WORDS = 160;
constexpr int PEER_UW_BYTES = 19456, PEER_VW_BYTES = 16896;
static_assert(8 * PEER_UW_BYTES <= MISC_OFF && 8 * PEER_VW_BYTES <= MISC_OFF && PEER_UW_BYTES % 256 == 0 && PEER_VW_BYTES % 256 == 0, "PEER LDS map");
DI void glds16s_x4(const void* sbase, unsigned v0, unsigned v1, unsigned v2, unsigned v3, unsigned lds_dst) { unsigned keep;
    asm volatile("s_mov_b32 %0, m0\n\ts_mov_b32 m0, %6\n\ts_nop 0\n\tglobal_load_lds_dwordx4 %1, %5\n\tglobal_load_lds_dwordx4 %2, %5 offset:1024\n\tglobal_load_lds_dwordx4 %3, %5 offset:2048\n\tglobal_load_lds_dwordx4 %4, %5 offset:3072\n\ts_mov_b32 m0, %0"
                 : "=&s"(keep) : "v"(v0), "v"(v1), "v"(v2), "v"(v3), "s"(sbase), "s"(lds_dst) : "memory"); }
typedef int i32x2 __attribute__((ext_vector_type(2)));
typedef int i32x4 __attribute__((ext_vector_type(4)));
typedef int i32x8 __attribute__((ext_vector_type(8)));
#define PEER_LOADIDX(tile) do { const LAS int* ip_ = sidx + 16 * (tile) + (lane >> 5); _Pragma("unroll") for (int j_ = 0; j_ < 8; ++j_) nx[j_] = (unsigned)ip_[2 * j_]; } while (0)

DI void peer_u_phase(Frame& F, int tg) {
    F.refresh();
    __syncthreads();
    const int lane = F.lane, wv = F.wave, grp = lane >> 4;
    LAS unsigned char* wb = F.lds + wv * PEER_UW_BYTES;
    LAS float* ssc = (LAS float*)wb; LAS unsigned char* six = wb + 1024;
    LAS int* sidx = (LAS int*)(wb + 1280); LAS float* sgate = (LAS float*)(wb + 1792);
    LAS unsigned char* hrow = wb + 2304;
    LAS unsigned char* ring = wb + 3072; const unsigned ringb = (unsigned)(uintptr_t)ring;
    const unsigned char* Ub = F.ws + WS_U;
    unsigned usw[4];
#pragma unroll
    for (int q = 0; q < 4; ++q) usw[q] = 16u * (unsigned)((lane & 31) ^ (2 * q + (lane >> 5))) + (4096u - 1024u * q);
    const LAS unsigned char* uadr[4];
#pragma unroll
    for (int j = 0; j < 4; ++j) uadr[j] = ring + (lane & 15) * 512 + 64 * (j ^ ((lane & 15) >> 2)) + 16 * (grp ^ (lane & 3));
#define PEER_ISSUE8U(tile) do { const unsigned rs_ = (unsigned)__builtin_amdgcn_readfirstlane((int)(ringb + (unsigned)((tile) & 1) * 8192u)); \
        glds16s_x4(Ub - 4096, nx[0] + usw[0], nx[1] + usw[1], nx[2] + usw[2], nx[3] + usw[3], rs_); \
        glds16s_x4(Ub - 4096, nx[4] + (usw[0] ^ 128u), nx[5] + (usw[1] ^ 128u), nx[6] + (usw[2] ^ 128u), nx[7] + (usw[3] ^ 128u), rs_ + 4096u); } while (0)
    const int TSTEP = 8 * F.G;
#pragma unroll 1
    for (int tl = F.vcu + F.G * wv; tl < TG; tl += TSTEP) {
        const size_t t = (size_t)tg * TG + tl;
        const float* srow = (const float*)(F.ws + WS_S) + (size_t)tl * 2048;
        const float cssp = ((const float*)(F.ws + WS_SSP) + t * 16)[lane & 15];
        const bf16* xr = (const bf16*)(F.ws + WS_XG) + t * 1024 + 16 * lane; const u32x4 w0 = *(const u32x4*)xr, w1 = *(const u32x4*)(xr + 8);
        float tch0 = 0.f, tch2 = 0.f, tch3 = 0.f;
        if (tl + TSTEP < TG) { const size_t tn = t + TSTEP; tch0 = (srow + (size_t)TSTEP * 2048)[lane * 32];
            tch2 = ((const float*)((const bf16*)(F.ws + WS_XG) + tn * 1024))[(lane & 15) * 32]; tch3 = ((const float*)(F.ws + WS_SSP) + tn * 16)[lane & 15]; }
        peer_topk_first(srow, ssc, six, lane);
        peer_topk_second(ssc, six, sidx, sgate, lane, 16383, 0, 8);
        asm volatile("s_waitcnt lgkmcnt(0)" ::: "memory");
        unsigned nx[8];
        PEER_LOADIDX(0); PEER_ISSUE8U(0); PEER_LOADIDX(1); PEER_ISSUE8U(1); PEER_LOADIDX(2);
        const float hs = __builtin_amdgcn_rsqf(row_sum16(cssp) * (1.0f / 1024.0f) + EPS) * PEER_H4_SCALE;
        { u32x2 hq;
          hq.x = __builtin_amdgcn_cvt_scalef32_pk_fp4_f32(0u, bflo(w0[0]) * hs, bfhi(w0[0]) * hs, 1.0f, 0); hq.x = __builtin_amdgcn_cvt_scalef32_pk_fp4_f32(hq.x, bflo(w0[1]) * hs, bfhi(w0[1]) * hs, 1.0f, 1);
          hq.x = __builtin_amdgcn_cvt_scalef32_pk_fp4_f32(hq.x, bflo(w0[2]) * hs, bfhi(w0[2]) * hs, 1.0f, 2); hq.x = __builtin_amdgcn_cvt_scalef32_pk_fp4_f32(hq.x, bflo(w0[3]) * hs, bfhi(w0[3]) * hs, 1.0f, 3);
          hq.y = __builtin_amdgcn_cvt_scalef32_pk_fp4_f32(0u, bflo(w1[0]) * hs, bfhi(w1[0]) * hs, 1.0f, 0); hq.y = __builtin_amdgcn_cvt_scalef32_pk_fp4_f32(hq.y, bflo(w1[1]) * hs, bfhi(w1[1]) * hs, 1.0f, 1);
          hq.y = __builtin_amdgcn_cvt_scalef32_pk_fp4_f32(hq.y, bflo(w1[2]) * hs, bfhi(w1[2]) * hs, 1.0f, 2); hq.y = __builtin_amdgcn_cvt_scalef32_pk_fp4_f32(hq.y, bflo(w1[3]) * hs, bfhi(w1[3]) * hs, 1.0f, 3);
          *(LAS u32x2*)(hrow + 8 * lane) = hq; }
        i32x4 hA[8];
#pragma unroll
        for (int ks = 0; ks < 8; ++ks) hA[ks] = *(const LAS i32x4*)(hrow + 64 * ks + 16 * grp);
        float dotA = 0.f, dotB = 0.f;
#pragma unroll 1
        for (int tt = 0; tt < 8; ++tt) {
            const int rp = (tt & 1) * 8192;
            if (tt < 7) asm volatile("s_waitcnt vmcnt(8)" ::: "memory"); else asm volatile("s_waitcnt vmcnt(0)" ::: "memory");
            f32x4 acc = {0.f, 0.f, 0.f, 0.f};
#pragma unroll
            for (int ks = 0; ks < 8; ++ks) { const i32x4 b_ = *(const LAS i32x4*)(uadr[ks & 3] + rp + 256 * (ks >> 2));
                const i32x8 b8_ = {b_.x, b_.y, b_.z, b_.w, 0, 0, 0, 0};
                const i32x8 a8_ = {hA[ks].x, hA[ks].y, hA[ks].z, hA[ks].w, 0, 0, 0, 0};
                acc = __builtin_amdgcn_mfma_scale_f32_16x16x128_f8f6f4(a8_, b8_, acc, 4  , 4  , 0, 127, 0, 127); }
            dotA = (tt == grp) ? acc[0] : dotA; dotB = (tt == grp + 4) ? acc[0] : dotB;
            __builtin_amdgcn_sched_barrier(0);
            if (tt < 6) { PEER_ISSUE8U(tt + 2); PEER_LOADIDX((tt + 3) & 7); }
            __builtin_amdgcn_sched_barrier(0);
        }
        const float ascale = 1.0f / (PEER_H4_SCALE * PEER_UF4_SCALE);
        unsigned loA, hiA, loB, hiB; float bscA, bscB;
        { const float av = dotA * ascale, bv = dotB * ascale;
          const float cA = sgate[lane] * (0.5f * av * (1.0f + erff(av * 0.70710678118654752f))), cB = sgate[64 + lane] * (0.5f * bv * (1.0f + erff(bv * 0.70710678118654752f)));
          const float mxA = __builtin_bit_cast(float, row_max16(__builtin_bit_cast(unsigned, fabsf(cA)))), mxB = __builtin_bit_cast(float, row_max16(__builtin_bit_cast(unsigned, fabsf(cB))));
          const float qsA = mxA > 0.f ? 7.0f * __builtin_amdgcn_rcpf(mxA) : 0.f, qsB = mxB > 0.f ? 7.0f * __builtin_amdgcn_rcpf(mxB) : 0.f;
          const unsigned cqA = ((unsigned)(int)__builtin_rintf(cA * qsA) & 15u) << (4 * (lane & 7)), cqB = ((unsigned)(int)__builtin_rintf(cB * qsB) & 15u) << (4 * (lane & 7));
          loA = (lane & 8) ? 0u : cqA; hiA = (lane & 8) ? cqA : 0u; loB = (lane & 8) ? 0u : cqB; hiB = (lane & 8) ? cqB : 0u;
          loA |= dpp_u<0xB1>(loA); loA |= dpp_u<0x4E>(loA); loA |= dpp_u<0x141>(loA); loA |= dpp_u<0x140>(loA);
          hiA |= dpp_u<0xB1>(hiA); hiA |= dpp_u<0x4E>(hiA); hiA |= dpp_u<0x141>(hiA); hiA |= dpp_u<0x140>(hiA);
          loB |= dpp_u<0xB1>(loB); loB |= dpp_u<0x4E>(loB); loB |= dpp_u<0x141>(loB); loB |= dpp_u<0x140>(loB);
          hiB |= dpp_u<0xB1>(hiB); hiB |= dpp_u<0x4E>(hiB); hiB |= dpp_u<0x141>(hiB); hiB |= dpp_u<0x140>(hiB);
          bscA = mxA * (1.0f / 7.0f); bscB = mxB * (1.0f / 7.0f); }
        unsigned* rec = (unsigned*)(F.ws + WS_PL) + t * PEER_REC_WORDS;
        rec[lane] = (unsigned)sidx[lane]; rec[64 + lane] = (unsigned)sidx[64 + lane];
        if ((lane & 15) == 0) { rec[128 + grp] = loA; rec[132 + grp] = loB; rec[136 + grp] = hiA; rec[140 + grp] = hiB; rec[144 + grp] = __builtin_bit_cast(unsigned, bscA); rec[148 + grp] = __builtin_bit_cast(unsigned, bscB); }
        asm volatile("" :: "v"(tch0), "v"(tch2), "v"(tch3));
    }
#undef PEER_ISSUE8U
}

DI void peer_v_phase(Frame& F, int tg, bool dry) {
    F.refresh();
    __syncthreads();
    const int lane = F.lane, wv = F.wave;
    LAS unsigned char* wb = F.lds + wv * PEER_VW_BYTES;
    LAS int* sidx = (LAS int*)wb;
    LAS unsigned char* ring = wb + 512; const unsigned ringb = (unsigned)(uintptr_t)ring;
    const unsigned char* Vb = F.ws + WS_V;
    const int a16 = (lane ^ 16) << 2, a32 = (lane ^ 32) << 2;
    unsigned usw[4];
#pragma unroll
    for (int q = 0; q < 4; ++q) usw[q] = 16u * (unsigned)((lane & 31) ^ (2 * q + (lane >> 5))) + (4096u - 1024u * q);
#define PEER_ISSUE8V(tile) do { const unsigned rs_ = (unsigned)__builtin_amdgcn_readfirstlane((int)(ringb + (unsigned)((tile) & 1) * 8192u)); \
        glds16s_x4(Vb - 4096, nx[0] + usw[0], nx[1] + usw[1], nx[2] + usw[2], nx[3] + usw[3], rs_); \
        glds16s_x4(Vb - 4096, nx[4] + (usw[0] ^ 128u), nx[5] + (usw[1] ^ 128u), nx[6] + (usw[2] ^ 128u), nx[7] + (usw[3] ^ 128u), rs_ + 4096u); } while (0)
    unsigned vxo[8];
#pragma unroll
    for (int l = 0; l < 8; ++l) vxo[l] = 32u * (unsigned)(l ^ ((lane & 15) >> 1));
    const LAS unsigned char* rowb0 = ring + (lane & 15) * 512 + 16 * (((lane >> 5) ^ lane) & 1) + 8 * ((lane >> 4) & 1);
    float gf[16];
#pragma unroll
    for (int cb = 0; cb < 16; ++cb) gf[cb] = F.final_norm_g[lane + 64 * cb];
    const int TSTEP = PEER_VACT * F.G;
    if (wv >= PEER_VACT) return;
    unsigned pi0 = 0u, pi1 = 0u, pcw = 0u; float px[16];
#define PEER_VFETCH(tl_) do { const size_t t_ = (size_t)tg * TG + (tl_); const unsigned* rec_ = (const unsigned*)(F.ws + WS_PL) + t_ * PEER_REC_WORDS; pi0 = rec_[lane]; pi1 = rec_[64 + lane]; pcw = rec_[128 + (lane & 31)]; \
        const float* xo_ = F.out + t_ * 1024 + lane; _Pragma("unroll") for (int cb = 0; cb < 16; ++cb) px[cb] = xo_[64 * cb]; } while (0)
    { const int tl0 = F.vcu + F.G * wv; if (tl0 < TG) PEER_VFETCH(tl0); else {
#pragma unroll
        for (int cb = 0; cb < 16; ++cb) px[cb] = 0.f; } }
#pragma unroll 1
    for (int tl = F.vcu + F.G * wv; tl < TG; tl += TSTEP) {
        const size_t t = (size_t)tg * TG + tl;
        const unsigned cw = pcw; float xa[16];
#pragma unroll
        for (int cb = 0; cb < 16; ++cb) xa[cb] = px[cb];
        sidx[lane] = (int)(dry ? pi0 & PROBE_VMASK : pi0); sidx[64 + lane] = (int)(dry ? pi1 & PROBE_VMASK : pi1);
        if (tl + TSTEP < TG) PEER_VFETCH(tl + TSTEP);
        asm volatile("s_waitcnt lgkmcnt(0)" ::: "memory");
        unsigned nx[8];
        PEER_LOADIDX(0); PEER_ISSUE8V(0); PEER_LOADIDX(1); PEER_ISSUE8V(1); PEER_LOADIDX(2);
        float oacc[16];
#pragma unroll
        for (int cb = 0; cb < 16; ++cb) oacc[cb] = 0.f;
#pragma unroll 1
        for (int vb = 0; vb < 8; ++vb) {
            if (vb < 7) asm volatile("s_waitcnt vmcnt(8)" ::: "memory"); else asm volatile("s_waitcnt vmcnt(0)" ::: "memory");
            const int clo = __builtin_amdgcn_readlane((int)cw, vb), chi = __builtin_amdgcn_readlane((int)cw, 8 + vb);
            const float bsc = __builtin_bit_cast(float, __builtin_amdgcn_readlane((int)cw, 16 + vb));
            const LAS unsigned char* rowp = rowb0 + (vb & 1) * 8192;
#pragma unroll
            for (int cb = 0; cb < 16; ++cb) {
                const i32x2 tr = __builtin_amdgcn_ds_read_tr4_b64_v2i32((LAS i32x2*)(rowp + vxo[cb & 7] + 256 * (cb >> 3)));
                const int ai = __builtin_amdgcn_sdot8(chi, tr.y, __builtin_amdgcn_sdot8(clo, tr.x, 0, false), false);
                oacc[cb] += (float)ai * bsc;
            }
            if (vb < 6) { PEER_ISSUE8V(vb + 2); PEER_LOADIDX((vb + 3) & 7); }
        }
        float* xo = dry ? (float*)(F.ws + WS_PROJ + (128u << 20)) + (size_t)tl * 1024 + lane : F.out + t * 1024 + lane;
        float ss = 0.f;
#pragma unroll
        for (int cb = 0; cb < 16; ++cb) { xa[cb] = xa[cb] + oacc[cb] * (1.0f / PEER_U_SCALE); ss += xa[cb] * xa[cb]; }
        ss = row_sum16(ss); ss += bperm_f(a16, ss); ss += bperm_f(a32, ss);
        const float rf = __builtin_amdgcn_rsqf(ss * (1.0f / 1024.0f) + EPS);
#pragma unroll
        for (int cb = 0; cb < 16; ++cb) xo[64 * cb] = xa[cb] * rf * gf[cb];
    }
#undef PEER_VFETCH
#undef PEER_ISSUE8V
}
#undef PEER_LOADIDX

DI void convert_uv(Frame& F, int part, int nparts, int cu, int ncu) {
    F.refresh();
    const int gt = cu * 512 + F.tid, NGT = ncu * 512, per = (2 * 16384 * 64) / nparts;
    for (int id = part * per + gt; id < (part + 1) * per; id += NGT) {
        const int which = id >> 20, off = (id & ((1 << 20) - 1)) * 16;
        const float* src = (which ? F.peer_v : F.peer_u) + off; unsigned char* dst = F.ws + (which ? WS_V : WS_U) + off / 2;
        u32x2 o;
        if (which == 0) {
#pragma unroll
            for (int q = 0; q < 2; ++q) { const f32x4 v0 = *(const f32x4*)(src + 8 * q) * PEER_UF4_SCALE, v1 = *(const f32x4*)(src + 8 * q + 4) * PEER_UF4_SCALE;
                unsigned pk = __builtin_amdgcn_cvt_scalef32_pk_fp4_f32(0u, v0.x, v0.y, 1.0f, 0); pk = __builtin_amdgcn_cvt_scalef32_pk_fp4_f32(pk, v0.z, v0.w, 1.0f, 1);
                pk = __builtin_amdgcn_cvt_scalef32_pk_fp4_f32(pk, v1.x, v1.y, 1.0f, 2); pk = __builtin_amdgcn_cvt_scalef32_pk_fp4_f32(pk, v1.z, v1.w, 1.0f, 3); o[q] = pk; }
        } else {
#pragma unroll
            for (int q = 0; q < 2; ++q) { const f32x4 v0 = *(const f32x4*)(src + 8 * q) * PEER_U_SCALE, v1 = *(const f32x4*)(src + 8 * q + 4) * PEER_U_SCALE; unsigned pk = 0u;
#pragma unroll
                for (int k = 0; k < 4; ++k) { pk |= ((unsigned)(int)__builtin_rintf(fminf(fmaxf(v0[k], -7.f), 7.f)) & 15u) << (4 * k); pk |= ((unsigned)(int)__builtin_rintf(fminf(fmaxf(v1[k], -7.f), 7.f)) & 15u) << (16 + 4 * k); }
                o[q] = pk; }
        }
        *(u32x2*)dst = o;
    }
}

constexpr int N_PHASES = 21;
struct Args { const float* in[17]; float* out; unsigned char* ws; int ph_lo, ph_hi; };

__global__ void __launch_bounds__(NWAVES * 64, 2) fwd_kernel(Args args) {
    extern __shared__ __attribute__((aligned(16))) unsigned char lds_raw[];
    Frame F;
    F.lds = (LAS unsigned char*)lds_raw;
    F.tid = threadIdx.x; F.lane = F.tid & 63; F.wave = __builtin_amdgcn_readfirstlane(F.tid >> 6);
    F.G = gridDim.x; { const int bx = blockIdx.x; F.vcu = (F.G % 8 == 0) ? (bx % 8) * (F.G / 8) + bx / 8 : bx; }
    F.x = args.in[0]; F.mem = args.in[1]; F.norm_mix_g = args.in[2]; F.w_in = args.in[3]; F.hg_lb = args.in[4]; F.hg_norm_g = args.in[5]; F.sc_conv_w = args.in[6];
    F.mem_norm_g = args.in[7]; F.w_mem_kv = args.in[8]; F.w_branch = args.in[9]; F.w_out = args.in[10]; F.norm_ffn_g = args.in[11]; F.peer_w_q = args.in[12];
    F.peer_sub_keys = args.in[13]; F.peer_u = args.in[14]; F.peer_v = args.in[15]; F.final_norm_g = args.in[16];
    F.out = args.out; F.ws = args.ws;
    volatile LAS unsigned* MISC = (volatile LAS unsigned*)(F.lds + MISC_OFF);
    for (int u = F.tid; u < (LDS_BYTES - MISC_OFF) / 4; u += NWAVES * 64) MISC[u] = 0u;
    __syncthreads();
    unsigned* barw = (unsigned*)(F.ws + WS_CTL) + CW_BAR;
    XcdBarrier bar; bar.bar = barw; bar.x = 0; bar.st = nullptr;
    const bool one_launch = (args.ph_hi - args.ph_lo) > 1;
    if (one_launch) bar = xcd_barrier_post(barw, MISC + 8);
    const int lo = args.ph_lo, hi = args.ph_hi;
#define IN(k) (lo <= (k) && (k) < hi)
#ifndef PMASK
#define PMASK 0x3ff
#endif
#define PC_(c) ((PMASK >> (c)) & 1)
#ifndef REP_MASK
#define REP_MASK 0
#endif
#define REPS(c) for (int rep_ = 0; rep_ < 1 + 2 * ((REP_MASK >> (c)) & 1); ++rep_)
#define SEAM(k) do { if (IN(k) && IN((k) + 1)) xcd_barrier(bar); } while (0)
    unsigned char* ws = F.ws;
    const int G = F.G, cid = (int)blockIdx.x;

    if (PC_(0) && IN(0)) { REPS(0) p0_prologue(F); } SEAM(0);

#pragma unroll 1
    for (int g = 0; g < NGRP; ++g) {
        const int pb = 1 + 6 * g;
        if (PC_(1) && IN(pb)) REPS(1) {
            pg8::InOrder S; S.init(TG, PC, G, cid); S.H = (const char*)(ws + WS_XG) + (size_t)g * TG * 1024 * 2; S.Win = (const char*)(ws + WS_WIN); S.Mn = (const char*)(ws + WS_MN); S.Wkv = (const char*)(ws + WS_WKV); S.n_extra = (g == 0) ? 64 : 0;
            pg8::EpiIn E{(bf16*)(ws + WS_PROJ), (bf16*)(ws + WS_KMEM), (bf16*)(ws + WS_VT)};
            pg8::gemm_phase<pg8::EpiIn, pg8::InOrder, true, true>(F.lds, pg8::Gemm{1024, 1024, 1024}, S, E);
            if (cid >= 128) convert_uv(F, g, NGRP, cid - 128, G - 128);
        } SEAM(pb);
        if (PC_(2) && IN(pb + 1)) REPS(2) {
            for (int it = F.vcu * 4; it < BG * 4 * NCHUNK; it += G * 4) { for (int k = 0; k < 4; ++k) hgrn_a_item(F, it + k, k < 3); }
            for (int it = F.vcu; it < BG * 4 * 8; it += G) attn_item(F, g, it);
            conv_phase(F);
        } SEAM(pb + 1);
        if (PC_(3) && IN(pb + 2)) { REPS(3) hgrn_scan(F); } SEAM(pb + 2);
        if (PC_(4) && IN(pb + 3)) REPS(4) { for (int it = F.vcu * 4; it < BG * 4 * NCHUNK; it += G * 4) { for (int k = 0; k < 4; ++k) hgrn_c_item(F, it + k, k < 3); } } SEAM(pb + 3);
        if (PC_(5) && IN(pb + 4)) REPS(5) {
            pg8::BranchOrder S; S.init(TG, 1024, G, cid); S.Y = (const char*)(ws + WS_YHG); S.Wb = (const char*)(ws + WS_WBR);
            pg8::EpiBranch E{(const bf16*)(ws + WS_PROJ), (bf16*)(ws + WS_MACC), (bf16*)(ws + WS_MERGED)};
            pg8::gemm_phase<pg8::EpiBranch, pg8::BranchOrder, true, true>(F.lds, pg8::Gemm{512, 512, 512}, S, E);
        } SEAM(pb + 4);
        if (PC_(6) && IN(pb + 5)) REPS(6) {
            pg8::PlainOrder S; S.init(TG, 1024, G, cid); S.A = (const char*)(ws + WS_MERGED); S.Bt = (const char*)(ws + WS_WOUT); S.a_tile = 256 * 1024 * 2; S.b_tile = 256 * 1024 * 2;
            pg8::EpiOut E{F.x + (size_t)g * TG * 1024, F.out + (size_t)g * TG * 1024, (bf16*)(ws + WS_XG) + (size_t)g * TG * 1024, F.norm_ffn_g, (float*)(ws + WS_SSP) + (size_t)g * TG * 16};
            pg8::gemm_phase<pg8::EpiOut, pg8::PlainOrder, true, true>(F.lds, pg8::Gemm{1024, 1024, 1024}, S, E);
        } SEAM(pb + 5);
    }
#pragma unroll 1
    for (int tg = 0; tg < NGRP; ++tg) {
        const int pb = 13 + 4 * tg;
        if (PC_(7) && IN(pb)) REPS(7) {
            pg8::PlainOrder S; S.init(TG, 2048, G, cid); S.A = (const char*)(ws + WS_XG) + (size_t)tg * TG * 1024 * 2; S.Bt = (const char*)(ws + WS_WQ); S.a_tile = 256 * 1024 * 2; S.b_tile = 256 * 1024 * 2;
            pg8::EpiQ E{(bf16*)(ws + WS_Q), 2048, (const float*)(ws + WS_SSP) + (size_t)tg * TG * 16};
            pg8::gemm_phase<pg8::EpiQ, pg8::PlainOrder, true, true>(F.lds, pg8::Gemm{1024, 1024, 1024}, S, E);
        } SEAM(pb);
        if (PC_(8) && IN(pb + 1)) REPS(8) {
            pg8::ScoreOrder S; S.init(TG, 2048, G, cid); S.Q = (const char*)(ws + WS_Q); S.Kbd = (const char*)(ws + WS_KBD);
            pg8::EpiF32 E{(float*)(ws + WS_S), 2048};
            pg8::gemm_phase<pg8::EpiF32, pg8::ScoreOrder, true, true>(F.lds, pg8::Gemm{2048, 256, 256}, S, E);
        } SEAM(pb + 1);
        if (PC_(9) && IN(pb + 2)) { REPS(9) peer_u_phase(F, tg); } SEAM(pb + 2);
        if (PC_(9) && IN(pb + 3)) { REPS(10) peer_v_phase(F, tg, rep_ < 2 * ((REP_MASK >> 10) & 1)); } SEAM(pb + 3);
    }
#undef IN
#undef SEAM
}

extern "C" void kernel_launch(void* const* d_in, const int* in_sizes, int n_in, void* d_out, int out_size, void* d_ws, size_t ws_size, hipStream_t stream) {
    static int ready = 0;
    if (ready == 0) {
        if (n_in != 17 || out_size != T_ALL * D_MODEL || ws_size < WS_END) { fprintf(stderr, "kernel_launch: unexpected shapes (n_in %d, out %d, ws %zu)\n", n_in, out_size, ws_size); ready = -1; return; }
        if (hipFuncSetAttribute((const void*)fwd_kernel, hipFuncAttributeMaxDynamicSharedMemorySize, LDS_BYTES) != hipSuccess) { fprintf(stderr, "kernel_launch: hipFuncSetAttribute failed\n"); ready = -1; return; }
        ready = 1;
    }
    if (ready < 0) return;
    (void)hipMemsetAsync((char*)d_ws + WS_CTL, 0, CTL_ZERO_BYTES, stream);
    Args a{};
    for (int i = 0; i < 17; ++i) a.in[i] = (const float*)d_in[i];
    a.out = (float*)d_out; a.ws = (unsigned char*)d_ws;
    const int grid = 256;
#if MK_N_LAUNCHES == 1
    a.ph_lo = 0; a.ph_hi = N_PHASES;
    hipLaunchKernelGGL(fwd_kernel, dim3(grid), dim3(NWAVES * 64), LDS_BYTES, stream, a);
#else
    for (int li = 0; li < N_PHASES; ++li) { a.ph_lo = li; a.ph_hi = li + 1; hipLaunchKernelGGL(fwd_kernel, dim3(grid), dim3(NWAVES * 64), LDS_BYTES, stream, a); }
#endif
}
```

```cpp
#include <hip/hip_runtime.h>
#include <cstdio>
#include <cstdint>

#ifndef MK_N_LAUNCHES
#define MK_N_LAUNCHES 1
#endif

#define LAS __attribute__((address_space(3)))
#define GAS __attribute__((address_space(1)))
typedef unsigned short bf16;
typedef short bf16x8 __attribute__((ext_vector_type(8)));
typedef short s16x4 __attribute__((ext_vector_type(4)));
typedef short v4i16_t __attribute__((ext_vector_type(4)));
typedef float f32x2 __attribute__((ext_vector_type(2)));
typedef float f32x4 __attribute__((ext_vector_type(4)));
typedef float f32x16 __attribute__((ext_vector_type(16)));
typedef unsigned u32x2 __attribute__((ext_vector_type(2)));
typedef unsigned u32x4 __attribute__((ext_vector_type(4)));
typedef __bf16 bf16x2_t __attribute__((ext_vector_type(2)));
typedef GAS unsigned gu32;
#define RLX_AGENT __ATOMIC_RELAXED, __HIP_MEMORY_SCOPE_AGENT
#define DI __device__ __forceinline__

constexpr int D_MODEL = 1024, BATCH = 16, SEQ = 2048, T_ALL = BATCH * SEQ;
constexpr int NGRP = 2, BG = BATCH / NGRP, TG = BG * SEQ;
constexpr int PC = 7680;
constexpr int C_HQ = 0, C_HI = 512, C_FF = 1024, C_FB = 1536, C_HG = 2048, C_SB = 2560, C_SC = 3072, C_SH = 3584, C_MQ = 4096, C_GATE = 4608;
constexpr int NMEM = 256, CHUNK = 64, NCHUNK = SEQ / CHUNK;
constexpr float EPS = 1e-6f;

constexpr size_t MiB = 1u << 20;
constexpr size_t WS_CTL = 0, CTL_ZERO_BYTES = 1 * MiB;
constexpr size_t WS_LB = 1 * MiB;
constexpr size_t WS_SSP = 2 * MiB;
constexpr size_t WS_DEC = 4 * MiB;
constexpr size_t WS_WIN = 5 * MiB, WS_WKV = 20 * MiB, WS_WBR = 22 * MiB, WS_WOUT = 25 * MiB, WS_WQ = 27 * MiB, WS_KBD = 31 * MiB;
constexpr size_t WS_MN = 32 * MiB, WS_KMEM = 40 * MiB, WS_VT = 44 * MiB;
constexpr size_t WS_XG = 48 * MiB;
constexpr size_t WS_YHG = 112 * MiB, WS_YSC = 128 * MiB, WS_YMX = 144 * MiB;
constexpr size_t WS_DS = 160 * MiB;
constexpr size_t WS_MACC = 160 * MiB;
constexpr size_t WS_MERGED = 224 * MiB;
constexpr size_t WS_PROJ = 256 * MiB;
constexpr size_t WS_U = 496 * MiB, WS_V = 504 * MiB;
constexpr size_t WS_Q = 176 * MiB;
constexpr size_t WS_S = 256 * MiB;
constexpr size_t WS_PL = 448 * MiB;
constexpr size_t WS_END = 512 * MiB;
constexpr size_t OUT_SST = 64 * MiB;

constexpr int LDS_BYTES = 160 * 1024;
constexpr int MISC_OFF = LDS_BYTES - 512;
constexpr int NWAVES = 8;

DI unsigned f2bf(float f) { unsigned u = __builtin_bit_cast(unsigned, f); return (u + 0x7fffu + ((u >> 16) & 1u)) >> 16; }
DI unsigned pk2(float lo, float hi) { return f2bf(lo) | (f2bf(hi) << 16); }
DI float bf2f(unsigned short b) { return __builtin_bit_cast(float, (unsigned)b << 16); }
DI float bflo(unsigned w) { return __builtin_bit_cast(float, w << 16); }
DI float bfhi(unsigned w) { return __builtin_bit_cast(float, w & 0xffff0000u); }
DI float wave_sum(float v) {
#pragma unroll
    for (int o = 1; o < 64; o <<= 1) v += __shfl_xor(v, o);
    return v;
}
DI unsigned cvtpk(float lo, float hi) { f32x2 v = {lo, hi}; bf16x2_t b = __builtin_convertvector(v, bf16x2_t); return __builtin_bit_cast(unsigned, b); }
template <int CTRL> DI unsigned dpp_u(unsigned v) { return (unsigned)__builtin_amdgcn_update_dpp(0, (int)v, CTRL, 0xF, 0xF, false); }
template <int CTRL> DI float dpp_f(float v) { return __builtin_bit_cast(float, __builtin_amdgcn_update_dpp(0, __builtin_bit_cast(int, v), CTRL, 0xF, 0xF, false)); }
DI float bperm_f(int addr, float v) { return __builtin_bit_cast(float, __builtin_amdgcn_ds_bpermute(addr, __builtin_bit_cast(int, v))); }
DI unsigned row_max16(unsigned m) { m = max(m, dpp_u<0xB1>(m)); m = max(m, dpp_u<0x4E>(m)); m = max(m, dpp_u<0x141>(m)); return max(m, dpp_u<0x140>(m)); }
DI float row_sum16(float v) { v += dpp_f<0xB1>(v); v += dpp_f<0x4E>(v); v += dpp_f<0x141>(v); return v + dpp_f<0x140>(v); }

DI float fast_sig(float z) { return __builtin_amdgcn_rcpf(1.0f + __builtin_amdgcn_exp2f(-1.4426950408889634f * z)); }
DI float sigmoidf_(float z) { return 1.0f / (1.0f + __expf(-z)); }

namespace pg8 {
constexpr int BM = 256, BK = 64, HALF = 128, HTB = HALF * BK * 2, STAGE_BYTES = 8 * HTB, NXCD = 8, WGM = 8;
__host__ __device__ __forceinline__ int lds_byte(int r, int c) { const int st = (r >> 4) * 2 + (c >> 5), rr = r & 15, cc = c & 31, ob = rr * 64 + cc * 2; return st * 1024 + (ob ^ (((ob >> 9) & 1) << 5)); }
__host__ __device__ __forceinline__ void stage_rc(int b, int& R, int& C) { const int st = b / 1024, sb = b % 1024, swz = sb ^ (((sb >> 9) & 1) << 5); R = (st >> 1) * 16 + swz / 64; C = (st & 1) * 32 + (swz % 64) / 2; }
__host__ __device__ __forceinline__ int perm32(int rho) { const int n = rho >> 4, i = rho & 15; return 8 * (i >> 2) + 4 * n + (i & 3); }

struct Unit { int pm, pn, z; };
struct Gemm { int lda, ldb, K; };

struct StaticOrder {
    int nM, nN, nwg, G, c;
    __device__ void init(int M, int N, int G_, int c_) { nM = M / BM; nN = N / BM; nwg = nM * nN; G = G_; c = c_; }
    __device__ bool tile(int i, Unit& u) const {
        const long L = (long)i * G + c; if (L >= nwg) return false;
        int wgid = (int)L; { const int q = nwg / NXCD, r = nwg % NXCD, xcd = wgid % NXCD, off = wgid / NXCD; wgid = (xcd < r ? xcd * (q + 1) : r * (q + 1) + (xcd - r) * q) + off; }
        const int nig = WGM * nN, gid = wgid / nig, fm = gid * WGM, gsz = (nM - fm) < WGM ? (nM - fm) : WGM;
        u.pm = fm + ((wgid % nig) % gsz); u.pn = (wgid % nig) / gsz; u.z = 0; return true;
    }
};

DI unsigned cvt_pk_bf16(float lo, float hi) { return cvtpk(lo, hi); }

template <class Epi, class Sched, bool ALIGN_EPI, bool SP2>
DI void gemm_phase(LAS unsigned char* lds, const Gemm g, const Sched& S, const Epi& E) {
    int tid_ = threadIdx.x; asm volatile("" : "+v"(tid_));
    const int tid = tid_, wid = __builtin_amdgcn_readfirstlane(tid >> 6), lane = tid & 63, wr = wid >> 2, wc = wid & 3, fr = lane & 15, fq = lane >> 4;
    int K_ = g.K; asm volatile("" : "+s"(K_));
    const int K = K_, nt = K / BK;
    unsigned voffA[2], voffB[2];
#pragma unroll
    for (int i = 0; i < 2; ++i) { int R, C; stage_rc(tid * 16 + i * 8192, R, C); const int Rb = Epi::PERM ? ((R & ~31) + perm32(R & 31)) : R;
        voffA[i] = (unsigned)(R * g.lda + C) * 2u; voffB[i] = (unsigned)(Rb * g.ldb + C) * 2u; }
    const size_t kstep = (size_t)(BK * 2);
    const size_t hA = (size_t)HALF * g.lda * 2, hB = (size_t)HALF * g.ldb * 2;
    const unsigned ldsw = (unsigned)wid * 1024u;
    const int aoff = lds_byte(wr * 64 + fr, fq * 8), boff = lds_byte(wc * 32 + fr, fq * 8);
#define PG8_SA(b, h) (((b) * 2 + (h)) * HTB)
#define PG8_SB(b, h) ((4 + (b) * 2 + (h)) * HTB)
#define PG8_STAGE(bufoff, gbase, voff) do { _Pragma("unroll") for (int _i = 0; _i < 2; ++_i) \
        __builtin_amdgcn_global_load_lds((const unsigned*)((const char*)(gbase) + (voff)[_i]), (LAS unsigned*)(lds + (bufoff) + ldsw + _i * 8192), 16, 0, 0); } while (0)
#define PG8_LDA(dst, b, h) do { _Pragma("unroll") for (int m = 0; m < 4; ++m) _Pragma("unroll") for (int k = 0; k < 2; ++k) dst[m][k] = *(const LAS bf16x8*)(lds + PG8_SA(b, h) + aoff + m * 2048 + k * 1024); } while (0)
#define PG8_LDB(dst, b, h) do { _Pragma("unroll") for (int n = 0; n < 2; ++n) _Pragma("unroll") for (int k = 0; k < 2; ++k) dst[n][k] = *(const LAS bf16x8*)(lds + PG8_SB(b, h) + boff + n * 2048 + k * 1024); } while (0)
#define PG8_MMA(ai, bj, At, Bt) do { __builtin_amdgcn_s_setprio(1); _Pragma("unroll") for (int m = 0; m < 4; ++m) _Pragma("unroll") for (int n = 0; n < 2; ++n) _Pragma("unroll") for (int k = 0; k < 2; ++k) \
        acc[ai][bj][m][n] = __builtin_amdgcn_mfma_f32_16x16x32_bf16(Bt[n][k], At[m][k], acc[ai][bj][m][n], 0, 0, 0); __builtin_amdgcn_s_setprio(0); } while (0)
#define PG8_WAIT_V(n) asm volatile("s_waitcnt vmcnt(" #n ")" ::: "memory")
#define PG8_WAIT_L(n) asm volatile("s_waitcnt lgkmcnt(" #n ")" ::: "memory")
#define PG8_BAR __builtin_amdgcn_s_barrier()
#define PG8_SCHED __builtin_amdgcn_sched_barrier(0)
    Unit cur, nxt; int ui = 0;
    if (!S.next(0, cur)) return;
    f32x4 acc[2][2][4][2];
#pragma unroll
    for (int a = 0; a < 2; ++a)
#pragma unroll
        for (int b = 0; b < 2; ++b)
#pragma unroll
            for (int m = 0; m < 4; ++m)
#pragma unroll
                for (int n = 0; n < 2; ++n) acc[a][b][m][n] = (f32x4){0.f, 0.f, 0.f, 0.f};
    bf16x8 At[4][2], B0[2][2], B1[2][2];
    const char* cA = S.a_base(cur); const char* cB = S.b_base(cur);
    if constexpr (SP2) {
        PG8_STAGE(PG8_SB(0, 0), cB, voffB); PG8_STAGE(PG8_SB(0, 1), cB + hB, voffB); PG8_STAGE(PG8_SA(0, 0), cA, voffA); PG8_STAGE(PG8_SA(0, 1), cA + hA, voffA);
        if (wr == 1) PG8_BAR;
        PG8_WAIT_V(2); PG8_BAR;
        PG8_STAGE(PG8_SB(1, 0), cB + kstep, voffB); PG8_STAGE(PG8_SA(1, 0), cA + kstep, voffA); PG8_STAGE(PG8_SB(1, 1), cB + hB + kstep, voffB);
        PG8_WAIT_V(6); PG8_BAR;
    } else {
        PG8_STAGE(PG8_SB(0, 0), cB, voffB); PG8_STAGE(PG8_SA(0, 0), cA, voffA); PG8_STAGE(PG8_SB(0, 1), cB + hB, voffB); PG8_STAGE(PG8_SA(0, 1), cA + hA, voffA);
        if (wr == 1) PG8_BAR;
        PG8_WAIT_V(4); PG8_BAR;
        PG8_STAGE(PG8_SB(1, 0), cB + kstep, voffB); PG8_STAGE(PG8_SA(1, 0), cA + kstep, voffA); PG8_STAGE(PG8_SB(1, 1), cB + hB + kstep, voffB);
        PG8_WAIT_V(6); PG8_BAR;
    }
    for (;;) {
        const bool has_next = S.next(ui + 1, nxt);
        const char* nA = has_next ? S.a_base(nxt) : cA; const char* nB = has_next ? S.b_base(nxt) : cB;
        for (int t = 0; t < nt; t += 2) {
            const bool last = (t == nt - 2);
            const char* a1 = cA + (size_t)(t + 1) * kstep;
            const char* a2 = last ? nA : cA + (size_t)(t + 2) * kstep; const char* b2 = last ? nB : cB + (size_t)(t + 2) * kstep;
            const char* a3 = a2 + kstep; const char* b3 = b2 + kstep;
            if constexpr (SP2) {
            PG8_LDB(B0, 0, 0); PG8_LDB(B1, 0, 1); PG8_SCHED; PG8_LDA(At, 0, 0); PG8_STAGE(PG8_SA(1, 1), a1 + hA, voffA);
            PG8_WAIT_V(8); PG8_WAIT_L(0); PG8_BAR; PG8_MMA(0, 0, At, B0); PG8_MMA(0, 1, At, B1); PG8_BAR; PG8_SCHED;
            PG8_LDA(At, 0, 1); PG8_STAGE(PG8_SB(0, 0), b2, voffB); PG8_STAGE(PG8_SB(0, 1), b2 + hB, voffB); PG8_STAGE(PG8_SA(0, 0), a2, voffA);
            PG8_WAIT_V(8); PG8_WAIT_L(0); PG8_BAR; PG8_MMA(1, 0, At, B0); PG8_MMA(1, 1, At, B1); PG8_BAR; PG8_SCHED;
            PG8_LDB(B0, 1, 0); PG8_LDB(B1, 1, 1); PG8_SCHED; PG8_LDA(At, 1, 0); PG8_STAGE(PG8_SA(0, 1), a2 + hA, voffA);
            PG8_WAIT_V(8); PG8_WAIT_L(0); PG8_BAR; PG8_MMA(0, 0, At, B0); PG8_MMA(0, 1, At, B1); PG8_BAR; PG8_SCHED;
            PG8_LDA(At, 1, 1); PG8_STAGE(PG8_SB(1, 0), b3, voffB); PG8_STAGE(PG8_SB(1, 1), b3 + hB, voffB); PG8_STAGE(PG8_SA(1, 0), a3, voffA);
            PG8_WAIT_V(8); PG8_WAIT_L(0); PG8_BAR; PG8_MMA(1, 0, At, B0); PG8_MMA(1, 1, At, B1); PG8_BAR; PG8_SCHED;
            } else {
            PG8_LDB(B0, 0, 0); PG8_SCHED; PG8_LDA(At, 0, 0); PG8_STAGE(PG8_SA(1, 1), a1 + hA, voffA);
            PG8_WAIT_L(8); PG8_BAR; PG8_WAIT_L(0); PG8_MMA(0, 0, At, B0); PG8_BAR; PG8_SCHED;
            PG8_LDB(B1, 0, 1); PG8_STAGE(PG8_SB(0, 0), b2, voffB);
            PG8_BAR; PG8_WAIT_L(0); PG8_MMA(0, 1, At, B1); PG8_BAR;
            PG8_LDA(At, 0, 1); PG8_STAGE(PG8_SA(0, 0), a2, voffA);
            PG8_BAR; PG8_WAIT_L(0); PG8_MMA(1, 0, At, B0); PG8_BAR; PG8_SCHED;
            PG8_STAGE(PG8_SB(0, 1), b2 + hB, voffB);
            PG8_WAIT_V(6); PG8_BAR; PG8_MMA(1, 1, At, B1); PG8_BAR;
            PG8_LDB(B0, 1, 0); PG8_SCHED; PG8_LDA(At, 1, 0); PG8_STAGE(PG8_SA(0, 1), a2 + hA, voffA);
            PG8_WAIT_L(8); PG8_BAR; PG8_WAIT_L(0); PG8_MMA(0, 0, At, B0); PG8_BAR; PG8_SCHED;
            PG8_LDB(B1, 1, 1); PG8_STAGE(PG8_SB(1, 0), b3, voffB);
            PG8_BAR; PG8_WAIT_L(0); PG8_MMA(0, 1, At, B1); PG8_BAR;
            PG8_LDA(At, 1, 1); PG8_STAGE(PG8_SA(1, 0), a3, voffA);
            PG8_BAR; PG8_WAIT_L(0); PG8_MMA(1, 0, At, B0); PG8_BAR; PG8_SCHED;
            PG8_STAGE(PG8_SB(1, 1), b3 + hB, voffB);
            PG8_WAIT_V(6); PG8_BAR; PG8_MMA(1, 1, At, B1); PG8_BAR;
            }
        }
        if constexpr (ALIGN_EPI) { if (wr == 0) PG8_BAR; }
        E(acc, cur, wr, wc, fr, fq);
        if (!has_next) break;
#pragma unroll
        for (int a = 0; a < 2; ++a)
#pragma unroll
            for (int b = 0; b < 2; ++b)
#pragma unroll
                for (int m = 0; m < 4; ++m)
#pragma unroll
                    for (int n = 0; n < 2; ++n) acc[a][b][m][n] = (f32x4){0.f, 0.f, 0.f, 0.f};
        cur = nxt; cA = nA; cB = nB; ++ui;
        if constexpr (ALIGN_EPI) { if (wr == 1) PG8_BAR; }
    }
    PG8_WAIT_V(0);
    if constexpr (!ALIGN_EPI) { if (wr == 0) PG8_BAR; }
    PG8_BAR;
#undef PG8_SA
#undef PG8_SB
#undef PG8_STAGE
#undef PG8_LDA
#undef PG8_LDB
#undef PG8_MMA
#undef PG8_WAIT_V
#undef PG8_WAIT_L
#undef PG8_BAR
#undef PG8_SCHED
}
}

namespace pg8 {
struct PlainOrder : StaticOrder {
    const char* A; const char* Bt; size_t a_tile, b_tile;
    __device__ bool next(int i, Unit& u) const { return tile(i, u); }
    DI const char* a_base(const Unit& u) const { return A + (size_t)u.pm * a_tile; }
    DI const char* b_base(const Unit& u) const { return Bt + (size_t)u.pn * b_tile; }
};
struct InOrder : StaticOrder {
    const char* H; const char* Win; const char* Mn; const char* Wkv; int n_extra;
    __device__ bool next(int i, Unit& u) const {
        const long L = (long)i * G + c;
        if (L >= (long)nwg + n_extra) return false;
        Unit t; t.pm = 0; t.pn = 0; t.z = 0;
        const bool main_tile = L < nwg;
        if (main_tile) (void)tile(i, t);
        const int e = (int)(L - nwg);
        const int pm1 = e >> 1, pn1 = e & 1, pm2 = (e - 32) >> 4, pn2 = (e - 32) & 15; const bool k1 = e < 32;
        u.pm = main_tile ? t.pm : (k1 ? pm1 : pm2); u.pn = main_tile ? t.pn : (k1 ? pn1 : pn2); u.z = main_tile ? 0 : (k1 ? 1 : 2);
        return true;
    }
    DI const char* a_base(const Unit& u) const { const long d1 = Mn - H, d2 = (Wkv + (size_t)512 * 1024 * 2) - H; return H + ((u.z == 1) ? d1 : 0L) + ((u.z == 2) ? d2 : 0L) + (size_t)u.pm * (256 * 1024 * 2); }
    DI const char* b_base(const Unit& u) const { const long d1 = Wkv - Win, d2 = Mn - Win; return Win + ((u.z == 1) ? d1 : 0L) + ((u.z == 2) ? d2 : 0L) + (size_t)u.pn * (256 * 1024 * 2); }
};
struct EpiIn {
    static constexpr bool PERM = true;
    bf16* proj; bf16* kmem; bf16* vt;
    DI void operator()(const f32x4 (&acc)[2][2][4][2], const Unit& u, int wr, int wc, int fr, int fq) const {
        const long dk = kmem - proj, dv = vt - proj; bf16* O = proj + ((u.z == 1) ? dk : 0L) + ((u.z == 2) ? dv : 0L); const int ldc = PC + ((u.z == 1) ? 512 - PC : 0) + ((u.z == 2) ? BATCH * NMEM - PC : 0);
        const int row0 = u.pm * BM + wr * 64 + fr, col0 = u.pn * BM + wc * 32 + 8 * fq;
#pragma unroll
        for (int ai = 0; ai < 2; ++ai)
#pragma unroll
            for (int m = 0; m < 4; ++m) { bf16* rowp = O + (size_t)(row0 + ai * HALF + m * 16) * ldc + col0;
#pragma unroll
                for (int bj = 0; bj < 2; ++bj) { const f32x4 v0 = acc[ai][bj][m][0], v1 = acc[ai][bj][m][1];
                    u32x4 w; w.x = cvt_pk_bf16(v0[0], v0[1]); w.y = cvt_pk_bf16(v0[2], v0[3]); w.z = cvt_pk_bf16(v1[0], v1[1]); w.w = cvt_pk_bf16(v1[2], v1[3]);
                    *(u32x4*)(rowp + bj * HALF) = w; } }
    }
};
struct BranchOrder : StaticOrder {
    const char* Y; const char* Wb;
    __device__ bool next(int i, Unit& u) const { if (!tile(i / 3, u)) return false; u.z = i % 3; return true; }
    DI const char* a_base(const Unit& u) const { return Y + (size_t)u.z * (16 * MiB) + (size_t)u.pm * (256 * 512 * 2); }
    DI const char* b_base(const Unit& u) const { return Wb + (size_t)u.z * (1024 * 512 * 2) + (size_t)u.pn * (256 * 512 * 2); }
};
struct ScoreOrder : StaticOrder {
    const char* Q; const char* Kbd;
    __device__ bool next(int i, Unit& u) const { return tile(i, u); }
    DI const char* a_base(const Unit& u) const { return Q + (size_t)u.pm * (256 * 2048 * 2) + (size_t)u.pn * 512; }
    DI const char* b_base(const Unit& u) const { return Kbd + (size_t)u.pn * (256 * 256 * 2); }
};

struct EpiBf16 {
    static constexpr bool PERM = true;
    bf16* O; int ldc;
    DI void operator()(const f32x4 (&acc)[2][2][4][2], const Unit& u, int wr, int wc, int fr, int fq) const {
        const int row0 = u.pm * BM + wr * 64 + fr, col0 = u.pn * BM + wc * 32 + 8 * fq;
#pragma unroll
        for (int ai = 0; ai < 2; ++ai)
#pragma unroll
            for (int m = 0; m < 4; ++m) { bf16* rowp = O + (size_t)(row0 + ai * HALF + m * 16) * ldc + col0;
#pragma unroll
                for (int bj = 0; bj < 2; ++bj) { const f32x4 v0 = acc[ai][bj][m][0], v1 = acc[ai][bj][m][1];
                    u32x4 w; w.x = cvt_pk_bf16(v0[0], v0[1]); w.y = cvt_pk_bf16(v0[2], v0[3]); w.z = cvt_pk_bf16(v1[0], v1[1]); w.w = cvt_pk_bf16(v1[2], v1[3]);
                    *(u32x4*)(rowp + bj * HALF) = w; } }
    }
};
struct EpiQ {
    static constexpr bool PERM = true;
    bf16* O; int ldc; const float* ssp;
    DI void operator()(const f32x4 (&acc)[2][2][4][2], const Unit& u, int wr, int wc, int fr, int fq) const {
        const int row0 = u.pm * BM + wr * 64 + fr, col0 = u.pn * BM + wc * 32 + 8 * fq;
#pragma unroll
        for (int ai = 0; ai < 2; ++ai)
#pragma unroll
            for (int m = 0; m < 4; ++m) { const int row = row0 + ai * HALF + m * 16; const f32x4* sp = (const f32x4*)(ssp + (size_t)row * 16);
                const f32x4 s0 = sp[0], s1 = sp[1], s2 = sp[2], s3 = sp[3];
                const float ss = ((s0[0] + s0[1]) + (s0[2] + s0[3])) + ((s1[0] + s1[1]) + (s1[2] + s1[3])) + ((s2[0] + s2[1]) + (s2[2] + s2[3])) + ((s3[0] + s3[1]) + (s3[2] + s3[3]));
                const float rs = 1.0f / sqrtf(ss * (1.0f / 1024.0f) + EPS);
                bf16* rowp = O + (size_t)row * ldc + col0;
#pragma unroll
                for (int bj = 0; bj < 2; ++bj) { const f32x4 v0 = acc[ai][bj][m][0] * rs, v1 = acc[ai][bj][m][1] * rs;
                    u32x4 w; w.x = cvt_pk_bf16(v0[0], v0[1]); w.y = cvt_pk_bf16(v0[2], v0[3]); w.z = cvt_pk_bf16(v1[0], v1[1]); w.w = cvt_pk_bf16(v1[2], v1[3]);
                    *(u32x4*)(rowp + bj * HALF) = w; }
                asm volatile("" ::: "memory"); }
    }
};
struct EpiF32 {
    static constexpr bool PERM = false;
    float* C; int ldc;
    DI void operator()(const f32x4 (&acc)[2][2][4][2], const Unit& u, int wr, int wc, int fr, int fq) const {
        const int row0 = u.pm * BM + wr * 64 + fr, col0 = u.pn * BM + wc * 32 + 4 * fq;
#pragma unroll
        for (int ai = 0; ai < 2; ++ai)
#pragma unroll
            for (int m = 0; m < 4; ++m) { float* rowp = C + (size_t)(row0 + ai * HALF + m * 16) * ldc + col0;
#pragma unroll
                for (int bj = 0; bj < 2; ++bj)
#pragma unroll
                    for (int n = 0; n < 2; ++n) *(f32x4*)(rowp + bj * HALF + n * 16) = acc[ai][bj][m][n]; }
    }
};
struct EpiBranch {
    static constexpr bool PERM = true;
    const bf16* proj; bf16* gbuf; bf16* merged;
    DI void operator()(const f32x4 (&acc)[2][2][4][2], const Unit& u, int wr, int wc, int fr, int fq) const {
        const int row0 = u.pm * BM + wr * 64 + fr, col0 = u.pn * BM + wc * 32 + 8 * fq;
#pragma unroll
        for (int ai = 0; ai < 2; ++ai)
#pragma unroll
            for (int m = 0; m < 4; ++m) { const int row = row0 + ai * HALF + m * 16;
#pragma unroll
                for (int bj = 0; bj < 2; ++bj) { const int col = col0 + bj * HALF;
                    const u32x4 gw = *(const u32x4*)(proj + (size_t)row * PC + C_GATE + u.z * 1024 + col);
                    f32x4 v0 = acc[ai][bj][m][0], v1 = acc[ai][bj][m][1];
                    v0[0] *= fast_sig(bflo(gw.x)); v0[1] *= fast_sig(bfhi(gw.x)); v0[2] *= fast_sig(bflo(gw.y)); v0[3] *= fast_sig(bfhi(gw.y));
                    v1[0] *= fast_sig(bflo(gw.z)); v1[1] *= fast_sig(bfhi(gw.z)); v1[2] *= fast_sig(bflo(gw.w)); v1[3] *= fast_sig(bfhi(gw.w));
                    const size_t off = (size_t)row * 1024 + col;
                    if (u.z == 2) { const u32x4 p0 = *(const u32x4*)(gbuf + off), p1 = *(const u32x4*)(gbuf + (size_t)TG * 1024 + off);
                        v0[0] += bflo(p0.x) + bflo(p1.x); v0[1] += bfhi(p0.x) + bfhi(p1.x); v0[2] += bflo(p0.y) + bflo(p1.y); v0[3] += bfhi(p0.y) + bfhi(p1.y);
                        v1[0] += bflo(p0.z) + bflo(p1.z); v1[1] += bfhi(p0.z) + bfhi(p1.z); v1[2] += bflo(p0.w) + bflo(p1.w); v1[3] += bfhi(p0.w) + bfhi(p1.w); }
                    u32x4 w; w.x = cvt_pk_bf16(v0[0], v0[1]); w.y = cvt_pk_bf16(v0[2], v0[3]); w.z = cvt_pk_bf16(v1[0], v1[1]); w.w = cvt_pk_bf16(v1[2], v1[3]);
                    *(u32x4*)((u.z == 2 ? merged : gbuf + (size_t)u.z * TG * 1024) + off) = w; }
                asm volatile("" ::: "memory"); }
    }
};
struct EpiOut {
    static constexpr bool PERM = true;
    const float* x; float* x1; bf16* xg; const float* gffn; float* ssp;
    DI void operator()(const f32x4 (&acc)[2][2][4][2], const Unit& u, int wr, int wc, int fr, int fq) const {
        const int row0 = u.pm * BM + wr * 64 + fr, col0 = u.pn * BM + wc * 32 + 8 * fq;
        f32x4 g0[2], g1[2];
#pragma unroll
        for (int bj = 0; bj < 2; ++bj) { g0[bj] = *(const f32x4*)(gffn + col0 + bj * HALF); g1[bj] = *(const f32x4*)(gffn + col0 + bj * HALF + 4); }
#pragma unroll
        for (int ai = 0; ai < 2; ++ai)
#pragma unroll
            for (int m = 0; m < 4; ++m) { const int row = row0 + ai * HALF + m * 16; float ss = 0.f;
#pragma unroll
                for (int bj = 0; bj < 2; ++bj) { const size_t off = (size_t)row * 1024 + col0 + bj * HALF;
                    const f32x4 v0 = acc[ai][bj][m][0] + *(const f32x4*)(x + off), v1 = acc[ai][bj][m][1] + *(const f32x4*)(x + off + 4);
                    *(f32x4*)(x1 + off) = v0; *(f32x4*)(x1 + off + 4) = v1;
                    ss += (v0[0] * v0[0] + v0[1] * v0[1]) + (v0[2] * v0[2] + v0[3] * v0[3]) + (v1[0] * v1[0] + v1[1] * v1[1]) + (v1[2] * v1[2] + v1[3] * v1[3]);
                    const f32x4 a = v0 * g0[bj], b = v1 * g1[bj];
                    u32x4 w; w.x = cvt_pk_bf16(a[0], a[1]); w.y = cvt_pk_bf16(a[2], a[3]); w.z = cvt_pk_bf16(b[0], b[1]); w.w = cvt_pk_bf16(b[2], b[3]);
                    *(u32x4*)(xg + off) = w; }
                ss += __shfl_xor(ss, 16); ss += __shfl_xor(ss, 32);
                if (fq == 0) ssp[(size_t)row * 16 + u.pn * 4 + wc] = ss;
                asm volatile("" ::: "memory"); }
    }
};
}

#define XB_TMO      128
#define XB_XCNT(j)  (256  + 64 * (j))
#define XB_XSUB(j)  (1280 + 64 * (j))
#define XB_XGEN(j)  (2304 + 64 * (j))
#define XB_TOP      3328
#define XB_TOPGEN   3392
#define XCD_BAR_WORDS 3456
#define XB_SPIN_CAP (1u << 18)
constexpr int CW_BAR = 4096;

DI unsigned xb_ld(unsigned* p)              { return __hip_atomic_load(p, __ATOMIC_RELAXED, __HIP_MEMORY_SCOPE_AGENT); }
DI unsigned xb_add(unsigned* p, unsigned v) { return __hip_atomic_fetch_add(p, v, __ATOMIC_RELAXED, __HIP_MEMORY_SCOPE_AGENT); }
DI unsigned xb_xcc_id() { return (unsigned)__builtin_amdgcn_s_getreg((3 << 11) | 20) & 0xFu; }
#define XB_SPIN(cond, bar) do { unsigned _sp = 0; while (cond) { __builtin_amdgcn_s_sleep(1); \
    if ((++_sp & 255u) == 0u) { if (xb_ld(&(bar)[XB_TMO])) break; if (_sp > XB_SPIN_CAP) { atomicAdd(&(bar)[XB_TMO], 1u); break; } } } } while (0)

struct XcdBarrier { unsigned* bar; unsigned x; volatile LAS unsigned* st; };

DI XcdBarrier xcd_barrier_post(unsigned* bar, volatile LAS unsigned* st) {
    XcdBarrier b; b.bar = bar; b.x = xb_xcc_id(); b.st = st;
    if (threadIdx.x == 0) (void)xb_add(&bar[XB_XCNT(b.x)], 1u);
    return b;
}
DI void xcd_barrier_complete(unsigned* bar, unsigned x, unsigned& nloc, unsigned& nx) {
    const unsigned G = gridDim.x * gridDim.y * gridDim.z;
    unsigned sum, cnt, mine, sp = 0u;
    for (;;) {
        sum = 0u; cnt = 0u; mine = 0u;
#pragma unroll
        for (unsigned j = 0; j < 16; ++j) { const unsigned c = xb_ld(&bar[XB_XCNT(j)]); sum += c; cnt += (c > 0u) ? 1u : 0u; mine = (j == x) ? c : mine; }
        if (sum == G) break;
        __builtin_amdgcn_s_sleep(1);
        if ((++sp & 255u) == 0u) { if (xb_ld(&bar[XB_TMO])) break; if (sp > XB_SPIN_CAP) { atomicAdd(&bar[XB_TMO], 1u); break; } }
    }
    nloc = mine > 0u ? mine : 1u; nx = cnt > 0u ? cnt : 1u;
}
DI void xcd_barrier(const XcdBarrier& b) {
    asm volatile("s_waitcnt vmcnt(0)" ::: "memory");
    __syncthreads();
    if (threadIdx.x == 0) {
        unsigned* bar = b.bar;
        __builtin_amdgcn_s_waitcnt(0);
        unsigned nloc = b.st[0], nx = b.st[1];
        if (nloc == 0u) { xcd_barrier_complete(bar, b.x, nloc, nx); b.st[0] = nloc; b.st[1] = nx; }
        const unsigned old = xb_add(&bar[XB_XSUB(b.x)], 1u);
        const unsigned gen = old / nloc;
        if (old + 1u == (gen + 1u) * nloc) {
            __builtin_amdgcn_fence(__ATOMIC_RELEASE, "agent");
            asm volatile("s_waitcnt vmcnt(0)" ::: "memory");
            const unsigned og = xb_add(&bar[XB_TOP], 1u);
            const unsigned tg = og / nx;
            if (og + 1u == (tg + 1u) * nx) xb_add(&bar[XB_TOPGEN], 1u);
            else XB_SPIN(xb_ld(&bar[XB_TOPGEN]) == tg, bar);
            __builtin_amdgcn_fence(__ATOMIC_ACQUIRE, "agent");
            xb_add(&bar[XB_XGEN(b.x)], 1u);
            asm volatile("s_waitcnt vmcnt(0)" ::: "memory");
        } else {
            XB_SPIN(xb_ld(&bar[XB_XGEN(b.x)]) == gen, bar);
            __builtin_amdgcn_fence(__ATOMIC_ACQUIRE, "agent");
            asm volatile("s_waitcnt vmcnt(0)" ::: "memory");
        }
    }
    __syncthreads();
}

struct Frame {
    LAS unsigned char* lds;
    int tid, lane, wave;
    DI void refresh() { int t = threadIdx.x; asm volatile("" : "+v"(t)); tid = t; lane = t & 63; wave = __builtin_amdgcn_readfirstlane(t >> 6); }
    int vcu, G;
    const float *x, *mem, *norm_mix_g, *w_in, *hg_lb, *hg_norm_g, *sc_conv_w, *mem_norm_g, *w_mem_kv, *w_branch, *w_out, *norm_ffn_g, *peer_w_q, *peer_sub_keys, *peer_u, *peer_v, *final_norm_g;
    float* out; unsigned char* ws;
};

DI void p0_transpose_item(const float* W, int K, int N, bf16* WT, LAS float* scr, int item, int lane) {
    const int nblk = N / 32, kb = item / nblk, nb = item % nblk, k0 = 64 * kb, n0 = 32 * nb;
#pragma unroll 8
    for (int i = 0; i < 32; ++i) { const int kk = 2 * i + (lane >> 5); scr[kk * 33 + (lane & 31)] = W[(size_t)(k0 + kk) * N + n0 + (lane & 31)]; }
    asm volatile("s_waitcnt lgkmcnt(0)" ::: "memory");
    const int c = lane & 7;
#pragma unroll
    for (int j = 0; j < 4; ++j) { const int n = (lane >> 3) + 8 * j; const LAS float* s = scr + (8 * c) * 33 + n;
        u32x4 o; o.x = pk2(s[0 * 33], s[1 * 33]); o.y = pk2(s[2 * 33], s[3 * 33]); o.z = pk2(s[4 * 33], s[5 * 33]); o.w = pk2(s[6 * 33], s[7 * 33]);
        *(u32x4*)(WT + (size_t)(n0 + n) * K + k0 + 8 * c) = o; }
    asm volatile("s_waitcnt lgkmcnt(0)" ::: "memory");
}
DI void rms_row_to_bf16(const float* xrow, const float* g, bf16* orow, int lane) {
    const f32x4* xr = (const f32x4*)xrow + lane; const f32x4* gr = (const f32x4*)g + lane;
    f32x4 v[4]; float s = 0.f;
#pragma unroll
    for (int j = 0; j < 4; ++j) { v[j] = xr[64 * j]; s += (v[j].x * v[j].x + v[j].y * v[j].y) + (v[j].z * v[j].z + v[j].w * v[j].w); }
    const float rstd = 1.0f / sqrtf(wave_sum(s) * (1.f / 1024.f) + EPS);
    unsigned long long* o8 = (unsigned long long*)orow + lane;
#pragma unroll
    for (int j = 0; j < 4; ++j) { const f32x4 gg = gr[64 * j]; const f32x4 y = v[j] * rstd * gg;
        o8[64 * j] = (unsigned long long)pk2(y.x, y.y) | ((unsigned long long)pk2(y.z, y.w) << 32); }
}
DI void p0_prologue(Frame& F) {
    F.refresh();
    LAS float* scr = (LAS float*)(F.lds + F.wave * 16384);
    const int gw = F.vcu * NWAVES + F.wave, NGW = F.G * NWAVES;
    unsigned char* ws = F.ws;
    constexpr int I_IN = (1024 / 64) * (PC / 32), I_KV = (1024 / 64) * (1024 / 32), I_BR = (512 / 64) * (1024 / 32), I_OUT = (1024 / 64) * (1024 / 32), I_Q = (1024 / 64) * (2048 / 32);
    constexpr int NITEMS = I_IN + I_KV + 3 * I_BR + I_OUT + I_Q;
    for (int it = gw; it < NITEMS; it += NGW) {
        int r = it;
        if (r < I_IN) { p0_transpose_item(F.w_in, 1024, PC, (bf16*)(ws + WS_WIN), scr, r, F.lane); continue; } r -= I_IN;
        if (r < I_KV) { p0_transpose_item(F.w_mem_kv, 1024, 1024, (bf16*)(ws + WS_WKV), scr, r, F.lane); continue; } r -= I_KV;
        if (r < 3 * I_BR) { const int n = r / I_BR; p0_transpose_item(F.w_branch + (size_t)n * 512 * 1024, 512, 1024, (bf16*)(ws + WS_WBR) + (size_t)n * 1024 * 512, scr, r % I_BR, F.lane); continue; } r -= 3 * I_BR;
        if (r < I_OUT) { p0_transpose_item(F.w_out, 1024, 1024, (bf16*)(ws + WS_WOUT), scr, r, F.lane); continue; } r -= I_OUT;
        p0_transpose_item(F.peer_w_q, 1024, 2048, (bf16*)(ws + WS_WQ), scr, r, F.lane);
    }
    const int gt = F.vcu * 512 + F.tid, NGT = F.G * 512;
    for (int it = gt; it < 8 * 256 * 32; it += NGT) {
        const int c8 = it & 31, row = (it >> 5) & 255, h = it >> 13, p = row >> 7, key = row & 127;
        u32x4 o = (u32x4){0u, 0u, 0u, 0u};
        if ((c8 >> 4) == p) { const float* s = F.peer_sub_keys + (((size_t)(h * 2 + p) * 128 + key) * 128 + (c8 & 15) * 8);
            const f32x4 a = *(const f32x4*)s, b = *(const f32x4*)(s + 4); o.x = pk2(a.x, a.y); o.y = pk2(a.z, a.w); o.z = pk2(b.x, b.y); o.w = pk2(b.z, b.w); }
        *(u32x4*)((bf16*)(ws + WS_KBD) + ((size_t)(h * 256 + row) * 256 + c8 * 8)) = o;
    }
    for (int it = gt; it < 1024; it += NGT) { const float a0 = F.hg_lb[it], a1 = F.hg_lb[1024 + it]; const float m = fmaxf(a0, a1); const float e0 = __expf(a0 - m), e1 = __expf(a1 - m);
        ((float*)(ws + WS_LB))[it] = e0 / (e0 + e1); }
    for (int m = gw; m < BATCH * NMEM; m += NGW) rms_row_to_bf16(F.mem + (size_t)m * 1024, F.mem_norm_g, (bf16*)(ws + WS_MN) + (size_t)m * 1024, F.lane);
    for (int m = gw; m < T_ALL; m += NGW) rms_row_to_bf16(F.x + (size_t)m * 1024, F.norm_mix_g, (bf16*)(ws + WS_XG) + (size_t)m * 1024, F.lane);
}

DI s16x4 tr16(const LAS unsigned char* p) { return __builtin_bit_cast(s16x4, __builtin_amdgcn_ds_read_tr16_b64_v4i16((LAS v4i16_t*)p)); }
DI bf16x8 cat8(s16x4 lo, s16x4 hi) { return __builtin_shufflevector(lo, hi, 0, 1, 2, 3, 4, 5, 6, 7); }
#define MFMA32(a, b, c) __builtin_amdgcn_mfma_f32_32x32x16_bf16((a), (b), (c), 0, 0, 0)
DI int crow(int reg, int h) { return (reg & 3) + 8 * (reg >> 2) + 4 * h; }
DI bf16x8 pack8(const f32x16& x, int s) {
    u32x4 p; p.x = cvtpk(x[8 * s], x[8 * s + 1]); p.y = cvtpk(x[8 * s + 2], x[8 * s + 3]); p.z = cvtpk(x[8 * s + 4], x[8 * s + 5]); p.w = cvtpk(x[8 * s + 6], x[8 * s + 7]);
    return __builtin_bit_cast(bf16x8, p);
}
constexpr int TS = 272;

DI void stage_tile(LAS unsigned char* tile, const bf16* src, int tid) {
#pragma unroll
    for (int i = 0; i < 2; ++i) { const int id = tid + 512 * i, c = id >> 4, ch = id & 15;
        *(LAS u32x4*)(tile + c * TS + ch * 16) = *(const u32x4*)(src + (size_t)c * PC + ch * 8); }
}
DI float touch_tile(const bf16* src, int i128) { return *(const float*)(src + (size_t)(i128 >> 1) * PC + (i128 & 1) * 64); }
DI void gate8(const LAS unsigned char* zt, int dp, int ts, f32x2 lb, f32x2 (&L)[8], f32x2 (&kk)[8], f32x2 (&lf)[8]) {
    f32x2 run = (f32x2){0.f, 0.f}; const f32x2 oml = 1.0f - lb;
#pragma unroll
    for (int i = 0; i < 8; ++i) { const unsigned w = *(const LAS unsigned*)(zt + (8 * ts + i) * TS + 4 * dp);
        const f32x2 sg = (f32x2){fast_sig(bflo(w)), fast_sig(bfhi(w))}; const f32x2 f = lb + oml * sg;
        lf[i] = (f32x2){__builtin_amdgcn_logf(f.x), __builtin_amdgcn_logf(f.y)}; kk[i] = oml * (1.0f - sg); run += lf[i]; L[i] = run; }
}
DI f32x2 exp2x2(f32x2 v) { return (f32x2){__builtin_amdgcn_exp2f(v.x), __builtin_amdgcn_exp2f(v.y)}; }
struct SliceSums { f32x2 offf, offb, glf, glb, greff, grefb; };
DI SliceSums slice_sums(const LAS float* tot, int dp, int ts) {
    SliceSums r; f32x2 tf[8], tb[8];
#pragma unroll
    for (int j = 0; j < 8; ++j) { tf[j] = *(const LAS f32x2*)(tot + j * 128 + 2 * dp); tb[j] = *(const LAS f32x2*)(tot + (8 + j) * 128 + 2 * dp); }
    r.offf = (f32x2){0.f, 0.f}; r.offb = (f32x2){0.f, 0.f};
#pragma unroll
    for (int j = 0; j < 8; ++j) { if (j < ts) r.offf += tf[j]; if (j > ts) r.offb += tb[j]; }
    r.greff = (tf[0] + tf[1]) + (tf[2] + tf[3]); r.glf = r.greff + ((tf[4] + tf[5]) + (tf[6] + tf[7]));
    r.grefb = (tb[4] + tb[5]) + (tb[6] + tb[7]); r.glb = r.grefb + ((tb[0] + tb[1]) + (tb[2] + tb[3]));
    return r;
}

DI void hgrn_a_item(Frame& F, int item, bool has_next) {
    F.refresh();
    constexpr int T_V = 0, T_KF = 17408, T_KB = 34816, TOT = 52224;
    LAS unsigned char* lds = F.lds;
    const int n = item & 31, h = (item >> 5) & 3, b = item >> 7;
    const bf16* proj = (const bf16*)(F.ws + WS_PROJ) + ((size_t)b * SEQ + n * CHUNK) * PC;
    const int tid = F.tid, dp = tid & 63, ts = F.wave;
    const float* lbp = (const float*)(F.ws + WS_LB);
    const f32x2 lbf = *(const f32x2*)(lbp + h * 128 + 2 * dp), lbb = *(const f32x2*)(lbp + 512 + h * 128 + 2 * dp);
    stage_tile(lds + T_V, proj + C_HI + h * 128, tid); stage_tile(lds + T_KF, proj + C_FF + h * 128, tid); stage_tile(lds + T_KB, proj + C_FB + h * 128, tid);
    float tch = 0.f;
    if (has_next) { const bf16* pn = proj + (size_t)CHUNK * PC + h * 128; const int i128 = tid & 127, wsel = tid >> 7; tch = touch_tile(pn + (wsel == 0 ? C_HI : wsel == 1 ? C_FF : C_FB), i128); }
    __syncthreads();
    f32x2 Lf[8], kf[8], lff[8], Lb[8], kb[8], lfb[8];
    gate8(lds + T_KF, dp, ts, lbf, Lf, kf, lff);
    gate8(lds + T_KB, dp, ts, lbb, Lb, kb, lfb);
    LAS float* tot = (LAS float*)(lds + TOT);
    *(LAS f32x2*)(tot + ts * 128 + 2 * dp) = Lf[7]; *(LAS f32x2*)(tot + (8 + ts) * 128 + 2 * dp) = Lb[7];
    asm volatile("" :: "v"(tch));
    __syncthreads();
    const SliceSums ss = slice_sums(tot, dp, ts);
    const f32x2 tbq = Lb[7];
#pragma unroll
    for (int i = 0; i < 8; ++i) { const int c = 8 * ts + i;
        const f32x2 G = ss.offf + Lf[i]; const f32x2 kd = kf[i] * exp2x2(ss.glf - G);
        const f32x2 Gb = ss.offb + (tbq - Lb[i] + lfb[i]); const f32x2 kdb = kb[i] * exp2x2(ss.glb - Gb);
        *(LAS unsigned*)(lds + T_KF + c * TS + 4 * dp) = cvtpk(kd.x, kd.y); *(LAS unsigned*)(lds + T_KB + c * TS + 4 * dp) = cvtpk(kdb.x, kdb.y); }
    if (ts == 0) { float* dec = (float*)(F.ws + WS_DEC) + (size_t)item * 256; *(f32x2*)(dec + 2 * dp) = exp2x2(ss.glf); *(f32x2*)(dec + 128 + 2 * dp) = exp2x2(ss.glb); }
    __syncthreads();
    const int w = F.wave, lane = F.lane, r = lane & 31, hh = lane >> 5, blk = (lane >> 4) & 1, q = (lane & 15) >> 2, p = lane & 3;
    const int dt = w >> 1, et0 = (w & 1) * 2;
#pragma unroll
    for (int dir = 0; dir < 2; ++dir) { const int TK = dir ? T_KB : T_KF;
#pragma unroll
        for (int e2 = 0; e2 < 2; ++e2) { const int et = et0 + e2; f32x16 acc;
#pragma unroll
            for (int i = 0; i < 16; ++i) acc[i] = 0.f;
#pragma unroll
            for (int ks = 0; ks < 4; ++ks) {
                const LAS unsigned char* ap = lds + TK + (16 * ks + 8 * hh + q) * TS + (32 * dt + 16 * blk + 4 * p) * 2;
                const LAS unsigned char* bp = lds + T_V + (16 * ks + 8 * hh + q) * TS + (32 * et + 16 * blk + 4 * p) * 2;
                const bf16x8 a = cat8(tr16(ap), tr16(ap + 4 * TS)), bq = cat8(tr16(bp), tr16(bp + 4 * TS));
                acc = MFMA32(a, bq, acc); }
            bf16* dsb = (bf16*)(F.ws + WS_DS) + ((size_t)(item * 2 + dir) * 128 + 32 * et + r) * 128 + 32 * dt + 4 * hh;
#pragma unroll
            for (int g4 = 0; g4 < 4; ++g4) { u32x2 wv; wv.x = cvtpk(acc[4 * g4], acc[4 * g4 + 1]); wv.y = cvtpk(acc[4 * g4 + 2], acc[4 * g4 + 3]); *(u32x2*)(dsb + 8 * g4) = wv; } } }
    __syncthreads();
}

DI void hgrn_scan(Frame& F) {
    F.refresh();
    const bf16* dS = (const bf16*)(F.ws + WS_DS); bf16* Sst = (bf16*)((unsigned char*)F.out + OUT_SST); const float* dec = (const float*)(F.ws + WS_DEC);
    const int gt = F.vcu * 512 + F.tid, NGT = F.G * 512;
    for (int id = gt; id < BG * 4 * 2 * 128 * 32; id += NGT) {
        const int d4 = id & 31, e = (id >> 5) & 127, dir = (id >> 12) & 1, bh = id >> 13;
        f32x4 S = (f32x4){0.f, 0.f, 0.f, 0.f};
#pragma unroll 4
        for (int s = 0; s < 32; ++s) { const int n = dir ? 31 - s : s, item = bh * 32 + n;
            const size_t off = ((size_t)(item * 2 + dir) * 128 + e) * 128 + d4 * 4;
            u32x2 o; o.x = cvtpk(S.x, S.y); o.y = cvtpk(S.z, S.w); *(u32x2*)(Sst + off) = o;
            const f32x4 dc = *(const f32x4*)(dec + (size_t)(item * 2 + dir) * 128 + d4 * 4);
            const u32x2 wv = *(const u32x2*)(dS + off);
            S.x = dc.x * S.x + bflo(wv.x); S.y = dc.y * S.y + bfhi(wv.x); S.z = dc.z * S.z + bflo(wv.y); S.w = dc.w * S.w + bfhi(wv.y); }
    }
}

DI void hgrn_c_item(Frame& F, int item, bool has_next) {
    F.refresh();
    constexpr int T_QRF = 0, T_KRF = 17408, T_QGF = 34816, T_QRB = 52224, T_KRB = 69632, T_QGB = 87040, T_V = 104448, TOT = 121856, O_OFF = 0, OS = 132;
    LAS unsigned char* lds = F.lds;
    const int n = item & 31, h = (item >> 5) & 3, b = item >> 7;
    const size_t row0 = (size_t)b * SEQ + n * CHUNK;
    const bf16* proj = (const bf16*)(F.ws + WS_PROJ) + row0 * PC;
    const int tid = F.tid, dp = tid & 63, ts = F.wave;
    const float* lbp = (const float*)(F.ws + WS_LB);
    const f32x2 lbf = *(const f32x2*)(lbp + h * 128 + 2 * dp), lbb = *(const f32x2*)(lbp + 512 + h * 128 + 2 * dp);
    stage_tile(lds + T_V, proj + C_HI + h * 128, tid); stage_tile(lds + T_KRF, proj + C_FF + h * 128, tid); stage_tile(lds + T_KRB, proj + C_FB + h * 128, tid); stage_tile(lds + T_QRF, proj + C_HQ + h * 128, tid);
    float tch = 0.f, tch2 = 0.f;
    if (has_next) { const bf16* pn = proj + (size_t)CHUNK * PC + h * 128; const int i128 = tid & 127, wsel = tid >> 7; tch = touch_tile(pn + (wsel == 0 ? C_HI : wsel == 1 ? C_FF : wsel == 2 ? C_FB : C_HQ), i128);
        tch2 = *(const float*)((const unsigned char*)F.out + OUT_SST + (size_t)(item + 1) * 65536 + (size_t)tid * 128); }
    __syncthreads();
    f32x2 qv[8];
#pragma unroll
    for (int i = 0; i < 8; ++i) { const unsigned w = *(const LAS unsigned*)(lds + T_QRF + (8 * ts + i) * TS + 4 * dp); const float z0 = bflo(w), z1 = bfhi(w); qv[i] = (f32x2){z0 * fast_sig(z0), z1 * fast_sig(z1)}; }
    f32x2 Lf[8], kf[8], lff[8], Lb[8], kb[8], lfb[8];
    gate8(lds + T_KRF, dp, ts, lbf, Lf, kf, lff);
    gate8(lds + T_KRB, dp, ts, lbb, Lb, kb, lfb);
    LAS float* tot = (LAS float*)(lds + TOT);
    *(LAS f32x2*)(tot + ts * 128 + 2 * dp) = Lf[7]; *(LAS f32x2*)(tot + (8 + ts) * 128 + 2 * dp) = Lb[7];
    asm volatile("" :: "v"(tch), "v"(tch2));
    __syncthreads();
    {
        const SliceSums ss = slice_sums(tot, dp, ts);
        const f32x2 tbq = Lb[7];
#pragma unroll
        for (int i = 0; i < 8; ++i) { const int c = 8 * ts + i; const int o = c * TS + 4 * dp;
            const f32x2 G = ss.offf + Lf[i]; const f32x2 x = G - ss.greff;
            const f32x2 qr = qv[i] * exp2x2(x), kr = kf[i] * exp2x2(-x), qg = qv[i] * exp2x2(G);
            *(LAS unsigned*)(lds + T_QRF + o) = cvtpk(qr.x, qr.y); *(LAS unsigned*)(lds + T_KRF + o) = cvtpk(kr.x, kr.y); *(LAS unsigned*)(lds + T_QGF + o) = cvtpk(qg.x, qg.y);
            const f32x2 Gb = ss.offb + (tbq - Lb[i] + lfb[i]); const f32x2 xb = Gb - ss.grefb;
            const f32x2 qrb = qv[i] * exp2x2(xb), krb = kb[i] * exp2x2(-xb), qgb = qv[i] * exp2x2(Gb);
            *(LAS unsigned*)(lds + T_QRB + o) = cvtpk(qrb.x, qrb.y); *(LAS unsigned*)(lds + T_KRB + o) = cvtpk(krb.x, krb.y); *(LAS unsigned*)(lds + T_QGB + o) = cvtpk(qgb.x, qgb.y); }
    }
    __syncthreads();
    const int w = F.wave, lane = F.lane, r = lane & 31, hh = lane >> 5, blk = (lane >> 4) & 1, q = (lane & 15) >> 2, p = lane & 3;
    const int ct = w >> 2, et = w & 3;
    const bf16* Sst = (const bf16*)((const unsigned char*)F.out + OUT_SST);
    f32x16 o;
#pragma unroll
    for (int i = 0; i < 16; ++i) o[i] = 0.f;
#pragma unroll
    for (int dir = 0; dir < 2; ++dir) { const int TQR = dir ? T_QRB : T_QRF, TKR = dir ? T_KRB : T_KRF, TQG = dir ? T_QGB : T_QGF;
#pragma unroll
        for (int st = 0; st < 2; ++st) {
            if (dir == 0 ? (st > ct) : (st < ct)) continue;
            f32x16 X;
#pragma unroll
            for (int i = 0; i < 16; ++i) X[i] = 0.f;
#pragma unroll
            for (int ks = 0; ks < 8; ++ks) { const bf16x8 a = *(const LAS bf16x8*)(lds + TKR + (32 * st + r) * TS + (16 * ks + 8 * hh) * 2), bq = *(const LAS bf16x8*)(lds + TQR + (32 * ct + r) * TS + (16 * ks + 8 * hh) * 2);
                X = MFMA32(a, bq, X); }
            const int cc = 32 * ct + r;
#pragma unroll
            for (int i = 0; i < 16; ++i) { const int s = 32 * st + crow(i, hh); const bool keep = dir == 0 ? (s <= cc) : (s >= cc); X[i] = keep ? X[i] : 0.f; }
#pragma unroll
            for (int s2 = 0; s2 < 2; ++s2) { const bf16x8 xs = pack8(X, s2);
                const LAS unsigned char* vp = lds + T_V + (32 * st + 16 * s2 + 4 * hh + q) * TS + (32 * et + 16 * blk + 4 * p) * 2;
                const bf16x8 pb = cat8(tr16(vp), tr16(vp + 8 * TS));
                o = MFMA32(xs, pb, o); }
        }
        const bf16* sp = Sst + ((size_t)(item * 2 + dir) * 128 + 32 * et + r) * 128 + 8 * hh;
#pragma unroll
        for (int ks = 0; ks < 8; ++ks) { const bf16x8 a = *(const LAS bf16x8*)(lds + TQG + (32 * ct + r) * TS + (16 * ks + 8 * hh) * 2); const bf16x8 bq = *(const bf16x8*)(sp + 16 * ks);
            o = MFMA32(a, bq, o); }
    }
    unsigned hw[8];
#pragma unroll
    for (int k = 0; k < 8; ++k) hw[k] = *(const unsigned*)(proj + (size_t)(8 * w + k) * PC + C_HG + h * 128 + 2 * lane);
    __syncthreads();
    LAS float* O = (LAS float*)(lds + O_OFF);
#pragma unroll
    for (int i = 0; i < 16; ++i) O[(32 * ct + crow(i, hh)) * OS + 32 * et + r] = o[i];
    __syncthreads();
    const f32x2 gn = *(const f32x2*)(F.hg_norm_g + h * 128 + 2 * lane);
    bf16* yhg = (bf16*)(F.ws + WS_YHG);
    const int a16 = (lane ^ 16) << 2, a32 = (lane ^ 32) << 2;
#pragma unroll
    for (int k = 0; k < 8; ++k) { const int c = 8 * w + k; const f32x2 v = *(const LAS f32x2*)(O + c * OS + 2 * lane);
        float ss = row_sum16(v.x * v.x + v.y * v.y); ss += bperm_f(a16, ss); ss += bperm_f(a32, ss);
        const float rstd = __builtin_amdgcn_rsqf(ss * (1.0f / 128.0f) + EPS);
        const float z0 = bflo(hw[k]), z1 = bfhi(hw[k]);
        const float y0 = v.x * rstd * gn.x * (z0 * fast_sig(z0)), y1 = v.y * rstd * gn.y * (z1 * fast_sig(z1));
        *(unsigned*)(yhg + (row0 + c) * 512 + h * 128 + 2 * lane) = cvtpk(y0, y1); }
    __syncthreads();
}

DI void attn_item(Frame& F, int g, int item) {
    F.refresh();
    constexpr int KS = 272, VS = 528, K_OFF = 0, V_OFF = 69632;
    LAS unsigned char* lds = F.lds;
    const int qb = item & 7, h = (item >> 3) & 3, b = item >> 5, bglob = g * BG + b;
    const bf16* Km = (const bf16*)(F.ws + WS_KMEM) + (size_t)bglob * 256 * 512 + h * 128;
    const bf16* VT = (const bf16*)(F.ws + WS_VT) + (size_t)(h * 128) * 4096 + bglob * 256;
    const int tid = F.tid;
#pragma unroll
    for (int i = 0; i < 8; ++i) { const int id = tid + 512 * i, key = id >> 4, ch = id & 15;
        *(LAS u32x4*)(lds + K_OFF + key * KS + ch * 16) = *(const u32x4*)(Km + (size_t)key * 512 + ch * 8); }
#pragma unroll
    for (int i = 0; i < 8; ++i) { const int id = tid + 512 * i, e = id >> 5, ch = id & 31;
        *(LAS u32x4*)(lds + V_OFF + e * VS + ch * 16) = *(const u32x4*)(VT + (size_t)e * 4096 + ch * 8); }
    __syncthreads();
    const int w = F.wave, lane = F.lane, r = lane & 31, hh = lane >> 5;
    const size_t qrow0 = (size_t)b * SEQ + qb * 256 + w * 32;
    const bf16* proj = (const bf16*)(F.ws + WS_PROJ);
    bf16x8 qf[8];
#pragma unroll
    for (int ks = 0; ks < 8; ++ks) qf[ks] = *(const bf16x8*)(proj + (qrow0 + r) * PC + C_MQ + h * 128 + 16 * ks + 8 * hh);
    const float scale = 0.08838834764831845f;
    float m_run = -INFINITY, l_run = 0.f;
#pragma unroll 1
    for (int kt = 0; kt < 8; ++kt) {
        f32x16 X;
#pragma unroll
        for (int i = 0; i < 16; ++i) X[i] = 0.f;
#pragma unroll
        for (int ks = 0; ks < 8; ++ks) { const bf16x8 a = *(const LAS bf16x8*)(lds + K_OFF + (32 * kt + r) * KS + (16 * ks + 8 * hh) * 2); X = MFMA32(a, qf[ks], X); }
        float tm = X[0];
#pragma unroll
        for (int i = 1; i < 16; ++i) tm = fmaxf(tm, X[i]);
        tm *= scale;
        const float mn = fmaxf(m_run, tm); float ls = 0.f;
#pragma unroll
        for (int i = 0; i < 16; ++i) ls += __expf(X[i] * scale - mn);
        l_run = l_run * __expf(m_run - mn) + ls; m_run = mn;
    }
    { const float mo = __shfl_xor(m_run, 32), lo = __shfl_xor(l_run, 32); const float m = fmaxf(m_run, mo);
      l_run = l_run * __expf(m_run - m) + lo * __expf(mo - m); m_run = m; }
    const float inv_l = 1.0f / l_run;
    f32x16 O[4];
#pragma unroll
    for (int e = 0; e < 4; ++e)
#pragma unroll
        for (int i = 0; i < 16; ++i) O[e][i] = 0.f;
#pragma unroll 1
    for (int kt = 0; kt < 8; ++kt) {
        f32x16 X;
#pragma unroll
        for (int i = 0; i < 16; ++i) X[i] = 0.f;
#pragma unroll
        for (int ks = 0; ks < 8; ++ks) { const bf16x8 a = *(const LAS bf16x8*)(lds + K_OFF + (32 * kt + r) * KS + (16 * ks + 8 * hh) * 2); X = MFMA32(a, qf[ks], X); }
#pragma unroll
        for (int i = 0; i < 16; ++i) X[i] = __expf(X[i] * scale - m_run) * inv_l;
#pragma unroll
        for (int s2 = 0; s2 < 2; ++s2) { const bf16x8 xs = pack8(X, s2);
#pragma unroll
            for (int e = 0; e < 4; ++e) { const LAS unsigned char* vp = lds + V_OFF + (32 * e + r) * VS + (32 * kt + 16 * s2 + 4 * hh) * 2;
                const bf16x8 pb = cat8(*(const LAS s16x4*)vp, *(const LAS s16x4*)(vp + 16));
                O[e] = MFMA32(xs, pb, O[e]); } }
    }
    bf16* ymx = (bf16*)(F.ws + WS_YMX);
#pragma unroll
    for (int e = 0; e < 4; ++e)
#pragma unroll
        for (int i = 0; i < 16; ++i) ymx[(qrow0 + crow(i, hh)) * 512 + h * 128 + 32 * e + r] = (bf16)f2bf(O[e][i]);
    __syncthreads();
}

DI void conv_phase(Frame& F) {
    F.refresh();
    const bf16* proj = (const bf16*)(F.ws + WS_PROJ); bf16* ysc = (bf16*)(F.ws + WS_YSC); const float* cw = F.sc_conv_w;
    const int gt = F.vcu * 512 + F.tid, NGT = F.G * 512;
    for (int id = gt; id < TG * 64; id += NGT) {
        const int c8 = id & 63, t = id >> 6, ts = t & (SEQ - 1);
        const bf16* pr = proj + (size_t)t * PC + c8 * 8;
        const u32x4 z4 = (u32x4){0u, 0u, 0u, 0u};
        const u32x4 sb = *(const u32x4*)(pr + C_SB), c1 = *(const u32x4*)(pr + C_SC), h1 = *(const u32x4*)(pr + C_SH);
        const u32x4 c0 = ts > 0 ? *(const u32x4*)(pr - PC + C_SC) : z4, h0 = ts > 0 ? *(const u32x4*)(pr - PC + C_SH) : z4;
        const u32x4 c2 = ts < SEQ - 1 ? *(const u32x4*)(pr + PC + C_SC) : z4, h2 = ts < SEQ - 1 ? *(const u32x4*)(pr + PC + C_SH) : z4;
        const f32x4 wa0 = *(const f32x4*)(cw + c8 * 8), wa1 = *(const f32x4*)(cw + c8 * 8 + 4), wb0 = *(const f32x4*)(cw + 512 + c8 * 8), wb1 = *(const f32x4*)(cw + 512 + c8 * 8 + 4),
                    wc0 = *(const f32x4*)(cw + 1024 + c8 * 8), wc1 = *(const f32x4*)(cw + 1024 + c8 * 8 + 4);
        float y[8];
#pragma unroll
        for (int k = 0; k < 4; ++k) {
            const float w0l = k < 2 ? wa0[2 * k] : wa1[2 * k - 4], w0h = k < 2 ? wa0[2 * k + 1] : wa1[2 * k - 3];
            const float w1l = k < 2 ? wb0[2 * k] : wb1[2 * k - 4], w1h = k < 2 ? wb0[2 * k + 1] : wb1[2 * k - 3];
            const float w2l = k < 2 ? wc0[2 * k] : wc1[2 * k - 4], w2h = k < 2 ? wc0[2 * k + 1] : wc1[2 * k - 3];
            y[2 * k]     = bflo(sb[k]) * (w0l * (bflo(c0[k]) * bflo(h0[k])) + w1l * (bflo(c1[k]) * bflo(h1[k])) + w2l * (bflo(c2[k]) * bflo(h2[k])));
            y[2 * k + 1] = bfhi(sb[k]) * (w0h * (bfhi(c0[k]) * bfhi(h0[k])) + w1h * (bfhi(c1[k]) * bfhi(h1[k])) + w2h * (bfhi(c2[k]) * bfhi(h2[k]))); }
        u32x4 o; o.x = cvtpk(y[0], y[1]); o.y = cvtpk(y[2], y[3]); o.z = cvtpk(y[4], y[5]); o.w = cvtpk(y[6], y[7]);
        *(u32x4*)(ysc + (size_t)t * 512 + c8 * 8) = o;
    }
}

DI unsigned ord_key(float v, int idx) { unsigned u = __builtin_bit_cast(unsigned, v); u ^= (u >> 31) ? 0xFFFFFFFFu : 0x80000000u; return (u & 0xFFFFFF80u) | (unsigned)(127 - idx); }
DI float key_val(unsigned k) { unsigned u = k & 0xFFFFFF80u; u = (u & 0x80000000u) ? (u ^ 0x80000000u) : ~u; return __builtin_bit_cast(float, u); }
DI float dot2bf(unsigned a, unsigned b, float c) { return __builtin_amdgcn_fdot2_f32_bf16(__builtin_bit_cast(bf16x2_t, a), __builtin_bit_cast(bf16x2_t, b), c, false); }
DI float dot8(const u32x4& a, const u32x4& b, float c) { c = dot2bf(a.x, b.x, c); c = dot2bf(a.y, b.y, c); c = dot2bf(a.z, b.z, c); return dot2bf(a.w, b.w, c); }
__host__ __device__ constexpr int cand_off(int i) { return i == 0 ? 0 : i == 1 ? 16 : i == 2 ? 24 : i == 3 ? 29 : i == 4 ? 33 : i == 5 ? 36 : i == 6 ? 38 : i == 7 ? 40 : 34 + i; }
__host__ __device__ constexpr int cand_i(int c) { return c < 16 ? 0 : c < 24 ? 1 : c < 29 ? 2 : c < 33 ? 3 : c < 36 ? 4 : c < 38 ? 5 : c < 40 ? 6 : c < 42 ? 7 : c - 34; }
__host__ __device__ constexpr int cand_pos(int c) { return cand_i(c) * 16 + (c - cand_off(cand_i(c))); }

#define PEER_CE(i, j) do { const unsigned hi_ = max(k[i], k[j]), lo_ = min(k[i], k[j]); k[i] = hi_; k[j] = lo_; } while (0)
DI void peer_topk_first(const float* srow, LAS float* ssc, LAS unsigned char* six, int lane) {
    const int gq = lane >> 4, li = lane & 15;
    const float* sl = srow + (gq >> 1) * 256 + (gq & 1) * 128 + li * 8;
    f32x4 nva = *(const f32x4*)sl, nvb = *(const f32x4*)(sl + 4);
#pragma unroll 1
    for (int hp = 0; hp < 4; ++hp) {
        const f32x4 va = nva, vb = nvb;
        if (hp < 3) { nva = *(const f32x4*)(sl + 512 * (hp + 1)); nvb = *(const f32x4*)(sl + 512 * (hp + 1) + 4); }
        unsigned k[8];
        k[0] = ord_key(va.x, li * 8 + 0); k[1] = ord_key(va.y, li * 8 + 1); k[2] = ord_key(va.z, li * 8 + 2); k[3] = ord_key(va.w, li * 8 + 3);
        k[4] = ord_key(vb.x, li * 8 + 4); k[5] = ord_key(vb.y, li * 8 + 5); k[6] = ord_key(vb.z, li * 8 + 6); k[7] = ord_key(vb.w, li * 8 + 7);
        PEER_CE(0, 1); PEER_CE(2, 3); PEER_CE(4, 5); PEER_CE(6, 7); PEER_CE(0, 2); PEER_CE(1, 3); PEER_CE(4, 6); PEER_CE(5, 7); PEER_CE(1, 2); PEER_CE(5, 6);
        PEER_CE(0, 4); PEER_CE(1, 5); PEER_CE(2, 6); PEER_CE(3, 7); PEER_CE(2, 4); PEER_CE(3, 5); PEER_CE(1, 2); PEER_CE(3, 4); PEER_CE(5, 6);
        unsigned mine = 0u;
#pragma unroll
        for (int rd = 0; rd < 16; ++rd) {
            const unsigned m = row_max16(k[0]);
            mine = (li == rd) ? m : mine;
            const bool wn = (k[0] == m);
            k[0] = wn ? k[1] : k[0]; k[1] = wn ? k[2] : k[1]; k[2] = wn ? k[3] : k[2]; k[3] = wn ? k[4] : k[3];
            k[4] = wn ? k[5] : k[4]; k[5] = wn ? k[6] : k[5]; k[6] = wn ? k[7] : k[6]; k[7] = wn ? 0u : k[7];
        }
        const int o = ((2 * hp + (gq >> 1)) * 2 + (gq & 1)) * 16 + li;
        ssc[o] = key_val(mine); six[o] = (unsigned char)(127u - (mine & 127u));
    }
}
DI void peer_topk_second(const LAS float* ssc, const LAS unsigned char* six, LAS int* widx, LAS float* wgate, int lane, int emask, int hd_lo, int hd_hi) {
    const int grp = lane >> 4, li = lane & 15;
    const int ri = li <= 1 ? 0 : li <= 8 ? li - 1 : 8, j0 = li == 1 ? 8 : 0;
    const int L = li <= 2 ? 8 : li == 3 ? 5 : li == 4 ? 4 : li == 5 ? 3 : li <= 8 ? 2 : li == 9 ? 8 : 0;
    const bool tail = li >= 9;
    const unsigned tag0 = tail ? 255u - 128u : 255u - (unsigned)(16 * ri + j0), tstep = tail ? 16u : 1u;
#pragma unroll 1
    for (int hd0 = hd_lo; hd0 < hd_hi; hd0 += 4) {
        const int hd = hd0 + grp;
        const LAS float* A = ssc + (hd * 2) * 16; const LAS float* B = A + 16;
        const LAS float* xp = tail ? A + 8 : B + j0;
        const float y = tail ? B[0] : A[ri];
        const f32x4 x0 = *(const LAS f32x4*)xp, x1 = *(const LAS f32x4*)(xp + 4);
        unsigned k[8];
#pragma unroll
        for (int jj = 0; jj < 8; ++jj) { const float v = (jj < 4 ? x0[jj & 3] : x1[jj & 3]) + y; unsigned u = __builtin_bit_cast(unsigned, v); u ^= (u >> 31) ? 0xFFFFFFFFu : 0x80000000u;
            k[jj] = jj < L ? ((u & 0xFFFFFF00u) | (tag0 - (unsigned)jj * tstep)) : 0u; }
        unsigned mine = 0u;
#pragma unroll
        for (int rd = 0; rd < 16; ++rd) {
            const unsigned m = row_max16(k[0]);
            mine = (li == rd) ? m : mine;
            const bool wn = (k[0] == m);
            k[0] = wn ? k[1] : k[0]; k[1] = wn ? k[2] : k[1]; k[2] = wn ? k[3] : k[2]; k[3] = wn ? k[4] : k[3];
            k[4] = wn ? k[5] : k[4]; k[5] = wn ? k[6] : k[5]; k[6] = wn ? k[7] : k[6]; k[7] = wn ? 0u : k[7];
        }
        const int tg_ = 255 - (int)(mine & 255u), ci = tg_ >> 4, cj = tg_ & 15;
        const float cs = A[ci] + B[cj];
        const int ia = (int)six[(hd * 2) * 16 + ci], ib = (int)six[(hd * 2 + 1) * 16 + cj];
        float mx = cs; mx = fmaxf(mx, dpp_f<0xB1>(mx)); mx = fmaxf(mx, dpp_f<0x4E>(mx)); mx = fmaxf(mx, dpp_f<0x141>(mx)); mx = fmaxf(mx, dpp_f<0x140>(mx));
        const float ev = __builtin_amdgcn_exp2f((cs - mx) * 1.4426950408889634f);
        const float sum = row_sum16(ev);
        if (hd < hd_hi) { widx[hd * 16 + li] = ((ia * 128 + ib) & emask) * 512  ; wgate[hd * 16 + li] = ev * __builtin_amdgcn_rcpf(sum); }
    }
}
#undef PEER_CE

constexpr float PEER_QSTEP = 0.35f;
constexpr float PEER_U_SCALE = 32.0f / PEER_QSTEP;
constexpr float PEER_UF4_SCALE = 64.0f;
constexpr float PEER_H4_SCALE = 2.0f;
#ifndef PEER_VACT
#define PEER_VACT 8
#endif
#ifndef PROBE_VMASK
#define PROBE_VMASK 0xFFFFFFFFu
#endif
constexpr int PEER_REC_WORDS = 160;
constexpr int PEER_VW_BYTES = 16896;
static_assert(8 * PEER_VW_BYTES <= MISC_OFF && PEER_VW_BYTES % 256 == 0, "PEER LDS map");
DI void glds16s_x4(const void* sbase, unsigned v0, unsigned v1, unsigned v2, unsigned v3, unsigned lds_dst) { unsigned keep;
    asm volatile("s_mov_b32 %0, m0\n\ts_mov_b32 m0, %6\n\ts_nop 0\n\tglobal_load_lds_dwordx4 %1, %5\n\tglobal_load_lds_dwordx4 %2, %5 offset:1024\n\tglobal_load_lds_dwordx4 %3, %5 offset:2048\n\tglobal_load_lds_dwordx4 %4, %5 offset:3072\n\ts_mov_b32 m0, %0"
                 : "=&s"(keep) : "v"(v0), "v"(v1), "v"(v2), "v"(v3), "s"(sbase), "s"(lds_dst) : "memory"); }
typedef int i32x2 __attribute__((ext_vector_type(2)));
typedef int i32x4 __attribute__((ext_vector_type(4)));
typedef int i32x8 __attribute__((ext_vector_type(8)));
#define PEER_LOADIDX(tile) do { const LAS int* ip_ = sidx + 16 * (tile) + (lane >> 5); _Pragma("unroll") for (int j_ = 0; j_ < 8; ++j_) nx[j_] = (unsigned)ip_[2 * j_]; } while (0)

constexpr int PEER_URT = 4;
constexpr int PEER_USLOT_OFF = 0, PEER_UFLAG_OFF = 8192, PEER_ULIST_OFF = 8256, PEER_UHROW_OFF = 13376, PEER_URING_OFF = 15616, PEER_URING_BYTES = PEER_URT * 8192;
static_assert(PEER_ULIST_OFF + 4 * 1280 <= PEER_UHROW_OFF && PEER_UHROW_OFF + 4 * 512 <= PEER_URING_OFF && PEER_URING_OFF % 256 == 0 && PEER_URING_OFF + 4 * PEER_URING_BYTES <= MISC_OFF, "PEER U-phase LDS map");
DI void peer_u_phase(Frame& F, int tg) {
    F.refresh();
    __syncthreads();
    const int lane = F.lane, wv = F.wave, grp = lane >> 4;
    volatile LAS unsigned* flags = (volatile LAS unsigned*)(F.lds + PEER_UFLAG_OFF);
    if (F.tid < 8) flags[F.tid] = 0u;
    __syncthreads();
    const int pr = wv & 3, TSTEP = 4 * F.G;
    if (wv < 4) {
        LAS float* ssc = (LAS float*)(F.lds + PEER_ULIST_OFF + pr * 1280); LAS unsigned char* six = F.lds + PEER_ULIST_OFF + pr * 1280 + 1024;
        int k = 0;
#pragma unroll 1
        for (int tl = F.vcu + F.G * pr; tl < TG; tl += TSTEP, ++k) {
            const float* srow = (const float*)(F.ws + WS_S) + (size_t)tl * 2048;
            float tch0 = 0.f;
            if (tl + TSTEP < TG) tch0 = (srow + (size_t)TSTEP * 2048)[lane * 32];
            peer_topk_first(srow, ssc, six, lane);
            const int slot = 2 * pr + (k & 1);
            while (flags[slot] != 0u) __builtin_amdgcn_s_sleep(2);
            asm volatile("" ::: "memory");
            peer_topk_second(ssc, six, (LAS int*)(F.lds + PEER_USLOT_OFF + slot * 1024), (LAS float*)(F.lds + PEER_USLOT_OFF + slot * 1024 + 512), lane, 16383, 0, 8);
            asm volatile("s_waitcnt lgkmcnt(0)" :: "v"(tch0) : "memory");
            if (lane == 0) flags[slot] = 1u;
        }
    } else {
        LAS unsigned char* hrow = F.lds + PEER_UHROW_OFF + pr * 512;
        LAS unsigned char* ring = F.lds + PEER_URING_OFF + pr * PEER_URING_BYTES; const unsigned ringb = (unsigned)(uintptr_t)ring;
        const unsigned char* Ub = F.ws + WS_U;
        unsigned usw[4];
#pragma unroll
        for (int q = 0; q < 4; ++q) usw[q] = 16u * (unsigned)((lane & 31) ^ (2 * q + (lane >> 5))) + (4096u - 1024u * q);
        const LAS unsigned char* uadr[4];
#pragma unroll
        for (int j = 0; j < 4; ++j) uadr[j] = ring + (lane & 15) * 512 + 64 * (j ^ ((lane & 15) >> 2)) + 16 * (grp ^ (lane & 3));
#define PEER_ISSUE8U(tile) do { const unsigned rs_ = (unsigned)__builtin_amdgcn_readfirstlane((int)(ringb + (unsigned)((tile) % PEER_URT) * 8192u)); \
            glds16s_x4(Ub - 4096, nx[0] + usw[0], nx[1] + usw[1], nx[2] + usw[2], nx[3] + usw[3], rs_); \
            glds16s_x4(Ub - 4096, nx[4] + (usw[0] ^ 128u), nx[5] + (usw[1] ^ 128u), nx[6] + (usw[2] ^ 128u), nx[7] + (usw[3] ^ 128u), rs_ + 4096u); } while (0)
        float nssp = 0.f; u32x4 nw0 = {0u, 0u, 0u, 0u}, nw1 = {0u, 0u, 0u, 0u};
#define PEER_ALOAD(tl_) do { const size_t t_ = (size_t)tg * TG + (tl_); nssp = ((const float*)(F.ws + WS_SSP) + t_ * 16)[lane & 15]; \
            const bf16* xr_ = (const bf16*)(F.ws + WS_XG) + t_ * 1024 + 16 * lane; nw0 = *(const u32x4*)xr_; nw1 = *(const u32x4*)(xr_ + 8); } while (0)
        const int tl0 = F.vcu + F.G * pr;
        if (tl0 < TG) PEER_ALOAD(tl0);
        int k = 0;
#pragma unroll 1
        for (int tl = tl0; tl < TG; tl += TSTEP, ++k) {
            const size_t t = (size_t)tg * TG + tl;
            const float hs = __builtin_amdgcn_rsqf(row_sum16(nssp) * (1.0f / 1024.0f) + EPS) * PEER_H4_SCALE;
            { const u32x4 w0 = nw0, w1 = nw1; u32x2 hq;
              hq.x = __builtin_amdgcn_cvt_scalef32_pk_fp4_f32(0u, bflo(w0[0]) * hs, bfhi(w0[0]) * hs, 1.0f, 0); hq.x = __builtin_amdgcn_cvt_scalef32_pk_fp4_f32(hq.x, bflo(w0[1]) * hs, bfhi(w0[1]) * hs, 1.0f, 1);
              hq.x = __builtin_amdgcn_cvt_scalef32_pk_fp4_f32(hq.x, bflo(w0[2]) * hs, bfhi(w0[2]) * hs, 1.0f, 2); hq.x = __builtin_amdgcn_cvt_scalef32_pk_fp4_f32(hq.x, bflo(w0[3]) * hs, bfhi(w0[3]) * hs, 1.0f, 3);
              hq.y = __builtin_amdgcn_cvt_scalef32_pk_fp4_f32(0u, bflo(w1[0]) * hs, bfhi(w1[0]) * hs, 1.0f, 0); hq.y = __builtin_amdgcn_cvt_scalef32_pk_fp4_f32(hq.y, bflo(w1[1]) * hs, bfhi(w1[1]) * hs, 1.0f, 1);
              hq.y = __builtin_amdgcn_cvt_scalef32_pk_fp4_f32(hq.y, bflo(w1[2]) * hs, bfhi(w1[2]) * hs, 1.0f, 2); hq.y = __builtin_amdgcn_cvt_scalef32_pk_fp4_f32(hq.y, bflo(w1[3]) * hs, bfhi(w1[3]) * hs, 1.0f, 3);
              *(LAS u32x2*)(hrow + 8 * lane) = hq; }
            i32x4 hA[8];
#pragma unroll
            for (int ks = 0; ks < 8; ++ks) hA[ks] = *(const LAS i32x4*)(hrow + 64 * ks + 16 * grp);
            if (tl + TSTEP < TG) PEER_ALOAD(tl + TSTEP);
            const int slot = 2 * pr + (k & 1);
            const LAS int* sidx = (const LAS int*)(F.lds + PEER_USLOT_OFF + slot * 1024); const LAS float* sgate = (const LAS float*)(F.lds + PEER_USLOT_OFF + slot * 1024 + 512);
            while (flags[slot] != 1u) __builtin_amdgcn_s_sleep(2);
            asm volatile("" ::: "memory");
            unsigned nx[8];
#pragma unroll
            for (int tt = 0; tt < PEER_URT; ++tt) { PEER_LOADIDX(tt); PEER_ISSUE8U(tt); }
            PEER_LOADIDX(PEER_URT);
            float dotA = 0.f, dotB = 0.f;
#pragma unroll 1
            for (int tt = 0; tt < 8; ++tt) {
                const int rp = (tt % PEER_URT) * 8192, left = 7 - tt < PEER_URT - 1 ? 7 - tt : PEER_URT - 1;
                if (left >= 3) asm volatile("s_waitcnt vmcnt(24)" ::: "memory"); else if (left == 2) asm volatile("s_waitcnt vmcnt(16)" ::: "memory"); else if (left == 1) asm volatile("s_waitcnt vmcnt(8)" ::: "memory"); else asm volatile("s_waitcnt vmcnt(0)" ::: "memory");
                f32x4 acc = {0.f, 0.f, 0.f, 0.f};
#pragma unroll
                for (int ks = 0; ks < 8; ++ks) { const i32x4 b_ = *(const LAS i32x4*)(uadr[ks & 3] + rp + 256 * (ks >> 2));
                    const i32x8 b8_ = {b_.x, b_.y, b_.z, b_.w, 0, 0, 0, 0};
                    const i32x8 a8_ = {hA[ks].x, hA[ks].y, hA[ks].z, hA[ks].w, 0, 0, 0, 0};
                    acc = __builtin_amdgcn_mfma_scale_f32_16x16x128_f8f6f4(a8_, b8_, acc, 4  , 4  , 0, 127, 0, 127); }
                dotA = (tt == grp) ? acc[0] : dotA; dotB = (tt == grp + 4) ? acc[0] : dotB;
                __builtin_amdgcn_sched_barrier(0);
                if (tt + PEER_URT < 8) { PEER_ISSUE8U(tt + PEER_URT); PEER_LOADIDX((tt + PEER_URT + 1) & 7); }
                __builtin_amdgcn_sched_barrier(0);
            }
            const float ascale = 1.0f / (PEER_H4_SCALE * PEER_UF4_SCALE);
            unsigned loA, hiA, loB, hiB; float bscA, bscB;
            { const float av = dotA * ascale, bv = dotB * ascale;
              const float cA = sgate[lane] * (0.5f * av * (1.0f + erff(av * 0.70710678118654752f))), cB = sgate[64 + lane] * (0.5f * bv * (1.0f + erff(bv * 0.70710678118654752f)));
              const float mxA = __builtin_bit_cast(float, row_max16(__builtin_bit_cast(unsigned, fabsf(cA)))), mxB = __builtin_bit_cast(float, row_max16(__builtin_bit_cast(unsigned, fabsf(cB))));
              const float qsA = mxA > 0.f ? 7.0f * __builtin_amdgcn_rcpf(mxA) : 0.f, qsB = mxB > 0.f ? 7.0f * __builtin_amdgcn_rcpf(mxB) : 0.f;
              const unsigned cqA = ((unsigned)(int)__builtin_rintf(cA * qsA) & 15u) << (4 * (lane & 7)), cqB = ((unsigned)(int)__builtin_rintf(cB * qsB) & 15u) << (4 * (lane & 7));
              loA = (lane & 8) ? 0u : cqA; hiA = (lane & 8) ? cqA : 0u; loB = (lane & 8) ? 0u : cqB; hiB = (lane & 8) ? cqB : 0u;
              loA |= dpp_u<0xB1>(loA); loA |= dpp_u<0x4E>(loA); loA |= dpp_u<0x141>(loA); loA |= dpp_u<0x140>(loA);
              hiA |= dpp_u<0xB1>(hiA); hiA |= dpp_u<0x4E>(hiA); hiA |= dpp_u<0x141>(hiA); hiA |= dpp_u<0x140>(hiA);
              loB |= dpp_u<0xB1>(loB); loB |= dpp_u<0x4E>(loB); loB |= dpp_u<0x141>(loB); loB |= dpp_u<0x140>(loB);
              hiB |= dpp_u<0xB1>(hiB); hiB |= dpp_u<0x4E>(hiB); hiB |= dpp_u<0x141>(hiB); hiB |= dpp_u<0x140>(hiB);
              bscA = mxA * (1.0f / 7.0f); bscB = mxB * (1.0f / 7.0f); }
            unsigned* rec = (unsigned*)(F.ws + WS_PL) + t * PEER_REC_WORDS;
            rec[lane] = (unsigned)sidx[lane]; rec[64 + lane] = (unsigned)sidx[64 + lane];
            if ((lane & 15) == 0) { rec[128 + grp] = loA; rec[132 + grp] = loB; rec[136 + grp] = hiA; rec[140 + grp] = hiB; rec[144 + grp] = __builtin_bit_cast(unsigned, bscA); rec[148 + grp] = __builtin_bit_cast(unsigned, bscB); }
            asm volatile("s_waitcnt lgkmcnt(0)" ::: "memory");
            if (lane == 0) flags[slot] = 0u;
        }
#undef PEER_ALOAD
#undef PEER_ISSUE8U
    }
}

DI void peer_v_phase(Frame& F, int tg, bool dry) {
    F.refresh();
    __syncthreads();
    const int lane = F.lane, wv = F.wave;
    LAS unsigned char* wb = F.lds + wv * PEER_VW_BYTES;
    LAS int* sidx = (LAS int*)wb;
    LAS unsigned char* ring = wb + 512; const unsigned ringb = (unsigned)(uintptr_t)ring;
    const unsigned char* Vb = F.ws + WS_V;
    const int a16 = (lane ^ 16) << 2, a32 = (lane ^ 32) << 2;
    unsigned usw[4];
#pragma unroll
    for (int q = 0; q < 4; ++q) usw[q] = 16u * (unsigned)((lane & 31) ^ (2 * q + (lane >> 5))) + (4096u - 1024u * q);
#define PEER_ISSUE8V(tile) do { const unsigned rs_ = (unsigned)__builtin_amdgcn_readfirstlane((int)(ringb + (unsigned)((tile) & 1) * 8192u)); \
        glds16s_x4(Vb - 4096, nx[0] + usw[0], nx[1] + usw[1], nx[2] + usw[2], nx[3] + usw[3], rs_); \
        glds16s_x4(Vb - 4096, nx[4] + (usw[0] ^ 128u), nx[5] + (usw[1] ^ 128u), nx[6] + (usw[2] ^ 128u), nx[7] + (usw[3] ^ 128u), rs_ + 4096u); } while (0)
    unsigned vxo[8];
#pragma unroll
    for (int l = 0; l < 8; ++l) vxo[l] = 32u * (unsigned)(l ^ ((lane & 15) >> 1));
    const LAS unsigned char* rowb0 = ring + (lane & 15) * 512 + 16 * (((lane >> 5) ^ lane) & 1) + 8 * ((lane >> 4) & 1);
    float gf[16];
#pragma unroll
    for (int cb = 0; cb < 16; ++cb) gf[cb] = F.final_norm_g[lane + 64 * cb];
    const int TSTEP = PEER_VACT * F.G;
    if (wv >= PEER_VACT) return;
    unsigned pi0 = 0u, pi1 = 0u, pcw = 0u; float px[16];
#define PEER_VFETCH(tl_) do { const size_t t_ = (size_t)tg * TG + (tl_); const unsigned* rec_ = (const unsigned*)(F.ws + WS_PL) + t_ * PEER_REC_WORDS; pi0 = rec_[lane]; pi1 = rec_[64 + lane]; pcw = rec_[128 + (lane & 31)]; \
        const float* xo_ = F.out + t_ * 1024 + lane; _Pragma("unroll") for (int cb = 0; cb < 16; ++cb) px[cb] = xo_[64 * cb]; } while (0)
    { const int tl0 = F.vcu + F.G * wv; if (tl0 < TG) PEER_VFETCH(tl0); else {
#pragma unroll
        for (int cb = 0; cb < 16; ++cb) px[cb] = 0.f; } }
#pragma unroll 1
    for (int tl = F.vcu + F.G * wv; tl < TG; tl += TSTEP) {
        const size_t t = (size_t)tg * TG + tl;
        const unsigned cw = pcw; float xa[16];
#pragma unroll
        for (int cb = 0; cb < 16; ++cb) xa[cb] = px[cb];
        sidx[lane] = (int)(dry ? pi0 & PROBE_VMASK : pi0); sidx[64 + lane] = (int)(dry ? pi1 & PROBE_VMASK : pi1);
        asm volatile("s_waitcnt lgkmcnt(0)" ::: "memory");
        unsigned nx[8];
        PEER_LOADIDX(0); PEER_ISSUE8V(0); PEER_LOADIDX(1); PEER_ISSUE8V(1); PEER_LOADIDX(2);
        float oacc[16];
#pragma unroll
        for (int cb = 0; cb < 16; ++cb) oacc[cb] = 0.f;
#pragma unroll 1
        for (int vb = 0; vb < 8; ++vb) {
            if (vb < 6) asm volatile("s_waitcnt vmcnt(8)" ::: "memory"); else if (vb == 6) asm volatile("s_waitcnt vmcnt(27)" ::: "memory"); else asm volatile("s_waitcnt vmcnt(19)" ::: "memory");
            const int clo = __builtin_amdgcn_readlane((int)cw, vb), chi = __builtin_amdgcn_readlane((int)cw, 8 + vb);
            const float bsc = __builtin_bit_cast(float, __builtin_amdgcn_readlane((int)cw, 16 + vb));
            const LAS unsigned char* rowp = rowb0 + (vb & 1) * 8192;
#pragma unroll
            for (int cb = 0; cb < 16; ++cb) {
                const i32x2 tr = __builtin_amdgcn_ds_read_tr4_b64_v2i32((LAS i32x2*)(rowp + vxo[cb & 7] + 256 * (cb >> 3)));
                const int ai = __builtin_amdgcn_sdot8(chi, tr.y, __builtin_amdgcn_sdot8(clo, tr.x, 0, false), false);
                oacc[cb] += (float)ai * bsc;
            }
            if (vb < 6) { PEER_ISSUE8V(vb + 2); PEER_LOADIDX((vb + 3) & 7); }
            if (vb == 5) { const int tn_ = tl + TSTEP < TG ? tl + TSTEP : tl; PEER_VFETCH(tn_); }
        }
        float* xo = dry ? (float*)(F.ws + WS_PROJ + (128u << 20)) + (size_t)tl * 1024 + lane : F.out + t * 1024 + lane;
        float ss = 0.f;
#pragma unroll
        for (int cb = 0; cb < 16; ++cb) { xa[cb] = xa[cb] + oacc[cb] * (1.0f / PEER_U_SCALE); ss += xa[cb] * xa[cb]; }
        ss = row_sum16(ss); ss += bperm_f(a16, ss); ss += bperm_f(a32, ss);
        const float rf = __builtin_amdgcn_rsqf(ss * (1.0f / 1024.0f) + EPS);
#pragma unroll
        for (int cb = 0; cb < 16; ++cb) xo[64 * cb] = xa[cb] * rf * gf[cb];
    }
#undef PEER_VFETCH
#undef PEER_ISSUE8V
}
#undef PEER_LOADIDX

DI void convert_uv(Frame& F, int part, int nparts, int cu, int ncu) {
    F.refresh();
    const int gt = cu * 512 + F.tid, NGT = ncu * 512, per = (2 * 16384 * 64) / nparts;
    for (int id = part * per + gt; id < (part + 1) * per; id += NGT) {
        const int which = id >> 20, off = (id & ((1 << 20) - 1)) * 16;
        const float* src = (which ? F.peer_v : F.peer_u) + off; unsigned char* dst = F.ws + (which ? WS_V : WS_U) + off / 2;
        u32x2 o;
        if (which == 0) {
#pragma unroll
            for (int q = 0; q < 2; ++q) { const f32x4 v0 = *(const f32x4*)(src + 8 * q) * PEER_UF4_SCALE, v1 = *(const f32x4*)(src + 8 * q + 4) * PEER_UF4_SCALE;
                unsigned pk = __builtin_amdgcn_cvt_scalef32_pk_fp4_f32(0u, v0.x, v0.y, 1.0f, 0); pk = __builtin_amdgcn_cvt_scalef32_pk_fp4_f32(pk, v0.z, v0.w, 1.0f, 1);
                pk = __builtin_amdgcn_cvt_scalef32_pk_fp4_f32(pk, v1.x, v1.y, 1.0f, 2); pk = __builtin_amdgcn_cvt_scalef32_pk_fp4_f32(pk, v1.z, v1.w, 1.0f, 3); o[q] = pk; }
        } else {
#pragma unroll
            for (int q = 0; q < 2; ++q) { const f32x4 v0 = *(const f32x4*)(src + 8 * q) * PEER_U_SCALE, v1 = *(const f32x4*)(src + 8 * q + 4) * PEER_U_SCALE; unsigned pk = 0u;
#pragma unroll
                for (int k = 0; k < 4; ++k) { pk |= ((unsigned)(int)__builtin_rintf(fminf(fmaxf(v0[k], -7.f), 7.f)) & 15u) << (4 * k); pk |= ((unsigned)(int)__builtin_rintf(fminf(fmaxf(v1[k], -7.f), 7.f)) & 15u) << (16 + 4 * k); }
                o[q] = pk; }
        }
        *(u32x2*)dst = o;
    }
}

constexpr int N_PHASES = 21;
struct Args { const float* in[17]; float* out; unsigned char* ws; int ph_lo, ph_hi; };

__global__ void __launch_bounds__(NWAVES * 64, 2) fwd_kernel(Args args) {
    extern __shared__ __attribute__((aligned(16))) unsigned char lds_raw[];
    Frame F;
    F.lds = (LAS unsigned char*)lds_raw;
    F.tid = threadIdx.x; F.lane = F.tid & 63; F.wave = __builtin_amdgcn_readfirstlane(F.tid >> 6);
    F.G = gridDim.x; { const int bx = blockIdx.x; F.vcu = (F.G % 8 == 0) ? (bx % 8) * (F.G / 8) + bx / 8 : bx; }
    F.x = args.in[0]; F.mem = args.in[1]; F.norm_mix_g = args.in[2]; F.w_in = args.in[3]; F.hg_lb = args.in[4]; F.hg_norm_g = args.in[5]; F.sc_conv_w = args.in[6];
    F.mem_norm_g = args.in[7]; F.w_mem_kv = args.in[8]; F.w_branch = args.in[9]; F.w_out = args.in[10]; F.norm_ffn_g = args.in[11]; F.peer_w_q = args.in[12];
    F.peer_sub_keys = args.in[13]; F.peer_u = args.in[14]; F.peer_v = args.in[15]; F.final_norm_g = args.in[16];
    F.out = args.out; F.ws = args.ws;
    volatile LAS unsigned* MISC = (volatile LAS unsigned*)(F.lds + MISC_OFF);
    for (int u = F.tid; u < (LDS_BYTES - MISC_OFF) / 4; u += NWAVES * 64) MISC[u] = 0u;
    __syncthreads();
    unsigned* barw = (unsigned*)(F.ws + WS_CTL) + CW_BAR;
    XcdBarrier bar; bar.bar = barw; bar.x = 0; bar.st = nullptr;
    const bool one_launch = (args.ph_hi - args.ph_lo) > 1;
    if (one_launch) bar = xcd_barrier_post(barw, MISC + 8);
    const int lo = args.ph_lo, hi = args.ph_hi;
#define IN(k) (lo <= (k) && (k) < hi)
#ifndef PMASK
#define PMASK 0x3ff
#endif
#define PC_(c) ((PMASK >> (c)) & 1)
#ifndef REP_MASK
#define REP_MASK 0
#endif
#define REPS(c) for (int rep_ = 0; rep_ < 1 + 2 * ((REP_MASK >> (c)) & 1); ++rep_)
#define SEAM(k) do { if (IN(k) && IN((k) + 1)) xcd_barrier(bar); } while (0)
    unsigned char* ws = F.ws;
    const int G = F.G, cid = (int)blockIdx.x;

    if (PC_(0) && IN(0)) { REPS(0) p0_prologue(F); } SEAM(0);

#pragma unroll 1
    for (int g = 0; g < NGRP; ++g) {
        const int pb = 1 + 6 * g;
        if (PC_(1) && IN(pb)) REPS(1) {
            pg8::InOrder S; S.init(TG, PC, G, cid); S.H = (const char*)(ws + WS_XG) + (size_t)g * TG * 1024 * 2; S.Win = (const char*)(ws + WS_WIN); S.Mn = (const char*)(ws + WS_MN); S.Wkv = (const char*)(ws + WS_WKV); S.n_extra = (g == 0) ? 64 : 0;
            pg8::EpiIn E{(bf16*)(ws + WS_PROJ), (bf16*)(ws + WS_KMEM), (bf16*)(ws + WS_VT)};
            pg8::gemm_phase<pg8::EpiIn, pg8::InOrder, true, true>(F.lds, pg8::Gemm{1024, 1024, 1024}, S, E);
            if (cid >= 128) convert_uv(F, g, NGRP, cid - 128, G - 128);
        } SEAM(pb);
        if (PC_(2) && IN(pb + 1)) REPS(2) {
            for (int it = F.vcu * 4; it < BG * 4 * NCHUNK; it += G * 4) { for (int k = 0; k < 4; ++k) hgrn_a_item(F, it + k, k < 3); }
            for (int it = F.vcu; it < BG * 4 * 8; it += G) attn_item(F, g, it);
            conv_phase(F);
        } SEAM(pb + 1);
        if (PC_(3) && IN(pb + 2)) { REPS(3) hgrn_scan(F); } SEAM(pb + 2);
        if (PC_(4) && IN(pb + 3)) REPS(4) { for (int it = F.vcu * 4; it < BG * 4 * NCHUNK; it += G * 4) { for (int k = 0; k < 4; ++k) hgrn_c_item(F, it + k, k < 3); } } SEAM(pb + 3);
        if (PC_(5) && IN(pb + 4)) REPS(5) {
            pg8::BranchOrder S; S.init(TG, 1024, G, cid); S.Y = (const char*)(ws + WS_YHG); S.Wb = (const char*)(ws + WS_WBR);
            pg8::EpiBranch E{(const bf16*)(ws + WS_PROJ), (bf16*)(ws + WS_MACC), (bf16*)(ws + WS_MERGED)};
            pg8::gemm_phase<pg8::EpiBranch, pg8::BranchOrder, true, true>(F.lds, pg8::Gemm{512, 512, 512}, S, E);
        } SEAM(pb + 4);
        if (PC_(6) && IN(pb + 5)) REPS(6) {
            pg8::PlainOrder S; S.init(TG, 1024, G, cid); S.A = (const char*)(ws + WS_MERGED); S.Bt = (const char*)(ws + WS_WOUT); S.a_tile = 256 * 1024 * 2; S.b_tile = 256 * 1024 * 2;
            pg8::EpiOut E{F.x + (size_t)g * TG * 1024, F.out + (size_t)g * TG * 1024, (bf16*)(ws + WS_XG) + (size_t)g * TG * 1024, F.norm_ffn_g, (float*)(ws + WS_SSP) + (size_t)g * TG * 16};
            pg8::gemm_phase<pg8::EpiOut, pg8::PlainOrder, true, true>(F.lds, pg8::Gemm{1024, 1024, 1024}, S, E);
        } SEAM(pb + 5);
    }
#pragma unroll 1
    for (int tg = 0; tg < NGRP; ++tg) {
        const int pb = 13 + 4 * tg;
        if (PC_(7) && IN(pb)) REPS(7) {
            pg8::PlainOrder S; S.init(TG, 2048, G, cid); S.A = (const char*)(ws + WS_XG) + (size_t)tg * TG * 1024 * 2; S.Bt = (const char*)(ws + WS_WQ); S.a_tile = 256 * 1024 * 2; S.b_tile = 256 * 1024 * 2;
            pg8::EpiQ E{(bf16*)(ws + WS_Q), 2048, (const float*)(ws + WS_SSP) + (size_t)tg * TG * 16};
            pg8::gemm_phase<pg8::EpiQ, pg8::PlainOrder, true, true>(F.lds, pg8::Gemm{1024, 1024, 1024}, S, E);
        } SEAM(pb);
        if (PC_(8) && IN(pb + 1)) REPS(8) {
            pg8::ScoreOrder S; S.init(TG, 2048, G, cid); S.Q = (const char*)(ws + WS_Q); S.Kbd = (const char*)(ws + WS_KBD);
            pg8::EpiF32 E{(float*)(ws + WS_S), 2048};
            pg8::gemm_phase<pg8::EpiF32, pg8::ScoreOrder, true, true>(F.lds, pg8::Gemm{2048, 256, 256}, S, E);
        } SEAM(pb + 1);
        if (PC_(9) && IN(pb + 2)) { REPS(9) peer_u_phase(F, tg); } SEAM(pb + 2);
        if (PC_(9) && IN(pb + 3)) { REPS(10) peer_v_phase(F, tg, rep_ < 2 * ((REP_MASK >> 10) & 1)); } SEAM(pb + 3);
    }
#undef IN
#undef SEAM
}

extern "C" void kernel_launch(void* const* d_in, const int* in_sizes, int n_in, void* d_out, int out_size, void* d_ws, size_t ws_size, hipStream_t stream) {
    static int ready = 0;
    if (ready == 0) {
        if (n_in != 17 || out_size != T_ALL * D_MODEL || ws_size < WS_END) { fprintf(stderr, "kernel_launch: unexpected shapes (n_in %d, out %d, ws %zu)\n", n_in, out_size, ws_size); ready = -1; return; }
        if (hipFuncSetAttribute((const void*)fwd_kernel, hipFuncAttributeMaxDynamicSharedMemorySize, LDS_BYTES) != hipSuccess) { fprintf(stderr, "kernel_launch: hipFuncSetAttribute failed\n"); ready = -1; return; }
        ready = 1;
    }
    if (ready < 0) return;
    (void)hipMemsetAsync((char*)d_ws + WS_CTL, 0, CTL_ZERO_BYTES, stream);
    Args a{};
    for (int i = 0; i < 17; ++i) a.in[i] = (const float*)d_in[i];
    a.out = (float*)d_out; a.ws = (unsigned char*)d_ws;
    const int grid = 256;
#if MK_N_LAUNCHES == 1
    a.ph_lo = 0; a.ph_hi = N_PHASES;
    hipLaunchKernelGGL(fwd_kernel, dim3(grid), dim3(NWAVES * 64), LDS_BYTES, stream, a);
#else
    for (int li = 0; li < N_PHASES; ++li) { a.ph_lo = li; a.ph_hi = li + 1; hipLaunchKernelGGL(fwd_kernel, dim3(grid), dim3(NWAVES * 64), LDS_BYTES, stream, a); }
#endif
}
```

```cpp
#include <hip/hip_runtime.h>
#include <cstdio>
#include <cstdint>

#ifndef MK_N_LAUNCHES
#define MK_N_LAUNCHES 1
#endif

#define LAS __attribute__((address_space(3)))
#define GAS __attribute__((address_space(1)))
typedef unsigned short bf16;
typedef short bf16x8 __attribute__((ext_vector_type(8)));
typedef short s16x4 __attribute__((ext_vector_type(4)));
typedef short v4i16_t __attribute__((ext_vector_type(4)));
typedef float f32x2 __attribute__((ext_vector_type(2)));
typedef float f32x4 __attribute__((ext_vector_type(4)));
typedef float f32x16 __attribute__((ext_vector_type(16)));
typedef unsigned u32x2 __attribute__((ext_vector_type(2)));
typedef unsigned u32x4 __attribute__((ext_vector_type(4)));
typedef __bf16 bf16x2_t __attribute__((ext_vector_type(2)));
typedef GAS unsigned gu32;
#define RLX_AGENT __ATOMIC_RELAXED, __HIP_MEMORY_SCOPE_AGENT
#define DI __device__ __forceinline__

constexpr int D_MODEL = 1024, BATCH = 16, SEQ = 2048, T_ALL = BATCH * SEQ;
constexpr int NGRP = 2, BG = BATCH / NGRP, TG = BG * SEQ;
constexpr int PC = 7680;
constexpr int C_HQ = 0, C_HI = 512, C_FF = 1024, C_FB = 1536, C_HG = 2048, C_SB = 2560, C_SC = 3072, C_SH = 3584, C_MQ = 4096, C_GATE = 4608;
constexpr int NMEM = 256, CHUNK = 64, NCHUNK = SEQ / CHUNK;
constexpr float EPS = 1e-6f;

constexpr size_t MiB = 1u << 20;
constexpr size_t WS_CTL = 0, CTL_ZERO_BYTES = 1 * MiB;
constexpr size_t WS_LB = 1 * MiB;
constexpr size_t WS_SSP = 2 * MiB;
constexpr size_t WS_DEC = 4 * MiB;
constexpr size_t WS_WIN = 5 * MiB, WS_WKV = 20 * MiB, WS_WBR = 22 * MiB, WS_WOUT = 25 * MiB, WS_WQ = 27 * MiB, WS_KBD = 31 * MiB;
constexpr size_t WS_MN = 32 * MiB, WS_KMEM = 40 * MiB, WS_VT = 44 * MiB;
constexpr size_t WS_XG = 48 * MiB;
constexpr size_t WS_YHG = 112 * MiB, WS_YSC = 128 * MiB, WS_YMX = 144 * MiB;
constexpr size_t WS_DS = 160 * MiB;
constexpr size_t WS_MACC = 160 * MiB;
constexpr size_t WS_MERGED = 224 * MiB;
constexpr size_t WS_PROJ = 256 * MiB;
constexpr size_t WS_U = 496 * MiB, WS_V = 504 * MiB;
constexpr size_t WS_Q = 160 * MiB;
constexpr size_t WS_S = 256 * MiB;
constexpr size_t WS_S1 = 384 * MiB;
constexpr int S1_SPLIT = 14336;
constexpr size_t WS_PL = 128 * MiB;
constexpr size_t WS_END = 512 * MiB;
constexpr size_t OUT_SST = 64 * MiB;

constexpr int LDS_BYTES = 160 * 1024;
constexpr int MISC_OFF = LDS_BYTES - 512;
constexpr int NWAVES = 8;

DI unsigned f2bf(float f) { unsigned u = __builtin_bit_cast(unsigned, f); return (u + 0x7fffu + ((u >> 16) & 1u)) >> 16; }
DI unsigned pk2(float lo, float hi) { return f2bf(lo) | (f2bf(hi) << 16); }
DI float bf2f(unsigned short b) { return __builtin_bit_cast(float, (unsigned)b << 16); }
DI float bflo(unsigned w) { return __builtin_bit_cast(float, w << 16); }
DI float bfhi(unsigned w) { return __builtin_bit_cast(float, w & 0xffff0000u); }
DI float wave_sum(float v) {
#pragma unroll
    for (int o = 1; o < 64; o <<= 1) v += __shfl_xor(v, o);
    return v;
}
DI unsigned cvtpk(float lo, float hi) { f32x2 v = {lo, hi}; bf16x2_t b = __builtin_convertvector(v, bf16x2_t); return __builtin_bit_cast(unsigned, b); }
template <int CTRL> DI unsigned dpp_u(unsigned v) { return (unsigned)__builtin_amdgcn_update_dpp(0, (int)v, CTRL, 0xF, 0xF, false); }
template <int CTRL> DI float dpp_f(float v) { return __builtin_bit_cast(float, __builtin_amdgcn_update_dpp(0, __builtin_bit_cast(int, v), CTRL, 0xF, 0xF, false)); }
DI float bperm_f(int addr, float v) { return __builtin_bit_cast(float, __builtin_amdgcn_ds_bpermute(addr, __builtin_bit_cast(int, v))); }
DI unsigned row_max16(unsigned m) { m = max(m, dpp_u<0xB1>(m)); m = max(m, dpp_u<0x4E>(m)); m = max(m, dpp_u<0x141>(m)); return max(m, dpp_u<0x140>(m)); }
DI float row_sum16(float v) { v += dpp_f<0xB1>(v); v += dpp_f<0x4E>(v); v += dpp_f<0x141>(v); return v + dpp_f<0x140>(v); }

DI float fast_sig(float z) { return __builtin_amdgcn_rcpf(1.0f + __builtin_amdgcn_exp2f(-1.4426950408889634f * z)); }
DI float sigmoidf_(float z) { return 1.0f / (1.0f + __expf(-z)); }

namespace pg8 {
constexpr int BM = 256, BK = 64, HALF = 128, HTB = HALF * BK * 2, STAGE_BYTES = 8 * HTB, NXCD = 8, WGM = 2;
__host__ __device__ __forceinline__ int lds_byte(int r, int c) { const int st = (r >> 4) * 2 + (c >> 5), rr = r & 15, cc = c & 31, ob = rr * 64 + cc * 2; return st * 1024 + (ob ^ (((ob >> 9) & 1) << 5)); }
__host__ __device__ __forceinline__ void stage_rc(int b, int& R, int& C) { const int st = b / 1024, sb = b % 1024, swz = sb ^ (((sb >> 9) & 1) << 5); R = (st >> 1) * 16 + swz / 64; C = (st & 1) * 32 + (swz % 64) / 2; }
__host__ __device__ __forceinline__ int perm32(int rho) { const int n = rho >> 4, i = rho & 15; return 8 * (i >> 2) + 4 * n + (i & 3); }

struct Unit { int pm, pn, z; };
struct Gemm { int lda, ldb, K; };

struct StaticOrder {
    static constexpr bool KEEP_ACC = false;
    int nM, nN, nwg, G, c;
    __device__ void init(int M, int N, int G_, int c_) { nM = M / BM; nN = N / BM; nwg = nM * nN; G = G_; c = c_; }
    __device__ bool tile(int i, Unit& u) const {
        const long L = (long)i * G + c; if (L >= nwg) return false;
        int wgid = (int)L; { const int q = nwg / NXCD, r = nwg % NXCD, xcd = wgid % NXCD, off = wgid / NXCD; wgid = (xcd < r ? xcd * (q + 1) : r * (q + 1) + (xcd - r) * q) + off; }
        const int nig = WGM * nN, gid = wgid / nig, fm = gid * WGM, gsz = (nM - fm) < WGM ? (nM - fm) : WGM;
        u.pm = fm + ((wgid % nig) % gsz); u.pn = (wgid % nig) / gsz; u.z = 0; return true;
    }
};

DI unsigned cvt_pk_bf16(float lo, float hi) { return cvtpk(lo, hi); }

template <class Epi, class Sched, bool ALIGN_EPI, bool SP2>
DI void gemm_phase(LAS unsigned char* lds, const Gemm g, const Sched& S, const Epi& E) {
    int tid_ = threadIdx.x; asm volatile("" : "+v"(tid_));
    const int tid = tid_, wid = __builtin_amdgcn_readfirstlane(tid >> 6), lane = tid & 63, wr = wid >> 2, wc = wid & 3, fr = lane & 15, fq = lane >> 4;
    int K_ = g.K; asm volatile("" : "+s"(K_));
    const int K = K_, nt = K / BK;
    unsigned voffA[2], voffB[2];
#pragma unroll
    for (int i = 0; i < 2; ++i) { int R, C; stage_rc(tid * 16 + i * 8192, R, C); const int Rb = Epi::PERM ? ((R & ~31) + perm32(R & 31)) : R;
        voffA[i] = (unsigned)(R * g.lda + C) * 2u; voffB[i] = (unsigned)(Rb * g.ldb + C) * 2u; }
    const size_t kstep = (size_t)(BK * 2);
    const size_t hA = (size_t)HALF * g.lda * 2, hB = (size_t)HALF * g.ldb * 2;
    const unsigned ldsw = (unsigned)wid * 1024u;
    const int aoff = lds_byte(wr * 64 + fr, fq * 8), boff = lds_byte(wc * 32 + fr, fq * 8);
#define PG8_SA(b, h) (((b) * 2 + (h)) * HTB)
#define PG8_SB(b, h) ((4 + (b) * 2 + (h)) * HTB)
#define PG8_STAGE(bufoff, gbase, voff) do { _Pragma("unroll") for (int _i = 0; _i < 2; ++_i) \
        __builtin_amdgcn_global_load_lds((const unsigned*)((const char*)(gbase) + (voff)[_i]), (LAS unsigned*)(lds + (bufoff) + ldsw + _i * 8192), 16, 0, 0); } while (0)
#define PG8_LDA(dst, b, h) do { _Pragma("unroll") for (int m = 0; m < 4; ++m) _Pragma("unroll") for (int k = 0; k < 2; ++k) dst[m][k] = *(const LAS bf16x8*)(lds + PG8_SA(b, h) + aoff + m * 2048 + k * 1024); } while (0)
#define PG8_LDB(dst, b, h) do { _Pragma("unroll") for (int n = 0; n < 2; ++n) _Pragma("unroll") for (int k = 0; k < 2; ++k) dst[n][k] = *(const LAS bf16x8*)(lds + PG8_SB(b, h) + boff + n * 2048 + k * 1024); } while (0)
#define PG8_MMA(ai, bj, At, Bt) do { __builtin_amdgcn_s_setprio(1); _Pragma("unroll") for (int m = 0; m < 4; ++m) _Pragma("unroll") for (int n = 0; n < 2; ++n) _Pragma("unroll") for (int k = 0; k < 2; ++k) \
        acc[ai][bj][m][n] = __builtin_amdgcn_mfma_f32_16x16x32_bf16(Bt[n][k], At[m][k], acc[ai][bj][m][n], 0, 0, 0); __builtin_amdgcn_s_setprio(0); } while (0)
#define PG8_WAIT_V(n) asm volatile("s_waitcnt vmcnt(" #n ")" ::: "memory")
#define PG8_WAIT_L(n) asm volatile("s_waitcnt lgkmcnt(" #n ")" ::: "memory")
#define PG8_BAR __builtin_amdgcn_s_barrier()
#define PG8_SCHED __builtin_amdgcn_sched_barrier(0)
    Unit cur, nxt; int ui = 0;
    if (!S.next(0, cur)) return;
    f32x4 acc[2][2][4][2];
#pragma unroll
    for (int a = 0; a < 2; ++a)
#pragma unroll
        for (int b = 0; b < 2; ++b)
#pragma unroll
            for (int m = 0; m < 4; ++m)
#pragma unroll
                for (int n = 0; n < 2; ++n) acc[a][b][m][n] = (f32x4){0.f, 0.f, 0.f, 0.f};
    bf16x8 At[4][2], B0[2][2], B1[2][2];
    const char* cA = S.a_base(cur); const char* cB = S.b_base(cur);
    if constexpr (SP2) {
        PG8_STAGE(PG8_SB(0, 0), cB, voffB); PG8_STAGE(PG8_SB(0, 1), cB + hB, voffB); PG8_STAGE(PG8_SA(0, 0), cA, voffA); PG8_STAGE(PG8_SA(0, 1), cA + hA, voffA);
        if (wr == 1) PG8_BAR;
        PG8_WAIT_V(2); PG8_BAR;
        PG8_STAGE(PG8_SB(1, 0), cB + kstep, voffB); PG8_STAGE(PG8_SA(1, 0), cA + kstep, voffA); PG8_STAGE(PG8_SB(1, 1), cB + hB + kstep, voffB);
        PG8_WAIT_V(6); PG8_BAR;
    } else {
        PG8_STAGE(PG8_SB(0, 0), cB, voffB); PG8_STAGE(PG8_SA(0, 0), cA, voffA); PG8_STAGE(PG8_SB(0, 1), cB + hB, voffB); PG8_STAGE(PG8_SA(0, 1), cA + hA, voffA);
        if (wr == 1) PG8_BAR;
        PG8_WAIT_V(4); PG8_BAR;
        PG8_STAGE(PG8_SB(1, 0), cB + kstep, voffB); PG8_STAGE(PG8_SA(1, 0), cA + kstep, voffA); PG8_STAGE(PG8_SB(1, 1), cB + hB + kstep, voffB);
        PG8_WAIT_V(6); PG8_BAR;
    }
    for (;;) {
        const bool has_next = S.next(ui + 1, nxt);
        const char* nA = has_next ? S.a_base(nxt) : cA; const char* nB = has_next ? S.b_base(nxt) : cB;
        for (int t = 0; t < nt; t += 2) {
            const bool last = (t == nt - 2);
            const char* a1 = cA + (size_t)(t + 1) * kstep;
            const char* a2 = last ? nA : cA + (size_t)(t + 2) * kstep; const char* b2 = last ? nB : cB + (size_t)(t + 2) * kstep;
            const char* a3 = a2 + kstep; const char* b3 = b2 + kstep;
            if constexpr (SP2) {
            PG8_LDB(B0, 0, 0); PG8_LDB(B1, 0, 1); PG8_SCHED; PG8_LDA(At, 0, 0); PG8_STAGE(PG8_SA(1, 1), a1 + hA, voffA);
            PG8_WAIT_V(8); PG8_WAIT_L(0); PG8_BAR; PG8_MMA(0, 0, At, B0); PG8_MMA(0, 1, At, B1); PG8_BAR; PG8_SCHED;
            PG8_LDA(At, 0, 1); PG8_STAGE(PG8_SB(0, 0), b2, voffB); PG8_STAGE(PG8_SB(0, 1), b2 + hB, voffB); PG8_STAGE(PG8_SA(0, 0), a2, voffA);
            PG8_WAIT_V(8); PG8_WAIT_L(0); PG8_BAR; PG8_MMA(1, 0, At, B0); PG8_MMA(1, 1, At, B1); PG8_BAR; PG8_SCHED;
            PG8_LDB(B0, 1, 0); PG8_LDB(B1, 1, 1); PG8_SCHED; PG8_LDA(At, 1, 0); PG8_STAGE(PG8_SA(0, 1), a2 + hA, voffA);
            PG8_WAIT_V(8); PG8_WAIT_L(0); PG8_BAR; PG8_MMA(0, 0, At, B0); PG8_MMA(0, 1, At, B1); PG8_BAR; PG8_SCHED;
            PG8_LDA(At, 1, 1); PG8_STAGE(PG8_SB(1, 0), b3, voffB); PG8_STAGE(PG8_SB(1, 1), b3 + hB, voffB); PG8_STAGE(PG8_SA(1, 0), a3, voffA);
            PG8_WAIT_V(8); PG8_WAIT_L(0); PG8_BAR; PG8_MMA(1, 0, At, B0); PG8_MMA(1, 1, At, B1); PG8_BAR; PG8_SCHED;
            } else {
            PG8_LDB(B0, 0, 0); PG8_SCHED; PG8_LDA(At, 0, 0); PG8_STAGE(PG8_SA(1, 1), a1 + hA, voffA);
            PG8_WAIT_L(8); PG8_BAR; PG8_WAIT_L(0); PG8_MMA(0, 0, At, B0); PG8_BAR; PG8_SCHED;
            PG8_LDB(B1, 0, 1); PG8_STAGE(PG8_SB(0, 0), b2, voffB);
            PG8_BAR; PG8_WAIT_L(0); PG8_MMA(0, 1, At, B1); PG8_BAR;
            PG8_LDA(At, 0, 1); PG8_STAGE(PG8_SA(0, 0), a2, voffA);
            PG8_BAR; PG8_WAIT_L(0); PG8_MMA(1, 0, At, B0); PG8_BAR; PG8_SCHED;
            PG8_STAGE(PG8_SB(0, 1), b2 + hB, voffB);
            PG8_WAIT_V(6); PG8_BAR; PG8_MMA(1, 1, At, B1); PG8_BAR;
            PG8_LDB(B0, 1, 0); PG8_SCHED; PG8_LDA(At, 1, 0); PG8_STAGE(PG8_SA(0, 1), a2 + hA, voffA);
            PG8_WAIT_L(8); PG8_BAR; PG8_WAIT_L(0); PG8_MMA(0, 0, At, B0); PG8_BAR; PG8_SCHED;
            PG8_LDB(B1, 1, 1); PG8_STAGE(PG8_SB(1, 0), b3, voffB);
            PG8_BAR; PG8_WAIT_L(0); PG8_MMA(0, 1, At, B1); PG8_BAR;
            PG8_LDA(At, 1, 1); PG8_STAGE(PG8_SA(1, 0), a3, voffA);
            PG8_BAR; PG8_WAIT_L(0); PG8_MMA(1, 0, At, B0); PG8_BAR; PG8_SCHED;
            PG8_STAGE(PG8_SB(1, 1), b3 + hB, voffB);
            PG8_WAIT_V(6); PG8_BAR; PG8_MMA(1, 1, At, B1); PG8_BAR;
            }
        }
        if constexpr (ALIGN_EPI) { if (wr == 0) PG8_BAR; }
        E(acc, cur, wr, wc, fr, fq);
        if (!has_next) break;
        if (!(Sched::KEEP_ACC && nxt.z != 0)) {
#pragma unroll
        for (int a = 0; a < 2; ++a)
#pragma unroll
            for (int b = 0; b < 2; ++b)
#pragma unroll
                for (int m = 0; m < 4; ++m)
#pragma unroll
                    for (int n = 0; n < 2; ++n) acc[a][b][m][n] = (f32x4){0.f, 0.f, 0.f, 0.f};
        }
        cur = nxt; cA = nA; cB = nB; ++ui;
        if constexpr (ALIGN_EPI) { if (wr == 1) PG8_BAR; }
    }
    PG8_WAIT_V(0);
    if constexpr (!ALIGN_EPI) { if (wr == 0) PG8_BAR; }
    PG8_BAR;
#undef PG8_SA
#undef PG8_SB
#undef PG8_STAGE
#undef PG8_LDA
#undef PG8_LDB
#undef PG8_MMA
#undef PG8_WAIT_V
#undef PG8_WAIT_L
#undef PG8_BAR
#undef PG8_SCHED
}
}

namespace pg8 {
struct PlainOrder : StaticOrder {
    const char* A; const char* Bt; size_t a_tile, b_tile;
    __device__ bool next(int i, Unit& u) const { return tile(i, u); }
    DI const char* a_base(const Unit& u) const { return A + (size_t)u.pm * a_tile; }
    DI const char* b_base(const Unit& u) const { return Bt + (size_t)u.pn * b_tile; }
};
struct InOrder : StaticOrder {
    const char* H; const char* Win; const char* Mn; const char* Wkv; int n_extra;
    __device__ bool next(int i, Unit& u) const {
        const long L = (long)i * G + c;
        if (L >= (long)nwg + n_extra) return false;
        Unit t; t.pm = 0; t.pn = 0; t.z = 0;
        const bool main_tile = L < nwg;
        if (main_tile) (void)tile(i, t);
        const int e = (int)(L - nwg);
        const int pm1 = e >> 1, pn1 = e & 1, pm2 = (e - 32) >> 4, pn2 = (e - 32) & 15; const bool k1 = e < 32;
        u.pm = main_tile ? t.pm : (k1 ? pm1 : pm2); u.pn = main_tile ? t.pn : (k1 ? pn1 : pn2); u.z = main_tile ? 0 : (k1 ? 1 : 2);
        return true;
    }
    DI const char* a_base(const Unit& u) const { const long d1 = Mn - H, d2 = (Wkv + (size_t)512 * 1024 * 2) - H; return H + ((u.z == 1) ? d1 : 0L) + ((u.z == 2) ? d2 : 0L) + (size_t)u.pm * (256 * 1024 * 2); }
    DI const char* b_base(const Unit& u) const { const long d1 = Wkv - Win, d2 = Mn - Win; return Win + ((u.z == 1) ? d1 : 0L) + ((u.z == 2) ? d2 : 0L) + (size_t)u.pn * (256 * 1024 * 2); }
};
DI void st16_wt(void* p, u32x4 v) { asm volatile("global_store_dwordx4 %0, %1, off sc1 nt\n\ts_nop 1" :: "v"(p), "v"(v) : "memory"); }
struct EpiIn {
    static constexpr bool PERM = true;
    bf16* proj; bf16* kmem; bf16* vt;
    DI void operator()(const f32x4 (&acc)[2][2][4][2], const Unit& u, int wr, int wc, int fr, int fq) const {
        const long dk = kmem - proj, dv = vt - proj; bf16* O = proj + ((u.z == 1) ? dk : 0L) + ((u.z == 2) ? dv : 0L); const int ldc = PC + ((u.z == 1) ? 512 - PC : 0) + ((u.z == 2) ? BATCH * NMEM - PC : 0);
        const int row0 = u.pm * BM + wr * 64 + fr, col0 = u.pn * BM + wc * 32 + 8 * fq;
#pragma unroll
        for (int ai = 0; ai < 2; ++ai)
#pragma unroll
            for (int m = 0; m < 4; ++m) { bf16* rowp = O + (size_t)(row0 + ai * HALF + m * 16) * ldc + col0;
#pragma unroll
                for (int bj = 0; bj < 2; ++bj) { const f32x4 v0 = acc[ai][bj][m][0], v1 = acc[ai][bj][m][1];
                    u32x4 w; w.x = cvt_pk_bf16(v0[0], v0[1]); w.y = cvt_pk_bf16(v0[2], v0[3]); w.z = cvt_pk_bf16(v1[0], v1[1]); w.w = cvt_pk_bf16(v1[2], v1[3]);
                    st16_wt(rowp + bj * HALF, w); } }
    }
};
struct BranchOrder : StaticOrder {
    static constexpr bool KEEP_ACC = true;
    const char* Y; const char* Wb;
    __device__ bool next(int i, Unit& u) const { if (!tile(i / 3, u)) return false; u.z = i % 3; return true; }
    DI const char* a_base(const Unit& u) const { return Y + (size_t)u.z * (16 * MiB) + (size_t)u.pm * (256 * 512 * 2); }
    DI const char* b_base(const Unit& u) const { return Wb + (size_t)u.z * (1024 * 512 * 2) + (size_t)u.pn * (256 * 512 * 2); }
};
struct ScoreOrder : StaticOrder {
    const char* Q; const char* Kbd;
    __device__ bool next(int i, Unit& u) const { return tile(i, u); }
    DI const char* a_base(const Unit& u) const { return Q + (size_t)u.pm * (256 * 2048 * 2) + (size_t)u.pn * 512; }
    DI const char* b_base(const Unit& u) const { return Kbd + (size_t)u.pn * (256 * 256 * 2); }
};

struct EpiBf16 {
    static constexpr bool PERM = true;
    bf16* O; int ldc;
    DI void operator()(const f32x4 (&acc)[2][2][4][2], const Unit& u, int wr, int wc, int fr, int fq) const {
        const int row0 = u.pm * BM + wr * 64 + fr, col0 = u.pn * BM + wc * 32 + 8 * fq;
#pragma unroll
        for (int ai = 0; ai < 2; ++ai)
#pragma unroll
            for (int m = 0; m < 4; ++m) { bf16* rowp = O + (size_t)(row0 + ai * HALF + m * 16) * ldc + col0;
#pragma unroll
                for (int bj = 0; bj < 2; ++bj) { const f32x4 v0 = acc[ai][bj][m][0], v1 = acc[ai][bj][m][1];
                    u32x4 w; w.x = cvt_pk_bf16(v0[0], v0[1]); w.y = cvt_pk_bf16(v0[2], v0[3]); w.z = cvt_pk_bf16(v1[0], v1[1]); w.w = cvt_pk_bf16(v1[2], v1[3]);
                    *(u32x4*)(rowp + bj * HALF) = w; } }
    }
};
struct EpiQ {
    static constexpr bool PERM = true;
    bf16* O; int ldc; const LAS float* rsl;
    DI void operator()(const f32x4 (&acc)[2][2][4][2], const Unit& u, int wr, int wc, int fr, int fq) const {
        const int lr0 = wr * 64 + fr, row0 = u.pm * BM + lr0, col0 = u.pn * BM + wc * 32 + 8 * fq;
#pragma unroll
        for (int ai = 0; ai < 2; ++ai)
#pragma unroll
            for (int m = 0; m < 4; ++m) { const int row = row0 + ai * HALF + m * 16;
                const float rs = rsl[u.z * 256 + lr0 + ai * HALF + m * 16];
                bf16* rowp = O + (size_t)row * ldc + col0;
#pragma unroll
                for (int bj = 0; bj < 2; ++bj) { const f32x4 v0 = acc[ai][bj][m][0] * rs, v1 = acc[ai][bj][m][1] * rs;
                    u32x4 w; w.x = cvt_pk_bf16(v0[0], v0[1]); w.y = cvt_pk_bf16(v0[2], v0[3]); w.z = cvt_pk_bf16(v1[0], v1[1]); w.w = cvt_pk_bf16(v1[2], v1[3]);
                    *(u32x4*)(rowp + bj * HALF) = w; }
                asm volatile("" ::: "memory"); }
    }
};
struct EpiF32 {
    static constexpr bool PERM = false;
    float* C; int ldc; int hi_pm; long hi_delta;
    DI void operator()(const f32x4 (&acc)[2][2][4][2], const Unit& u, int wr, int wc, int fr, int fq) const {
        const int row0 = u.pm * BM + wr * 64 + fr, col0 = u.pn * BM + wc * 32 + 4 * fq;
        float* Cb = C + (u.pm >= hi_pm ? hi_delta : 0L);
#pragma unroll
        for (int ai = 0; ai < 2; ++ai)
#pragma unroll
            for (int m = 0; m < 4; ++m) { float* rowp = Cb + (size_t)(row0 + ai * HALF + m * 16) * ldc + col0;
#pragma unroll
                for (int bj = 0; bj < 2; ++bj)
#pragma unroll
                    for (int n = 0; n < 2; ++n) *(f32x4*)(rowp + bj * HALF + n * 16) = acc[ai][bj][m][n]; }
    }
};
struct EpiBranch {
    static constexpr bool PERM = true;
    const bf16* proj; bf16* merged;
    DI void operator()(f32x4 (&acc)[2][2][4][2], const Unit& u, int wr, int wc, int fr, int fq) const {
        const int row0 = u.pm * BM + wr * 64 + fr, col0 = u.pn * BM + wc * 32 + 8 * fq;
        const int gz = u.z * 1024, gn = (u.z < 2 ? u.z + 1 : u.z) * 1024;
#pragma unroll
        for (int ai = 0; ai < 2; ++ai)
#pragma unroll
            for (int m = 0; m < 4; ++m) { const int row = row0 + ai * HALF + m * 16;
#pragma unroll
                for (int bj = 0; bj < 2; ++bj) { const int col = col0 + bj * HALF;
                    const bf16* gp = proj + (size_t)row * PC + C_GATE + col;
                    const u32x4 gw = *(const u32x4*)(gp + gz), gx = *(const u32x4*)(gp + gn);
                    f32x4 v0 = acc[ai][bj][m][0], v1 = acc[ai][bj][m][1];
                    float r[8];
#pragma unroll
                    for (int k = 0; k < 4; ++k) {
                        const float d0 = 1.0f + __builtin_amdgcn_exp2f(-1.4426950408889634f * bflo(gw[k])), d1 = 1.0f + __builtin_amdgcn_exp2f(-1.4426950408889634f * bfhi(gw[k]));
                        const float n0 = u.z < 2 ? 1.0f + __builtin_amdgcn_exp2f(-1.4426950408889634f * bflo(gx[k])) : 1.0f, n1 = u.z < 2 ? 1.0f + __builtin_amdgcn_exp2f(-1.4426950408889634f * bfhi(gx[k])) : 1.0f;
                        r[2 * k] = n0 * __builtin_amdgcn_rcpf(d0); r[2 * k + 1] = n1 * __builtin_amdgcn_rcpf(d1); }
                    v0[0] *= r[0]; v0[1] *= r[1]; v0[2] *= r[2]; v0[3] *= r[3]; v1[0] *= r[4]; v1[1] *= r[5]; v1[2] *= r[6]; v1[3] *= r[7];
                    if (u.z == 2) { u32x4 w; w.x = cvt_pk_bf16(v0[0], v0[1]); w.y = cvt_pk_bf16(v0[2], v0[3]); w.z = cvt_pk_bf16(v1[0], v1[1]); w.w = cvt_pk_bf16(v1[2], v1[3]);
                        *(u32x4*)(merged + (size_t)row * 1024 + col) = w; }
                    else { acc[ai][bj][m][0] = v0; acc[ai][bj][m][1] = v1; } }
                asm volatile("" ::: "memory"); }
    }
};
struct EpiOut {
    static constexpr bool PERM = true;
    const float* x; float* x1; bf16* xg; const float* gffn; float* ssp;
    DI void operator()(const f32x4 (&acc)[2][2][4][2], const Unit& u, int wr, int wc, int fr, int fq) const {
        const int row0 = u.pm * BM + wr * 64 + fr, col0 = u.pn * BM + wc * 32 + 8 * fq;
        f32x4 g0[2], g1[2];
#pragma unroll
        for (int bj = 0; bj < 2; ++bj) { g0[bj] = *(const f32x4*)(gffn + col0 + bj * HALF); g1[bj] = *(const f32x4*)(gffn + col0 + bj * HALF + 4); }
#pragma unroll
        for (int ai = 0; ai < 2; ++ai)
#pragma unroll
            for (int m = 0; m < 4; ++m) { const int row = row0 + ai * HALF + m * 16; float ss = 0.f;
#pragma unroll
                for (int bj = 0; bj < 2; ++bj) { const size_t off = (size_t)row * 1024 + col0 + bj * HALF;
                    const f32x4 v0 = acc[ai][bj][m][0] + *(const f32x4*)(x + off), v1 = acc[ai][bj][m][1] + *(const f32x4*)(x + off + 4);
                    __builtin_nontemporal_store(v0, (f32x4*)(x1 + off)); __builtin_nontemporal_store(v1, (f32x4*)(x1 + off + 4));
                    ss += (v0[0] * v0[0] + v0[1] * v0[1]) + (v0[2] * v0[2] + v0[3] * v0[3]) + (v1[0] * v1[0] + v1[1] * v1[1]) + (v1[2] * v1[2] + v1[3] * v1[3]);
                    const f32x4 a = v0 * g0[bj], b = v1 * g1[bj];
                    u32x4 w; w.x = cvt_pk_bf16(a[0], a[1]); w.y = cvt_pk_bf16(a[2], a[3]); w.z = cvt_pk_bf16(b[0], b[1]); w.w = cvt_pk_bf16(b[2], b[3]);
                    *(u32x4*)(xg + off) = w; }
                ss += __shfl_xor(ss, 16); ss += __shfl_xor(ss, 32);
                if (fq == 0) ssp[(size_t)row * 16 + u.pn * 4 + wc] = ss;
                asm volatile("" ::: "memory"); }
    }
};
struct QOrder : PlainOrder { int lo = 0, hi = 1 << 30;
    __device__ bool next(int i, Unit& u) const { i += lo; if (i >= hi || !tile(i, u)) return false; u.z = i; return true; } };
template <class Y> struct MixOrder {
    static constexpr bool KEEP_ACC = false;
    Y y; PlainOrder o; int ny, no, ins;
    __device__ void finish(int c) { Unit t; ny = 0; while (y.next(ny, t)) ++ny; no = 0; while (o.next(no, t)) ++no; ins = ny; (void)c; }
    __device__ bool next(int i, Unit& u) const {
        if (i >= ny + no) return false;
        if (i >= ins && i < ins + no) { (void)o.next(i - ins, u); u.z = 3; } else { (void)y.next(i < ins ? i : i - no, u); }
        return true;
    }
    DI const char* a_base(const Unit& u) const { const char* p = y.a_base(u); const long d = o.a_base(u) - p; return p + ((u.z == 3) ? d : 0L); }
    DI const char* b_base(const Unit& u) const { const char* p = y.b_base(u); const long d = o.b_base(u) - p; return p + ((u.z == 3) ? d : 0L); }
};
template <class EY> struct EpiMix {
    static constexpr bool PERM = true;
    EY ey; EpiOut eo;
    DI void operator()(const f32x4 (&acc)[2][2][4][2], const Unit& u, int wr, int wc, int fr, int fq) const { if (u.z == 3) eo(acc, u, wr, wc, fr, fq); else ey(acc, u, wr, wc, fr, fq); }
};
static_assert(EpiIn::PERM && EpiOut::PERM, "mixed streams need one weight staging order");

}

#define XB_TMO      128
#define XB_XCNT(j)  (256  + 64 * (j))
#define XB_XSUB(j)  (1280 + 64 * (j))
#define XB_XGEN(j)  (2304 + 64 * (j))
#define XB_TOP      3328
#define XB_TOPGEN   3392
#define XCD_BAR_WORDS 3456
#define XB_SPIN_CAP (1u << 18)
constexpr int CW_BAR = 4096;

DI unsigned xb_ld(unsigned* p)              { return __hip_atomic_load(p, __ATOMIC_RELAXED, __HIP_MEMORY_SCOPE_AGENT); }
DI unsigned xb_add(unsigned* p, unsigned v) { return __hip_atomic_fetch_add(p, v, __ATOMIC_RELAXED, __HIP_MEMORY_SCOPE_AGENT); }
DI unsigned xb_xcc_id() { return (unsigned)__builtin_amdgcn_s_getreg((3 << 11) | 20) & 0xFu; }
#define XB_SPIN(cond, bar) do { unsigned _sp = 0; while (cond) { __builtin_amdgcn_s_sleep(1); \
    if ((++_sp & 255u) == 0u) { if (xb_ld(&(bar)[XB_TMO])) break; if (_sp > XB_SPIN_CAP) { atomicAdd(&(bar)[XB_TMO], 1u); break; } } } } while (0)

struct XcdBarrier { unsigned* bar; unsigned x; volatile LAS unsigned* st; };

DI XcdBarrier xcd_barrier_post(unsigned* bar, volatile LAS unsigned* st) {
    XcdBarrier b; b.bar = bar; b.x = xb_xcc_id(); b.st = st;
    if (threadIdx.x == 0) (void)xb_add(&bar[XB_XCNT(b.x)], 1u);
    return b;
}
DI void xcd_barrier_complete(unsigned* bar, unsigned x, unsigned& nloc, unsigned& nx) {
    const unsigned G = gridDim.x * gridDim.y * gridDim.z;
    unsigned sum, cnt, mine, sp = 0u;
    for (;;) {
        sum = 0u; cnt = 0u; mine = 0u;
#pragma unroll
        for (unsigned j = 0; j < 16; ++j) { const unsigned c = xb_ld(&bar[XB_XCNT(j)]); sum += c; cnt += (c > 0u) ? 1u : 0u; mine = (j == x) ? c : mine; }
        if (sum == G) break;
        __builtin_amdgcn_s_sleep(1);
        if ((++sp & 255u) == 0u) { if (xb_ld(&bar[XB_TMO])) break; if (sp > XB_SPIN_CAP) { atomicAdd(&bar[XB_TMO], 1u); break; } }
    }
    nloc = mine > 0u ? mine : 1u; nx = cnt > 0u ? cnt : 1u;
}
DI void xcd_barrier(const XcdBarrier& b) {
    asm volatile("s_waitcnt vmcnt(0)" ::: "memory");
    __syncthreads();
    if (threadIdx.x == 0) {
        unsigned* bar = b.bar;
        __builtin_amdgcn_s_waitcnt(0);
        unsigned nloc = b.st[0], nx = b.st[1];
        if (nloc == 0u) { xcd_barrier_complete(bar, b.x, nloc, nx); b.st[0] = nloc; b.st[1] = nx; }
        const unsigned old = xb_add(&bar[XB_XSUB(b.x)], 1u);
        const unsigned gen = old / nloc;
        if (old + 1u == (gen + 1u) * nloc) {
            __builtin_amdgcn_fence(__ATOMIC_RELEASE, "agent");
            asm volatile("s_waitcnt vmcnt(0)" ::: "memory");
            const unsigned og = xb_add(&bar[XB_TOP], 1u);
            const unsigned tg = og / nx;
            if (og + 1u == (tg + 1u) * nx) xb_add(&bar[XB_TOPGEN], 1u);
            else XB_SPIN((int)(xb_ld(&bar[XB_TOPGEN]) - tg) <= 0, bar);
            __builtin_amdgcn_fence(__ATOMIC_ACQUIRE, "agent");
            xb_add(&bar[XB_XGEN(b.x)], 1u);
            asm volatile("s_waitcnt vmcnt(0)" ::: "memory");
        } else {
            XB_SPIN((int)(xb_ld(&bar[XB_XGEN(b.x)]) - gen) <= 0, bar);
            __builtin_amdgcn_fence(__ATOMIC_ACQUIRE, "agent");
            asm volatile("s_waitcnt vmcnt(0)" ::: "memory");
        }
    }
    __syncthreads();
}

DI void xcd_barrier_arrive(const XcdBarrier& b) {
    asm volatile("s_waitcnt vmcnt(0)" ::: "memory");
    __syncthreads();
    if (threadIdx.x == 0) {
        unsigned* bar = b.bar;
        __builtin_amdgcn_s_waitcnt(0);
        unsigned nloc = b.st[0], nx = b.st[1];
        if (nloc == 0u) { xcd_barrier_complete(bar, b.x, nloc, nx); b.st[0] = nloc; b.st[1] = nx; }
        const unsigned old = xb_add(&bar[XB_XSUB(b.x)], 1u);
        const unsigned gen = old / nloc;
        unsigned last = 0u;
        if (old + 1u == (gen + 1u) * nloc) {
            __builtin_amdgcn_fence(__ATOMIC_RELEASE, "agent");
            asm volatile("s_waitcnt vmcnt(0)" ::: "memory");
            const unsigned og = xb_add(&bar[XB_TOP], 1u);
            if (og + 1u == (og / nx + 1u) * nx) xb_add(&bar[XB_TOPGEN], 1u);
            last = 1u;
        }
        b.st[2] = last; b.st[3] = gen;
    }
}
DI void xcd_barrier_wait(const XcdBarrier& b) {
    if (threadIdx.x == 0) {
        unsigned* bar = b.bar;
        const unsigned last = b.st[2], gen = b.st[3];
        XB_SPIN((int)(xb_ld(&bar[XB_TOPGEN]) - gen) <= 0, bar);
        __builtin_amdgcn_fence(__ATOMIC_ACQUIRE, "agent");
        if (last) xb_add(&bar[XB_XGEN(b.x)], 1u);
        asm volatile("s_waitcnt vmcnt(0)" ::: "memory");
    }
    __syncthreads();
}

struct Frame {
    LAS unsigned char* lds;
    int tid, lane, wave;
    DI void refresh() { int t = threadIdx.x; asm volatile("" : "+v"(t)); tid = t; lane = t & 63; wave = __builtin_amdgcn_readfirstlane(t >> 6); }
    int vcu, G;
    const float *x, *mem, *norm_mix_g, *w_in, *hg_lb, *hg_norm_g, *sc_conv_w, *mem_norm_g, *w_mem_kv, *w_branch, *w_out, *norm_ffn_g, *peer_w_q, *peer_sub_keys, *peer_u, *peer_v, *final_norm_g;
    float* out; unsigned char* ws;
};

DI void p0_transpose_item(const float* W, int K, int N, bf16* WT, LAS float* scr, int item, int lane) {
    const int nblk = N / 32, kb = item / nblk, nb = item % nblk, k0 = 64 * kb, n0 = 32 * nb;
#pragma unroll 8
    for (int i = 0; i < 32; ++i) { const int kk = 2 * i + (lane >> 5); scr[kk * 33 + (lane & 31)] = W[(size_t)(k0 + kk) * N + n0 + (lane & 31)]; }
    asm volatile("s_waitcnt lgkmcnt(0)" ::: "memory");
    const int c = lane & 7;
#pragma unroll
    for (int j = 0; j < 4; ++j) { const int n = (lane >> 3) + 8 * j; const LAS float* s = scr + (8 * c) * 33 + n;
        u32x4 o; o.x = pk2(s[0 * 33], s[1 * 33]); o.y = pk2(s[2 * 33], s[3 * 33]); o.z = pk2(s[4 * 33], s[5 * 33]); o.w = pk2(s[6 * 33], s[7 * 33]);
        *(u32x4*)(WT + (size_t)(n0 + n) * K + k0 + 8 * c) = o; }
    asm volatile("s_waitcnt lgkmcnt(0)" ::: "memory");
}
DI void rms_row_to_bf16(const float* xrow, const float* g, bf16* orow, int lane, bool stream = false) {
    const f32x4* xr = (const f32x4*)xrow + lane; const f32x4* gr = (const f32x4*)g + lane;
    f32x4 v[4]; float s = 0.f;
#pragma unroll
    for (int j = 0; j < 4; ++j) { v[j] = xr[64 * j]; s += (v[j].x * v[j].x + v[j].y * v[j].y) + (v[j].z * v[j].z + v[j].w * v[j].w); }
    const float rstd = 1.0f / sqrtf(wave_sum(s) * (1.f / 1024.f) + EPS);
    unsigned long long* o8 = (unsigned long long*)orow + lane;
#pragma unroll
    for (int j = 0; j < 4; ++j) { const f32x4 gg = gr[64 * j]; const f32x4 y = v[j] * rstd * gg;
        const unsigned long long w = (unsigned long long)pk2(y.x, y.y) | ((unsigned long long)pk2(y.z, y.w) << 32);
        if (stream) __builtin_nontemporal_store(w, o8 + 64 * j); else o8[64 * j] = w; }
}
DI void p0_prologue(Frame& F) {
    F.refresh();
    LAS float* scr = (LAS float*)(F.lds + F.wave * 16384);
    const int gw = F.vcu * NWAVES + F.wave, NGW = F.G * NWAVES;
    unsigned char* ws = F.ws;
    constexpr int I_IN = (1024 / 64) * (PC / 32), I_KV = (1024 / 64) * (1024 / 32), I_BR = (512 / 64) * (1024 / 32), I_OUT = (1024 / 64) * (1024 / 32), I_Q = (1024 / 64) * (2048 / 32);
    constexpr int NITEMS = I_IN + I_KV + 3 * I_BR + I_OUT + I_Q;
    for (int it = gw; it < NITEMS; it += NGW) {
        int r = it;
        if (r < I_IN) { p0_transpose_item(F.w_in, 1024, PC, (bf16*)(ws + WS_WIN), scr, r, F.lane); continue; } r -= I_IN;
        if (r < I_KV) { p0_transpose_item(F.w_mem_kv, 1024, 1024, (bf16*)(ws + WS_WKV), scr, r, F.lane); continue; } r -= I_KV;
        if (r < 3 * I_BR) { const int n = r / I_BR; p0_transpose_item(F.w_branch + (size_t)n * 512 * 1024, 512, 1024, (bf16*)(ws + WS_WBR) + (size_t)n * 1024 * 512, scr, r % I_BR, F.lane); continue; } r -= 3 * I_BR;
        if (r < I_OUT) { p0_transpose_item(F.w_out, 1024, 1024, (bf16*)(ws + WS_WOUT), scr, r, F.lane); continue; } r -= I_OUT;
        p0_transpose_item(F.peer_w_q, 1024, 2048, (bf16*)(ws + WS_WQ), scr, r, F.lane);
    }
    const int gt = F.vcu * 512 + F.tid, NGT = F.G * 512;
    for (int it = gt; it < 8 * 256 * 32; it += NGT) {
        const int c8 = it & 31, row = (it >> 5) & 255, h = it >> 13, p = row >> 7, key = row & 127;
        u32x4 o = (u32x4){0u, 0u, 0u, 0u};
        if ((c8 >> 4) == p) { const float* s = F.peer_sub_keys + (((size_t)(h * 2 + p) * 128 + key) * 128 + (c8 & 15) * 8);
            const f32x4 a = *(const f32x4*)s, b = *(const f32x4*)(s + 4); o.x = pk2(a.x, a.y); o.y = pk2(a.z, a.w); o.z = pk2(b.x, b.y); o.w = pk2(b.z, b.w); }
        *(u32x4*)((bf16*)(ws + WS_KBD) + ((size_t)(h * 256 + row) * 256 + c8 * 8)) = o;
    }
    for (int it = gt; it < 1024; it += NGT) { const float a0 = F.hg_lb[it], a1 = F.hg_lb[1024 + it]; const float m = fmaxf(a0, a1); const float e0 = __expf(a0 - m), e1 = __expf(a1 - m);
        ((float*)(ws + WS_LB))[it] = e0 / (e0 + e1); }
    for (int m = gw; m < BATCH * NMEM; m += NGW) rms_row_to_bf16(F.mem + (size_t)m * 1024, F.mem_norm_g, (bf16*)(ws + WS_MN) + (size_t)m * 1024, F.lane);
    for (int m0 = gw; m0 < T_ALL; m0 += NGW) { const int m = m0 < TG ? m0 + TG : m0 - TG;
        rms_row_to_bf16(F.x + (size_t)m * 1024, F.norm_mix_g, (bf16*)(ws + WS_XG) + (size_t)m * 1024, F.lane, m >= TG); }
}

DI s16x4 tr16(const LAS unsigned char* p) { return __builtin_bit_cast(s16x4, __builtin_amdgcn_ds_read_tr16_b64_v4i16((LAS v4i16_t*)p)); }
DI bf16x8 cat8(s16x4 lo, s16x4 hi) { return __builtin_shufflevector(lo, hi, 0, 1, 2, 3, 4, 5, 6, 7); }
#define MFMA32(a, b, c) __builtin_amdgcn_mfma_f32_32x32x16_bf16((a), (b), (c), 0, 0, 0)
DI int crow(int reg, int h) { return (reg & 3) + 8 * (reg >> 2) + 4 * h; }
DI bf16x8 pack8(const f32x16& x, int s) {
    u32x4 p; p.x = cvtpk(x[8 * s], x[8 * s + 1]); p.y = cvtpk(x[8 * s + 2], x[8 * s + 3]); p.z = cvtpk(x[8 * s + 4], x[8 * s + 5]); p.w = cvtpk(x[8 * s + 6], x[8 * s + 7]);
    return __builtin_bit_cast(bf16x8, p);
}
constexpr int TS = 272;

DI void stage_tile(LAS unsigned char* tile, const bf16* src, int tid) {
#pragma unroll
    for (int i = 0; i < 2; ++i) { const int id = tid + 512 * i, c = id >> 4, ch = id & 15;
        *(LAS u32x4*)(tile + c * TS + ch * 16) = __builtin_nontemporal_load((const u32x4*)(src + (size_t)c * PC + ch * 8)); }
}
DI float touch_tile(const bf16* src, int i128) { return *(const float*)(src + (size_t)(i128 >> 1) * PC + (i128 & 1) * 64); }
DI void gate8(const LAS unsigned char* zt, int dp, int ts, f32x2 lb, f32x2 (&L)[8], f32x2 (&kk)[8], f32x2 (&lf)[8]) {
    f32x2 run = (f32x2){0.f, 0.f}; const f32x2 oml = 1.0f - lb;
#pragma unroll
    for (int i = 0; i < 8; ++i) { const unsigned w = *(const LAS unsigned*)(zt + (8 * ts + i) * TS + 4 * dp);
        const f32x2 sg = (f32x2){fast_sig(bflo(w)), fast_sig(bfhi(w))}; const f32x2 f = lb + oml * sg;
        lf[i] = (f32x2){__builtin_amdgcn_logf(f.x), __builtin_amdgcn_logf(f.y)}; kk[i] = oml * (1.0f - sg); run += lf[i]; L[i] = run; }
}
DI f32x2 exp2x2(f32x2 v) { return (f32x2){__builtin_amdgcn_exp2f(v.x), __builtin_amdgcn_exp2f(v.y)}; }
struct SliceSums { f32x2 offf, offb, glf, glb, greff, grefb; };
DI SliceSums slice_sums(const LAS float* tot, int dp, int ts) {
    SliceSums r; f32x2 tf[8], tb[8];
#pragma unroll
    for (int j = 0; j < 8; ++j) { tf[j] = *(const LAS f32x2*)(tot + j * 128 + 2 * dp); tb[j] = *(const LAS f32x2*)(tot + (8 + j) * 128 + 2 * dp); }
    r.offf = (f32x2){0.f, 0.f}; r.offb = (f32x2){0.f, 0.f};
#pragma unroll
    for (int j = 0; j < 8; ++j) { if (j < ts) r.offf += tf[j]; if (j > ts) r.offb += tb[j]; }
    r.greff = (tf[0] + tf[1]) + (tf[2] + tf[3]); r.glf = r.greff + ((tf[4] + tf[5]) + (tf[6] + tf[7]));
    r.grefb = (tb[4] + tb[5]) + (tb[6] + tb[7]); r.glb = r.grefb + ((tb[0] + tb[1]) + (tb[2] + tb[3]));
    return r;
}

DI void hgrn_a_item(Frame& F, int item, bool has_next) {
    F.refresh();
    constexpr int T_V = 0, T_KF = 17408, T_KB = 34816, TOT = 52224;
    LAS unsigned char* lds = F.lds;
    const int n = item & 31, h = (item >> 5) & 3, b = item >> 7;
    const bf16* proj = (const bf16*)(F.ws + WS_PROJ) + ((size_t)b * SEQ + n * CHUNK) * PC;
    const int tid = F.tid, dp = tid & 63, ts = F.wave;
    const float* lbp = (const float*)(F.ws + WS_LB);
    const f32x2 lbf = *(const f32x2*)(lbp + h * 128 + 2 * dp), lbb = *(const f32x2*)(lbp + 512 + h * 128 + 2 * dp);
    stage_tile(lds + T_V, proj + C_HI + h * 128, tid); stage_tile(lds + T_KF, proj + C_FF + h * 128, tid); stage_tile(lds + T_KB, proj + C_FB + h * 128, tid);
    float tch = 0.f;
    if (has_next) { const bf16* pn = proj + (size_t)CHUNK * PC + h * 128; const int i128 = tid & 127, wsel = tid >> 7; tch = touch_tile(pn + (wsel == 0 ? C_HI : wsel == 1 ? C_FF : C_FB), i128); }
    __syncthreads();
    f32x2 Lf[8], kf[8], lff[8], Lb[8], kb[8], lfb[8];
    gate8(lds + T_KF, dp, ts, lbf, Lf, kf, lff);
    gate8(lds + T_KB, dp, ts, lbb, Lb, kb, lfb);
    LAS float* tot = (LAS float*)(lds + TOT);
    *(LAS f32x2*)(tot + ts * 128 + 2 * dp) = Lf[7]; *(LAS f32x2*)(tot + (8 + ts) * 128 + 2 * dp) = Lb[7];
    asm volatile("" :: "v"(tch));
    __syncthreads();
    const SliceSums ss = slice_sums(tot, dp, ts);
    const f32x2 tbq = Lb[7];
#pragma unroll
    for (int i = 0; i < 8; ++i) { const int c = 8 * ts + i;
        const f32x2 G = ss.offf + Lf[i]; const f32x2 kd = kf[i] * exp2x2(ss.glf - G);
        const f32x2 Gb = ss.offb + (tbq - Lb[i] + lfb[i]); const f32x2 kdb = kb[i] * exp2x2(ss.glb - Gb);
        *(LAS unsigned*)(lds + T_KF + c * TS + 4 * dp) = cvtpk(kd.x, kd.y); *(LAS unsigned*)(lds + T_KB + c * TS + 4 * dp) = cvtpk(kdb.x, kdb.y); }
    if (ts == 0) { float* dec = (float*)(F.ws + WS_DEC) + (size_t)item * 256; *(f32x2*)(dec + 2 * dp) = exp2x2(ss.glf); *(f32x2*)(dec + 128 + 2 * dp) = exp2x2(ss.glb); }
    __syncthreads();
    const int w = F.wave, lane = F.lane, r = lane & 31, hh = lane >> 5, blk = (lane >> 4) & 1, q = (lane & 15) >> 2, p = lane & 3;
    const int dt = w >> 1, et0 = (w & 1) * 2;
#pragma unroll
    for (int dir = 0; dir < 2; ++dir) { const int TK = dir ? T_KB : T_KF;
#pragma unroll
        for (int e2 = 0; e2 < 2; ++e2) { const int et = et0 + e2; f32x16 acc;
#pragma unroll
            for (int i = 0; i < 16; ++i) acc[i] = 0.f;
#pragma unroll
            for (int ks = 0; ks < 4; ++ks) {
                const LAS unsigned char* ap = lds + TK + (16 * ks + 8 * hh + q) * TS + (32 * dt + 16 * blk + 4 * p) * 2;
                const LAS unsigned char* bp = lds + T_V + (16 * ks + 8 * hh + q) * TS + (32 * et + 16 * blk + 4 * p) * 2;
                const bf16x8 a = cat8(tr16(ap), tr16(ap + 4 * TS)), bq = cat8(tr16(bp), tr16(bp + 4 * TS));
                acc = MFMA32(a, bq, acc); }
            bf16* dsb = (bf16*)(F.ws + WS_DS) + ((size_t)(item * 2 + dir) * 128 + 32 * et + r) * 128 + 32 * dt + 4 * hh;
#pragma unroll
            for (int g4 = 0; g4 < 4; ++g4) { u32x2 wv; wv.x = cvtpk(acc[4 * g4], acc[4 * g4 + 1]); wv.y = cvtpk(acc[4 * g4 + 2], acc[4 * g4 + 3]); *(u32x2*)(dsb + 8 * g4) = wv; } } }
    __syncthreads();
}

DI void hgrn_scan(Frame& F) {
    F.refresh();
    const bf16* dS = (const bf16*)(F.ws + WS_DS); bf16* Sst = (bf16*)((unsigned char*)F.out + OUT_SST); const float* dec = (const float*)(F.ws + WS_DEC);
    const int gt = F.vcu * 512 + F.tid, NGT = F.G * 512;
    for (int id = gt; id < BG * 4 * 2 * 128 * 32; id += NGT) {
        const int d4 = id & 31, e = (id >> 5) & 127, dir = (id >> 12) & 1, bh = id >> 13;
        f32x4 S = (f32x4){0.f, 0.f, 0.f, 0.f};
#pragma unroll 4
        for (int s = 0; s < 32; ++s) { const int n = dir ? 31 - s : s, item = bh * 32 + n;
            const size_t off = ((size_t)(item * 2 + dir) * 128 + e) * 128 + d4 * 4;
            u32x2 o; o.x = cvtpk(S.x, S.y); o.y = cvtpk(S.z, S.w); __builtin_nontemporal_store(o, (u32x2*)(Sst + off));
            const f32x4 dc = *(const f32x4*)(dec + (size_t)(item * 2 + dir) * 128 + d4 * 4);
            const u32x2 wv = __builtin_nontemporal_load((const u32x2*)(dS + off));
            S.x = dc.x * S.x + bflo(wv.x); S.y = dc.y * S.y + bfhi(wv.x); S.z = dc.z * S.z + bflo(wv.y); S.w = dc.w * S.w + bfhi(wv.y); }
    }
}

DI void hgrn_c_item(Frame& F, int item, bool has_next) {
    F.refresh();
    constexpr int T_QRF = 0, T_KRF = 17408, T_QGF = 34816, T_QRB = 52224, T_KRB = 69632, T_QGB = 87040, T_V = 104448, TOT = 121856, O_OFF = 0, OS = 132;
    LAS unsigned char* lds = F.lds;
    const int n = item & 31, h = (item >> 5) & 3, b = item >> 7;
    const size_t row0 = (size_t)b * SEQ + n * CHUNK;
    const bf16* proj = (const bf16*)(F.ws + WS_PROJ) + row0 * PC;
    const int tid = F.tid, dp = tid & 63, ts = F.wave;
    const float* lbp = (const float*)(F.ws + WS_LB);
    const f32x2 lbf = *(const f32x2*)(lbp + h * 128 + 2 * dp), lbb = *(const f32x2*)(lbp + 512 + h * 128 + 2 * dp);
    stage_tile(lds + T_V, proj + C_HI + h * 128, tid); stage_tile(lds + T_KRF, proj + C_FF + h * 128, tid); stage_tile(lds + T_KRB, proj + C_FB + h * 128, tid); stage_tile(lds + T_QRF, proj + C_HQ + h * 128, tid);
    float tch = 0.f, tch2 = 0.f;
    if (has_next) { const bf16* pn = proj + (size_t)CHUNK * PC + h * 128; const int i128 = tid & 127, wsel = tid >> 7; tch = touch_tile(pn + (wsel == 0 ? C_HI : wsel == 1 ? C_FF : wsel == 2 ? C_FB : C_HQ), i128);
        tch2 = *(const float*)((const unsigned char*)F.out + OUT_SST + (size_t)(item + 1) * 65536 + (size_t)tid * 128); }
    __syncthreads();
    f32x2 qv[8];
#pragma unroll
    for (int i = 0; i < 8; ++i) { const unsigned w = *(const LAS unsigned*)(lds + T_QRF + (8 * ts + i) * TS + 4 * dp); const float z0 = bflo(w), z1 = bfhi(w); qv[i] = (f32x2){z0 * fast_sig(z0), z1 * fast_sig(z1)}; }
    f32x2 Lf[8], kf[8], lff[8], Lb[8], kb[8], lfb[8];
    gate8(lds + T_KRF, dp, ts, lbf, Lf, kf, lff);
    gate8(lds + T_KRB, dp, ts, lbb, Lb, kb, lfb);
    LAS float* tot = (LAS float*)(lds + TOT);
    *(LAS f32x2*)(tot + ts * 128 + 2 * dp) = Lf[7]; *(LAS f32x2*)(tot + (8 + ts) * 128 + 2 * dp) = Lb[7];
    asm volatile("" :: "v"(tch), "v"(tch2));
    __syncthreads();
    {
        const SliceSums ss = slice_sums(tot, dp, ts);
        const f32x2 tbq = Lb[7];
#pragma unroll
        for (int i = 0; i < 8; ++i) { const int c = 8 * ts + i; const int o = c * TS + 4 * dp;
            const f32x2 G = ss.offf + Lf[i]; const f32x2 x = G - ss.greff;
            const f32x2 qr = qv[i] * exp2x2(x), kr = kf[i] * exp2x2(-x), qg = qv[i] * exp2x2(G);
            *(LAS unsigned*)(lds + T_QRF + o) = cvtpk(qr.x, qr.y); *(LAS unsigned*)(lds + T_KRF + o) = cvtpk(kr.x, kr.y); *(LAS unsigned*)(lds + T_QGF + o) = cvtpk(qg.x, qg.y);
            const f32x2 Gb = ss.offb + (tbq - Lb[i] + lfb[i]); const f32x2 xb = Gb - ss.grefb;
            const f32x2 qrb = qv[i] * exp2x2(xb), krb = kb[i] * exp2x2(-xb), qgb = qv[i] * exp2x2(Gb);
            *(LAS unsigned*)(lds + T_QRB + o) = cvtpk(qrb.x, qrb.y); *(LAS unsigned*)(lds + T_KRB + o) = cvtpk(krb.x, krb.y); *(LAS unsigned*)(lds + T_QGB + o) = cvtpk(qgb.x, qgb.y); }
    }
    __syncthreads();
    const int w = F.wave, lane = F.lane, r = lane & 31, hh = lane >> 5, blk = (lane >> 4) & 1, q = (lane & 15) >> 2, p = lane & 3;
    const int ct = w >> 2, et = w & 3;
    const bf16* Sst = (const bf16*)((const unsigned char*)F.out + OUT_SST);
    f32x16 o;
#pragma unroll
    for (int i = 0; i < 16; ++i) o[i] = 0.f;
#pragma unroll
    for (int dir = 0; dir < 2; ++dir) { const int TQR = dir ? T_QRB : T_QRF, TKR = dir ? T_KRB : T_KRF, TQG = dir ? T_QGB : T_QGF;
#pragma unroll
        for (int st = 0; st < 2; ++st) {
            if (dir == 0 ? (st > ct) : (st < ct)) continue;
            f32x16 X;
#pragma unroll
            for (int i = 0; i < 16; ++i) X[i] = 0.f;
#pragma unroll
            for (int ks = 0; ks < 8; ++ks) { const bf16x8 a = *(const LAS bf16x8*)(lds + TKR + (32 * st + r) * TS + (16 * ks + 8 * hh) * 2), bq = *(const LAS bf16x8*)(lds + TQR + (32 * ct + r) * TS + (16 * ks + 8 * hh) * 2);
                X = MFMA32(a, bq, X); }
            const int cc = 32 * ct + r;
#pragma unroll
            for (int i = 0; i < 16; ++i) { const int s = 32 * st + crow(i, hh); const bool keep = dir == 0 ? (s <= cc) : (s >= cc); X[i] = keep ? X[i] : 0.f; }
#pragma unroll
            for (int s2 = 0; s2 < 2; ++s2) { const bf16x8 xs = pack8(X, s2);
                const LAS unsigned char* vp = lds + T_V + (32 * st + 16 * s2 + 4 * hh + q) * TS + (32 * et + 16 * blk + 4 * p) * 2;
                const bf16x8 pb = cat8(tr16(vp), tr16(vp + 8 * TS));
                o = MFMA32(xs, pb, o); }
        }
        const bf16* sp = Sst + ((size_t)(item * 2 + dir) * 128 + 32 * et + r) * 128 + 8 * hh;
#pragma unroll
        for (int ks = 0; ks < 8; ++ks) { const bf16x8 a = *(const LAS bf16x8*)(lds + TQG + (32 * ct + r) * TS + (16 * ks + 8 * hh) * 2); const bf16x8 bq = *(const bf16x8*)(sp + 16 * ks);
            o = MFMA32(a, bq, o); }
    }
    unsigned hw[8];
#pragma unroll
    for (int k = 0; k < 8; ++k) hw[k] = *(const unsigned*)(proj + (size_t)(8 * w + k) * PC + C_HG + h * 128 + 2 * lane);
    __syncthreads();
    LAS float* O = (LAS float*)(lds + O_OFF);
#pragma unroll
    for (int i = 0; i < 16; ++i) O[(32 * ct + crow(i, hh)) * OS + 32 * et + r] = o[i];
    __syncthreads();
    const f32x2 gn = *(const f32x2*)(F.hg_norm_g + h * 128 + 2 * lane);
    bf16* yhg = (bf16*)(F.ws + WS_YHG);
    const int a16 = (lane ^ 16) << 2, a32 = (lane ^ 32) << 2;
#pragma unroll
    for (int k = 0; k < 8; ++k) { const int c = 8 * w + k; const f32x2 v = *(const LAS f32x2*)(O + c * OS + 2 * lane);
        float ss = row_sum16(v.x * v.x + v.y * v.y); ss += bperm_f(a16, ss); ss += bperm_f(a32, ss);
        const float rstd = __builtin_amdgcn_rsqf(ss * (1.0f / 128.0f) + EPS);
        const float z0 = bflo(hw[k]), z1 = bfhi(hw[k]);
        const float y0 = v.x * rstd * gn.x * (z0 * fast_sig(z0)), y1 = v.y * rstd * gn.y * (z1 * fast_sig(z1));
        *(unsigned*)(yhg + (row0 + c) * 512 + h * 128 + 2 * lane) = cvtpk(y0, y1); }
    __syncthreads();
}

DI void attn_item(Frame& F, int g, int item) {
    F.refresh();
    constexpr int KS = 272, VS = 528, K_OFF = 0, V_OFF = 69632;
    LAS unsigned char* lds = F.lds;
    const int qb = item & 7, h = (item >> 3) & 3, b = item >> 5, bglob = g * BG + b;
    const bf16* Km = (const bf16*)(F.ws + WS_KMEM) + (size_t)bglob * 256 * 512 + h * 128;
    const bf16* VT = (const bf16*)(F.ws + WS_VT) + (size_t)(h * 128) * 4096 + bglob * 256;
    const int tid = F.tid;
#pragma unroll
    for (int i = 0; i < 8; ++i) { const int id = tid + 512 * i, key = id >> 4, ch = id & 15;
        *(LAS u32x4*)(lds + K_OFF + key * KS + ch * 16) = *(const u32x4*)(Km + (size_t)key * 512 + ch * 8); }
#pragma unroll
    for (int i = 0; i < 8; ++i) { const int id = tid + 512 * i, e = id >> 5, ch = id & 31;
        *(LAS u32x4*)(lds + V_OFF + e * VS + ch * 16) = *(const u32x4*)(VT + (size_t)e * 4096 + ch * 8); }
    __syncthreads();
    const int w = F.wave, lane = F.lane, r = lane & 31, hh = lane >> 5;
    const size_t qrow0 = (size_t)b * SEQ + qb * 256 + w * 32;
    const bf16* proj = (const bf16*)(F.ws + WS_PROJ);
    bf16x8 qf[8];
#pragma unroll
    for (int ks = 0; ks < 8; ++ks) qf[ks] = *(const bf16x8*)(proj + (qrow0 + r) * PC + C_MQ + h * 128 + 16 * ks + 8 * hh);
    const float scale = 0.08838834764831845f;
    float m_run = -INFINITY, l_run = 0.f;
#pragma unroll 1
    for (int kt = 0; kt < 8; ++kt) {
        f32x16 X;
#pragma unroll
        for (int i = 0; i < 16; ++i) X[i] = 0.f;
#pragma unroll
        for (int ks = 0; ks < 8; ++ks) { const bf16x8 a = *(const LAS bf16x8*)(lds + K_OFF + (32 * kt + r) * KS + (16 * ks + 8 * hh) * 2); X = MFMA32(a, qf[ks], X); }
        float tm = X[0];
#pragma unroll
        for (int i = 1; i < 16; ++i) tm = fmaxf(tm, X[i]);
        tm *= scale;
        const float mn = fmaxf(m_run, tm); float ls = 0.f;
#pragma unroll
        for (int i = 0; i < 16; ++i) ls += __expf(X[i] * scale - mn);
        l_run = l_run * __expf(m_run - mn) + ls; m_run = mn;
    }
    { const float mo = __shfl_xor(m_run, 32), lo = __shfl_xor(l_run, 32); const float m = fmaxf(m_run, mo);
      l_run = l_run * __expf(m_run - m) + lo * __expf(mo - m); m_run = m; }
    const float inv_l = 1.0f / l_run;
    f32x16 O[4];
#pragma unroll
    for (int e = 0; e < 4; ++e)
#pragma unroll
        for (int i = 0; i < 16; ++i) O[e][i] = 0.f;
#pragma unroll 1
    for (int kt = 0; kt < 8; ++kt) {
        f32x16 X;
#pragma unroll
        for (int i = 0; i < 16; ++i) X[i] = 0.f;
#pragma unroll
        for (int ks = 0; ks < 8; ++ks) { const bf16x8 a = *(const LAS bf16x8*)(lds + K_OFF + (32 * kt + r) * KS + (16 * ks + 8 * hh) * 2); X = MFMA32(a, qf[ks], X); }
#pragma unroll
        for (int i = 0; i < 16; ++i) X[i] = __expf(X[i] * scale - m_run) * inv_l;
#pragma unroll
        for (int s2 = 0; s2 < 2; ++s2) { const bf16x8 xs = pack8(X, s2);
#pragma unroll
            for (int e = 0; e < 4; ++e) { const LAS unsigned char* vp = lds + V_OFF + (32 * e + r) * VS + (32 * kt + 16 * s2 + 4 * hh) * 2;
                const bf16x8 pb = cat8(*(const LAS s16x4*)vp, *(const LAS s16x4*)(vp + 16));
                O[e] = MFMA32(xs, pb, O[e]); } }
    }
    bf16* ymx = (bf16*)(F.ws + WS_YMX);
#pragma unroll
    for (int e = 0; e < 4; ++e)
#pragma unroll
        for (int i = 0; i < 16; ++i) ymx[(qrow0 + crow(i, hh)) * 512 + h * 128 + 32 * e + r] = (bf16)f2bf(O[e][i]);
    __syncthreads();
}

DI void conv_phase(Frame& F) {
    F.refresh();
    const bf16* proj = (const bf16*)(F.ws + WS_PROJ); bf16* ysc = (bf16*)(F.ws + WS_YSC); const float* cw = F.sc_conv_w;
    const int gt = F.vcu * 512 + F.tid, NGT = F.G * 512;
    for (int id = gt; id < TG * 64; id += NGT) {
        const int c8 = id & 63, t = id >> 6, ts = t & (SEQ - 1);
        const bf16* pr = proj + (size_t)t * PC + c8 * 8;
        const u32x4 z4 = (u32x4){0u, 0u, 0u, 0u};
        const u32x4 sb = *(const u32x4*)(pr + C_SB), c1 = *(const u32x4*)(pr + C_SC), h1 = *(const u32x4*)(pr + C_SH);
        const u32x4 c0 = ts > 0 ? *(const u32x4*)(pr - PC + C_SC) : z4, h0 = ts > 0 ? *(const u32x4*)(pr - PC + C_SH) : z4;
        const u32x4 c2 = ts < SEQ - 1 ? *(const u32x4*)(pr + PC + C_SC) : z4, h2 = ts < SEQ - 1 ? *(const u32x4*)(pr + PC + C_SH) : z4;
        const f32x4 wa0 = *(const f32x4*)(cw + c8 * 8), wa1 = *(const f32x4*)(cw + c8 * 8 + 4), wb0 = *(const f32x4*)(cw + 512 + c8 * 8), wb1 = *(const f32x4*)(cw + 512 + c8 * 8 + 4),
                    wc0 = *(const f32x4*)(cw + 1024 + c8 * 8), wc1 = *(const f32x4*)(cw + 1024 + c8 * 8 + 4);
        float y[8];
#pragma unroll
        for (int k = 0; k < 4; ++k) {
            const float w0l = k < 2 ? wa0[2 * k] : wa1[2 * k - 4], w0h = k < 2 ? wa0[2 * k + 1] : wa1[2 * k - 3];
            const float w1l = k < 2 ? wb0[2 * k] : wb1[2 * k - 4], w1h = k < 2 ? wb0[2 * k + 1] : wb1[2 * k - 3];
            const float w2l = k < 2 ? wc0[2 * k] : wc1[2 * k - 4], w2h = k < 2 ? wc0[2 * k + 1] : wc1[2 * k - 3];
            y[2 * k]     = bflo(sb[k]) * (w0l * (bflo(c0[k]) * bflo(h0[k])) + w1l * (bflo(c1[k]) * bflo(h1[k])) + w2l * (bflo(c2[k]) * bflo(h2[k])));
            y[2 * k + 1] = bfhi(sb[k]) * (w0h * (bfhi(c0[k]) * bfhi(h0[k])) + w1h * (bfhi(c1[k]) * bfhi(h1[k])) + w2h * (bfhi(c2[k]) * bfhi(h2[k]))); }
        u32x4 o; o.x = cvtpk(y[0], y[1]); o.y = cvtpk(y[2], y[3]); o.z = cvtpk(y[4], y[5]); o.w = cvtpk(y[6], y[7]);
        *(u32x4*)(ysc + (size_t)t * 512 + c8 * 8) = o;
    }
}

DI unsigned ord_key(float v, int idx) { unsigned u = __builtin_bit_cast(unsigned, v); u ^= (u >> 31) ? 0xFFFFFFFFu : 0x80000000u; return (u & 0xFFFFFF80u) | (unsigned)(127 - idx); }
DI float key_val(unsigned k) { unsigned u = k & 0xFFFFFF80u; u = (u & 0x80000000u) ? (u ^ 0x80000000u) : ~u; return __builtin_bit_cast(float, u); }
DI float dot2bf(unsigned a, unsigned b, float c) { return __builtin_amdgcn_fdot2_f32_bf16(__builtin_bit_cast(bf16x2_t, a), __builtin_bit_cast(bf16x2_t, b), c, false); }
DI float dot8(const u32x4& a, const u32x4& b, float c) { c = dot2bf(a.x, b.x, c); c = dot2bf(a.y, b.y, c); c = dot2bf(a.z, b.z, c); return dot2bf(a.w, b.w, c); }
__host__ __device__ constexpr int cand_off(int i) { return i == 0 ? 0 : i == 1 ? 16 : i == 2 ? 24 : i == 3 ? 29 : i == 4 ? 33 : i == 5 ? 36 : i == 6 ? 38 : i == 7 ? 40 : 34 + i; }
__host__ __device__ constexpr int cand_i(int c) { return c < 16 ? 0 : c < 24 ? 1 : c < 29 ? 2 : c < 33 ? 3 : c < 36 ? 4 : c < 38 ? 5 : c < 40 ? 6 : c < 42 ? 7 : c - 34; }
__host__ __device__ constexpr int cand_pos(int c) { return cand_i(c) * 16 + (c - cand_off(cand_i(c))); }

#define PEER_CE(i, j) do { const unsigned hi_ = max(k[i], k[j]), lo_ = min(k[i], k[j]); k[i] = hi_; k[j] = lo_; } while (0)
DI void peer_topk_first(const float* srow, LAS float* ssc, LAS unsigned char* six, int lane) {
    const int gq = lane >> 4, li = lane & 15;
    const float* sl = srow + (gq >> 1) * 256 + (gq & 1) * 128 + li * 8;
    f32x4 nva = __builtin_nontemporal_load((const f32x4*)sl), nvb = __builtin_nontemporal_load((const f32x4*)(sl + 4));
#pragma unroll 1
    for (int hp = 0; hp < 4; ++hp) {
        const f32x4 va = nva, vb = nvb;
        if (hp < 3) { nva = __builtin_nontemporal_load((const f32x4*)(sl + 512 * (hp + 1))); nvb = __builtin_nontemporal_load((const f32x4*)(sl + 512 * (hp + 1) + 4)); }
        unsigned k[8];
        k[0] = ord_key(va.x, li * 8 + 0); k[1] = ord_key(va.y, li * 8 + 1); k[2] = ord_key(va.z, li * 8 + 2); k[3] = ord_key(va.w, li * 8 + 3);
        k[4] = ord_key(vb.x, li * 8 + 4); k[5] = ord_key(vb.y, li * 8 + 5); k[6] = ord_key(vb.z, li * 8 + 6); k[7] = ord_key(vb.w, li * 8 + 7);
        PEER_CE(0, 1); PEER_CE(2, 3); PEER_CE(4, 5); PEER_CE(6, 7); PEER_CE(0, 2); PEER_CE(1, 3); PEER_CE(4, 6); PEER_CE(5, 7); PEER_CE(1, 2); PEER_CE(5, 6);
        PEER_CE(0, 4); PEER_CE(1, 5); PEER_CE(2, 6); PEER_CE(3, 7); PEER_CE(2, 4); PEER_CE(3, 5); PEER_CE(1, 2); PEER_CE(3, 4); PEER_CE(5, 6);
        unsigned mine = 0u;
#pragma unroll
        for (int rd = 0; rd < 16; ++rd) {
            const unsigned m = row_max16(k[0]);
            mine = (li == rd) ? m : mine;
            const bool wn = (k[0] == m);
            k[0] = wn ? k[1] : k[0]; k[1] = wn ? k[2] : k[1]; k[2] = wn ? k[3] : k[2]; k[3] = wn ? k[4] : k[3];
            k[4] = wn ? k[5] : k[4]; k[5] = wn ? k[6] : k[5]; k[6] = wn ? k[7] : k[6]; k[7] = wn ? 0u : k[7];
        }
        const int o = ((2 * hp + (gq >> 1)) * 2 + (gq & 1)) * 16 + li;
        ssc[o] = key_val(mine); six[o] = (unsigned char)(127u - (mine & 127u));
    }
}
DI void peer_topk_second(const LAS float* ssc, const LAS unsigned char* six, LAS int* widx, LAS float* wgate, int lane, int emask, int hd_lo, int hd_hi) {
    const int grp = lane >> 4, li = lane & 15;
    const int ri = li <= 1 ? 0 : li <= 8 ? li - 1 : 8, j0 = li == 1 ? 8 : 0;
    const int L = li <= 2 ? 8 : li == 3 ? 5 : li == 4 ? 4 : li == 5 ? 3 : li <= 8 ? 2 : li == 9 ? 8 : 0;
    const bool tail = li >= 9;
    const unsigned tag0 = tail ? 255u - 128u : 255u - (unsigned)(16 * ri + j0), tstep = tail ? 16u : 1u;
#pragma unroll 1
    for (int hd0 = hd_lo; hd0 < hd_hi; hd0 += 4) {
        const int hd = hd0 + grp;
        const LAS float* A = ssc + (hd * 2) * 16; const LAS float* B = A + 16;
        const LAS float* xp = tail ? A + 8 : B + j0;
        const float y = tail ? B[0] : A[ri];
        const f32x4 x0 = *(const LAS f32x4*)xp, x1 = *(const LAS f32x4*)(xp + 4);
        unsigned k[8];
#pragma unroll
        for (int jj = 0; jj < 8; ++jj) { const float v = (jj < 4 ? x0[jj & 3] : x1[jj & 3]) + y; unsigned u = __builtin_bit_cast(unsigned, v); u ^= (u >> 31) ? 0xFFFFFFFFu : 0x80000000u;
            k[jj] = jj < L ? ((u & 0xFFFFFF00u) | (tag0 - (unsigned)jj * tstep)) : 0u; }
        unsigned mine = 0u;
#pragma unroll
        for (int rd = 0; rd < 16; ++rd) {
            const unsigned m = row_max16(k[0]);
            mine = (li == rd) ? m : mine;
            const bool wn = (k[0] == m);
            k[0] = wn ? k[1] : k[0]; k[1] = wn ? k[2] : k[1]; k[2] = wn ? k[3] : k[2]; k[3] = wn ? k[4] : k[3];
            k[4] = wn ? k[5] : k[4]; k[5] = wn ? k[6] : k[5]; k[6] = wn ? k[7] : k[6]; k[7] = wn ? 0u : k[7];
        }
        const int tg_ = 255 - (int)(mine & 255u), ci = tg_ >> 4, cj = tg_ & 15;
        const float cs = A[ci] + B[cj];
        const int ia = (int)six[(hd * 2) * 16 + ci], ib = (int)six[(hd * 2 + 1) * 16 + cj];
        float mx = cs; mx = fmaxf(mx, dpp_f<0xB1>(mx)); mx = fmaxf(mx, dpp_f<0x4E>(mx)); mx = fmaxf(mx, dpp_f<0x141>(mx)); mx = fmaxf(mx, dpp_f<0x140>(mx));
        const float ev = __builtin_amdgcn_exp2f((cs - mx) * 1.4426950408889634f);
        const float sum = row_sum16(ev);
        if (hd < hd_hi) { widx[hd * 16 + li] = ((ia * 128 + ib) & emask) * 512  ; wgate[hd * 16 + li] = ev * __builtin_amdgcn_rcpf(sum); }
    }
}
#undef PEER_CE

constexpr float PEER_QSTEP = 0.35f;
constexpr float PEER_U_SCALE = 32.0f / PEER_QSTEP;
constexpr float PEER_UF4_SCALE = 64.0f;
constexpr float PEER_H4_SCALE = 2.0f;
#ifndef PEER_VACT
#define PEER_VACT 8
#endif
#ifndef PROBE_VMASK
#define PROBE_VMASK 0xFFFFFFFFu
#endif
constexpr int PEER_REC_WORDS = 160;
constexpr int PEER_VW_BYTES = 16896;
static_assert(8 * PEER_VW_BYTES <= MISC_OFF && PEER_VW_BYTES % 256 == 0, "PEER LDS map");
DI void glds16s_x4(const void* sbase, unsigned v0, unsigned v1, unsigned v2, unsigned v3, unsigned lds_dst) { unsigned keep;
    asm volatile("s_mov_b32 %0, m0\n\ts_mov_b32 m0, %6\n\ts_nop 0\n\tglobal_load_lds_dwordx4 %1, %5\n\tglobal_load_lds_dwordx4 %2, %5 offset:1024\n\tglobal_load_lds_dwordx4 %3, %5 offset:2048\n\tglobal_load_lds_dwordx4 %4, %5 offset:3072\n\ts_mov_b32 m0, %0"
                 : "=&s"(keep) : "v"(v0), "v"(v1), "v"(v2), "v"(v3), "s"(sbase), "s"(lds_dst) : "memory"); }
typedef int i32x2 __attribute__((ext_vector_type(2)));
typedef int i32x4 __attribute__((ext_vector_type(4)));
typedef int i32x8 __attribute__((ext_vector_type(8)));
#define PEER_LOADIDX(tile) do { const LAS int* ip_ = sidx + 16 * (tile) + (lane >> 5); _Pragma("unroll") for (int j_ = 0; j_ < 8; ++j_) nx[j_] = (unsigned)ip_[2 * j_]; } while (0)

constexpr int PEER_URT = 4;
#ifndef PEER_USPLIT
#define PEER_USPLIT 1
#endif
constexpr int PEER_USLOT_BYTES = 1280;
constexpr int PEER_USLOT_OFF = 0, PEER_UFLAG_OFF = 8 * PEER_USLOT_BYTES, PEER_ULIST_OFF = PEER_UFLAG_OFF + 64, PEER_UHROW_OFF = PEER_ULIST_OFF + 4 * 1280, PEER_URING_OFF = 17664, PEER_URING_BYTES = PEER_URT * 8192;
static_assert(PEER_UHROW_OFF + 4 * 512 <= PEER_URING_OFF && PEER_URING_OFF % 256 == 0 && PEER_URING_OFF + 4 * PEER_URING_BYTES <= MISC_OFF, "PEER U-phase LDS map");
DI void peer_u_phase(Frame& F, int tg) {
    F.refresh();
    __syncthreads();
    const int lane = F.lane, wv = F.wave, grp = lane >> 4;
    volatile LAS unsigned* flags = (volatile LAS unsigned*)(F.lds + PEER_UFLAG_OFF);
    if (F.tid < 8) flags[F.tid] = 0u;
    __syncthreads();
    const int pr = wv & 3, TSTEP = 4 * F.G;
    if (wv < 4) {
        LAS float* ssc = (LAS float*)(F.lds + PEER_ULIST_OFF + pr * 1280); LAS unsigned char* six = F.lds + PEER_ULIST_OFF + pr * 1280 + 1024;
        int k = 0;
#pragma unroll 1
        for (int tl = F.vcu + F.G * pr; tl < TG; tl += TSTEP, ++k) {
            const float* srow = (const float*)(F.ws + (tg == 0 ? WS_S : (tl < S1_SPLIT ? WS_S1 : (size_t)0))) + (size_t)tl * 2048;
            float tch0 = 0.f;
            if (tl + TSTEP < TG) tch0 = (srow + (size_t)TSTEP * 2048)[lane * 32];
            const int slot = 2 * pr + (k & 1);
            if (PEER_USPLIT) {
                while (flags[slot] != 0u) __builtin_amdgcn_s_sleep(2);
                asm volatile("" ::: "memory");
                peer_topk_first(srow, (LAS float*)(F.lds + PEER_USLOT_OFF + slot * PEER_USLOT_BYTES), F.lds + PEER_USLOT_OFF + slot * PEER_USLOT_BYTES + 1024, lane);
            } else {
                peer_topk_first(srow, ssc, six, lane);
                while (flags[slot] != 0u) __builtin_amdgcn_s_sleep(2);
                asm volatile("" ::: "memory");
                peer_topk_second(ssc, six, (LAS int*)(F.lds + PEER_USLOT_OFF + slot * PEER_USLOT_BYTES), (LAS float*)(F.lds + PEER_USLOT_OFF + slot * PEER_USLOT_BYTES + 512), lane, 16383, 0, 8);
            }
            asm volatile("s_waitcnt lgkmcnt(0)" :: "v"(tch0) : "memory");
            if (lane == 0) flags[slot] = 1u;
        }
    } else {
        LAS unsigned char* hrow = F.lds + PEER_UHROW_OFF + pr * 512;
        LAS unsigned char* ring = F.lds + PEER_URING_OFF + pr * PEER_URING_BYTES; const unsigned ringb = (unsigned)(uintptr_t)ring;
        const unsigned char* Ub = F.ws + WS_U;
        unsigned usw[4];
#pragma unroll
        for (int q = 0; q < 4; ++q) usw[q] = 16u * (unsigned)((lane & 31) ^ (2 * q + (lane >> 5))) + (4096u - 1024u * q);
        const LAS unsigned char* uadr[4];
#pragma unroll
        for (int j = 0; j < 4; ++j) uadr[j] = ring + (lane & 15) * 512 + 64 * (j ^ ((lane & 15) >> 2)) + 16 * (grp ^ (lane & 3));
#define PEER_ISSUE8U(tile) do { const unsigned rs_ = (unsigned)__builtin_amdgcn_readfirstlane((int)(ringb + (unsigned)((tile) % PEER_URT) * 8192u)); \
            glds16s_x4(Ub - 4096, nx[0] + usw[0], nx[1] + usw[1], nx[2] + usw[2], nx[3] + usw[3], rs_); \
            glds16s_x4(Ub - 4096, nx[4] + (usw[0] ^ 128u), nx[5] + (usw[1] ^ 128u), nx[6] + (usw[2] ^ 128u), nx[7] + (usw[3] ^ 128u), rs_ + 4096u); } while (0)
        float nssp = 0.f; u32x4 nw0 = {0u, 0u, 0u, 0u}, nw1 = {0u, 0u, 0u, 0u};
#define PEER_ALOAD(tl_) do { const size_t t_ = (size_t)tg * TG + (tl_); nssp = ((const float*)(F.ws + WS_SSP) + t_ * 16)[lane & 15]; \
            const bf16* xr_ = (const bf16*)(F.ws + WS_XG) + t_ * 1024 + 16 * lane; nw0 = *(const u32x4*)xr_; nw1 = *(const u32x4*)(xr_ + 8); } while (0)
        const int tl0 = F.vcu + F.G * pr;
        if (tl0 < TG) PEER_ALOAD(tl0);
        int k = 0;
#pragma unroll 1
        for (int tl = tl0; tl < TG; tl += TSTEP, ++k) {
            const size_t t = (size_t)tg * TG + tl;
            const float hs = __builtin_amdgcn_rsqf(row_sum16(nssp) * (1.0f / 1024.0f) + EPS) * PEER_H4_SCALE;
            { const u32x4 w0 = nw0, w1 = nw1; u32x2 hq;
              hq.x = __builtin_amdgcn_cvt_scalef32_pk_fp4_f32(0u, bflo(w0[0]) * hs, bfhi(w0[0]) * hs, 1.0f, 0); hq.x = __builtin_amdgcn_cvt_scalef32_pk_fp4_f32(hq.x, bflo(w0[1]) * hs, bfhi(w0[1]) * hs, 1.0f, 1);
              hq.x = __builtin_amdgcn_cvt_scalef32_pk_fp4_f32(hq.x, bflo(w0[2]) * hs, bfhi(w0[2]) * hs, 1.0f, 2); hq.x = __builtin_amdgcn_cvt_scalef32_pk_fp4_f32(hq.x, bflo(w0[3]) * hs, bfhi(w0[3]) * hs, 1.0f, 3);
              hq.y = __builtin_amdgcn_cvt_scalef32_pk_fp4_f32(0u, bflo(w1[0]) * hs, bfhi(w1[0]) * hs, 1.0f, 0); hq.y = __builtin_amdgcn_cvt_scalef32_pk_fp4_f32(hq.y, bflo(w1[1]) * hs, bfhi(w1[1]) * hs, 1.0f, 1);
              hq.y = __builtin_amdgcn_cvt_scalef32_pk_fp4_f32(hq.y, bflo(w1[2]) * hs, bfhi(w1[2]) * hs, 1.0f, 2); hq.y = __builtin_amdgcn_cvt_scalef32_pk_fp4_f32(hq.y, bflo(w1[3]) * hs, bfhi(w1[3]) * hs, 1.0f, 3);
              *(LAS u32x2*)(hrow + 8 * lane) = hq; }
            i32x4 hA[8];
#pragma unroll
            for (int ks = 0; ks < 8; ++ks) hA[ks] = *(const LAS i32x4*)(hrow + 64 * ks + 16 * grp);
            if (tl + TSTEP < TG) PEER_ALOAD(tl + TSTEP);
            const int slot = 2 * pr + (k & 1);
            const LAS unsigned char* sb = F.lds + PEER_USLOT_OFF + slot * PEER_USLOT_BYTES;
            LAS int* pidx = (LAS int*)(F.lds + PEER_ULIST_OFF + pr * 1280); LAS float* pgate = (LAS float*)(F.lds + PEER_ULIST_OFF + pr * 1280 + 512);
            const LAS int* sidx = PEER_USPLIT ? (const LAS int*)pidx : (const LAS int*)sb; const LAS float* sgate = PEER_USPLIT ? (const LAS float*)pgate : (const LAS float*)(sb + 512);
            while (flags[slot] != 1u) __builtin_amdgcn_s_sleep(2);
            asm volatile("" ::: "memory");
            if (PEER_USPLIT) { peer_topk_second((const LAS float*)sb, sb + 1024, pidx, pgate, lane, 16383, 0, 8);
                asm volatile("s_waitcnt lgkmcnt(0)" ::: "memory");
                if (lane == 0) flags[slot] = 0u; }
            unsigned nx[8];
#pragma unroll
            for (int tt = 0; tt < PEER_URT; ++tt) { PEER_LOADIDX(tt); PEER_ISSUE8U(tt); }
            PEER_LOADIDX(PEER_URT);
            float dotA = 0.f, dotB = 0.f;
#pragma unroll 1
            for (int tt = 0; tt < 8; ++tt) {
                const int rp = (tt % PEER_URT) * 8192, left = 7 - tt < PEER_URT - 1 ? 7 - tt : PEER_URT - 1;
                if (left >= 3) asm volatile("s_waitcnt vmcnt(24)" ::: "memory"); else if (left == 2) asm volatile("s_waitcnt vmcnt(16)" ::: "memory"); else if (left == 1) asm volatile("s_waitcnt vmcnt(8)" ::: "memory"); else asm volatile("s_waitcnt vmcnt(0)" ::: "memory");
                f32x4 acc = {0.f, 0.f, 0.f, 0.f};
#pragma unroll
                for (int ks = 0; ks < 8; ++ks) { const i32x4 b_ = *(const LAS i32x4*)(uadr[ks & 3] + rp + 256 * (ks >> 2));
                    const i32x8 b8_ = {b_.x, b_.y, b_.z, b_.w, 0, 0, 0, 0};
                    const i32x8 a8_ = {hA[ks].x, hA[ks].y, hA[ks].z, hA[ks].w, 0, 0, 0, 0};
                    acc = __builtin_amdgcn_mfma_scale_f32_16x16x128_f8f6f4(a8_, b8_, acc, 4  , 4  , 0, 127, 0, 127); }
                dotA = (tt == grp) ? acc[0] : dotA; dotB = (tt == grp + 4) ? acc[0] : dotB;
                __builtin_amdgcn_sched_barrier(0);
                if (tt + PEER_URT < 8) { PEER_ISSUE8U(tt + PEER_URT); PEER_LOADIDX((tt + PEER_URT + 1) & 7); }
                __builtin_amdgcn_sched_barrier(0);
            }
            const float ascale = 1.0f / (PEER_H4_SCALE * PEER_UF4_SCALE);
            unsigned loA, hiA, loB, hiB; float bscA, bscB;
            { const float av = dotA * ascale, bv = dotB * ascale;
              const float cA = sgate[lane] * (0.5f * av * (1.0f + erff(av * 0.70710678118654752f))), cB = sgate[64 + lane] * (0.5f * bv * (1.0f + erff(bv * 0.70710678118654752f)));
              const float mxA = __builtin_bit_cast(float, row_max16(__builtin_bit_cast(unsigned, fabsf(cA)))), mxB = __builtin_bit_cast(float, row_max16(__builtin_bit_cast(unsigned, fabsf(cB))));
              const float qsA = mxA > 0.f ? 7.0f * __builtin_amdgcn_rcpf(mxA) : 0.f, qsB = mxB > 0.f ? 7.0f * __builtin_amdgcn_rcpf(mxB) : 0.f;
              const unsigned cqA = ((unsigned)(int)__builtin_rintf(cA * qsA) & 15u) << (4 * (lane & 7)), cqB = ((unsigned)(int)__builtin_rintf(cB * qsB) & 15u) << (4 * (lane & 7));
              loA = (lane & 8) ? 0u : cqA; hiA = (lane & 8) ? cqA : 0u; loB = (lane & 8) ? 0u : cqB; hiB = (lane & 8) ? cqB : 0u;
              loA |= dpp_u<0xB1>(loA); loA |= dpp_u<0x4E>(loA); loA |= dpp_u<0x141>(loA); loA |= dpp_u<0x140>(loA);
              hiA |= dpp_u<0xB1>(hiA); hiA |= dpp_u<0x4E>(hiA); hiA |= dpp_u<0x141>(hiA); hiA |= dpp_u<0x140>(hiA);
              loB |= dpp_u<0xB1>(loB); loB |= dpp_u<0x4E>(loB); loB |= dpp_u<0x141>(loB); loB |= dpp_u<0x140>(loB);
              hiB |= dpp_u<0xB1>(hiB); hiB |= dpp_u<0x4E>(hiB); hiB |= dpp_u<0x141>(hiB); hiB |= dpp_u<0x140>(hiB);
              bscA = mxA * (1.0f / 7.0f); bscB = mxB * (1.0f / 7.0f); }
            unsigned* rec = (unsigned*)(F.ws + WS_PL) + t * PEER_REC_WORDS;
            rec[lane] = (unsigned)sidx[lane]; rec[64 + lane] = (unsigned)sidx[64 + lane];
            if ((lane & 15) == 0) { rec[128 + grp] = loA; rec[132 + grp] = loB; rec[136 + grp] = hiA; rec[140 + grp] = hiB; rec[144 + grp] = __builtin_bit_cast(unsigned, bscA); rec[148 + grp] = __builtin_bit_cast(unsigned, bscB); }
            if (!PEER_USPLIT) { asm volatile("s_waitcnt lgkmcnt(0)" ::: "memory"); if (lane == 0) flags[slot] = 0u; }
        }
#undef PEER_ALOAD
#undef PEER_ISSUE8U
    }
}

DI void peer_v_phase(Frame& F, int tg, bool dry) {
    F.refresh();
    __syncthreads();
    const int lane = F.lane, wv = F.wave;
    LAS unsigned char* wb = F.lds + wv * PEER_VW_BYTES;
    LAS int* sidx = (LAS int*)wb;
    LAS unsigned char* ring = wb + 512; const unsigned ringb = (unsigned)(uintptr_t)ring;
    const unsigned char* Vb = F.ws + WS_V;
    const int a16 = (lane ^ 16) << 2, a32 = (lane ^ 32) << 2;
    unsigned usw[4];
#pragma unroll
    for (int q = 0; q < 4; ++q) usw[q] = 16u * (unsigned)((lane & 31) ^ (2 * q + (lane >> 5))) + (4096u - 1024u * q);
#define PEER_ISSUE8V(tile) do { const unsigned rs_ = (unsigned)__builtin_amdgcn_readfirstlane((int)(ringb + (unsigned)((tile) & 1) * 8192u)); \
        glds16s_x4(Vb - 4096, nx[0] + usw[0], nx[1] + usw[1], nx[2] + usw[2], nx[3] + usw[3], rs_); \
        glds16s_x4(Vb - 4096, nx[4] + (usw[0] ^ 128u), nx[5] + (usw[1] ^ 128u), nx[6] + (usw[2] ^ 128u), nx[7] + (usw[3] ^ 128u), rs_ + 4096u); } while (0)
    unsigned vxo[8];
#pragma unroll
    for (int l = 0; l < 8; ++l) vxo[l] = 32u * (unsigned)(l ^ ((lane & 15) >> 1));
    const LAS unsigned char* rowb0 = ring + (lane & 15) * 512 + 16 * (((lane >> 5) ^ lane) & 1) + 8 * ((lane >> 4) & 1);
    float gf[16];
#pragma unroll
    for (int cb = 0; cb < 16; ++cb) gf[cb] = F.final_norm_g[lane + 64 * cb];
    const int TSTEP = PEER_VACT * F.G;
    if (wv >= PEER_VACT) return;
    unsigned pi0 = 0u, pi1 = 0u, pcw = 0u; float px[16];
#define PEER_VFETCH(tl_) do { const size_t t_ = (size_t)tg * TG + (tl_); const unsigned* rec_ = (const unsigned*)(F.ws + WS_PL) + t_ * PEER_REC_WORDS; pi0 = rec_[lane]; pi1 = rec_[64 + lane]; pcw = rec_[128 + (lane & 31)]; \
        const float* xo_ = F.out + t_ * 1024 + lane; _Pragma("unroll") for (int cb = 0; cb < 16; ++cb) px[cb] = xo_[64 * cb]; } while (0)
    { const int tl0 = F.vcu + F.G * wv; if (tl0 < TG) PEER_VFETCH(tl0); else {
#pragma unroll
        for (int cb = 0; cb < 16; ++cb) px[cb] = 0.f; } }
#pragma unroll 1
    for (int tl = F.vcu + F.G * wv; tl < TG; tl += TSTEP) {
        const size_t t = (size_t)tg * TG + tl;
        const unsigned cw = pcw; float xa[16];
#pragma unroll
        for (int cb = 0; cb < 16; ++cb) xa[cb] = px[cb];
        sidx[lane] = (int)(dry ? pi0 & PROBE_VMASK : pi0); sidx[64 + lane] = (int)(dry ? pi1 & PROBE_VMASK : pi1);
        asm volatile("s_waitcnt lgkmcnt(0)" ::: "memory");
        unsigned nx[8];
        PEER_LOADIDX(0); PEER_ISSUE8V(0); PEER_LOADIDX(1); PEER_ISSUE8V(1); PEER_LOADIDX(2);
        float oacc[16];
#pragma unroll
        for (int cb = 0; cb < 16; ++cb) oacc[cb] = 0.f;
#pragma unroll 1
        for (int vb = 0; vb < 8; ++vb) {
            if (vb < 6) asm volatile("s_waitcnt vmcnt(8)" ::: "memory"); else if (vb == 6) asm volatile("s_waitcnt vmcnt(27)" ::: "memory"); else asm volatile("s_waitcnt vmcnt(19)" ::: "memory");
            const int clo = __builtin_amdgcn_readlane((int)cw, vb), chi = __builtin_amdgcn_readlane((int)cw, 8 + vb);
            const float bsc = __builtin_bit_cast(float, __builtin_amdgcn_readlane((int)cw, 16 + vb));
            const LAS unsigned char* rowp = rowb0 + (vb & 1) * 8192;
#pragma unroll
            for (int cb = 0; cb < 16; ++cb) {
                const i32x2 tr = __builtin_amdgcn_ds_read_tr4_b64_v2i32((LAS i32x2*)(rowp + vxo[cb & 7] + 256 * (cb >> 3)));
                const int ai = __builtin_amdgcn_sdot8(chi, tr.y, __builtin_amdgcn_sdot8(clo, tr.x, 0, false), false);
                oacc[cb] += (float)ai * bsc;
            }
            if (vb < 6) { PEER_ISSUE8V(vb + 2); PEER_LOADIDX((vb + 3) & 7); }
            if (vb == 5) { const int tn_ = tl + TSTEP < TG ? tl + TSTEP : tl; PEER_VFETCH(tn_); }
        }
        float* xo = dry ? (float*)(F.ws + WS_PROJ + (128u << 20)) + (size_t)tl * 1024 + lane : F.out + t * 1024 + lane;
        float ss = 0.f;
#pragma unroll
        for (int cb = 0; cb < 16; ++cb) { xa[cb] = xa[cb] + oacc[cb] * (1.0f / PEER_U_SCALE); ss += xa[cb] * xa[cb]; }
        ss = row_sum16(ss); ss += bperm_f(a16, ss); ss += bperm_f(a32, ss);
        const float rf = __builtin_amdgcn_rsqf(ss * (1.0f / 1024.0f) + EPS);
#pragma unroll
        for (int cb = 0; cb < 16; ++cb) __builtin_nontemporal_store(xa[cb] * rf * gf[cb], xo + 64 * cb);
    }
#undef PEER_VFETCH
#undef PEER_ISSUE8V
}
#undef PEER_LOADIDX

constexpr int UV_IDS = 2 * 16384 * 64;
DI void convert_uv(Frame& F, int begin, int end, int cu, int ncu) {
    F.refresh();
    const int gt = cu * 512 + F.tid, NGT = ncu * 512;
#pragma unroll 1
    for (int id0 = begin + gt; id0 < end; id0 += 4 * NGT) {
        f32x4 v[4][4];
#pragma unroll
        for (int k = 0; k < 4; ++k) { const int id = id0 + k * NGT < end ? id0 + k * NGT : id0; const int which = id >> 20, off = (id & ((1 << 20) - 1)) * 16; const float* src = (which ? F.peer_v : F.peer_u) + off;
#pragma unroll
            for (int j = 0; j < 4; ++j) v[k][j] = *(const f32x4*)(src + 4 * j); }
#pragma unroll
        for (int k = 0; k < 4; ++k) { const int id = id0 + k * NGT; if (id >= end) break;
            const int which = id >> 20, off = (id & ((1 << 20) - 1)) * 16; unsigned char* dst = F.ws + (which ? WS_V : WS_U) + off / 2;
            u32x2 o;
            if (which == 0) {
#pragma unroll
                for (int q = 0; q < 2; ++q) { const f32x4 v0 = v[k][2 * q] * PEER_UF4_SCALE, v1 = v[k][2 * q + 1] * PEER_UF4_SCALE;
                    unsigned pk = __builtin_amdgcn_cvt_scalef32_pk_fp4_f32(0u, v0.x, v0.y, 1.0f, 0); pk = __builtin_amdgcn_cvt_scalef32_pk_fp4_f32(pk, v0.z, v0.w, 1.0f, 1);
                    pk = __builtin_amdgcn_cvt_scalef32_pk_fp4_f32(pk, v1.x, v1.y, 1.0f, 2); pk = __builtin_amdgcn_cvt_scalef32_pk_fp4_f32(pk, v1.z, v1.w, 1.0f, 3); o[q] = pk; }
            } else {
#pragma unroll
                for (int q = 0; q < 2; ++q) { const f32x4 v0 = v[k][2 * q] * PEER_U_SCALE, v1 = v[k][2 * q + 1] * PEER_U_SCALE; unsigned pk = 0u;
#pragma unroll
                    for (int e = 0; e < 4; ++e) { pk |= ((unsigned)(int)__builtin_rintf(fminf(fmaxf(v0[e], -7.f), 7.f)) & 15u) << (4 * e); pk |= ((unsigned)(int)__builtin_rintf(fminf(fmaxf(v1[e], -7.f), 7.f)) & 15u) << (16 + 4 * e); }
                    o[q] = pk; }
            }
            __builtin_nontemporal_store(o, (u32x2*)dst); }
    }
}

constexpr int QRS_OFF = 131072, QRS_MAXU = 3;
static_assert(QRS_OFF + QRS_MAXU * 1024 <= MISC_OFF, "q row scales in LDS");
template <class QS> DI void q_row_scales(Frame& F, const QS& S, int tg) {
    F.refresh();
    const float* ssp = (const float*)(F.ws + WS_SSP) + (size_t)tg * TG * 16;
    LAS float* rsl = (LAS float*)(F.lds + QRS_OFF);
    pg8::Unit u;
    for (int i = 0; i < QRS_MAXU && S.next(i, u); ++i) {
        if (F.tid < 256) { const f32x4* sp = (const f32x4*)(ssp + (size_t)(u.pm * 256 + F.tid) * 16);
            const f32x4 s0 = sp[0], s1 = sp[1], s2 = sp[2], s3 = sp[3];
            const float ss = ((s0[0] + s0[1]) + (s0[2] + s0[3])) + ((s1[0] + s1[1]) + (s1[2] + s1[3])) + ((s2[0] + s2[1]) + (s2[2] + s2[3])) + ((s3[0] + s3[1]) + (s3[2] + s3[3]));
            rsl[u.z * 256 + F.tid] = 1.0f / sqrtf(ss * (1.0f / 1024.0f) + EPS); }
    }
    __syncthreads();
}

constexpr int N_PHASES = 19;
struct Args { const float* in[17]; float* out; unsigned char* ws; int ph_lo, ph_hi; };

__global__ void __launch_bounds__(NWAVES * 64, 2) fwd_kernel(Args args) {
    extern __shared__ __attribute__((aligned(16))) unsigned char lds_raw[];
    Frame F;
    F.lds = (LAS unsigned char*)lds_raw;
    F.tid = threadIdx.x; F.lane = F.tid & 63; F.wave = __builtin_amdgcn_readfirstlane(F.tid >> 6);
    F.G = gridDim.x; { const int bx = blockIdx.x; F.vcu = (F.G % 8 == 0) ? (bx % 8) * (F.G / 8) + bx / 8 : bx; }
    F.x = args.in[0]; F.mem = args.in[1]; F.norm_mix_g = args.in[2]; F.w_in = args.in[3]; F.hg_lb = args.in[4]; F.hg_norm_g = args.in[5]; F.sc_conv_w = args.in[6];
    F.mem_norm_g = args.in[7]; F.w_mem_kv = args.in[8]; F.w_branch = args.in[9]; F.w_out = args.in[10]; F.norm_ffn_g = args.in[11]; F.peer_w_q = args.in[12];
    F.peer_sub_keys = args.in[13]; F.peer_u = args.in[14]; F.peer_v = args.in[15]; F.final_norm_g = args.in[16];
    F.out = args.out; F.ws = args.ws;
    volatile LAS unsigned* MISC = (volatile LAS unsigned*)(F.lds + MISC_OFF);
    for (int u = F.tid; u < (LDS_BYTES - MISC_OFF) / 4; u += NWAVES * 64) MISC[u] = 0u;
    __syncthreads();
    unsigned* barw = (unsigned*)(F.ws + WS_CTL) + CW_BAR;
    XcdBarrier bar; bar.bar = barw; bar.x = 0; bar.st = nullptr;
    const bool one_launch = (args.ph_hi - args.ph_lo) > 1;
    if (one_launch) bar = xcd_barrier_post(barw, MISC + 8);
    const int lo = args.ph_lo, hi = args.ph_hi;
#define IN(k) (lo <= (k) && (k) < hi)
#ifndef PMASK
#define PMASK 0x3ff
#endif
#define PC_(c) ((PMASK >> (c)) & 1)
#ifndef REP_MASK
#define REP_MASK 0
#endif
#define REPS(c) for (int rep_ = 0; rep_ < 1 + 2 * ((REP_MASK >> (c)) & 1); ++rep_)
#define SEAM(k) do { if (IN(k) && IN((k) + 1)) xcd_barrier(bar); } while (0)
#define LOCAL_SEAM(k) do { if (IN(k) && IN((k) + 1)) { asm volatile("s_waitcnt vmcnt(0)" ::: "memory"); __builtin_amdgcn_fence(__ATOMIC_RELEASE, "workgroup"); __syncthreads(); __builtin_amdgcn_fence(__ATOMIC_ACQUIRE, "workgroup"); } } while (0)
    unsigned char* ws = F.ws;
    const int G = F.G, cid = (int)blockIdx.x;

    constexpr int UV_T1 = 699392, UV_T2 = 2 * 699392;
    if (PC_(0) && IN(0)) { REPS(0) p0_prologue(F); }
    if (one_launch && IN(0) && IN(2)) { xcd_barrier_arrive(bar); convert_uv(F, 0, UV_T1, cid, G); xcd_barrier_wait(bar); }
    else SEAM(0);

    auto opq = [](int v) { asm volatile("" : "+s"(v)); return v; };
    auto mk_in = [&](int g) { pg8::InOrder S; S.init(TG, PC, opq(G), opq(cid)); S.H = (const char*)(ws + WS_XG) + (size_t)g * TG * 1024 * 2; S.Win = (const char*)(ws + WS_WIN); S.Mn = (const char*)(ws + WS_MN); S.Wkv = (const char*)(ws + WS_WKV); S.n_extra = (g == 0) ? 64 : 0; return S; };
    auto mk_out = [&]() { pg8::PlainOrder S; S.init(TG, 1024, opq(G), opq(cid)); S.A = (const char*)(ws + WS_MERGED); S.Bt = (const char*)(ws + WS_WOUT); S.a_tile = 256 * 1024 * 2; S.b_tile = 256 * 1024 * 2; return S; };
    auto mk_q = [&](int tg) { pg8::QOrder S; S.init(TG, 2048, opq(G), opq(cid)); S.A = (const char*)(ws + WS_XG) + (size_t)tg * TG * 1024 * 2; S.Bt = (const char*)(ws + WS_WQ); S.a_tile = 256 * 1024 * 2; S.b_tile = 256 * 1024 * 2; return S; };
    auto ep_out = [&](int g) { return pg8::EpiOut{F.x + (size_t)g * TG * 1024, F.out + (size_t)g * TG * 1024, (bf16*)(ws + WS_XG) + (size_t)g * TG * 1024, F.norm_ffn_g, (float*)(ws + WS_SSP) + (size_t)g * TG * 16}; };
    auto ep_q = [&](int) { return pg8::EpiQ{(bf16*)(ws + WS_Q), 2048, (const LAS float*)(F.lds + QRS_OFF)}; };
    const pg8::EpiIn ep_in{(bf16*)(ws + WS_PROJ), (bf16*)(ws + WS_KMEM), (bf16*)(ws + WS_VT)};
    auto do_q = [&](int tg, int lo_, int hi_) __attribute__((always_inline)) { pg8::QOrder S = mk_q(tg); S.lo = lo_; S.hi = hi_; q_row_scales(F, S, tg); const pg8::EpiQ E = ep_q(tg);
        pg8::gemm_phase<pg8::EpiQ, pg8::QOrder, true, true>(F.lds, pg8::Gemm{1024, 1024, 1024}, S, E); };
#pragma unroll 1
    for (int g = 0; g < NGRP; ++g) {
        const int pb = g == 0 ? 1 : 6;
        if (PC_(1) && IN(pb)) {
            if (g == 0) { REPS(1) { const pg8::InOrder S = mk_in(0);
                pg8::gemm_phase<pg8::EpiIn, pg8::InOrder, true, true>(F.lds, pg8::Gemm{1024, 1024, 1024}, S, ep_in); } }
            else { pg8::MixOrder<pg8::InOrder> S; S.y = mk_in(1); S.o = mk_out(); S.finish(opq(cid));
                const pg8::EpiMix<pg8::EpiIn> E{ep_in, ep_out(0)};
                pg8::gemm_phase<pg8::EpiMix<pg8::EpiIn>, pg8::MixOrder<pg8::InOrder>, true, true>(F.lds, pg8::Gemm{1024, 1024, 1024}, S, E); }
            if (!(one_launch && IN(pb + 1)) && cid >= 128) convert_uv(F, g * (UV_IDS / 2), (g + 1) * (UV_IDS / 2), cid - 128, G - 128);
        }
        if (one_launch && IN(pb) && IN(pb + 1)) { xcd_barrier_arrive(bar); convert_uv(F, g == 0 ? UV_T1 : UV_T2, g == 0 ? UV_T2 : UV_IDS, cid, G); xcd_barrier_wait(bar); }
        else SEAM(pb);
        if (one_launch && IN(pb + 1) && IN(pb + 3)) {
            if (PC_(2)) { for (int it = F.vcu * 4; it < BG * 4 * NCHUNK; it += G * 4) { for (int k = 0; k < 4; ++k) hgrn_a_item(F, it + k, k < 3); } }
            xcd_barrier_arrive(bar);
            if (PC_(2)) conv_phase(F);
            xcd_barrier_wait(bar);
            if (PC_(3)) hgrn_scan(F);
            xcd_barrier_arrive(bar);
            if (PC_(2)) { for (int it = F.vcu; it < BG * 4 * 8; it += G) attn_item(F, g, it); }
            xcd_barrier_wait(bar);
            if (PC_(4)) { for (int it = F.vcu * 4; it < BG * 4 * NCHUNK; it += G * 4) { for (int k = 0; k < 4; ++k) hgrn_c_item(F, it + k, k < 3); } }
            if (g == NGRP - 1 && IN(11)) { xcd_barrier_arrive(bar); if (PC_(6)) do_q(0, 0, 1); xcd_barrier_wait(bar); }
            else xcd_barrier(bar);
        } else {
        if (PC_(2) && IN(pb + 1)) REPS(2) {
            for (int it = F.vcu * 4; it < BG * 4 * NCHUNK; it += G * 4) { for (int k = 0; k < 4; ++k) hgrn_a_item(F, it + k, k < 3); }
            for (int it = F.vcu; it < BG * 4 * 8; it += G) attn_item(F, g, it);
            conv_phase(F);
        } SEAM(pb + 1);
        if (PC_(3) && IN(pb + 2)) { REPS(3) hgrn_scan(F); } SEAM(pb + 2);
        if (PC_(4) && IN(pb + 3)) REPS(4) { for (int it = F.vcu * 4; it < BG * 4 * NCHUNK; it += G * 4) { for (int k = 0; k < 4; ++k) hgrn_c_item(F, it + k, k < 3); } } SEAM(pb + 3);
        }
        if (PC_(5) && IN(pb + 4)) REPS(5) {
            pg8::BranchOrder S; S.init(TG, 1024, G, cid); S.Y = (const char*)(ws + WS_YHG); S.Wb = (const char*)(ws + WS_WBR);
            pg8::EpiBranch E{(const bf16*)(ws + WS_PROJ), (bf16*)(ws + WS_MERGED)};
            pg8::gemm_phase<pg8::EpiBranch, pg8::BranchOrder, true, true>(F.lds, pg8::Gemm{512, 512, 512}, S, E);
        } if (!(one_launch && g == NGRP - 1 && IN(pb + 5))) SEAM(pb + 4);
    }
    const bool fuseq = one_launch && IN(10) && IN(11), fuse2 = one_launch && IN(11) && IN(17);
    if (IN(11)) {
        if (fuseq) xcd_barrier_arrive(bar);
        if (PC_(6)) do_q(0, fuseq ? 1 : 0, 1 << 30);
        if (fuseq) xcd_barrier_wait(bar);
        if (PC_(6)) { const pg8::PlainOrder S = mk_out(); const pg8::EpiOut E = ep_out(1);
            pg8::gemm_phase<pg8::EpiOut, pg8::PlainOrder, true, true>(F.lds, pg8::Gemm{1024, 1024, 1024}, S, E); }
        if (fuse2) xcd_barrier_arrive(bar);
    } LOCAL_SEAM(11);
    auto do_q1 = [&]() __attribute__((always_inline)) { if (PC_(7)) REPS(7) do_q(1, 0, 1 << 30); };
    auto do_score = [&](int tg) __attribute__((always_inline)) { if (PC_(8)) REPS(8) {
        pg8::ScoreOrder S; S.init(TG, 2048, opq(G), opq(cid)); S.Q = (const char*)(ws + WS_Q); S.Kbd = (const char*)(ws + WS_KBD);
        pg8::EpiF32 E{(float*)(ws + (tg == 0 ? WS_S : WS_S1)), 2048, tg == 0 ? (1 << 30) : S1_SPLIT / 256, -(long)(WS_S1 / 4)};
        pg8::gemm_phase<pg8::EpiF32, pg8::ScoreOrder, true, true>(F.lds, pg8::Gemm{2048, 256, 256}, S, E); } };
#define LOCAL_SYNC() do { asm volatile("s_waitcnt vmcnt(0)" ::: "memory"); __builtin_amdgcn_fence(__ATOMIC_RELEASE, "workgroup"); __syncthreads(); __builtin_amdgcn_fence(__ATOMIC_ACQUIRE, "workgroup"); } while (0)
    if (IN(12)) do_score(0);
    if (fuse2) { xcd_barrier_wait(bar);
                 xcd_barrier_arrive(bar); do_q1(); LOCAL_SYNC(); do_score(1); xcd_barrier_wait(bar);
                 xcd_barrier_arrive(bar); }
    else SEAM(12);
    if (PC_(9) && IN(13)) { REPS(9) peer_u_phase(F, 0); } LOCAL_SEAM(13);
    if (PC_(9) && IN(14)) { REPS(10) peer_v_phase(F, 0, rep_ < 2 * ((REP_MASK >> 10) & 1)); }
    if (fuse2) xcd_barrier_wait(bar);
    else { LOCAL_SEAM(14); if (IN(15)) do_q1(); LOCAL_SEAM(15); if (IN(16)) do_score(1); SEAM(16); }
    if (PC_(9) && IN(17)) { REPS(9) peer_u_phase(F, 1); } LOCAL_SEAM(17);
    if (PC_(9) && IN(18)) { REPS(10) peer_v_phase(F, 1, rep_ < 2 * ((REP_MASK >> 10) & 1)); }
#undef LOCAL_SYNC
#undef IN
#undef SEAM
#undef LOCAL_SEAM
}

extern "C" void kernel_launch(void* const* d_in, const int* in_sizes, int n_in, void* d_out, int out_size, void* d_ws, size_t ws_size, hipStream_t stream) {
    static int ready = 0;
    if (ready == 0) {
        if (n_in != 17 || out_size != T_ALL * D_MODEL || ws_size < WS_END) { fprintf(stderr, "kernel_launch: unexpected shapes (n_in %d, out %d, ws %zu)\n", n_in, out_size, ws_size); ready = -1; return; }
        if (hipFuncSetAttribute((const void*)fwd_kernel, hipFuncAttributeMaxDynamicSharedMemorySize, LDS_BYTES) != hipSuccess) { fprintf(stderr, "kernel_launch: hipFuncSetAttribute failed\n"); ready = -1; return; }
        ready = 1;
    }
    if (ready < 0) return;
    (void)hipMemsetAsync((char*)d_ws + WS_CTL, 0, CTL_ZERO_BYTES, stream);
    Args a{};
    for (int i = 0; i < 17; ++i) a.in[i] = (const float*)d_in[i];
    a.out = (float*)d_out; a.ws = (unsigned char*)d_ws;
    const int grid = 256;
#if MK_N_LAUNCHES == 1
    a.ph_lo = 0; a.ph_hi = N_PHASES;
    hipLaunchKernelGGL(fwd_kernel, dim3(grid), dim3(NWAVES * 64), LDS_BYTES, stream, a);
#else
    for (int li = 0; li < N_PHASES; ++li) { a.ph_lo = li; a.ph_hi = li + 1; hipLaunchKernelGGL(fwd_kernel, dim3(grid), dim3(NWAVES * 64), LDS_BYTES, stream, a); }
#endif
}
```
